# Optimizing an MI355X kernel written in HIP

```python
import jax, jax.numpy as jnp
from jax import lax
import numpy as np

D_MODEL = 1024
BATCH = 8
SEQ = 4096
DEPTH = 1

MEM_LEN = 256
D_MIX = D_MODEL
DSA_HEADS = 8
DSA_HEAD_DIM = 64
IDX_HEADS = 8
IDX_DIM = 32
TOPK_MAX = 256
Q_BLOCK = 128
GLA_HEADS = 4
GLA_DK = 64
GLA_DV = 128
GLA_GATE_RANK = 16
GLA_GATE_TEMP = 16.0
GLA_CHUNK = 64
ROPE_THETA = 500000.0
ROPE_FRACTION = 4
XATTN_HEADS = 4
XATTN_HEAD_DIM = D_MODEL // XATTN_HEADS
PEER_N_KEYS = 128
PEER_N_EXPERTS = PEER_N_KEYS * PEER_N_KEYS
PEER_HEADS = 8
PEER_D_KEY = 256
PEER_TOPK = 16
PEER_BLOCK = 128
LN_EPS = 1e-5
RMS_EPS = 1e-6
DEEPNORM_ALPHA = (2.0 * DEPTH) ** 0.25
DEEPNORM_BETA = (8.0 * DEPTH) ** -0.25
IN_SPLITS = (
    DSA_HEADS * DSA_HEAD_DIM,
    DSA_HEADS * DSA_HEAD_DIM,
    DSA_HEADS * DSA_HEAD_DIM,
    IDX_HEADS * IDX_DIM,
    IDX_DIM,
    IDX_HEADS,
    GLA_HEADS * GLA_DK,
    GLA_HEADS * GLA_DK,
    GLA_HEADS * GLA_DV,
    GLA_GATE_RANK,
    GLA_HEADS * GLA_DV,
)
IN_IS_VALUE = (False, False, True, False, False, False, False, False, True, False, False)
IN_WIDTH = sum(IN_SPLITS)

kernel_name = "hybrid_dsa_gla_peer_deepnorm"


def layer_norm(x, g, b):
    xf = x.astype(jnp.float32)
    mu = jnp.mean(xf, axis=-1, keepdims=True)
    var = jnp.mean(jnp.square(xf - mu), axis=-1, keepdims=True)
    return ((xf - mu) * lax.rsqrt(var + LN_EPS) * g.astype(jnp.float32) + b.astype(jnp.float32)).astype(x.dtype)


def rms_norm(x, g):
    xf = x.astype(jnp.float32)
    return xf * lax.rsqrt(jnp.mean(jnp.square(xf), axis=-1, keepdims=True) + RMS_EPS) * g.astype(jnp.float32)


def rotary_partial(x, positions):
    d = x.shape[-1]
    r = d // ROPE_FRACTION
    half = r // 2
    inv_freq = ROPE_THETA ** (-jnp.arange(half, dtype=jnp.float32) / half)
    ang = positions.astype(jnp.float32)[..., None] * inv_freq
    cos = jnp.cos(ang)[:, :, None, :]
    sin = jnp.sin(ang)[:, :, None, :]
    xf = x.astype(jnp.float32)
    x1, x2, x_pass = xf[..., :half], xf[..., half:r], xf[..., r:]
    out = jnp.concatenate([x1 * cos - x2 * sin, x2 * cos + x1 * sin, x_pass], axis=-1)
    return out.astype(x.dtype)


def dsa_attention(q, k, v, q_idx, k_idx, w_idx):
    B, S = q.shape[0], q.shape[1]
    n_sel = min(TOPK_MAX, S // 4)
    nb = S // Q_BLOCK

    def to_blocks(a):
        return jnp.moveaxis(a.reshape((B, nb, Q_BLOCK) + a.shape[2:]), 1, 0)

    k_idx_f = k_idx.astype(jnp.float32)
    key_pos = jnp.arange(S)
    b_ix = jnp.arange(B)[:, None, None]
    idx_scale = IDX_DIM ** -0.5
    w_scale = IDX_HEADS ** -0.5
    attn_scale = DSA_HEAD_DIM ** -0.5

    def block(args):
        blk, qb, qib, wb = args
        q_pos = blk * Q_BLOCK + jnp.arange(Q_BLOCK)
        causal = key_pos[None, :] <= q_pos[:, None]
        dots = jnp.einsum('bqhd,bsd->bqhs', qib.astype(jnp.float32), k_idx_f) * idx_scale
        score = jnp.einsum('bqh,bqhs->bqs', wb.astype(jnp.float32) * w_scale, jax.nn.relu(dots))
        score = jnp.where(causal[None], score, -jnp.inf)
        _, sel = lax.top_k(score, n_sel)
        valid = sel <= q_pos[None, :, None]
        k_sel = k[b_ix, sel]
        v_sel = v[b_ix, sel]
        logits = jnp.einsum('bqhd,bqkhd->bqhk', qb.astype(jnp.float32), k_sel.astype(jnp.float32)) * attn_scale
        logits = jnp.where(valid[:, :, None, :], logits, -jnp.inf)
        p = jax.nn.softmax(logits, axis=-1)
        return jnp.einsum('bqhk,bqkhd->bqhd', p.astype(v.dtype), v_sel)

    outs = lax.map(block, (jnp.arange(nb), to_blocks(q), to_blocks(q_idx), to_blocks(w_idx)))
    return jnp.moveaxis(outs, 0, 1).reshape(B, S, DSA_HEADS * DSA_HEAD_DIM)


def gla_chunked(q, k, v, log_a):
    B, S, H, dk = q.shape
    dv = v.shape[-1]
    C = GLA_CHUNK
    N = S // C

    def chunks(a):
        return a.astype(jnp.float32).reshape(B, N, C, H, a.shape[-1]).transpose(0, 3, 1, 2, 4)

    qc = chunks(q) * dk ** -0.5
    kc, vc, ac = chunks(k), chunks(v), chunks(log_a)
    bcum = jnp.cumsum(ac, axis=3)
    b_last = bcum[:, :, :, -1:, :]
    q_dec = qc * jnp.exp(bcum)
    k_inv = kc * jnp.exp(-bcum)
    k_to_end = kc * jnp.exp(b_last - bcum)
    causal = jnp.tril(jnp.ones((C, C), dtype=bool))
    attn = jnp.where(causal, jnp.einsum('bhncd,bhnsd->bhncs', q_dec, k_inv), 0.0)
    o_intra = jnp.einsum('bhncs,bhnse->bhnce', attn, vc)
    chunk_kv = jnp.einsum('bhnsd,bhnse->bhnde', k_to_end, vc)
    chunk_decay = jnp.exp(b_last[:, :, :, 0, :])

    def step(state, inp):
        decay, kv = inp
        return decay[..., None] * state + kv, state

    init = jnp.zeros((B, H, dk, dv), jnp.float32)
    _, prev = lax.scan(step, init, (jnp.moveaxis(chunk_decay, 2, 0), jnp.moveaxis(chunk_kv, 2, 0)))
    prev = jnp.moveaxis(prev, 0, 2)
    o_inter = jnp.einsum('bhncd,bhnde->bhnce', q_dec, prev)
    return (o_intra + o_inter).transpose(0, 2, 3, 1, 4).reshape(B, S, H, dv)


def hybrid_mixer(x, positions, w_in, gate_up, gate_bias, norm_g, w_out):
    B, S, _ = x.shape
    proj = jnp.einsum('bsd,de->bse', x, w_in)
    splits = np.cumsum(IN_SPLITS)[:-1].tolist()
    (q, k, v, q_idx, k_idx, w_idx, g_q, g_k, g_v, g_lr, g_r) = jnp.split(proj, splits, axis=-1)

    def heads(a, n):
        return a.reshape(B, S, n, a.shape[-1] // n)

    q = rotary_partial(heads(q, DSA_HEADS), positions)
    k = rotary_partial(heads(k, DSA_HEADS), positions)
    q_idx = rotary_partial(heads(q_idx, IDX_HEADS), positions)
    k_idx = rotary_partial(k_idx[:, :, None, :], positions)[:, :, 0, :]
    y_dsa = dsa_attention(q, k, heads(v, DSA_HEADS), q_idx, k_idx, w_idx)

    log_a = jax.nn.log_sigmoid((g_lr @ gate_up + gate_bias).astype(jnp.float32)) / GLA_GATE_TEMP
    o = gla_chunked(heads(g_q, GLA_HEADS), heads(g_k, GLA_HEADS), heads(g_v, GLA_HEADS),
                    log_a.reshape(B, S, GLA_HEADS, GLA_DK))
    o = rms_norm(o, norm_g).reshape(B, S, GLA_HEADS * GLA_DV).astype(x.dtype)
    y_gla = o * jax.nn.silu(g_r)

    y = jnp.concatenate([y_dsa, y_gla], axis=-1)
    return y @ w_out


def memory_cross_attention(x, mem, w_q, w_k, w_v, w_o):
    B, S, _ = x.shape
    M = mem.shape[1]
    q = (x @ w_q).reshape(B, S, XATTN_HEADS, XATTN_HEAD_DIM)
    k = (mem @ w_k).reshape(B, M, XATTN_HEADS, XATTN_HEAD_DIM)
    v = (mem @ w_v).reshape(B, M, XATTN_HEADS, XATTN_HEAD_DIM)
    logits = jnp.einsum('bshd,bmhd->bhsm', q.astype(jnp.float32), k.astype(jnp.float32)) * XATTN_HEAD_DIM ** -0.5
    p = jax.nn.softmax(logits, axis=-1).astype(v.dtype)
    o = jnp.einsum('bhsm,bmhd->bshd', p, v).reshape(B, S, D_MODEL)
    return o @ w_o


def peer(x, w_query, sub_keys_1, sub_keys_2, expert_down, expert_up):
    B, S, D = x.shape
    half = PEER_D_KEY // 2
    q = (x @ w_query).reshape(B, S, PEER_HEADS, PEER_D_KEY).astype(jnp.float32)
    s1 = jnp.einsum('bshd,nd->bshn', q[..., :half], sub_keys_1.astype(jnp.float32))
    s2 = jnp.einsum('bshd,nd->bshn', q[..., half:], sub_keys_2.astype(jnp.float32))
    v1, i1 = lax.top_k(s1, PEER_TOPK)
    v2, i2 = lax.top_k(s2, PEER_TOPK)
    n_cand = PEER_TOPK * PEER_TOPK
    cand = (v1[..., :, None] + v2[..., None, :]).reshape(B, S, PEER_HEADS, n_cand)
    cand_idx = (i1[..., :, None] * PEER_N_KEYS + i2[..., None, :]).reshape(B, S, PEER_HEADS, n_cand)
    top_s, pos = lax.top_k(cand, PEER_TOPK)
    experts = jnp.take_along_axis(cand_idx, pos, axis=-1)
    gates = jax.nn.softmax(top_s, axis=-1)

    T = B * S
    nb = T // PEER_BLOCK
    hk = PEER_HEADS * PEER_TOPK
    xb = x.reshape(nb, PEER_BLOCK, D)
    eb = experts.reshape(nb, PEER_BLOCK, hk)
    gb = gates.reshape(nb, PEER_BLOCK, hk)

    def block(args):
        xt, et, gt = args
        u = expert_down[et]
        act = jax.nn.gelu(jnp.einsum('td,tkd->tk', xt, u).astype(jnp.float32), approximate=False)
        vv = expert_up[et]
        return jnp.einsum('tk,tkd->td', (gt * act).astype(xt.dtype), vv)

    y = lax.map(block, (xb, eb, gb))
    return y.reshape(B, S, D)


def setup_inputs(seed: int = 0) -> dict:
    key = jax.random.key(seed)
    ks = jax.random.split(key, 24)
    f32 = jnp.float32
    nrm = lambda k, shape, scale: jax.random.normal(k, shape, f32) * scale
    col_scale = jnp.concatenate([jnp.full((n,), DEEPNORM_BETA if is_v else 1.0, f32)
                                 for n, is_v in zip(IN_SPLITS, IN_IS_VALUE)])
    return {
        "x": nrm(ks[0], (BATCH, SEQ, D_MODEL), 1.0),
        "positions": jnp.broadcast_to(jnp.arange(SEQ, dtype=jnp.int32)[None, :], (BATCH, SEQ)),
        "mem": nrm(ks[1], (BATCH, MEM_LEN, D_MODEL), 1.0),
        "w_in": nrm(ks[2], (DEPTH, D_MODEL, IN_WIDTH), D_MODEL ** -0.5) * col_scale,
        "gla_gate_up": nrm(ks[3], (DEPTH, GLA_GATE_RANK, GLA_HEADS * GLA_DK), GLA_GATE_RANK ** -0.5),
        "gla_gate_bias": nrm(ks[4], (DEPTH, GLA_HEADS * GLA_DK), 0.1),
        "gla_norm_g": 1.0 + nrm(ks[5], (DEPTH, GLA_DV), 0.01),
        "w_out": nrm(ks[6], (DEPTH, D_MIX, D_MODEL), D_MIX ** -0.5) * DEEPNORM_BETA,
        "ln_mix_g": 1.0 + nrm(ks[7], (DEPTH, D_MODEL), 0.01),
        "ln_mix_b": nrm(ks[8], (DEPTH, D_MODEL), 0.01),
        "xattn_w_q": nrm(ks[9], (DEPTH, D_MODEL, D_MODEL), D_MODEL ** -0.5),
        "xattn_w_k": nrm(ks[10], (DEPTH, D_MODEL, D_MODEL), D_MODEL ** -0.5),
        "xattn_w_v": nrm(ks[11], (DEPTH, D_MODEL, D_MODEL), D_MODEL ** -0.5) * DEEPNORM_BETA,
        "xattn_w_o": nrm(ks[12], (DEPTH, D_MODEL, D_MODEL), D_MODEL ** -0.5) * DEEPNORM_BETA,
        "ln_mem_g": 1.0 + nrm(ks[13], (DEPTH, D_MODEL), 0.01),
        "ln_mem_b": nrm(ks[14], (DEPTH, D_MODEL), 0.01),
        "peer_w_query": nrm(ks[15], (DEPTH, D_MODEL, PEER_HEADS * PEER_D_KEY), D_MODEL ** -0.5),
        "peer_sub_keys_1": nrm(ks[16], (DEPTH, PEER_N_KEYS, PEER_D_KEY // 2), (PEER_D_KEY // 2) ** -0.5),
        "peer_sub_keys_2": nrm(ks[17], (DEPTH, PEER_N_KEYS, PEER_D_KEY // 2), (PEER_D_KEY // 2) ** -0.5),
        "peer_expert_down": nrm(ks[18], (DEPTH, PEER_N_EXPERTS, D_MODEL), D_MODEL ** -0.5),
        "peer_expert_up": nrm(ks[19], (DEPTH, PEER_N_EXPERTS, D_MODEL), PEER_HEADS ** -0.5) * DEEPNORM_BETA,
        "ln_ffn_g": 1.0 + nrm(ks[20], (DEPTH, D_MODEL), 0.01),
        "ln_ffn_b": nrm(ks[21], (DEPTH, D_MODEL), 0.01),
    }


def reference(x, positions, mem, w_in, gla_gate_up, gla_gate_bias, gla_norm_g, w_out,
              ln_mix_g, ln_mix_b, xattn_w_q, xattn_w_k, xattn_w_v, xattn_w_o, ln_mem_g, ln_mem_b,
              peer_w_query, peer_sub_keys_1, peer_sub_keys_2, peer_expert_down, peer_expert_up,
              ln_ffn_g, ln_ffn_b):
    h = x
    for l in range(DEPTH):
        mix = hybrid_mixer(h, positions, w_in[l], gla_gate_up[l], gla_gate_bias[l], gla_norm_g[l], w_out[l])
        h = layer_norm(DEEPNORM_ALPHA * h + mix, ln_mix_g[l], ln_mix_b[l])
        ca = memory_cross_attention(h, mem, xattn_w_q[l], xattn_w_k[l], xattn_w_v[l], xattn_w_o[l])
        h = layer_norm(DEEPNORM_ALPHA * h + ca, ln_mem_g[l], ln_mem_b[l])
        ff = peer(h, peer_w_query[l], peer_sub_keys_1[l], peer_sub_keys_2[l],
                  peer_expert_down[l], peer_expert_up[l])
        h = layer_norm(DEEPNORM_ALPHA * h + ff, ln_ffn_g[l], ln_ffn_b[l])
    return h
```

```cpp
#include <hip/hip_runtime.h>
#include <hip/hip_cooperative_groups.h>
#include <cstdio>
#include <cmath>
namespace cg = cooperative_groups;

#define DI __device__ __forceinline__
typedef short bf16x8 __attribute__((ext_vector_type(8)));
typedef short bf16x4 __attribute__((ext_vector_type(4)));
typedef float f32x16 __attribute__((ext_vector_type(16)));
typedef float f32x4 __attribute__((ext_vector_type(4)));
typedef unsigned u32x4 __attribute__((ext_vector_type(4)));
typedef unsigned u32x2 __attribute__((ext_vector_type(2)));
typedef unsigned short u16;
typedef __bf16 bf2_t __attribute__((ext_vector_type(2)));
typedef float f2_t __attribute__((ext_vector_type(2)));

#define MFMA(a, b, c) __builtin_amdgcn_mfma_f32_32x32x16_bf16((a), (b), (c), 0, 0, 0)

constexpr int T_ = 32768;
constexpr int S_ = 4096;
constexpr int TMW = 2368;
constexpr int TM_Q = 0, TM_K = 512, TM_QI = 1024, TM_KI = 1280, TM_WI = 1312, TM_GLR = 1320, TM_GQ = 1344, TM_GK = 1600, TM_GR = 1856;
constexpr int PROJ_N = 3456;
constexpr float ALPHA = 1.189207115002721f;
constexpr size_t MiB = 1024 * 1024;

constexpr size_t OFF_XB = 0;
constexpr size_t OFF_EXD = 64 * MiB;
constexpr size_t OFF_EXU = 96 * MiB;
constexpr size_t OFF_WIN = 128 * MiB;
constexpr size_t OFF_WOUT = OFF_WIN + (size_t)PROJ_N * 1024 * 2;
constexpr size_t OFF_WQ = OFF_WOUT + 2 * MiB;
constexpr size_t OFF_WK = OFF_WQ + 2 * MiB;
constexpr size_t OFF_WV = OFF_WK + 2 * MiB;
constexpr size_t OFF_WO = OFF_WV + 2 * MiB;
constexpr size_t OFF_WPQ = OFF_WO + 2 * MiB;
constexpr size_t OFF_MEMB = 152 * MiB;
constexpr size_t OFF_MEMK = 156 * MiB;
constexpr size_t OFF_MEMVT = 160 * MiB;
constexpr size_t OFF_THR = 164 * MiB;
constexpr size_t OFF_SK = OFF_THR + 256 * 1024;
constexpr size_t OFF_DECAY = OFF_SK + 128 * 1024;
constexpr size_t OFF_TM = 168 * MiB;
constexpr size_t OFF_VT = 316 * MiB;
constexpr size_t OFF_GVT = 348 * MiB;
constexpr size_t OFF_KVT = 380 * MiB;
constexpr size_t OFF_PREV = 444 * MiB;
constexpr size_t OFF_H = 168 * MiB;
constexpr size_t OFF_HB = 296 * MiB;
constexpr size_t OFF_QX = 360 * MiB;
constexpr size_t OFF_OX = 424 * MiB;
constexpr size_t OFF_EIDX = 0;
constexpr size_t OFF_GATE = 16 * MiB;

struct Params {
  const float* x; const int* positions; const float* mem; const float* w_in;
  const float* gate_up; const float* gate_bias; const float* norm_g; const float* w_out;
  const float* ln_mix_g; const float* ln_mix_b;
  const float* wq; const float* wk; const float* wv; const float* wo;
  const float* ln_mem_g; const float* ln_mem_b;
  const float* w_pq; const float* sk1; const float* sk2; const float* ex_down; const float* ex_up;
  const float* ln_ffn_g; const float* ln_ffn_b;
  float* out; char* ws;
};

DI unsigned pk_bf16(float a, float b) {
  f2_t v = {a, b};
  bf2_t r = __builtin_convertvector(v, bf2_t);
  return __builtin_bit_cast(unsigned, r);
}
DI u16 f2bf(float a) { return (u16)(pk_bf16(a, 0.f) & 0xffffu); }
DI float bf2f(u16 u) { return __uint_as_float(((unsigned)u) << 16); }
DI float bflo(unsigned u) { return __uint_as_float(u << 16); }
DI float bfhi(unsigned u) { return __uint_as_float(u & 0xffff0000u); }
DI int crow(int i, int h) { return (i & 3) + 8 * (i >> 2) + 4 * h; }
DI bf16x8 ldg8(const u16* p) { return *reinterpret_cast<const bf16x8*>(p); }
DI bf16x8 pack8(float a0, float a1, float a2, float a3, float a4, float a5, float a6, float a7) {
  u32x4 r; r[0] = pk_bf16(a0, a1); r[1] = pk_bf16(a2, a3); r[2] = pk_bf16(a4, a5); r[3] = pk_bf16(a6, a7);
  return __builtin_bit_cast(bf16x8, r);
}
DI bf16x8 cat44(bf16x4 lo, bf16x4 hi) { return __builtin_shufflevector(lo, hi, 0, 1, 2, 3, 4, 5, 6, 7); }
DI void st4bf(u16* p, float a, float b, float c, float d) {
  u32x2 v; v[0] = pk_bf16(a, b); v[1] = pk_bf16(c, d);
  *reinterpret_cast<u32x2*>(p) = v;
}
DI float wave_sum(float v) {
#pragma unroll
  for (int d = 32; d >= 1; d >>= 1) v += __shfl_xor(v, d);
  return v;
}
DI void sincos_rad(float ang, float& s, float& c) {
  constexpr float C_hi = (float)0.15915494309189535;
  constexpr float C_lo = (float)(0.15915494309189535 - (double)C_hi);
  float k = rintf(ang * C_hi);
  float f = fmaf(ang, C_hi, -k);
  f = fmaf(ang, C_lo, f);
  s = __builtin_amdgcn_sinf(f);
  c = __builtin_amdgcn_cosf(f);
}
DI unsigned fkey(float s) {
  unsigned u = __float_as_uint(s + 0.0f);
  return (u & 0x80000000u) ? ~u : (u | 0x80000000u);
}
DI f32x16 zero16() { f32x16 z; for (int i = 0; i < 16; ++i) z[i] = 0.f; return z; }

DI int win_src_col(int n) {
  if (n < 1832) return n;
  if (n < 1848) return 2856 + (n - 1832);
  if (n < 1856) return -1;
  if (n < 2880) return n - 24;
  if (n < 3392) return n - 8;
  return -1;
}

DI void cvt_stream(const float* __restrict__ src, u16* __restrict__ dst, size_t n, size_t gtid, size_t gn) {
  size_t n8 = n / 8;
  for (size_t i = gtid; i < n8; i += gn) {
    f32x4 a = *reinterpret_cast<const f32x4*>(src + i * 8);
    f32x4 b = *reinterpret_cast<const f32x4*>(src + i * 8 + 4);
    u32x4 r; r[0] = pk_bf16(a[0], a[1]); r[1] = pk_bf16(a[2], a[3]); r[2] = pk_bf16(b[0], b[1]); r[3] = pk_bf16(b[2], b[3]);
    *reinterpret_cast<u32x4*>(dst + i * 8) = r;
  }
}

template <bool MAPPED>
DI void transpose_tile(const float* __restrict__ W, int ldn, u16* __restrict__ Wt, int k0, int n0, float* tile) {
  const int tid = threadIdx.x;
  {
    int nn = n0 + (tid & 63);
    int c = MAPPED ? win_src_col(nn) : nn;
#pragma unroll
    for (int rr = 0; rr < 8; ++rr) {
      int kk = (tid >> 6) + 8 * rr;
      float v = (c >= 0) ? W[(size_t)(k0 + kk) * ldn + c] : 0.f;
      tile[kk * 65 + (tid & 63)] = v;
    }
  }
  __syncthreads();
#pragma unroll
  for (int rr = 0; rr < 8; ++rr) {
    int nn = (tid >> 6) + 8 * rr;
    int kk = tid & 63;
    Wt[(size_t)(n0 + nn) * 1024 + k0 + kk] = f2bf(tile[kk * 65 + nn]);
  }
  __syncthreads();
}

DI void phase_prep(const Params& p, char* smem) {
  const size_t gtid = (size_t)blockIdx.x * blockDim.x + threadIdx.x;
  const size_t gn = (size_t)gridDim.x * blockDim.x;
  char* ws = p.ws;
  cvt_stream(p.x, (u16*)(ws + OFF_XB), (size_t)T_ * 1024, gtid, gn);
  cvt_stream(p.mem, (u16*)(ws + OFF_MEMB), (size_t)2048 * 1024, gtid, gn);
  cvt_stream(p.ex_down, (u16*)(ws + OFF_EXD), (size_t)16384 * 1024, gtid, gn);
  cvt_stream(p.ex_up, (u16*)(ws + OFF_EXU), (size_t)16384 * 1024, gtid, gn);
  cvt_stream(p.sk1, (u16*)(ws + OFF_SK), (size_t)128 * 128, gtid, gn);
  cvt_stream(p.sk2, (u16*)(ws + OFF_SK) + 128 * 128, (size_t)128 * 128, gtid, gn);
  float* tile = (float*)smem;
  const int n_win = 54 * 16, n_sq = 256, n_pq = 512;
  const int total = n_win + 5 * n_sq + n_pq;
  for (int t = blockIdx.x; t < total; t += gridDim.x) {
    if (t < n_win) {
      transpose_tile<true>(p.w_in, 3384, (u16*)(ws + OFF_WIN), (t & 15) * 64, (t >> 4) * 64, tile);
    } else if (t < n_win + 5 * n_sq) {
      int u = t - n_win; int which = u >> 8; int r = u & 255;
      const float* W = which == 0 ? p.w_out : which == 1 ? p.wq : which == 2 ? p.wk : which == 3 ? p.wv : p.wo;
      size_t off = which == 0 ? OFF_WOUT : which == 1 ? OFF_WQ : which == 2 ? OFF_WK : which == 3 ? OFF_WV : OFF_WO;
      transpose_tile<false>(W, 1024, (u16*)(ws + off), (r & 15) * 64, (r >> 4) * 64, tile);
    } else {
      int r = t - n_win - 5 * n_sq;
      transpose_tile<false>(p.w_pq, 2048, (u16*)(ws + OFF_WPQ), (r & 15) * 64, (r >> 4) * 64, tile);
    }
  }
}

DI void gemm_tile(const u16* __restrict__ X, int ldx, const u16* __restrict__ Wt, int ldw, int K, char* smem,
                  f32x16 (&acc)[2][2]) {
  u16* Xs = (u16*)smem;
  u16* Ws = (u16*)(smem + 256 * 72 * 2);
  const int tid = threadIdx.x, lane = tid & 63, wave = tid >> 6;
  const int fw = wave & 1, tq = wave >> 1, lr = lane & 31, lh = lane >> 5;
  const int lrow = tid >> 3, lch = tid & 7;
  u32x4 xr[4], wr[2];
#pragma unroll
  for (int a = 0; a < 2; ++a)
#pragma unroll
    for (int b = 0; b < 2; ++b) acc[a][b] = zero16();
  const int nk = K / 64;
  const u16* xp = X + (size_t)lrow * ldx + lch * 8;
  const u16* wp = Wt + (size_t)lrow * ldw + lch * 8;
#pragma unroll
  for (int i = 0; i < 4; ++i) xr[i] = *reinterpret_cast<const u32x4*>(xp + (size_t)(64 * i) * ldx);
#pragma unroll
  for (int i = 0; i < 2; ++i) wr[i] = *reinterpret_cast<const u32x4*>(wp + (size_t)(64 * i) * ldw);
#pragma unroll
  for (int i = 0; i < 4; ++i) *reinterpret_cast<u32x4*>(Xs + (lrow + 64 * i) * 72 + lch * 8) = xr[i];
#pragma unroll
  for (int i = 0; i < 2; ++i) *reinterpret_cast<u32x4*>(Ws + (lrow + 64 * i) * 72 + lch * 8) = wr[i];
  __syncthreads();
  for (int kt = 0; kt < nk; ++kt) {
    if (kt + 1 < nk) {
#pragma unroll
      for (int i = 0; i < 4; ++i) xr[i] = *reinterpret_cast<const u32x4*>(xp + (size_t)(64 * i) * ldx + (kt + 1) * 64);
#pragma unroll
      for (int i = 0; i < 2; ++i) wr[i] = *reinterpret_cast<const u32x4*>(wp + (size_t)(64 * i) * ldw + (kt + 1) * 64);
    }
#pragma unroll
    for (int ks = 0; ks < 4; ++ks) {
      bf16x8 a[2], b[2];
#pragma unroll
      for (int ft = 0; ft < 2; ++ft) a[ft] = *reinterpret_cast<const bf16x8*>(Ws + (fw * 64 + ft * 32 + lr) * 72 + ks * 16 + lh * 8);
#pragma unroll
      for (int tt = 0; tt < 2; ++tt) b[tt] = *reinterpret_cast<const bf16x8*>(Xs + (tq * 64 + tt * 32 + lr) * 72 + ks * 16 + lh * 8);
#pragma unroll
      for (int ft = 0; ft < 2; ++ft)
#pragma unroll
        for (int tt = 0; tt < 2; ++tt) acc[ft][tt] = MFMA(a[ft], b[tt], acc[ft][tt]);
    }
    __syncthreads();
    if (kt + 1 < nk) {
#pragma unroll
      for (int i = 0; i < 4; ++i) *reinterpret_cast<u32x4*>(Xs + (lrow + 64 * i) * 72 + lch * 8) = xr[i];
#pragma unroll
      for (int i = 0; i < 2; ++i) *reinterpret_cast<u32x4*>(Ws + (lrow + 64 * i) * 72 + lch * 8) = wr[i];
      __syncthreads();
    }
  }
}

DI void epi_inproj(const Params& p, int tok0, int f0, f32x16 (&acc)[2][2]) {
  const int tid = threadIdx.x, lane = tid & 63, wave = tid >> 6;
  const int fw = wave & 1, tq = wave >> 1, lr = lane & 31, lh = lane >> 5;
  const int fbase = f0 + fw * 64;
  if (fbase >= 3392) return;
  u16* tm = (u16*)(p.ws + OFF_TM);
#pragma unroll
  for (int tt = 0; tt < 2; ++tt) {
    const int tok = tok0 + tq * 64 + tt * 32 + lr;
    const float posf = (float)p.positions[tok];
    const int bb = tok >> 12, ss = tok & 4095;
    if (fbase < 1024) {
#pragma unroll
      for (int r = 0; r < 4; ++r) {
        float j = (float)(4 * lh + r);
        float inv = exp2f(-j * (18.931568569324174f / 8.0f));
        float sn, cs; sincos_rad(posf * inv, sn, cs);
        float x1 = acc[0][tt][r], x2 = acc[0][tt][r + 4];
        acc[0][tt][r] = x1 * cs - x2 * sn;
        acc[0][tt][r + 4] = x2 * cs + x1 * sn;
      }
#pragma unroll
      for (int ft = 0; ft < 2; ++ft)
#pragma unroll
        for (int g = 0; g < 4; ++g)
          st4bf(tm + (size_t)tok * TMW + fbase + ft * 32 + 8 * g + 4 * lh, acc[ft][tt][4 * g], acc[ft][tt][4 * g + 1], acc[ft][tt][4 * g + 2], acc[ft][tt][4 * g + 3]);
    } else if (fbase < 1536 || (fbase >= 2368 && fbase < 2880)) {
      u16* vt = (fbase < 1536) ? (u16*)(p.ws + OFF_VT) : (u16*)(p.ws + OFF_GVT);
      const int fo = (fbase < 1536) ? fbase - 1024 : fbase - 2368;
#pragma unroll
      for (int ft = 0; ft < 2; ++ft)
#pragma unroll
        for (int i = 0; i < 16; ++i) {
          int feat = fo + ft * 32 + crow(i, lh);
          vt[((size_t)bb * 512 + feat) * 4096 + ss] = f2bf(acc[ft][tt][i]);
        }
    } else {
      int colbase;
      if (fbase < 1856) {
#pragma unroll
        for (int ft = 0; ft < 2; ++ft) {
          const bool rot = (fbase < 1792) || (ft == 0);
#pragma unroll
          for (int r = 0; r < 4; ++r) {
            float v = acc[ft][tt][r];
            float o = __shfl_xor(v, 32);
            float inv = exp2f(-(float)r * (18.931568569324174f / 4.0f));
            float sn, cs; sincos_rad(posf * inv, sn, cs);
            float res = (lh == 0) ? (v * cs - o * sn) : (v * cs + o * sn);
            acc[ft][tt][r] = rot ? res : v;
          }
        }
        colbase = fbase - 512;
      } else if (fbase < 2368) {
        colbase = fbase - 512;
      } else {
        colbase = fbase - 1024;
      }
#pragma unroll
      for (int ft = 0; ft < 2; ++ft)
#pragma unroll
        for (int g = 0; g < 4; ++g)
          st4bf(tm + (size_t)tok * TMW + colbase + ft * 32 + 8 * g + 4 * lh, acc[ft][tt][4 * g], acc[ft][tt][4 * g + 1], acc[ft][tt][4 * g + 2], acc[ft][tt][4 * g + 3]);
    }
  }
}

DI void phase_inproj(const Params& p, char* smem) {
  const int n_in = 128 * 27;
  const int total = n_in + 128;
  const u16* xb = (const u16*)(p.ws + OFF_XB);
  const u16* memb = (const u16*)(p.ws + OFF_MEMB);
  const int tid = threadIdx.x, lane = tid & 63, wave = tid >> 6;
  const int fw = wave & 1, tq = wave >> 1, lr = lane & 31, lh = lane >> 5;
  for (int t = blockIdx.x; t < total; t += gridDim.x) {
    f32x16 acc[2][2];
    if (t < n_in) {
      int mt = t / 27, nt = t % 27;
      gemm_tile(xb + (size_t)mt * 256 * 1024, 1024, (const u16*)(p.ws + OFF_WIN) + (size_t)nt * 128 * 1024, 1024, 1024, smem, acc);
      epi_inproj(p, mt * 256, nt * 128, acc);
    } else {
      int u = t - n_in; int which = u >> 6; int r = u & 63; int mt = r >> 3, nt = r & 7;
      const u16* W = (const u16*)(p.ws + (which == 0 ? OFF_WK : OFF_WV));
      gemm_tile(memb + (size_t)mt * 256 * 1024, 1024, W + (size_t)nt * 128 * 1024, 1024, 1024, smem, acc);
#pragma unroll
      for (int tt = 0; tt < 2; ++tt) {
        const int tok = mt * 256 + tq * 64 + tt * 32 + lr;
        if (which == 0) {
          u16* mk = (u16*)(p.ws + OFF_MEMK);
#pragma unroll
          for (int ft = 0; ft < 2; ++ft)
#pragma unroll
            for (int g = 0; g < 4; ++g)
              st4bf(mk + (size_t)tok * 1024 + nt * 128 + fw * 64 + ft * 32 + 8 * g + 4 * lh, acc[ft][tt][4 * g], acc[ft][tt][4 * g + 1], acc[ft][tt][4 * g + 2], acc[ft][tt][4 * g + 3]);
        } else {
          u16* mv = (u16*)(p.ws + OFF_MEMVT);
          const int bb = tok >> 8, mm = tok & 255;
#pragma unroll
          for (int ft = 0; ft < 2; ++ft)
#pragma unroll
            for (int i = 0; i < 16; ++i) {
              int feat = nt * 128 + fw * 64 + ft * 32 + crow(i, lh);
              mv[((size_t)bb * 1024 + feat) * 256 + mm] = f2bf(acc[ft][tt][i]);
            }
        }
      }
    }
  }
}

DI void idx_scores(const bf16x8 (&qf)[8][2], const float (&wq)[8], bf16x8 k0, bf16x8 k1, float (&sc)[16]) {
#pragma unroll
  for (int i = 0; i < 16; ++i) sc[i] = 0.f;
#pragma unroll
  for (int hd = 0; hd < 8; ++hd) {
    f32x16 a = zero16();
    a = MFMA(k0, qf[hd][0], a);
    a = MFMA(k1, qf[hd][1], a);
#pragma unroll
    for (int i = 0; i < 16; ++i) sc[i] = fmaf(wq[hd], fmaxf(a[i], 0.f), sc[i]);
  }
}

DI void load_idx_q(const u16* tm, int tok, int lh, bf16x8 (&qf)[8][2], float (&wq)[8]) {
  const u16* row = tm + (size_t)tok * TMW;
#pragma unroll
  for (int hd = 0; hd < 8; ++hd)
#pragma unroll
    for (int ks = 0; ks < 2; ++ks) qf[hd][ks] = ldg8(row + TM_QI + hd * 32 + ks * 16 + lh * 8);
  bf16x8 w8 = ldg8(row + TM_WI);
#pragma unroll
  for (int hd = 0; hd < 8; ++hd) wq[hd] = bf2f((u16)w8[hd]) * 0.0625f;
}

DI int wave_incl_scan(int v, int lane) {
#pragma unroll
  for (int d = 1; d < 64; d <<= 1) {
    int t = __shfl_up(v, d);
    if (lane >= d) v += t;
  }
  return v;
}

DI void dsa_thr_item(const Params& p, int b, int qblk, char* smem) {
  unsigned* hist = (unsigned*)smem;
  unsigned* pref = (unsigned*)(smem + 32768);
  int* rank = (int*)(smem + 32768 + 128);
  const u16* tm = (const u16*)(p.ws + OFF_TM);
  const int tid = threadIdx.x, lane = tid & 63, wave = tid >> 6, lr = lane & 31, lh = lane >> 5;
  const int q0 = qblk * 32;
  bf16x8 qf[8][2]; float wq[8];
  load_idx_q(tm, b * S_ + q0 + lr, lh, qf, wq);
  if (tid < 32) { pref[tid] = 0u; rank[tid] = min(256, q0 + tid + 1); }
  for (int pass = 0; pass < 4; ++pass) {
    for (int i = tid; i < 8192; i += 512) hist[i] = 0u;
    __syncthreads();
    const int shift = 24 - 8 * pass;
    const unsigned mypref = pref[lr];
    for (int kt = wave; kt <= qblk; kt += 8) {
      const u16* krow = tm + (size_t)(b * S_ + kt * 32 + lr) * TMW + TM_KI + lh * 8;
      bf16x8 k0 = ldg8(krow), k1 = ldg8(krow + 16);
      float sc[16];
      idx_scores(qf, wq, k0, k1, sc);
#pragma unroll
      for (int i = 0; i < 16; ++i) {
        int kp = kt * 32 + crow(i, lh);
        unsigned ky = fkey(sc[i]);
        unsigned hi = (ky >> shift);
        if (kp <= q0 + lr && (hi >> 8) == mypref) atomicAdd(&hist[(hi & 255u) * 32 + lr], 1u);
      }
    }
    __syncthreads();
#pragma unroll 1
    for (int qq = 0; qq < 4; ++qq) {
      const int q = wave * 4 + qq;
      const int rk = rank[q];
      int c[4];
#pragma unroll
      for (int j = 0; j < 4; ++j) c[j] = (int)hist[(255 - 4 * lane - j) * 32 + q];
      int s = c[0] + c[1] + c[2] + c[3];
      int P = wave_incl_scan(s, lane);
      int excl = P - s;
      if (P >= rk && excl < rk) {
        int cum = excl; int bin = 0; int nr = 1; bool found = false;
#pragma unroll
        for (int j = 0; j < 4; ++j) {
          if (!found && cum + c[j] >= rk) { bin = 255 - 4 * lane - j; nr = rk - cum; found = true; }
          if (!found) cum += c[j];
        }
        pref[q] = (pref[q] << 8) | (unsigned)bin;
        rank[q] = nr;
      }
    }
    __syncthreads();
  }
  if (tid < 32) ((unsigned*)(p.ws + OFF_THR))[b * S_ + q0 + tid] = pref[tid];
  __syncthreads();
}

DI void dsa_attn_item(const Params& p, int b, int qblk, char* smem) {
  u16* maskbuf = (u16*)smem;
  u16* qi = (u16*)(smem + 4096);
  const u16* tm = (const u16*)(p.ws + OFF_TM);
  const u16* vT = (const u16*)(p.ws + OFF_VT);
  const unsigned* thr = (const unsigned*)(p.ws + OFF_THR);
  const int tid = threadIdx.x, lane = tid & 63, wave = tid >> 6, lr = lane & 31, lh = lane >> 5;
  const int q0 = qblk * 32;
  const int head = wave;
  const int qtok = b * S_ + q0 + lr;
  bf16x8 Qf[4];
#pragma unroll
  for (int ks = 0; ks < 4; ++ks) {
    bf16x8 raw = ldg8(tm + (size_t)qtok * TMW + TM_Q + head * 64 + ks * 16 + lh * 8);
    float f[8];
#pragma unroll
    for (int j = 0; j < 8; ++j) f[j] = bf2f((u16)raw[j]) * 0.125f;
    Qf[ks] = pack8(f[0], f[1], f[2], f[3], f[4], f[5], f[6], f[7]);
  }
  f32x16 O[2];
  O[0] = zero16(); O[1] = zero16();
  float mrun = -INFINITY, lrun = 0.f;
  const unsigned thrq = thr[qtok];
  const int nchunks = (q0 + 31) / 256 + 1;
  const u16* vbase = vT + ((size_t)b * 512 + head * 64 + lr) * 4096 + 4 * lh;
  for (int i = tid; i < 32 * 32; i += 512) {
    int q = i >> 5, ch = i & 31;
    *reinterpret_cast<u32x4*>(qi + q * 264 + ch * 8) = *reinterpret_cast<const u32x4*>(tm + (size_t)(b * S_ + q0 + q) * TMW + TM_QI + ch * 8);
  }
  float wq[8];
  {
    bf16x8 w8 = ldg8(tm + (size_t)qtok * TMW + TM_WI);
#pragma unroll
    for (int hd = 0; hd < 8; ++hd) wq[hd] = bf2f((u16)w8[hd]) * 0.0625f;
  }
  __syncthreads();
  const u16* qil = qi + lr * 264 + lh * 8;
  for (int c = 0; c < nchunks; ++c) {
    const int buf = c & 1;
    {
      const int key0 = (c * 8 + wave) * 32;
      unsigned bits = 0u;
      if (key0 <= q0 + 31) {
        const u16* krow = tm + (size_t)(b * S_ + key0 + lr) * TMW + TM_KI + lh * 8;
        bf16x8 k0 = ldg8(krow), k1 = ldg8(krow + 16);
        float sc[16];
#pragma unroll
        for (int i = 0; i < 16; ++i) sc[i] = 0.f;
#pragma unroll
        for (int hd = 0; hd < 8; ++hd) {
          f32x16 a = zero16();
          a = MFMA(k0, *reinterpret_cast<const bf16x8*>(qil + hd * 32), a);
          a = MFMA(k1, *reinterpret_cast<const bf16x8*>(qil + hd * 32 + 16), a);
#pragma unroll
          for (int i = 0; i < 16; ++i) sc[i] = fmaf(wq[hd], fmaxf(a[i], 0.f), sc[i]);
        }
#pragma unroll
        for (int i = 0; i < 16; ++i) {
          int kp = key0 + crow(i, lh);
          if (kp <= q0 + lr && fkey(sc[i]) >= thrq) bits |= (1u << i);
        }
      }
      maskbuf[(buf * 8 + wave) * 64 + lane] = (u16)bits;
    }
    __syncthreads();
#pragma unroll 1
    for (int t8 = 0; t8 < 8; ++t8) {
      const int key0 = (c * 8 + t8) * 32;
      if (key0 > q0 + 31) break;
      bf16x8 Kf[4];
      const u16* krow = tm + (size_t)(b * S_ + key0 + lr) * TMW + TM_K + head * 64 + lh * 8;
#pragma unroll
      for (int ks = 0; ks < 4; ++ks) Kf[ks] = ldg8(krow + ks * 16);
      bf16x8 Vf[2][2];
#pragma unroll
      for (int dt = 0; dt < 2; ++dt)
#pragma unroll
        for (int s = 0; s < 2; ++s) {
          const u16* vp = vbase + (size_t)(dt * 32) * 4096 + key0 + 16 * s;
          bf16x4 lo = *reinterpret_cast<const bf16x4*>(vp);
          bf16x4 hi = *reinterpret_cast<const bf16x4*>(vp + 8);
          Vf[dt][s] = cat44(lo, hi);
        }
      const unsigned bits = maskbuf[(buf * 8 + t8) * 64 + lane];
      f32x16 Sx = zero16();
#pragma unroll
      for (int ks = 0; ks < 4; ++ks) Sx = MFMA(Kf[ks], Qf[ks], Sx);
      float mt = -INFINITY;
#pragma unroll
      for (int i = 0; i < 16; ++i) mt = ((bits >> i) & 1u) ? fmaxf(mt, Sx[i]) : mt;
      mt = fmaxf(mt, __shfl_xor(mt, 32));
      const float mnew = fmaxf(mrun, mt);
      const float msafe = (mnew == -INFINITY) ? 0.f : mnew;
      const float alpha = __expf(mrun - msafe);
      float pv[16]; float ps = 0.f;
#pragma unroll
      for (int i = 0; i < 16; ++i) { pv[i] = ((bits >> i) & 1u) ? __expf(Sx[i] - msafe) : 0.f; ps += pv[i]; }
      lrun = lrun * alpha + ps;
      mrun = mnew;
#pragma unroll
      for (int dt = 0; dt < 2; ++dt)
#pragma unroll
        for (int i = 0; i < 16; ++i) O[dt][i] *= alpha;
      bf16x8 Pf[2];
#pragma unroll
      for (int s = 0; s < 2; ++s) Pf[s] = pack8(pv[8 * s], pv[8 * s + 1], pv[8 * s + 2], pv[8 * s + 3], pv[8 * s + 4], pv[8 * s + 5], pv[8 * s + 6], pv[8 * s + 7]);
#pragma unroll
      for (int dt = 0; dt < 2; ++dt)
#pragma unroll
        for (int s = 0; s < 2; ++s) O[dt] = MFMA(Vf[dt][s], Pf[s], O[dt]);
    }
  }
  u16* y = (u16*)(p.ws + OFF_XB);
  {
    float lt = lrun + __shfl_xor(lrun, 32);
    float inv = 1.f / lt;
#pragma unroll
    for (int dt = 0; dt < 2; ++dt)
#pragma unroll
      for (int g = 0; g < 4; ++g)
        st4bf(y + (size_t)qtok * 1024 + head * 64 + dt * 32 + 8 * g + 4 * lh, O[dt][4 * g] * inv, O[dt][4 * g + 1] * inv, O[dt][4 * g + 2] * inv, O[dt][4 * g + 3] * inv);
  }
  __syncthreads();
}

DI void gla_bcum(const Params& p, int b, int h, int n, float* bc, float* glr_s, float* segtot) {
  const u16* tm = (const u16*)(p.ws + OFF_TM);
  const int tid = threadIdx.x;
  const int tok0 = b * S_ + n * 64;
  for (int i = tid; i < 1024; i += 512) glr_s[i] = bf2f(tm[(size_t)(tok0 + (i >> 4)) * TMW + TM_GLR + (i & 15)]);
  const int d = tid & 63, cgp = tid >> 6;
  float gu[16];
#pragma unroll
  for (int j = 0; j < 16; ++j) gu[j] = p.gate_up[j * 256 + h * 64 + d];
  const float bias = p.gate_bias[h * 64 + d];
  __syncthreads();
  float v[8]; float run = 0.f;
#pragma unroll
  for (int r = 0; r < 8; ++r) {
    const int c = cgp * 8 + r;
    float z = bias;
#pragma unroll
    for (int j = 0; j < 16; ++j) z = fmaf(glr_s[c * 16 + j], gu[j], z);
    float la = (fminf(z, 0.f) - log1pf(__expf(-fabsf(z)))) * 0.0625f;
    run += la; v[r] = run;
  }
  segtot[cgp * 64 + d] = run;
  __syncthreads();
  float off = 0.f;
#pragma unroll
  for (int g = 0; g < 8; ++g) off += (g < cgp) ? segtot[g * 64 + d] : 0.f;
#pragma unroll
  for (int r = 0; r < 8; ++r) bc[(cgp * 8 + r) * 64 + d] = off + v[r];
  __syncthreads();
}

DI void gla_g1_item(const Params& p, int item, char* smem) {
  float* bc = (float*)smem;
  float* glr_s = (float*)(smem + 16384);
  float* segtot = (float*)(smem + 20480);
  u16* KeT = (u16*)(smem + 22528);
  const int b = item >> 8, h = (item >> 6) & 3, n = item & 63;
  const u16* tm = (const u16*)(p.ws + OFF_TM);
  const u16* gvT = (const u16*)(p.ws + OFF_GVT);
  const int tid = threadIdx.x, lane = tid & 63, wave = tid >> 6, lr = lane & 31, lh = lane >> 5;
  const int tok0 = b * S_ + n * 64;
  gla_bcum(p, b, h, n, bc, glr_s, segtot);
  {
    const int d = tid & 63, cgp = tid >> 6;
    const float blast = bc[63 * 64 + d];
    float f[8];
#pragma unroll
    for (int r = 0; r < 8; ++r) {
      const int c = cgp * 8 + r;
      float kv = bf2f(tm[(size_t)(tok0 + c) * TMW + TM_GK + h * 64 + d]);
      f[r] = kv * __expf(blast - bc[c * 64 + d]);
    }
    *reinterpret_cast<bf16x8*>(KeT + d * 72 + cgp * 8) = pack8(f[0], f[1], f[2], f[3], f[4], f[5], f[6], f[7]);
    if (cgp == 0) ((float*)(p.ws + OFF_DECAY))[item * 64 + d] = __expf(blast);
  }
  __syncthreads();
  {
    const int et = wave & 3, dtl = wave >> 2;
    f32x16 acc = zero16();
    const u16* arow = gvT + ((size_t)b * 512 + h * 128 + et * 32 + lr) * 4096 + n * 64 + lh * 8;
#pragma unroll
    for (int ks = 0; ks < 4; ++ks) {
      bf16x8 a = ldg8(arow + ks * 16);
      bf16x8 bb = *reinterpret_cast<const bf16x8*>(KeT + (dtl * 32 + lr) * 72 + ks * 16 + lh * 8);
      acc = MFMA(a, bb, acc);
    }
    float* kvT = (float*)(p.ws + OFF_KVT);
#pragma unroll
    for (int i = 0; i < 16; ++i) kvT[((size_t)item * 128 + et * 32 + crow(i, lh)) * 64 + dtl * 32 + lr] = acc[i];
  }
  __syncthreads();
}

DI void gla_scan(const Params& p) {
  const float* kvT = (const float*)(p.ws + OFF_KVT);
  const float* decay = (const float*)(p.ws + OFF_DECAY);
  u16* prev = (u16*)(p.ws + OFF_PREV);
  const int gtid = blockIdx.x * blockDim.x + threadIdx.x;
  const int gn = gridDim.x * blockDim.x;
  for (int u = gtid; u < 32 * 2048; u += gn) {
    const int bh = u >> 11, rem = u & 2047, e = rem >> 4, d4 = (rem & 15) * 4;
    f32x4 st = {0.f, 0.f, 0.f, 0.f};
#pragma unroll 4
    for (int n = 0; n < 64; ++n) {
      const int item = bh * 64 + n;
      st4bf(prev + ((size_t)item * 128 + e) * 64 + d4, st[0], st[1], st[2], st[3]);
      f32x4 dc = *reinterpret_cast<const f32x4*>(decay + item * 64 + d4);
      f32x4 kv = *reinterpret_cast<const f32x4*>(kvT + ((size_t)item * 128 + e) * 64 + d4);
      st = dc * st + kv;
    }
  }
}

DI void gla_g3_item(const Params& p, int item, char* smem) {
  float* bc = (float*)smem;
  float* glr_s = (float*)(smem + 16384);
  float* segtot = (float*)(smem + 20480);
  float* red = (float*)(smem + 22528);
  const int b = item >> 8, h = (item >> 6) & 3, n = item & 63;
  const u16* tm = (const u16*)(p.ws + OFF_TM);
  const u16* gvT = (const u16*)(p.ws + OFF_GVT);
  const u16* prev = (const u16*)(p.ws + OFF_PREV);
  const int tid = threadIdx.x, lane = tid & 63, wave = tid >> 6, lr = lane & 31, lh = lane >> 5;
  const int tok0 = b * S_ + n * 64;
  gla_bcum(p, b, h, n, bc, glr_s, segtot);
  const int et = wave & 3, ct = wave >> 2;
  bf16x8 Qd[4];
  {
    const int c = ct * 32 + lr;
#pragma unroll
    for (int ks = 0; ks < 4; ++ks) {
      bf16x8 raw = ldg8(tm + (size_t)(tok0 + c) * TMW + TM_GQ + h * 64 + ks * 16 + lh * 8);
      float f[8];
#pragma unroll
      for (int j = 0; j < 8; ++j) f[j] = bf2f((u16)raw[j]) * 0.125f * __expf(bc[c * 64 + ks * 16 + lh * 8 + j]);
      Qd[ks] = pack8(f[0], f[1], f[2], f[3], f[4], f[5], f[6], f[7]);
    }
  }
  f32x16 O = zero16();
  const u16* vrow = gvT + ((size_t)b * 512 + h * 128 + et * 32 + lr) * 4096 + n * 64 + 4 * lh;
#pragma unroll
  for (int st = 0; st < 2; ++st) {
    if (st <= ct) {
      f32x16 A = zero16();
      const int s = st * 32 + lr;
#pragma unroll
      for (int ks = 0; ks < 4; ++ks) {
        bf16x8 raw = ldg8(tm + (size_t)(tok0 + s) * TMW + TM_GK + h * 64 + ks * 16 + lh * 8);
        float f[8];
#pragma unroll
        for (int j = 0; j < 8; ++j) f[j] = bf2f((u16)raw[j]) * __expf(-bc[s * 64 + ks * 16 + lh * 8 + j]);
        bf16x8 Ki = pack8(f[0], f[1], f[2], f[3], f[4], f[5], f[6], f[7]);
        A = MFMA(Ki, Qd[ks], A);
      }
      float pv[16];
#pragma unroll
      for (int i = 0; i < 16; ++i) pv[i] = (st * 32 + crow(i, lh) <= ct * 32 + lr) ? A[i] : 0.f;
#pragma unroll
      for (int s2 = 0; s2 < 2; ++s2) {
        bf16x8 Pf = pack8(pv[8 * s2], pv[8 * s2 + 1], pv[8 * s2 + 2], pv[8 * s2 + 3], pv[8 * s2 + 4], pv[8 * s2 + 5], pv[8 * s2 + 6], pv[8 * s2 + 7]);
        const u16* vp = vrow + st * 32 + 16 * s2;
        bf16x4 lo = *reinterpret_cast<const bf16x4*>(vp);
        bf16x4 hi = *reinterpret_cast<const bf16x4*>(vp + 8);
        O = MFMA(cat44(lo, hi), Pf, O);
      }
    }
  }
  {
    const u16* srow = prev + ((size_t)item * 128 + et * 32 + lr) * 64 + lh * 8;
#pragma unroll
    for (int ks = 0; ks < 4; ++ks) O = MFMA(ldg8(srow + ks * 16), Qd[ks], O);
  }
  float ss = 0.f;
#pragma unroll
  for (int i = 0; i < 16; ++i) ss += O[i] * O[i];
  ss += __shfl_xor(ss, 32);
  if (lh == 0) red[(ct * 4 + et) * 32 + lr] = ss;
  __syncthreads();
  const float tot = red[(ct * 4 + 0) * 32 + lr] + red[(ct * 4 + 1) * 32 + lr] + red[(ct * 4 + 2) * 32 + lr] + red[(ct * 4 + 3) * 32 + lr];
  const float rinv = rsqrtf(tot * (1.f / 128.f) + 1e-6f);
  const int tok = tok0 + ct * 32 + lr;
  u16* y = (u16*)(p.ws + OFF_XB);
#pragma unroll
  for (int g = 0; g < 4; ++g) {
    const int e0 = et * 32 + 8 * g + 4 * lh;
    u32x2 gr = *reinterpret_cast<const u32x2*>(tm + (size_t)tok * TMW + TM_GR + h * 128 + e0);
    f32x4 ng = *reinterpret_cast<const f32x4*>(p.norm_g + e0);
    float grv[4] = {bflo(gr[0]), bfhi(gr[0]), bflo(gr[1]), bfhi(gr[1])};
    float o[4];
#pragma unroll
    for (int r = 0; r < 4; ++r) {
      float sl = grv[r] / (1.f + __expf(-grv[r]));
      o[r] = O[4 * g + r] * rinv * ng[r] * sl;
    }
    st4bf(y + (size_t)tok * 1024 + 512 + h * 128 + e0, o[0], o[1], o[2], o[3]);
  }
  __syncthreads();
}

template <int MODE>
DI void phase_gemm(const Params& p, const u16* X, const u16* Wt, int N, const float* resid, float* outf, u16* outb, int ldo, char* smem) {
  const int ntn = N / 128;
  const int total = 128 * ntn;
  const int tid = threadIdx.x, lane = tid & 63, wave = tid >> 6;
  const int fw = wave & 1, tq = wave >> 1, lr = lane & 31, lh = lane >> 5;
  for (int t = blockIdx.x; t < total; t += gridDim.x) {
    const int mt = t / ntn, nt = t % ntn;
    f32x16 acc[2][2];
    gemm_tile(X + (size_t)mt * 256 * 1024, 1024, Wt + (size_t)nt * 128 * 1024, 1024, 1024, smem, acc);
#pragma unroll
    for (int tt = 0; tt < 2; ++tt) {
      const int tok = mt * 256 + tq * 64 + tt * 32 + lr;
#pragma unroll
      for (int ft = 0; ft < 2; ++ft)
#pragma unroll
        for (int g = 0; g < 4; ++g) {
          const int f = nt * 128 + fw * 64 + ft * 32 + 8 * g + 4 * lh;
          if (MODE == 0) {
            f32x4 r = *reinterpret_cast<const f32x4*>(resid + (size_t)tok * 1024 + f);
            f32x4 o;
#pragma unroll
            for (int k = 0; k < 4; ++k) o[k] = ALPHA * r[k] + acc[ft][tt][4 * g + k];
            *reinterpret_cast<f32x4*>(outf + (size_t)tok * 1024 + f) = o;
          } else {
            st4bf(outb + (size_t)tok * ldo + f, acc[ft][tt][4 * g], acc[ft][tt][4 * g + 1], acc[ft][tt][4 * g + 2], acc[ft][tt][4 * g + 3]);
          }
        }
    }
  }
}

DI void phase_ln(const Params& p, float* h, u16* hb, const float* g, const float* bta) {
  const int lane = threadIdx.x & 63;
  const int gw = (blockIdx.x * blockDim.x + threadIdx.x) >> 6;
  const int nw = (gridDim.x * blockDim.x) >> 6;
  for (int row = gw; row < T_; row += nw) {
    float* r = h + (size_t)row * 1024;
    f32x4 v[4]; float s = 0.f;
#pragma unroll
    for (int c = 0; c < 4; ++c) { v[c] = *reinterpret_cast<const f32x4*>(r + c * 256 + lane * 4); s += v[c][0] + v[c][1] + v[c][2] + v[c][3]; }
    const float mean = wave_sum(s) * (1.f / 1024.f);
    float q = 0.f;
#pragma unroll
    for (int c = 0; c < 4; ++c)
#pragma unroll
      for (int k = 0; k < 4; ++k) { float d = v[c][k] - mean; q += d * d; }
    const float rstd = rsqrtf(wave_sum(q) * (1.f / 1024.f) + 1e-5f);
#pragma unroll
    for (int c = 0; c < 4; ++c) {
      f32x4 gg = *reinterpret_cast<const f32x4*>(g + c * 256 + lane * 4);
      f32x4 bb = *reinterpret_cast<const f32x4*>(bta + c * 256 + lane * 4);
      f32x4 o;
#pragma unroll
      for (int k = 0; k < 4; ++k) o[k] = (v[c][k] - mean) * rstd * gg[k] + bb[k];
      *reinterpret_cast<f32x4*>(r + c * 256 + lane * 4) = o;
      st4bf(hb + (size_t)row * 1024 + c * 256 + lane * 4, o[0], o[1], o[2], o[3]);
    }
  }
}

DI void phase_xattn(const Params& p) {
  const u16* qx = (const u16*)(p.ws + OFF_QX);
  const u16* mk = (const u16*)(p.ws + OFF_MEMK);
  const u16* mv = (const u16*)(p.ws + OFF_MEMVT);
  u16* ox = (u16*)(p.ws + OFF_OX);
  const int lane = threadIdx.x & 63, lr = lane & 31, lh = lane >> 5;
  const int gw = (blockIdx.x * blockDim.x + threadIdx.x) >> 6;
  const int nw = (gridDim.x * blockDim.x) >> 6;
  for (int it = gw; it < 8 * 4 * 128; it += nw) {
    const int qt = it & 127, h = (it >> 7) & 3, b = it >> 9;
    const int tok = b * S_ + qt * 32 + lr;
    f32x16 Sx[8];
#pragma unroll
    for (int kt = 0; kt < 8; ++kt) Sx[kt] = zero16();
    const u16* qrow = qx + (size_t)tok * 1024 + h * 256 + lh * 8;
    const u16* krow = mk + (size_t)(b * 256 + lr) * 1024 + h * 256 + lh * 8;
#pragma unroll 2
    for (int ks = 0; ks < 16; ++ks) {
      bf16x8 qf = ldg8(qrow + ks * 16);
#pragma unroll
      for (int kt = 0; kt < 8; ++kt) Sx[kt] = MFMA(ldg8(krow + (size_t)(kt * 32) * 1024 + ks * 16), qf, Sx[kt]);
    }
    float mx = -INFINITY;
#pragma unroll
    for (int kt = 0; kt < 8; ++kt)
#pragma unroll
      for (int i = 0; i < 16; ++i) mx = fmaxf(mx, Sx[kt][i]);
    mx = fmaxf(mx, __shfl_xor(mx, 32));
    float ls = 0.f;
    bf16x8 Pf[8][2];
#pragma unroll
    for (int kt = 0; kt < 8; ++kt) {
      float pv[16];
#pragma unroll
      for (int i = 0; i < 16; ++i) { pv[i] = __expf((Sx[kt][i] - mx) * 0.0625f); ls += pv[i]; }
#pragma unroll
      for (int s = 0; s < 2; ++s) Pf[kt][s] = pack8(pv[8 * s], pv[8 * s + 1], pv[8 * s + 2], pv[8 * s + 3], pv[8 * s + 4], pv[8 * s + 5], pv[8 * s + 6], pv[8 * s + 7]);
    }
    ls += __shfl_xor(ls, 32);
    const float inv = 1.f / ls;
#pragma unroll 1
    for (int dt = 0; dt < 8; ++dt) {
      f32x16 o = zero16();
      const u16* vrow = mv + ((size_t)b * 1024 + h * 256 + dt * 32 + lr) * 256 + 4 * lh;
#pragma unroll
      for (int kt = 0; kt < 8; ++kt)
#pragma unroll
        for (int s = 0; s < 2; ++s) {
          const u16* vp = vrow + kt * 32 + 16 * s;
          bf16x4 lo = *reinterpret_cast<const bf16x4*>(vp);
          bf16x4 hi = *reinterpret_cast<const bf16x4*>(vp + 8);
          o = MFMA(cat44(lo, hi), Pf[kt][s], o);
        }
#pragma unroll
      for (int g = 0; g < 4; ++g)
        st4bf(ox + (size_t)tok * 1024 + h * 256 + dt * 32 + 8 * g + 4 * lh, o[4 * g] * inv, o[4 * g + 1] * inv, o[4 * g + 2] * inv, o[4 * g + 3] * inv);
    }
  }
}

DI void peer_topk_item(const Params& p, int tt128, int head, char* smem) {
  float* sc = (float*)smem;
  float* topv = (float*)(smem + 132096);
  unsigned char* topi = (unsigned char*)(smem + 132096 + 16384);
  const u16* pq = (const u16*)(p.ws + OFF_QX);
  const u16* sk = (const u16*)(p.ws + OFF_SK);
  const int tid = threadIdx.x, lane = tid & 63, wave = tid >> 6, lr = lane & 31, lh = lane >> 5;
  const int tok0 = tt128 * 128;
  {
    const int half = wave >> 2, kt = wave & 3;
    bf16x8 af[8];
#pragma unroll
    for (int ks = 0; ks < 8; ++ks) af[ks] = ldg8(sk + (size_t)half * 16384 + (kt * 32 + lr) * 128 + ks * 16 + lh * 8);
#pragma unroll 1
    for (int tt = 0; tt < 4; ++tt) {
      f32x16 acc = zero16();
      const u16* brow = pq + (size_t)(tok0 + tt * 32 + lr) * 2048 + head * 256 + half * 128 + lh * 8;
#pragma unroll
      for (int ks = 0; ks < 8; ++ks) acc = MFMA(af[ks], ldg8(brow + ks * 16), acc);
#pragma unroll
      for (int i = 0; i < 16; ++i) sc[(half * 128 + tt * 32 + lr) * 129 + kt * 32 + crow(i, lh)] = acc[i];
    }
  }
  __syncthreads();
  if (tid < 256) {
    float* row = sc + tid * 129;
    float gm[8]; int gi[8];
#pragma unroll
    for (int g = 0; g < 8; ++g) {
      float m = -INFINITY; int mi = g * 16;
#pragma unroll
      for (int j = 0; j < 16; ++j) { float v = row[g * 16 + j]; if (v > m) { m = v; mi = g * 16 + j; } }
      gm[g] = m; gi[g] = mi;
    }
#pragma unroll 1
    for (int r = 0; r < 16; ++r) {
      float best = gm[0]; int bg = 0; int bi = gi[0];
#pragma unroll
      for (int g = 1; g < 8; ++g) if (gm[g] > best) { best = gm[g]; bg = g; bi = gi[g]; }
      topv[tid * 16 + r] = best; topi[tid * 16 + r] = (unsigned char)bi;
      row[bi] = -INFINITY;
      float m = -INFINITY; int mi = bg * 16;
#pragma unroll
      for (int j = 0; j < 16; ++j) { float v = row[bg * 16 + j]; if (v > m) { m = v; mi = bg * 16 + j; } }
#pragma unroll
      for (int g = 0; g < 8; ++g) { gm[g] = (g == bg) ? m : gm[g]; gi[g] = (g == bg) ? mi : gi[g]; }
    }
  }
  __syncthreads();
  if (tid < 128) {
    const float* av = topv + tid * 16;
    const float* bv = topv + (128 + tid) * 16;
    const unsigned char* ai = topi + tid * 16;
    const unsigned char* bi_ = topi + (128 + tid) * 16;
    float cur[16]; int pp[16];
    const float b0 = bv[0];
#pragma unroll
    for (int i = 0; i < 16; ++i) { cur[i] = av[i] + b0; pp[i] = 0; }
    float sel[16]; int eid[16];
#pragma unroll
    for (int r = 0; r < 16; ++r) {
      float best = cur[0]; int bi = 0; int bj = pp[0];
#pragma unroll
      for (int i = 1; i < 16; ++i) if (cur[i] > best) { best = cur[i]; bi = i; bj = pp[i]; }
      sel[r] = best;
      eid[r] = (int)ai[bi] * 128 + (int)bi_[bj];
      const int nj = bj + 1;
      const float nv = (nj < 16) ? (av[bi] + bv[nj & 15]) : -INFINITY;
#pragma unroll
      for (int i = 0; i < 16; ++i) { cur[i] = (i == bi) ? nv : cur[i]; pp[i] = (i == bi) ? nj : pp[i]; }
    }
    float sum = 0.f;
    const float smax = sel[0];
#pragma unroll
    for (int r = 0; r < 16; ++r) { sel[r] = __expf(sel[r] - smax); sum += sel[r]; }
    const float inv = 1.f / sum;
    int* eo = (int*)(p.ws + OFF_EIDX) + (size_t)(tok0 + tid) * 128 + head * 16;
    float* go = (float*)(p.ws + OFF_GATE) + (size_t)(tok0 + tid) * 128 + head * 16;
#pragma unroll
    for (int r = 0; r < 16; ++r) { eo[r] = eid[r]; go[r] = sel[r] * inv; }
  }
  __syncthreads();
}

DI float dot2bf(unsigned a, unsigned b, float c) {
  return __builtin_amdgcn_fdot2_f32_bf16(__builtin_bit_cast(bf2_t, a), __builtin_bit_cast(bf2_t, b), c, false);
}

DI void phase_peer_ffn(const Params& p) {
  const u16* exd = (const u16*)(p.ws + OFF_EXD);
  const u16* exu = (const u16*)(p.ws + OFF_EXU);
  const float* h = (const float*)(p.ws + OFF_H);
  const int* eidx = (const int*)(p.ws + OFF_EIDX);
  const float* gate = (const float*)(p.ws + OFF_GATE);
  const int lane = threadIdx.x & 63;
  const int gw = (blockIdx.x * blockDim.x + threadIdx.x) >> 6;
  const int nw = (gridDim.x * blockDim.x) >> 6;
  for (int tok = gw; tok < T_; tok += nw) {
    const float* xr = h + (size_t)tok * 1024;
    f32x4 x0 = *reinterpret_cast<const f32x4*>(xr + lane * 8);
    f32x4 x1 = *reinterpret_cast<const f32x4*>(xr + lane * 8 + 4);
    f32x4 x2 = *reinterpret_cast<const f32x4*>(xr + 512 + lane * 8);
    f32x4 x3 = *reinterpret_cast<const f32x4*>(xr + 512 + lane * 8 + 4);
    unsigned xp[8];
    xp[0] = pk_bf16(x0[0], x0[1]); xp[1] = pk_bf16(x0[2], x0[3]); xp[2] = pk_bf16(x1[0], x1[1]); xp[3] = pk_bf16(x1[2], x1[3]);
    xp[4] = pk_bf16(x2[0], x2[1]); xp[5] = pk_bf16(x2[2], x2[3]); xp[6] = pk_bf16(x3[0], x3[1]); xp[7] = pk_bf16(x3[2], x3[3]);
    float yacc[16];
#pragma unroll
    for (int i = 0; i < 16; ++i) yacc[i] = 0.f;
    const int e_lo = eidx[(size_t)tok * 128 + lane];
    const int e_hi = eidx[(size_t)tok * 128 + 64 + lane];
    const float g_lo = gate[(size_t)tok * 128 + lane];
    const float g_hi = gate[(size_t)tok * 128 + 64 + lane];
#pragma unroll 1
    for (int eb = 0; eb < 16; ++eb) {
      const int ev = (eb < 8) ? e_lo : e_hi;
      const float gv = (eb < 8) ? g_lo : g_hi;
      const int lbase = (eb & 7) * 8;
      int er[8];
#pragma unroll
      for (int k = 0; k < 8; ++k) er[k] = __builtin_amdgcn_readlane(ev, lbase + k);
      float part[8];
#pragma unroll
      for (int k = 0; k < 8; ++k) {
        const u16* row = exd + (size_t)er[k] * 1024;
        u32x4 d0 = *reinterpret_cast<const u32x4*>(row + lane * 8);
        u32x4 d1 = *reinterpret_cast<const u32x4*>(row + 512 + lane * 8);
        float a = 0.f;
#pragma unroll
        for (int j = 0; j < 4; ++j) a = dot2bf(d0[j], xp[j], a);
#pragma unroll
        for (int j = 0; j < 4; ++j) a = dot2bf(d1[j], xp[4 + j], a);
        part[k] = a;
      }
      float r4[4], r2[2], r1;
#pragma unroll
      for (int k = 0; k < 4; ++k) {
        float send = (lane & 1) ? part[2 * k] : part[2 * k + 1];
        float keep = (lane & 1) ? part[2 * k + 1] : part[2 * k];
        r4[k] = keep + __shfl_xor(send, 1);
      }
#pragma unroll
      for (int k = 0; k < 2; ++k) {
        float send = (lane & 2) ? r4[2 * k] : r4[2 * k + 1];
        float keep = (lane & 2) ? r4[2 * k + 1] : r4[2 * k];
        r2[k] = keep + __shfl_xor(send, 2);
      }
      {
        float send = (lane & 4) ? r2[0] : r2[1];
        float keep = (lane & 4) ? r2[1] : r2[0];
        r1 = keep + __shfl_xor(send, 4);
      }
      r1 += __shfl_xor(r1, 8);
      r1 += __shfl_xor(r1, 16);
      r1 += __shfl_xor(r1, 32);
      const float gsel = __shfl(gv, lbase + (lane & 7));
      const float act = 0.5f * r1 * (1.f + erff(r1 * 0.70710678118654752f));
      const float coef = gsel * act;
#pragma unroll
      for (int k = 0; k < 8; ++k) {
        const float ck = __int_as_float(__builtin_amdgcn_readlane(__float_as_int(coef), k));
        const u16* row = exu + (size_t)er[k] * 1024;
        u32x4 u0 = *reinterpret_cast<const u32x4*>(row + lane * 8);
        u32x4 u1 = *reinterpret_cast<const u32x4*>(row + 512 + lane * 8);
#pragma unroll
        for (int j = 0; j < 4; ++j) {
          yacc[2 * j] = fmaf(ck, bflo(u0[j]), yacc[2 * j]);
          yacc[2 * j + 1] = fmaf(ck, bfhi(u0[j]), yacc[2 * j + 1]);
          yacc[8 + 2 * j] = fmaf(ck, bflo(u1[j]), yacc[8 + 2 * j]);
          yacc[8 + 2 * j + 1] = fmaf(ck, bfhi(u1[j]), yacc[8 + 2 * j + 1]);
        }
      }
    }
    float v[16];
#pragma unroll
    for (int k = 0; k < 4; ++k) { v[k] = ALPHA * x0[k] + yacc[k]; v[4 + k] = ALPHA * x1[k] + yacc[4 + k]; v[8 + k] = ALPHA * x2[k] + yacc[8 + k]; v[12 + k] = ALPHA * x3[k] + yacc[12 + k]; }
    float s = 0.f;
#pragma unroll
    for (int i = 0; i < 16; ++i) s += v[i];
    const float mean = wave_sum(s) * (1.f / 1024.f);
    float q = 0.f;
#pragma unroll
    for (int i = 0; i < 16; ++i) { float d = v[i] - mean; q += d * d; }
    const float rstd = rsqrtf(wave_sum(q) * (1.f / 1024.f) + 1e-5f);
    float* orow = p.out + (size_t)tok * 1024;
#pragma unroll
    for (int part2 = 0; part2 < 2; ++part2)
#pragma unroll
      for (int c = 0; c < 2; ++c) {
        const int col = part2 * 512 + lane * 8 + c * 4;
        f32x4 gg = *reinterpret_cast<const f32x4*>(p.ln_ffn_g + col);
        f32x4 bb = *reinterpret_cast<const f32x4*>(p.ln_ffn_b + col);
        f32x4 o;
#pragma unroll
        for (int k = 0; k < 4; ++k) o[k] = (v[part2 * 8 + c * 4 + k] - mean) * rstd * gg[k] + bb[k];
        *reinterpret_cast<f32x4*>(orow + col) = o;
      }
  }
}

__global__ void __launch_bounds__(512) fwd_megakernel(Params p) {
  __shared__ __attribute__((aligned(16))) char smem[155648];
  cg::grid_group grid = cg::this_grid();
  const int G = gridDim.x;
  char* ws = p.ws;

  phase_prep(p, smem);
  grid.sync();

  phase_inproj(p, smem);
  grid.sync();

  for (int k = 0; k * G < 1024; ++k) {
    int j = (k & 1) ? (G - 1 - (int)blockIdx.x) : (int)blockIdx.x;
    int idx = k * G + j;
    if (idx < 1024) dsa_thr_item(p, idx & 7, 127 - (idx >> 3), smem);
  }
  for (int it = blockIdx.x; it < 2048; it += G) gla_g1_item(p, it, smem);
  grid.sync();

  for (int k = 0; k * G < 1024; ++k) {
    int j = (k & 1) ? (G - 1 - (int)blockIdx.x) : (int)blockIdx.x;
    int idx = k * G + j;
    if (idx < 1024) dsa_attn_item(p, idx & 7, 127 - (idx >> 3), smem);
  }
  gla_scan(p);
  grid.sync();

  for (int it = blockIdx.x; it < 2048; it += G) gla_g3_item(p, it, smem);
  grid.sync();

  phase_gemm<0>(p, (const u16*)(ws + OFF_XB), (const u16*)(ws + OFF_WOUT), 1024, p.x, (float*)(ws + OFF_H), nullptr, 0, smem);
  grid.sync();
  phase_ln(p, (float*)(ws + OFF_H), (u16*)(ws + OFF_HB), p.ln_mix_g, p.ln_mix_b);
  grid.sync();

  phase_gemm<1>(p, (const u16*)(ws + OFF_HB), (const u16*)(ws + OFF_WQ), 1024, nullptr, nullptr, (u16*)(ws + OFF_QX), 1024, smem);
  grid.sync();
  phase_xattn(p);
  grid.sync();
  phase_gemm<0>(p, (const u16*)(ws + OFF_OX), (const u16*)(ws + OFF_WO), 1024, (const float*)(ws + OFF_H), (float*)(ws + OFF_H), nullptr, 0, smem);
  grid.sync();
  phase_ln(p, (float*)(ws + OFF_H), (u16*)(ws + OFF_HB), p.ln_mem_g, p.ln_mem_b);
  grid.sync();

  phase_gemm<1>(p, (const u16*)(ws + OFF_HB), (const u16*)(ws + OFF_WPQ), 2048, nullptr, nullptr, (u16*)(ws + OFF_QX), 2048, smem);
  grid.sync();
  for (int it = blockIdx.x; it < 2048; it += G) peer_topk_item(p, it >> 3, it & 7, smem);
  grid.sync();
  phase_peer_ffn(p);
}

extern "C" void kernel_launch(void* const* d_in, const int* in_sizes, int n_in,
                              void* d_out, int out_size, void* d_ws, size_t ws_size,
                              hipStream_t stream) {
  static int grid_blocks = 0;
  if (!grid_blocks) {
    int dev = 0, cus = 0, per_cu = 0;
    (void)hipGetDevice(&dev);
    (void)hipDeviceGetAttribute(&cus, hipDeviceAttributeMultiprocessorCount, dev);
    (void)hipOccupancyMaxActiveBlocksPerMultiprocessor(&per_cu, fwd_megakernel, 512, 0);
    if (per_cu > 1) per_cu = 1;
    grid_blocks = cus * per_cu;
    if (grid_blocks > 256) grid_blocks = 256;
    if (ws_size < 512 * MiB) fprintf(stderr, "workspace too small: %zu\n", ws_size);
  }
  Params p{};
  p.x = (const float*)d_in[0]; p.positions = (const int*)d_in[1]; p.mem = (const float*)d_in[2]; p.w_in = (const float*)d_in[3];
  p.gate_up = (const float*)d_in[4]; p.gate_bias = (const float*)d_in[5]; p.norm_g = (const float*)d_in[6]; p.w_out = (const float*)d_in[7];
  p.ln_mix_g = (const float*)d_in[8]; p.ln_mix_b = (const float*)d_in[9];
  p.wq = (const float*)d_in[10]; p.wk = (const float*)d_in[11]; p.wv = (const float*)d_in[12]; p.wo = (const float*)d_in[13];
  p.ln_mem_g = (const float*)d_in[14]; p.ln_mem_b = (const float*)d_in[15];
  p.w_pq = (const float*)d_in[16]; p.sk1 = (const float*)d_in[17]; p.sk2 = (const float*)d_in[18];
  p.ex_down = (const float*)d_in[19]; p.ex_up = (const float*)d_in[20];
  p.ln_ffn_g = (const float*)d_in[21]; p.ln_ffn_b = (const float*)d_in[22];
  p.out = (float*)d_out; p.ws = (char*)d_ws;
  void* args[] = {&p};
  hipError_t e = hipLaunchCooperativeKernel((void*)fwd_megakernel, dim3(grid_blocks), dim3(512), args, 0, stream);
  if (e != hipSuccess) fprintf(stderr, "cooperative launch failed: %s (grid %d)\n", hipGetErrorString(e), grid_blocks);
}
```

```cpp
#include <hip/hip_runtime.h>
#include <hip/hip_cooperative_groups.h>
#include <cstdio>
#include <cmath>
namespace cg = cooperative_groups;

#define DI __device__ __forceinline__
typedef short bf16x8 __attribute__((ext_vector_type(8)));
typedef short bf16x4 __attribute__((ext_vector_type(4)));
typedef float f32x16 __attribute__((ext_vector_type(16)));
typedef float f32x4 __attribute__((ext_vector_type(4)));
typedef unsigned u32x4 __attribute__((ext_vector_type(4)));
typedef unsigned u32x2 __attribute__((ext_vector_type(2)));
typedef unsigned short u16;
typedef __bf16 bf2_t __attribute__((ext_vector_type(2)));
typedef float f2_t __attribute__((ext_vector_type(2)));

#define MFMA(a, b, c) __builtin_amdgcn_mfma_f32_32x32x16_bf16((a), (b), (c), 0, 0, 0)

constexpr int T_ = 32768;
constexpr int S_ = 4096;
constexpr int TMW = 2368;
constexpr int TM_Q = 0, TM_K = 512, TM_QI = 1024, TM_KI = 1280, TM_WI = 1312, TM_GLR = 1320, TM_GQ = 1344, TM_GK = 1600, TM_GR = 1856;
constexpr int PROJ_N = 3456;
constexpr float ALPHA = 1.189207115002721f;
constexpr size_t MiB = 1024 * 1024;

constexpr size_t OFF_XB = 0;
constexpr size_t OFF_EXD = 64 * MiB;
constexpr size_t OFF_EXU = 96 * MiB;
constexpr size_t OFF_WIN = 128 * MiB;
constexpr size_t OFF_WOUT = OFF_WIN + (size_t)PROJ_N * 1024 * 2;
constexpr size_t OFF_WQ = OFF_WOUT + 2 * MiB;
constexpr size_t OFF_WK = OFF_WQ + 2 * MiB;
constexpr size_t OFF_WV = OFF_WK + 2 * MiB;
constexpr size_t OFF_WO = OFF_WV + 2 * MiB;
constexpr size_t OFF_WPQ = OFF_WO + 2 * MiB;
constexpr size_t OFF_MEMB = 152 * MiB;
constexpr size_t OFF_MEMK = 156 * MiB;
constexpr size_t OFF_MEMVT = 160 * MiB;
constexpr size_t OFF_THR = 164 * MiB;
constexpr size_t OFF_SK = OFF_THR + 256 * 1024;
constexpr size_t OFF_DECAY = OFF_SK + 128 * 1024;
constexpr size_t OFF_ESC = 165 * MiB;
constexpr size_t OFF_TM = 168 * MiB;
constexpr size_t OFF_VT = 316 * MiB;
constexpr size_t OFF_GVT = 348 * MiB;
constexpr size_t OFF_KVT = 380 * MiB;
constexpr size_t OFF_PREV = 444 * MiB;
constexpr size_t OFF_H = 168 * MiB;
constexpr size_t OFF_HB = 296 * MiB;
constexpr size_t OFF_QX = 360 * MiB;
constexpr size_t OFF_OX = 424 * MiB;
constexpr size_t OFF_EIDX = 0;
constexpr size_t OFF_GATE = 16 * MiB;

struct Params {
  const float* x; const int* positions; const float* mem; const float* w_in;
  const float* gate_up; const float* gate_bias; const float* norm_g; const float* w_out;
  const float* ln_mix_g; const float* ln_mix_b;
  const float* wq; const float* wk; const float* wv; const float* wo;
  const float* ln_mem_g; const float* ln_mem_b;
  const float* w_pq; const float* sk1; const float* sk2; const float* ex_down; const float* ex_up;
  const float* ln_ffn_g; const float* ln_ffn_b;
  float* out; char* ws;
};

DI unsigned pk_bf16(float a, float b) {
  f2_t v = {a, b};
  bf2_t r = __builtin_convertvector(v, bf2_t);
  return __builtin_bit_cast(unsigned, r);
}
DI u16 f2bf(float a) { return (u16)(pk_bf16(a, 0.f) & 0xffffu); }
DI float bf2f(u16 u) { return __uint_as_float(((unsigned)u) << 16); }
DI float bflo(unsigned u) { return __uint_as_float(u << 16); }
DI float bfhi(unsigned u) { return __uint_as_float(u & 0xffff0000u); }
DI int crow(int i, int h) { return (i & 3) + 8 * (i >> 2) + 4 * h; }
DI bf16x8 ldg8(const u16* p) { return *reinterpret_cast<const bf16x8*>(p); }
DI bf16x8 pack8(float a0, float a1, float a2, float a3, float a4, float a5, float a6, float a7) {
  u32x4 r; r[0] = pk_bf16(a0, a1); r[1] = pk_bf16(a2, a3); r[2] = pk_bf16(a4, a5); r[3] = pk_bf16(a6, a7);
  return __builtin_bit_cast(bf16x8, r);
}
DI bf16x8 cat44(bf16x4 lo, bf16x4 hi) { return __builtin_shufflevector(lo, hi, 0, 1, 2, 3, 4, 5, 6, 7); }
DI void st4bf(u16* p, float a, float b, float c, float d) {
  u32x2 v; v[0] = pk_bf16(a, b); v[1] = pk_bf16(c, d);
  *reinterpret_cast<u32x2*>(p) = v;
}
DI float wave_sum(float v) {
#pragma unroll
  for (int d = 32; d >= 1; d >>= 1) v += __shfl_xor(v, d);
  return v;
}
DI void sincos_rad(float ang, float& s, float& c) {
  constexpr float C_hi = (float)0.15915494309189535;
  constexpr float C_lo = (float)(0.15915494309189535 - (double)C_hi);
  float k = rintf(ang * C_hi);
  float f = fmaf(ang, C_hi, -k);
  f = fmaf(ang, C_lo, f);
  s = __builtin_amdgcn_sinf(f);
  c = __builtin_amdgcn_cosf(f);
}
DI unsigned fkey(float s) {
  unsigned u = __float_as_uint(s + 0.0f);
  return (u & 0x80000000u) ? ~u : (u | 0x80000000u);
}
DI f32x16 zero16() { f32x16 z; for (int i = 0; i < 16; ++i) z[i] = 0.f; return z; }

DI int win_src_col(int n) {
  if (n < 1832) return n;
  if (n < 1848) return 2856 + (n - 1832);
  if (n < 1856) return -1;
  if (n < 2880) return n - 24;
  if (n < 3392) return n - 8;
  return -1;
}

DI void cvt_stream(const float* __restrict__ src, u16* __restrict__ dst, size_t n, size_t gtid, size_t gn) {
  size_t n8 = n / 8;
  for (size_t i = gtid; i < n8; i += gn) {
    f32x4 a = *reinterpret_cast<const f32x4*>(src + i * 8);
    f32x4 b = *reinterpret_cast<const f32x4*>(src + i * 8 + 4);
    u32x4 r; r[0] = pk_bf16(a[0], a[1]); r[1] = pk_bf16(a[2], a[3]); r[2] = pk_bf16(b[0], b[1]); r[3] = pk_bf16(b[2], b[3]);
    *reinterpret_cast<u32x4*>(dst + i * 8) = r;
  }
}

template <bool MAPPED>
DI void transpose_tile(const float* __restrict__ W, int ldn, u16* __restrict__ Wt, int k0, int n0, float* tile) {
  const int tid = threadIdx.x;
  {
    int nn = n0 + (tid & 63);
    int c = MAPPED ? win_src_col(nn) : nn;
#pragma unroll
    for (int rr = 0; rr < 8; ++rr) {
      int kk = (tid >> 6) + 8 * rr;
      float v = (c >= 0) ? W[(size_t)(k0 + kk) * ldn + c] : 0.f;
      tile[kk * 65 + (tid & 63)] = v;
    }
  }
  __syncthreads();
#pragma unroll
  for (int rr = 0; rr < 8; ++rr) {
    int nn = (tid >> 6) + 8 * rr;
    int kk = tid & 63;
    Wt[(size_t)(n0 + nn) * 1024 + k0 + kk] = f2bf(tile[kk * 65 + nn]);
  }
  __syncthreads();
}

DI void phase_prep(const Params& p, char* smem) {
  const size_t gtid = (size_t)blockIdx.x * blockDim.x + threadIdx.x;
  const size_t gn = (size_t)gridDim.x * blockDim.x;
  char* ws = p.ws;
  cvt_stream(p.x, (u16*)(ws + OFF_XB), (size_t)T_ * 1024, gtid, gn);
  cvt_stream(p.mem, (u16*)(ws + OFF_MEMB), (size_t)2048 * 1024, gtid, gn);
  {
    const int lane = threadIdx.x & 63;
    const int gw = (int)(gtid >> 6), nw = (int)(gn >> 6);
    for (int r = gw; r < 2 * 16384; r += nw) {
      const int tbl = r >> 14, row = r & 16383;
      const float* src = (tbl ? p.ex_up : p.ex_down) + (size_t)row * 1024 + lane * 16;
      f32x4 v[4]; float mx = 0.f;
#pragma unroll
      for (int c = 0; c < 4; ++c) {
        v[c] = *reinterpret_cast<const f32x4*>(src + c * 4);
#pragma unroll
        for (int k = 0; k < 4; ++k) mx = fmaxf(mx, fabsf(v[c][k]));
      }
#pragma unroll
      for (int d = 32; d >= 1; d >>= 1) mx = fmaxf(mx, __shfl_xor(mx, d));
      float sc = (mx > 0.f) ? exp2f(floorf(log2f(224.f / mx))) : 1.f;
      u32x4 o;
#pragma unroll
      for (int c = 0; c < 4; ++c) {
        int t = __builtin_amdgcn_cvt_pk_fp8_f32(v[c][0] * sc, v[c][1] * sc, 0, false);
        t = __builtin_amdgcn_cvt_pk_fp8_f32(v[c][2] * sc, v[c][3] * sc, t, true);
        o[c] = (unsigned)t;
      }
      *reinterpret_cast<u32x4*>(ws + (tbl ? OFF_EXU : OFF_EXD) + (size_t)row * 1024 + lane * 16) = o;
      if (lane == 0) ((float*)(ws + OFF_ESC))[r] = 1.f / sc;
    }
  }
  cvt_stream(p.sk1, (u16*)(ws + OFF_SK), (size_t)128 * 128, gtid, gn);
  cvt_stream(p.sk2, (u16*)(ws + OFF_SK) + 128 * 128, (size_t)128 * 128, gtid, gn);
  float* tile = (float*)smem;
  const int n_win = 54 * 16, n_sq = 256, n_pq = 512;
  const int total = n_win + 5 * n_sq + n_pq;
  for (int t = blockIdx.x; t < total; t += gridDim.x) {
    if (t < n_win) {
      transpose_tile<true>(p.w_in, 3384, (u16*)(ws + OFF_WIN), (t & 15) * 64, (t >> 4) * 64, tile);
    } else if (t < n_win + 5 * n_sq) {
      int u = t - n_win; int which = u >> 8; int r = u & 255;
      const float* W = which == 0 ? p.w_out : which == 1 ? p.wq : which == 2 ? p.wk : which == 3 ? p.wv : p.wo;
      size_t off = which == 0 ? OFF_WOUT : which == 1 ? OFF_WQ : which == 2 ? OFF_WK : which == 3 ? OFF_WV : OFF_WO;
      transpose_tile<false>(W, 1024, (u16*)(ws + off), (r & 15) * 64, (r >> 4) * 64, tile);
    } else {
      int r = t - n_win - 5 * n_sq;
      transpose_tile<false>(p.w_pq, 2048, (u16*)(ws + OFF_WPQ), (r & 15) * 64, (r >> 4) * 64, tile);
    }
  }
}

DI void gemm_tile(const u16* __restrict__ X, int ldx, const u16* __restrict__ Wt, int ldw, int K, char* smem,
                  f32x16 (&acc)[2][2]) {
  u16* Xs = (u16*)smem;
  u16* Ws = (u16*)(smem + 256 * 72 * 2);
  const int tid = threadIdx.x, lane = tid & 63, wave = tid >> 6;
  const int fw = wave & 1, tq = wave >> 1, lr = lane & 31, lh = lane >> 5;
  const int lrow = tid >> 3, lch = tid & 7;
  u32x4 xr[4], wr[2];
#pragma unroll
  for (int a = 0; a < 2; ++a)
#pragma unroll
    for (int b = 0; b < 2; ++b) acc[a][b] = zero16();
  const int nk = K / 64;
  const u16* xp = X + (size_t)lrow * ldx + lch * 8;
  const u16* wp = Wt + (size_t)lrow * ldw + lch * 8;
#pragma unroll
  for (int i = 0; i < 4; ++i) xr[i] = *reinterpret_cast<const u32x4*>(xp + (size_t)(64 * i) * ldx);
#pragma unroll
  for (int i = 0; i < 2; ++i) wr[i] = *reinterpret_cast<const u32x4*>(wp + (size_t)(64 * i) * ldw);
#pragma unroll
  for (int i = 0; i < 4; ++i) *reinterpret_cast<u32x4*>(Xs + (lrow + 64 * i) * 72 + lch * 8) = xr[i];
#pragma unroll
  for (int i = 0; i < 2; ++i) *reinterpret_cast<u32x4*>(Ws + (lrow + 64 * i) * 72 + lch * 8) = wr[i];
  __syncthreads();
  for (int kt = 0; kt < nk; ++kt) {
    if (kt + 1 < nk) {
#pragma unroll
      for (int i = 0; i < 4; ++i) xr[i] = *reinterpret_cast<const u32x4*>(xp + (size_t)(64 * i) * ldx + (kt + 1) * 64);
#pragma unroll
      for (int i = 0; i < 2; ++i) wr[i] = *reinterpret_cast<const u32x4*>(wp + (size_t)(64 * i) * ldw + (kt + 1) * 64);
    }
#pragma unroll
    for (int ks = 0; ks < 4; ++ks) {
      bf16x8 a[2], b[2];
#pragma unroll
      for (int ft = 0; ft < 2; ++ft) a[ft] = *reinterpret_cast<const bf16x8*>(Ws + (fw * 64 + ft * 32 + lr) * 72 + ks * 16 + lh * 8);
#pragma unroll
      for (int tt = 0; tt < 2; ++tt) b[tt] = *reinterpret_cast<const bf16x8*>(Xs + (tq * 64 + tt * 32 + lr) * 72 + ks * 16 + lh * 8);
#pragma unroll
      for (int ft = 0; ft < 2; ++ft)
#pragma unroll
        for (int tt = 0; tt < 2; ++tt) acc[ft][tt] = MFMA(a[ft], b[tt], acc[ft][tt]);
    }
    __syncthreads();
    if (kt + 1 < nk) {
#pragma unroll
      for (int i = 0; i < 4; ++i) *reinterpret_cast<u32x4*>(Xs + (lrow + 64 * i) * 72 + lch * 8) = xr[i];
#pragma unroll
      for (int i = 0; i < 2; ++i) *reinterpret_cast<u32x4*>(Ws + (lrow + 64 * i) * 72 + lch * 8) = wr[i];
      __syncthreads();
    }
  }
}

DI void epi_inproj(const Params& p, int tok0, int f0, f32x16 (&acc)[2][2]) {
  const int tid = threadIdx.x, lane = tid & 63, wave = tid >> 6;
  const int fw = wave & 1, tq = wave >> 1, lr = lane & 31, lh = lane >> 5;
  const int fbase = f0 + fw * 64;
  if (fbase >= 3392) return;
  u16* tm = (u16*)(p.ws + OFF_TM);
#pragma unroll
  for (int tt = 0; tt < 2; ++tt) {
    const int tok = tok0 + tq * 64 + tt * 32 + lr;
    const float posf = (float)p.positions[tok];
    const int bb = tok >> 12, ss = tok & 4095;
    if (fbase < 1024) {
#pragma unroll
      for (int r = 0; r < 4; ++r) {
        float j = (float)(4 * lh + r);
        float inv = exp2f(-j * (18.931568569324174f / 8.0f));
        float sn, cs; sincos_rad(posf * inv, sn, cs);
        float x1 = acc[0][tt][r], x2 = acc[0][tt][r + 4];
        acc[0][tt][r] = x1 * cs - x2 * sn;
        acc[0][tt][r + 4] = x2 * cs + x1 * sn;
      }
#pragma unroll
      for (int ft = 0; ft < 2; ++ft)
#pragma unroll
        for (int g = 0; g < 4; ++g)
          st4bf(tm + (size_t)tok * TMW + fbase + ft * 32 + 8 * g + 4 * lh, acc[ft][tt][4 * g], acc[ft][tt][4 * g + 1], acc[ft][tt][4 * g + 2], acc[ft][tt][4 * g + 3]);
    } else if (fbase < 1536 || (fbase >= 2368 && fbase < 2880)) {
      u16* vt = (fbase < 1536) ? (u16*)(p.ws + OFF_VT) : (u16*)(p.ws + OFF_GVT);
      const int fo = (fbase < 1536) ? fbase - 1024 : fbase - 2368;
#pragma unroll
      for (int ft = 0; ft < 2; ++ft)
#pragma unroll
        for (int i = 0; i < 16; ++i) {
          int feat = fo + ft * 32 + crow(i, lh);
          vt[((size_t)bb * 512 + feat) * 4096 + ss] = f2bf(acc[ft][tt][i]);
        }
    } else {
      int colbase;
      if (fbase < 1856) {
#pragma unroll
        for (int ft = 0; ft < 2; ++ft) {
          const bool rot = (fbase < 1792) || (ft == 0);
#pragma unroll
          for (int r = 0; r < 4; ++r) {
            float v = acc[ft][tt][r];
            float o = __shfl_xor(v, 32);
            float inv = exp2f(-(float)r * (18.931568569324174f / 4.0f));
            float sn, cs; sincos_rad(posf * inv, sn, cs);
            float res = (lh == 0) ? (v * cs - o * sn) : (v * cs + o * sn);
            acc[ft][tt][r] = rot ? res : v;
          }
        }
        colbase = fbase - 512;
      } else if (fbase < 2368) {
        colbase = fbase - 512;
      } else {
        colbase = fbase - 1024;
      }
#pragma unroll
      for (int ft = 0; ft < 2; ++ft)
#pragma unroll
        for (int g = 0; g < 4; ++g)
          st4bf(tm + (size_t)tok * TMW + colbase + ft * 32 + 8 * g + 4 * lh, acc[ft][tt][4 * g], acc[ft][tt][4 * g + 1], acc[ft][tt][4 * g + 2], acc[ft][tt][4 * g + 3]);
    }
  }
}

DI void phase_inproj(const Params& p, char* smem) {
  const int n_in = 128 * 27;
  const int total = n_in + 128;
  const u16* xb = (const u16*)(p.ws + OFF_XB);
  const u16* memb = (const u16*)(p.ws + OFF_MEMB);
  const int tid = threadIdx.x, lane = tid & 63, wave = tid >> 6;
  const int fw = wave & 1, tq = wave >> 1, lr = lane & 31, lh = lane >> 5;
  for (int t = blockIdx.x; t < total; t += gridDim.x) {
    f32x16 acc[2][2];
    if (t < n_in) {
      int mt = t / 27, nt = t % 27;
      gemm_tile(xb + (size_t)mt * 256 * 1024, 1024, (const u16*)(p.ws + OFF_WIN) + (size_t)nt * 128 * 1024, 1024, 1024, smem, acc);
      epi_inproj(p, mt * 256, nt * 128, acc);
    } else {
      int u = t - n_in; int which = u >> 6; int r = u & 63; int mt = r >> 3, nt = r & 7;
      const u16* W = (const u16*)(p.ws + (which == 0 ? OFF_WK : OFF_WV));
      gemm_tile(memb + (size_t)mt * 256 * 1024, 1024, W + (size_t)nt * 128 * 1024, 1024, 1024, smem, acc);
#pragma unroll
      for (int tt = 0; tt < 2; ++tt) {
        const int tok = mt * 256 + tq * 64 + tt * 32 + lr;
        if (which == 0) {
          u16* mk = (u16*)(p.ws + OFF_MEMK);
#pragma unroll
          for (int ft = 0; ft < 2; ++ft)
#pragma unroll
            for (int g = 0; g < 4; ++g)
              st4bf(mk + (size_t)tok * 1024 + nt * 128 + fw * 64 + ft * 32 + 8 * g + 4 * lh, acc[ft][tt][4 * g], acc[ft][tt][4 * g + 1], acc[ft][tt][4 * g + 2], acc[ft][tt][4 * g + 3]);
        } else {
          u16* mv = (u16*)(p.ws + OFF_MEMVT);
          const int bb = tok >> 8, mm = tok & 255;
#pragma unroll
          for (int ft = 0; ft < 2; ++ft)
#pragma unroll
            for (int i = 0; i < 16; ++i) {
              int feat = nt * 128 + fw * 64 + ft * 32 + crow(i, lh);
              mv[((size_t)bb * 1024 + feat) * 256 + mm] = f2bf(acc[ft][tt][i]);
            }
        }
      }
    }
  }
}

DI void idx_scores(const bf16x8 (&qf)[8][2], const float (&wq)[8], bf16x8 k0, bf16x8 k1, float (&sc)[16]) {
#pragma unroll
  for (int i = 0; i < 16; ++i) sc[i] = 0.f;
#pragma unroll
  for (int hd = 0; hd < 8; ++hd) {
    f32x16 a = zero16();
    a = MFMA(k0, qf[hd][0], a);
    a = MFMA(k1, qf[hd][1], a);
#pragma unroll
    for (int i = 0; i < 16; ++i) sc[i] = fmaf(wq[hd], fmaxf(a[i], 0.f), sc[i]);
  }
}

DI void load_idx_q(const u16* tm, int tok, int lh, bf16x8 (&qf)[8][2], float (&wq)[8]) {
  const u16* row = tm + (size_t)tok * TMW;
#pragma unroll
  for (int hd = 0; hd < 8; ++hd)
#pragma unroll
    for (int ks = 0; ks < 2; ++ks) qf[hd][ks] = ldg8(row + TM_QI + hd * 32 + ks * 16 + lh * 8);
  bf16x8 w8 = ldg8(row + TM_WI);
#pragma unroll
  for (int hd = 0; hd < 8; ++hd) wq[hd] = bf2f((u16)w8[hd]) * 0.0625f;
}

DI int wave_incl_scan(int v, int lane) {
#pragma unroll
  for (int d = 1; d < 64; d <<= 1) {
    int t = __shfl_up(v, d);
    if (lane >= d) v += t;
  }
  return v;
}

DI void dsa_thr_item(const Params& p, int b, int qblk, char* smem) {
  unsigned* hist = (unsigned*)smem;
  unsigned* pref = (unsigned*)(smem + 32768);
  int* rank = (int*)(smem + 32768 + 128);
  const u16* tm = (const u16*)(p.ws + OFF_TM);
  const int tid = threadIdx.x, lane = tid & 63, wave = tid >> 6, lr = lane & 31, lh = lane >> 5;
  const int q0 = qblk * 32;
  bf16x8 qf[8][2]; float wq[8];
  load_idx_q(tm, b * S_ + q0 + lr, lh, qf, wq);
  if (tid < 32) { pref[tid] = 0u; rank[tid] = min(256, q0 + tid + 1); }
  for (int pass = 0; pass < 4; ++pass) {
    for (int i = tid; i < 8192; i += 512) hist[i] = 0u;
    __syncthreads();
    const int shift = 24 - 8 * pass;
    const unsigned mypref = pref[lr];
    for (int kt = wave; kt <= qblk; kt += 8) {
      const u16* krow = tm + (size_t)(b * S_ + kt * 32 + lr) * TMW + TM_KI + lh * 8;
      bf16x8 k0 = ldg8(krow), k1 = ldg8(krow + 16);
      float sc[16];
      idx_scores(qf, wq, k0, k1, sc);
#pragma unroll
      for (int i = 0; i < 16; ++i) {
        int kp = kt * 32 + crow(i, lh);
        unsigned ky = fkey(sc[i]);
        unsigned hi = (ky >> shift);
        if (kp <= q0 + lr && (hi >> 8) == mypref) atomicAdd(&hist[(hi & 255u) * 32 + lr], 1u);
      }
    }
    __syncthreads();
#pragma unroll 1
    for (int qq = 0; qq < 4; ++qq) {
      const int q = wave * 4 + qq;
      const int rk = rank[q];
      int c[4];
#pragma unroll
      for (int j = 0; j < 4; ++j) c[j] = (int)hist[(255 - 4 * lane - j) * 32 + q];
      int s = c[0] + c[1] + c[2] + c[3];
      int P = wave_incl_scan(s, lane);
      int excl = P - s;
      if (P >= rk && excl < rk) {
        int cum = excl; int bin = 0; int nr = 1; bool found = false;
#pragma unroll
        for (int j = 0; j < 4; ++j) {
          if (!found && cum + c[j] >= rk) { bin = 255 - 4 * lane - j; nr = rk - cum; found = true; }
          if (!found) cum += c[j];
        }
        pref[q] = (pref[q] << 8) | (unsigned)bin;
        rank[q] = nr;
      }
    }
    __syncthreads();
  }
  if (tid < 32) ((unsigned*)(p.ws + OFF_THR))[b * S_ + q0 + tid] = pref[tid];
  __syncthreads();
}

DI void dsa_attn_item(const Params& p, int b, int qblk, char* smem) {
  u16* maskbuf = (u16*)smem;
  u16* qi = (u16*)(smem + 4096);
  const u16* tm = (const u16*)(p.ws + OFF_TM);
  const u16* vT = (const u16*)(p.ws + OFF_VT);
  const unsigned* thr = (const unsigned*)(p.ws + OFF_THR);
  const int tid = threadIdx.x, lane = tid & 63, wave = tid >> 6, lr = lane & 31, lh = lane >> 5;
  const int q0 = qblk * 32;
  const int head = wave;
  const int qtok = b * S_ + q0 + lr;
  bf16x8 Qf[4];
#pragma unroll
  for (int ks = 0; ks < 4; ++ks) {
    bf16x8 raw = ldg8(tm + (size_t)qtok * TMW + TM_Q + head * 64 + ks * 16 + lh * 8);
    float f[8];
#pragma unroll
    for (int j = 0; j < 8; ++j) f[j] = bf2f((u16)raw[j]) * 0.125f;
    Qf[ks] = pack8(f[0], f[1], f[2], f[3], f[4], f[5], f[6], f[7]);
  }
  f32x16 O[2];
  O[0] = zero16(); O[1] = zero16();
  float mrun = -INFINITY, lrun = 0.f;
  const unsigned thrq = thr[qtok];
  const int nchunks = (q0 + 31) / 256 + 1;
  const u16* vbase = vT + ((size_t)b * 512 + head * 64 + lr) * 4096 + 4 * lh;
  for (int i = tid; i < 32 * 32; i += 512) {
    int q = i >> 5, ch = i & 31;
    *reinterpret_cast<u32x4*>(qi + q * 264 + ch * 8) = *reinterpret_cast<const u32x4*>(tm + (size_t)(b * S_ + q0 + q) * TMW + TM_QI + ch * 8);
  }
  float wq[8];
  {
    bf16x8 w8 = ldg8(tm + (size_t)qtok * TMW + TM_WI);
#pragma unroll
    for (int hd = 0; hd < 8; ++hd) wq[hd] = bf2f((u16)w8[hd]) * 0.0625f;
  }
  __syncthreads();
  const u16* qil = qi + lr * 264 + lh * 8;
  for (int c = 0; c < nchunks; ++c) {
    const int buf = c & 1;
    {
      const int key0 = (c * 8 + wave) * 32;
      unsigned bits = 0u;
      if (key0 <= q0 + 31) {
        const u16* krow = tm + (size_t)(b * S_ + key0 + lr) * TMW + TM_KI + lh * 8;
        bf16x8 k0 = ldg8(krow), k1 = ldg8(krow + 16);
        float sc[16];
#pragma unroll
        for (int i = 0; i < 16; ++i) sc[i] = 0.f;
#pragma unroll
        for (int hd = 0; hd < 8; ++hd) {
          f32x16 a = zero16();
          a = MFMA(k0, *reinterpret_cast<const bf16x8*>(qil + hd * 32), a);
          a = MFMA(k1, *reinterpret_cast<const bf16x8*>(qil + hd * 32 + 16), a);
#pragma unroll
          for (int i = 0; i < 16; ++i) sc[i] = fmaf(wq[hd], fmaxf(a[i], 0.f), sc[i]);
        }
#pragma unroll
        for (int i = 0; i < 16; ++i) {
          int kp = key0 + crow(i, lh);
          if (kp <= q0 + lr && fkey(sc[i]) >= thrq) bits |= (1u << i);
        }
      }
      maskbuf[(buf * 8 + wave) * 64 + lane] = (u16)bits;
    }
    __syncthreads();
#pragma unroll 1
    for (int t8 = 0; t8 < 8; ++t8) {
      const int key0 = (c * 8 + t8) * 32;
      if (key0 > q0 + 31) break;
      bf16x8 Kf[4];
      const u16* krow = tm + (size_t)(b * S_ + key0 + lr) * TMW + TM_K + head * 64 + lh * 8;
#pragma unroll
      for (int ks = 0; ks < 4; ++ks) Kf[ks] = ldg8(krow + ks * 16);
      bf16x8 Vf[2][2];
#pragma unroll
      for (int dt = 0; dt < 2; ++dt)
#pragma unroll
        for (int s = 0; s < 2; ++s) {
          const u16* vp = vbase + (size_t)(dt * 32) * 4096 + key0 + 16 * s;
          bf16x4 lo = *reinterpret_cast<const bf16x4*>(vp);
          bf16x4 hi = *reinterpret_cast<const bf16x4*>(vp + 8);
          Vf[dt][s] = cat44(lo, hi);
        }
      const unsigned bits = maskbuf[(buf * 8 + t8) * 64 + lane];
      f32x16 Sx = zero16();
#pragma unroll
      for (int ks = 0; ks < 4; ++ks) Sx = MFMA(Kf[ks], Qf[ks], Sx);
      float mt = -INFINITY;
#pragma unroll
      for (int i = 0; i < 16; ++i) mt = ((bits >> i) & 1u) ? fmaxf(mt, Sx[i]) : mt;
      mt = fmaxf(mt, __shfl_xor(mt, 32));
      const float mnew = fmaxf(mrun, mt);
      const float msafe = (mnew == -INFINITY) ? 0.f : mnew;
      const float alpha = __expf(mrun - msafe);
      float pv[16]; float ps = 0.f;
#pragma unroll
      for (int i = 0; i < 16; ++i) { pv[i] = ((bits >> i) & 1u) ? __expf(Sx[i] - msafe) : 0.f; ps += pv[i]; }
      lrun = lrun * alpha + ps;
      mrun = mnew;
#pragma unroll
      for (int dt = 0; dt < 2; ++dt)
#pragma unroll
        for (int i = 0; i < 16; ++i) O[dt][i] *= alpha;
      bf16x8 Pf[2];
#pragma unroll
      for (int s = 0; s < 2; ++s) Pf[s] = pack8(pv[8 * s], pv[8 * s + 1], pv[8 * s + 2], pv[8 * s + 3], pv[8 * s + 4], pv[8 * s + 5], pv[8 * s + 6], pv[8 * s + 7]);
#pragma unroll
      for (int dt = 0; dt < 2; ++dt)
#pragma unroll
        for (int s = 0; s < 2; ++s) O[dt] = MFMA(Vf[dt][s], Pf[s], O[dt]);
    }
  }
  u16* y = (u16*)(p.ws + OFF_XB);
  {
    float lt = lrun + __shfl_xor(lrun, 32);
    float inv = 1.f / lt;
#pragma unroll
    for (int dt = 0; dt < 2; ++dt)
#pragma unroll
      for (int g = 0; g < 4; ++g)
        st4bf(y + (size_t)qtok * 1024 + head * 64 + dt * 32 + 8 * g + 4 * lh, O[dt][4 * g] * inv, O[dt][4 * g + 1] * inv, O[dt][4 * g + 2] * inv, O[dt][4 * g + 3] * inv);
  }
  __syncthreads();
}

DI void gla_bcum(const Params& p, int b, int h, int n, float* bc, float* glr_s, float* segtot) {
  const u16* tm = (const u16*)(p.ws + OFF_TM);
  const int tid = threadIdx.x;
  const int tok0 = b * S_ + n * 64;
  for (int i = tid; i < 1024; i += 512) glr_s[i] = bf2f(tm[(size_t)(tok0 + (i >> 4)) * TMW + TM_GLR + (i & 15)]);
  const int d = tid & 63, cgp = tid >> 6;
  float gu[16];
#pragma unroll
  for (int j = 0; j < 16; ++j) gu[j] = p.gate_up[j * 256 + h * 64 + d];
  const float bias = p.gate_bias[h * 64 + d];
  __syncthreads();
  float v[8]; float run = 0.f;
#pragma unroll
  for (int r = 0; r < 8; ++r) {
    const int c = cgp * 8 + r;
    float z = bias;
#pragma unroll
    for (int j = 0; j < 16; ++j) z = fmaf(glr_s[c * 16 + j], gu[j], z);
    float la = (fminf(z, 0.f) - log1pf(__expf(-fabsf(z)))) * 0.0625f;
    run += la; v[r] = run;
  }
  segtot[cgp * 64 + d] = run;
  __syncthreads();
  float off = 0.f;
#pragma unroll
  for (int g = 0; g < 8; ++g) off += (g < cgp) ? segtot[g * 64 + d] : 0.f;
#pragma unroll
  for (int r = 0; r < 8; ++r) bc[(cgp * 8 + r) * 64 + d] = off + v[r];
  __syncthreads();
}

DI void gla_g1_item(const Params& p, int item, char* smem) {
  float* bc = (float*)smem;
  float* glr_s = (float*)(smem + 16384);
  float* segtot = (float*)(smem + 20480);
  u16* KeT = (u16*)(smem + 22528);
  const int b = item >> 8, h = (item >> 6) & 3, n = item & 63;
  const u16* tm = (const u16*)(p.ws + OFF_TM);
  const u16* gvT = (const u16*)(p.ws + OFF_GVT);
  const int tid = threadIdx.x, lane = tid & 63, wave = tid >> 6, lr = lane & 31, lh = lane >> 5;
  const int tok0 = b * S_ + n * 64;
  gla_bcum(p, b, h, n, bc, glr_s, segtot);
  {
    const int d = tid & 63, cgp = tid >> 6;
    const float blast = bc[63 * 64 + d];
    float f[8];
#pragma unroll
    for (int r = 0; r < 8; ++r) {
      const int c = cgp * 8 + r;
      float kv = bf2f(tm[(size_t)(tok0 + c) * TMW + TM_GK + h * 64 + d]);
      f[r] = kv * __expf(blast - bc[c * 64 + d]);
    }
    *reinterpret_cast<bf16x8*>(KeT + d * 72 + cgp * 8) = pack8(f[0], f[1], f[2], f[3], f[4], f[5], f[6], f[7]);
    if (cgp == 0) ((float*)(p.ws + OFF_DECAY))[item * 64 + d] = __expf(blast);
  }
  __syncthreads();
  {
    const int et = wave & 3, dtl = wave >> 2;
    f32x16 acc = zero16();
    const u16* arow = gvT + ((size_t)b * 512 + h * 128 + et * 32 + lr) * 4096 + n * 64 + lh * 8;
#pragma unroll
    for (int ks = 0; ks < 4; ++ks) {
      bf16x8 a = ldg8(arow + ks * 16);
      bf16x8 bb = *reinterpret_cast<const bf16x8*>(KeT + (dtl * 32 + lr) * 72 + ks * 16 + lh * 8);
      acc = MFMA(a, bb, acc);
    }
    float* kvT = (float*)(p.ws + OFF_KVT);
#pragma unroll
    for (int i = 0; i < 16; ++i) kvT[((size_t)item * 128 + et * 32 + crow(i, lh)) * 64 + dtl * 32 + lr] = acc[i];
  }
  __syncthreads();
}

DI void gla_scan(const Params& p) {
  const float* kvT = (const float*)(p.ws + OFF_KVT);
  const float* decay = (const float*)(p.ws + OFF_DECAY);
  u16* prev = (u16*)(p.ws + OFF_PREV);
  const int gtid = blockIdx.x * blockDim.x + threadIdx.x;
  const int gn = gridDim.x * blockDim.x;
  for (int u = gtid; u < 32 * 2048; u += gn) {
    const int bh = u >> 11, rem = u & 2047, e = rem >> 4, d4 = (rem & 15) * 4;
    f32x4 st = {0.f, 0.f, 0.f, 0.f};
#pragma unroll 4
    for (int n = 0; n < 64; ++n) {
      const int item = bh * 64 + n;
      st4bf(prev + ((size_t)item * 128 + e) * 64 + d4, st[0], st[1], st[2], st[3]);
      f32x4 dc = *reinterpret_cast<const f32x4*>(decay + item * 64 + d4);
      f32x4 kv = *reinterpret_cast<const f32x4*>(kvT + ((size_t)item * 128 + e) * 64 + d4);
      st = dc * st + kv;
    }
  }
}

DI void gla_g3_item(const Params& p, int item, char* smem) {
  float* bc = (float*)smem;
  float* glr_s = (float*)(smem + 16384);
  float* segtot = (float*)(smem + 20480);
  float* red = (float*)(smem + 22528);
  const int b = item >> 8, h = (item >> 6) & 3, n = item & 63;
  const u16* tm = (const u16*)(p.ws + OFF_TM);
  const u16* gvT = (const u16*)(p.ws + OFF_GVT);
  const u16* prev = (const u16*)(p.ws + OFF_PREV);
  const int tid = threadIdx.x, lane = tid & 63, wave = tid >> 6, lr = lane & 31, lh = lane >> 5;
  const int tok0 = b * S_ + n * 64;
  gla_bcum(p, b, h, n, bc, glr_s, segtot);
  const int et = wave & 3, ct = wave >> 2;
  bf16x8 Qd[4];
  {
    const int c = ct * 32 + lr;
#pragma unroll
    for (int ks = 0; ks < 4; ++ks) {
      bf16x8 raw = ldg8(tm + (size_t)(tok0 + c) * TMW + TM_GQ + h * 64 + ks * 16 + lh * 8);
      float f[8];
#pragma unroll
      for (int j = 0; j < 8; ++j) f[j] = bf2f((u16)raw[j]) * 0.125f * __expf(bc[c * 64 + ks * 16 + lh * 8 + j]);
      Qd[ks] = pack8(f[0], f[1], f[2], f[3], f[4], f[5], f[6], f[7]);
    }
  }
  f32x16 O = zero16();
  const u16* vrow = gvT + ((size_t)b * 512 + h * 128 + et * 32 + lr) * 4096 + n * 64 + 4 * lh;
#pragma unroll
  for (int st = 0; st < 2; ++st) {
    if (st <= ct) {
      f32x16 A = zero16();
      const int s = st * 32 + lr;
#pragma unroll
      for (int ks = 0; ks < 4; ++ks) {
        bf16x8 raw = ldg8(tm + (size_t)(tok0 + s) * TMW + TM_GK + h * 64 + ks * 16 + lh * 8);
        float f[8];
#pragma unroll
        for (int j = 0; j < 8; ++j) f[j] = bf2f((u16)raw[j]) * __expf(-bc[s * 64 + ks * 16 + lh * 8 + j]);
        bf16x8 Ki = pack8(f[0], f[1], f[2], f[3], f[4], f[5], f[6], f[7]);
        A = MFMA(Ki, Qd[ks], A);
      }
      float pv[16];
#pragma unroll
      for (int i = 0; i < 16; ++i) pv[i] = (st * 32 + crow(i, lh) <= ct * 32 + lr) ? A[i] : 0.f;
#pragma unroll
      for (int s2 = 0; s2 < 2; ++s2) {
        bf16x8 Pf = pack8(pv[8 * s2], pv[8 * s2 + 1], pv[8 * s2 + 2], pv[8 * s2 + 3], pv[8 * s2 + 4], pv[8 * s2 + 5], pv[8 * s2 + 6], pv[8 * s2 + 7]);
        const u16* vp = vrow + st * 32 + 16 * s2;
        bf16x4 lo = *reinterpret_cast<const bf16x4*>(vp);
        bf16x4 hi = *reinterpret_cast<const bf16x4*>(vp + 8);
        O = MFMA(cat44(lo, hi), Pf, O);
      }
    }
  }
  {
    const u16* srow = prev + ((size_t)item * 128 + et * 32 + lr) * 64 + lh * 8;
#pragma unroll
    for (int ks = 0; ks < 4; ++ks) O = MFMA(ldg8(srow + ks * 16), Qd[ks], O);
  }
  float ss = 0.f;
#pragma unroll
  for (int i = 0; i < 16; ++i) ss += O[i] * O[i];
  ss += __shfl_xor(ss, 32);
  if (lh == 0) red[(ct * 4 + et) * 32 + lr] = ss;
  __syncthreads();
  const float tot = red[(ct * 4 + 0) * 32 + lr] + red[(ct * 4 + 1) * 32 + lr] + red[(ct * 4 + 2) * 32 + lr] + red[(ct * 4 + 3) * 32 + lr];
  const float rinv = rsqrtf(tot * (1.f / 128.f) + 1e-6f);
  const int tok = tok0 + ct * 32 + lr;
  u16* y = (u16*)(p.ws + OFF_XB);
#pragma unroll
  for (int g = 0; g < 4; ++g) {
    const int e0 = et * 32 + 8 * g + 4 * lh;
    u32x2 gr = *reinterpret_cast<const u32x2*>(tm + (size_t)tok * TMW + TM_GR + h * 128 + e0);
    f32x4 ng = *reinterpret_cast<const f32x4*>(p.norm_g + e0);
    float grv[4] = {bflo(gr[0]), bfhi(gr[0]), bflo(gr[1]), bfhi(gr[1])};
    float o[4];
#pragma unroll
    for (int r = 0; r < 4; ++r) {
      float sl = grv[r] / (1.f + __expf(-grv[r]));
      o[r] = O[4 * g + r] * rinv * ng[r] * sl;
    }
    st4bf(y + (size_t)tok * 1024 + 512 + h * 128 + e0, o[0], o[1], o[2], o[3]);
  }
  __syncthreads();
}

template <int MODE>
DI void phase_gemm(const Params& p, const u16* X, const u16* Wt, int N, const float* resid, float* outf, u16* outb, int ldo, char* smem) {
  const int ntn = N / 128;
  const int total = 128 * ntn;
  const int tid = threadIdx.x, lane = tid & 63, wave = tid >> 6;
  const int fw = wave & 1, tq = wave >> 1, lr = lane & 31, lh = lane >> 5;
  for (int t = blockIdx.x; t < total; t += gridDim.x) {
    const int mt = t / ntn, nt = t % ntn;
    f32x16 acc[2][2];
    gemm_tile(X + (size_t)mt * 256 * 1024, 1024, Wt + (size_t)nt * 128 * 1024, 1024, 1024, smem, acc);
#pragma unroll
    for (int tt = 0; tt < 2; ++tt) {
      const int tok = mt * 256 + tq * 64 + tt * 32 + lr;
#pragma unroll
      for (int ft = 0; ft < 2; ++ft)
#pragma unroll
        for (int g = 0; g < 4; ++g) {
          const int f = nt * 128 + fw * 64 + ft * 32 + 8 * g + 4 * lh;
          if (MODE == 0) {
            f32x4 r = *reinterpret_cast<const f32x4*>(resid + (size_t)tok * 1024 + f);
            f32x4 o;
#pragma unroll
            for (int k = 0; k < 4; ++k) o[k] = ALPHA * r[k] + acc[ft][tt][4 * g + k];
            *reinterpret_cast<f32x4*>(outf + (size_t)tok * 1024 + f) = o;
          } else {
            st4bf(outb + (size_t)tok * ldo + f, acc[ft][tt][4 * g], acc[ft][tt][4 * g + 1], acc[ft][tt][4 * g + 2], acc[ft][tt][4 * g + 3]);
          }
        }
    }
  }
}

DI void phase_ln(const Params& p, float* h, u16* hb, const float* g, const float* bta) {
  const int lane = threadIdx.x & 63;
  const int gw = (blockIdx.x * blockDim.x + threadIdx.x) >> 6;
  const int nw = (gridDim.x * blockDim.x) >> 6;
  for (int row = gw; row < T_; row += nw) {
    float* r = h + (size_t)row * 1024;
    f32x4 v[4]; float s = 0.f;
#pragma unroll
    for (int c = 0; c < 4; ++c) { v[c] = *reinterpret_cast<const f32x4*>(r + c * 256 + lane * 4); s += v[c][0] + v[c][1] + v[c][2] + v[c][3]; }
    const float mean = wave_sum(s) * (1.f / 1024.f);
    float q = 0.f;
#pragma unroll
    for (int c = 0; c < 4; ++c)
#pragma unroll
      for (int k = 0; k < 4; ++k) { float d = v[c][k] - mean; q += d * d; }
    const float rstd = rsqrtf(wave_sum(q) * (1.f / 1024.f) + 1e-5f);
#pragma unroll
    for (int c = 0; c < 4; ++c) {
      f32x4 gg = *reinterpret_cast<const f32x4*>(g + c * 256 + lane * 4);
      f32x4 bb = *reinterpret_cast<const f32x4*>(bta + c * 256 + lane * 4);
      f32x4 o;
#pragma unroll
      for (int k = 0; k < 4; ++k) o[k] = (v[c][k] - mean) * rstd * gg[k] + bb[k];
      *reinterpret_cast<f32x4*>(r + c * 256 + lane * 4) = o;
      st4bf(hb + (size_t)row * 1024 + c * 256 + lane * 4, o[0], o[1], o[2], o[3]);
    }
  }
}

DI void phase_xattn(const Params& p) {
  const u16* qx = (const u16*)(p.ws + OFF_QX);
  const u16* mk = (const u16*)(p.ws + OFF_MEMK);
  const u16* mv = (const u16*)(p.ws + OFF_MEMVT);
  u16* ox = (u16*)(p.ws + OFF_OX);
  const int lane = threadIdx.x & 63, lr = lane & 31, lh = lane >> 5;
  const int gw = (blockIdx.x * blockDim.x + threadIdx.x) >> 6;
  const int nw = (gridDim.x * blockDim.x) >> 6;
  for (int it = gw; it < 8 * 4 * 128; it += nw) {
    const int qt = it & 127, h = (it >> 7) & 3, b = it >> 9;
    const int tok = b * S_ + qt * 32 + lr;
    f32x16 Sx[8];
#pragma unroll
    for (int kt = 0; kt < 8; ++kt) Sx[kt] = zero16();
    const u16* qrow = qx + (size_t)tok * 1024 + h * 256 + lh * 8;
    const u16* krow = mk + (size_t)(b * 256 + lr) * 1024 + h * 256 + lh * 8;
#pragma unroll 2
    for (int ks = 0; ks < 16; ++ks) {
      bf16x8 qf = ldg8(qrow + ks * 16);
#pragma unroll
      for (int kt = 0; kt < 8; ++kt) Sx[kt] = MFMA(ldg8(krow + (size_t)(kt * 32) * 1024 + ks * 16), qf, Sx[kt]);
    }
    float mx = -INFINITY;
#pragma unroll
    for (int kt = 0; kt < 8; ++kt)
#pragma unroll
      for (int i = 0; i < 16; ++i) mx = fmaxf(mx, Sx[kt][i]);
    mx = fmaxf(mx, __shfl_xor(mx, 32));
    float ls = 0.f;
    bf16x8 Pf[8][2];
#pragma unroll
    for (int kt = 0; kt < 8; ++kt) {
      float pv[16];
#pragma unroll
      for (int i = 0; i < 16; ++i) { pv[i] = __expf((Sx[kt][i] - mx) * 0.0625f); ls += pv[i]; }
#pragma unroll
      for (int s = 0; s < 2; ++s) Pf[kt][s] = pack8(pv[8 * s], pv[8 * s + 1], pv[8 * s + 2], pv[8 * s + 3], pv[8 * s + 4], pv[8 * s + 5], pv[8 * s + 6], pv[8 * s + 7]);
    }
    ls += __shfl_xor(ls, 32);
    const float inv = 1.f / ls;
#pragma unroll 1
    for (int dt = 0; dt < 8; ++dt) {
      f32x16 o = zero16();
      const u16* vrow = mv + ((size_t)b * 1024 + h * 256 + dt * 32 + lr) * 256 + 4 * lh;
#pragma unroll
      for (int kt = 0; kt < 8; ++kt)
#pragma unroll
        for (int s = 0; s < 2; ++s) {
          const u16* vp = vrow + kt * 32 + 16 * s;
          bf16x4 lo = *reinterpret_cast<const bf16x4*>(vp);
          bf16x4 hi = *reinterpret_cast<const bf16x4*>(vp + 8);
          o = MFMA(cat44(lo, hi), Pf[kt][s], o);
        }
#pragma unroll
      for (int g = 0; g < 4; ++g)
        st4bf(ox + (size_t)tok * 1024 + h * 256 + dt * 32 + 8 * g + 4 * lh, o[4 * g] * inv, o[4 * g + 1] * inv, o[4 * g + 2] * inv, o[4 * g + 3] * inv);
    }
  }
}

DI void peer_topk_item(const Params& p, int tt128, int head, char* smem) {
  float* sc = (float*)smem;
  float* topv = (float*)(smem + 132096);
  unsigned char* topi = (unsigned char*)(smem + 132096 + 16384);
  const u16* pq = (const u16*)(p.ws + OFF_QX);
  const u16* sk = (const u16*)(p.ws + OFF_SK);
  const int tid = threadIdx.x, lane = tid & 63, wave = tid >> 6, lr = lane & 31, lh = lane >> 5;
  const int tok0 = tt128 * 128;
  {
    const int half = wave >> 2, kt = wave & 3;
    bf16x8 af[8];
#pragma unroll
    for (int ks = 0; ks < 8; ++ks) af[ks] = ldg8(sk + (size_t)half * 16384 + (kt * 32 + lr) * 128 + ks * 16 + lh * 8);
#pragma unroll 1
    for (int tt = 0; tt < 4; ++tt) {
      f32x16 acc = zero16();
      const u16* brow = pq + (size_t)(tok0 + tt * 32 + lr) * 2048 + head * 256 + half * 128 + lh * 8;
#pragma unroll
      for (int ks = 0; ks < 8; ++ks) acc = MFMA(af[ks], ldg8(brow + ks * 16), acc);
#pragma unroll
      for (int i = 0; i < 16; ++i) sc[(half * 128 + tt * 32 + lr) * 129 + kt * 32 + crow(i, lh)] = acc[i];
    }
  }
  __syncthreads();
  if (tid < 256) {
    float* row = sc + tid * 129;
    float gm[8]; int gi[8];
#pragma unroll
    for (int g = 0; g < 8; ++g) {
      float m = -INFINITY; int mi = g * 16;
#pragma unroll
      for (int j = 0; j < 16; ++j) { float v = row[g * 16 + j]; if (v > m) { m = v; mi = g * 16 + j; } }
      gm[g] = m; gi[g] = mi;
    }
#pragma unroll 1
    for (int r = 0; r < 16; ++r) {
      float best = gm[0]; int bg = 0; int bi = gi[0];
#pragma unroll
      for (int g = 1; g < 8; ++g) if (gm[g] > best) { best = gm[g]; bg = g; bi = gi[g]; }
      topv[tid * 16 + r] = best; topi[tid * 16 + r] = (unsigned char)bi;
      row[bi] = -INFINITY;
      float m = -INFINITY; int mi = bg * 16;
#pragma unroll
      for (int j = 0; j < 16; ++j) { float v = row[bg * 16 + j]; if (v > m) { m = v; mi = bg * 16 + j; } }
#pragma unroll
      for (int g = 0; g < 8; ++g) { gm[g] = (g == bg) ? m : gm[g]; gi[g] = (g == bg) ? mi : gi[g]; }
    }
  }
  __syncthreads();
  if (tid < 128) {
    const float* av = topv + tid * 16;
    const float* bv = topv + (128 + tid) * 16;
    const unsigned char* ai = topi + tid * 16;
    const unsigned char* bi_ = topi + (128 + tid) * 16;
    float cur[16]; int pp[16];
    const float b0 = bv[0];
#pragma unroll
    for (int i = 0; i < 16; ++i) { cur[i] = av[i] + b0; pp[i] = 0; }
    float sel[16]; int eid[16];
#pragma unroll
    for (int r = 0; r < 16; ++r) {
      float best = cur[0]; int bi = 0; int bj = pp[0];
#pragma unroll
      for (int i = 1; i < 16; ++i) if (cur[i] > best) { best = cur[i]; bi = i; bj = pp[i]; }
      sel[r] = best;
      eid[r] = (int)ai[bi] * 128 + (int)bi_[bj];
      const int nj = bj + 1;
      const float nv = (nj < 16) ? (av[bi] + bv[nj & 15]) : -INFINITY;
#pragma unroll
      for (int i = 0; i < 16; ++i) { cur[i] = (i == bi) ? nv : cur[i]; pp[i] = (i == bi) ? nj : pp[i]; }
    }
    float sum = 0.f;
    const float smax = sel[0];
#pragma unroll
    for (int r = 0; r < 16; ++r) { sel[r] = __expf(sel[r] - smax); sum += sel[r]; }
    const float inv = 1.f / sum;
    int* eo = (int*)(p.ws + OFF_EIDX) + (size_t)(tok0 + tid) * 128 + head * 16;
    float* go = (float*)(p.ws + OFF_GATE) + (size_t)(tok0 + tid) * 128 + head * 16;
#pragma unroll
    for (int r = 0; r < 16; ++r) { eo[r] = eid[r]; go[r] = sel[r] * inv; }
  }
  __syncthreads();
}

DI float dot2bf(unsigned a, unsigned b, float c) {
  return __builtin_amdgcn_fdot2_f32_bf16(__builtin_bit_cast(bf2_t, a), __builtin_bit_cast(bf2_t, b), c, false);
}

DI void phase_peer_ffn(const Params& p) {
  const char* exd = p.ws + OFF_EXD;
  const char* exu = p.ws + OFF_EXU;
  const float* esc = (const float*)(p.ws + OFF_ESC);
  const float* h = (const float*)(p.ws + OFF_H);
  const int* eidx = (const int*)(p.ws + OFF_EIDX);
  const float* gate = (const float*)(p.ws + OFF_GATE);
  const int lane = threadIdx.x & 63;
  const int gw = (blockIdx.x * blockDim.x + threadIdx.x) >> 6;
  const int nw = (gridDim.x * blockDim.x) >> 6;
  for (int tok = gw; tok < T_; tok += nw) {
    const float* xr = h + (size_t)tok * 1024 + lane * 16;
    float x[16];
#pragma unroll
    for (int c = 0; c < 4; ++c) {
      f32x4 t = *reinterpret_cast<const f32x4*>(xr + c * 4);
      x[4 * c] = t[0]; x[4 * c + 1] = t[1]; x[4 * c + 2] = t[2]; x[4 * c + 3] = t[3];
    }
    float yacc[16];
#pragma unroll
    for (int i = 0; i < 16; ++i) yacc[i] = 0.f;
    const int e_lo = eidx[(size_t)tok * 128 + lane];
    const int e_hi = eidx[(size_t)tok * 128 + 64 + lane];
    const float g_lo = gate[(size_t)tok * 128 + lane];
    const float g_hi = gate[(size_t)tok * 128 + 64 + lane];
#pragma unroll 1
    for (int eb = 0; eb < 16; ++eb) {
      const int ev = (eb < 8) ? e_lo : e_hi;
      const float gv = (eb < 8) ? g_lo : g_hi;
      const int lbase = (eb & 7) * 8;
      int er[8];
#pragma unroll
      for (int k = 0; k < 8; ++k) er[k] = __builtin_amdgcn_readlane(ev, lbase + k);
      u32x4 dr[8], ur[8];
#pragma unroll
      for (int k = 0; k < 8; ++k) dr[k] = *reinterpret_cast<const u32x4*>(exd + (size_t)er[k] * 1024 + lane * 16);
#pragma unroll
      for (int k = 0; k < 8; ++k) ur[k] = *reinterpret_cast<const u32x4*>(exu + (size_t)er[k] * 1024 + lane * 16);
      const int emine = __shfl(ev, lbase + (lane & 7));
      const float gsel = __shfl(gv, lbase + (lane & 7));
      const float sd = esc[emine];
      const float su = esc[16384 + emine];
      float part[8];
#pragma unroll
      for (int k = 0; k < 8; ++k) {
        float a0 = 0.f, a1 = 0.f;
#pragma unroll
        for (int w = 0; w < 4; ++w) {
          f2_t lo = __builtin_amdgcn_cvt_pk_f32_fp8((int)dr[k][w], false);
          f2_t hi = __builtin_amdgcn_cvt_pk_f32_fp8((int)dr[k][w], true);
          a0 = fmaf(lo[0], x[4 * w], a0); a1 = fmaf(lo[1], x[4 * w + 1], a1);
          a0 = fmaf(hi[0], x[4 * w + 2], a0); a1 = fmaf(hi[1], x[4 * w + 3], a1);
        }
        part[k] = a0 + a1;
      }
      float r4[4], r2[2], r1;
#pragma unroll
      for (int k = 0; k < 4; ++k) {
        float send = (lane & 1) ? part[2 * k] : part[2 * k + 1];
        float keep = (lane & 1) ? part[2 * k + 1] : part[2 * k];
        r4[k] = keep + __shfl_xor(send, 1);
      }
#pragma unroll
      for (int k = 0; k < 2; ++k) {
        float send = (lane & 2) ? r4[2 * k] : r4[2 * k + 1];
        float keep = (lane & 2) ? r4[2 * k + 1] : r4[2 * k];
        r2[k] = keep + __shfl_xor(send, 2);
      }
      {
        float send = (lane & 4) ? r2[0] : r2[1];
        float keep = (lane & 4) ? r2[1] : r2[0];
        r1 = keep + __shfl_xor(send, 4);
      }
      r1 += __shfl_xor(r1, 8);
      r1 += __shfl_xor(r1, 16);
      r1 += __shfl_xor(r1, 32);
      r1 *= sd;
      const float act = 0.5f * r1 * (1.f + erff(r1 * 0.70710678118654752f));
      const float coef = gsel * act * su;
#pragma unroll
      for (int k = 0; k < 8; ++k) {
        const float ck = __int_as_float(__builtin_amdgcn_readlane(__float_as_int(coef), k));
#pragma unroll
        for (int w = 0; w < 4; ++w) {
          f2_t lo = __builtin_amdgcn_cvt_pk_f32_fp8((int)ur[k][w], false);
          f2_t hi = __builtin_amdgcn_cvt_pk_f32_fp8((int)ur[k][w], true);
          yacc[4 * w] = fmaf(ck, lo[0], yacc[4 * w]);
          yacc[4 * w + 1] = fmaf(ck, lo[1], yacc[4 * w + 1]);
          yacc[4 * w + 2] = fmaf(ck, hi[0], yacc[4 * w + 2]);
          yacc[4 * w + 3] = fmaf(ck, hi[1], yacc[4 * w + 3]);
        }
      }
    }
    float v[16];
#pragma unroll
    for (int i = 0; i < 16; ++i) v[i] = ALPHA * x[i] + yacc[i];
    float s = 0.f;
#pragma unroll
    for (int i = 0; i < 16; ++i) s += v[i];
    const float mean = wave_sum(s) * (1.f / 1024.f);
    float q = 0.f;
#pragma unroll
    for (int i = 0; i < 16; ++i) { float d = v[i] - mean; q += d * d; }
    const float rstd = rsqrtf(wave_sum(q) * (1.f / 1024.f) + 1e-5f);
    float* orow = p.out + (size_t)tok * 1024 + lane * 16;
#pragma unroll
    for (int c = 0; c < 4; ++c) {
      f32x4 gg = *reinterpret_cast<const f32x4*>(p.ln_ffn_g + lane * 16 + c * 4);
      f32x4 bb = *reinterpret_cast<const f32x4*>(p.ln_ffn_b + lane * 16 + c * 4);
      f32x4 o;
#pragma unroll
      for (int k = 0; k < 4; ++k) o[k] = (v[4 * c + k] - mean) * rstd * gg[k] + bb[k];
      *reinterpret_cast<f32x4*>(orow + c * 4) = o;
    }
  }
}

constexpr size_t OFF_BAR = 166 * MiB;
DI void gbar(unsigned* ctr, unsigned target) {
  asm volatile("s_waitcnt vmcnt(0)" ::: "memory");
  __syncthreads();
  if (threadIdx.x == 0) {
    __builtin_amdgcn_fence(__ATOMIC_RELEASE, "agent");
    asm volatile("s_waitcnt vmcnt(0)" ::: "memory");
    __hip_atomic_fetch_add(ctr, 1u, __ATOMIC_RELAXED, __HIP_MEMORY_SCOPE_AGENT);
    while (__hip_atomic_load(ctr, __ATOMIC_RELAXED, __HIP_MEMORY_SCOPE_AGENT) < target) __builtin_amdgcn_s_sleep(2);
    __builtin_amdgcn_fence(__ATOMIC_ACQUIRE, "agent");
    asm volatile("s_waitcnt vmcnt(0)" ::: "memory");
  }
  __syncthreads();
}

__global__ void __launch_bounds__(512) fwd_megakernel(Params p) {
  __shared__ __attribute__((aligned(16))) char smem[155648];
  cg::grid_group grid = cg::this_grid();
  const int G = gridDim.x;
  char* ws = p.ws;
  unsigned* bar = (unsigned*)(ws + OFF_BAR);

  phase_prep(p, smem);
  grid.sync();

  phase_inproj(p, smem);
  gbar(bar, (unsigned)(1 * G));

  for (int k = 0; k * G < 1024; ++k) {
    int j = (k & 1) ? (G - 1 - (int)blockIdx.x) : (int)blockIdx.x;
    int idx = k * G + j;
    if (idx < 1024) dsa_thr_item(p, idx & 7, 127 - (idx >> 3), smem);
  }
  for (int it = blockIdx.x; it < 2048; it += G) gla_g1_item(p, it, smem);
  gbar(bar, (unsigned)(2 * G));

  for (int k = 0; k * G < 1024; ++k) {
    int j = (k & 1) ? (G - 1 - (int)blockIdx.x) : (int)blockIdx.x;
    int idx = k * G + j;
    if (idx < 1024) dsa_attn_item(p, idx & 7, 127 - (idx >> 3), smem);
  }
  gla_scan(p);
  gbar(bar, (unsigned)(3 * G));

  for (int it = blockIdx.x; it < 2048; it += G) gla_g3_item(p, it, smem);
  gbar(bar, (unsigned)(4 * G));

  phase_gemm<0>(p, (const u16*)(ws + OFF_XB), (const u16*)(ws + OFF_WOUT), 1024, p.x, (float*)(ws + OFF_H), nullptr, 0, smem);
  gbar(bar, (unsigned)(5 * G));
  phase_ln(p, (float*)(ws + OFF_H), (u16*)(ws + OFF_HB), p.ln_mix_g, p.ln_mix_b);
  gbar(bar, (unsigned)(6 * G));

  phase_gemm<1>(p, (const u16*)(ws + OFF_HB), (const u16*)(ws + OFF_WQ), 1024, nullptr, nullptr, (u16*)(ws + OFF_QX), 1024, smem);
  gbar(bar, (unsigned)(7 * G));
  phase_xattn(p);
  gbar(bar, (unsigned)(8 * G));
  phase_gemm<0>(p, (const u16*)(ws + OFF_OX), (const u16*)(ws + OFF_WO), 1024, (const float*)(ws + OFF_H), (float*)(ws + OFF_H), nullptr, 0, smem);
  gbar(bar, (unsigned)(9 * G));
  phase_ln(p, (float*)(ws + OFF_H), (u16*)(ws + OFF_HB), p.ln_mem_g, p.ln_mem_b);
  gbar(bar, (unsigned)(10 * G));

  phase_gemm<1>(p, (const u16*)(ws + OFF_HB), (const u16*)(ws + OFF_WPQ), 2048, nullptr, nullptr, (u16*)(ws + OFF_QX), 2048, smem);
  gbar(bar, (unsigned)(11 * G));
  for (int it = blockIdx.x; it < 2048; it += G) peer_topk_item(p, it >> 3, it & 7, smem);
  gbar(bar, (unsigned)(12 * G));
  phase_peer_ffn(p);
}

extern "C" void kernel_launch(void* const* d_in, const int* in_sizes, int n_in,
                              void* d_out, int out_size, void* d_ws, size_t ws_size,
                              hipStream_t stream) {
  static int grid_blocks = 0;
  if (!grid_blocks) {
    int dev = 0, cus = 0, per_cu = 0;
    (void)hipGetDevice(&dev);
    (void)hipDeviceGetAttribute(&cus, hipDeviceAttributeMultiprocessorCount, dev);
    (void)hipOccupancyMaxActiveBlocksPerMultiprocessor(&per_cu, fwd_megakernel, 512, 0);
    if (per_cu > 1) per_cu = 1;
    grid_blocks = cus * per_cu;
    if (grid_blocks > 256) grid_blocks = 256;
    if (ws_size < 512 * MiB) fprintf(stderr, "workspace too small: %zu\n", ws_size);
  }
  Params p{};
  p.x = (const float*)d_in[0]; p.positions = (const int*)d_in[1]; p.mem = (const float*)d_in[2]; p.w_in = (const float*)d_in[3];
  p.gate_up = (const float*)d_in[4]; p.gate_bias = (const float*)d_in[5]; p.norm_g = (const float*)d_in[6]; p.w_out = (const float*)d_in[7];
  p.ln_mix_g = (const float*)d_in[8]; p.ln_mix_b = (const float*)d_in[9];
  p.wq = (const float*)d_in[10]; p.wk = (const float*)d_in[11]; p.wv = (const float*)d_in[12]; p.wo = (const float*)d_in[13];
  p.ln_mem_g = (const float*)d_in[14]; p.ln_mem_b = (const float*)d_in[15];
  p.w_pq = (const float*)d_in[16]; p.sk1 = (const float*)d_in[17]; p.sk2 = (const float*)d_in[18];
  p.ex_down = (const float*)d_in[19]; p.ex_up = (const float*)d_in[20];
  p.ln_ffn_g = (const float*)d_in[21]; p.ln_ffn_b = (const float*)d_in[22];
  p.out = (float*)d_out; p.ws = (char*)d_ws;
  (void)hipMemsetAsync((char*)d_ws + OFF_BAR, 0, 256, stream);
  void* args[] = {&p};
  hipError_t e = hipLaunchCooperativeKernel((void*)fwd_megakernel, dim3(grid_blocks), dim3(512), args, 0, stream);
  if (e != hipSuccess) fprintf(stderr, "cooperative launch failed: %s (grid %d)\n", hipGetErrorString(e), grid_blocks);
}
```

```cpp
#include <hip/hip_runtime.h>
#include <hip/hip_cooperative_groups.h>
#include <cstdio>
#include <cmath>
namespace cg = cooperative_groups;

#define DI __device__ __forceinline__
typedef short bf16x8 __attribute__((ext_vector_type(8)));
typedef short bf16x4 __attribute__((ext_vector_type(4)));
typedef float f32x16 __attribute__((ext_vector_type(16)));
typedef float f32x4 __attribute__((ext_vector_type(4)));
typedef unsigned u32x4 __attribute__((ext_vector_type(4)));
typedef unsigned u32x2 __attribute__((ext_vector_type(2)));
typedef unsigned short u16;
typedef __bf16 bf2_t __attribute__((ext_vector_type(2)));
typedef float f2_t __attribute__((ext_vector_type(2)));

#define MFMA(a, b, c) __builtin_amdgcn_mfma_f32_32x32x16_bf16((a), (b), (c), 0, 0, 0)

constexpr int T_ = 32768;
constexpr int S_ = 4096;
constexpr int TMW = 2368;
constexpr int TM_Q = 0, TM_K = 512, TM_QI = 1024, TM_KI = 1280, TM_WI = 1312, TM_GLR = 1320, TM_GQ = 1344, TM_GK = 1600, TM_GR = 1856;
constexpr int PROJ_N = 3456;
constexpr float ALPHA = 1.189207115002721f;
constexpr size_t MiB = 1024 * 1024;

constexpr size_t OFF_XB = 0;
constexpr size_t OFF_EXD = 64 * MiB;
constexpr size_t OFF_EXU = 96 * MiB;
constexpr size_t OFF_WIN = 128 * MiB;
constexpr size_t OFF_WOUT = OFF_WIN + (size_t)PROJ_N * 1024 * 2;
constexpr size_t OFF_WQ = OFF_WOUT + 2 * MiB;
constexpr size_t OFF_WK = OFF_WQ + 2 * MiB;
constexpr size_t OFF_WV = OFF_WK + 2 * MiB;
constexpr size_t OFF_WO = OFF_WV + 2 * MiB;
constexpr size_t OFF_WPQ = OFF_WO + 2 * MiB;
constexpr size_t OFF_MEMB = 152 * MiB;
constexpr size_t OFF_MEMK = 156 * MiB;
constexpr size_t OFF_MEMVT = 160 * MiB;
constexpr size_t OFF_THR = 164 * MiB;
constexpr size_t OFF_SK = OFF_THR + 256 * 1024;
constexpr size_t OFF_DECAY = OFF_SK + 128 * 1024;
constexpr size_t OFF_ESC = 165 * MiB;
constexpr size_t OFF_TM = 168 * MiB;
constexpr size_t OFF_VT = 316 * MiB;
constexpr size_t OFF_KFR = 476 * MiB;
constexpr size_t OFF_GVT = 348 * MiB;
constexpr size_t OFF_KVT = 380 * MiB;
constexpr size_t OFF_PREV = 444 * MiB;
constexpr size_t OFF_H = 168 * MiB;
constexpr size_t OFF_HB = 296 * MiB;
constexpr size_t OFF_QX = 360 * MiB;
constexpr size_t OFF_OX = 424 * MiB;
constexpr size_t OFF_EIDX = 0;
constexpr size_t OFF_GATE = 16 * MiB;

struct Params {
  const float* x; const int* positions; const float* mem; const float* w_in;
  const float* gate_up; const float* gate_bias; const float* norm_g; const float* w_out;
  const float* ln_mix_g; const float* ln_mix_b;
  const float* wq; const float* wk; const float* wv; const float* wo;
  const float* ln_mem_g; const float* ln_mem_b;
  const float* w_pq; const float* sk1; const float* sk2; const float* ex_down; const float* ex_up;
  const float* ln_ffn_g; const float* ln_ffn_b;
  float* out; char* ws;
};

DI unsigned pk_bf16(float a, float b) {
  f2_t v = {a, b};
  bf2_t r = __builtin_convertvector(v, bf2_t);
  return __builtin_bit_cast(unsigned, r);
}
DI u16 f2bf(float a) { return (u16)(pk_bf16(a, 0.f) & 0xffffu); }
DI float bf2f(u16 u) { return __uint_as_float(((unsigned)u) << 16); }
DI float bflo(unsigned u) { return __uint_as_float(u << 16); }
DI float bfhi(unsigned u) { return __uint_as_float(u & 0xffff0000u); }
DI int crow(int i, int h) { return (i & 3) + 8 * (i >> 2) + 4 * h; }
DI bf16x8 ldg8(const u16* p) { return *reinterpret_cast<const bf16x8*>(p); }
DI bf16x8 pack8(float a0, float a1, float a2, float a3, float a4, float a5, float a6, float a7) {
  u32x4 r; r[0] = pk_bf16(a0, a1); r[1] = pk_bf16(a2, a3); r[2] = pk_bf16(a4, a5); r[3] = pk_bf16(a6, a7);
  return __builtin_bit_cast(bf16x8, r);
}
DI bf16x8 cat44(bf16x4 lo, bf16x4 hi) { return __builtin_shufflevector(lo, hi, 0, 1, 2, 3, 4, 5, 6, 7); }
DI void st4bf(u16* p, float a, float b, float c, float d) {
  u32x2 v; v[0] = pk_bf16(a, b); v[1] = pk_bf16(c, d);
  *reinterpret_cast<u32x2*>(p) = v;
}
DI float wave_sum(float v) {
#pragma unroll
  for (int d = 32; d >= 1; d >>= 1) v += __shfl_xor(v, d);
  return v;
}
DI void sincos_rad(float ang, float& s, float& c) {
  constexpr float C_hi = (float)0.15915494309189535;
  constexpr float C_lo = (float)(0.15915494309189535 - (double)C_hi);
  float k = rintf(ang * C_hi);
  float f = fmaf(ang, C_hi, -k);
  f = fmaf(ang, C_lo, f);
  s = __builtin_amdgcn_sinf(f);
  c = __builtin_amdgcn_cosf(f);
}
DI unsigned fkey(float s) {
  unsigned u = __float_as_uint(s + 0.0f);
  return (u & 0x80000000u) ? ~u : (u | 0x80000000u);
}
DI f32x16 zero16() { f32x16 z; for (int i = 0; i < 16; ++i) z[i] = 0.f; return z; }

DI int win_src_col(int n) {
  if (n < 1832) return n;
  if (n < 1848) return 2856 + (n - 1832);
  if (n < 1856) return -1;
  if (n < 2880) return n - 24;
  if (n < 3392) return n - 8;
  return -1;
}

DI void cvt_stream(const float* __restrict__ src, u16* __restrict__ dst, size_t n, size_t gtid, size_t gn) {
  size_t n8 = n / 8;
  for (size_t i = gtid; i < n8; i += gn) {
    f32x4 a = *reinterpret_cast<const f32x4*>(src + i * 8);
    f32x4 b = *reinterpret_cast<const f32x4*>(src + i * 8 + 4);
    u32x4 r; r[0] = pk_bf16(a[0], a[1]); r[1] = pk_bf16(a[2], a[3]); r[2] = pk_bf16(b[0], b[1]); r[3] = pk_bf16(b[2], b[3]);
    *reinterpret_cast<u32x4*>(dst + i * 8) = r;
  }
}

template <bool MAPPED>
DI void transpose_tile(const float* __restrict__ W, int ldn, u16* __restrict__ Wt, int k0, int n0, float* tile) {
  const int tid = threadIdx.x;
  {
    int nn = n0 + (tid & 63);
    int c = MAPPED ? win_src_col(nn) : nn;
#pragma unroll
    for (int rr = 0; rr < 8; ++rr) {
      int kk = (tid >> 6) + 8 * rr;
      float v = (c >= 0) ? W[(size_t)(k0 + kk) * ldn + c] : 0.f;
      tile[kk * 65 + (tid & 63)] = v;
    }
  }
  __syncthreads();
#pragma unroll
  for (int rr = 0; rr < 8; ++rr) {
    int nn = (tid >> 6) + 8 * rr;
    int kk = tid & 63;
    Wt[(size_t)(n0 + nn) * 1024 + k0 + kk] = f2bf(tile[kk * 65 + nn]);
  }
  __syncthreads();
}

DI void phase_prep(const Params& p, char* smem) {
  const size_t gtid = (size_t)blockIdx.x * blockDim.x + threadIdx.x;
  const size_t gn = (size_t)gridDim.x * blockDim.x;
  char* ws = p.ws;
  cvt_stream(p.x, (u16*)(ws + OFF_XB), (size_t)T_ * 1024, gtid, gn);
  cvt_stream(p.mem, (u16*)(ws + OFF_MEMB), (size_t)2048 * 1024, gtid, gn);
  {
    const int lane = threadIdx.x & 63;
    const int gw = (int)(gtid >> 6), nw = (int)(gn >> 6);
    for (int r = gw; r < 2 * 16384; r += nw) {
      const int tbl = r >> 14, row = r & 16383;
      const float* src = (tbl ? p.ex_up : p.ex_down) + (size_t)row * 1024 + lane * 16;
      f32x4 v[4]; float mx = 0.f;
#pragma unroll
      for (int c = 0; c < 4; ++c) {
        v[c] = *reinterpret_cast<const f32x4*>(src + c * 4);
#pragma unroll
        for (int k = 0; k < 4; ++k) mx = fmaxf(mx, fabsf(v[c][k]));
      }
#pragma unroll
      for (int d = 32; d >= 1; d >>= 1) mx = fmaxf(mx, __shfl_xor(mx, d));
      float sc = (mx > 0.f) ? exp2f(floorf(log2f(224.f / mx))) : 1.f;
      u32x4 o;
#pragma unroll
      for (int c = 0; c < 4; ++c) {
        int t = __builtin_amdgcn_cvt_pk_fp8_f32(v[c][0] * sc, v[c][1] * sc, 0, false);
        t = __builtin_amdgcn_cvt_pk_fp8_f32(v[c][2] * sc, v[c][3] * sc, t, true);
        o[c] = (unsigned)t;
      }
      *reinterpret_cast<u32x4*>(ws + (tbl ? OFF_EXU : OFF_EXD) + (size_t)row * 1024 + lane * 16) = o;
      if (lane == 0) ((float*)(ws + OFF_ESC))[r] = 1.f / sc;
    }
  }
  cvt_stream(p.sk1, (u16*)(ws + OFF_SK), (size_t)128 * 128, gtid, gn);
  cvt_stream(p.sk2, (u16*)(ws + OFF_SK) + 128 * 128, (size_t)128 * 128, gtid, gn);
  float* tile = (float*)smem;
  const int n_win = 54 * 16, n_sq = 256, n_pq = 512;
  const int total = n_win + 5 * n_sq + n_pq;
  for (int t = blockIdx.x; t < total; t += gridDim.x) {
    if (t < n_win) {
      transpose_tile<true>(p.w_in, 3384, (u16*)(ws + OFF_WIN), (t & 15) * 64, (t >> 4) * 64, tile);
    } else if (t < n_win + 5 * n_sq) {
      int u = t - n_win; int which = u >> 8; int r = u & 255;
      const float* W = which == 0 ? p.w_out : which == 1 ? p.wq : which == 2 ? p.wk : which == 3 ? p.wv : p.wo;
      size_t off = which == 0 ? OFF_WOUT : which == 1 ? OFF_WQ : which == 2 ? OFF_WK : which == 3 ? OFF_WV : OFF_WO;
      transpose_tile<false>(W, 1024, (u16*)(ws + off), (r & 15) * 64, (r >> 4) * 64, tile);
    } else {
      int r = t - n_win - 5 * n_sq;
      transpose_tile<false>(p.w_pq, 2048, (u16*)(ws + OFF_WPQ), (r & 15) * 64, (r >> 4) * 64, tile);
    }
  }
}

#define WAIT_V(n) asm volatile("s_waitcnt vmcnt(%0)" ::"n"(n) : "memory")
#define RAW_BARRIER() do { asm volatile("s_waitcnt lgkmcnt(0)" ::: "memory"); __builtin_amdgcn_s_barrier(); asm volatile("" ::: "memory"); } while (0)
constexpr int G_STAGE = 384 * 128;
DI void gemm_tile(const u16* __restrict__ X, int ldx, const u16* __restrict__ Wt, int ldw, int K, char* smem,
                  f32x16 (&acc)[2][2]) {
  const int tid = threadIdx.x, lane = tid & 63, wave = tid >> 6;
  const int fw = wave & 1, tq = wave >> 1, lr = lane & 31, lh = lane >> 5;
#pragma unroll
  for (int a = 0; a < 2; ++a)
#pragma unroll
    for (int b = 0; b < 2; ++b) acc[a][b] = zero16();
  const int nk = K / 64;
  const u16* src[6];
#pragma unroll
  for (int i = 0; i < 6; ++i) {
    const int R = 8 * (wave + 8 * i) + (lane >> 3);
    const int c = (lane & 7) ^ ((R >> 1) & 7);
    src[i] = (i < 4) ? (X + (size_t)R * ldx + c * 8) : (Wt + (size_t)(R - 256) * ldw + c * 8);
  }
#define GLDS_STAGE(slot, kt) do { _Pragma("unroll") for (int i = 0; i < 6; ++i) \
    __builtin_amdgcn_global_load_lds((const unsigned*)(src[i] + (kt) * 64), (__attribute__((address_space(3))) unsigned*)(smem + (slot) * G_STAGE + (wave + 8 * i) * 1024), 16, 0, 0); } while (0)
  int offA[2], offB[2], xa[2], xb[2];
#pragma unroll
  for (int ft = 0; ft < 2; ++ft) { const int R = 256 + fw * 64 + ft * 32 + lr; offA[ft] = R * 128; xa[ft] = (R >> 1) & 7; }
#pragma unroll
  for (int tt = 0; tt < 2; ++tt) { const int R = tq * 64 + tt * 32 + lr; offB[tt] = R * 128; xb[tt] = (R >> 1) & 7; }
  GLDS_STAGE(0, 0); GLDS_STAGE(1, 1); WAIT_V(6); RAW_BARRIER();
  int cur = 0;
  for (int kt = 0; kt < nk; ++kt) {
    const int nxt = (cur >= 1) ? cur - 1 : 2;
    if (kt + 2 < nk) GLDS_STAGE(nxt, kt + 2);
    __builtin_amdgcn_sched_barrier(0);
    const char* st = smem + cur * G_STAGE;
#pragma unroll
    for (int ks = 0; ks < 4; ++ks) {
      bf16x8 a[2], b[2];
#pragma unroll
      for (int ft = 0; ft < 2; ++ft) a[ft] = *reinterpret_cast<const bf16x8*>(st + offA[ft] + (((ks * 2 + lh) ^ xa[ft]) << 4));
#pragma unroll
      for (int tt = 0; tt < 2; ++tt) b[tt] = *reinterpret_cast<const bf16x8*>(st + offB[tt] + (((ks * 2 + lh) ^ xb[tt]) << 4));
#pragma unroll
      for (int ft = 0; ft < 2; ++ft)
#pragma unroll
        for (int tt = 0; tt < 2; ++tt) acc[ft][tt] = MFMA(a[ft], b[tt], acc[ft][tt]);
    }
    if (kt + 2 < nk) { WAIT_V(6); } else { WAIT_V(0); }
    RAW_BARRIER();
    cur = (cur == 2) ? 0 : cur + 1;
  }
#undef GLDS_STAGE
}

DI void epi_inproj(const Params& p, int tok0, int f0, f32x16 (&acc)[2][2]) {
  const int tid = threadIdx.x, lane = tid & 63, wave = tid >> 6;
  const int fw = wave & 1, tq = wave >> 1, lr = lane & 31, lh = lane >> 5;
  const int fbase = f0 + fw * 64;
  if (fbase >= 3392) return;
  u16* tm = (u16*)(p.ws + OFF_TM);
#pragma unroll
  for (int tt = 0; tt < 2; ++tt) {
    const int tok = tok0 + tq * 64 + tt * 32 + lr;
    const float posf = (float)p.positions[tok];
    const int bb = tok >> 12, ss = tok & 4095;
    if (fbase < 1024) {
#pragma unroll
      for (int r = 0; r < 4; ++r) {
        float j = (float)(4 * lh + r);
        float inv = exp2f(-j * (18.931568569324174f / 8.0f));
        float sn, cs; sincos_rad(posf * inv, sn, cs);
        float x1 = acc[0][tt][r], x2 = acc[0][tt][r + 4];
        acc[0][tt][r] = x1 * cs - x2 * sn;
        acc[0][tt][r + 4] = x2 * cs + x1 * sn;
      }
      if (fbase < 512) {
#pragma unroll
        for (int ft = 0; ft < 2; ++ft)
#pragma unroll
          for (int g = 0; g < 4; ++g)
            st4bf(tm + (size_t)tok * TMW + fbase + ft * 32 + 8 * g + 4 * lh, acc[ft][tt][4 * g], acc[ft][tt][4 * g + 1], acc[ft][tt][4 * g + 2], acc[ft][tt][4 * g + 3]);
      } else {
        u16* kfr = (u16*)(p.ws + OFF_KFR);
        const int head = (fbase - 512) >> 6, gt = ss >> 5;
#pragma unroll
        for (int ft = 0; ft < 2; ++ft)
#pragma unroll
          for (int g = 0; g < 4; ++g) {
            const int ks = ft * 2 + (g >> 1), lane2 = (g & 1) * 32 + lr;
            st4bf(kfr + ((((size_t)(bb * 8 + head) * 128 + gt) * 4 + ks) * 64 + lane2) * 8 + 4 * lh, acc[ft][tt][4 * g], acc[ft][tt][4 * g + 1], acc[ft][tt][4 * g + 2], acc[ft][tt][4 * g + 3]);
          }
      }
    } else if (fbase < 1536) {
      u16* vfr = (u16*)(p.ws + OFF_VT);
      const int head = (fbase - 1024) >> 6, gt = ss >> 5;
      const int s = lr >> 4, r16 = lr & 15, j = 4 * (r16 >> 3) + (r16 & 3), lh2 = (r16 >> 2) & 1;
#pragma unroll
      for (int ft = 0; ft < 2; ++ft)
#pragma unroll
        for (int i = 0; i < 16; ++i) {
          const int lane2 = lh2 * 32 + crow(i, lh);
          vfr[((((((size_t)(bb * 8 + head) * 128 + gt) * 2 + ft) * 2 + s) * 64 + lane2) * 8) + j] = f2bf(acc[ft][tt][i]);
        }
    } else if (fbase >= 2368 && fbase < 2880) {
      u16* vt = (u16*)(p.ws + OFF_GVT);
      const int fo = fbase - 2368;
#pragma unroll
      for (int ft = 0; ft < 2; ++ft)
#pragma unroll
        for (int i = 0; i < 16; ++i) {
          int feat = fo + ft * 32 + crow(i, lh);
          vt[((size_t)bb * 512 + feat) * 4096 + ss] = f2bf(acc[ft][tt][i]);
        }
    } else {
      int colbase;
      if (fbase < 1856) {
#pragma unroll
        for (int ft = 0; ft < 2; ++ft) {
          const bool rot = (fbase < 1792) || (ft == 0);
#pragma unroll
          for (int r = 0; r < 4; ++r) {
            float v = acc[ft][tt][r];
            float o = __shfl_xor(v, 32);
            float inv = exp2f(-(float)r * (18.931568569324174f / 4.0f));
            float sn, cs; sincos_rad(posf * inv, sn, cs);
            float res = (lh == 0) ? (v * cs - o * sn) : (v * cs + o * sn);
            acc[ft][tt][r] = rot ? res : v;
          }
        }
        colbase = fbase - 512;
      } else if (fbase < 2368) {
        colbase = fbase - 512;
      } else {
        colbase = fbase - 1024;
      }
#pragma unroll
      for (int ft = 0; ft < 2; ++ft)
#pragma unroll
        for (int g = 0; g < 4; ++g)
          st4bf(tm + (size_t)tok * TMW + colbase + ft * 32 + 8 * g + 4 * lh, acc[ft][tt][4 * g], acc[ft][tt][4 * g + 1], acc[ft][tt][4 * g + 2], acc[ft][tt][4 * g + 3]);
    }
  }
}

DI void phase_inproj(const Params& p, char* smem) {
  const int n_in = 128 * 27;
  const int total = n_in + 128;
  const u16* xb = (const u16*)(p.ws + OFF_XB);
  const u16* memb = (const u16*)(p.ws + OFF_MEMB);
  const int tid = threadIdx.x, lane = tid & 63, wave = tid >> 6;
  const int fw = wave & 1, tq = wave >> 1, lr = lane & 31, lh = lane >> 5;
  for (int t = blockIdx.x; t < total; t += gridDim.x) {
    f32x16 acc[2][2];
    if (t < n_in) {
      int mt = t / 27, nt = t % 27;
      gemm_tile(xb + (size_t)mt * 256 * 1024, 1024, (const u16*)(p.ws + OFF_WIN) + (size_t)nt * 128 * 1024, 1024, 1024, smem, acc);
      epi_inproj(p, mt * 256, nt * 128, acc);
    } else {
      int u = t - n_in; int which = u >> 6; int r = u & 63; int mt = r >> 3, nt = r & 7;
      const u16* W = (const u16*)(p.ws + (which == 0 ? OFF_WK : OFF_WV));
      gemm_tile(memb + (size_t)mt * 256 * 1024, 1024, W + (size_t)nt * 128 * 1024, 1024, 1024, smem, acc);
#pragma unroll
      for (int tt = 0; tt < 2; ++tt) {
        const int tok = mt * 256 + tq * 64 + tt * 32 + lr;
        const int bb = tok >> 8, mm = tok & 255, hh = nt >> 1, kt = mm >> 5;
        if (which == 0) {
          u16* mk = (u16*)(p.ws + OFF_MEMK);
#pragma unroll
          for (int ft = 0; ft < 2; ++ft)
#pragma unroll
            for (int g = 0; g < 4; ++g) {
              const int ks = (nt & 1) * 8 + fw * 4 + ft * 2 + (g >> 1), lane2 = (g & 1) * 32 + lr;
              st4bf(mk + ((((size_t)(bb * 4 + hh) * 8 + kt) * 16 + ks) * 64 + lane2) * 8 + 4 * lh, acc[ft][tt][4 * g], acc[ft][tt][4 * g + 1], acc[ft][tt][4 * g + 2], acc[ft][tt][4 * g + 3]);
            }
        } else {
          u16* mv = (u16*)(p.ws + OFF_MEMVT);
          const int s = lr >> 4, r16 = lr & 15, j = 4 * (r16 >> 3) + (r16 & 3), lh2 = (r16 >> 2) & 1;
#pragma unroll
          for (int ft = 0; ft < 2; ++ft) {
            const int dt = (nt & 1) * 4 + fw * 2 + ft;
#pragma unroll
            for (int i = 0; i < 16; ++i) {
              const int lane2 = lh2 * 32 + crow(i, lh);
              mv[((((((size_t)(bb * 4 + hh) * 8 + dt) * 8 + kt) * 2 + s) * 64 + lane2) * 8) + j] = f2bf(acc[ft][tt][i]);
            }
          }
        }
      }
    }
  }
}

DI void idx_scores(const bf16x8 (&qf)[8][2], const float (&wq)[8], bf16x8 k0, bf16x8 k1, float (&sc)[16]) {
#pragma unroll
  for (int i = 0; i < 16; ++i) sc[i] = 0.f;
#pragma unroll
  for (int hd = 0; hd < 8; ++hd) {
    f32x16 a = zero16();
    a = MFMA(k0, qf[hd][0], a);
    a = MFMA(k1, qf[hd][1], a);
#pragma unroll
    for (int i = 0; i < 16; ++i) sc[i] = fmaf(wq[hd], fmaxf(a[i], 0.f), sc[i]);
  }
}

DI void load_idx_q(const u16* tm, int tok, int lh, bf16x8 (&qf)[8][2], float (&wq)[8]) {
  const u16* row = tm + (size_t)tok * TMW;
#pragma unroll
  for (int hd = 0; hd < 8; ++hd)
#pragma unroll
    for (int ks = 0; ks < 2; ++ks) qf[hd][ks] = ldg8(row + TM_QI + hd * 32 + ks * 16 + lh * 8);
  bf16x8 w8 = ldg8(row + TM_WI);
#pragma unroll
  for (int hd = 0; hd < 8; ++hd) wq[hd] = bf2f((u16)w8[hd]) * 0.0625f;
}

DI int wave_incl_scan(int v, int lane) {
#pragma unroll
  for (int d = 1; d < 64; d <<= 1) {
    int t = __shfl_up(v, d);
    if (lane >= d) v += t;
  }
  return v;
}

DI void dsa_thr_item(const Params& p, int b, int qblk, char* smem) {
  unsigned* hist = (unsigned*)smem;
  unsigned* pref = (unsigned*)(smem + 32768);
  int* rank = (int*)(smem + 32768 + 128);
  const u16* tm = (const u16*)(p.ws + OFF_TM);
  const int tid = threadIdx.x, lane = tid & 63, wave = tid >> 6, lr = lane & 31, lh = lane >> 5;
  const int q0 = qblk * 32;
  u16* qi = (u16*)(smem + 33280);
  for (int i = tid; i < 32 * 32; i += 512) {
    int q = i >> 5, ch = i & 31;
    *reinterpret_cast<u32x4*>(qi + q * 264 + ch * 8) = *reinterpret_cast<const u32x4*>(tm + (size_t)(b * S_ + q0 + q) * TMW + TM_QI + ch * 8);
  }
  float wq[8];
  {
    bf16x8 w8 = ldg8(tm + (size_t)(b * S_ + q0 + lr) * TMW + TM_WI);
#pragma unroll
    for (int hd = 0; hd < 8; ++hd) wq[hd] = bf2f((u16)w8[hd]) * 0.0625f;
  }
  const u16* qil = qi + lr * 264 + lh * 8;
  if (tid < 32) { pref[tid] = 0u; rank[tid] = min(256, q0 + tid + 1); }
  for (int pass = 0; pass < 4; ++pass) {
    for (int i = tid; i < 8192; i += 512) hist[i] = 0u;
    __syncthreads();
    const int shift = 24 - 8 * pass;
    const unsigned mypref = pref[lr];
    for (int kt = wave; kt <= qblk; kt += 8) {
      const u16* krow = tm + (size_t)(b * S_ + kt * 32 + lr) * TMW + TM_KI + lh * 8;
      bf16x8 k0 = ldg8(krow), k1 = ldg8(krow + 16);
      float sc[16];
#pragma unroll
      for (int i = 0; i < 16; ++i) sc[i] = 0.f;
#pragma unroll
      for (int hd = 0; hd < 8; ++hd) {
        f32x16 a = zero16();
        a = MFMA(k0, *reinterpret_cast<const bf16x8*>(qil + hd * 32), a);
        a = MFMA(k1, *reinterpret_cast<const bf16x8*>(qil + hd * 32 + 16), a);
#pragma unroll
        for (int i = 0; i < 16; ++i) sc[i] = fmaf(wq[hd], fmaxf(a[i], 0.f), sc[i]);
      }
#pragma unroll
      for (int i = 0; i < 16; ++i) {
        int kp = kt * 32 + crow(i, lh);
        unsigned ky = fkey(sc[i]);
        unsigned hi = (ky >> shift);
        if (kp <= q0 + lr && (hi >> 8) == mypref) atomicAdd(&hist[(hi & 255u) * 32 + lr], 1u);
      }
    }
    __syncthreads();
#pragma unroll 1
    for (int qq = 0; qq < 4; ++qq) {
      const int q = wave * 4 + qq;
      const int rk = rank[q];
      int c[4];
#pragma unroll
      for (int j = 0; j < 4; ++j) c[j] = (int)hist[(255 - 4 * lane - j) * 32 + q];
      int s = c[0] + c[1] + c[2] + c[3];
      int P = wave_incl_scan(s, lane);
      int excl = P - s;
      if (P >= rk && excl < rk) {
        int cum = excl; int bin = 0; int nr = 1; bool found = false;
#pragma unroll
        for (int j = 0; j < 4; ++j) {
          if (!found && cum + c[j] >= rk) { bin = 255 - 4 * lane - j; nr = rk - cum; found = true; }
          if (!found) cum += c[j];
        }
        pref[q] = (pref[q] << 8) | (unsigned)bin;
        rank[q] = nr;
      }
    }
    __syncthreads();
  }
  if (tid < 32) ((unsigned*)(p.ws + OFF_THR))[b * S_ + q0 + tid] = pref[tid];
  __syncthreads();
}

DI void dsa_attn_item(const Params& p, int b, int qblk, char* smem) {
  u16* maskbuf = (u16*)smem;
  u16* qi = (u16*)(smem + 4096);
  const u16* tm = (const u16*)(p.ws + OFF_TM);
  const u16* vfr = (const u16*)(p.ws + OFF_VT) + ((size_t)(b * 8 + (threadIdx.x >> 6)) * 128) * 2048 + (threadIdx.x & 63) * 8;
  const u16* kfr = (const u16*)(p.ws + OFF_KFR) + ((size_t)(b * 8 + (threadIdx.x >> 6)) * 128) * 2048 + (threadIdx.x & 63) * 8;
  const unsigned* thr = (const unsigned*)(p.ws + OFF_THR);
  const int tid = threadIdx.x, lane = tid & 63, wave = tid >> 6, lr = lane & 31, lh = lane >> 5;
  const int q0 = qblk * 32;
  const int head = wave;
  const int qtok = b * S_ + q0 + lr;
  bf16x8 Qf[4];
#pragma unroll
  for (int ks = 0; ks < 4; ++ks) {
    bf16x8 raw = ldg8(tm + (size_t)qtok * TMW + TM_Q + head * 64 + ks * 16 + lh * 8);
    float f[8];
#pragma unroll
    for (int j = 0; j < 8; ++j) f[j] = bf2f((u16)raw[j]) * 0.125f;
    Qf[ks] = pack8(f[0], f[1], f[2], f[3], f[4], f[5], f[6], f[7]);
  }
  f32x16 O[2];
  O[0] = zero16(); O[1] = zero16();
  float mrun = -INFINITY, lrun = 0.f;
  const unsigned thrq = thr[qtok];
  const int nchunks = (q0 + 31) / 256 + 1;
  for (int i = tid; i < 32 * 32; i += 512) {
    int q = i >> 5, ch = i & 31;
    *reinterpret_cast<u32x4*>(qi + q * 264 + ch * 8) = *reinterpret_cast<const u32x4*>(tm + (size_t)(b * S_ + q0 + q) * TMW + TM_QI + ch * 8);
  }
  float* wqs = (float*)(smem + 4096 + 32 * 264 * 2);
  if (tid < 256) wqs[tid] = bf2f(tm[(size_t)(b * S_ + q0 + (tid & 31)) * TMW + TM_WI + (tid >> 5)]) * 0.0625f;
  __syncthreads();
  const u16* qil = qi + lr * 264 + lh * 8;
  const u16* kibase = tm + (size_t)(b * S_ + lr) * TMW + TM_KI + lh * 8;
  bf16x8 Kf[4], Kn[4];
#pragma unroll
  for (int ks = 0; ks < 4; ++ks) Kf[ks] = ldg8(kfr + ks * 512);
  bf16x8 ki0, ki1;
  {
    const int kt0 = min(wave, qblk);
    ki0 = ldg8(kibase + (size_t)(kt0 * 32) * TMW); ki1 = ldg8(kibase + (size_t)(kt0 * 32) * TMW + 16);
  }
  for (int c = 0; c < nchunks; ++c) {
    const int buf = c & 1;
    {
      const int key0 = (c * 8 + wave) * 32;
      unsigned bits = 0u;
      const bf16x8 k0 = ki0, k1 = ki1;
      {
        const int ktn = min((c + 1) * 8 + wave, qblk);
        ki0 = ldg8(kibase + (size_t)(ktn * 32) * TMW); ki1 = ldg8(kibase + (size_t)(ktn * 32) * TMW + 16);
      }
      if (key0 <= q0 + 31) {
        float sc[16];
#pragma unroll
        for (int i = 0; i < 16; ++i) sc[i] = 0.f;
#pragma unroll 2
        for (int hd = 0; hd < 8; ++hd) {
          f32x16 a = zero16();
          a = MFMA(k0, *reinterpret_cast<const bf16x8*>(qil + hd * 32), a);
          a = MFMA(k1, *reinterpret_cast<const bf16x8*>(qil + hd * 32 + 16), a);
          const float wh = wqs[hd * 32 + lr];
#pragma unroll
          for (int i = 0; i < 16; ++i) sc[i] = fmaf(wh, fmaxf(a[i], 0.f), sc[i]);
        }
        __builtin_amdgcn_sched_barrier(0);
#pragma unroll
        for (int i = 0; i < 16; ++i) {
          int kp = key0 + crow(i, lh);
          if (kp <= q0 + lr && fkey(sc[i]) >= thrq) bits |= (1u << i);
        }
      }
      maskbuf[(buf * 8 + wave) * 64 + lane] = (u16)bits;
    }
    __syncthreads();
#pragma unroll 1
    for (int t8 = 0; t8 < 8; ++t8) {
      const int g = c * 8 + t8;
      if (g > qblk) break;
      {
        const int gn = min(g + 1, qblk);
        const u16* kr = kfr + (size_t)gn * 2048;
#pragma unroll
        for (int ks = 0; ks < 4; ++ks) Kn[ks] = ldg8(kr + ks * 512);
      }
      bf16x8 Vf[2][2];
#pragma unroll
      for (int dt = 0; dt < 2; ++dt)
#pragma unroll
        for (int s = 0; s < 2; ++s) Vf[dt][s] = ldg8(vfr + (size_t)g * 2048 + (dt * 2 + s) * 512);
      const unsigned bits = maskbuf[(buf * 8 + t8) * 64 + lane];
      f32x16 Sx = zero16();
#pragma unroll
      for (int ks = 0; ks < 4; ++ks) Sx = MFMA(Kf[ks], Qf[ks], Sx);
      float mt = -INFINITY;
#pragma unroll
      for (int i = 0; i < 16; ++i) mt = ((bits >> i) & 1u) ? fmaxf(mt, Sx[i]) : mt;
      mt = fmaxf(mt, __shfl_xor(mt, 32));
      const float mnew = fmaxf(mrun, mt);
      const float msafe = (mnew == -INFINITY) ? 0.f : mnew;
      const float alpha = __expf(mrun - msafe);
      float pv[16]; float ps = 0.f;
#pragma unroll
      for (int i = 0; i < 16; ++i) { pv[i] = ((bits >> i) & 1u) ? __expf(Sx[i] - msafe) : 0.f; ps += pv[i]; }
      lrun = lrun * alpha + ps;
      mrun = mnew;
      if (__builtin_amdgcn_ballot_w64(alpha != 1.f) != 0ull) {
#pragma unroll
        for (int dt = 0; dt < 2; ++dt)
#pragma unroll
          for (int i = 0; i < 16; ++i) O[dt][i] *= alpha;
      }
      bf16x8 Pf[2];
#pragma unroll
      for (int s = 0; s < 2; ++s) Pf[s] = pack8(pv[8 * s], pv[8 * s + 1], pv[8 * s + 2], pv[8 * s + 3], pv[8 * s + 4], pv[8 * s + 5], pv[8 * s + 6], pv[8 * s + 7]);
#pragma unroll
      for (int dt = 0; dt < 2; ++dt)
#pragma unroll
        for (int s = 0; s < 2; ++s) O[dt] = MFMA(Vf[dt][s], Pf[s], O[dt]);
#pragma unroll
      for (int ks = 0; ks < 4; ++ks) Kf[ks] = Kn[ks];
    }
  }
  u16* y = (u16*)(p.ws + OFF_XB);
  {
    float lt = lrun + __shfl_xor(lrun, 32);
    float inv = 1.f / lt;
#pragma unroll
    for (int dt = 0; dt < 2; ++dt)
#pragma unroll
      for (int g = 0; g < 4; ++g)
        st4bf(y + (size_t)qtok * 1024 + head * 64 + dt * 32 + 8 * g + 4 * lh, O[dt][4 * g] * inv, O[dt][4 * g + 1] * inv, O[dt][4 * g + 2] * inv, O[dt][4 * g + 3] * inv);
  }
  __syncthreads();
}

DI void gla_bcum(const Params& p, int b, int h, int n, float* bc, float* glr_s, float* segtot) {
  const u16* tm = (const u16*)(p.ws + OFF_TM);
  const int tid = threadIdx.x;
  const int tok0 = b * S_ + n * 64;
  for (int i = tid; i < 1024; i += 512) glr_s[i] = bf2f(tm[(size_t)(tok0 + (i >> 4)) * TMW + TM_GLR + (i & 15)]);
  const int d = tid & 63, cgp = tid >> 6;
  float gu[16];
#pragma unroll
  for (int j = 0; j < 16; ++j) gu[j] = p.gate_up[j * 256 + h * 64 + d];
  const float bias = p.gate_bias[h * 64 + d];
  __syncthreads();
  float v[8]; float run = 0.f;
#pragma unroll
  for (int r = 0; r < 8; ++r) {
    const int c = cgp * 8 + r;
    float z = bias;
#pragma unroll
    for (int j = 0; j < 16; ++j) z = fmaf(glr_s[c * 16 + j], gu[j], z);
    float la = (fminf(z, 0.f) - log1pf(__expf(-fabsf(z)))) * 0.0625f;
    run += la; v[r] = run;
  }
  segtot[cgp * 64 + d] = run;
  __syncthreads();
  float off = 0.f;
#pragma unroll
  for (int g = 0; g < 8; ++g) off += (g < cgp) ? segtot[g * 64 + d] : 0.f;
#pragma unroll
  for (int r = 0; r < 8; ++r) bc[(cgp * 8 + r) * 64 + d] = off + v[r];
  __syncthreads();
}

DI void gla_g1_item(const Params& p, int item, char* smem) {
  float* bc = (float*)smem;
  float* glr_s = (float*)(smem + 16384);
  float* segtot = (float*)(smem + 20480);
  u16* KeT = (u16*)(smem + 22528);
  const int b = item >> 8, h = (item >> 6) & 3, n = item & 63;
  const u16* tm = (const u16*)(p.ws + OFF_TM);
  const u16* gvT = (const u16*)(p.ws + OFF_GVT);
  const int tid = threadIdx.x, lane = tid & 63, wave = tid >> 6, lr = lane & 31, lh = lane >> 5;
  const int tok0 = b * S_ + n * 64;
  gla_bcum(p, b, h, n, bc, glr_s, segtot);
  {
    const int d = tid & 63, cgp = tid >> 6;
    const float blast = bc[63 * 64 + d];
    float f[8];
#pragma unroll
    for (int r = 0; r < 8; ++r) {
      const int c = cgp * 8 + r;
      float kv = bf2f(tm[(size_t)(tok0 + c) * TMW + TM_GK + h * 64 + d]);
      f[r] = kv * __expf(blast - bc[c * 64 + d]);
    }
    *reinterpret_cast<bf16x8*>(KeT + d * 72 + cgp * 8) = pack8(f[0], f[1], f[2], f[3], f[4], f[5], f[6], f[7]);
    if (cgp == 0) ((float*)(p.ws + OFF_DECAY))[item * 64 + d] = __expf(blast);
  }
  __syncthreads();
  {
    const int et = wave & 3, dtl = wave >> 2;
    f32x16 acc = zero16();
    const u16* arow = gvT + ((size_t)b * 512 + h * 128 + et * 32 + lr) * 4096 + n * 64 + lh * 8;
#pragma unroll
    for (int ks = 0; ks < 4; ++ks) {
      bf16x8 a = ldg8(arow + ks * 16);
      bf16x8 bb = *reinterpret_cast<const bf16x8*>(KeT + (dtl * 32 + lr) * 72 + ks * 16 + lh * 8);
      acc = MFMA(a, bb, acc);
    }
    float* kvT = (float*)(p.ws + OFF_KVT);
#pragma unroll
    for (int i = 0; i < 16; ++i) kvT[((size_t)item * 128 + et * 32 + crow(i, lh)) * 64 + dtl * 32 + lr] = acc[i];
  }
  __syncthreads();
}

DI void gla_scan(const Params& p) {
  const float* kvT = (const float*)(p.ws + OFF_KVT);
  const float* decay = (const float*)(p.ws + OFF_DECAY);
  u16* prev = (u16*)(p.ws + OFF_PREV);
  const int gtid = blockIdx.x * blockDim.x + threadIdx.x;
  const int gn = gridDim.x * blockDim.x;
  for (int u = gtid; u < 32 * 2048; u += gn) {
    const int bh = u >> 11, rem = u & 2047, e = rem >> 4, d4 = (rem & 15) * 4;
    f32x4 st = {0.f, 0.f, 0.f, 0.f};
#pragma unroll 4
    for (int n = 0; n < 64; ++n) {
      const int item = bh * 64 + n;
      st4bf(prev + ((size_t)item * 128 + e) * 64 + d4, st[0], st[1], st[2], st[3]);
      f32x4 dc = *reinterpret_cast<const f32x4*>(decay + item * 64 + d4);
      f32x4 kv = *reinterpret_cast<const f32x4*>(kvT + ((size_t)item * 128 + e) * 64 + d4);
      st = dc * st + kv;
    }
  }
}

DI void gla_g3_item(const Params& p, int item, char* smem) {
  float* bc = (float*)smem;
  float* glr_s = (float*)(smem + 16384);
  float* segtot = (float*)(smem + 20480);
  float* red = (float*)(smem + 22528);
  const int b = item >> 8, h = (item >> 6) & 3, n = item & 63;
  const u16* tm = (const u16*)(p.ws + OFF_TM);
  const u16* gvT = (const u16*)(p.ws + OFF_GVT);
  const u16* prev = (const u16*)(p.ws + OFF_PREV);
  const int tid = threadIdx.x, lane = tid & 63, wave = tid >> 6, lr = lane & 31, lh = lane >> 5;
  const int tok0 = b * S_ + n * 64;
  gla_bcum(p, b, h, n, bc, glr_s, segtot);
  const int et = wave & 3, ct = wave >> 2;
  bf16x8 Qd[4];
  {
    const int c = ct * 32 + lr;
#pragma unroll
    for (int ks = 0; ks < 4; ++ks) {
      bf16x8 raw = ldg8(tm + (size_t)(tok0 + c) * TMW + TM_GQ + h * 64 + ks * 16 + lh * 8);
      float f[8];
#pragma unroll
      for (int j = 0; j < 8; ++j) f[j] = bf2f((u16)raw[j]) * 0.125f * __expf(bc[c * 64 + ks * 16 + lh * 8 + j]);
      Qd[ks] = pack8(f[0], f[1], f[2], f[3], f[4], f[5], f[6], f[7]);
    }
  }
  f32x16 O = zero16();
  const u16* vrow = gvT + ((size_t)b * 512 + h * 128 + et * 32 + lr) * 4096 + n * 64 + 4 * lh;
#pragma unroll
  for (int st = 0; st < 2; ++st) {
    if (st <= ct) {
      f32x16 A = zero16();
      const int s = st * 32 + lr;
#pragma unroll
      for (int ks = 0; ks < 4; ++ks) {
        bf16x8 raw = ldg8(tm + (size_t)(tok0 + s) * TMW + TM_GK + h * 64 + ks * 16 + lh * 8);
        float f[8];
#pragma unroll
        for (int j = 0; j < 8; ++j) f[j] = bf2f((u16)raw[j]) * __expf(-bc[s * 64 + ks * 16 + lh * 8 + j]);
        bf16x8 Ki = pack8(f[0], f[1], f[2], f[3], f[4], f[5], f[6], f[7]);
        A = MFMA(Ki, Qd[ks], A);
      }
      float pv[16];
#pragma unroll
      for (int i = 0; i < 16; ++i) pv[i] = (st * 32 + crow(i, lh) <= ct * 32 + lr) ? A[i] : 0.f;
#pragma unroll
      for (int s2 = 0; s2 < 2; ++s2) {
        bf16x8 Pf = pack8(pv[8 * s2], pv[8 * s2 + 1], pv[8 * s2 + 2], pv[8 * s2 + 3], pv[8 * s2 + 4], pv[8 * s2 + 5], pv[8 * s2 + 6], pv[8 * s2 + 7]);
        const u16* vp = vrow + st * 32 + 16 * s2;
        bf16x4 lo = *reinterpret_cast<const bf16x4*>(vp);
        bf16x4 hi = *reinterpret_cast<const bf16x4*>(vp + 8);
        O = MFMA(cat44(lo, hi), Pf, O);
      }
    }
  }
  {
    const u16* srow = prev + ((size_t)item * 128 + et * 32 + lr) * 64 + lh * 8;
#pragma unroll
    for (int ks = 0; ks < 4; ++ks) O = MFMA(ldg8(srow + ks * 16), Qd[ks], O);
  }
  float ss = 0.f;
#pragma unroll
  for (int i = 0; i < 16; ++i) ss += O[i] * O[i];
  ss += __shfl_xor(ss, 32);
  if (lh == 0) red[(ct * 4 + et) * 32 + lr] = ss;
  __syncthreads();
  const float tot = red[(ct * 4 + 0) * 32 + lr] + red[(ct * 4 + 1) * 32 + lr] + red[(ct * 4 + 2) * 32 + lr] + red[(ct * 4 + 3) * 32 + lr];
  const float rinv = rsqrtf(tot * (1.f / 128.f) + 1e-6f);
  const int tok = tok0 + ct * 32 + lr;
  u16* y = (u16*)(p.ws + OFF_XB);
#pragma unroll
  for (int g = 0; g < 4; ++g) {
    const int e0 = et * 32 + 8 * g + 4 * lh;
    u32x2 gr = *reinterpret_cast<const u32x2*>(tm + (size_t)tok * TMW + TM_GR + h * 128 + e0);
    f32x4 ng = *reinterpret_cast<const f32x4*>(p.norm_g + e0);
    float grv[4] = {bflo(gr[0]), bfhi(gr[0]), bflo(gr[1]), bfhi(gr[1])};
    float o[4];
#pragma unroll
    for (int r = 0; r < 4; ++r) {
      float sl = grv[r] / (1.f + __expf(-grv[r]));
      o[r] = O[4 * g + r] * rinv * ng[r] * sl;
    }
    st4bf(y + (size_t)tok * 1024 + 512 + h * 128 + e0, o[0], o[1], o[2], o[3]);
  }
  __syncthreads();
}

template <int MODE>
DI void phase_gemm(const Params& p, const u16* X, const u16* Wt, int N, const float* resid, float* outf, u16* outb, int ldo, char* smem) {
  const int ntn = N / 128;
  const int total = 128 * ntn;
  const int tid = threadIdx.x, lane = tid & 63, wave = tid >> 6;
  const int fw = wave & 1, tq = wave >> 1, lr = lane & 31, lh = lane >> 5;
  for (int t = blockIdx.x; t < total; t += gridDim.x) {
    const int mt = t / ntn, nt = t % ntn;
    f32x16 acc[2][2];
    gemm_tile(X + (size_t)mt * 256 * 1024, 1024, Wt + (size_t)nt * 128 * 1024, 1024, 1024, smem, acc);
#pragma unroll
    for (int tt = 0; tt < 2; ++tt) {
      const int tok = mt * 256 + tq * 64 + tt * 32 + lr;
#pragma unroll
      for (int ft = 0; ft < 2; ++ft)
#pragma unroll
        for (int g = 0; g < 4; ++g) {
          const int f = nt * 128 + fw * 64 + ft * 32 + 8 * g + 4 * lh;
          if (MODE == 0) {
            f32x4 r = *reinterpret_cast<const f32x4*>(resid + (size_t)tok * 1024 + f);
            f32x4 o;
#pragma unroll
            for (int k = 0; k < 4; ++k) o[k] = ALPHA * r[k] + acc[ft][tt][4 * g + k];
            *reinterpret_cast<f32x4*>(outf + (size_t)tok * 1024 + f) = o;
          } else if (MODE == 1) {
            st4bf(outb + (size_t)tok * ldo + f, acc[ft][tt][4 * g], acc[ft][tt][4 * g + 1], acc[ft][tt][4 * g + 2], acc[ft][tt][4 * g + 3]);
          } else {
            const int hh = f >> 8, fh = f & 255, ks = fh >> 4, lane2 = ((fh >> 3) & 1) * 32 + lr;
            st4bf(outb + ((((size_t)(tok >> 5) * 4 + hh) * 16 + ks) * 64 + lane2) * 8 + 4 * lh, acc[ft][tt][4 * g], acc[ft][tt][4 * g + 1], acc[ft][tt][4 * g + 2], acc[ft][tt][4 * g + 3]);
          }
        }
    }
  }
}

DI void phase_ln(const Params& p, float* h, u16* hb, const float* g, const float* bta) {
  const int lane = threadIdx.x & 63;
  const int gw = (blockIdx.x * blockDim.x + threadIdx.x) >> 6;
  const int nw = (gridDim.x * blockDim.x) >> 6;
  for (int row = gw; row < T_; row += nw) {
    float* r = h + (size_t)row * 1024;
    f32x4 v[4]; float s = 0.f;
#pragma unroll
    for (int c = 0; c < 4; ++c) { v[c] = *reinterpret_cast<const f32x4*>(r + c * 256 + lane * 4); s += v[c][0] + v[c][1] + v[c][2] + v[c][3]; }
    const float mean = wave_sum(s) * (1.f / 1024.f);
    float q = 0.f;
#pragma unroll
    for (int c = 0; c < 4; ++c)
#pragma unroll
      for (int k = 0; k < 4; ++k) { float d = v[c][k] - mean; q += d * d; }
    const float rstd = rsqrtf(wave_sum(q) * (1.f / 1024.f) + 1e-5f);
#pragma unroll
    for (int c = 0; c < 4; ++c) {
      f32x4 gg = *reinterpret_cast<const f32x4*>(g + c * 256 + lane * 4);
      f32x4 bb = *reinterpret_cast<const f32x4*>(bta + c * 256 + lane * 4);
      f32x4 o;
#pragma unroll
      for (int k = 0; k < 4; ++k) o[k] = (v[c][k] - mean) * rstd * gg[k] + bb[k];
      *reinterpret_cast<f32x4*>(r + c * 256 + lane * 4) = o;
      st4bf(hb + (size_t)row * 1024 + c * 256 + lane * 4, o[0], o[1], o[2], o[3]);
    }
  }
}

DI void phase_xattn(const Params& p) {
  const u16* qx = (const u16*)(p.ws + OFF_QX);
  const u16* mk = (const u16*)(p.ws + OFF_MEMK);
  const u16* mv = (const u16*)(p.ws + OFF_MEMVT);
  u16* ox = (u16*)(p.ws + OFF_OX);
  const int lane = threadIdx.x & 63, lr = lane & 31, lh = lane >> 5;
  const int gw = (blockIdx.x * blockDim.x + threadIdx.x) >> 6;
  const int nw = (gridDim.x * blockDim.x) >> 6;
  for (int it = gw; it < 8 * 4 * 128; it += nw) {
    const int qt = it & 127, h = (it >> 7) & 3, b = it >> 9;
    const int tok = b * S_ + qt * 32 + lr;
    f32x16 Sx[8];
#pragma unroll
    for (int kt = 0; kt < 8; ++kt) Sx[kt] = zero16();
    const u16* qrow = qx + (((size_t)(b * 128 + qt) * 4 + h) * 16) * 512 + lane * 8;
    const u16* krow = mk + (((size_t)(b * 4 + h) * 8) * 16) * 512 + lane * 8;
#pragma unroll 2
    for (int ks = 0; ks < 16; ++ks) {
      bf16x8 qf = ldg8(qrow + ks * 512);
#pragma unroll
      for (int kt = 0; kt < 8; ++kt) Sx[kt] = MFMA(ldg8(krow + (kt * 16 + ks) * 512), qf, Sx[kt]);
    }
    float mx = -INFINITY;
#pragma unroll
    for (int kt = 0; kt < 8; ++kt)
#pragma unroll
      for (int i = 0; i < 16; ++i) mx = fmaxf(mx, Sx[kt][i]);
    mx = fmaxf(mx, __shfl_xor(mx, 32));
    float ls = 0.f;
    bf16x8 Pf[8][2];
#pragma unroll
    for (int kt = 0; kt < 8; ++kt) {
      float pv[16];
#pragma unroll
      for (int i = 0; i < 16; ++i) { pv[i] = __expf((Sx[kt][i] - mx) * 0.0625f); ls += pv[i]; }
#pragma unroll
      for (int s = 0; s < 2; ++s) Pf[kt][s] = pack8(pv[8 * s], pv[8 * s + 1], pv[8 * s + 2], pv[8 * s + 3], pv[8 * s + 4], pv[8 * s + 5], pv[8 * s + 6], pv[8 * s + 7]);
    }
    ls += __shfl_xor(ls, 32);
    const float inv = 1.f / ls;
#pragma unroll 1
    for (int dt = 0; dt < 8; ++dt) {
      f32x16 o = zero16();
      const u16* vrow = mv + ((((size_t)(b * 4 + h) * 8 + dt) * 8) * 2) * 512 + lane * 8;
#pragma unroll
      for (int kt = 0; kt < 8; ++kt)
#pragma unroll
        for (int s = 0; s < 2; ++s) o = MFMA(ldg8(vrow + (kt * 2 + s) * 512), Pf[kt][s], o);
#pragma unroll
      for (int g = 0; g < 4; ++g)
        st4bf(ox + (size_t)tok * 1024 + h * 256 + dt * 32 + 8 * g + 4 * lh, o[4 * g] * inv, o[4 * g + 1] * inv, o[4 * g + 2] * inv, o[4 * g + 3] * inv);
    }
  }
}

DI void peer_topk_item(const Params& p, int tt128, int head, char* smem) {
  float* sc = (float*)smem;
  float* topv = (float*)(smem + 132096);
  unsigned char* topi = (unsigned char*)(smem + 132096 + 16384);
  const u16* pq = (const u16*)(p.ws + OFF_QX);
  const u16* sk = (const u16*)(p.ws + OFF_SK);
  const int tid = threadIdx.x, lane = tid & 63, wave = tid >> 6, lr = lane & 31, lh = lane >> 5;
  const int tok0 = tt128 * 128;
  {
    const int half = wave >> 2, kt = wave & 3;
    bf16x8 af[8];
#pragma unroll
    for (int ks = 0; ks < 8; ++ks) af[ks] = ldg8(sk + (size_t)half * 16384 + (kt * 32 + lr) * 128 + ks * 16 + lh * 8);
#pragma unroll 1
    for (int tt = 0; tt < 4; ++tt) {
      f32x16 acc = zero16();
      const u16* brow = pq + (size_t)(tok0 + tt * 32 + lr) * 2048 + head * 256 + half * 128 + lh * 8;
#pragma unroll
      for (int ks = 0; ks < 8; ++ks) acc = MFMA(af[ks], ldg8(brow + ks * 16), acc);
#pragma unroll
      for (int i = 0; i < 16; ++i) sc[(half * 128 + tt * 32 + lr) * 129 + kt * 32 + crow(i, lh)] = acc[i];
    }
  }
  __syncthreads();
  if (tid < 256) {
    float* row = sc + tid * 129;
    float gm[8]; int gi[8];
#pragma unroll
    for (int g = 0; g < 8; ++g) {
      float m = -INFINITY; int mi = g * 16;
#pragma unroll
      for (int j = 0; j < 16; ++j) { float v = row[g * 16 + j]; if (v > m) { m = v; mi = g * 16 + j; } }
      gm[g] = m; gi[g] = mi;
    }
#pragma unroll 1
    for (int r = 0; r < 16; ++r) {
      float best = gm[0]; int bg = 0; int bi = gi[0];
#pragma unroll
      for (int g = 1; g < 8; ++g) if (gm[g] > best) { best = gm[g]; bg = g; bi = gi[g]; }
      topv[tid * 16 + r] = best; topi[tid * 16 + r] = (unsigned char)bi;
      row[bi] = -INFINITY;
      float m = -INFINITY; int mi = bg * 16;
#pragma unroll
      for (int j = 0; j < 16; ++j) { float v = row[bg * 16 + j]; if (v > m) { m = v; mi = bg * 16 + j; } }
#pragma unroll
      for (int g = 0; g < 8; ++g) { gm[g] = (g == bg) ? m : gm[g]; gi[g] = (g == bg) ? mi : gi[g]; }
    }
  }
  __syncthreads();
  if (tid < 128) {
    const float* av = topv + tid * 16;
    const float* bv = topv + (128 + tid) * 16;
    const unsigned char* ai = topi + tid * 16;
    const unsigned char* bi_ = topi + (128 + tid) * 16;
    float cur[16]; int pp[16];
    const float b0 = bv[0];
#pragma unroll
    for (int i = 0; i < 16; ++i) { cur[i] = av[i] + b0; pp[i] = 0; }
    float sel[16]; int eid[16];
#pragma unroll
    for (int r = 0; r < 16; ++r) {
      float best = cur[0]; int bi = 0; int bj = pp[0];
#pragma unroll
      for (int i = 1; i < 16; ++i) if (cur[i] > best) { best = cur[i]; bi = i; bj = pp[i]; }
      sel[r] = best;
      eid[r] = (int)ai[bi] * 128 + (int)bi_[bj];
      const int nj = bj + 1;
      const float nv = (nj < 16) ? (av[bi] + bv[nj & 15]) : -INFINITY;
#pragma unroll
      for (int i = 0; i < 16; ++i) { cur[i] = (i == bi) ? nv : cur[i]; pp[i] = (i == bi) ? nj : pp[i]; }
    }
    float sum = 0.f;
    const float smax = sel[0];
#pragma unroll
    for (int r = 0; r < 16; ++r) { sel[r] = __expf(sel[r] - smax); sum += sel[r]; }
    const float inv = 1.f / sum;
    int* eo = (int*)(p.ws + OFF_EIDX) + (size_t)(tok0 + tid) * 128 + head * 16;
    float* go = (float*)(p.ws + OFF_GATE) + (size_t)(tok0 + tid) * 128 + head * 16;
#pragma unroll
    for (int r = 0; r < 16; ++r) { eo[r] = eid[r]; go[r] = sel[r] * inv; }
  }
  __syncthreads();
}

DI float dot2bf(unsigned a, unsigned b, float c) {
  return __builtin_amdgcn_fdot2_f32_bf16(__builtin_bit_cast(bf2_t, a), __builtin_bit_cast(bf2_t, b), c, false);
}

DI void phase_peer_ffn(const Params& p) {
  const char* exd = p.ws + OFF_EXD;
  const char* exu = p.ws + OFF_EXU;
  const float* esc = (const float*)(p.ws + OFF_ESC);
  const float* h = (const float*)(p.ws + OFF_H);
  const int* eidx = (const int*)(p.ws + OFF_EIDX);
  const float* gate = (const float*)(p.ws + OFF_GATE);
  const int lane = threadIdx.x & 63;
  const int gw = (blockIdx.x * blockDim.x + threadIdx.x) >> 6;
  const int nw = (gridDim.x * blockDim.x) >> 6;
  for (int tok = gw; tok < T_; tok += nw) {
    const float* xr = h + (size_t)tok * 1024 + lane * 16;
    float x[16];
#pragma unroll
    for (int c = 0; c < 4; ++c) {
      f32x4 t = *reinterpret_cast<const f32x4*>(xr + c * 4);
      x[4 * c] = t[0]; x[4 * c + 1] = t[1]; x[4 * c + 2] = t[2]; x[4 * c + 3] = t[3];
    }
    float yacc[16];
#pragma unroll
    for (int i = 0; i < 16; ++i) yacc[i] = 0.f;
    const int e_lo = eidx[(size_t)tok * 128 + lane];
    const int e_hi = eidx[(size_t)tok * 128 + 64 + lane];
    const float g_lo = gate[(size_t)tok * 128 + lane];
    const float g_hi = gate[(size_t)tok * 128 + 64 + lane];
#pragma unroll 1
    for (int eb = 0; eb < 16; ++eb) {
      const int ev = (eb < 8) ? e_lo : e_hi;
      const float gv = (eb < 8) ? g_lo : g_hi;
      const int lbase = (eb & 7) * 8;
      int er[8];
#pragma unroll
      for (int k = 0; k < 8; ++k) er[k] = __builtin_amdgcn_readlane(ev, lbase + k);
      u32x4 dr[8], ur[8];
#pragma unroll
      for (int k = 0; k < 8; ++k) dr[k] = *reinterpret_cast<const u32x4*>(exd + (size_t)er[k] * 1024 + lane * 16);
#pragma unroll
      for (int k = 0; k < 8; ++k) ur[k] = *reinterpret_cast<const u32x4*>(exu + (size_t)er[k] * 1024 + lane * 16);
      const int emine = __shfl(ev, lbase + (lane & 7));
      const float gsel = __shfl(gv, lbase + (lane & 7));
      const float sd = esc[emine];
      const float su = esc[16384 + emine];
      float part[8];
#pragma unroll
      for (int k = 0; k < 8; ++k) {
        float a0 = 0.f, a1 = 0.f;
#pragma unroll
        for (int w = 0; w < 4; ++w) {
          f2_t lo = __builtin_amdgcn_cvt_pk_f32_fp8((int)dr[k][w], false);
          f2_t hi = __builtin_amdgcn_cvt_pk_f32_fp8((int)dr[k][w], true);
          a0 = fmaf(lo[0], x[4 * w], a0); a1 = fmaf(lo[1], x[4 * w + 1], a1);
          a0 = fmaf(hi[0], x[4 * w + 2], a0); a1 = fmaf(hi[1], x[4 * w + 3], a1);
        }
        part[k] = a0 + a1;
      }
      float r4[4], r2[2], r1;
#pragma unroll
      for (int k = 0; k < 4; ++k) {
        float send = (lane & 1) ? part[2 * k] : part[2 * k + 1];
        float keep = (lane & 1) ? part[2 * k + 1] : part[2 * k];
        r4[k] = keep + __shfl_xor(send, 1);
      }
#pragma unroll
      for (int k = 0; k < 2; ++k) {
        float send = (lane & 2) ? r4[2 * k] : r4[2 * k + 1];
        float keep = (lane & 2) ? r4[2 * k + 1] : r4[2 * k];
        r2[k] = keep + __shfl_xor(send, 2);
      }
      {
        float send = (lane & 4) ? r2[0] : r2[1];
        float keep = (lane & 4) ? r2[1] : r2[0];
        r1 = keep + __shfl_xor(send, 4);
      }
      r1 += __shfl_xor(r1, 8);
      r1 += __shfl_xor(r1, 16);
      r1 += __shfl_xor(r1, 32);
      r1 *= sd;
      const float act = 0.5f * r1 * (1.f + erff(r1 * 0.70710678118654752f));
      const float coef = gsel * act * su;
#pragma unroll
      for (int k = 0; k < 8; ++k) {
        const float ck = __int_as_float(__builtin_amdgcn_readlane(__float_as_int(coef), k));
#pragma unroll
        for (int w = 0; w < 4; ++w) {
          f2_t lo = __builtin_amdgcn_cvt_pk_f32_fp8((int)ur[k][w], false);
          f2_t hi = __builtin_amdgcn_cvt_pk_f32_fp8((int)ur[k][w], true);
          yacc[4 * w] = fmaf(ck, lo[0], yacc[4 * w]);
          yacc[4 * w + 1] = fmaf(ck, lo[1], yacc[4 * w + 1]);
          yacc[4 * w + 2] = fmaf(ck, hi[0], yacc[4 * w + 2]);
          yacc[4 * w + 3] = fmaf(ck, hi[1], yacc[4 * w + 3]);
        }
      }
    }
    float v[16];
#pragma unroll
    for (int i = 0; i < 16; ++i) v[i] = ALPHA * x[i] + yacc[i];
    float s = 0.f;
#pragma unroll
    for (int i = 0; i < 16; ++i) s += v[i];
    const float mean = wave_sum(s) * (1.f / 1024.f);
    float q = 0.f;
#pragma unroll
    for (int i = 0; i < 16; ++i) { float d = v[i] - mean; q += d * d; }
    const float rstd = rsqrtf(wave_sum(q) * (1.f / 1024.f) + 1e-5f);
    float* orow = p.out + (size_t)tok * 1024 + lane * 16;
#pragma unroll
    for (int c = 0; c < 4; ++c) {
      f32x4 gg = *reinterpret_cast<const f32x4*>(p.ln_ffn_g + lane * 16 + c * 4);
      f32x4 bb = *reinterpret_cast<const f32x4*>(p.ln_ffn_b + lane * 16 + c * 4);
      f32x4 o;
#pragma unroll
      for (int k = 0; k < 4; ++k) o[k] = (v[4 * c + k] - mean) * rstd * gg[k] + bb[k];
      *reinterpret_cast<f32x4*>(orow + c * 4) = o;
    }
  }
}

constexpr size_t OFF_BAR = 166 * MiB;
DI void gbar(unsigned* ctr, unsigned target) {
  asm volatile("s_waitcnt vmcnt(0)" ::: "memory");
  __syncthreads();
  if (threadIdx.x == 0) {
    __builtin_amdgcn_fence(__ATOMIC_RELEASE, "agent");
    asm volatile("s_waitcnt vmcnt(0)" ::: "memory");
    __hip_atomic_fetch_add(ctr, 1u, __ATOMIC_RELAXED, __HIP_MEMORY_SCOPE_AGENT);
    while (__hip_atomic_load(ctr, __ATOMIC_RELAXED, __HIP_MEMORY_SCOPE_AGENT) < target) __builtin_amdgcn_s_sleep(2);
    __builtin_amdgcn_fence(__ATOMIC_ACQUIRE, "agent");
    asm volatile("s_waitcnt vmcnt(0)" ::: "memory");
  }
  __syncthreads();
}

__global__ void __launch_bounds__(512) fwd_megakernel(Params p) {
  __shared__ __attribute__((aligned(1024))) char smem[155648];
  cg::grid_group grid = cg::this_grid();
  const int G = gridDim.x;
  char* ws = p.ws;
  unsigned* bar = (unsigned*)(ws + OFF_BAR);

  phase_prep(p, smem);
  grid.sync();

  phase_inproj(p, smem);
  gbar(bar, (unsigned)(1 * G));

  for (int k = 0; k * G < 1024; ++k) {
    int j = (k & 1) ? (G - 1 - (int)blockIdx.x) : (int)blockIdx.x;
    int idx = k * G + j;
    if (idx < 1024) dsa_thr_item(p, idx & 7, 127 - (idx >> 3), smem);
  }
  for (int it = blockIdx.x; it < 2048; it += G) gla_g1_item(p, it, smem);
  gbar(bar, (unsigned)(2 * G));

  for (int k = 0; k * G < 1024; ++k) {
    int j = (k & 1) ? (G - 1 - (int)blockIdx.x) : (int)blockIdx.x;
    int idx = k * G + j;
    if (idx < 1024) dsa_attn_item(p, idx & 7, 127 - (idx >> 3), smem);
  }
  gla_scan(p);
  gbar(bar, (unsigned)(3 * G));

  for (int it = blockIdx.x; it < 2048; it += G) gla_g3_item(p, it, smem);
  gbar(bar, (unsigned)(4 * G));

  phase_gemm<0>(p, (const u16*)(ws + OFF_XB), (const u16*)(ws + OFF_WOUT), 1024, p.x, (float*)(ws + OFF_H), nullptr, 0, smem);
  gbar(bar, (unsigned)(5 * G));
  phase_ln(p, (float*)(ws + OFF_H), (u16*)(ws + OFF_HB), p.ln_mix_g, p.ln_mix_b);
  gbar(bar, (unsigned)(6 * G));

  phase_gemm<2>(p, (const u16*)(ws + OFF_HB), (const u16*)(ws + OFF_WQ), 1024, nullptr, nullptr, (u16*)(ws + OFF_QX), 1024, smem);
  gbar(bar, (unsigned)(7 * G));
  phase_xattn(p);
  gbar(bar, (unsigned)(8 * G));
  phase_gemm<0>(p, (const u16*)(ws + OFF_OX), (const u16*)(ws + OFF_WO), 1024, (const float*)(ws + OFF_H), (float*)(ws + OFF_H), nullptr, 0, smem);
  gbar(bar, (unsigned)(9 * G));
  phase_ln(p, (float*)(ws + OFF_H), (u16*)(ws + OFF_HB), p.ln_mem_g, p.ln_mem_b);
  gbar(bar, (unsigned)(10 * G));

  phase_gemm<1>(p, (const u16*)(ws + OFF_HB), (const u16*)(ws + OFF_WPQ), 2048, nullptr, nullptr, (u16*)(ws + OFF_QX), 2048, smem);
  gbar(bar, (unsigned)(11 * G));
  for (int it = blockIdx.x; it < 2048; it += G) peer_topk_item(p, it >> 3, it & 7, smem);
  gbar(bar, (unsigned)(12 * G));
  phase_peer_ffn(p);
}

extern "C" void kernel_launch(void* const* d_in, const int* in_sizes, int n_in,
                              void* d_out, int out_size, void* d_ws, size_t ws_size,
                              hipStream_t stream) {
  static int grid_blocks = 0;
  if (!grid_blocks) {
    int dev = 0, cus = 0, per_cu = 0;
    (void)hipGetDevice(&dev);
    (void)hipDeviceGetAttribute(&cus, hipDeviceAttributeMultiprocessorCount, dev);
    (void)hipOccupancyMaxActiveBlocksPerMultiprocessor(&per_cu, fwd_megakernel, 512, 0);
    if (per_cu > 1) per_cu = 1;
    grid_blocks = cus * per_cu;
    if (grid_blocks > 256) grid_blocks = 256;
    if (ws_size < 512 * MiB) fprintf(stderr, "workspace too small: %zu\n", ws_size);
  }
  Params p{};
  p.x = (const float*)d_in[0]; p.positions = (const int*)d_in[1]; p.mem = (const float*)d_in[2]; p.w_in = (const float*)d_in[3];
  p.gate_up = (const float*)d_in[4]; p.gate_bias = (const float*)d_in[5]; p.norm_g = (const float*)d_in[6]; p.w_out = (const float*)d_in[7];
  p.ln_mix_g = (const float*)d_in[8]; p.ln_mix_b = (const float*)d_in[9];
  p.wq = (const float*)d_in[10]; p.wk = (const float*)d_in[11]; p.wv = (const float*)d_in[12]; p.wo = (const float*)d_in[13];
  p.ln_mem_g = (const float*)d_in[14]; p.ln_mem_b = (const float*)d_in[15];
  p.w_pq = (const float*)d_in[16]; p.sk1 = (const float*)d_in[17]; p.sk2 = (const float*)d_in[18];
  p.ex_down = (const float*)d_in[19]; p.ex_up = (const float*)d_in[20];
  p.ln_ffn_g = (const float*)d_in[21]; p.ln_ffn_b = (const float*)d_in[22];
  p.out = (float*)d_out; p.ws = (char*)d_ws;
  (void)hipMemsetAsync((char*)d_ws + OFF_BAR, 0, 256, stream);
  void* args[] = {&p};
  hipError_t e = hipLaunchCooperativeKernel((void*)fwd_megakernel, dim3(grid_blocks), dim3(512), args, 0, stream);
  if (e != hipSuccess) fprintf(stderr, "cooperative launch failed: %s (grid %d)\n", hipGetErrorString(e), grid_blocks);
}
```

```cpp
#include <hip/hip_runtime.h>
#include <hip/hip_cooperative_groups.h>
#include <cstdio>
#include <cmath>
namespace cg = cooperative_groups;

#define DI __device__ __forceinline__
typedef short bf16x8 __attribute__((ext_vector_type(8)));
typedef short bf16x4 __attribute__((ext_vector_type(4)));
typedef float f32x16 __attribute__((ext_vector_type(16)));
typedef float f32x4 __attribute__((ext_vector_type(4)));
typedef unsigned u32x4 __attribute__((ext_vector_type(4)));
typedef unsigned u32x2 __attribute__((ext_vector_type(2)));
typedef unsigned short u16;
typedef __bf16 bf2_t __attribute__((ext_vector_type(2)));
typedef float f2_t __attribute__((ext_vector_type(2)));

#define MFMA(a, b, c) __builtin_amdgcn_mfma_f32_32x32x16_bf16((a), (b), (c), 0, 0, 0)

constexpr int T_ = 32768;
constexpr int S_ = 4096;
constexpr int TMW = 2368;
constexpr int TM_Q = 0, TM_K = 512, TM_QI = 1024, TM_KI = 1280, TM_WI = 1312, TM_GLR = 1320, TM_GQ = 1344, TM_GK = 1600, TM_GR = 1856;
constexpr int PROJ_N = 3456;
constexpr float ALPHA = 1.189207115002721f;
constexpr size_t MiB = 1024 * 1024;

constexpr size_t OFF_XB = 0;
constexpr size_t OFF_EXD = 64 * MiB;
constexpr size_t OFF_EXU = 80 * MiB;
constexpr size_t OFF_BCG = 96 * MiB;
constexpr size_t OFF_WIN = 128 * MiB;
constexpr size_t OFF_WOUT = OFF_WIN + (size_t)PROJ_N * 1024 * 2;
constexpr size_t OFF_WQ = OFF_WOUT + 2 * MiB;
constexpr size_t OFF_WK = OFF_WQ + 2 * MiB;
constexpr size_t OFF_WV = OFF_WK + 2 * MiB;
constexpr size_t OFF_WO = OFF_WV + 2 * MiB;
constexpr size_t OFF_WPQ = OFF_WO + 2 * MiB;
constexpr size_t OFF_MEMB = 152 * MiB;
constexpr size_t OFF_MEMK = 156 * MiB;
constexpr size_t OFF_MEMVT = 160 * MiB;
constexpr size_t OFF_THR = 164 * MiB;
constexpr size_t OFF_SK = OFF_THR + 256 * 1024;
constexpr size_t OFF_DECAY = OFF_SK + 128 * 1024;
constexpr size_t OFF_ESC = 165 * MiB;
constexpr size_t OFF_TM = 168 * MiB;
constexpr size_t OFF_VT = 316 * MiB;
constexpr size_t OFF_KFR = 476 * MiB;
constexpr size_t OFF_GVT = 348 * MiB;
constexpr size_t OFF_KVT = 380 * MiB;
constexpr size_t OFF_PREV = 444 * MiB;
constexpr size_t OFF_H = 168 * MiB;
constexpr size_t OFF_HB = 296 * MiB;
constexpr size_t OFF_QX = 360 * MiB;
constexpr size_t OFF_OX = 424 * MiB;
constexpr size_t OFF_EIDX = 0;
constexpr size_t OFF_GATE = 16 * MiB;
constexpr size_t OFF_COEF = 32 * MiB;

struct Params {
  const float* x; const int* positions; const float* mem; const float* w_in;
  const float* gate_up; const float* gate_bias; const float* norm_g; const float* w_out;
  const float* ln_mix_g; const float* ln_mix_b;
  const float* wq; const float* wk; const float* wv; const float* wo;
  const float* ln_mem_g; const float* ln_mem_b;
  const float* w_pq; const float* sk1; const float* sk2; const float* ex_down; const float* ex_up;
  const float* ln_ffn_g; const float* ln_ffn_b;
  float* out; char* ws;
};

DI unsigned pk_bf16(float a, float b) {
  f2_t v = {a, b};
  bf2_t r = __builtin_convertvector(v, bf2_t);
  return __builtin_bit_cast(unsigned, r);
}
DI u16 f2bf(float a) { return (u16)(pk_bf16(a, 0.f) & 0xffffu); }
DI float bf2f(u16 u) { return __uint_as_float(((unsigned)u) << 16); }
DI float bflo(unsigned u) { return __uint_as_float(u << 16); }
DI float bfhi(unsigned u) { return __uint_as_float(u & 0xffff0000u); }
DI int crow(int i, int h) { return (i & 3) + 8 * (i >> 2) + 4 * h; }
DI bf16x8 ldg8(const u16* p) { return *reinterpret_cast<const bf16x8*>(p); }
DI bf16x8 pack8(float a0, float a1, float a2, float a3, float a4, float a5, float a6, float a7) {
  u32x4 r; r[0] = pk_bf16(a0, a1); r[1] = pk_bf16(a2, a3); r[2] = pk_bf16(a4, a5); r[3] = pk_bf16(a6, a7);
  return __builtin_bit_cast(bf16x8, r);
}
DI bf16x8 cat44(bf16x4 lo, bf16x4 hi) { return __builtin_shufflevector(lo, hi, 0, 1, 2, 3, 4, 5, 6, 7); }
DI void st4bf(u16* p, float a, float b, float c, float d) {
  u32x2 v; v[0] = pk_bf16(a, b); v[1] = pk_bf16(c, d);
  *reinterpret_cast<u32x2*>(p) = v;
}
DI float wave_sum(float v) {
#pragma unroll
  for (int d = 32; d >= 1; d >>= 1) v += __shfl_xor(v, d);
  return v;
}
DI void sincos_rad(float ang, float& s, float& c) {
  constexpr float C_hi = (float)0.15915494309189535;
  constexpr float C_lo = (float)(0.15915494309189535 - (double)C_hi);
  float k = rintf(ang * C_hi);
  float f = fmaf(ang, C_hi, -k);
  f = fmaf(ang, C_lo, f);
  s = __builtin_amdgcn_sinf(f);
  c = __builtin_amdgcn_cosf(f);
}
DI unsigned fkey(float s) {
  unsigned u = __float_as_uint(s + 0.0f);
  return (u & 0x80000000u) ? ~u : (u | 0x80000000u);
}
DI f32x16 zero16() { f32x16 z; for (int i = 0; i < 16; ++i) z[i] = 0.f; return z; }

DI int win_src_col(int n) {
  if (n < 1832) return n;
  if (n < 1848) return 2856 + (n - 1832);
  if (n < 1856) return -1;
  if (n < 2880) return n - 24;
  if (n < 3392) return n - 8;
  return -1;
}

DI void cvt_stream(const float* __restrict__ src, u16* __restrict__ dst, size_t n, size_t gtid, size_t gn) {
  size_t n8 = n / 8;
  for (size_t i = gtid; i < n8; i += gn) {
    f32x4 a = *reinterpret_cast<const f32x4*>(src + i * 8);
    f32x4 b = *reinterpret_cast<const f32x4*>(src + i * 8 + 4);
    u32x4 r; r[0] = pk_bf16(a[0], a[1]); r[1] = pk_bf16(a[2], a[3]); r[2] = pk_bf16(b[0], b[1]); r[3] = pk_bf16(b[2], b[3]);
    *reinterpret_cast<u32x4*>(dst + i * 8) = r;
  }
}

template <bool MAPPED>
DI void transpose_tile(const float* __restrict__ W, int ldn, u16* __restrict__ Wt, int k0, int n0, float* tile) {
  const int tid = threadIdx.x;
  {
    int nn = n0 + (tid & 63);
    int c = MAPPED ? win_src_col(nn) : nn;
#pragma unroll
    for (int rr = 0; rr < 8; ++rr) {
      int kk = (tid >> 6) + 8 * rr;
      float v = (c >= 0) ? W[(size_t)(k0 + kk) * ldn + c] : 0.f;
      tile[kk * 65 + (tid & 63)] = v;
    }
  }
  __syncthreads();
#pragma unroll
  for (int rr = 0; rr < 8; ++rr) {
    int nn = (tid >> 6) + 8 * rr;
    int kk = tid & 63;
    Wt[(size_t)(n0 + nn) * 1024 + k0 + kk] = f2bf(tile[kk * 65 + nn]);
  }
  __syncthreads();
}

DI void phase_prep(const Params& p, char* smem) {
  const size_t gtid = (size_t)blockIdx.x * blockDim.x + threadIdx.x;
  const size_t gn = (size_t)gridDim.x * blockDim.x;
  char* ws = p.ws;
  cvt_stream(p.x, (u16*)(ws + OFF_XB), (size_t)T_ * 1024, gtid, gn);
  cvt_stream(p.mem, (u16*)(ws + OFF_MEMB), (size_t)2048 * 1024, gtid, gn);
  {
    const int lane = threadIdx.x & 63;
    const int gw = (int)(gtid >> 6), nw = (int)(gn >> 6);
    for (int r = gw; r < 2 * 16384; r += nw) {
      const int tbl = r >> 14, row = r & 16383;
      const float* src = (tbl ? p.ex_up : p.ex_down) + (size_t)row * 1024 + lane * 16;
      f32x4 v[4]; float mx = 0.f;
#pragma unroll
      for (int c = 0; c < 4; ++c) {
        v[c] = *reinterpret_cast<const f32x4*>(src + c * 4);
#pragma unroll
        for (int k = 0; k < 4; ++k) mx = fmaxf(mx, fabsf(v[c][k]));
      }
#pragma unroll
      for (int d = 32; d >= 1; d >>= 1) mx = fmaxf(mx, __shfl_xor(mx, d));
      float sc = (mx > 0.f) ? exp2f(floorf(log2f(224.f / mx))) : 1.f;
      u32x4 o;
#pragma unroll
      for (int c = 0; c < 4; ++c) {
        int t = __builtin_amdgcn_cvt_pk_fp8_f32(v[c][0] * sc, v[c][1] * sc, 0, false);
        t = __builtin_amdgcn_cvt_pk_fp8_f32(v[c][2] * sc, v[c][3] * sc, t, true);
        o[c] = (unsigned)t;
      }
      *reinterpret_cast<u32x4*>(ws + (tbl ? OFF_EXU : OFF_EXD) + (size_t)row * 1024 + lane * 16) = o;
      if (lane == 0) ((float*)(ws + OFF_ESC))[r] = 1.f / sc;
    }
  }
  cvt_stream(p.sk1, (u16*)(ws + OFF_SK), (size_t)128 * 128, gtid, gn);
  cvt_stream(p.sk2, (u16*)(ws + OFF_SK) + 128 * 128, (size_t)128 * 128, gtid, gn);
  float* tile = (float*)smem;
  const int n_win = 54 * 16, n_sq = 256, n_pq = 512;
  const int total = n_win + 5 * n_sq + n_pq;
  for (int t = blockIdx.x; t < total; t += gridDim.x) {
    if (t < n_win) {
      transpose_tile<true>(p.w_in, 3384, (u16*)(ws + OFF_WIN), (t & 15) * 64, (t >> 4) * 64, tile);
    } else if (t < n_win + 5 * n_sq) {
      int u = t - n_win; int which = u >> 8; int r = u & 255;
      const float* W = which == 0 ? p.w_out : which == 1 ? p.wq : which == 2 ? p.wk : which == 3 ? p.wv : p.wo;
      size_t off = which == 0 ? OFF_WOUT : which == 1 ? OFF_WQ : which == 2 ? OFF_WK : which == 3 ? OFF_WV : OFF_WO;
      transpose_tile<false>(W, 1024, (u16*)(ws + off), (r & 15) * 64, (r >> 4) * 64, tile);
    } else {
      int r = t - n_win - 5 * n_sq;
      transpose_tile<false>(p.w_pq, 2048, (u16*)(ws + OFF_WPQ), (r & 15) * 64, (r >> 4) * 64, tile);
    }
  }
}

#define WAIT_V(n) asm volatile("s_waitcnt vmcnt(%0)" ::"n"(n) : "memory")
#define RAW_BARRIER() do { asm volatile("s_waitcnt lgkmcnt(0)" ::: "memory"); __builtin_amdgcn_s_barrier(); asm volatile("" ::: "memory"); } while (0)
constexpr int G_STAGE = 384 * 128;
DI void gemm_tile(const u16* __restrict__ X, int ldx, const u16* __restrict__ Wt, int ldw, int K, char* smem,
                  f32x16 (&acc)[2][2]) {
  const int tid = threadIdx.x, lane = tid & 63, wave = tid >> 6;
  const int fw = wave & 1, tq = wave >> 1, lr = lane & 31, lh = lane >> 5;
#pragma unroll
  for (int a = 0; a < 2; ++a)
#pragma unroll
    for (int b = 0; b < 2; ++b) acc[a][b] = zero16();
  const int nk = K / 64;
  const u16* src[6];
#pragma unroll
  for (int i = 0; i < 6; ++i) {
    const int R = 8 * (wave + 8 * i) + (lane >> 3);
    const int c = (lane & 7) ^ ((R >> 1) & 7);
    src[i] = (i < 4) ? (X + (size_t)R * ldx + c * 8) : (Wt + (size_t)(R - 256) * ldw + c * 8);
  }
#define GLDS_STAGE(slot, kt) do { _Pragma("unroll") for (int i = 0; i < 6; ++i) \
    __builtin_amdgcn_global_load_lds((const unsigned*)(src[i] + (kt) * 64), (__attribute__((address_space(3))) unsigned*)(smem + (slot) * G_STAGE + (wave + 8 * i) * 1024), 16, 0, 0); } while (0)
  int offA[2], offB[2], xa[2], xb[2];
#pragma unroll
  for (int ft = 0; ft < 2; ++ft) { const int R = 256 + fw * 64 + ft * 32 + lr; offA[ft] = R * 128; xa[ft] = (R >> 1) & 7; }
#pragma unroll
  for (int tt = 0; tt < 2; ++tt) { const int R = tq * 64 + tt * 32 + lr; offB[tt] = R * 128; xb[tt] = (R >> 1) & 7; }
  GLDS_STAGE(0, 0); GLDS_STAGE(1, 1); WAIT_V(6); RAW_BARRIER();
  int cur = 0;
  for (int kt = 0; kt < nk; ++kt) {
    const int nxt = (cur >= 1) ? cur - 1 : 2;
    if (kt + 2 < nk) GLDS_STAGE(nxt, kt + 2);
    __builtin_amdgcn_sched_barrier(0);
    const char* st = smem + cur * G_STAGE;
#pragma unroll
    for (int ks = 0; ks < 4; ++ks) {
      bf16x8 a[2], b[2];
#pragma unroll
      for (int ft = 0; ft < 2; ++ft) a[ft] = *reinterpret_cast<const bf16x8*>(st + offA[ft] + (((ks * 2 + lh) ^ xa[ft]) << 4));
#pragma unroll
      for (int tt = 0; tt < 2; ++tt) b[tt] = *reinterpret_cast<const bf16x8*>(st + offB[tt] + (((ks * 2 + lh) ^ xb[tt]) << 4));
#pragma unroll
      for (int ft = 0; ft < 2; ++ft)
#pragma unroll
        for (int tt = 0; tt < 2; ++tt) acc[ft][tt] = MFMA(a[ft], b[tt], acc[ft][tt]);
    }
    if (kt + 2 < nk) { WAIT_V(6); } else { WAIT_V(0); }
    RAW_BARRIER();
    cur = (cur == 2) ? 0 : cur + 1;
  }
#undef GLDS_STAGE
}

DI void epi_inproj(const Params& p, int tok0, int f0, f32x16 (&acc)[2][2]) {
  const int tid = threadIdx.x, lane = tid & 63, wave = tid >> 6;
  const int fw = wave & 1, tq = wave >> 1, lr = lane & 31, lh = lane >> 5;
  const int fbase = f0 + fw * 64;
  if (fbase >= 3392) return;
  u16* tm = (u16*)(p.ws + OFF_TM);
#pragma unroll
  for (int tt = 0; tt < 2; ++tt) {
    const int tok = tok0 + tq * 64 + tt * 32 + lr;
    const float posf = (float)p.positions[tok];
    const int bb = tok >> 12, ss = tok & 4095;
    if (fbase < 1024) {
#pragma unroll
      for (int r = 0; r < 4; ++r) {
        float j = (float)(4 * lh + r);
        float inv = exp2f(-j * (18.931568569324174f / 8.0f));
        float sn, cs; sincos_rad(posf * inv, sn, cs);
        float x1 = acc[0][tt][r], x2 = acc[0][tt][r + 4];
        acc[0][tt][r] = x1 * cs - x2 * sn;
        acc[0][tt][r + 4] = x2 * cs + x1 * sn;
      }
      if (fbase < 512) {
#pragma unroll
        for (int ft = 0; ft < 2; ++ft)
#pragma unroll
          for (int g = 0; g < 4; ++g)
            st4bf(tm + (size_t)tok * TMW + fbase + ft * 32 + 8 * g + 4 * lh, acc[ft][tt][4 * g], acc[ft][tt][4 * g + 1], acc[ft][tt][4 * g + 2], acc[ft][tt][4 * g + 3]);
      } else {
        u16* kfr = (u16*)(p.ws + OFF_KFR);
        const int head = (fbase - 512) >> 6, gt = ss >> 5;
#pragma unroll
        for (int ft = 0; ft < 2; ++ft)
#pragma unroll
          for (int g = 0; g < 4; ++g) {
            const int ks = ft * 2 + (g >> 1), lane2 = (g & 1) * 32 + lr;
            st4bf(kfr + ((((size_t)(bb * 8 + head) * 128 + gt) * 4 + ks) * 64 + lane2) * 8 + 4 * lh, acc[ft][tt][4 * g], acc[ft][tt][4 * g + 1], acc[ft][tt][4 * g + 2], acc[ft][tt][4 * g + 3]);
          }
      }
    } else if (fbase < 1536) {
      u16* vfr = (u16*)(p.ws + OFF_VT);
      const int head = (fbase - 1024) >> 6, gt = ss >> 5;
      const int s = lr >> 4, r16 = lr & 15, j = 4 * (r16 >> 3) + (r16 & 3), lh2 = (r16 >> 2) & 1;
#pragma unroll
      for (int ft = 0; ft < 2; ++ft)
#pragma unroll
        for (int i = 0; i < 16; ++i) {
          const int lane2 = lh2 * 32 + crow(i, lh);
          vfr[((((((size_t)(bb * 8 + head) * 128 + gt) * 2 + ft) * 2 + s) * 64 + lane2) * 8) + j] = f2bf(acc[ft][tt][i]);
        }
    } else if (fbase >= 2368 && fbase < 2880) {
      u16* vt = (u16*)(p.ws + OFF_GVT);
      const int fo = fbase - 2368;
#pragma unroll
      for (int ft = 0; ft < 2; ++ft)
#pragma unroll
        for (int i = 0; i < 16; ++i) {
          int feat = fo + ft * 32 + crow(i, lh);
          vt[((size_t)bb * 512 + feat) * 4096 + ss] = f2bf(acc[ft][tt][i]);
        }
    } else {
      int colbase;
      if (fbase < 1856) {
#pragma unroll
        for (int ft = 0; ft < 2; ++ft) {
          const bool rot = (fbase < 1792) || (ft == 0);
#pragma unroll
          for (int r = 0; r < 4; ++r) {
            float v = acc[ft][tt][r];
            float o = __shfl_xor(v, 32);
            float inv = exp2f(-(float)r * (18.931568569324174f / 4.0f));
            float sn, cs; sincos_rad(posf * inv, sn, cs);
            float res = (lh == 0) ? (v * cs - o * sn) : (v * cs + o * sn);
            acc[ft][tt][r] = rot ? res : v;
          }
        }
        colbase = fbase - 512;
      } else if (fbase < 2368) {
        colbase = fbase - 512;
      } else {
        colbase = fbase - 1024;
      }
#pragma unroll
      for (int ft = 0; ft < 2; ++ft)
#pragma unroll
        for (int g = 0; g < 4; ++g)
          st4bf(tm + (size_t)tok * TMW + colbase + ft * 32 + 8 * g + 4 * lh, acc[ft][tt][4 * g], acc[ft][tt][4 * g + 1], acc[ft][tt][4 * g + 2], acc[ft][tt][4 * g + 3]);
    }
  }
}

DI void phase_inproj(const Params& p, char* smem) {
  const int n_in = 128 * 27;
  const int total = n_in + 128;
  const u16* xb = (const u16*)(p.ws + OFF_XB);
  const u16* memb = (const u16*)(p.ws + OFF_MEMB);
  const int tid = threadIdx.x, lane = tid & 63, wave = tid >> 6;
  const int fw = wave & 1, tq = wave >> 1, lr = lane & 31, lh = lane >> 5;
  for (int t = blockIdx.x; t < total; t += gridDim.x) {
    f32x16 acc[2][2];
    if (t < n_in) {
      int mt = t / 27, nt = t % 27;
      gemm_tile(xb + (size_t)mt * 256 * 1024, 1024, (const u16*)(p.ws + OFF_WIN) + (size_t)nt * 128 * 1024, 1024, 1024, smem, acc);
      epi_inproj(p, mt * 256, nt * 128, acc);
    } else {
      int u = t - n_in; int which = u >> 6; int r = u & 63; int mt = r >> 3, nt = r & 7;
      const u16* W = (const u16*)(p.ws + (which == 0 ? OFF_WK : OFF_WV));
      gemm_tile(memb + (size_t)mt * 256 * 1024, 1024, W + (size_t)nt * 128 * 1024, 1024, 1024, smem, acc);
#pragma unroll
      for (int tt = 0; tt < 2; ++tt) {
        const int tok = mt * 256 + tq * 64 + tt * 32 + lr;
        const int bb = tok >> 8, mm = tok & 255, hh = nt >> 1, kt = mm >> 5;
        if (which == 0) {
          u16* mk = (u16*)(p.ws + OFF_MEMK);
#pragma unroll
          for (int ft = 0; ft < 2; ++ft)
#pragma unroll
            for (int g = 0; g < 4; ++g) {
              const int ks = (nt & 1) * 8 + fw * 4 + ft * 2 + (g >> 1), lane2 = (g & 1) * 32 + lr;
              st4bf(mk + ((((size_t)(bb * 4 + hh) * 8 + kt) * 16 + ks) * 64 + lane2) * 8 + 4 * lh, acc[ft][tt][4 * g], acc[ft][tt][4 * g + 1], acc[ft][tt][4 * g + 2], acc[ft][tt][4 * g + 3]);
            }
        } else {
          u16* mv = (u16*)(p.ws + OFF_MEMVT);
          const int s = lr >> 4, r16 = lr & 15, j = 4 * (r16 >> 3) + (r16 & 3), lh2 = (r16 >> 2) & 1;
#pragma unroll
          for (int ft = 0; ft < 2; ++ft) {
            const int dt = (nt & 1) * 4 + fw * 2 + ft;
#pragma unroll
            for (int i = 0; i < 16; ++i) {
              const int lane2 = lh2 * 32 + crow(i, lh);
              mv[((((((size_t)(bb * 4 + hh) * 8 + dt) * 8 + kt) * 2 + s) * 64 + lane2) * 8) + j] = f2bf(acc[ft][tt][i]);
            }
          }
        }
      }
    }
  }
}

DI void idx_scores(const bf16x8 (&qf)[8][2], const float (&wq)[8], bf16x8 k0, bf16x8 k1, float (&sc)[16]) {
#pragma unroll
  for (int i = 0; i < 16; ++i) sc[i] = 0.f;
#pragma unroll
  for (int hd = 0; hd < 8; ++hd) {
    f32x16 a = zero16();
    a = MFMA(k0, qf[hd][0], a);
    a = MFMA(k1, qf[hd][1], a);
#pragma unroll
    for (int i = 0; i < 16; ++i) sc[i] = fmaf(wq[hd], fmaxf(a[i], 0.f), sc[i]);
  }
}

DI void load_idx_q(const u16* tm, int tok, int lh, bf16x8 (&qf)[8][2], float (&wq)[8]) {
  const u16* row = tm + (size_t)tok * TMW;
#pragma unroll
  for (int hd = 0; hd < 8; ++hd)
#pragma unroll
    for (int ks = 0; ks < 2; ++ks) qf[hd][ks] = ldg8(row + TM_QI + hd * 32 + ks * 16 + lh * 8);
  bf16x8 w8 = ldg8(row + TM_WI);
#pragma unroll
  for (int hd = 0; hd < 8; ++hd) wq[hd] = bf2f((u16)w8[hd]) * 0.0625f;
}

DI int wave_incl_scan(int v, int lane) {
#pragma unroll
  for (int d = 1; d < 64; d <<= 1) {
    int t = __shfl_up(v, d);
    if (lane >= d) v += t;
  }
  return v;
}

DI void dsa_thr_item(const Params& p, int b, int qblk, char* smem) {
  unsigned* hist = (unsigned*)smem;
  unsigned* pref = (unsigned*)(smem + 32768);
  int* rank = (int*)(smem + 32768 + 128);
  const u16* tm = (const u16*)(p.ws + OFF_TM);
  const int tid = threadIdx.x, lane = tid & 63, wave = tid >> 6, lr = lane & 31, lh = lane >> 5;
  const int q0 = qblk * 32;
  u16* qi = (u16*)(smem + 33280);
  for (int i = tid; i < 32 * 32; i += 512) {
    int q = i >> 5, ch = i & 31;
    *reinterpret_cast<u32x4*>(qi + q * 264 + ch * 8) = *reinterpret_cast<const u32x4*>(tm + (size_t)(b * S_ + q0 + q) * TMW + TM_QI + ch * 8);
  }
  float wq[8];
  {
    bf16x8 w8 = ldg8(tm + (size_t)(b * S_ + q0 + lr) * TMW + TM_WI);
#pragma unroll
    for (int hd = 0; hd < 8; ++hd) wq[hd] = bf2f((u16)w8[hd]) * 0.0625f;
  }
  const u16* qil = qi + lr * 264 + lh * 8;
  if (tid < 32) { pref[tid] = 0u; rank[tid] = min(256, q0 + tid + 1); }
  for (int pass = 0; pass < 4; ++pass) {
    for (int i = tid; i < 8192; i += 512) hist[i] = 0u;
    __syncthreads();
    const int shift = 24 - 8 * pass;
    const unsigned mypref = pref[lr];
    const u16* kib = tm + (size_t)(b * S_ + lr) * TMW + TM_KI + lh * 8;
    bf16x8 kn0, kn1;
    {
      const int kt0 = min(wave, qblk);
      kn0 = ldg8(kib + (size_t)(kt0 * 32) * TMW); kn1 = ldg8(kib + (size_t)(kt0 * 32) * TMW + 16);
    }
    for (int kt = wave; kt <= qblk; kt += 8) {
      const bf16x8 k0 = kn0, k1 = kn1;
      {
        const int ktn = min(kt + 8, qblk);
        kn0 = ldg8(kib + (size_t)(ktn * 32) * TMW); kn1 = ldg8(kib + (size_t)(ktn * 32) * TMW + 16);
      }
      float sc[16];
#pragma unroll
      for (int i = 0; i < 16; ++i) sc[i] = 0.f;
#pragma unroll
      for (int hd = 0; hd < 8; ++hd) {
        f32x16 a = zero16();
        a = MFMA(k0, *reinterpret_cast<const bf16x8*>(qil + hd * 32), a);
        a = MFMA(k1, *reinterpret_cast<const bf16x8*>(qil + hd * 32 + 16), a);
#pragma unroll
        for (int i = 0; i < 16; ++i) sc[i] = fmaf(wq[hd], fmaxf(a[i], 0.f), sc[i]);
      }
#pragma unroll
      for (int i = 0; i < 16; ++i) {
        int kp = kt * 32 + crow(i, lh);
        unsigned ky = fkey(sc[i]);
        unsigned hi = (ky >> shift);
        if (kp <= q0 + lr && (hi >> 8) == mypref) atomicAdd(&hist[(hi & 255u) * 32 + lr], 1u);
      }
    }
    __syncthreads();
#pragma unroll 1
    for (int qq = 0; qq < 4; ++qq) {
      const int q = wave * 4 + qq;
      const int rk = rank[q];
      int c[4];
#pragma unroll
      for (int j = 0; j < 4; ++j) c[j] = (int)hist[(255 - 4 * lane - j) * 32 + q];
      int s = c[0] + c[1] + c[2] + c[3];
      int P = wave_incl_scan(s, lane);
      int excl = P - s;
      if (P >= rk && excl < rk) {
        int cum = excl; int bin = 0; int nr = 1; bool found = false;
#pragma unroll
        for (int j = 0; j < 4; ++j) {
          if (!found && cum + c[j] >= rk) { bin = 255 - 4 * lane - j; nr = rk - cum; found = true; }
          if (!found) cum += c[j];
        }
        pref[q] = (pref[q] << 8) | (unsigned)bin;
        rank[q] = nr;
      }
    }
    __syncthreads();
  }
  if (tid < 32) ((unsigned*)(p.ws + OFF_THR))[b * S_ + q0 + tid] = pref[tid];
  __syncthreads();
}

DI void dsa_attn_item(const Params& p, int b, int qblk, char* smem) {
  u16* maskbuf = (u16*)smem;
  u16* qi = (u16*)(smem + 4096);
  const u16* tm = (const u16*)(p.ws + OFF_TM);
  const u16* vfr = (const u16*)(p.ws + OFF_VT) + ((size_t)(b * 8 + (threadIdx.x >> 6)) * 128) * 2048 + (threadIdx.x & 63) * 8;
  const u16* kfr = (const u16*)(p.ws + OFF_KFR) + ((size_t)(b * 8 + (threadIdx.x >> 6)) * 128) * 2048 + (threadIdx.x & 63) * 8;
  const unsigned* thr = (const unsigned*)(p.ws + OFF_THR);
  const int tid = threadIdx.x, lane = tid & 63, wave = tid >> 6, lr = lane & 31, lh = lane >> 5;
  const int q0 = qblk * 32;
  const int head = wave;
  const int qtok = b * S_ + q0 + lr;
  bf16x8 Qf[4];
#pragma unroll
  for (int ks = 0; ks < 4; ++ks) {
    bf16x8 raw = ldg8(tm + (size_t)qtok * TMW + TM_Q + head * 64 + ks * 16 + lh * 8);
    float f[8];
#pragma unroll
    for (int j = 0; j < 8; ++j) f[j] = bf2f((u16)raw[j]) * 0.125f;
    Qf[ks] = pack8(f[0], f[1], f[2], f[3], f[4], f[5], f[6], f[7]);
  }
  f32x16 O[2];
  O[0] = zero16(); O[1] = zero16();
  float mrun = -INFINITY, lrun = 0.f;
  const unsigned thrq = thr[qtok];
  const int nchunks = (q0 + 31) / 256 + 1;
  for (int i = tid; i < 32 * 32; i += 512) {
    int q = i >> 5, ch = i & 31;
    *reinterpret_cast<u32x4*>(qi + q * 264 + ch * 8) = *reinterpret_cast<const u32x4*>(tm + (size_t)(b * S_ + q0 + q) * TMW + TM_QI + ch * 8);
  }
  float* wqs = (float*)(smem + 4096 + 32 * 264 * 2);
  if (tid < 256) wqs[tid] = bf2f(tm[(size_t)(b * S_ + q0 + (tid & 31)) * TMW + TM_WI + (tid >> 5)]) * 0.0625f;
  __syncthreads();
  const u16* qil = qi + lr * 264 + lh * 8;
  const u16* kibase = tm + (size_t)(b * S_ + lr) * TMW + TM_KI + lh * 8;
  bf16x8 Kf[4], Kn[4];
#pragma unroll
  for (int ks = 0; ks < 4; ++ks) Kf[ks] = ldg8(kfr + ks * 512);
  bf16x8 ki0, ki1;
  {
    const int kt0 = min(wave, qblk);
    ki0 = ldg8(kibase + (size_t)(kt0 * 32) * TMW); ki1 = ldg8(kibase + (size_t)(kt0 * 32) * TMW + 16);
  }
  for (int c = 0; c < nchunks; ++c) {
    const int buf = c & 1;
    {
      const int key0 = (c * 8 + wave) * 32;
      unsigned bits = 0u;
      const bf16x8 k0 = ki0, k1 = ki1;
      {
        const int ktn = min((c + 1) * 8 + wave, qblk);
        ki0 = ldg8(kibase + (size_t)(ktn * 32) * TMW); ki1 = ldg8(kibase + (size_t)(ktn * 32) * TMW + 16);
      }
      if (key0 <= q0 + 31) {
        float sc[16];
#pragma unroll
        for (int i = 0; i < 16; ++i) sc[i] = 0.f;
#pragma unroll 2
        for (int hd = 0; hd < 8; ++hd) {
          f32x16 a = zero16();
          a = MFMA(k0, *reinterpret_cast<const bf16x8*>(qil + hd * 32), a);
          a = MFMA(k1, *reinterpret_cast<const bf16x8*>(qil + hd * 32 + 16), a);
          const float wh = wqs[hd * 32 + lr];
#pragma unroll
          for (int i = 0; i < 16; ++i) sc[i] = fmaf(wh, fmaxf(a[i], 0.f), sc[i]);
        }
        __builtin_amdgcn_sched_barrier(0);
#pragma unroll
        for (int i = 0; i < 16; ++i) {
          int kp = key0 + crow(i, lh);
          if (kp <= q0 + lr && fkey(sc[i]) >= thrq) bits |= (1u << i);
        }
      }
      maskbuf[(buf * 8 + wave) * 64 + lane] = (u16)bits;
    }
    __syncthreads();
#pragma unroll 1
    for (int t8 = 0; t8 < 8; ++t8) {
      const int g = c * 8 + t8;
      if (g > qblk) break;
      {
        const int gn = min(g + 1, qblk);
        const u16* kr = kfr + (size_t)gn * 2048;
#pragma unroll
        for (int ks = 0; ks < 4; ++ks) Kn[ks] = ldg8(kr + ks * 512);
      }
      bf16x8 Vf[2][2];
#pragma unroll
      for (int dt = 0; dt < 2; ++dt)
#pragma unroll
        for (int s = 0; s < 2; ++s) Vf[dt][s] = ldg8(vfr + (size_t)g * 2048 + (dt * 2 + s) * 512);
      const unsigned bits = maskbuf[(buf * 8 + t8) * 64 + lane];
      f32x16 Sx = zero16();
#pragma unroll
      for (int ks = 0; ks < 4; ++ks) Sx = MFMA(Kf[ks], Qf[ks], Sx);
      float mt = -INFINITY;
#pragma unroll
      for (int i = 0; i < 16; ++i) mt = ((bits >> i) & 1u) ? fmaxf(mt, Sx[i]) : mt;
      mt = fmaxf(mt, __shfl_xor(mt, 32));
      const float mnew = fmaxf(mrun, mt);
      const float msafe = (mnew == -INFINITY) ? 0.f : mnew;
      const float alpha = __expf(mrun - msafe);
      float pv[16]; float ps = 0.f;
#pragma unroll
      for (int i = 0; i < 16; ++i) { pv[i] = ((bits >> i) & 1u) ? __expf(Sx[i] - msafe) : 0.f; ps += pv[i]; }
      lrun = lrun * alpha + ps;
      mrun = mnew;
      if (__builtin_amdgcn_ballot_w64(alpha != 1.f) != 0ull) {
#pragma unroll
        for (int dt = 0; dt < 2; ++dt)
#pragma unroll
          for (int i = 0; i < 16; ++i) O[dt][i] *= alpha;
      }
      bf16x8 Pf[2];
#pragma unroll
      for (int s = 0; s < 2; ++s) Pf[s] = pack8(pv[8 * s], pv[8 * s + 1], pv[8 * s + 2], pv[8 * s + 3], pv[8 * s + 4], pv[8 * s + 5], pv[8 * s + 6], pv[8 * s + 7]);
#pragma unroll
      for (int dt = 0; dt < 2; ++dt)
#pragma unroll
        for (int s = 0; s < 2; ++s) O[dt] = MFMA(Vf[dt][s], Pf[s], O[dt]);
#pragma unroll
      for (int ks = 0; ks < 4; ++ks) Kf[ks] = Kn[ks];
    }
  }
  u16* y = (u16*)(p.ws + OFF_XB);
  {
    float lt = lrun + __shfl_xor(lrun, 32);
    float inv = 1.f / lt;
#pragma unroll
    for (int dt = 0; dt < 2; ++dt)
#pragma unroll
      for (int g = 0; g < 4; ++g)
        st4bf(y + (size_t)qtok * 1024 + head * 64 + dt * 32 + 8 * g + 4 * lh, O[dt][4 * g] * inv, O[dt][4 * g + 1] * inv, O[dt][4 * g + 2] * inv, O[dt][4 * g + 3] * inv);
  }
  __syncthreads();
}

DI void gla_bcum(const Params& p, int b, int h, int n, float* bc, float* glr_s, float* segtot) {
  const u16* tm = (const u16*)(p.ws + OFF_TM);
  const int tid = threadIdx.x;
  const int tok0 = b * S_ + n * 64;
  for (int i = tid; i < 1024; i += 512) glr_s[i] = bf2f(tm[(size_t)(tok0 + (i >> 4)) * TMW + TM_GLR + (i & 15)]);
  const int d = tid & 63, cgp = tid >> 6;
  float gu[16];
#pragma unroll
  for (int j = 0; j < 16; ++j) gu[j] = p.gate_up[j * 256 + h * 64 + d];
  const float bias = p.gate_bias[h * 64 + d];
  __syncthreads();
  float v[8]; float run = 0.f;
#pragma unroll
  for (int r = 0; r < 8; ++r) {
    const int c = cgp * 8 + r;
    float z = bias;
#pragma unroll
    for (int j = 0; j < 16; ++j) z = fmaf(glr_s[c * 16 + j], gu[j], z);
    float la = (fminf(z, 0.f) - log1pf(__expf(-fabsf(z)))) * 0.0625f;
    run += la; v[r] = run;
  }
  segtot[cgp * 64 + d] = run;
  __syncthreads();
  float off = 0.f;
#pragma unroll
  for (int g = 0; g < 8; ++g) off += (g < cgp) ? segtot[g * 64 + d] : 0.f;
#pragma unroll
  for (int r = 0; r < 8; ++r) bc[(cgp * 8 + r) * 64 + d] = off + v[r];
  __syncthreads();
}

DI void gla_g1_item(const Params& p, int item, char* smem) {
  float* bc = (float*)smem;
  float* glr_s = (float*)(smem + 16384);
  float* segtot = (float*)(smem + 20480);
  u16* KeT = (u16*)(smem + 22528);
  const int b = item >> 8, h = (item >> 6) & 3, n = item & 63;
  const u16* tm = (const u16*)(p.ws + OFF_TM);
  const u16* gvT = (const u16*)(p.ws + OFF_GVT);
  const int tid = threadIdx.x, lane = tid & 63, wave = tid >> 6, lr = lane & 31, lh = lane >> 5;
  const int tok0 = b * S_ + n * 64;
  u16 kraw[8];
  {
    const int d = tid & 63, cgp = tid >> 6;
#pragma unroll
    for (int r = 0; r < 8; ++r) kraw[r] = tm[(size_t)(tok0 + cgp * 8 + r) * TMW + TM_GK + h * 64 + d];
  }
  bf16x8 afr[4];
  {
    const int et = wave & 3;
    const u16* arow = gvT + ((size_t)b * 512 + h * 128 + et * 32 + lr) * 4096 + n * 64 + lh * 8;
#pragma unroll
    for (int ks = 0; ks < 4; ++ks) afr[ks] = ldg8(arow + ks * 16);
  }
  gla_bcum(p, b, h, n, bc, glr_s, segtot);
  {
    const int d = tid & 63, cgp = tid >> 6;
    const float blast = bc[63 * 64 + d];
    {
      float* bcg = (float*)(p.ws + OFF_BCG) + (size_t)item * 4096;
#pragma unroll
      for (int r = 0; r < 8; ++r) bcg[(cgp * 8 + r) * 64 + d] = bc[(cgp * 8 + r) * 64 + d];
    }
    float f[8];
#pragma unroll
    for (int r = 0; r < 8; ++r) {
      const int c = cgp * 8 + r;
      float kv = bf2f(kraw[r]);
      f[r] = kv * __expf(blast - bc[c * 64 + d]);
    }
    *reinterpret_cast<bf16x8*>(KeT + d * 72 + cgp * 8) = pack8(f[0], f[1], f[2], f[3], f[4], f[5], f[6], f[7]);
    if (cgp == 0) ((float*)(p.ws + OFF_DECAY))[item * 64 + d] = __expf(blast);
  }
  __syncthreads();
  {
    const int et = wave & 3, dtl = wave >> 2;
    f32x16 acc = zero16();
#pragma unroll
    for (int ks = 0; ks < 4; ++ks) {
      bf16x8 a = afr[ks];
      bf16x8 bb = *reinterpret_cast<const bf16x8*>(KeT + (dtl * 32 + lr) * 72 + ks * 16 + lh * 8);
      acc = MFMA(a, bb, acc);
    }
    float* kvT = (float*)(p.ws + OFF_KVT);
#pragma unroll
    for (int i = 0; i < 16; ++i) kvT[((size_t)item * 128 + et * 32 + crow(i, lh)) * 64 + dtl * 32 + lr] = acc[i];
  }
  __syncthreads();
}

DI void gla_scan(const Params& p) {
  const float* kvT = (const float*)(p.ws + OFF_KVT);
  const float* decay = (const float*)(p.ws + OFF_DECAY);
  u16* prev = (u16*)(p.ws + OFF_PREV);
  const int gtid = blockIdx.x * blockDim.x + threadIdx.x;
  const int gn = gridDim.x * blockDim.x;
  for (int u = gtid; u < 32 * 2048; u += gn) {
    const int bh = u >> 11, rem = u & 2047, e = rem >> 4, d4 = (rem & 15) * 4;
    f32x4 st = {0.f, 0.f, 0.f, 0.f};
#pragma unroll 4
    for (int n = 0; n < 64; ++n) {
      const int item = bh * 64 + n;
      st4bf(prev + ((size_t)item * 128 + e) * 64 + d4, st[0], st[1], st[2], st[3]);
      f32x4 dc = *reinterpret_cast<const f32x4*>(decay + item * 64 + d4);
      f32x4 kv = *reinterpret_cast<const f32x4*>(kvT + ((size_t)item * 128 + e) * 64 + d4);
      st = dc * st + kv;
    }
  }
}

DI void gla_g3_item(const Params& p, int item, char* smem) {
  float* red = (float*)smem;
  const int b = item >> 8, h = (item >> 6) & 3, n = item & 63;
  const u16* tm = (const u16*)(p.ws + OFF_TM);
  const u16* gvT = (const u16*)(p.ws + OFF_GVT);
  const u16* prev = (const u16*)(p.ws + OFF_PREV);
  const float* bcg = (const float*)(p.ws + OFF_BCG) + (size_t)item * 4096;
  const int tid = threadIdx.x, lane = tid & 63, wave = tid >> 6, lr = lane & 31, lh = lane >> 5;
  const int tok0 = b * S_ + n * 64;
  const int et = wave & 3, ct = wave >> 2;
  bf16x8 qraw[4], kraw[2][4], sfr[4];
  bf16x4 vlo[2][2], vhi[2][2];
  f32x4 bq[4][2];
  {
    const u16* vrow0 = gvT + ((size_t)b * 512 + h * 128 + et * 32 + lr) * 4096 + n * 64 + 4 * lh;
    const u16* srow0 = prev + ((size_t)item * 128 + et * 32 + lr) * 64 + lh * 8;
#pragma unroll
    for (int ks = 0; ks < 4; ++ks) {
      qraw[ks] = ldg8(tm + (size_t)(tok0 + ct * 32 + lr) * TMW + TM_GQ + h * 64 + ks * 16 + lh * 8);
      kraw[0][ks] = ldg8(tm + (size_t)(tok0 + lr) * TMW + TM_GK + h * 64 + ks * 16 + lh * 8);
      kraw[1][ks] = ldg8(tm + (size_t)(tok0 + ct * 32 + lr) * TMW + TM_GK + h * 64 + ks * 16 + lh * 8);
      sfr[ks] = ldg8(srow0 + ks * 16);
      bq[ks][0] = *reinterpret_cast<const f32x4*>(bcg + (ct * 32 + lr) * 64 + ks * 16 + lh * 8);
      bq[ks][1] = *reinterpret_cast<const f32x4*>(bcg + (ct * 32 + lr) * 64 + ks * 16 + lh * 8 + 4);
    }
#pragma unroll
    for (int st = 0; st < 2; ++st)
#pragma unroll
      for (int s2 = 0; s2 < 2; ++s2) {
        const u16* vp = vrow0 + (st * ct) * 32 + 16 * s2;
        vlo[st][s2] = *reinterpret_cast<const bf16x4*>(vp);
        vhi[st][s2] = *reinterpret_cast<const bf16x4*>(vp + 8);
      }
  }
  bf16x8 Qd[4];
#pragma unroll
  for (int ks = 0; ks < 4; ++ks) {
    float f[8];
#pragma unroll
    for (int j = 0; j < 8; ++j) f[j] = bf2f((u16)qraw[ks][j]) * 0.125f * __expf(bq[ks][j >> 2][j & 3]);
    Qd[ks] = pack8(f[0], f[1], f[2], f[3], f[4], f[5], f[6], f[7]);
  }
  f32x16 O = zero16();
#pragma unroll
  for (int st = 0; st < 2; ++st) {
    if (st <= ct) {
      f32x16 A = zero16();
      const int s = st * 32 + lr;
#pragma unroll
      for (int ks = 0; ks < 4; ++ks) {
        f32x4 b0 = (st == 1) ? bq[ks][0] : *reinterpret_cast<const f32x4*>(bcg + s * 64 + ks * 16 + lh * 8);
        f32x4 b1 = (st == 1) ? bq[ks][1] : *reinterpret_cast<const f32x4*>(bcg + s * 64 + ks * 16 + lh * 8 + 4);
        float f[8];
#pragma unroll
        for (int j = 0; j < 8; ++j) f[j] = bf2f((u16)kraw[st][ks][j]) * __expf(-((j < 4) ? b0[j & 3] : b1[j & 3]));
        bf16x8 Ki = pack8(f[0], f[1], f[2], f[3], f[4], f[5], f[6], f[7]);
        A = MFMA(Ki, Qd[ks], A);
      }
      float pv[16];
#pragma unroll
      for (int i = 0; i < 16; ++i) pv[i] = (st * 32 + crow(i, lh) <= ct * 32 + lr) ? A[i] : 0.f;
#pragma unroll
      for (int s2 = 0; s2 < 2; ++s2) {
        bf16x8 Pf = pack8(pv[8 * s2], pv[8 * s2 + 1], pv[8 * s2 + 2], pv[8 * s2 + 3], pv[8 * s2 + 4], pv[8 * s2 + 5], pv[8 * s2 + 6], pv[8 * s2 + 7]);
        O = MFMA(cat44(vlo[st][s2], vhi[st][s2]), Pf, O);
      }
    }
  }
#pragma unroll
  for (int ks = 0; ks < 4; ++ks) O = MFMA(sfr[ks], Qd[ks], O);
  float ss = 0.f;
#pragma unroll
  for (int i = 0; i < 16; ++i) ss += O[i] * O[i];
  ss += __shfl_xor(ss, 32);
  if (lh == 0) red[(ct * 4 + et) * 32 + lr] = ss;
  __syncthreads();
  const float tot = red[(ct * 4 + 0) * 32 + lr] + red[(ct * 4 + 1) * 32 + lr] + red[(ct * 4 + 2) * 32 + lr] + red[(ct * 4 + 3) * 32 + lr];
  const float rinv = rsqrtf(tot * (1.f / 128.f) + 1e-6f);
  const int tok = tok0 + ct * 32 + lr;
  u16* y = (u16*)(p.ws + OFF_XB);
#pragma unroll
  for (int g = 0; g < 4; ++g) {
    const int e0 = et * 32 + 8 * g + 4 * lh;
    u32x2 gr = *reinterpret_cast<const u32x2*>(tm + (size_t)tok * TMW + TM_GR + h * 128 + e0);
    f32x4 ng = *reinterpret_cast<const f32x4*>(p.norm_g + e0);
    float grv[4] = {bflo(gr[0]), bfhi(gr[0]), bflo(gr[1]), bfhi(gr[1])};
    float o[4];
#pragma unroll
    for (int r = 0; r < 4; ++r) {
      float sl = grv[r] / (1.f + __expf(-grv[r]));
      o[r] = O[4 * g + r] * rinv * ng[r] * sl;
    }
    st4bf(y + (size_t)tok * 1024 + 512 + h * 128 + e0, o[0], o[1], o[2], o[3]);
  }
  __syncthreads();
}

template <int MODE>
DI void phase_gemm(const Params& p, const u16* X, const u16* Wt, int N, const float* resid, float* outf, u16* outb, int ldo, char* smem) {
  const int ntn = N / 128;
  const int total = 128 * ntn;
  const int tid = threadIdx.x, lane = tid & 63, wave = tid >> 6;
  const int fw = wave & 1, tq = wave >> 1, lr = lane & 31, lh = lane >> 5;
  for (int t = blockIdx.x; t < total; t += gridDim.x) {
    const int mt = t / ntn, nt = t % ntn;
    f32x16 acc[2][2];
    gemm_tile(X + (size_t)mt * 256 * 1024, 1024, Wt + (size_t)nt * 128 * 1024, 1024, 1024, smem, acc);
#pragma unroll
    for (int tt = 0; tt < 2; ++tt) {
      const int tok = mt * 256 + tq * 64 + tt * 32 + lr;
#pragma unroll
      for (int ft = 0; ft < 2; ++ft)
#pragma unroll
        for (int g = 0; g < 4; ++g) {
          const int f = nt * 128 + fw * 64 + ft * 32 + 8 * g + 4 * lh;
          if (MODE == 0) {
            f32x4 r = *reinterpret_cast<const f32x4*>(resid + (size_t)tok * 1024 + f);
            f32x4 o;
#pragma unroll
            for (int k = 0; k < 4; ++k) o[k] = ALPHA * r[k] + acc[ft][tt][4 * g + k];
            *reinterpret_cast<f32x4*>(outf + (size_t)tok * 1024 + f) = o;
          } else if (MODE == 1) {
            st4bf(outb + (size_t)tok * ldo + f, acc[ft][tt][4 * g], acc[ft][tt][4 * g + 1], acc[ft][tt][4 * g + 2], acc[ft][tt][4 * g + 3]);
          } else {
            const int hh = f >> 8, fh = f & 255, ks = fh >> 4, lane2 = ((fh >> 3) & 1) * 32 + lr;
            st4bf(outb + ((((size_t)(tok >> 5) * 4 + hh) * 16 + ks) * 64 + lane2) * 8 + 4 * lh, acc[ft][tt][4 * g], acc[ft][tt][4 * g + 1], acc[ft][tt][4 * g + 2], acc[ft][tt][4 * g + 3]);
          }
        }
    }
  }
}

DI void phase_ln(const Params& p, float* h, u16* hb, const float* g, const float* bta) {
  const int lane = threadIdx.x & 63;
  const int gw = (blockIdx.x * blockDim.x + threadIdx.x) >> 6;
  const int nw = (gridDim.x * blockDim.x) >> 6;
  for (int row = gw; row < T_; row += nw) {
    float* r = h + (size_t)row * 1024;
    f32x4 v[4]; float s = 0.f;
#pragma unroll
    for (int c = 0; c < 4; ++c) { v[c] = *reinterpret_cast<const f32x4*>(r + c * 256 + lane * 4); s += v[c][0] + v[c][1] + v[c][2] + v[c][3]; }
    const float mean = wave_sum(s) * (1.f / 1024.f);
    float q = 0.f;
#pragma unroll
    for (int c = 0; c < 4; ++c)
#pragma unroll
      for (int k = 0; k < 4; ++k) { float d = v[c][k] - mean; q += d * d; }
    const float rstd = rsqrtf(wave_sum(q) * (1.f / 1024.f) + 1e-5f);
#pragma unroll
    for (int c = 0; c < 4; ++c) {
      f32x4 gg = *reinterpret_cast<const f32x4*>(g + c * 256 + lane * 4);
      f32x4 bb = *reinterpret_cast<const f32x4*>(bta + c * 256 + lane * 4);
      f32x4 o;
#pragma unroll
      for (int k = 0; k < 4; ++k) o[k] = (v[c][k] - mean) * rstd * gg[k] + bb[k];
      *reinterpret_cast<f32x4*>(r + c * 256 + lane * 4) = o;
      st4bf(hb + (size_t)row * 1024 + c * 256 + lane * 4, o[0], o[1], o[2], o[3]);
    }
  }
}

DI void phase_xattn(const Params& p) {
  const u16* qx = (const u16*)(p.ws + OFF_QX);
  const u16* mk = (const u16*)(p.ws + OFF_MEMK);
  const u16* mv = (const u16*)(p.ws + OFF_MEMVT);
  u16* ox = (u16*)(p.ws + OFF_OX);
  const int lane = threadIdx.x & 63, lr = lane & 31, lh = lane >> 5;
  const int gw = (blockIdx.x * blockDim.x + threadIdx.x) >> 6;
  const int nw = (gridDim.x * blockDim.x) >> 6;
  for (int it = gw; it < 8 * 4 * 128; it += nw) {
    const int qt = it & 127, h = (it >> 7) & 3, b = it >> 9;
    const int tok = b * S_ + qt * 32 + lr;
    f32x16 Sx[8];
#pragma unroll
    for (int kt = 0; kt < 8; ++kt) Sx[kt] = zero16();
    const u16* qrow = qx + (((size_t)(b * 128 + qt) * 4 + h) * 16) * 512 + lane * 8;
    const u16* krow = mk + (((size_t)(b * 4 + h) * 8) * 16) * 512 + lane * 8;
#pragma unroll 2
    for (int ks = 0; ks < 16; ++ks) {
      bf16x8 qf = ldg8(qrow + ks * 512);
#pragma unroll
      for (int kt = 0; kt < 8; ++kt) Sx[kt] = MFMA(ldg8(krow + (kt * 16 + ks) * 512), qf, Sx[kt]);
    }
    float mx = -INFINITY;
#pragma unroll
    for (int kt = 0; kt < 8; ++kt)
#pragma unroll
      for (int i = 0; i < 16; ++i) mx = fmaxf(mx, Sx[kt][i]);
    mx = fmaxf(mx, __shfl_xor(mx, 32));
    float ls = 0.f;
    bf16x8 Pf[8][2];
#pragma unroll
    for (int kt = 0; kt < 8; ++kt) {
      float pv[16];
#pragma unroll
      for (int i = 0; i < 16; ++i) { pv[i] = __expf((Sx[kt][i] - mx) * 0.0625f); ls += pv[i]; }
#pragma unroll
      for (int s = 0; s < 2; ++s) Pf[kt][s] = pack8(pv[8 * s], pv[8 * s + 1], pv[8 * s + 2], pv[8 * s + 3], pv[8 * s + 4], pv[8 * s + 5], pv[8 * s + 6], pv[8 * s + 7]);
    }
    ls += __shfl_xor(ls, 32);
    const float inv = 1.f / ls;
#pragma unroll 1
    for (int dt = 0; dt < 8; ++dt) {
      f32x16 o = zero16();
      const u16* vrow = mv + ((((size_t)(b * 4 + h) * 8 + dt) * 8) * 2) * 512 + lane * 8;
#pragma unroll
      for (int kt = 0; kt < 8; ++kt)
#pragma unroll
        for (int s = 0; s < 2; ++s) o = MFMA(ldg8(vrow + (kt * 2 + s) * 512), Pf[kt][s], o);
#pragma unroll
      for (int g = 0; g < 4; ++g)
        st4bf(ox + (size_t)tok * 1024 + h * 256 + dt * 32 + 8 * g + 4 * lh, o[4 * g] * inv, o[4 * g + 1] * inv, o[4 * g + 2] * inv, o[4 * g + 3] * inv);
    }
  }
}

DI void peer_topk_item(const Params& p, int tt128, int head, char* smem) {
  float* sc = (float*)smem;
  float* topv = (float*)(smem + 132096);
  unsigned char* topi = (unsigned char*)(smem + 132096 + 16384);
  const u16* pq = (const u16*)(p.ws + OFF_QX);
  const u16* sk = (const u16*)(p.ws + OFF_SK);
  const int tid = threadIdx.x, lane = tid & 63, wave = tid >> 6, lr = lane & 31, lh = lane >> 5;
  const int tok0 = tt128 * 128;
  {
    const int half = wave >> 2, kt = wave & 3;
    bf16x8 af[8];
#pragma unroll
    for (int ks = 0; ks < 8; ++ks) af[ks] = ldg8(sk + (size_t)half * 16384 + (kt * 32 + lr) * 128 + ks * 16 + lh * 8);
#pragma unroll 1
    for (int tt = 0; tt < 4; ++tt) {
      f32x16 acc = zero16();
      const u16* brow = pq + (size_t)(tok0 + tt * 32 + lr) * 2048 + head * 256 + half * 128 + lh * 8;
#pragma unroll
      for (int ks = 0; ks < 8; ++ks) acc = MFMA(af[ks], ldg8(brow + ks * 16), acc);
#pragma unroll
      for (int i = 0; i < 16; ++i) sc[(half * 128 + tt * 32 + lr) * 129 + kt * 32 + crow(i, lh)] = acc[i];
    }
  }
  __syncthreads();
  if (tid < 256) {
    float* row = sc + tid * 129;
    float gm[8]; int gi[8];
#pragma unroll
    for (int g = 0; g < 8; ++g) {
      float m = -INFINITY; int mi = g * 16;
#pragma unroll
      for (int j = 0; j < 16; ++j) { float v = row[g * 16 + j]; if (v > m) { m = v; mi = g * 16 + j; } }
      gm[g] = m; gi[g] = mi;
    }
#pragma unroll 1
    for (int r = 0; r < 16; ++r) {
      float best = gm[0]; int bg = 0; int bi = gi[0];
#pragma unroll
      for (int g = 1; g < 8; ++g) if (gm[g] > best) { best = gm[g]; bg = g; bi = gi[g]; }
      topv[tid * 16 + r] = best; topi[tid * 16 + r] = (unsigned char)bi;
      row[bi] = -INFINITY;
      float m = -INFINITY; int mi = bg * 16;
#pragma unroll
      for (int j = 0; j < 16; ++j) { float v = row[bg * 16 + j]; if (v > m) { m = v; mi = bg * 16 + j; } }
#pragma unroll
      for (int g = 0; g < 8; ++g) { gm[g] = (g == bg) ? m : gm[g]; gi[g] = (g == bg) ? mi : gi[g]; }
    }
  }
  __syncthreads();
  if (tid < 128) {
    const float* av = topv + tid * 16;
    const float* bv = topv + (128 + tid) * 16;
    const unsigned char* ai = topi + tid * 16;
    const unsigned char* bi_ = topi + (128 + tid) * 16;
    float cur[16]; int pp[16];
    const float b0 = bv[0];
#pragma unroll
    for (int i = 0; i < 16; ++i) { cur[i] = av[i] + b0; pp[i] = 0; }
    float sel[16]; int eid[16];
#pragma unroll
    for (int r = 0; r < 16; ++r) {
      float best = cur[0]; int bi = 0; int bj = pp[0];
#pragma unroll
      for (int i = 1; i < 16; ++i) if (cur[i] > best) { best = cur[i]; bi = i; bj = pp[i]; }
      sel[r] = best;
      eid[r] = (int)ai[bi] * 128 + (int)bi_[bj];
      const int nj = bj + 1;
      const float nv = (nj < 16) ? (av[bi] + bv[nj & 15]) : -INFINITY;
#pragma unroll
      for (int i = 0; i < 16; ++i) { cur[i] = (i == bi) ? nv : cur[i]; pp[i] = (i == bi) ? nj : pp[i]; }
    }
    float sum = 0.f;
    const float smax = sel[0];
#pragma unroll
    for (int r = 0; r < 16; ++r) { sel[r] = __expf(sel[r] - smax); sum += sel[r]; }
    const float inv = 1.f / sum;
    int* eo = (int*)(p.ws + OFF_EIDX) + (size_t)(tok0 + tid) * 128 + head * 16;
    float* go = (float*)(p.ws + OFF_GATE) + (size_t)(tok0 + tid) * 128 + head * 16;
#pragma unroll
    for (int r = 0; r < 16; ++r) { eo[r] = eid[r]; go[r] = sel[r] * inv; }
  }
  __syncthreads();
}

DI float dot2bf(unsigned a, unsigned b, float c) {
  return __builtin_amdgcn_fdot2_f32_bf16(__builtin_bit_cast(bf2_t, a), __builtin_bit_cast(bf2_t, b), c, false);
}

DI float reduce8(float (&part)[8], int lane) {
  float r4[4], r2[2], r1;
#pragma unroll
  for (int k = 0; k < 4; ++k) {
    float send = (lane & 1) ? part[2 * k] : part[2 * k + 1];
    float keep = (lane & 1) ? part[2 * k + 1] : part[2 * k];
    r4[k] = keep + __shfl_xor(send, 1);
  }
#pragma unroll
  for (int k = 0; k < 2; ++k) {
    float send = (lane & 2) ? r4[2 * k] : r4[2 * k + 1];
    float keep = (lane & 2) ? r4[2 * k + 1] : r4[2 * k];
    r2[k] = keep + __shfl_xor(send, 2);
  }
  {
    float send = (lane & 4) ? r2[0] : r2[1];
    float keep = (lane & 4) ? r2[1] : r2[0];
    r1 = keep + __shfl_xor(send, 4);
  }
  r1 += __shfl_xor(r1, 8);
  r1 += __shfl_xor(r1, 16);
  r1 += __shfl_xor(r1, 32);
  return r1;
}

DI void phase_peer_down(const Params& p) {
  const char* exd = p.ws + OFF_EXD;
  const float* esc = (const float*)(p.ws + OFF_ESC);
  const u16* hb = (const u16*)(p.ws + OFF_HB);
  const int* eidx = (const int*)(p.ws + OFF_EIDX);
  const float* gate = (const float*)(p.ws + OFF_GATE);
  float* coefw = (float*)(p.ws + OFF_COEF);
  const int lane = threadIdx.x & 63;
  const int gw = (blockIdx.x * blockDim.x + threadIdx.x) >> 6;
  const int nw = (gridDim.x * blockDim.x) >> 6;
#pragma unroll 1
  for (int sl = 0; sl < 2; ++sl) {
#pragma unroll 1
    for (int tok = gw; tok < T_; tok += nw) {
      float x[16];
      {
        const u16* xr = hb + (size_t)tok * 1024 + lane * 16;
        u32x4 a = *reinterpret_cast<const u32x4*>(xr);
        u32x4 c = *reinterpret_cast<const u32x4*>(xr + 8);
#pragma unroll
        for (int w = 0; w < 4; ++w) { x[2 * w] = bflo(a[w]); x[2 * w + 1] = bfhi(a[w]); x[8 + 2 * w] = bflo(c[w]); x[8 + 2 * w + 1] = bfhi(c[w]); }
      }
#pragma unroll 1
      for (int half = 0; half < 2; ++half) {
        const int ev = eidx[(size_t)tok * 128 + half * 64 + lane];
        const float gv = gate[(size_t)tok * 128 + half * 64 + lane];
        unsigned long long m = __builtin_amdgcn_ballot_w64((ev >> 13) == sl);
        while (m != 0ull) {
          int pos[8];
          const int first = __builtin_ctzll(m);
#pragma unroll
          for (int k = 0; k < 8; ++k) {
            if (m != 0ull) { pos[k] = __builtin_ctzll(m); m &= m - 1ull; } else pos[k] = -1;
          }
          u32x4 dr[8];
#pragma unroll
          for (int k = 0; k < 8; ++k) {
            const int er = __builtin_amdgcn_readlane(ev, pos[k] >= 0 ? pos[k] : first);
            dr[k] = *reinterpret_cast<const u32x4*>(exd + (size_t)er * 1024 + lane * 16);
          }
          int pmine = pos[0];
#pragma unroll
          for (int k = 1; k < 8; ++k) pmine = ((lane & 7) == k) ? pos[k] : pmine;
          const int psafe = pmine >= 0 ? pmine : first;
          const int emine = __shfl(ev, psafe);
          const float gsel = __shfl(gv, psafe);
          const float sd = esc[emine];
          const float su = esc[16384 + emine];
          float part[8];
#pragma unroll
          for (int k = 0; k < 8; ++k) {
            float a0 = 0.f, a1 = 0.f;
#pragma unroll
            for (int w = 0; w < 4; ++w) {
              f2_t lo = __builtin_amdgcn_cvt_pk_f32_fp8((int)dr[k][w], false);
              f2_t hi = __builtin_amdgcn_cvt_pk_f32_fp8((int)dr[k][w], true);
              a0 = fmaf(lo[0], x[4 * w], a0); a1 = fmaf(lo[1], x[4 * w + 1], a1);
              a0 = fmaf(hi[0], x[4 * w + 2], a0); a1 = fmaf(hi[1], x[4 * w + 3], a1);
            }
            part[k] = a0 + a1;
          }
          float r1 = reduce8(part, lane) * sd;
          const float act = 0.5f * r1 * (1.f + erff(r1 * 0.70710678118654752f));
          if (lane < 8 && pmine >= 0) coefw[(size_t)tok * 128 + half * 64 + pmine] = gsel * act * su;
        }
      }
    }
  }
}

DI void phase_peer_ffn(const Params& p) {
  const char* exu = p.ws + OFF_EXU;
  const float* h = (const float*)(p.ws + OFF_H);
  const int* eidx = (const int*)(p.ws + OFF_EIDX);
  const float* coefw = (const float*)(p.ws + OFF_COEF);
  const int lane = threadIdx.x & 63;
  const int gw = (blockIdx.x * blockDim.x + threadIdx.x) >> 6;
  const int nw = (gridDim.x * blockDim.x) >> 6;
  for (int tok = gw; tok < T_; tok += nw) {
    float yacc[16];
#pragma unroll
    for (int i = 0; i < 16; ++i) yacc[i] = 0.f;
    const int e_lo = eidx[(size_t)tok * 128 + lane];
    const int e_hi = eidx[(size_t)tok * 128 + 64 + lane];
    const float c_lo = coefw[(size_t)tok * 128 + lane];
    const float c_hi = coefw[(size_t)tok * 128 + 64 + lane];
#pragma unroll 1
    for (int eb = 0; eb < 8; ++eb) {
      const int ev = (eb < 4) ? e_lo : e_hi;
      const float cv = (eb < 4) ? c_lo : c_hi;
      const int lbase = (eb & 3) * 16;
      u32x4 ur[16];
#pragma unroll
      for (int k = 0; k < 16; ++k) {
        const int er = __builtin_amdgcn_readlane(ev, lbase + k);
        ur[k] = *reinterpret_cast<const u32x4*>(exu + (size_t)er * 1024 + lane * 16);
      }
#pragma unroll
      for (int k = 0; k < 16; ++k) {
        const float ck = __int_as_float(__builtin_amdgcn_readlane(__float_as_int(cv), lbase + k));
#pragma unroll
        for (int w = 0; w < 4; ++w) {
          f2_t lo = __builtin_amdgcn_cvt_pk_f32_fp8((int)ur[k][w], false);
          f2_t hi = __builtin_amdgcn_cvt_pk_f32_fp8((int)ur[k][w], true);
          yacc[4 * w] = fmaf(ck, lo[0], yacc[4 * w]);
          yacc[4 * w + 1] = fmaf(ck, lo[1], yacc[4 * w + 1]);
          yacc[4 * w + 2] = fmaf(ck, hi[0], yacc[4 * w + 2]);
          yacc[4 * w + 3] = fmaf(ck, hi[1], yacc[4 * w + 3]);
        }
      }
    }
    const float* xr = h + (size_t)tok * 1024 + lane * 16;
    float v[16];
#pragma unroll
    for (int c = 0; c < 4; ++c) {
      f32x4 t = *reinterpret_cast<const f32x4*>(xr + c * 4);
#pragma unroll
      for (int k = 0; k < 4; ++k) v[4 * c + k] = ALPHA * t[k] + yacc[4 * c + k];
    }
    float s = 0.f;
#pragma unroll
    for (int i = 0; i < 16; ++i) s += v[i];
    const float mean = wave_sum(s) * (1.f / 1024.f);
    float q = 0.f;
#pragma unroll
    for (int i = 0; i < 16; ++i) { float d = v[i] - mean; q += d * d; }
    const float rstd = rsqrtf(wave_sum(q) * (1.f / 1024.f) + 1e-5f);
    float* orow = p.out + (size_t)tok * 1024 + lane * 16;
#pragma unroll
    for (int c = 0; c < 4; ++c) {
      f32x4 gg = *reinterpret_cast<const f32x4*>(p.ln_ffn_g + lane * 16 + c * 4);
      f32x4 bb = *reinterpret_cast<const f32x4*>(p.ln_ffn_b + lane * 16 + c * 4);
      f32x4 o;
#pragma unroll
      for (int k = 0; k < 4; ++k) o[k] = (v[4 * c + k] - mean) * rstd * gg[k] + bb[k];
      *reinterpret_cast<f32x4*>(orow + c * 4) = o;
    }
  }
}

constexpr size_t OFF_BAR = 166 * MiB;
DI void gbar(unsigned* ctr, unsigned target) {
  asm volatile("s_waitcnt vmcnt(0)" ::: "memory");
  __syncthreads();
  if (threadIdx.x == 0) {
    __builtin_amdgcn_fence(__ATOMIC_RELEASE, "agent");
    asm volatile("s_waitcnt vmcnt(0)" ::: "memory");
    __hip_atomic_fetch_add(ctr, 1u, __ATOMIC_RELAXED, __HIP_MEMORY_SCOPE_AGENT);
    while (__hip_atomic_load(ctr, __ATOMIC_RELAXED, __HIP_MEMORY_SCOPE_AGENT) < target) __builtin_amdgcn_s_sleep(2);
    __builtin_amdgcn_fence(__ATOMIC_ACQUIRE, "agent");
    asm volatile("s_waitcnt vmcnt(0)" ::: "memory");
  }
  __syncthreads();
}

__global__ void __launch_bounds__(512) fwd_megakernel(Params p) {
  __shared__ __attribute__((aligned(1024))) char smem[155648];
  cg::grid_group grid = cg::this_grid();
  const int G = gridDim.x;
  char* ws = p.ws;
  unsigned* bar = (unsigned*)(ws + OFF_BAR);

  phase_prep(p, smem);
  grid.sync();

  phase_inproj(p, smem);
  gbar(bar, (unsigned)(1 * G));

  for (int k = 0; k * G < 1024; ++k) {
    int j = (k & 1) ? (G - 1 - (int)blockIdx.x) : (int)blockIdx.x;
    int idx = k * G + j;
    if (idx < 1024) dsa_thr_item(p, idx & 7, 127 - (idx >> 3), smem);
  }
  for (int it = blockIdx.x; it < 2048; it += G) gla_g1_item(p, it, smem);
  gbar(bar, (unsigned)(2 * G));

  for (int k = 0; k * G < 1024; ++k) {
    int j = (k & 1) ? (G - 1 - (int)blockIdx.x) : (int)blockIdx.x;
    int idx = k * G + j;
    if (idx < 1024) dsa_attn_item(p, idx & 7, 127 - (idx >> 3), smem);
  }
  gla_scan(p);
  gbar(bar, (unsigned)(3 * G));

  for (int it = blockIdx.x; it < 2048; it += G) gla_g3_item(p, it, smem);
  gbar(bar, (unsigned)(4 * G));

  phase_gemm<0>(p, (const u16*)(ws + OFF_XB), (const u16*)(ws + OFF_WOUT), 1024, p.x, (float*)(ws + OFF_H), nullptr, 0, smem);
  gbar(bar, (unsigned)(5 * G));
  phase_ln(p, (float*)(ws + OFF_H), (u16*)(ws + OFF_HB), p.ln_mix_g, p.ln_mix_b);
  gbar(bar, (unsigned)(6 * G));

  phase_gemm<2>(p, (const u16*)(ws + OFF_HB), (const u16*)(ws + OFF_WQ), 1024, nullptr, nullptr, (u16*)(ws + OFF_QX), 1024, smem);
  gbar(bar, (unsigned)(7 * G));
  phase_xattn(p);
  gbar(bar, (unsigned)(8 * G));
  phase_gemm<0>(p, (const u16*)(ws + OFF_OX), (const u16*)(ws + OFF_WO), 1024, (const float*)(ws + OFF_H), (float*)(ws + OFF_H), nullptr, 0, smem);
  gbar(bar, (unsigned)(9 * G));
  phase_ln(p, (float*)(ws + OFF_H), (u16*)(ws + OFF_HB), p.ln_mem_g, p.ln_mem_b);
  gbar(bar, (unsigned)(10 * G));

  phase_gemm<1>(p, (const u16*)(ws + OFF_HB), (const u16*)(ws + OFF_WPQ), 2048, nullptr, nullptr, (u16*)(ws + OFF_QX), 2048, smem);
  gbar(bar, (unsigned)(11 * G));
  for (int it = blockIdx.x; it < 2048; it += G) peer_topk_item(p, it >> 3, it & 7, smem);
  gbar(bar, (unsigned)(12 * G));
  phase_peer_down(p);
  gbar(bar, (unsigned)(13 * G));
  phase_peer_ffn(p);
}

extern "C" void kernel_launch(void* const* d_in, const int* in_sizes, int n_in,
                              void* d_out, int out_size, void* d_ws, size_t ws_size,
                              hipStream_t stream) {
  static int grid_blocks = 0;
  if (!grid_blocks) {
    int dev = 0, cus = 0, per_cu = 0;
    (void)hipGetDevice(&dev);
    (void)hipDeviceGetAttribute(&cus, hipDeviceAttributeMultiprocessorCount, dev);
    (void)hipOccupancyMaxActiveBlocksPerMultiprocessor(&per_cu, fwd_megakernel, 512, 0);
    if (per_cu > 1) per_cu = 1;
    grid_blocks = cus * per_cu;
    if (grid_blocks > 256) grid_blocks = 256;
    if (ws_size < 512 * MiB) fprintf(stderr, "workspace too small: %zu\n", ws_size);
  }
  Params p{};
  p.x = (const float*)d_in[0]; p.positions = (const int*)d_in[1]; p.mem = (const float*)d_in[2]; p.w_in = (const float*)d_in[3];
  p.gate_up = (const float*)d_in[4]; p.gate_bias = (const float*)d_in[5]; p.norm_g = (const float*)d_in[6]; p.w_out = (const float*)d_in[7];
  p.ln_mix_g = (const float*)d_in[8]; p.ln_mix_b = (const float*)d_in[9];
  p.wq = (const float*)d_in[10]; p.wk = (const float*)d_in[11]; p.wv = (const float*)d_in[12]; p.wo = (const float*)d_in[13];
  p.ln_mem_g = (const float*)d_in[14]; p.ln_mem_b = (const float*)d_in[15];
  p.w_pq = (const float*)d_in[16]; p.sk1 = (const float*)d_in[17]; p.sk2 = (const float*)d_in[18];
  p.ex_down = (const float*)d_in[19]; p.ex_up = (const float*)d_in[20];
  p.ln_ffn_g = (const float*)d_in[21]; p.ln_ffn_b = (const float*)d_in[22];
  p.out = (float*)d_out; p.ws = (char*)d_ws;
  (void)hipMemsetAsync((char*)d_ws + OFF_BAR, 0, 256, stream);
  void* args[] = {&p};
  hipError_t e = hipLaunchCooperativeKernel((void*)fwd_megakernel, dim3(grid_blocks), dim3(512), args, 0, stream);
  if (e != hipSuccess) fprintf(stderr, "cooperative launch failed: %s (grid %d)\n", hipGetErrorString(e), grid_blocks);
}
```

```cpp
#include <hip/hip_runtime.h>
#include <hip/hip_cooperative_groups.h>
#include <cstdio>
#include <cmath>
namespace cg = cooperative_groups;

#define DI __device__ __forceinline__
typedef short bf16x8 __attribute__((ext_vector_type(8)));
typedef short bf16x4 __attribute__((ext_vector_type(4)));
typedef float f32x16 __attribute__((ext_vector_type(16)));
typedef float f32x4 __attribute__((ext_vector_type(4)));
typedef unsigned u32x4 __attribute__((ext_vector_type(4)));
typedef unsigned u32x2 __attribute__((ext_vector_type(2)));
typedef unsigned short u16;
typedef __bf16 bf2_t __attribute__((ext_vector_type(2)));
typedef float f2_t __attribute__((ext_vector_type(2)));

#define MFMA(a, b, c) __builtin_amdgcn_mfma_f32_32x32x16_bf16((a), (b), (c), 0, 0, 0)

constexpr int T_ = 32768;
constexpr int S_ = 4096;
constexpr int TMW = 2368;
constexpr int TM_Q = 0, TM_K = 512, TM_QI = 1024, TM_KI = 1280, TM_WI = 1312, TM_GLR = 1320, TM_GQ = 1344, TM_GK = 1600, TM_GR = 1856;
constexpr int PROJ_N = 3456;
constexpr float ALPHA = 1.189207115002721f;
constexpr size_t MiB = 1024 * 1024;

constexpr size_t OFF_XB = 0;
constexpr size_t OFF_EXD = 64 * MiB;
constexpr size_t OFF_EXU = 80 * MiB;
constexpr size_t OFF_BCG = 96 * MiB;
constexpr size_t OFF_WIN = 128 * MiB;
constexpr size_t OFF_WOUT = OFF_WIN + (size_t)PROJ_N * 1024 * 2;
constexpr size_t OFF_WQ = OFF_WOUT + 2 * MiB;
constexpr size_t OFF_WK = OFF_WQ + 2 * MiB;
constexpr size_t OFF_WV = OFF_WK + 2 * MiB;
constexpr size_t OFF_WO = OFF_WV + 2 * MiB;
constexpr size_t OFF_WPQ = OFF_WO + 2 * MiB;
constexpr size_t OFF_MEMB = 152 * MiB;
constexpr size_t OFF_MEMK = 156 * MiB;
constexpr size_t OFF_MEMVT = 160 * MiB;
constexpr size_t OFF_THR = 164 * MiB;
constexpr size_t OFF_SK = OFF_THR + 256 * 1024;
constexpr size_t OFF_DECAY = OFF_SK + 128 * 1024;
constexpr size_t OFF_ESC = 165 * MiB;
constexpr size_t OFF_TM = 168 * MiB;
constexpr size_t OFF_VT = 316 * MiB;
constexpr size_t OFF_KFR = 476 * MiB;
constexpr size_t OFF_GVT = 348 * MiB;
constexpr size_t OFF_KVT = 380 * MiB;
constexpr size_t OFF_PREV = 444 * MiB;
constexpr size_t OFF_H = 168 * MiB;
constexpr size_t OFF_HB = 296 * MiB;
constexpr size_t OFF_QX = 360 * MiB;
constexpr size_t OFF_OX = 424 * MiB;
constexpr size_t OFF_EIDX = 0;
constexpr size_t OFF_GATE = 16 * MiB;
constexpr size_t OFF_COEF = 32 * MiB;

struct Params {
  const float* x; const int* positions; const float* mem; const float* w_in;
  const float* gate_up; const float* gate_bias; const float* norm_g; const float* w_out;
  const float* ln_mix_g; const float* ln_mix_b;
  const float* wq; const float* wk; const float* wv; const float* wo;
  const float* ln_mem_g; const float* ln_mem_b;
  const float* w_pq; const float* sk1; const float* sk2; const float* ex_down; const float* ex_up;
  const float* ln_ffn_g; const float* ln_ffn_b;
  float* out; char* ws;
};

DI unsigned pk_bf16(float a, float b) {
  f2_t v = {a, b};
  bf2_t r = __builtin_convertvector(v, bf2_t);
  return __builtin_bit_cast(unsigned, r);
}
DI u16 f2bf(float a) { return (u16)(pk_bf16(a, 0.f) & 0xffffu); }
DI float bf2f(u16 u) { return __uint_as_float(((unsigned)u) << 16); }
DI float bflo(unsigned u) { return __uint_as_float(u << 16); }
DI float bfhi(unsigned u) { return __uint_as_float(u & 0xffff0000u); }
DI int crow(int i, int h) { return (i & 3) + 8 * (i >> 2) + 4 * h; }
DI bf16x8 ldg8(const u16* p) { return *reinterpret_cast<const bf16x8*>(p); }
DI bf16x8 pack8(float a0, float a1, float a2, float a3, float a4, float a5, float a6, float a7) {
  u32x4 r; r[0] = pk_bf16(a0, a1); r[1] = pk_bf16(a2, a3); r[2] = pk_bf16(a4, a5); r[3] = pk_bf16(a6, a7);
  return __builtin_bit_cast(bf16x8, r);
}
DI bf16x8 cat44(bf16x4 lo, bf16x4 hi) { return __builtin_shufflevector(lo, hi, 0, 1, 2, 3, 4, 5, 6, 7); }
DI void st4bf(u16* p, float a, float b, float c, float d) {
  u32x2 v; v[0] = pk_bf16(a, b); v[1] = pk_bf16(c, d);
  *reinterpret_cast<u32x2*>(p) = v;
}
DI float wave_sum(float v) {
#pragma unroll
  for (int d = 32; d >= 1; d >>= 1) v += __shfl_xor(v, d);
  return v;
}
DI void sincos_rad(float ang, float& s, float& c) {
  constexpr float C_hi = (float)0.15915494309189535;
  constexpr float C_lo = (float)(0.15915494309189535 - (double)C_hi);
  float k = rintf(ang * C_hi);
  float f = fmaf(ang, C_hi, -k);
  f = fmaf(ang, C_lo, f);
  s = __builtin_amdgcn_sinf(f);
  c = __builtin_amdgcn_cosf(f);
}
DI unsigned fkey(float s) {
  unsigned u = __float_as_uint(s + 0.0f);
  return (u & 0x80000000u) ? ~u : (u | 0x80000000u);
}
DI f32x16 zero16() { f32x16 z; for (int i = 0; i < 16; ++i) z[i] = 0.f; return z; }

DI int win_src_col(int n) {
  if (n < 1832) return n;
  if (n < 1848) return 2856 + (n - 1832);
  if (n < 1856) return -1;
  if (n < 2880) return n - 24;
  if (n < 3392) return n - 8;
  return -1;
}

DI void cvt_stream(const float* __restrict__ src, u16* __restrict__ dst, size_t n, size_t gtid, size_t gn) {
  size_t n8 = n / 8;
  for (size_t i = gtid; i < n8; i += gn) {
    f32x4 a = *reinterpret_cast<const f32x4*>(src + i * 8);
    f32x4 b = *reinterpret_cast<const f32x4*>(src + i * 8 + 4);
    u32x4 r; r[0] = pk_bf16(a[0], a[1]); r[1] = pk_bf16(a[2], a[3]); r[2] = pk_bf16(b[0], b[1]); r[3] = pk_bf16(b[2], b[3]);
    *reinterpret_cast<u32x4*>(dst + i * 8) = r;
  }
}

template <bool MAPPED>
DI void transpose_tile(const float* __restrict__ W, int ldn, u16* __restrict__ Wt, int k0, int n0, float* tile) {
  const int tid = threadIdx.x;
  {
    int nn = n0 + (tid & 63);
    int c = MAPPED ? win_src_col(nn) : nn;
#pragma unroll
    for (int rr = 0; rr < 8; ++rr) {
      int kk = (tid >> 6) + 8 * rr;
      float v = (c >= 0) ? W[(size_t)(k0 + kk) * ldn + c] : 0.f;
      tile[kk * 65 + (tid & 63)] = v;
    }
  }
  __syncthreads();
#pragma unroll
  for (int rr = 0; rr < 8; ++rr) {
    int nn = (tid >> 6) + 8 * rr;
    int kk = tid & 63;
    Wt[(size_t)(n0 + nn) * 1024 + k0 + kk] = f2bf(tile[kk * 65 + nn]);
  }
  __syncthreads();
}

DI void phase_prep(const Params& p, char* smem) {
  const size_t gtid = (size_t)blockIdx.x * blockDim.x + threadIdx.x;
  const size_t gn = (size_t)gridDim.x * blockDim.x;
  char* ws = p.ws;
  cvt_stream(p.x, (u16*)(ws + OFF_XB), (size_t)T_ * 1024, gtid, gn);
  cvt_stream(p.mem, (u16*)(ws + OFF_MEMB), (size_t)2048 * 1024, gtid, gn);
  {
    const int lane = threadIdx.x & 63;
    const int gw = (int)(gtid >> 6), nw = (int)(gn >> 6);
    for (int r = gw; r < 2 * 16384; r += nw) {
      const int tbl = r >> 14, row = r & 16383;
      const float* src = (tbl ? p.ex_up : p.ex_down) + (size_t)row * 1024 + lane * 16;
      f32x4 v[4]; float mx = 0.f;
#pragma unroll
      for (int c = 0; c < 4; ++c) {
        v[c] = *reinterpret_cast<const f32x4*>(src + c * 4);
#pragma unroll
        for (int k = 0; k < 4; ++k) mx = fmaxf(mx, fabsf(v[c][k]));
      }
#pragma unroll
      for (int d = 32; d >= 1; d >>= 1) mx = fmaxf(mx, __shfl_xor(mx, d));
      float sc = (mx > 0.f) ? exp2f(floorf(log2f(224.f / mx))) : 1.f;
      u32x4 o;
#pragma unroll
      for (int c = 0; c < 4; ++c) {
        int t = __builtin_amdgcn_cvt_pk_fp8_f32(v[c][0] * sc, v[c][1] * sc, 0, false);
        t = __builtin_amdgcn_cvt_pk_fp8_f32(v[c][2] * sc, v[c][3] * sc, t, true);
        o[c] = (unsigned)t;
      }
      *reinterpret_cast<u32x4*>(ws + (tbl ? OFF_EXU : OFF_EXD) + (size_t)row * 1024 + lane * 16) = o;
      if (lane == 0) ((float*)(ws + OFF_ESC))[r] = 1.f / sc;
    }
  }
  cvt_stream(p.sk1, (u16*)(ws + OFF_SK), (size_t)128 * 128, gtid, gn);
  cvt_stream(p.sk2, (u16*)(ws + OFF_SK) + 128 * 128, (size_t)128 * 128, gtid, gn);
  float* tile = (float*)smem;
  const int n_win = 54 * 16, n_sq = 256, n_pq = 512;
  const int total = n_win + 5 * n_sq + n_pq;
  for (int t = blockIdx.x; t < total; t += gridDim.x) {
    if (t < n_win) {
      transpose_tile<true>(p.w_in, 3384, (u16*)(ws + OFF_WIN), (t & 15) * 64, (t >> 4) * 64, tile);
    } else if (t < n_win + 5 * n_sq) {
      int u = t - n_win; int which = u >> 8; int r = u & 255;
      const float* W = which == 0 ? p.w_out : which == 1 ? p.wq : which == 2 ? p.wk : which == 3 ? p.wv : p.wo;
      size_t off = which == 0 ? OFF_WOUT : which == 1 ? OFF_WQ : which == 2 ? OFF_WK : which == 3 ? OFF_WV : OFF_WO;
      transpose_tile<false>(W, 1024, (u16*)(ws + off), (r & 15) * 64, (r >> 4) * 64, tile);
    } else {
      int r = t - n_win - 5 * n_sq;
      transpose_tile<false>(p.w_pq, 2048, (u16*)(ws + OFF_WPQ), (r & 15) * 64, (r >> 4) * 64, tile);
    }
  }
}

#define WAIT_V(n) asm volatile("s_waitcnt vmcnt(%0)" ::"n"(n) : "memory")
#define RAW_BARRIER() do { asm volatile("s_waitcnt lgkmcnt(0)" ::: "memory"); __builtin_amdgcn_s_barrier(); asm volatile("" ::: "memory"); } while (0)
constexpr int G_STAGE = 384 * 128;
DI void gemm_tile(const u16* __restrict__ X, int ldx, const u16* __restrict__ Wt, int ldw, int K, char* smem,
                  f32x16 (&acc)[2][2]) {
  const int tid = threadIdx.x, lane = tid & 63, wave = tid >> 6;
  const int fw = wave & 1, tq = wave >> 1, lr = lane & 31, lh = lane >> 5;
#pragma unroll
  for (int a = 0; a < 2; ++a)
#pragma unroll
    for (int b = 0; b < 2; ++b) acc[a][b] = zero16();
  const int nk = K / 64;
  const u16* src[6];
#pragma unroll
  for (int i = 0; i < 6; ++i) {
    const int R = 8 * (wave + 8 * i) + (lane >> 3);
    const int c = (lane & 7) ^ ((R >> 1) & 7);
    src[i] = (i < 4) ? (X + (size_t)R * ldx + c * 8) : (Wt + (size_t)(R - 256) * ldw + c * 8);
  }
#define GLDS_STAGE(slot, kt) do { _Pragma("unroll") for (int i = 0; i < 6; ++i) \
    __builtin_amdgcn_global_load_lds((const unsigned*)(src[i] + (kt) * 64), (__attribute__((address_space(3))) unsigned*)(smem + (slot) * G_STAGE + (wave + 8 * i) * 1024), 16, 0, 0); } while (0)
  int offA[2], offB[2], xa[2], xb[2];
#pragma unroll
  for (int ft = 0; ft < 2; ++ft) { const int R = 256 + fw * 64 + ft * 32 + lr; offA[ft] = R * 128; xa[ft] = (R >> 1) & 7; }
#pragma unroll
  for (int tt = 0; tt < 2; ++tt) { const int R = tq * 64 + tt * 32 + lr; offB[tt] = R * 128; xb[tt] = (R >> 1) & 7; }
  GLDS_STAGE(0, 0); GLDS_STAGE(1, 1); WAIT_V(6); RAW_BARRIER();
  int cur = 0;
  for (int kt = 0; kt < nk; ++kt) {
    const int nxt = (cur >= 1) ? cur - 1 : 2;
    if (kt + 2 < nk) GLDS_STAGE(nxt, kt + 2);
    __builtin_amdgcn_sched_barrier(0);
    const char* st = smem + cur * G_STAGE;
#pragma unroll
    for (int ks = 0; ks < 4; ++ks) {
      bf16x8 a[2], b[2];
#pragma unroll
      for (int ft = 0; ft < 2; ++ft) a[ft] = *reinterpret_cast<const bf16x8*>(st + offA[ft] + (((ks * 2 + lh) ^ xa[ft]) << 4));
#pragma unroll
      for (int tt = 0; tt < 2; ++tt) b[tt] = *reinterpret_cast<const bf16x8*>(st + offB[tt] + (((ks * 2 + lh) ^ xb[tt]) << 4));
#pragma unroll
      for (int ft = 0; ft < 2; ++ft)
#pragma unroll
        for (int tt = 0; tt < 2; ++tt) acc[ft][tt] = MFMA(a[ft], b[tt], acc[ft][tt]);
    }
    if (kt + 2 < nk) { WAIT_V(6); } else { WAIT_V(0); }
    RAW_BARRIER();
    cur = (cur == 2) ? 0 : cur + 1;
  }
#undef GLDS_STAGE
}

DI void epi_inproj(const Params& p, int tok0, int f0, f32x16 (&acc)[2][2]) {
  const int tid = threadIdx.x, lane = tid & 63, wave = tid >> 6;
  const int fw = wave & 1, tq = wave >> 1, lr = lane & 31, lh = lane >> 5;
  const int fbase = f0 + fw * 64;
  if (fbase >= 3392) return;
  u16* tm = (u16*)(p.ws + OFF_TM);
#pragma unroll
  for (int tt = 0; tt < 2; ++tt) {
    const int tok = tok0 + tq * 64 + tt * 32 + lr;
    const float posf = (float)p.positions[tok];
    const int bb = tok >> 12, ss = tok & 4095;
    if (fbase < 1024) {
#pragma unroll
      for (int r = 0; r < 4; ++r) {
        float j = (float)(4 * lh + r);
        float inv = exp2f(-j * (18.931568569324174f / 8.0f));
        float sn, cs; sincos_rad(posf * inv, sn, cs);
        float x1 = acc[0][tt][r], x2 = acc[0][tt][r + 4];
        acc[0][tt][r] = x1 * cs - x2 * sn;
        acc[0][tt][r + 4] = x2 * cs + x1 * sn;
      }
      if (fbase < 512) {
#pragma unroll
        for (int ft = 0; ft < 2; ++ft)
#pragma unroll
          for (int g = 0; g < 4; ++g)
            st4bf(tm + (size_t)tok * TMW + fbase + ft * 32 + 8 * g + 4 * lh, acc[ft][tt][4 * g], acc[ft][tt][4 * g + 1], acc[ft][tt][4 * g + 2], acc[ft][tt][4 * g + 3]);
      } else {
        u16* kfr = (u16*)(p.ws + OFF_KFR);
        const int head = (fbase - 512) >> 6, gt = ss >> 5;
#pragma unroll
        for (int ft = 0; ft < 2; ++ft)
#pragma unroll
          for (int g = 0; g < 4; ++g) {
            const int ks = ft * 2 + (g >> 1), lane2 = (g & 1) * 32 + lr;
            st4bf(kfr + ((((size_t)(bb * 8 + head) * 128 + gt) * 4 + ks) * 64 + lane2) * 8 + 4 * lh, acc[ft][tt][4 * g], acc[ft][tt][4 * g + 1], acc[ft][tt][4 * g + 2], acc[ft][tt][4 * g + 3]);
          }
      }
    } else if (fbase < 1536) {
      u16* vfr = (u16*)(p.ws + OFF_VT);
      const int head = (fbase - 1024) >> 6, gt = ss >> 5;
      const int s = lr >> 4, r16 = lr & 15, j = 4 * (r16 >> 3) + (r16 & 3), lh2 = (r16 >> 2) & 1;
#pragma unroll
      for (int ft = 0; ft < 2; ++ft)
#pragma unroll
        for (int i = 0; i < 16; ++i) {
          const int lane2 = lh2 * 32 + crow(i, lh);
          vfr[((((((size_t)(bb * 8 + head) * 128 + gt) * 2 + ft) * 2 + s) * 64 + lane2) * 8) + j] = f2bf(acc[ft][tt][i]);
        }
    } else if (fbase >= 2368 && fbase < 2880) {
      u16* vt = (u16*)(p.ws + OFF_GVT);
      const int fo = fbase - 2368;
#pragma unroll
      for (int ft = 0; ft < 2; ++ft)
#pragma unroll
        for (int i = 0; i < 16; ++i) {
          int feat = fo + ft * 32 + crow(i, lh);
          vt[((size_t)bb * 512 + feat) * 4096 + ss] = f2bf(acc[ft][tt][i]);
        }
    } else {
      int colbase;
      if (fbase < 1856) {
#pragma unroll
        for (int ft = 0; ft < 2; ++ft) {
          const bool rot = (fbase < 1792) || (ft == 0);
#pragma unroll
          for (int r = 0; r < 4; ++r) {
            float v = acc[ft][tt][r];
            float o = __shfl_xor(v, 32);
            float inv = exp2f(-(float)r * (18.931568569324174f / 4.0f));
            float sn, cs; sincos_rad(posf * inv, sn, cs);
            float res = (lh == 0) ? (v * cs - o * sn) : (v * cs + o * sn);
            acc[ft][tt][r] = rot ? res : v;
          }
        }
        colbase = fbase - 512;
      } else if (fbase < 2368) {
        colbase = fbase - 512;
      } else {
        colbase = fbase - 1024;
      }
#pragma unroll
      for (int ft = 0; ft < 2; ++ft)
#pragma unroll
        for (int g = 0; g < 4; ++g)
          st4bf(tm + (size_t)tok * TMW + colbase + ft * 32 + 8 * g + 4 * lh, acc[ft][tt][4 * g], acc[ft][tt][4 * g + 1], acc[ft][tt][4 * g + 2], acc[ft][tt][4 * g + 3]);
    }
  }
}

DI void phase_inproj(const Params& p, char* smem) {
  const int n_in = 128 * 27;
  const int total = n_in + 128;
  const u16* xb = (const u16*)(p.ws + OFF_XB);
  const u16* memb = (const u16*)(p.ws + OFF_MEMB);
  const int tid = threadIdx.x, lane = tid & 63, wave = tid >> 6;
  const int fw = wave & 1, tq = wave >> 1, lr = lane & 31, lh = lane >> 5;
  for (int t = blockIdx.x; t < total; t += gridDim.x) {
    f32x16 acc[2][2];
    if (t < n_in) {
      int mt = t / 27, nt = t % 27;
      gemm_tile(xb + (size_t)mt * 256 * 1024, 1024, (const u16*)(p.ws + OFF_WIN) + (size_t)nt * 128 * 1024, 1024, 1024, smem, acc);
      epi_inproj(p, mt * 256, nt * 128, acc);
    } else {
      int u = t - n_in; int which = u >> 6; int r = u & 63; int mt = r >> 3, nt = r & 7;
      const u16* W = (const u16*)(p.ws + (which == 0 ? OFF_WK : OFF_WV));
      gemm_tile(memb + (size_t)mt * 256 * 1024, 1024, W + (size_t)nt * 128 * 1024, 1024, 1024, smem, acc);
#pragma unroll
      for (int tt = 0; tt < 2; ++tt) {
        const int tok = mt * 256 + tq * 64 + tt * 32 + lr;
        const int bb = tok >> 8, mm = tok & 255, hh = nt >> 1, kt = mm >> 5;
        if (which == 0) {
          u16* mk = (u16*)(p.ws + OFF_MEMK);
#pragma unroll
          for (int ft = 0; ft < 2; ++ft)
#pragma unroll
            for (int g = 0; g < 4; ++g) {
              const int ks = (nt & 1) * 8 + fw * 4 + ft * 2 + (g >> 1), lane2 = (g & 1) * 32 + lr;
              st4bf(mk + ((((size_t)(bb * 4 + hh) * 8 + kt) * 16 + ks) * 64 + lane2) * 8 + 4 * lh, acc[ft][tt][4 * g], acc[ft][tt][4 * g + 1], acc[ft][tt][4 * g + 2], acc[ft][tt][4 * g + 3]);
            }
        } else {
          u16* mv = (u16*)(p.ws + OFF_MEMVT);
          const int s = lr >> 4, r16 = lr & 15, j = 4 * (r16 >> 3) + (r16 & 3), lh2 = (r16 >> 2) & 1;
#pragma unroll
          for (int ft = 0; ft < 2; ++ft) {
            const int dt = (nt & 1) * 4 + fw * 2 + ft;
#pragma unroll
            for (int i = 0; i < 16; ++i) {
              const int lane2 = lh2 * 32 + crow(i, lh);
              mv[((((((size_t)(bb * 4 + hh) * 8 + dt) * 8 + kt) * 2 + s) * 64 + lane2) * 8) + j] = f2bf(acc[ft][tt][i]);
            }
          }
        }
      }
    }
  }
}

DI void idx_scores(const bf16x8 (&qf)[8][2], const float (&wq)[8], bf16x8 k0, bf16x8 k1, float (&sc)[16]) {
#pragma unroll
  for (int i = 0; i < 16; ++i) sc[i] = 0.f;
#pragma unroll
  for (int hd = 0; hd < 8; ++hd) {
    f32x16 a = zero16();
    a = MFMA(k0, qf[hd][0], a);
    a = MFMA(k1, qf[hd][1], a);
#pragma unroll
    for (int i = 0; i < 16; ++i) sc[i] = fmaf(wq[hd], fmaxf(a[i], 0.f), sc[i]);
  }
}

DI void load_idx_q(const u16* tm, int tok, int lh, bf16x8 (&qf)[8][2], float (&wq)[8]) {
  const u16* row = tm + (size_t)tok * TMW;
#pragma unroll
  for (int hd = 0; hd < 8; ++hd)
#pragma unroll
    for (int ks = 0; ks < 2; ++ks) qf[hd][ks] = ldg8(row + TM_QI + hd * 32 + ks * 16 + lh * 8);
  bf16x8 w8 = ldg8(row + TM_WI);
#pragma unroll
  for (int hd = 0; hd < 8; ++hd) wq[hd] = bf2f((u16)w8[hd]) * 0.0625f;
}

DI int wave_incl_scan(int v, int lane) {
#pragma unroll
  for (int d = 1; d < 64; d <<= 1) {
    int t = __shfl_up(v, d);
    if (lane >= d) v += t;
  }
  return v;
}

DI void dsa_thr_item(const Params& p, int b, int qblk, char* smem) {
  unsigned* hist = (unsigned*)smem;
  unsigned* pref = (unsigned*)(smem + 32768);
  int* rank = (int*)(smem + 32768 + 128);
  const u16* tm = (const u16*)(p.ws + OFF_TM);
  const int tid = threadIdx.x, lane = tid & 63, wave = tid >> 6, lr = lane & 31, lh = lane >> 5;
  const int q0 = qblk * 32;
  u16* qi = (u16*)(smem + 33280);
  for (int i = tid; i < 32 * 32; i += 512) {
    int q = i >> 5, ch = i & 31;
    *reinterpret_cast<u32x4*>(qi + q * 296 + ch * 8) = *reinterpret_cast<const u32x4*>(tm + (size_t)(b * S_ + q0 + q) * TMW + TM_QI + ch * 8);
  }
  float wq[8];
  {
    bf16x8 w8 = ldg8(tm + (size_t)(b * S_ + q0 + lr) * TMW + TM_WI);
#pragma unroll
    for (int hd = 0; hd < 8; ++hd) wq[hd] = bf2f((u16)w8[hd]) * 0.0625f;
  }
  __syncthreads();
  for (int i = tid; i < 32 * 32; i += 512) {
    const int q = i >> 5, d = i & 31;
    float acc = 0.f;
#pragma unroll
    for (int hd = 0; hd < 8; ++hd) acc = fmaf(bf2f(tm[(size_t)(b * S_ + q0 + q) * TMW + TM_WI + hd]) * 0.0625f, bf2f(qi[q * 296 + hd * 32 + d]), acc);
    qi[q * 296 + 256 + d] = f2bf(acc);
  }
  const u16* qil = qi + lr * 296 + lh * 8;
  if (tid < 32) { pref[tid] = 0u; rank[tid] = min(256, q0 + tid + 1); }
  for (int pass = 0; pass < 4; ++pass) {
    for (int i = tid; i < 8192; i += 512) hist[i] = 0u;
    __syncthreads();
    const int shift = 24 - 8 * pass;
    const unsigned mypref = pref[lr];
    const u16* kib = tm + (size_t)(b * S_ + lr) * TMW + TM_KI + lh * 8;
    bf16x8 kn0, kn1;
    {
      const int kt0 = min(wave, qblk);
      kn0 = ldg8(kib + (size_t)(kt0 * 32) * TMW); kn1 = ldg8(kib + (size_t)(kt0 * 32) * TMW + 16);
    }
    for (int kt = wave; kt <= qblk; kt += 8) {
      const bf16x8 k0 = kn0, k1 = kn1;
      {
        const int ktn = min(kt + 8, qblk);
        kn0 = ldg8(kib + (size_t)(ktn * 32) * TMW); kn1 = ldg8(kib + (size_t)(ktn * 32) * TMW + 16);
      }
      float sc[16];
      {
        f32x16 a = zero16();
        a = MFMA(k0, *reinterpret_cast<const bf16x8*>(qil + 256), a);
        a = MFMA(k1, *reinterpret_cast<const bf16x8*>(qil + 256 + 16), a);
#pragma unroll
        for (int i = 0; i < 16; ++i) sc[i] = 0.5f * a[i];
      }
#pragma unroll
      for (int hd = 0; hd < 8; ++hd) {
        f32x16 a = zero16();
        a = MFMA(k0, *reinterpret_cast<const bf16x8*>(qil + hd * 32), a);
        a = MFMA(k1, *reinterpret_cast<const bf16x8*>(qil + hd * 32 + 16), a);
        const float wh = 0.5f * wq[hd];
#pragma unroll
        for (int i = 0; i < 16; ++i) sc[i] = fmaf(fabsf(a[i]), wh, sc[i]);
      }
#pragma unroll
      for (int i = 0; i < 16; ++i) {
        int kp = kt * 32 + crow(i, lh);
        unsigned ky = fkey(sc[i]);
        unsigned hi = (ky >> shift);
        if (kp <= q0 + lr && (hi >> 8) == mypref) atomicAdd(&hist[(hi & 255u) * 32 + lr], 1u);
      }
    }
    __syncthreads();
#pragma unroll 1
    for (int qq = 0; qq < 4; ++qq) {
      const int q = wave * 4 + qq;
      const int rk = rank[q];
      int c[4];
#pragma unroll
      for (int j = 0; j < 4; ++j) c[j] = (int)hist[(255 - 4 * lane - j) * 32 + q];
      int s = c[0] + c[1] + c[2] + c[3];
      int P = wave_incl_scan(s, lane);
      int excl = P - s;
      if (P >= rk && excl < rk) {
        int cum = excl; int bin = 0; int nr = 1; bool found = false;
#pragma unroll
        for (int j = 0; j < 4; ++j) {
          if (!found && cum + c[j] >= rk) { bin = 255 - 4 * lane - j; nr = rk - cum; found = true; }
          if (!found) cum += c[j];
        }
        pref[q] = (pref[q] << 8) | (unsigned)bin;
        rank[q] = nr;
      }
    }
    __syncthreads();
  }
  if (tid < 32) ((unsigned*)(p.ws + OFF_THR))[b * S_ + q0 + tid] = pref[tid];
  __syncthreads();
}

DI void dsa_attn_item(const Params& p, int b, int qblk, char* smem) {
  u16* maskbuf = (u16*)smem;
  u16* qi = (u16*)(smem + 4096);
  const u16* tm = (const u16*)(p.ws + OFF_TM);
  const u16* vfr = (const u16*)(p.ws + OFF_VT) + ((size_t)(b * 8 + (threadIdx.x >> 6)) * 128) * 2048 + (threadIdx.x & 63) * 8;
  const u16* kfr = (const u16*)(p.ws + OFF_KFR) + ((size_t)(b * 8 + (threadIdx.x >> 6)) * 128) * 2048 + (threadIdx.x & 63) * 8;
  const unsigned* thr = (const unsigned*)(p.ws + OFF_THR);
  const int tid = threadIdx.x, lane = tid & 63, wave = tid >> 6, lr = lane & 31, lh = lane >> 5;
  const int q0 = qblk * 32;
  const int head = wave;
  const int qtok = b * S_ + q0 + lr;
  bf16x8 Qf[4];
#pragma unroll
  for (int ks = 0; ks < 4; ++ks) {
    bf16x8 raw = ldg8(tm + (size_t)qtok * TMW + TM_Q + head * 64 + ks * 16 + lh * 8);
    float f[8];
#pragma unroll
    for (int j = 0; j < 8; ++j) f[j] = bf2f((u16)raw[j]) * 0.125f;
    Qf[ks] = pack8(f[0], f[1], f[2], f[3], f[4], f[5], f[6], f[7]);
  }
  f32x16 O[2];
  O[0] = zero16(); O[1] = zero16();
  float mrun = -INFINITY, lrun = 0.f;
  const unsigned thrq = thr[qtok];
  const int nchunks = (q0 + 31) / 256 + 1;
  for (int i = tid; i < 32 * 32; i += 512) {
    int q = i >> 5, ch = i & 31;
    *reinterpret_cast<u32x4*>(qi + q * 296 + ch * 8) = *reinterpret_cast<const u32x4*>(tm + (size_t)(b * S_ + q0 + q) * TMW + TM_QI + ch * 8);
  }
  float* wqs = (float*)(smem + 4096 + 32 * 296 * 2);
  if (tid < 256) wqs[tid] = bf2f(tm[(size_t)(b * S_ + q0 + (tid & 31)) * TMW + TM_WI + (tid >> 5)]) * 0.0625f;
  __syncthreads();
  for (int i = tid; i < 32 * 32; i += 512) {
    const int q = i >> 5, d = i & 31;
    float acc = 0.f;
#pragma unroll
    for (int hd = 0; hd < 8; ++hd) acc = fmaf(bf2f(tm[(size_t)(b * S_ + q0 + q) * TMW + TM_WI + hd]) * 0.0625f, bf2f(qi[q * 296 + hd * 32 + d]), acc);
    qi[q * 296 + 256 + d] = f2bf(acc);
  }
  __syncthreads();
  const u16* qil = qi + lr * 296 + lh * 8;
  const u16* kibase = tm + (size_t)(b * S_ + lr) * TMW + TM_KI + lh * 8;
  bf16x8 Kf[4], Kn[4];
#pragma unroll
  for (int ks = 0; ks < 4; ++ks) Kf[ks] = ldg8(kfr + ks * 512);
  bf16x8 Vf[2][2], Vn[2][2];
#pragma unroll
  for (int dt = 0; dt < 2; ++dt)
#pragma unroll
    for (int s = 0; s < 2; ++s) Vf[dt][s] = ldg8(vfr + (dt * 2 + s) * 512);
  bf16x8 ki0, ki1;
  {
    const int kt0 = min(wave, qblk);
    ki0 = ldg8(kibase + (size_t)(kt0 * 32) * TMW); ki1 = ldg8(kibase + (size_t)(kt0 * 32) * TMW + 16);
  }
  for (int c = 0; c < nchunks; ++c) {
    const int buf = c & 1;
    {
      const int key0 = (c * 8 + wave) * 32;
      unsigned bits = 0u;
      const bf16x8 k0 = ki0, k1 = ki1;
      {
        const int ktn = min((c + 1) * 8 + wave, qblk);
        ki0 = ldg8(kibase + (size_t)(ktn * 32) * TMW); ki1 = ldg8(kibase + (size_t)(ktn * 32) * TMW + 16);
      }
      if (key0 <= q0 + 31) {
        float sc[16];
        {
          f32x16 a = zero16();
          a = MFMA(k0, *reinterpret_cast<const bf16x8*>(qil + 256), a);
          a = MFMA(k1, *reinterpret_cast<const bf16x8*>(qil + 256 + 16), a);
#pragma unroll
          for (int i = 0; i < 16; ++i) sc[i] = 0.5f * a[i];
        }
#pragma unroll 2
        for (int hd = 0; hd < 8; ++hd) {
          f32x16 a = zero16();
          a = MFMA(k0, *reinterpret_cast<const bf16x8*>(qil + hd * 32), a);
          a = MFMA(k1, *reinterpret_cast<const bf16x8*>(qil + hd * 32 + 16), a);
          const float wh = 0.5f * wqs[hd * 32 + lr];
#pragma unroll
          for (int i = 0; i < 16; ++i) sc[i] = fmaf(fabsf(a[i]), wh, sc[i]);
        }
        __builtin_amdgcn_sched_barrier(0);
#pragma unroll
        for (int i = 0; i < 16; ++i) {
          int kp = key0 + crow(i, lh);
          if (kp <= q0 + lr && fkey(sc[i]) >= thrq) bits |= (1u << i);
        }
      }
      maskbuf[(buf * 8 + wave) * 64 + lane] = (u16)bits;
    }
    __syncthreads();
#pragma unroll 1
    for (int t8 = 0; t8 < 8; ++t8) {
      const int g = c * 8 + t8;
      if (g > qblk) break;
      {
        const int gn = min(g + 1, qblk);
        const u16* kr = kfr + (size_t)gn * 2048;
#pragma unroll
        for (int ks = 0; ks < 4; ++ks) Kn[ks] = ldg8(kr + ks * 512);
#pragma unroll
        for (int dt = 0; dt < 2; ++dt)
#pragma unroll
          for (int s = 0; s < 2; ++s) Vn[dt][s] = ldg8(vfr + (size_t)gn * 2048 + (dt * 2 + s) * 512);
      }

      const unsigned bits = maskbuf[(buf * 8 + t8) * 64 + lane];
      f32x16 Sx = zero16();
#pragma unroll
      for (int ks = 0; ks < 4; ++ks) Sx = MFMA(Kf[ks], Qf[ks], Sx);
      float mt = -INFINITY;
#pragma unroll
      for (int i = 0; i < 16; ++i) mt = ((bits >> i) & 1u) ? fmaxf(mt, Sx[i]) : mt;
      mt = fmaxf(mt, __shfl_xor(mt, 32));
      const float mnew = fmaxf(mrun, mt);
      const float msafe = (mnew == -INFINITY) ? 0.f : mnew;
      const float alpha = __expf(mrun - msafe);
      float pv[16]; float ps = 0.f;
#pragma unroll
      for (int i = 0; i < 16; ++i) { pv[i] = ((bits >> i) & 1u) ? __expf(Sx[i] - msafe) : 0.f; ps += pv[i]; }
      lrun = lrun * alpha + ps;
      mrun = mnew;
      if (__builtin_amdgcn_ballot_w64(alpha != 1.f) != 0ull) {
#pragma unroll
        for (int dt = 0; dt < 2; ++dt)
#pragma unroll
          for (int i = 0; i < 16; ++i) O[dt][i] *= alpha;
      }
      bf16x8 Pf[2];
#pragma unroll
      for (int s = 0; s < 2; ++s) Pf[s] = pack8(pv[8 * s], pv[8 * s + 1], pv[8 * s + 2], pv[8 * s + 3], pv[8 * s + 4], pv[8 * s + 5], pv[8 * s + 6], pv[8 * s + 7]);
#pragma unroll
      for (int dt = 0; dt < 2; ++dt)
#pragma unroll
        for (int s = 0; s < 2; ++s) O[dt] = MFMA(Vf[dt][s], Pf[s], O[dt]);
#pragma unroll
      for (int ks = 0; ks < 4; ++ks) Kf[ks] = Kn[ks];
#pragma unroll
      for (int dt = 0; dt < 2; ++dt)
#pragma unroll
        for (int s = 0; s < 2; ++s) Vf[dt][s] = Vn[dt][s];
    }
  }
  u16* y = (u16*)(p.ws + OFF_XB);
  {
    float lt = lrun + __shfl_xor(lrun, 32);
    float inv = 1.f / lt;
#pragma unroll
    for (int dt = 0; dt < 2; ++dt)
#pragma unroll
      for (int g = 0; g < 4; ++g)
        st4bf(y + (size_t)qtok * 1024 + head * 64 + dt * 32 + 8 * g + 4 * lh, O[dt][4 * g] * inv, O[dt][4 * g + 1] * inv, O[dt][4 * g + 2] * inv, O[dt][4 * g + 3] * inv);
  }
  __syncthreads();
}

DI void gla_bcum(const Params& p, int b, int h, int n, float* bc, float* glr_s, float* segtot) {
  const u16* tm = (const u16*)(p.ws + OFF_TM);
  const int tid = threadIdx.x;
  const int tok0 = b * S_ + n * 64;
  for (int i = tid; i < 1024; i += 512) glr_s[i] = bf2f(tm[(size_t)(tok0 + (i >> 4)) * TMW + TM_GLR + (i & 15)]);
  const int d = tid & 63, cgp = tid >> 6;
  float gu[16];
#pragma unroll
  for (int j = 0; j < 16; ++j) gu[j] = p.gate_up[j * 256 + h * 64 + d];
  const float bias = p.gate_bias[h * 64 + d];
  __syncthreads();
  float v[8]; float run = 0.f;
#pragma unroll
  for (int r = 0; r < 8; ++r) {
    const int c = cgp * 8 + r;
    float z = bias;
#pragma unroll
    for (int j = 0; j < 16; ++j) z = fmaf(glr_s[c * 16 + j], gu[j], z);
    float la = (fminf(z, 0.f) - log1pf(__expf(-fabsf(z)))) * 0.0625f;
    run += la; v[r] = run;
  }
  segtot[cgp * 64 + d] = run;
  __syncthreads();
  float off = 0.f;
#pragma unroll
  for (int g = 0; g < 8; ++g) off += (g < cgp) ? segtot[g * 64 + d] : 0.f;
#pragma unroll
  for (int r = 0; r < 8; ++r) bc[(cgp * 8 + r) * 64 + d] = off + v[r];
  __syncthreads();
}

DI void gla_g1_item(const Params& p, int item, char* smem) {
  float* bc = (float*)smem;
  float* glr_s = (float*)(smem + 16384);
  float* segtot = (float*)(smem + 20480);
  u16* KeT = (u16*)(smem + 22528);
  const int b = item >> 8, h = (item >> 6) & 3, n = item & 63;
  const u16* tm = (const u16*)(p.ws + OFF_TM);
  const u16* gvT = (const u16*)(p.ws + OFF_GVT);
  const int tid = threadIdx.x, lane = tid & 63, wave = tid >> 6, lr = lane & 31, lh = lane >> 5;
  const int tok0 = b * S_ + n * 64;
  u16 kraw[8];
  {
    const int d = tid & 63, cgp = tid >> 6;
#pragma unroll
    for (int r = 0; r < 8; ++r) kraw[r] = tm[(size_t)(tok0 + cgp * 8 + r) * TMW + TM_GK + h * 64 + d];
  }
  bf16x8 afr[4];
  {
    const int et = wave & 3;
    const u16* arow = gvT + ((size_t)b * 512 + h * 128 + et * 32 + lr) * 4096 + n * 64 + lh * 8;
#pragma unroll
    for (int ks = 0; ks < 4; ++ks) afr[ks] = ldg8(arow + ks * 16);
  }
  gla_bcum(p, b, h, n, bc, glr_s, segtot);
  {
    const int d = tid & 63, cgp = tid >> 6;
    const float blast = bc[63 * 64 + d];
    {
      float* bcg = (float*)(p.ws + OFF_BCG) + (size_t)item * 4096;
#pragma unroll
      for (int r = 0; r < 8; ++r) bcg[(cgp * 8 + r) * 64 + d] = bc[(cgp * 8 + r) * 64 + d];
    }
    float f[8];
#pragma unroll
    for (int r = 0; r < 8; ++r) {
      const int c = cgp * 8 + r;
      float kv = bf2f(kraw[r]);
      f[r] = kv * __expf(blast - bc[c * 64 + d]);
    }
    *reinterpret_cast<bf16x8*>(KeT + d * 72 + cgp * 8) = pack8(f[0], f[1], f[2], f[3], f[4], f[5], f[6], f[7]);
    if (cgp == 0) ((float*)(p.ws + OFF_DECAY))[item * 64 + d] = __expf(blast);
  }
  __syncthreads();
  {
    const int et = wave & 3, dtl = wave >> 2;
    f32x16 acc = zero16();
#pragma unroll
    for (int ks = 0; ks < 4; ++ks) {
      bf16x8 a = afr[ks];
      bf16x8 bb = *reinterpret_cast<const bf16x8*>(KeT + (dtl * 32 + lr) * 72 + ks * 16 + lh * 8);
      acc = MFMA(a, bb, acc);
    }
    float* kvT = (float*)(p.ws + OFF_KVT);
#pragma unroll
    for (int i = 0; i < 16; ++i) kvT[((size_t)item * 128 + et * 32 + crow(i, lh)) * 64 + dtl * 32 + lr] = acc[i];
  }
  __syncthreads();
}

DI void gla_scan(const Params& p) {
  const float* kvT = (const float*)(p.ws + OFF_KVT);
  const float* decay = (const float*)(p.ws + OFF_DECAY);
  u16* prev = (u16*)(p.ws + OFF_PREV);
  const int gtid = blockIdx.x * blockDim.x + threadIdx.x;
  const int gn = gridDim.x * blockDim.x;
  for (int u = gtid; u < 32 * 2048; u += gn) {
    const int bh = u >> 11, rem = u & 2047, e = rem >> 4, d4 = (rem & 15) * 4;
    f32x4 st = {0.f, 0.f, 0.f, 0.f};
#pragma unroll 4
    for (int n = 0; n < 64; ++n) {
      const int item = bh * 64 + n;
      st4bf(prev + ((size_t)item * 128 + e) * 64 + d4, st[0], st[1], st[2], st[3]);
      f32x4 dc = *reinterpret_cast<const f32x4*>(decay + item * 64 + d4);
      f32x4 kv = *reinterpret_cast<const f32x4*>(kvT + ((size_t)item * 128 + e) * 64 + d4);
      st = dc * st + kv;
    }
  }
}

DI void gla_g3_item(const Params& p, int item, char* smem) {
  float* red = (float*)smem;
  const int b = item >> 8, h = (item >> 6) & 3, n = item & 63;
  const u16* tm = (const u16*)(p.ws + OFF_TM);
  const u16* gvT = (const u16*)(p.ws + OFF_GVT);
  const u16* prev = (const u16*)(p.ws + OFF_PREV);
  const float* bcg = (const float*)(p.ws + OFF_BCG) + (size_t)item * 4096;
  const int tid = threadIdx.x, lane = tid & 63, wave = tid >> 6, lr = lane & 31, lh = lane >> 5;
  const int tok0 = b * S_ + n * 64;
  const int et = wave & 3, ct = wave >> 2;
  bf16x8 qraw[4], kraw[2][4], sfr[4];
  bf16x4 vlo[2][2], vhi[2][2];
  f32x4 bq[4][2];
  {
    const u16* vrow0 = gvT + ((size_t)b * 512 + h * 128 + et * 32 + lr) * 4096 + n * 64 + 4 * lh;
    const u16* srow0 = prev + ((size_t)item * 128 + et * 32 + lr) * 64 + lh * 8;
#pragma unroll
    for (int ks = 0; ks < 4; ++ks) {
      qraw[ks] = ldg8(tm + (size_t)(tok0 + ct * 32 + lr) * TMW + TM_GQ + h * 64 + ks * 16 + lh * 8);
      kraw[0][ks] = ldg8(tm + (size_t)(tok0 + lr) * TMW + TM_GK + h * 64 + ks * 16 + lh * 8);
      kraw[1][ks] = ldg8(tm + (size_t)(tok0 + ct * 32 + lr) * TMW + TM_GK + h * 64 + ks * 16 + lh * 8);
      sfr[ks] = ldg8(srow0 + ks * 16);
      bq[ks][0] = *reinterpret_cast<const f32x4*>(bcg + (ct * 32 + lr) * 64 + ks * 16 + lh * 8);
      bq[ks][1] = *reinterpret_cast<const f32x4*>(bcg + (ct * 32 + lr) * 64 + ks * 16 + lh * 8 + 4);
    }
#pragma unroll
    for (int st = 0; st < 2; ++st)
#pragma unroll
      for (int s2 = 0; s2 < 2; ++s2) {
        const u16* vp = vrow0 + (st * ct) * 32 + 16 * s2;
        vlo[st][s2] = *reinterpret_cast<const bf16x4*>(vp);
        vhi[st][s2] = *reinterpret_cast<const bf16x4*>(vp + 8);
      }
  }
  bf16x8 Qd[4];
#pragma unroll
  for (int ks = 0; ks < 4; ++ks) {
    float f[8];
#pragma unroll
    for (int j = 0; j < 8; ++j) f[j] = bf2f((u16)qraw[ks][j]) * 0.125f * __expf(bq[ks][j >> 2][j & 3]);
    Qd[ks] = pack8(f[0], f[1], f[2], f[3], f[4], f[5], f[6], f[7]);
  }
  f32x16 O = zero16();
#pragma unroll
  for (int st = 0; st < 2; ++st) {
    if (st <= ct) {
      f32x16 A = zero16();
      const int s = st * 32 + lr;
#pragma unroll
      for (int ks = 0; ks < 4; ++ks) {
        f32x4 b0 = (st == 1) ? bq[ks][0] : *reinterpret_cast<const f32x4*>(bcg + s * 64 + ks * 16 + lh * 8);
        f32x4 b1 = (st == 1) ? bq[ks][1] : *reinterpret_cast<const f32x4*>(bcg + s * 64 + ks * 16 + lh * 8 + 4);
        float f[8];
#pragma unroll
        for (int j = 0; j < 8; ++j) f[j] = bf2f((u16)kraw[st][ks][j]) * __expf(-((j < 4) ? b0[j & 3] : b1[j & 3]));
        bf16x8 Ki = pack8(f[0], f[1], f[2], f[3], f[4], f[5], f[6], f[7]);
        A = MFMA(Ki, Qd[ks], A);
      }
      float pv[16];
#pragma unroll
      for (int i = 0; i < 16; ++i) pv[i] = (st * 32 + crow(i, lh) <= ct * 32 + lr) ? A[i] : 0.f;
#pragma unroll
      for (int s2 = 0; s2 < 2; ++s2) {
        bf16x8 Pf = pack8(pv[8 * s2], pv[8 * s2 + 1], pv[8 * s2 + 2], pv[8 * s2 + 3], pv[8 * s2 + 4], pv[8 * s2 + 5], pv[8 * s2 + 6], pv[8 * s2 + 7]);
        O = MFMA(cat44(vlo[st][s2], vhi[st][s2]), Pf, O);
      }
    }
  }
#pragma unroll
  for (int ks = 0; ks < 4; ++ks) O = MFMA(sfr[ks], Qd[ks], O);
  float ss = 0.f;
#pragma unroll
  for (int i = 0; i < 16; ++i) ss += O[i] * O[i];
  ss += __shfl_xor(ss, 32);
  if (lh == 0) red[(ct * 4 + et) * 32 + lr] = ss;
  __syncthreads();
  const float tot = red[(ct * 4 + 0) * 32 + lr] + red[(ct * 4 + 1) * 32 + lr] + red[(ct * 4 + 2) * 32 + lr] + red[(ct * 4 + 3) * 32 + lr];
  const float rinv = rsqrtf(tot * (1.f / 128.f) + 1e-6f);
  const int tok = tok0 + ct * 32 + lr;
  u16* y = (u16*)(p.ws + OFF_XB);
#pragma unroll
  for (int g = 0; g < 4; ++g) {
    const int e0 = et * 32 + 8 * g + 4 * lh;
    u32x2 gr = *reinterpret_cast<const u32x2*>(tm + (size_t)tok * TMW + TM_GR + h * 128 + e0);
    f32x4 ng = *reinterpret_cast<const f32x4*>(p.norm_g + e0);
    float grv[4] = {bflo(gr[0]), bfhi(gr[0]), bflo(gr[1]), bfhi(gr[1])};
    float o[4];
#pragma unroll
    for (int r = 0; r < 4; ++r) {
      float sl = grv[r] / (1.f + __expf(-grv[r]));
      o[r] = O[4 * g + r] * rinv * ng[r] * sl;
    }
    st4bf(y + (size_t)tok * 1024 + 512 + h * 128 + e0, o[0], o[1], o[2], o[3]);
  }
  __syncthreads();
}

template <int MODE>
DI void phase_gemm(const Params& p, const u16* X, const u16* Wt, int N, const float* resid, float* outf, u16* outb, int ldo, char* smem) {
  const int ntn = N / 128;
  const int total = 128 * ntn;
  const int tid = threadIdx.x, lane = tid & 63, wave = tid >> 6;
  const int fw = wave & 1, tq = wave >> 1, lr = lane & 31, lh = lane >> 5;
  for (int t = blockIdx.x; t < total; t += gridDim.x) {
    const int mt = t / ntn, nt = t % ntn;
    f32x16 acc[2][2];
    gemm_tile(X + (size_t)mt * 256 * 1024, 1024, Wt + (size_t)nt * 128 * 1024, 1024, 1024, smem, acc);
#pragma unroll
    for (int tt = 0; tt < 2; ++tt) {
      const int tok = mt * 256 + tq * 64 + tt * 32 + lr;
#pragma unroll
      for (int ft = 0; ft < 2; ++ft)
#pragma unroll
        for (int g = 0; g < 4; ++g) {
          const int f = nt * 128 + fw * 64 + ft * 32 + 8 * g + 4 * lh;
          if (MODE == 0) {
            f32x4 r = *reinterpret_cast<const f32x4*>(resid + (size_t)tok * 1024 + f);
            f32x4 o;
#pragma unroll
            for (int k = 0; k < 4; ++k) o[k] = ALPHA * r[k] + acc[ft][tt][4 * g + k];
            *reinterpret_cast<f32x4*>(outf + (size_t)tok * 1024 + f) = o;
          } else if (MODE == 1) {
            st4bf(outb + (size_t)tok * ldo + f, acc[ft][tt][4 * g], acc[ft][tt][4 * g + 1], acc[ft][tt][4 * g + 2], acc[ft][tt][4 * g + 3]);
          } else {
            const int hh = f >> 8, fh = f & 255, ks = fh >> 4, lane2 = ((fh >> 3) & 1) * 32 + lr;
            st4bf(outb + ((((size_t)(tok >> 5) * 4 + hh) * 16 + ks) * 64 + lane2) * 8 + 4 * lh, acc[ft][tt][4 * g], acc[ft][tt][4 * g + 1], acc[ft][tt][4 * g + 2], acc[ft][tt][4 * g + 3]);
          }
        }
    }
  }
}

DI void phase_ln(const Params& p, float* h, u16* hb, const float* g, const float* bta) {
  const int lane = threadIdx.x & 63;
  const int gw = (blockIdx.x * blockDim.x + threadIdx.x) >> 6;
  const int nw = (gridDim.x * blockDim.x) >> 6;
  for (int row = gw; row < T_; row += nw) {
    float* r = h + (size_t)row * 1024;
    f32x4 v[4]; float s = 0.f;
#pragma unroll
    for (int c = 0; c < 4; ++c) { v[c] = *reinterpret_cast<const f32x4*>(r + c * 256 + lane * 4); s += v[c][0] + v[c][1] + v[c][2] + v[c][3]; }
    const float mean = wave_sum(s) * (1.f / 1024.f);
    float q = 0.f;
#pragma unroll
    for (int c = 0; c < 4; ++c)
#pragma unroll
      for (int k = 0; k < 4; ++k) { float d = v[c][k] - mean; q += d * d; }
    const float rstd = rsqrtf(wave_sum(q) * (1.f / 1024.f) + 1e-5f);
#pragma unroll
    for (int c = 0; c < 4; ++c) {
      f32x4 gg = *reinterpret_cast<const f32x4*>(g + c * 256 + lane * 4);
      f32x4 bb = *reinterpret_cast<const f32x4*>(bta + c * 256 + lane * 4);
      f32x4 o;
#pragma unroll
      for (int k = 0; k < 4; ++k) o[k] = (v[c][k] - mean) * rstd * gg[k] + bb[k];
      *reinterpret_cast<f32x4*>(r + c * 256 + lane * 4) = o;
      st4bf(hb + (size_t)row * 1024 + c * 256 + lane * 4, o[0], o[1], o[2], o[3]);
    }
  }
}

DI void phase_xattn(const Params& p) {
  const u16* qx = (const u16*)(p.ws + OFF_QX);
  const u16* mk = (const u16*)(p.ws + OFF_MEMK);
  const u16* mv = (const u16*)(p.ws + OFF_MEMVT);
  u16* ox = (u16*)(p.ws + OFF_OX);
  const int lane = threadIdx.x & 63, lr = lane & 31, lh = lane >> 5;
  const int gw = (blockIdx.x * blockDim.x + threadIdx.x) >> 6;
  const int nw = (gridDim.x * blockDim.x) >> 6;
  for (int it = gw; it < 8 * 4 * 128; it += nw) {
    const int qt = it & 127, h = (it >> 7) & 3, b = it >> 9;
    const int tok = b * S_ + qt * 32 + lr;
    f32x16 Sx[8];
#pragma unroll
    for (int kt = 0; kt < 8; ++kt) Sx[kt] = zero16();
    const u16* qrow = qx + (((size_t)(b * 128 + qt) * 4 + h) * 16) * 512 + lane * 8;
    const u16* krow = mk + (((size_t)(b * 4 + h) * 8) * 16) * 512 + lane * 8;
#pragma unroll 2
    for (int ks = 0; ks < 16; ++ks) {
      bf16x8 qf = ldg8(qrow + ks * 512);
#pragma unroll
      for (int kt = 0; kt < 8; ++kt) Sx[kt] = MFMA(ldg8(krow + (kt * 16 + ks) * 512), qf, Sx[kt]);
    }
    float mx = -INFINITY;
#pragma unroll
    for (int kt = 0; kt < 8; ++kt)
#pragma unroll
      for (int i = 0; i < 16; ++i) mx = fmaxf(mx, Sx[kt][i]);
    mx = fmaxf(mx, __shfl_xor(mx, 32));
    float ls = 0.f;
    bf16x8 Pf[8][2];
#pragma unroll
    for (int kt = 0; kt < 8; ++kt) {
      float pv[16];
#pragma unroll
      for (int i = 0; i < 16; ++i) { pv[i] = __expf((Sx[kt][i] - mx) * 0.0625f); ls += pv[i]; }
#pragma unroll
      for (int s = 0; s < 2; ++s) Pf[kt][s] = pack8(pv[8 * s], pv[8 * s + 1], pv[8 * s + 2], pv[8 * s + 3], pv[8 * s + 4], pv[8 * s + 5], pv[8 * s + 6], pv[8 * s + 7]);
    }
    ls += __shfl_xor(ls, 32);
    const float inv = 1.f / ls;
#pragma unroll 1
    for (int dt = 0; dt < 8; ++dt) {
      f32x16 o = zero16();
      const u16* vrow = mv + ((((size_t)(b * 4 + h) * 8 + dt) * 8) * 2) * 512 + lane * 8;
#pragma unroll
      for (int kt = 0; kt < 8; ++kt)
#pragma unroll
        for (int s = 0; s < 2; ++s) o = MFMA(ldg8(vrow + (kt * 2 + s) * 512), Pf[kt][s], o);
#pragma unroll
      for (int g = 0; g < 4; ++g)
        st4bf(ox + (size_t)tok * 1024 + h * 256 + dt * 32 + 8 * g + 4 * lh, o[4 * g] * inv, o[4 * g + 1] * inv, o[4 * g + 2] * inv, o[4 * g + 3] * inv);
    }
  }
}

DI void peer_topk_item(const Params& p, int tt128, int head, char* smem) {
  float* sc = (float*)smem;
  float* topv = (float*)(smem + 132096);
  unsigned char* topi = (unsigned char*)(smem + 132096 + 16384);
  const u16* pq = (const u16*)(p.ws + OFF_QX);
  const u16* sk = (const u16*)(p.ws + OFF_SK);
  const int tid = threadIdx.x, lane = tid & 63, wave = tid >> 6, lr = lane & 31, lh = lane >> 5;
  const int tok0 = tt128 * 128;
  {
    const int half = wave >> 2, kt = wave & 3;
    bf16x8 af[8];
#pragma unroll
    for (int ks = 0; ks < 8; ++ks) af[ks] = ldg8(sk + (size_t)half * 16384 + (kt * 32 + lr) * 128 + ks * 16 + lh * 8);
#pragma unroll 1
    for (int tt = 0; tt < 4; ++tt) {
      f32x16 acc = zero16();
      const u16* brow = pq + (size_t)(tok0 + tt * 32 + lr) * 2048 + head * 256 + half * 128 + lh * 8;
#pragma unroll
      for (int ks = 0; ks < 8; ++ks) acc = MFMA(af[ks], ldg8(brow + ks * 16), acc);
#pragma unroll
      for (int i = 0; i < 16; ++i) sc[(half * 128 + tt * 32 + lr) * 129 + kt * 32 + crow(i, lh)] = acc[i];
    }
  }
  __syncthreads();
  if (tid < 256) {
    float* row = sc + tid * 129;
    float gm[8]; int gi[8];
#pragma unroll
    for (int g = 0; g < 8; ++g) {
      float m = -INFINITY; int mi = g * 16;
#pragma unroll
      for (int j = 0; j < 16; ++j) { float v = row[g * 16 + j]; if (v > m) { m = v; mi = g * 16 + j; } }
      gm[g] = m; gi[g] = mi;
    }
#pragma unroll 1
    for (int r = 0; r < 16; ++r) {
      float best = gm[0]; int bg = 0; int bi = gi[0];
#pragma unroll
      for (int g = 1; g < 8; ++g) if (gm[g] > best) { best = gm[g]; bg = g; bi = gi[g]; }
      topv[tid * 16 + r] = best; topi[tid * 16 + r] = (unsigned char)bi;
      row[bi] = -INFINITY;
      float m = -INFINITY; int mi = bg * 16;
#pragma unroll
      for (int j = 0; j < 16; ++j) { float v = row[bg * 16 + j]; if (v > m) { m = v; mi = bg * 16 + j; } }
#pragma unroll
      for (int g = 0; g < 8; ++g) { gm[g] = (g == bg) ? m : gm[g]; gi[g] = (g == bg) ? mi : gi[g]; }
    }
  }
  __syncthreads();
  if (tid < 128) {
    const float* av = topv + tid * 16;
    const float* bv = topv + (128 + tid) * 16;
    const unsigned char* ai = topi + tid * 16;
    const unsigned char* bi_ = topi + (128 + tid) * 16;
    float cur[16]; int pp[16];
    const float b0 = bv[0];
#pragma unroll
    for (int i = 0; i < 16; ++i) { cur[i] = av[i] + b0; pp[i] = 0; }
    float sel[16]; int eid[16];
#pragma unroll
    for (int r = 0; r < 16; ++r) {
      float best = cur[0]; int bi = 0; int bj = pp[0];
#pragma unroll
      for (int i = 1; i < 16; ++i) if (cur[i] > best) { best = cur[i]; bi = i; bj = pp[i]; }
      sel[r] = best;
      eid[r] = (int)ai[bi] * 128 + (int)bi_[bj];
      const int nj = bj + 1;
      const float nv = (nj < 16) ? (av[bi] + bv[nj & 15]) : -INFINITY;
#pragma unroll
      for (int i = 0; i < 16; ++i) { cur[i] = (i == bi) ? nv : cur[i]; pp[i] = (i == bi) ? nj : pp[i]; }
    }
    float sum = 0.f;
    const float smax = sel[0];
#pragma unroll
    for (int r = 0; r < 16; ++r) { sel[r] = __expf(sel[r] - smax); sum += sel[r]; }
    const float inv = 1.f / sum;
    int* eo = (int*)(p.ws + OFF_EIDX) + (size_t)(tok0 + tid) * 128 + head * 16;
    float* go = (float*)(p.ws + OFF_GATE) + (size_t)(tok0 + tid) * 128 + head * 16;
#pragma unroll
    for (int r = 0; r < 16; ++r) { eo[r] = eid[r]; go[r] = sel[r] * inv; }
  }
  __syncthreads();
}

DI float dot2bf(unsigned a, unsigned b, float c) {
  return __builtin_amdgcn_fdot2_f32_bf16(__builtin_bit_cast(bf2_t, a), __builtin_bit_cast(bf2_t, b), c, false);
}

DI float reduce8(float (&part)[8], int lane) {
  float r4[4], r2[2], r1;
#pragma unroll
  for (int k = 0; k < 4; ++k) {
    float send = (lane & 1) ? part[2 * k] : part[2 * k + 1];
    float keep = (lane & 1) ? part[2 * k + 1] : part[2 * k];
    r4[k] = keep + __shfl_xor(send, 1);
  }
#pragma unroll
  for (int k = 0; k < 2; ++k) {
    float send = (lane & 2) ? r4[2 * k] : r4[2 * k + 1];
    float keep = (lane & 2) ? r4[2 * k + 1] : r4[2 * k];
    r2[k] = keep + __shfl_xor(send, 2);
  }
  {
    float send = (lane & 4) ? r2[0] : r2[1];
    float keep = (lane & 4) ? r2[1] : r2[0];
    r1 = keep + __shfl_xor(send, 4);
  }
  r1 += __shfl_xor(r1, 8);
  r1 += __shfl_xor(r1, 16);
  r1 += __shfl_xor(r1, 32);
  return r1;
}

DI void phase_peer_down(const Params& p) {
  const char* exd = p.ws + OFF_EXD;
  const float* esc = (const float*)(p.ws + OFF_ESC);
  const u16* hb = (const u16*)(p.ws + OFF_HB);
  const int* eidx = (const int*)(p.ws + OFF_EIDX);
  const float* gate = (const float*)(p.ws + OFF_GATE);
  float* coefw = (float*)(p.ws + OFF_COEF);
  const int lane = threadIdx.x & 63;
  const int gw = (blockIdx.x * blockDim.x + threadIdx.x) >> 6;
  const int nw = (gridDim.x * blockDim.x) >> 6;
#pragma unroll 1
  for (int sl = 0; sl < 2; ++sl) {
#pragma unroll 1
    for (int tok = gw; tok < T_; tok += nw) {
      float x[16];
      {
        const u16* xr = hb + (size_t)tok * 1024 + lane * 16;
        u32x4 a = *reinterpret_cast<const u32x4*>(xr);
        u32x4 c = *reinterpret_cast<const u32x4*>(xr + 8);
#pragma unroll
        for (int w = 0; w < 4; ++w) { x[2 * w] = bflo(a[w]); x[2 * w + 1] = bfhi(a[w]); x[8 + 2 * w] = bflo(c[w]); x[8 + 2 * w + 1] = bfhi(c[w]); }
      }
#pragma unroll 1
      for (int half = 0; half < 2; ++half) {
        const int ev = eidx[(size_t)tok * 128 + half * 64 + lane];
        const float gv = gate[(size_t)tok * 128 + half * 64 + lane];
        unsigned long long m = __builtin_amdgcn_ballot_w64((ev >> 13) == sl);
        while (m != 0ull) {
          int pos[8];
          const int first = __builtin_ctzll(m);
#pragma unroll
          for (int k = 0; k < 8; ++k) {
            if (m != 0ull) { pos[k] = __builtin_ctzll(m); m &= m - 1ull; } else pos[k] = -1;
          }
          u32x4 dr[8];
#pragma unroll
          for (int k = 0; k < 8; ++k) {
            const int er = __builtin_amdgcn_readlane(ev, pos[k] >= 0 ? pos[k] : first);
            dr[k] = *reinterpret_cast<const u32x4*>(exd + (size_t)er * 1024 + lane * 16);
          }
          int pmine = pos[0];
#pragma unroll
          for (int k = 1; k < 8; ++k) pmine = ((lane & 7) == k) ? pos[k] : pmine;
          const int psafe = pmine >= 0 ? pmine : first;
          const int emine = __shfl(ev, psafe);
          const float gsel = __shfl(gv, psafe);
          const float sd = esc[emine];
          const float su = esc[16384 + emine];
          float part[8];
#pragma unroll
          for (int k = 0; k < 8; ++k) {
            float a0 = 0.f, a1 = 0.f;
#pragma unroll
            for (int w = 0; w < 4; ++w) {
              f2_t lo = __builtin_amdgcn_cvt_pk_f32_fp8((int)dr[k][w], false);
              f2_t hi = __builtin_amdgcn_cvt_pk_f32_fp8((int)dr[k][w], true);
              a0 = fmaf(lo[0], x[4 * w], a0); a1 = fmaf(lo[1], x[4 * w + 1], a1);
              a0 = fmaf(hi[0], x[4 * w + 2], a0); a1 = fmaf(hi[1], x[4 * w + 3], a1);
            }
            part[k] = a0 + a1;
          }
          float r1 = reduce8(part, lane) * sd;
          const float act = 0.5f * r1 * (1.f + erff(r1 * 0.70710678118654752f));
          if (lane < 8 && pmine >= 0) coefw[(size_t)tok * 128 + half * 64 + pmine] = gsel * act * su;
        }
      }
    }
  }
}

DI void phase_peer_ffn(const Params& p) {
  const char* exu = p.ws + OFF_EXU;
  const float* h = (const float*)(p.ws + OFF_H);
  const int* eidx = (const int*)(p.ws + OFF_EIDX);
  const float* coefw = (const float*)(p.ws + OFF_COEF);
  const int lane = threadIdx.x & 63;
  const int gw = (blockIdx.x * blockDim.x + threadIdx.x) >> 6;
  const int nw = (gridDim.x * blockDim.x) >> 6;
  for (int tok = gw; tok < T_; tok += nw) {
    float yacc[16];
#pragma unroll
    for (int i = 0; i < 16; ++i) yacc[i] = 0.f;
    const int e_lo = eidx[(size_t)tok * 128 + lane];
    const int e_hi = eidx[(size_t)tok * 128 + 64 + lane];
    const float c_lo = coefw[(size_t)tok * 128 + lane];
    const float c_hi = coefw[(size_t)tok * 128 + 64 + lane];
#pragma unroll 1
    for (int eb = 0; eb < 8; ++eb) {
      const int ev = (eb < 4) ? e_lo : e_hi;
      const float cv = (eb < 4) ? c_lo : c_hi;
      const int lbase = (eb & 3) * 16;
      u32x4 ur[16];
#pragma unroll
      for (int k = 0; k < 16; ++k) {
        const int er = __builtin_amdgcn_readlane(ev, lbase + k);
        ur[k] = *reinterpret_cast<const u32x4*>(exu + (size_t)er * 1024 + lane * 16);
      }
#pragma unroll
      for (int k = 0; k < 16; ++k) {
        const float ck = __int_as_float(__builtin_amdgcn_readlane(__float_as_int(cv), lbase + k));
#pragma unroll
        for (int w = 0; w < 4; ++w) {
          f2_t lo = __builtin_amdgcn_cvt_pk_f32_fp8((int)ur[k][w], false);
          f2_t hi = __builtin_amdgcn_cvt_pk_f32_fp8((int)ur[k][w], true);
          yacc[4 * w] = fmaf(ck, lo[0], yacc[4 * w]);
          yacc[4 * w + 1] = fmaf(ck, lo[1], yacc[4 * w + 1]);
          yacc[4 * w + 2] = fmaf(ck, hi[0], yacc[4 * w + 2]);
          yacc[4 * w + 3] = fmaf(ck, hi[1], yacc[4 * w + 3]);
        }
      }
    }
    const float* xr = h + (size_t)tok * 1024 + lane * 16;
    float v[16];
#pragma unroll
    for (int c = 0; c < 4; ++c) {
      f32x4 t = *reinterpret_cast<const f32x4*>(xr + c * 4);
#pragma unroll
      for (int k = 0; k < 4; ++k) v[4 * c + k] = ALPHA * t[k] + yacc[4 * c + k];
    }
    float s = 0.f;
#pragma unroll
    for (int i = 0; i < 16; ++i) s += v[i];
    const float mean = wave_sum(s) * (1.f / 1024.f);
    float q = 0.f;
#pragma unroll
    for (int i = 0; i < 16; ++i) { float d = v[i] - mean; q += d * d; }
    const float rstd = rsqrtf(wave_sum(q) * (1.f / 1024.f) + 1e-5f);
    float* orow = p.out + (size_t)tok * 1024 + lane * 16;
#pragma unroll
    for (int c = 0; c < 4; ++c) {
      f32x4 gg = *reinterpret_cast<const f32x4*>(p.ln_ffn_g + lane * 16 + c * 4);
      f32x4 bb = *reinterpret_cast<const f32x4*>(p.ln_ffn_b + lane * 16 + c * 4);
      f32x4 o;
#pragma unroll
      for (int k = 0; k < 4; ++k) o[k] = (v[4 * c + k] - mean) * rstd * gg[k] + bb[k];
      *reinterpret_cast<f32x4*>(orow + c * 4) = o;
    }
  }
}

constexpr size_t OFF_BAR = 166 * MiB;
DI void gbar(unsigned* ctr, unsigned target) {
  asm volatile("s_waitcnt vmcnt(0)" ::: "memory");
  __syncthreads();
  if (threadIdx.x == 0) {
    __builtin_amdgcn_fence(__ATOMIC_RELEASE, "agent");
    asm volatile("s_waitcnt vmcnt(0)" ::: "memory");
    __hip_atomic_fetch_add(ctr, 1u, __ATOMIC_RELAXED, __HIP_MEMORY_SCOPE_AGENT);
    while (__hip_atomic_load(ctr, __ATOMIC_RELAXED, __HIP_MEMORY_SCOPE_AGENT) < target) __builtin_amdgcn_s_sleep(2);
    __builtin_amdgcn_fence(__ATOMIC_ACQUIRE, "agent");
    asm volatile("s_waitcnt vmcnt(0)" ::: "memory");
  }
  __syncthreads();
}

__global__ void __launch_bounds__(512) fwd_megakernel(Params p) {
  __shared__ __attribute__((aligned(1024))) char smem[155648];
  cg::grid_group grid = cg::this_grid();
  const int G = gridDim.x;
  char* ws = p.ws;
  unsigned* bar = (unsigned*)(ws + OFF_BAR);

  phase_prep(p, smem);
  grid.sync();

  phase_inproj(p, smem);
  gbar(bar, (unsigned)(1 * G));

  for (int k = 0; k * G < 1024; ++k) {
    int j = (k & 1) ? (G - 1 - (int)blockIdx.x) : (int)blockIdx.x;
    int idx = k * G + j;
    if (idx < 1024) dsa_thr_item(p, idx & 7, 127 - (idx >> 3), smem);
  }
  for (int it = blockIdx.x; it < 2048; it += G) gla_g1_item(p, it, smem);
  gbar(bar, (unsigned)(2 * G));

  for (int k = 0; k * G < 1024; ++k) {
    int j = (k & 1) ? (G - 1 - (int)blockIdx.x) : (int)blockIdx.x;
    int idx = k * G + j;
    if (idx < 1024) dsa_attn_item(p, idx & 7, 127 - (idx >> 3), smem);
  }
  gla_scan(p);
  gbar(bar, (unsigned)(3 * G));

  for (int it = blockIdx.x; it < 2048; it += G) gla_g3_item(p, it, smem);
  gbar(bar, (unsigned)(4 * G));

  phase_gemm<0>(p, (const u16*)(ws + OFF_XB), (const u16*)(ws + OFF_WOUT), 1024, p.x, (float*)(ws + OFF_H), nullptr, 0, smem);
  gbar(bar, (unsigned)(5 * G));
  phase_ln(p, (float*)(ws + OFF_H), (u16*)(ws + OFF_HB), p.ln_mix_g, p.ln_mix_b);
  gbar(bar, (unsigned)(6 * G));

  phase_gemm<2>(p, (const u16*)(ws + OFF_HB), (const u16*)(ws + OFF_WQ), 1024, nullptr, nullptr, (u16*)(ws + OFF_QX), 1024, smem);
  gbar(bar, (unsigned)(7 * G));
  phase_xattn(p);
  gbar(bar, (unsigned)(8 * G));
  phase_gemm<0>(p, (const u16*)(ws + OFF_OX), (const u16*)(ws + OFF_WO), 1024, (const float*)(ws + OFF_H), (float*)(ws + OFF_H), nullptr, 0, smem);
  gbar(bar, (unsigned)(9 * G));
  phase_ln(p, (float*)(ws + OFF_H), (u16*)(ws + OFF_HB), p.ln_mem_g, p.ln_mem_b);
  gbar(bar, (unsigned)(10 * G));

  phase_gemm<1>(p, (const u16*)(ws + OFF_HB), (const u16*)(ws + OFF_WPQ), 2048, nullptr, nullptr, (u16*)(ws + OFF_QX), 2048, smem);
  gbar(bar, (unsigned)(11 * G));
  for (int it = blockIdx.x; it < 2048; it += G) peer_topk_item(p, it >> 3, it & 7, smem);
  gbar(bar, (unsigned)(12 * G));
  phase_peer_down(p);
  gbar(bar, (unsigned)(13 * G));
  phase_peer_ffn(p);
}

extern "C" void kernel_launch(void* const* d_in, const int* in_sizes, int n_in,
                              void* d_out, int out_size, void* d_ws, size_t ws_size,
                              hipStream_t stream) {
  static int grid_blocks = 0;
  if (!grid_blocks) {
    int dev = 0, cus = 0, per_cu = 0;
    (void)hipGetDevice(&dev);
    (void)hipDeviceGetAttribute(&cus, hipDeviceAttributeMultiprocessorCount, dev);
    (void)hipOccupancyMaxActiveBlocksPerMultiprocessor(&per_cu, fwd_megakernel, 512, 0);
    if (per_cu > 1) per_cu = 1;
    grid_blocks = cus * per_cu;
    if (grid_blocks > 256) grid_blocks = 256;
    if (ws_size < 512 * MiB) fprintf(stderr, "workspace too small: %zu\n", ws_size);
  }
  Params p{};
  p.x = (const float*)d_in[0]; p.positions = (const int*)d_in[1]; p.mem = (const float*)d_in[2]; p.w_in = (const float*)d_in[3];
  p.gate_up = (const float*)d_in[4]; p.gate_bias = (const float*)d_in[5]; p.norm_g = (const float*)d_in[6]; p.w_out = (const float*)d_in[7];
  p.ln_mix_g = (const float*)d_in[8]; p.ln_mix_b = (const float*)d_in[9];
  p.wq = (const float*)d_in[10]; p.wk = (const float*)d_in[11]; p.wv = (const float*)d_in[12]; p.wo = (const float*)d_in[13];
  p.ln_mem_g = (const float*)d_in[14]; p.ln_mem_b = (const float*)d_in[15];
  p.w_pq = (const float*)d_in[16]; p.sk1 = (const float*)d_in[17]; p.sk2 = (const float*)d_in[18];
  p.ex_down = (const float*)d_in[19]; p.ex_up = (const float*)d_in[20];
  p.ln_ffn_g = (const float*)d_in[21]; p.ln_ffn_b = (const float*)d_in[22];
  p.out = (float*)d_out; p.ws = (char*)d_ws;
  (void)hipMemsetAsync((char*)d_ws + OFF_BAR, 0, 256, stream);
  void* args[] = {&p};
  hipError_t e = hipLaunchCooperativeKernel((void*)fwd_megakernel, dim3(grid_blocks), dim3(512), args, 0, stream);
  if (e != hipSuccess) fprintf(stderr, "cooperative launch failed: %s (grid %d)\n", hipGetErrorString(e), grid_blocks);
}
```

```cpp
#include <hip/hip_runtime.h>
#include <hip/hip_cooperative_groups.h>
#include <cstdio>
#include <cmath>
namespace cg = cooperative_groups;

#define DI __device__ __forceinline__
typedef short bf16x8 __attribute__((ext_vector_type(8)));
typedef short bf16x4 __attribute__((ext_vector_type(4)));
typedef float f32x16 __attribute__((ext_vector_type(16)));
typedef float f32x4 __attribute__((ext_vector_type(4)));
typedef unsigned u32x4 __attribute__((ext_vector_type(4)));
typedef unsigned u32x2 __attribute__((ext_vector_type(2)));
typedef unsigned short u16;
typedef __bf16 bf2_t __attribute__((ext_vector_type(2)));
typedef float f2_t __attribute__((ext_vector_type(2)));

#define MFMA(a, b, c) __builtin_amdgcn_mfma_f32_32x32x16_bf16((a), (b), (c), 0, 0, 0)

constexpr int T_ = 32768;
constexpr int S_ = 4096;
constexpr int TMW = 2368;
constexpr int TM_Q = 0, TM_K = 512, TM_QI = 1024, TM_KI = 1280, TM_WI = 1312, TM_GLR = 1320, TM_GQ = 1344, TM_GK = 1600, TM_GR = 1856;
constexpr int PROJ_N = 3456;
constexpr float ALPHA = 1.189207115002721f;
constexpr size_t MiB = 1024 * 1024;

constexpr size_t OFF_XB = 0;
constexpr size_t OFF_EXD = 64 * MiB;
constexpr size_t OFF_EXU = 80 * MiB;
constexpr size_t OFF_BCG = 96 * MiB;
constexpr size_t OFF_WIN = 128 * MiB;
constexpr size_t OFF_WOUT = OFF_WIN + (size_t)PROJ_N * 1024 * 2;
constexpr size_t OFF_WQ = OFF_WOUT + 2 * MiB;
constexpr size_t OFF_WK = OFF_WQ + 2 * MiB;
constexpr size_t OFF_WV = OFF_WK + 2 * MiB;
constexpr size_t OFF_WO = OFF_WV + 2 * MiB;
constexpr size_t OFF_WPQ = OFF_WO + 2 * MiB;
constexpr size_t OFF_MEMB = 152 * MiB;
constexpr size_t OFF_MEMK = 156 * MiB;
constexpr size_t OFF_MEMVT = 160 * MiB;
constexpr size_t OFF_THR = 164 * MiB;
constexpr size_t OFF_SK = OFF_THR + 256 * 1024;
constexpr size_t OFF_DECAY = OFF_SK + 128 * 1024;
constexpr size_t OFF_ESC = 165 * MiB;
constexpr size_t OFF_TM = 168 * MiB;
constexpr size_t OFF_VT = 316 * MiB;
constexpr size_t OFF_KFR = 476 * MiB;
constexpr size_t OFF_GVT = 348 * MiB;
constexpr size_t OFF_KVT = 380 * MiB;
constexpr size_t OFF_PREV = 444 * MiB;
constexpr size_t OFF_H = 168 * MiB;
constexpr size_t OFF_HB = 296 * MiB;
constexpr size_t OFF_QX = 360 * MiB;
constexpr size_t OFF_OX = 424 * MiB;
constexpr size_t OFF_EIDX = 0;
constexpr size_t OFF_GATE = 16 * MiB;
constexpr size_t OFF_COEF = 32 * MiB;

struct Params {
  const float* x; const int* positions; const float* mem; const float* w_in;
  const float* gate_up; const float* gate_bias; const float* norm_g; const float* w_out;
  const float* ln_mix_g; const float* ln_mix_b;
  const float* wq; const float* wk; const float* wv; const float* wo;
  const float* ln_mem_g; const float* ln_mem_b;
  const float* w_pq; const float* sk1; const float* sk2; const float* ex_down; const float* ex_up;
  const float* ln_ffn_g; const float* ln_ffn_b;
  float* out; char* ws;
};

DI unsigned pk_bf16(float a, float b) {
  f2_t v = {a, b};
  bf2_t r = __builtin_convertvector(v, bf2_t);
  return __builtin_bit_cast(unsigned, r);
}
DI u16 f2bf(float a) { return (u16)(pk_bf16(a, 0.f) & 0xffffu); }
DI float bf2f(u16 u) { return __uint_as_float(((unsigned)u) << 16); }
DI float bflo(unsigned u) { return __uint_as_float(u << 16); }
DI float bfhi(unsigned u) { return __uint_as_float(u & 0xffff0000u); }
DI int crow(int i, int h) { return (i & 3) + 8 * (i >> 2) + 4 * h; }
DI bf16x8 ldg8(const u16* p) { return *reinterpret_cast<const bf16x8*>(p); }
DI bf16x8 pack8(float a0, float a1, float a2, float a3, float a4, float a5, float a6, float a7) {
  u32x4 r; r[0] = pk_bf16(a0, a1); r[1] = pk_bf16(a2, a3); r[2] = pk_bf16(a4, a5); r[3] = pk_bf16(a6, a7);
  return __builtin_bit_cast(bf16x8, r);
}
DI bf16x8 cat44(bf16x4 lo, bf16x4 hi) { return __builtin_shufflevector(lo, hi, 0, 1, 2, 3, 4, 5, 6, 7); }
DI void st4bf(u16* p, float a, float b, float c, float d) {
  u32x2 v; v[0] = pk_bf16(a, b); v[1] = pk_bf16(c, d);
  *reinterpret_cast<u32x2*>(p) = v;
}
DI float wave_sum(float v) {
#pragma unroll
  for (int d = 32; d >= 1; d >>= 1) v += __shfl_xor(v, d);
  return v;
}
DI void sincos_rad(float ang, float& s, float& c) {
  constexpr float C_hi = (float)0.15915494309189535;
  constexpr float C_lo = (float)(0.15915494309189535 - (double)C_hi);
  float k = rintf(ang * C_hi);
  float f = fmaf(ang, C_hi, -k);
  f = fmaf(ang, C_lo, f);
  s = __builtin_amdgcn_sinf(f);
  c = __builtin_amdgcn_cosf(f);
}
DI unsigned fkey(float s) {
  unsigned u = __float_as_uint(s + 0.0f);
  return (u & 0x80000000u) ? ~u : (u | 0x80000000u);
}
DI f32x16 zero16() { f32x16 z; for (int i = 0; i < 16; ++i) z[i] = 0.f; return z; }

DI int win_src_col(int n) {
  if (n < 1832) return n;
  if (n < 1848) return 2856 + (n - 1832);
  if (n < 1856) return -1;
  if (n < 2880) return n - 24;
  if (n < 3392) return n - 8;
  return -1;
}

DI void cvt_stream(const float* __restrict__ src, u16* __restrict__ dst, size_t n, size_t gtid, size_t gn) {
  size_t n8 = n / 8;
  for (size_t i = gtid; i < n8; i += gn) {
    f32x4 a = *reinterpret_cast<const f32x4*>(src + i * 8);
    f32x4 b = *reinterpret_cast<const f32x4*>(src + i * 8 + 4);
    u32x4 r; r[0] = pk_bf16(a[0], a[1]); r[1] = pk_bf16(a[2], a[3]); r[2] = pk_bf16(b[0], b[1]); r[3] = pk_bf16(b[2], b[3]);
    *reinterpret_cast<u32x4*>(dst + i * 8) = r;
  }
}

template <bool MAPPED>
DI void transpose_tile(const float* __restrict__ W, int ldn, u16* __restrict__ Wt, int k0, int n0, float* tile) {
  const int tid = threadIdx.x;
  {
    int nn = n0 + (tid & 63);
    int c = MAPPED ? win_src_col(nn) : nn;
#pragma unroll
    for (int rr = 0; rr < 8; ++rr) {
      int kk = (tid >> 6) + 8 * rr;
      float v = (c >= 0) ? W[(size_t)(k0 + kk) * ldn + c] : 0.f;
      tile[kk * 65 + (tid & 63)] = v;
    }
  }
  __syncthreads();
#pragma unroll
  for (int rr = 0; rr < 8; ++rr) {
    int nn = (tid >> 6) + 8 * rr;
    int kk = tid & 63;
    Wt[(size_t)(n0 + nn) * 1024 + k0 + kk] = f2bf(tile[kk * 65 + nn]);
  }
  __syncthreads();
}

DI void phase_prep(const Params& p, char* smem) {
  const size_t gtid = (size_t)blockIdx.x * blockDim.x + threadIdx.x;
  const size_t gn = (size_t)gridDim.x * blockDim.x;
  char* ws = p.ws;
  cvt_stream(p.x, (u16*)(ws + OFF_XB), (size_t)T_ * 1024, gtid, gn);
  cvt_stream(p.mem, (u16*)(ws + OFF_MEMB), (size_t)2048 * 1024, gtid, gn);
  {
    const int lane = threadIdx.x & 63;
    const int gw = (int)(gtid >> 6), nw = (int)(gn >> 6);
    for (int r = gw; r < 2 * 16384; r += nw) {
      const int tbl = r >> 14, row = r & 16383;
      const float* src = (tbl ? p.ex_up : p.ex_down) + (size_t)row * 1024 + lane * 16;
      f32x4 v[4]; float mx = 0.f;
#pragma unroll
      for (int c = 0; c < 4; ++c) {
        v[c] = *reinterpret_cast<const f32x4*>(src + c * 4);
#pragma unroll
        for (int k = 0; k < 4; ++k) mx = fmaxf(mx, fabsf(v[c][k]));
      }
#pragma unroll
      for (int d = 32; d >= 1; d >>= 1) mx = fmaxf(mx, __shfl_xor(mx, d));
      float sc = (mx > 0.f) ? exp2f(floorf(log2f(224.f / mx))) : 1.f;
      u32x4 o;
#pragma unroll
      for (int c = 0; c < 4; ++c) {
        int t = __builtin_amdgcn_cvt_pk_fp8_f32(v[c][0] * sc, v[c][1] * sc, 0, false);
        t = __builtin_amdgcn_cvt_pk_fp8_f32(v[c][2] * sc, v[c][3] * sc, t, true);
        o[c] = (unsigned)t;
      }
      *reinterpret_cast<u32x4*>(ws + (tbl ? OFF_EXU : OFF_EXD) + (size_t)row * 1024 + lane * 16) = o;
      if (lane == 0) ((float*)(ws + OFF_ESC))[r] = 1.f / sc;
    }
  }
  cvt_stream(p.sk1, (u16*)(ws + OFF_SK), (size_t)128 * 128, gtid, gn);
  cvt_stream(p.sk2, (u16*)(ws + OFF_SK) + 128 * 128, (size_t)128 * 128, gtid, gn);
  float* tile = (float*)smem;
  const int n_win = 54 * 16, n_sq = 256, n_pq = 512;
  const int total = n_win + 5 * n_sq + n_pq;
  for (int t = blockIdx.x; t < total; t += gridDim.x) {
    if (t < n_win) {
      transpose_tile<true>(p.w_in, 3384, (u16*)(ws + OFF_WIN), (t & 15) * 64, (t >> 4) * 64, tile);
    } else if (t < n_win + 5 * n_sq) {
      int u = t - n_win; int which = u >> 8; int r = u & 255;
      const float* W = which == 0 ? p.w_out : which == 1 ? p.wq : which == 2 ? p.wk : which == 3 ? p.wv : p.wo;
      size_t off = which == 0 ? OFF_WOUT : which == 1 ? OFF_WQ : which == 2 ? OFF_WK : which == 3 ? OFF_WV : OFF_WO;
      transpose_tile<false>(W, 1024, (u16*)(ws + off), (r & 15) * 64, (r >> 4) * 64, tile);
    } else {
      int r = t - n_win - 5 * n_sq;
      transpose_tile<false>(p.w_pq, 2048, (u16*)(ws + OFF_WPQ), (r & 15) * 64, (r >> 4) * 64, tile);
    }
  }
}

#define WAIT_V(n) asm volatile("s_waitcnt vmcnt(%0)" ::"n"(n) : "memory")
#define RAW_BARRIER() do { asm volatile("s_waitcnt lgkmcnt(0)" ::: "memory"); __builtin_amdgcn_s_barrier(); asm volatile("" ::: "memory"); } while (0)
constexpr int G_STAGE = 384 * 128;
DI void gemm_tile(const u16* __restrict__ X, int ldx, const u16* __restrict__ Wt, int ldw, int K, char* smem,
                  f32x16 (&acc)[2][2]) {
  const int tid = threadIdx.x, lane = tid & 63, wave = tid >> 6;
  const int fw = wave & 1, tq = wave >> 1, lr = lane & 31, lh = lane >> 5;
#pragma unroll
  for (int a = 0; a < 2; ++a)
#pragma unroll
    for (int b = 0; b < 2; ++b) acc[a][b] = zero16();
  const int nk = K / 64;
  const u16* src[6];
#pragma unroll
  for (int i = 0; i < 6; ++i) {
    const int R = 8 * (wave + 8 * i) + (lane >> 3);
    const int c = (lane & 7) ^ ((R >> 1) & 7);
    src[i] = (i < 4) ? (X + (size_t)R * ldx + c * 8) : (Wt + (size_t)(R - 256) * ldw + c * 8);
  }
#define GLDS_STAGE(slot, kt) do { _Pragma("unroll") for (int i = 0; i < 6; ++i) \
    __builtin_amdgcn_global_load_lds((const unsigned*)(src[i] + (kt) * 64), (__attribute__((address_space(3))) unsigned*)(smem + (slot) * G_STAGE + (wave + 8 * i) * 1024), 16, 0, 0); } while (0)
  int offA[2], offB[2], xa[2], xb[2];
#pragma unroll
  for (int ft = 0; ft < 2; ++ft) { const int R = 256 + fw * 64 + ft * 32 + lr; offA[ft] = R * 128; xa[ft] = (R >> 1) & 7; }
#pragma unroll
  for (int tt = 0; tt < 2; ++tt) { const int R = tq * 64 + tt * 32 + lr; offB[tt] = R * 128; xb[tt] = (R >> 1) & 7; }
  GLDS_STAGE(0, 0); GLDS_STAGE(1, 1); WAIT_V(6); RAW_BARRIER();
  int cur = 0;
  for (int kt = 0; kt < nk; ++kt) {
    const int nxt = (cur >= 1) ? cur - 1 : 2;
    if (kt + 2 < nk) GLDS_STAGE(nxt, kt + 2);
    __builtin_amdgcn_sched_barrier(0);
    const char* st = smem + cur * G_STAGE;
#pragma unroll
    for (int ks = 0; ks < 4; ++ks) {
      bf16x8 a[2], b[2];
#pragma unroll
      for (int ft = 0; ft < 2; ++ft) a[ft] = *reinterpret_cast<const bf16x8*>(st + offA[ft] + (((ks * 2 + lh) ^ xa[ft]) << 4));
#pragma unroll
      for (int tt = 0; tt < 2; ++tt) b[tt] = *reinterpret_cast<const bf16x8*>(st + offB[tt] + (((ks * 2 + lh) ^ xb[tt]) << 4));
#pragma unroll
      for (int ft = 0; ft < 2; ++ft)
#pragma unroll
        for (int tt = 0; tt < 2; ++tt) acc[ft][tt] = MFMA(a[ft], b[tt], acc[ft][tt]);
    }
    if (kt + 2 < nk) { WAIT_V(6); } else { WAIT_V(0); }
    RAW_BARRIER();
    cur = (cur == 2) ? 0 : cur + 1;
  }
#undef GLDS_STAGE
}

DI void store_tm_rows(f32x16 (&acc)[2][2], char* smem, u16* tm, int tokbase, int col) {
  const int lane = threadIdx.x & 63, wave = threadIdx.x >> 6, lr = lane & 31, lh = lane >> 5;
  float* wl = (float*)(smem + wave * 17408);
#pragma unroll
  for (int tt = 0; tt < 2; ++tt)
#pragma unroll
    for (int ft = 0; ft < 2; ++ft)
#pragma unroll
      for (int g = 0; g < 4; ++g) {
        f32x4 v = {acc[ft][tt][4 * g], acc[ft][tt][4 * g + 1], acc[ft][tt][4 * g + 2], acc[ft][tt][4 * g + 3]};
        *reinterpret_cast<f32x4*>(wl + (tt * 32 + lr) * 68 + ft * 32 + 8 * g + 4 * lh) = v;
      }
  const int ch = lane & 15, r0 = lane >> 4;
#pragma unroll 4
  for (int k = 0; k < 16; ++k) {
    const int row = r0 + 4 * k;
    f32x4 v = *reinterpret_cast<const f32x4*>(wl + row * 68 + ch * 4);
    st4bf(tm + (size_t)(tokbase + row) * TMW + col + ch * 4, v[0], v[1], v[2], v[3]);
  }
}

DI void epi_inproj(const Params& p, int tok0, int f0, f32x16 (&acc)[2][2], char* smem) {
  const int tid = threadIdx.x, lane = tid & 63, wave = tid >> 6;
  const int fw = wave & 1, tq = wave >> 1, lr = lane & 31, lh = lane >> 5;
  const int fbase = f0 + fw * 64;
  if (fbase >= 3392) return;
  u16* tm = (u16*)(p.ws + OFF_TM);
  int tmcol = -1;
#pragma unroll
  for (int tt = 0; tt < 2; ++tt) {
    const int tok = tok0 + tq * 64 + tt * 32 + lr;
    const float posf = (float)p.positions[tok];
    const int bb = tok >> 12, ss = tok & 4095;
    if (fbase < 1024) {
#pragma unroll
      for (int r = 0; r < 4; ++r) {
        float j = (float)(4 * lh + r);
        float inv = exp2f(-j * (18.931568569324174f / 8.0f));
        float sn, cs; sincos_rad(posf * inv, sn, cs);
        float x1 = acc[0][tt][r], x2 = acc[0][tt][r + 4];
        acc[0][tt][r] = x1 * cs - x2 * sn;
        acc[0][tt][r + 4] = x2 * cs + x1 * sn;
      }
      if (fbase < 512) {
        tmcol = fbase;
      } else {
        u16* kfr = (u16*)(p.ws + OFF_KFR);
        const int head = (fbase - 512) >> 6, gt = ss >> 5;
#pragma unroll
        for (int ft = 0; ft < 2; ++ft)
#pragma unroll
          for (int g = 0; g < 4; ++g) {
            const int ks = ft * 2 + (g >> 1), lane2 = (g & 1) * 32 + lr;
            st4bf(kfr + ((((size_t)(bb * 8 + head) * 128 + gt) * 4 + ks) * 64 + lane2) * 8 + 4 * lh, acc[ft][tt][4 * g], acc[ft][tt][4 * g + 1], acc[ft][tt][4 * g + 2], acc[ft][tt][4 * g + 3]);
          }
      }
    } else if (fbase < 1536) {
      u16* vfr = (u16*)(p.ws + OFF_VT);
      const int head = (fbase - 1024) >> 6, gt = ss >> 5;
      const int s = lr >> 4, r16 = lr & 15, j = 4 * (r16 >> 3) + (r16 & 3), lh2 = (r16 >> 2) & 1;
#pragma unroll
      for (int ft = 0; ft < 2; ++ft)
#pragma unroll
        for (int i = 0; i < 16; ++i) {
          const int lane2 = lh2 * 32 + crow(i, lh);
          vfr[((((((size_t)(bb * 8 + head) * 128 + gt) * 2 + ft) * 2 + s) * 64 + lane2) * 8) + j] = f2bf(acc[ft][tt][i]);
        }
    } else if (fbase >= 2368 && fbase < 2880) {
      u16* vt = (u16*)(p.ws + OFF_GVT);
      const int fo = fbase - 2368;
#pragma unroll
      for (int ft = 0; ft < 2; ++ft)
#pragma unroll
        for (int i = 0; i < 16; ++i) {
          int feat = fo + ft * 32 + crow(i, lh);
          vt[((size_t)bb * 512 + feat) * 4096 + ss] = f2bf(acc[ft][tt][i]);
        }
    } else {
      if (fbase < 1856) {
#pragma unroll
        for (int ft = 0; ft < 2; ++ft) {
          const bool rot = (fbase < 1792) || (ft == 0);
#pragma unroll
          for (int r = 0; r < 4; ++r) {
            float v = acc[ft][tt][r];
            float o = __shfl_xor(v, 32);
            float inv = exp2f(-(float)r * (18.931568569324174f / 4.0f));
            float sn, cs; sincos_rad(posf * inv, sn, cs);
            float res = (lh == 0) ? (v * cs - o * sn) : (v * cs + o * sn);
            acc[ft][tt][r] = rot ? res : v;
          }
        }
        tmcol = fbase - 512;
      } else if (fbase < 2368) {
        tmcol = fbase - 512;
      } else {
        tmcol = fbase - 1024;
      }
    }
  }
  if (tmcol >= 0) store_tm_rows(acc, smem, tm, tok0 + tq * 64, tmcol);
}

DI void phase_inproj(const Params& p, char* smem) {
  const int n_in = 128 * 27;
  const int total = n_in + 128;
  const u16* xb = (const u16*)(p.ws + OFF_XB);
  const u16* memb = (const u16*)(p.ws + OFF_MEMB);
  const int tid = threadIdx.x, lane = tid & 63, wave = tid >> 6;
  const int fw = wave & 1, tq = wave >> 1, lr = lane & 31, lh = lane >> 5;
  for (int t = blockIdx.x; t < total; t += gridDim.x) {
    f32x16 acc[2][2];
    if (t < n_in) {
      int mt = t / 27, nt = t % 27;
      gemm_tile(xb + (size_t)mt * 256 * 1024, 1024, (const u16*)(p.ws + OFF_WIN) + (size_t)nt * 128 * 1024, 1024, 1024, smem, acc);
      epi_inproj(p, mt * 256, nt * 128, acc, smem);
      __syncthreads();
    } else {
      int u = t - n_in; int which = u >> 6; int r = u & 63; int mt = r >> 3, nt = r & 7;
      const u16* W = (const u16*)(p.ws + (which == 0 ? OFF_WK : OFF_WV));
      gemm_tile(memb + (size_t)mt * 256 * 1024, 1024, W + (size_t)nt * 128 * 1024, 1024, 1024, smem, acc);
#pragma unroll
      for (int tt = 0; tt < 2; ++tt) {
        const int tok = mt * 256 + tq * 64 + tt * 32 + lr;
        const int bb = tok >> 8, mm = tok & 255, hh = nt >> 1, kt = mm >> 5;
        if (which == 0) {
          u16* mk = (u16*)(p.ws + OFF_MEMK);
#pragma unroll
          for (int ft = 0; ft < 2; ++ft)
#pragma unroll
            for (int g = 0; g < 4; ++g) {
              const int ks = (nt & 1) * 8 + fw * 4 + ft * 2 + (g >> 1), lane2 = (g & 1) * 32 + lr;
              st4bf(mk + ((((size_t)(bb * 4 + hh) * 8 + kt) * 16 + ks) * 64 + lane2) * 8 + 4 * lh, acc[ft][tt][4 * g], acc[ft][tt][4 * g + 1], acc[ft][tt][4 * g + 2], acc[ft][tt][4 * g + 3]);
            }
        } else {
          u16* mv = (u16*)(p.ws + OFF_MEMVT);
          const int s = lr >> 4, r16 = lr & 15, j = 4 * (r16 >> 3) + (r16 & 3), lh2 = (r16 >> 2) & 1;
#pragma unroll
          for (int ft = 0; ft < 2; ++ft) {
            const int dt = (nt & 1) * 4 + fw * 2 + ft;
#pragma unroll
            for (int i = 0; i < 16; ++i) {
              const int lane2 = lh2 * 32 + crow(i, lh);
              mv[((((((size_t)(bb * 4 + hh) * 8 + dt) * 8 + kt) * 2 + s) * 64 + lane2) * 8) + j] = f2bf(acc[ft][tt][i]);
            }
          }
        }
      }
    }
  }
}

DI void idx_scores(const bf16x8 (&qf)[8][2], const float (&wq)[8], bf16x8 k0, bf16x8 k1, float (&sc)[16]) {
#pragma unroll
  for (int i = 0; i < 16; ++i) sc[i] = 0.f;
#pragma unroll
  for (int hd = 0; hd < 8; ++hd) {
    f32x16 a = zero16();
    a = MFMA(k0, qf[hd][0], a);
    a = MFMA(k1, qf[hd][1], a);
#pragma unroll
    for (int i = 0; i < 16; ++i) sc[i] = fmaf(wq[hd], fmaxf(a[i], 0.f), sc[i]);
  }
}

DI void load_idx_q(const u16* tm, int tok, int lh, bf16x8 (&qf)[8][2], float (&wq)[8]) {
  const u16* row = tm + (size_t)tok * TMW;
#pragma unroll
  for (int hd = 0; hd < 8; ++hd)
#pragma unroll
    for (int ks = 0; ks < 2; ++ks) qf[hd][ks] = ldg8(row + TM_QI + hd * 32 + ks * 16 + lh * 8);
  bf16x8 w8 = ldg8(row + TM_WI);
#pragma unroll
  for (int hd = 0; hd < 8; ++hd) wq[hd] = bf2f((u16)w8[hd]) * 0.0625f;
}

DI int wave_incl_scan(int v, int lane) {
#pragma unroll
  for (int d = 1; d < 64; d <<= 1) {
    int t = __shfl_up(v, d);
    if (lane >= d) v += t;
  }
  return v;
}

DI void dsa_thr_item(const Params& p, int b, int qblk, char* smem) {
  unsigned* hist = (unsigned*)smem;
  unsigned* pref = (unsigned*)(smem + 32768);
  int* rank = (int*)(smem + 32768 + 128);
  const u16* tm = (const u16*)(p.ws + OFF_TM);
  const int tid = threadIdx.x, lane = tid & 63, wave = tid >> 6, lr = lane & 31, lh = lane >> 5;
  const int q0 = qblk * 32;
  u16* qi = (u16*)(smem + 33280);
  for (int i = tid; i < 32 * 32; i += 512) {
    int q = i >> 5, ch = i & 31;
    *reinterpret_cast<u32x4*>(qi + q * 296 + ch * 8) = *reinterpret_cast<const u32x4*>(tm + (size_t)(b * S_ + q0 + q) * TMW + TM_QI + ch * 8);
  }
  float wq[8];
  {
    bf16x8 w8 = ldg8(tm + (size_t)(b * S_ + q0 + lr) * TMW + TM_WI);
#pragma unroll
    for (int hd = 0; hd < 8; ++hd) wq[hd] = bf2f((u16)w8[hd]) * 0.0625f;
  }
  __syncthreads();
  for (int i = tid; i < 32 * 32; i += 512) {
    const int q = i >> 5, d = i & 31;
    float acc = 0.f;
#pragma unroll
    for (int hd = 0; hd < 8; ++hd) acc = fmaf(bf2f(tm[(size_t)(b * S_ + q0 + q) * TMW + TM_WI + hd]) * 0.0625f, bf2f(qi[q * 296 + hd * 32 + d]), acc);
    qi[q * 296 + 256 + d] = f2bf(acc);
  }
  const u16* qil = qi + lr * 296 + lh * 8;
  if (tid < 32) { pref[tid] = 0u; rank[tid] = min(256, q0 + tid + 1); }
  for (int pass = 0; pass < 4; ++pass) {
    for (int i = tid; i < 8192; i += 512) hist[i] = 0u;
    __syncthreads();
    const int shift = 24 - 8 * pass;
    const unsigned mypref = pref[lr];
    const u16* kib = tm + (size_t)(b * S_ + lr) * TMW + TM_KI + lh * 8;
    bf16x8 kn0, kn1;
    {
      const int kt0 = min(wave, qblk);
      kn0 = ldg8(kib + (size_t)(kt0 * 32) * TMW); kn1 = ldg8(kib + (size_t)(kt0 * 32) * TMW + 16);
    }
    for (int kt = wave; kt <= qblk; kt += 8) {
      const bf16x8 k0 = kn0, k1 = kn1;
      {
        const int ktn = min(kt + 8, qblk);
        kn0 = ldg8(kib + (size_t)(ktn * 32) * TMW); kn1 = ldg8(kib + (size_t)(ktn * 32) * TMW + 16);
      }
      float sc[16];
      {
        f32x16 a = zero16();
        a = MFMA(k0, *reinterpret_cast<const bf16x8*>(qil + 256), a);
        a = MFMA(k1, *reinterpret_cast<const bf16x8*>(qil + 256 + 16), a);
#pragma unroll
        for (int i = 0; i < 16; ++i) sc[i] = 0.5f * a[i];
      }
#pragma unroll
      for (int hd = 0; hd < 8; ++hd) {
        f32x16 a = zero16();
        a = MFMA(k0, *reinterpret_cast<const bf16x8*>(qil + hd * 32), a);
        a = MFMA(k1, *reinterpret_cast<const bf16x8*>(qil + hd * 32 + 16), a);
        const float wh = 0.5f * wq[hd];
#pragma unroll
        for (int i = 0; i < 16; ++i) sc[i] = fmaf(fabsf(a[i]), wh, sc[i]);
      }
#pragma unroll
      for (int i = 0; i < 16; ++i) {
        int kp = kt * 32 + crow(i, lh);
        unsigned ky = fkey(sc[i]);
        unsigned hi = (ky >> shift);
        if (kp <= q0 + lr && (hi >> 8) == mypref) atomicAdd(&hist[(hi & 255u) * 32 + lr], 1u);
      }
    }
    __syncthreads();
#pragma unroll 1
    for (int qq = 0; qq < 4; ++qq) {
      const int q = wave * 4 + qq;
      const int rk = rank[q];
      int c[4];
#pragma unroll
      for (int j = 0; j < 4; ++j) c[j] = (int)hist[(255 - 4 * lane - j) * 32 + q];
      int s = c[0] + c[1] + c[2] + c[3];
      int P = wave_incl_scan(s, lane);
      int excl = P - s;
      if (P >= rk && excl < rk) {
        int cum = excl; int bin = 0; int nr = 1; bool found = false;
#pragma unroll
        for (int j = 0; j < 4; ++j) {
          if (!found && cum + c[j] >= rk) { bin = 255 - 4 * lane - j; nr = rk - cum; found = true; }
          if (!found) cum += c[j];
        }
        pref[q] = (pref[q] << 8) | (unsigned)bin;
        rank[q] = nr;
      }
    }
    __syncthreads();
  }
  if (tid < 32) ((unsigned*)(p.ws + OFF_THR))[b * S_ + q0 + tid] = pref[tid];
  __syncthreads();
}

DI void dsa_attn_item(const Params& p, int b, int qblk, char* smem) {
  u16* maskbuf = (u16*)smem;
  u16* qi = (u16*)(smem + 4096);
  const u16* tm = (const u16*)(p.ws + OFF_TM);
  const u16* vfr = (const u16*)(p.ws + OFF_VT) + ((size_t)(b * 8 + (threadIdx.x >> 6)) * 128) * 2048 + (threadIdx.x & 63) * 8;
  const u16* kfr = (const u16*)(p.ws + OFF_KFR) + ((size_t)(b * 8 + (threadIdx.x >> 6)) * 128) * 2048 + (threadIdx.x & 63) * 8;
  const unsigned* thr = (const unsigned*)(p.ws + OFF_THR);
  const int tid = threadIdx.x, lane = tid & 63, wave = tid >> 6, lr = lane & 31, lh = lane >> 5;
  const int q0 = qblk * 32;
  const int head = wave;
  const int qtok = b * S_ + q0 + lr;
  bf16x8 Qf[4];
#pragma unroll
  for (int ks = 0; ks < 4; ++ks) {
    bf16x8 raw = ldg8(tm + (size_t)qtok * TMW + TM_Q + head * 64 + ks * 16 + lh * 8);
    float f[8];
#pragma unroll
    for (int j = 0; j < 8; ++j) f[j] = bf2f((u16)raw[j]) * 0.125f;
    Qf[ks] = pack8(f[0], f[1], f[2], f[3], f[4], f[5], f[6], f[7]);
  }
  f32x16 O[2];
  O[0] = zero16(); O[1] = zero16();
  float mrun = -INFINITY, lrun = 0.f;
  const unsigned thrq = thr[qtok];
  const int nchunks = (q0 + 31) / 256 + 1;
  for (int i = tid; i < 32 * 32; i += 512) {
    int q = i >> 5, ch = i & 31;
    *reinterpret_cast<u32x4*>(qi + q * 296 + ch * 8) = *reinterpret_cast<const u32x4*>(tm + (size_t)(b * S_ + q0 + q) * TMW + TM_QI + ch * 8);
  }
  float* wqs = (float*)(smem + 4096 + 32 * 296 * 2);
  if (tid < 256) wqs[tid] = bf2f(tm[(size_t)(b * S_ + q0 + (tid & 31)) * TMW + TM_WI + (tid >> 5)]) * 0.0625f;
  __syncthreads();
  for (int i = tid; i < 32 * 32; i += 512) {
    const int q = i >> 5, d = i & 31;
    float acc = 0.f;
#pragma unroll
    for (int hd = 0; hd < 8; ++hd) acc = fmaf(bf2f(tm[(size_t)(b * S_ + q0 + q) * TMW + TM_WI + hd]) * 0.0625f, bf2f(qi[q * 296 + hd * 32 + d]), acc);
    qi[q * 296 + 256 + d] = f2bf(acc);
  }
  __syncthreads();
  const u16* qil = qi + lr * 296 + lh * 8;
  const u16* kibase = tm + (size_t)(b * S_ + lr) * TMW + TM_KI + lh * 8;
  bf16x8 Kf[4], Kn[4];
#pragma unroll
  for (int ks = 0; ks < 4; ++ks) Kf[ks] = ldg8(kfr + ks * 512);
  bf16x8 Vf[2][2], Vn[2][2];
#pragma unroll
  for (int dt = 0; dt < 2; ++dt)
#pragma unroll
    for (int s = 0; s < 2; ++s) Vf[dt][s] = ldg8(vfr + (dt * 2 + s) * 512);
  bf16x8 ki0, ki1;
  {
    const int kt0 = min(wave, qblk);
    ki0 = ldg8(kibase + (size_t)(kt0 * 32) * TMW); ki1 = ldg8(kibase + (size_t)(kt0 * 32) * TMW + 16);
  }
  for (int c = 0; c < nchunks; ++c) {
    const int buf = c & 1;
    {
      const int key0 = (c * 8 + wave) * 32;
      unsigned bits = 0u;
      const bf16x8 k0 = ki0, k1 = ki1;
      {
        const int ktn = min((c + 1) * 8 + wave, qblk);
        ki0 = ldg8(kibase + (size_t)(ktn * 32) * TMW); ki1 = ldg8(kibase + (size_t)(ktn * 32) * TMW + 16);
      }
      if (key0 <= q0 + 31) {
        float sc[16];
        {
          f32x16 a = zero16();
          a = MFMA(k0, *reinterpret_cast<const bf16x8*>(qil + 256), a);
          a = MFMA(k1, *reinterpret_cast<const bf16x8*>(qil + 256 + 16), a);
#pragma unroll
          for (int i = 0; i < 16; ++i) sc[i] = 0.5f * a[i];
        }
#pragma unroll 2
        for (int hd = 0; hd < 8; ++hd) {
          f32x16 a = zero16();
          a = MFMA(k0, *reinterpret_cast<const bf16x8*>(qil + hd * 32), a);
          a = MFMA(k1, *reinterpret_cast<const bf16x8*>(qil + hd * 32 + 16), a);
          const float wh = 0.5f * wqs[hd * 32 + lr];
#pragma unroll
          for (int i = 0; i < 16; ++i) sc[i] = fmaf(fabsf(a[i]), wh, sc[i]);
        }
        __builtin_amdgcn_sched_barrier(0);
#pragma unroll
        for (int i = 0; i < 16; ++i) {
          int kp = key0 + crow(i, lh);
          if (kp <= q0 + lr && fkey(sc[i]) >= thrq) bits |= (1u << i);
        }
      }
      maskbuf[(buf * 8 + wave) * 64 + lane] = (u16)bits;
    }
    __syncthreads();
#pragma unroll 1
    for (int t8 = 0; t8 < 8; ++t8) {
      const int g = c * 8 + t8;
      if (g > qblk) break;
      {
        const int gn = min(g + 1, qblk);
        const u16* kr = kfr + (size_t)gn * 2048;
#pragma unroll
        for (int ks = 0; ks < 4; ++ks) Kn[ks] = ldg8(kr + ks * 512);
#pragma unroll
        for (int dt = 0; dt < 2; ++dt)
#pragma unroll
          for (int s = 0; s < 2; ++s) Vn[dt][s] = ldg8(vfr + (size_t)gn * 2048 + (dt * 2 + s) * 512);
      }

      const unsigned bits = maskbuf[(buf * 8 + t8) * 64 + lane];
      f32x16 Sx = zero16();
#pragma unroll
      for (int ks = 0; ks < 4; ++ks) Sx = MFMA(Kf[ks], Qf[ks], Sx);
      float mt = -INFINITY;
#pragma unroll
      for (int i = 0; i < 16; ++i) mt = ((bits >> i) & 1u) ? fmaxf(mt, Sx[i]) : mt;
      mt = fmaxf(mt, __shfl_xor(mt, 32));
      const float mnew = fmaxf(mrun, mt);
      const float msafe = (mnew == -INFINITY) ? 0.f : mnew;
      const float alpha = __expf(mrun - msafe);
      float pv[16]; float ps = 0.f;
#pragma unroll
      for (int i = 0; i < 16; ++i) { pv[i] = ((bits >> i) & 1u) ? __expf(Sx[i] - msafe) : 0.f; ps += pv[i]; }
      lrun = lrun * alpha + ps;
      mrun = mnew;
      if (__builtin_amdgcn_ballot_w64(alpha != 1.f) != 0ull) {
#pragma unroll
        for (int dt = 0; dt < 2; ++dt)
#pragma unroll
          for (int i = 0; i < 16; ++i) O[dt][i] *= alpha;
      }
      bf16x8 Pf[2];
#pragma unroll
      for (int s = 0; s < 2; ++s) Pf[s] = pack8(pv[8 * s], pv[8 * s + 1], pv[8 * s + 2], pv[8 * s + 3], pv[8 * s + 4], pv[8 * s + 5], pv[8 * s + 6], pv[8 * s + 7]);
#pragma unroll
      for (int dt = 0; dt < 2; ++dt)
#pragma unroll
        for (int s = 0; s < 2; ++s) O[dt] = MFMA(Vf[dt][s], Pf[s], O[dt]);
#pragma unroll
      for (int ks = 0; ks < 4; ++ks) Kf[ks] = Kn[ks];
#pragma unroll
      for (int dt = 0; dt < 2; ++dt)
#pragma unroll
        for (int s = 0; s < 2; ++s) Vf[dt][s] = Vn[dt][s];
    }
  }
  u16* y = (u16*)(p.ws + OFF_XB);
  {
    float lt = lrun + __shfl_xor(lrun, 32);
    float inv = 1.f / lt;
#pragma unroll
    for (int dt = 0; dt < 2; ++dt)
#pragma unroll
      for (int g = 0; g < 4; ++g)
        st4bf(y + (size_t)qtok * 1024 + head * 64 + dt * 32 + 8 * g + 4 * lh, O[dt][4 * g] * inv, O[dt][4 * g + 1] * inv, O[dt][4 * g + 2] * inv, O[dt][4 * g + 3] * inv);
  }
  __syncthreads();
}

DI void gla_bcum(const Params& p, int b, int h, int n, float* bc, float* glr_s, float* segtot) {
  const u16* tm = (const u16*)(p.ws + OFF_TM);
  const int tid = threadIdx.x;
  const int tok0 = b * S_ + n * 64;
  for (int i = tid; i < 1024; i += 512) glr_s[i] = bf2f(tm[(size_t)(tok0 + (i >> 4)) * TMW + TM_GLR + (i & 15)]);
  const int d = tid & 63, cgp = tid >> 6;
  float gu[16];
#pragma unroll
  for (int j = 0; j < 16; ++j) gu[j] = p.gate_up[j * 256 + h * 64 + d];
  const float bias = p.gate_bias[h * 64 + d];
  __syncthreads();
  float v[8]; float run = 0.f;
#pragma unroll
  for (int r = 0; r < 8; ++r) {
    const int c = cgp * 8 + r;
    float z = bias;
#pragma unroll
    for (int j = 0; j < 16; ++j) z = fmaf(glr_s[c * 16 + j], gu[j], z);
    float la = (fminf(z, 0.f) - log1pf(__expf(-fabsf(z)))) * 0.0625f;
    run += la; v[r] = run;
  }
  segtot[cgp * 64 + d] = run;
  __syncthreads();
  float off = 0.f;
#pragma unroll
  for (int g = 0; g < 8; ++g) off += (g < cgp) ? segtot[g * 64 + d] : 0.f;
#pragma unroll
  for (int r = 0; r < 8; ++r) bc[(cgp * 8 + r) * 64 + d] = off + v[r];
  __syncthreads();
}

DI void gla_g1_item(const Params& p, int item, char* smem) {
  float* bc = (float*)smem;
  float* glr_s = (float*)(smem + 16384);
  float* segtot = (float*)(smem + 20480);
  u16* KeT = (u16*)(smem + 22528);
  const int b = item >> 8, h = (item >> 6) & 3, n = item & 63;
  const u16* tm = (const u16*)(p.ws + OFF_TM);
  const u16* gvT = (const u16*)(p.ws + OFF_GVT);
  const int tid = threadIdx.x, lane = tid & 63, wave = tid >> 6, lr = lane & 31, lh = lane >> 5;
  const int tok0 = b * S_ + n * 64;
  u16 kraw[8];
  {
    const int d = tid & 63, cgp = tid >> 6;
#pragma unroll
    for (int r = 0; r < 8; ++r) kraw[r] = tm[(size_t)(tok0 + cgp * 8 + r) * TMW + TM_GK + h * 64 + d];
  }
  bf16x8 afr[4];
  {
    const int et = wave & 3;
    const u16* arow = gvT + ((size_t)b * 512 + h * 128 + et * 32 + lr) * 4096 + n * 64 + lh * 8;
#pragma unroll
    for (int ks = 0; ks < 4; ++ks) afr[ks] = ldg8(arow + ks * 16);
  }
  gla_bcum(p, b, h, n, bc, glr_s, segtot);
  {
    const int d = tid & 63, cgp = tid >> 6;
    const float blast = bc[63 * 64 + d];
    {
      float* bcg = (float*)(p.ws + OFF_BCG) + (size_t)item * 4096;
#pragma unroll
      for (int r = 0; r < 8; ++r) bcg[(cgp * 8 + r) * 64 + d] = bc[(cgp * 8 + r) * 64 + d];
    }
    float f[8];
#pragma unroll
    for (int r = 0; r < 8; ++r) {
      const int c = cgp * 8 + r;
      float kv = bf2f(kraw[r]);
      f[r] = kv * __expf(blast - bc[c * 64 + d]);
    }
    *reinterpret_cast<bf16x8*>(KeT + d * 72 + cgp * 8) = pack8(f[0], f[1], f[2], f[3], f[4], f[5], f[6], f[7]);
    if (cgp == 0) ((float*)(p.ws + OFF_DECAY))[item * 64 + d] = __expf(blast);
  }
  __syncthreads();
  {
    const int et = wave & 3, dtl = wave >> 2;
    f32x16 acc = zero16();
#pragma unroll
    for (int ks = 0; ks < 4; ++ks) {
      bf16x8 a = afr[ks];
      bf16x8 bb = *reinterpret_cast<const bf16x8*>(KeT + (dtl * 32 + lr) * 72 + ks * 16 + lh * 8);
      acc = MFMA(a, bb, acc);
    }
    float* kvT = (float*)(p.ws + OFF_KVT);
#pragma unroll
    for (int i = 0; i < 16; ++i) kvT[((size_t)item * 128 + et * 32 + crow(i, lh)) * 64 + dtl * 32 + lr] = acc[i];
  }
  __syncthreads();
}

DI void gla_scan(const Params& p) {
  const float* kvT = (const float*)(p.ws + OFF_KVT);
  const float* decay = (const float*)(p.ws + OFF_DECAY);
  u16* prev = (u16*)(p.ws + OFF_PREV);
  const int gtid = blockIdx.x * blockDim.x + threadIdx.x;
  const int gn = gridDim.x * blockDim.x;
  for (int u = gtid; u < 32 * 2048; u += gn) {
    const int bh = u >> 11, rem = u & 2047, e = rem >> 4, d4 = (rem & 15) * 4;
    f32x4 st = {0.f, 0.f, 0.f, 0.f};
#pragma unroll 4
    for (int n = 0; n < 64; ++n) {
      const int item = bh * 64 + n;
      st4bf(prev + ((size_t)item * 128 + e) * 64 + d4, st[0], st[1], st[2], st[3]);
      f32x4 dc = *reinterpret_cast<const f32x4*>(decay + item * 64 + d4);
      f32x4 kv = *reinterpret_cast<const f32x4*>(kvT + ((size_t)item * 128 + e) * 64 + d4);
      st = dc * st + kv;
    }
  }
}

DI void gla_g3_item(const Params& p, int item, char* smem) {
  float* red = (float*)smem;
  const int b = item >> 8, h = (item >> 6) & 3, n = item & 63;
  const u16* tm = (const u16*)(p.ws + OFF_TM);
  const u16* gvT = (const u16*)(p.ws + OFF_GVT);
  const u16* prev = (const u16*)(p.ws + OFF_PREV);
  const float* bcg = (const float*)(p.ws + OFF_BCG) + (size_t)item * 4096;
  const int tid = threadIdx.x, lane = tid & 63, wave = tid >> 6, lr = lane & 31, lh = lane >> 5;
  const int tok0 = b * S_ + n * 64;
  const int et = wave & 3, ct = wave >> 2;
  bf16x8 qraw[4], kraw[2][4], sfr[4];
  bf16x4 vlo[2][2], vhi[2][2];
  f32x4 bq[4][2];
  {
    const u16* vrow0 = gvT + ((size_t)b * 512 + h * 128 + et * 32 + lr) * 4096 + n * 64 + 4 * lh;
    const u16* srow0 = prev + ((size_t)item * 128 + et * 32 + lr) * 64 + lh * 8;
#pragma unroll
    for (int ks = 0; ks < 4; ++ks) {
      qraw[ks] = ldg8(tm + (size_t)(tok0 + ct * 32 + lr) * TMW + TM_GQ + h * 64 + ks * 16 + lh * 8);
      kraw[0][ks] = ldg8(tm + (size_t)(tok0 + lr) * TMW + TM_GK + h * 64 + ks * 16 + lh * 8);
      kraw[1][ks] = ldg8(tm + (size_t)(tok0 + ct * 32 + lr) * TMW + TM_GK + h * 64 + ks * 16 + lh * 8);
      sfr[ks] = ldg8(srow0 + ks * 16);
      bq[ks][0] = *reinterpret_cast<const f32x4*>(bcg + (ct * 32 + lr) * 64 + ks * 16 + lh * 8);
      bq[ks][1] = *reinterpret_cast<const f32x4*>(bcg + (ct * 32 + lr) * 64 + ks * 16 + lh * 8 + 4);
    }
#pragma unroll
    for (int st = 0; st < 2; ++st)
#pragma unroll
      for (int s2 = 0; s2 < 2; ++s2) {
        const u16* vp = vrow0 + (st * ct) * 32 + 16 * s2;
        vlo[st][s2] = *reinterpret_cast<const bf16x4*>(vp);
        vhi[st][s2] = *reinterpret_cast<const bf16x4*>(vp + 8);
      }
  }
  bf16x8 Qd[4];
#pragma unroll
  for (int ks = 0; ks < 4; ++ks) {
    float f[8];
#pragma unroll
    for (int j = 0; j < 8; ++j) f[j] = bf2f((u16)qraw[ks][j]) * 0.125f * __expf(bq[ks][j >> 2][j & 3]);
    Qd[ks] = pack8(f[0], f[1], f[2], f[3], f[4], f[5], f[6], f[7]);
  }
  f32x16 O = zero16();
#pragma unroll
  for (int st = 0; st < 2; ++st) {
    if (st <= ct) {
      f32x16 A = zero16();
      const int s = st * 32 + lr;
#pragma unroll
      for (int ks = 0; ks < 4; ++ks) {
        f32x4 b0 = (st == 1) ? bq[ks][0] : *reinterpret_cast<const f32x4*>(bcg + s * 64 + ks * 16 + lh * 8);
        f32x4 b1 = (st == 1) ? bq[ks][1] : *reinterpret_cast<const f32x4*>(bcg + s * 64 + ks * 16 + lh * 8 + 4);
        float f[8];
#pragma unroll
        for (int j = 0; j < 8; ++j) f[j] = bf2f((u16)kraw[st][ks][j]) * __expf(-((j < 4) ? b0[j & 3] : b1[j & 3]));
        bf16x8 Ki = pack8(f[0], f[1], f[2], f[3], f[4], f[5], f[6], f[7]);
        A = MFMA(Ki, Qd[ks], A);
      }
      float pv[16];
#pragma unroll
      for (int i = 0; i < 16; ++i) pv[i] = (st * 32 + crow(i, lh) <= ct * 32 + lr) ? A[i] : 0.f;
#pragma unroll
      for (int s2 = 0; s2 < 2; ++s2) {
        bf16x8 Pf = pack8(pv[8 * s2], pv[8 * s2 + 1], pv[8 * s2 + 2], pv[8 * s2 + 3], pv[8 * s2 + 4], pv[8 * s2 + 5], pv[8 * s2 + 6], pv[8 * s2 + 7]);
        O = MFMA(cat44(vlo[st][s2], vhi[st][s2]), Pf, O);
      }
    }
  }
#pragma unroll
  for (int ks = 0; ks < 4; ++ks) O = MFMA(sfr[ks], Qd[ks], O);
  float ss = 0.f;
#pragma unroll
  for (int i = 0; i < 16; ++i) ss += O[i] * O[i];
  ss += __shfl_xor(ss, 32);
  if (lh == 0) red[(ct * 4 + et) * 32 + lr] = ss;
  __syncthreads();
  const float tot = red[(ct * 4 + 0) * 32 + lr] + red[(ct * 4 + 1) * 32 + lr] + red[(ct * 4 + 2) * 32 + lr] + red[(ct * 4 + 3) * 32 + lr];
  const float rinv = rsqrtf(tot * (1.f / 128.f) + 1e-6f);
  const int tok = tok0 + ct * 32 + lr;
  u16* y = (u16*)(p.ws + OFF_XB);
#pragma unroll
  for (int g = 0; g < 4; ++g) {
    const int e0 = et * 32 + 8 * g + 4 * lh;
    u32x2 gr = *reinterpret_cast<const u32x2*>(tm + (size_t)tok * TMW + TM_GR + h * 128 + e0);
    f32x4 ng = *reinterpret_cast<const f32x4*>(p.norm_g + e0);
    float grv[4] = {bflo(gr[0]), bfhi(gr[0]), bflo(gr[1]), bfhi(gr[1])};
    float o[4];
#pragma unroll
    for (int r = 0; r < 4; ++r) {
      float sl = grv[r] / (1.f + __expf(-grv[r]));
      o[r] = O[4 * g + r] * rinv * ng[r] * sl;
    }
    st4bf(y + (size_t)tok * 1024 + 512 + h * 128 + e0, o[0], o[1], o[2], o[3]);
  }
  __syncthreads();
}

template <int MODE>
DI void phase_gemm(const Params& p, const u16* X, const u16* Wt, int N, const float* resid, float* outf, u16* outb, int ldo, char* smem) {
  const int ntn = N / 128;
  const int total = 128 * ntn;
  const int tid = threadIdx.x, lane = tid & 63, wave = tid >> 6;
  const int fw = wave & 1, tq = wave >> 1, lr = lane & 31, lh = lane >> 5;
  for (int t = blockIdx.x; t < total; t += gridDim.x) {
    const int mt = t / ntn, nt = t % ntn;
    f32x16 acc[2][2];
    gemm_tile(X + (size_t)mt * 256 * 1024, 1024, Wt + (size_t)nt * 128 * 1024, 1024, 1024, smem, acc);
    if (MODE == 0 || MODE == 1) {
      float* wl = (float*)(smem + wave * 17408);
#pragma unroll
      for (int tt = 0; tt < 2; ++tt)
#pragma unroll
        for (int ft = 0; ft < 2; ++ft)
#pragma unroll
          for (int g = 0; g < 4; ++g) {
            f32x4 v = {acc[ft][tt][4 * g], acc[ft][tt][4 * g + 1], acc[ft][tt][4 * g + 2], acc[ft][tt][4 * g + 3]};
            *reinterpret_cast<f32x4*>(wl + (tt * 32 + lr) * 68 + ft * 32 + 8 * g + 4 * lh) = v;
          }
      const int ch = lane & 15, r0 = lane >> 4;
      const int f = nt * 128 + fw * 64 + ch * 4;
#pragma unroll 4
      for (int k = 0; k < 16; ++k) {
        const int row = r0 + 4 * k;
        const int tok = mt * 256 + tq * 64 + row;
        f32x4 v = *reinterpret_cast<const f32x4*>(wl + row * 68 + ch * 4);
        if (MODE == 0) {
          f32x4 r = *reinterpret_cast<const f32x4*>(resid + (size_t)tok * 1024 + f);
          f32x4 o;
#pragma unroll
          for (int j = 0; j < 4; ++j) o[j] = ALPHA * r[j] + v[j];
          *reinterpret_cast<f32x4*>(outf + (size_t)tok * 1024 + f) = o;
        } else {
          st4bf(outb + (size_t)tok * ldo + f, v[0], v[1], v[2], v[3]);
        }
      }
      __syncthreads();
    } else {
#pragma unroll
      for (int tt = 0; tt < 2; ++tt) {
        const int tok = mt * 256 + tq * 64 + tt * 32 + lr;
#pragma unroll
        for (int ft = 0; ft < 2; ++ft)
#pragma unroll
          for (int g = 0; g < 4; ++g) {
            const int f = nt * 128 + fw * 64 + ft * 32 + 8 * g + 4 * lh;
            if (MODE == 2) {
              const int hh = f >> 8, fh = f & 255, ks = fh >> 4, lane2 = ((fh >> 3) & 1) * 32 + lr;
              st4bf(outb + ((((size_t)(tok >> 5) * 4 + hh) * 16 + ks) * 64 + lane2) * 8 + 4 * lh, acc[ft][tt][4 * g], acc[ft][tt][4 * g + 1], acc[ft][tt][4 * g + 2], acc[ft][tt][4 * g + 3]);
            } else {
              const int hh = f >> 8, fq = f & 127, half = (f >> 7) & 1, ks = fq >> 4, lane2 = ((fq >> 3) & 1) * 32 + lr;
              st4bf(outb + (((((size_t)(tok >> 5) * 8 + hh) * 2 + half) * 8 + ks) * 64 + lane2) * 8 + 4 * lh, acc[ft][tt][4 * g], acc[ft][tt][4 * g + 1], acc[ft][tt][4 * g + 2], acc[ft][tt][4 * g + 3]);
            }
          }
      }
    }
  }
}

DI void phase_ln(const Params& p, float* h, u16* hb, const float* g, const float* bta) {
  const int lane = threadIdx.x & 63;
  const int gw = (blockIdx.x * blockDim.x + threadIdx.x) >> 6;
  const int nw = (gridDim.x * blockDim.x) >> 6;
  for (int row = gw; row < T_; row += nw) {
    float* r = h + (size_t)row * 1024;
    f32x4 v[4]; float s = 0.f;
#pragma unroll
    for (int c = 0; c < 4; ++c) { v[c] = *reinterpret_cast<const f32x4*>(r + c * 256 + lane * 4); s += v[c][0] + v[c][1] + v[c][2] + v[c][3]; }
    const float mean = wave_sum(s) * (1.f / 1024.f);
    float q = 0.f;
#pragma unroll
    for (int c = 0; c < 4; ++c)
#pragma unroll
      for (int k = 0; k < 4; ++k) { float d = v[c][k] - mean; q += d * d; }
    const float rstd = rsqrtf(wave_sum(q) * (1.f / 1024.f) + 1e-5f);
#pragma unroll
    for (int c = 0; c < 4; ++c) {
      f32x4 gg = *reinterpret_cast<const f32x4*>(g + c * 256 + lane * 4);
      f32x4 bb = *reinterpret_cast<const f32x4*>(bta + c * 256 + lane * 4);
      f32x4 o;
#pragma unroll
      for (int k = 0; k < 4; ++k) o[k] = (v[c][k] - mean) * rstd * gg[k] + bb[k];
      *reinterpret_cast<f32x4*>(r + c * 256 + lane * 4) = o;
      st4bf(hb + (size_t)row * 1024 + c * 256 + lane * 4, o[0], o[1], o[2], o[3]);
    }
  }
}

DI void phase_xattn(const Params& p) {
  const u16* qx = (const u16*)(p.ws + OFF_QX);
  const u16* mk = (const u16*)(p.ws + OFF_MEMK);
  const u16* mv = (const u16*)(p.ws + OFF_MEMVT);
  u16* ox = (u16*)(p.ws + OFF_OX);
  const int lane = threadIdx.x & 63, lr = lane & 31, lh = lane >> 5;
  const int gw = (blockIdx.x * blockDim.x + threadIdx.x) >> 6;
  const int nw = (gridDim.x * blockDim.x) >> 6;
  for (int it = gw; it < 8 * 4 * 128; it += nw) {
    const int qt = it & 127, h = (it >> 7) & 3, b = it >> 9;
    const int tok = b * S_ + qt * 32 + lr;
    f32x16 Sx[8];
#pragma unroll
    for (int kt = 0; kt < 8; ++kt) Sx[kt] = zero16();
    const u16* qrow = qx + (((size_t)(b * 128 + qt) * 4 + h) * 16) * 512 + lane * 8;
    const u16* krow = mk + (((size_t)(b * 4 + h) * 8) * 16) * 512 + lane * 8;
#pragma unroll 2
    for (int ks = 0; ks < 16; ++ks) {
      bf16x8 qf = ldg8(qrow + ks * 512);
#pragma unroll
      for (int kt = 0; kt < 8; ++kt) Sx[kt] = MFMA(ldg8(krow + (kt * 16 + ks) * 512), qf, Sx[kt]);
    }
    float mx = -INFINITY;
#pragma unroll
    for (int kt = 0; kt < 8; ++kt)
#pragma unroll
      for (int i = 0; i < 16; ++i) mx = fmaxf(mx, Sx[kt][i]);
    mx = fmaxf(mx, __shfl_xor(mx, 32));
    float ls = 0.f;
    bf16x8 Pf[8][2];
#pragma unroll
    for (int kt = 0; kt < 8; ++kt) {
      float pv[16];
#pragma unroll
      for (int i = 0; i < 16; ++i) { pv[i] = __expf((Sx[kt][i] - mx) * 0.0625f); ls += pv[i]; }
#pragma unroll
      for (int s = 0; s < 2; ++s) Pf[kt][s] = pack8(pv[8 * s], pv[8 * s + 1], pv[8 * s + 2], pv[8 * s + 3], pv[8 * s + 4], pv[8 * s + 5], pv[8 * s + 6], pv[8 * s + 7]);
    }
    ls += __shfl_xor(ls, 32);
    const float inv = 1.f / ls;
#pragma unroll 1
    for (int dt = 0; dt < 8; ++dt) {
      f32x16 o = zero16();
      const u16* vrow = mv + ((((size_t)(b * 4 + h) * 8 + dt) * 8) * 2) * 512 + lane * 8;
#pragma unroll
      for (int kt = 0; kt < 8; ++kt)
#pragma unroll
        for (int s = 0; s < 2; ++s) o = MFMA(ldg8(vrow + (kt * 2 + s) * 512), Pf[kt][s], o);
#pragma unroll
      for (int g = 0; g < 4; ++g)
        st4bf(ox + (size_t)tok * 1024 + h * 256 + dt * 32 + 8 * g + 4 * lh, o[4 * g] * inv, o[4 * g + 1] * inv, o[4 * g + 2] * inv, o[4 * g + 3] * inv);
    }
  }
}

DI void peer_topk_item(const Params& p, int tt128, int head, char* smem) {
  float* sc = (float*)smem;
  float* topv = (float*)(smem + 132096);
  unsigned char* topi = (unsigned char*)(smem + 132096 + 16384);
  const u16* pq = (const u16*)(p.ws + OFF_QX);
  const u16* sk = (const u16*)(p.ws + OFF_SK);
  const int tid = threadIdx.x, lane = tid & 63, wave = tid >> 6, lr = lane & 31, lh = lane >> 5;
  const int tok0 = tt128 * 128;
  {
    const int half = wave >> 2, kt = wave & 3;
    bf16x8 af[8];
#pragma unroll
    for (int ks = 0; ks < 8; ++ks) af[ks] = ldg8(sk + (size_t)half * 16384 + (kt * 32 + lr) * 128 + ks * 16 + lh * 8);
#pragma unroll 1
    for (int tt = 0; tt < 4; ++tt) {
      f32x16 acc = zero16();
      const u16* brow = pq + (((((size_t)(tok0 >> 5) + tt) * 8 + head) * 2 + half) * 8) * 512 + lane * 8;
#pragma unroll
      for (int ks = 0; ks < 8; ++ks) acc = MFMA(af[ks], ldg8(brow + ks * 512), acc);
#pragma unroll
      for (int i = 0; i < 16; ++i) sc[(half * 128 + tt * 32 + lr) * 129 + kt * 32 + crow(i, lh)] = acc[i];
    }
  }
  __syncthreads();
  if (tid < 256) {
    float* row = sc + tid * 129;
    float gm[8]; int gi[8];
#pragma unroll
    for (int g = 0; g < 8; ++g) {
      float m = -INFINITY; int mi = g * 16;
#pragma unroll
      for (int j = 0; j < 16; ++j) { float v = row[g * 16 + j]; if (v > m) { m = v; mi = g * 16 + j; } }
      gm[g] = m; gi[g] = mi;
    }
#pragma unroll 1
    for (int r = 0; r < 16; ++r) {
      float best = gm[0]; int bg = 0; int bi = gi[0];
#pragma unroll
      for (int g = 1; g < 8; ++g) if (gm[g] > best) { best = gm[g]; bg = g; bi = gi[g]; }
      topv[tid * 16 + r] = best; topi[tid * 16 + r] = (unsigned char)bi;
      row[bi] = -INFINITY;
      float m = -INFINITY; int mi = bg * 16;
#pragma unroll
      for (int j = 0; j < 16; ++j) { float v = row[bg * 16 + j]; if (v > m) { m = v; mi = bg * 16 + j; } }
#pragma unroll
      for (int g = 0; g < 8; ++g) { gm[g] = (g == bg) ? m : gm[g]; gi[g] = (g == bg) ? mi : gi[g]; }
    }
  }
  __syncthreads();
  if (tid < 128) {
    const float* av = topv + tid * 16;
    const float* bv = topv + (128 + tid) * 16;
    const unsigned char* ai = topi + tid * 16;
    const unsigned char* bi_ = topi + (128 + tid) * 16;
    float cur[16]; int pp[16];
    const float b0 = bv[0];
#pragma unroll
    for (int i = 0; i < 16; ++i) { cur[i] = av[i] + b0; pp[i] = 0; }
    float sel[16]; int eid[16];
#pragma unroll
    for (int r = 0; r < 16; ++r) {
      float best = cur[0]; int bi = 0; int bj = pp[0];
#pragma unroll
      for (int i = 1; i < 16; ++i) if (cur[i] > best) { best = cur[i]; bi = i; bj = pp[i]; }
      sel[r] = best;
      eid[r] = (int)ai[bi] * 128 + (int)bi_[bj];
      const int nj = bj + 1;
      const float nv = (nj < 16) ? (av[bi] + bv[nj & 15]) : -INFINITY;
#pragma unroll
      for (int i = 0; i < 16; ++i) { cur[i] = (i == bi) ? nv : cur[i]; pp[i] = (i == bi) ? nj : pp[i]; }
    }
    float sum = 0.f;
    const float smax = sel[0];
#pragma unroll
    for (int r = 0; r < 16; ++r) { sel[r] = __expf(sel[r] - smax); sum += sel[r]; }
    const float inv = 1.f / sum;
    int* eo = (int*)(p.ws + OFF_EIDX) + (size_t)(tok0 + tid) * 128 + head * 16;
    float* go = (float*)(p.ws + OFF_GATE) + (size_t)(tok0 + tid) * 128 + head * 16;
#pragma unroll
    for (int r = 0; r < 16; ++r) { eo[r] = eid[r]; go[r] = sel[r] * inv; }
  }
  __syncthreads();
}

DI float dot2bf(unsigned a, unsigned b, float c) {
  return __builtin_amdgcn_fdot2_f32_bf16(__builtin_bit_cast(bf2_t, a), __builtin_bit_cast(bf2_t, b), c, false);
}

DI float reduce8(float (&part)[8], int lane) {
  float r4[4], r2[2], r1;
#pragma unroll
  for (int k = 0; k < 4; ++k) {
    float send = (lane & 1) ? part[2 * k] : part[2 * k + 1];
    float keep = (lane & 1) ? part[2 * k + 1] : part[2 * k];
    r4[k] = keep + __shfl_xor(send, 1);
  }
#pragma unroll
  for (int k = 0; k < 2; ++k) {
    float send = (lane & 2) ? r4[2 * k] : r4[2 * k + 1];
    float keep = (lane & 2) ? r4[2 * k + 1] : r4[2 * k];
    r2[k] = keep + __shfl_xor(send, 2);
  }
  {
    float send = (lane & 4) ? r2[0] : r2[1];
    float keep = (lane & 4) ? r2[1] : r2[0];
    r1 = keep + __shfl_xor(send, 4);
  }
  r1 += __shfl_xor(r1, 8);
  r1 += __shfl_xor(r1, 16);
  r1 += __shfl_xor(r1, 32);
  return r1;
}

DI void phase_peer_down(const Params& p) {
  const char* exd = p.ws + OFF_EXD;
  const float* esc = (const float*)(p.ws + OFF_ESC);
  const u16* hb = (const u16*)(p.ws + OFF_HB);
  const int* eidx = (const int*)(p.ws + OFF_EIDX);
  const float* gate = (const float*)(p.ws + OFF_GATE);
  float* coefw = (float*)(p.ws + OFF_COEF);
  const int lane = threadIdx.x & 63;
  const int gw = (blockIdx.x * blockDim.x + threadIdx.x) >> 6;
  const int nw = (gridDim.x * blockDim.x) >> 6;
#pragma unroll 1
  for (int sl = 0; sl < 2; ++sl) {
#pragma unroll 1
    for (int tok = gw; tok < T_; tok += nw) {
      float x[16];
      {
        const u16* xr = hb + (size_t)tok * 1024 + lane * 16;
        u32x4 a = *reinterpret_cast<const u32x4*>(xr);
        u32x4 c = *reinterpret_cast<const u32x4*>(xr + 8);
#pragma unroll
        for (int w = 0; w < 4; ++w) { x[2 * w] = bflo(a[w]); x[2 * w + 1] = bfhi(a[w]); x[8 + 2 * w] = bflo(c[w]); x[8 + 2 * w + 1] = bfhi(c[w]); }
      }
#pragma unroll 1
      for (int half = 0; half < 2; ++half) {
        const int ev = eidx[(size_t)tok * 128 + half * 64 + lane];
        const float gv = gate[(size_t)tok * 128 + half * 64 + lane];
        unsigned long long m = __builtin_amdgcn_ballot_w64((ev >> 13) == sl);
        while (m != 0ull) {
          int pos[8];
          const int first = __builtin_ctzll(m);
#pragma unroll
          for (int k = 0; k < 8; ++k) {
            if (m != 0ull) { pos[k] = __builtin_ctzll(m); m &= m - 1ull; } else pos[k] = -1;
          }
          u32x4 dr[8];
#pragma unroll
          for (int k = 0; k < 8; ++k) {
            const int er = __builtin_amdgcn_readlane(ev, pos[k] >= 0 ? pos[k] : first);
            dr[k] = *reinterpret_cast<const u32x4*>(exd + (size_t)er * 1024 + lane * 16);
          }
          int pmine = pos[0];
#pragma unroll
          for (int k = 1; k < 8; ++k) pmine = ((lane & 7) == k) ? pos[k] : pmine;
          const int psafe = pmine >= 0 ? pmine : first;
          const int emine = __shfl(ev, psafe);
          const float gsel = __shfl(gv, psafe);
          const float sd = esc[emine];
          const float su = esc[16384 + emine];
          float part[8];
#pragma unroll
          for (int k = 0; k < 8; ++k) {
            float a0 = 0.f, a1 = 0.f;
#pragma unroll
            for (int w = 0; w < 4; ++w) {
              f2_t lo = __builtin_amdgcn_cvt_pk_f32_fp8((int)dr[k][w], false);
              f2_t hi = __builtin_amdgcn_cvt_pk_f32_fp8((int)dr[k][w], true);
              a0 = fmaf(lo[0], x[4 * w], a0); a1 = fmaf(lo[1], x[4 * w + 1], a1);
              a0 = fmaf(hi[0], x[4 * w + 2], a0); a1 = fmaf(hi[1], x[4 * w + 3], a1);
            }
            part[k] = a0 + a1;
          }
          float r1 = reduce8(part, lane) * sd;
          const float act = 0.5f * r1 * (1.f + erff(r1 * 0.70710678118654752f));
          if (lane < 8 && pmine >= 0) coefw[(size_t)tok * 128 + half * 64 + pmine] = gsel * act * su;
        }
      }
    }
  }
}

DI void phase_peer_ffn(const Params& p) {
  const char* exu = p.ws + OFF_EXU;
  const float* h = (const float*)(p.ws + OFF_H);
  const int* eidx = (const int*)(p.ws + OFF_EIDX);
  const float* coefw = (const float*)(p.ws + OFF_COEF);
  const int lane = threadIdx.x & 63;
  const int gw = (blockIdx.x * blockDim.x + threadIdx.x) >> 6;
  const int nw = (gridDim.x * blockDim.x) >> 6;
  for (int tok = gw; tok < T_; tok += nw) {
    float yacc[16];
#pragma unroll
    for (int i = 0; i < 16; ++i) yacc[i] = 0.f;
    const int e_lo = eidx[(size_t)tok * 128 + lane];
    const int e_hi = eidx[(size_t)tok * 128 + 64 + lane];
    const float c_lo = coefw[(size_t)tok * 128 + lane];
    const float c_hi = coefw[(size_t)tok * 128 + 64 + lane];
#pragma unroll 1
    for (int eb = 0; eb < 8; ++eb) {
      const int ev = (eb < 4) ? e_lo : e_hi;
      const float cv = (eb < 4) ? c_lo : c_hi;
      const int lbase = (eb & 3) * 16;
      u32x4 ur[16];
#pragma unroll
      for (int k = 0; k < 16; ++k) {
        const int er = __builtin_amdgcn_readlane(ev, lbase + k);
        ur[k] = *reinterpret_cast<const u32x4*>(exu + (size_t)er * 1024 + lane * 16);
      }
#pragma unroll
      for (int k = 0; k < 16; ++k) {
        const float ck = __int_as_float(__builtin_amdgcn_readlane(__float_as_int(cv), lbase + k));
#pragma unroll
        for (int w = 0; w < 4; ++w) {
          f2_t lo = __builtin_amdgcn_cvt_pk_f32_fp8((int)ur[k][w], false);
          f2_t hi = __builtin_amdgcn_cvt_pk_f32_fp8((int)ur[k][w], true);
          yacc[4 * w] = fmaf(ck, lo[0], yacc[4 * w]);
          yacc[4 * w + 1] = fmaf(ck, lo[1], yacc[4 * w + 1]);
          yacc[4 * w + 2] = fmaf(ck, hi[0], yacc[4 * w + 2]);
          yacc[4 * w + 3] = fmaf(ck, hi[1], yacc[4 * w + 3]);
        }
      }
    }
    const float* xr = h + (size_t)tok * 1024 + lane * 16;
    float v[16];
#pragma unroll
    for (int c = 0; c < 4; ++c) {
      f32x4 t = *reinterpret_cast<const f32x4*>(xr + c * 4);
#pragma unroll
      for (int k = 0; k < 4; ++k) v[4 * c + k] = ALPHA * t[k] + yacc[4 * c + k];
    }
    float s = 0.f;
#pragma unroll
    for (int i = 0; i < 16; ++i) s += v[i];
    const float mean = wave_sum(s) * (1.f / 1024.f);
    float q = 0.f;
#pragma unroll
    for (int i = 0; i < 16; ++i) { float d = v[i] - mean; q += d * d; }
    const float rstd = rsqrtf(wave_sum(q) * (1.f / 1024.f) + 1e-5f);
    float* orow = p.out + (size_t)tok * 1024 + lane * 16;
#pragma unroll
    for (int c = 0; c < 4; ++c) {
      f32x4 gg = *reinterpret_cast<const f32x4*>(p.ln_ffn_g + lane * 16 + c * 4);
      f32x4 bb = *reinterpret_cast<const f32x4*>(p.ln_ffn_b + lane * 16 + c * 4);
      f32x4 o;
#pragma unroll
      for (int k = 0; k < 4; ++k) o[k] = (v[4 * c + k] - mean) * rstd * gg[k] + bb[k];
      *reinterpret_cast<f32x4*>(orow + c * 4) = o;
    }
  }
}

constexpr size_t OFF_BAR = 166 * MiB;
DI void gbar(unsigned* ctr, unsigned target) {
  asm volatile("s_waitcnt vmcnt(0)" ::: "memory");
  __syncthreads();
  if (threadIdx.x == 0) {
    __builtin_amdgcn_fence(__ATOMIC_RELEASE, "agent");
    asm volatile("s_waitcnt vmcnt(0)" ::: "memory");
    __hip_atomic_fetch_add(ctr, 1u, __ATOMIC_RELAXED, __HIP_MEMORY_SCOPE_AGENT);
    while (__hip_atomic_load(ctr, __ATOMIC_RELAXED, __HIP_MEMORY_SCOPE_AGENT) < target) __builtin_amdgcn_s_sleep(2);
    __builtin_amdgcn_fence(__ATOMIC_ACQUIRE, "agent");
    asm volatile("s_waitcnt vmcnt(0)" ::: "memory");
  }
  __syncthreads();
}

__global__ void __launch_bounds__(512) fwd_megakernel(Params p) {
  __shared__ __attribute__((aligned(1024))) char smem[155648];
  cg::grid_group grid = cg::this_grid();
  const int G = gridDim.x;
  char* ws = p.ws;
  unsigned* bar = (unsigned*)(ws + OFF_BAR);

  phase_prep(p, smem);
  grid.sync();

  phase_inproj(p, smem);
  gbar(bar, (unsigned)(1 * G));

  for (int k = 0; k * G < 1024; ++k) {
    int j = (k & 1) ? (G - 1 - (int)blockIdx.x) : (int)blockIdx.x;
    int idx = k * G + j;
    if (idx < 1024) dsa_thr_item(p, idx & 7, 127 - (idx >> 3), smem);
  }
  for (int it = blockIdx.x; it < 2048; it += G) gla_g1_item(p, it, smem);
  gbar(bar, (unsigned)(2 * G));

  for (int k = 0; k * G < 1024; ++k) {
    int j = (k & 1) ? (G - 1 - (int)blockIdx.x) : (int)blockIdx.x;
    int idx = k * G + j;
    if (idx < 1024) dsa_attn_item(p, idx & 7, 127 - (idx >> 3), smem);
  }
  gla_scan(p);
  gbar(bar, (unsigned)(3 * G));

  for (int it = blockIdx.x; it < 2048; it += G) gla_g3_item(p, it, smem);
  gbar(bar, (unsigned)(4 * G));

  phase_gemm<0>(p, (const u16*)(ws + OFF_XB), (const u16*)(ws + OFF_WOUT), 1024, p.x, (float*)(ws + OFF_H), nullptr, 0, smem);
  gbar(bar, (unsigned)(5 * G));
  phase_ln(p, (float*)(ws + OFF_H), (u16*)(ws + OFF_HB), p.ln_mix_g, p.ln_mix_b);
  gbar(bar, (unsigned)(6 * G));

  phase_gemm<2>(p, (const u16*)(ws + OFF_HB), (const u16*)(ws + OFF_WQ), 1024, nullptr, nullptr, (u16*)(ws + OFF_QX), 1024, smem);
  gbar(bar, (unsigned)(7 * G));
  phase_xattn(p);
  gbar(bar, (unsigned)(8 * G));
  phase_gemm<0>(p, (const u16*)(ws + OFF_OX), (const u16*)(ws + OFF_WO), 1024, (const float*)(ws + OFF_H), (float*)(ws + OFF_H), nullptr, 0, smem);
  gbar(bar, (unsigned)(9 * G));
  phase_ln(p, (float*)(ws + OFF_H), (u16*)(ws + OFF_HB), p.ln_mem_g, p.ln_mem_b);
  gbar(bar, (unsigned)(10 * G));

  phase_gemm<5>(p, (const u16*)(ws + OFF_HB), (const u16*)(ws + OFF_WPQ), 2048, nullptr, nullptr, (u16*)(ws + OFF_QX), 2048, smem);
  gbar(bar, (unsigned)(11 * G));
  for (int it = blockIdx.x; it < 2048; it += G) peer_topk_item(p, it >> 3, it & 7, smem);
  gbar(bar, (unsigned)(12 * G));
  phase_peer_down(p);
  gbar(bar, (unsigned)(13 * G));
  phase_peer_ffn(p);
}

extern "C" void kernel_launch(void* const* d_in, const int* in_sizes, int n_in,
                              void* d_out, int out_size, void* d_ws, size_t ws_size,
                              hipStream_t stream) {
  static int grid_blocks = 0;
  if (!grid_blocks) {
    int dev = 0, cus = 0, per_cu = 0;
    (void)hipGetDevice(&dev);
    (void)hipDeviceGetAttribute(&cus, hipDeviceAttributeMultiprocessorCount, dev);
    (void)hipOccupancyMaxActiveBlocksPerMultiprocessor(&per_cu, fwd_megakernel, 512, 0);
    if (per_cu > 1) per_cu = 1;
    grid_blocks = cus * per_cu;
    if (grid_blocks > 256) grid_blocks = 256;
    if (ws_size < 512 * MiB) fprintf(stderr, "workspace too small: %zu\n", ws_size);
  }
  Params p{};
  p.x = (const float*)d_in[0]; p.positions = (const int*)d_in[1]; p.mem = (const float*)d_in[2]; p.w_in = (const float*)d_in[3];
  p.gate_up = (const float*)d_in[4]; p.gate_bias = (const float*)d_in[5]; p.norm_g = (const float*)d_in[6]; p.w_out = (const float*)d_in[7];
  p.ln_mix_g = (const float*)d_in[8]; p.ln_mix_b = (const float*)d_in[9];
  p.wq = (const float*)d_in[10]; p.wk = (const float*)d_in[11]; p.wv = (const float*)d_in[12]; p.wo = (const float*)d_in[13];
  p.ln_mem_g = (const float*)d_in[14]; p.ln_mem_b = (const float*)d_in[15];
  p.w_pq = (const float*)d_in[16]; p.sk1 = (const float*)d_in[17]; p.sk2 = (const float*)d_in[18];
  p.ex_down = (const float*)d_in[19]; p.ex_up = (const float*)d_in[20];
  p.ln_ffn_g = (const float*)d_in[21]; p.ln_ffn_b = (const float*)d_in[22];
  p.out = (float*)d_out; p.ws = (char*)d_ws;
  (void)hipMemsetAsync((char*)d_ws + OFF_BAR, 0, 256, stream);
  void* args[] = {&p};
  hipError_t e = hipLaunchCooperativeKernel((void*)fwd_megakernel, dim3(grid_blocks), dim3(512), args, 0, stream);
  if (e != hipSuccess) fprintf(stderr, "cooperative launch failed: %s (grid %d)\n", hipGetErrorString(e), grid_blocks);
}
```

```cpp
#include <hip/hip_runtime.h>
#include <hip/hip_cooperative_groups.h>
#include <cstdio>
#include <cmath>
namespace cg = cooperative_groups;

#define DI __device__ __forceinline__
typedef short bf16x8 __attribute__((ext_vector_type(8)));
typedef short bf16x4 __attribute__((ext_vector_type(4)));
typedef float f32x16 __attribute__((ext_vector_type(16)));
typedef float f32x4 __attribute__((ext_vector_type(4)));
typedef unsigned u32x4 __attribute__((ext_vector_type(4)));
typedef unsigned u32x2 __attribute__((ext_vector_type(2)));
typedef unsigned short u16;
typedef __bf16 bf2_t __attribute__((ext_vector_type(2)));
typedef float f2_t __attribute__((ext_vector_type(2)));

#define MFMA(a, b, c) __builtin_amdgcn_mfma_f32_32x32x16_bf16((a), (b), (c), 0, 0, 0)

constexpr int T_ = 32768;
constexpr int S_ = 4096;
constexpr int TMW = 2368;
constexpr int TM_Q = 0, TM_K = 512, TM_QI = 1024, TM_KI = 1280, TM_WI = 1312, TM_GLR = 1320, TM_GQ = 1344, TM_GK = 1600, TM_GR = 1856;
constexpr int PROJ_N = 3456;
constexpr float ALPHA = 1.189207115002721f;
constexpr size_t MiB = 1024 * 1024;

constexpr size_t OFF_XB = 0;
constexpr size_t OFF_EXD = 64 * MiB;
constexpr size_t OFF_EXU = 80 * MiB;
constexpr size_t OFF_BCG = 96 * MiB;
constexpr size_t OFF_WIN = 128 * MiB;
constexpr size_t OFF_WOUT = OFF_WIN + (size_t)PROJ_N * 1024 * 2;
constexpr size_t OFF_WQ = OFF_WOUT + 2 * MiB;
constexpr size_t OFF_WK = OFF_WQ + 2 * MiB;
constexpr size_t OFF_WV = OFF_WK + 2 * MiB;
constexpr size_t OFF_WO = OFF_WV + 2 * MiB;
constexpr size_t OFF_WPQ = OFF_WO + 2 * MiB;
constexpr size_t OFF_KIF = 149 * MiB;
constexpr size_t OFF_MEMB = 152 * MiB;
constexpr size_t OFF_MEMK = 156 * MiB;
constexpr size_t OFF_MEMVT = 160 * MiB;
constexpr size_t OFF_THR = 164 * MiB;
constexpr size_t OFF_SK = OFF_THR + 256 * 1024;
constexpr size_t OFF_DECAY = OFF_SK + 128 * 1024;
constexpr size_t OFF_ESC = 165 * MiB;
constexpr size_t OFF_TM = 168 * MiB;
constexpr size_t OFF_VT = 316 * MiB;
constexpr size_t OFF_KFR = 476 * MiB;
constexpr size_t OFF_GVT = 348 * MiB;
constexpr size_t OFF_KVT = 380 * MiB;
constexpr size_t OFF_PREV = 444 * MiB;
constexpr size_t OFF_H = 168 * MiB;
constexpr size_t OFF_HB = 296 * MiB;
constexpr size_t OFF_QX = 360 * MiB;
constexpr size_t OFF_OX = 424 * MiB;
constexpr size_t OFF_EIDX = 0;
constexpr size_t OFF_GATE = 16 * MiB;
constexpr size_t OFF_COEF = 32 * MiB;

struct Params {
  const float* x; const int* positions; const float* mem; const float* w_in;
  const float* gate_up; const float* gate_bias; const float* norm_g; const float* w_out;
  const float* ln_mix_g; const float* ln_mix_b;
  const float* wq; const float* wk; const float* wv; const float* wo;
  const float* ln_mem_g; const float* ln_mem_b;
  const float* w_pq; const float* sk1; const float* sk2; const float* ex_down; const float* ex_up;
  const float* ln_ffn_g; const float* ln_ffn_b;
  float* out; char* ws;
};

DI unsigned pk_bf16(float a, float b) {
  f2_t v = {a, b};
  bf2_t r = __builtin_convertvector(v, bf2_t);
  return __builtin_bit_cast(unsigned, r);
}
DI u16 f2bf(float a) { return (u16)(pk_bf16(a, 0.f) & 0xffffu); }
DI float bf2f(u16 u) { return __uint_as_float(((unsigned)u) << 16); }
DI float bflo(unsigned u) { return __uint_as_float(u << 16); }
DI float bfhi(unsigned u) { return __uint_as_float(u & 0xffff0000u); }
DI int crow(int i, int h) { return (i & 3) + 8 * (i >> 2) + 4 * h; }
DI bf16x8 ldg8(const u16* p) { return *reinterpret_cast<const bf16x8*>(p); }
DI bf16x8 pack8(float a0, float a1, float a2, float a3, float a4, float a5, float a6, float a7) {
  u32x4 r; r[0] = pk_bf16(a0, a1); r[1] = pk_bf16(a2, a3); r[2] = pk_bf16(a4, a5); r[3] = pk_bf16(a6, a7);
  return __builtin_bit_cast(bf16x8, r);
}
DI bf16x8 cat44(bf16x4 lo, bf16x4 hi) { return __builtin_shufflevector(lo, hi, 0, 1, 2, 3, 4, 5, 6, 7); }
DI void st4bf(u16* p, float a, float b, float c, float d) {
  u32x2 v; v[0] = pk_bf16(a, b); v[1] = pk_bf16(c, d);
  *reinterpret_cast<u32x2*>(p) = v;
}
DI float wave_sum(float v) {
#pragma unroll
  for (int d = 32; d >= 1; d >>= 1) v += __shfl_xor(v, d);
  return v;
}
DI void sincos_rad(float ang, float& s, float& c) {
  constexpr float C_hi = (float)0.15915494309189535;
  constexpr float C_lo = (float)(0.15915494309189535 - (double)C_hi);
  float k = rintf(ang * C_hi);
  float f = fmaf(ang, C_hi, -k);
  f = fmaf(ang, C_lo, f);
  s = __builtin_amdgcn_sinf(f);
  c = __builtin_amdgcn_cosf(f);
}
DI unsigned fkey(float s) {
  const unsigned u = __float_as_uint(s);
  return u ^ ((unsigned)((int)u >> 31) | 0x80000000u);
}
DI f32x16 zero16() { f32x16 z; for (int i = 0; i < 16; ++i) z[i] = 0.f; return z; }

DI int win_src_col(int n) {
  if (n < 1832) return n;
  if (n < 1848) return 2856 + (n - 1832);
  if (n < 1856) return -1;
  if (n < 2880) return n - 24;
  if (n < 3392) return n - 8;
  return -1;
}

DI void cvt_stream(const float* __restrict__ src, u16* __restrict__ dst, size_t n, size_t gtid, size_t gn) {
  size_t n8 = n / 8;
  for (size_t i = gtid; i < n8; i += gn) {
    f32x4 a = *reinterpret_cast<const f32x4*>(src + i * 8);
    f32x4 b = *reinterpret_cast<const f32x4*>(src + i * 8 + 4);
    u32x4 r; r[0] = pk_bf16(a[0], a[1]); r[1] = pk_bf16(a[2], a[3]); r[2] = pk_bf16(b[0], b[1]); r[3] = pk_bf16(b[2], b[3]);
    *reinterpret_cast<u32x4*>(dst + i * 8) = r;
  }
}

template <bool MAPPED>
DI void transpose_tile(const float* __restrict__ W, int ldn, u16* __restrict__ Wt, int k0, int n0, float* tile) {
  const int tid = threadIdx.x;
  {
    int nn = n0 + (tid & 63);
    int c = MAPPED ? win_src_col(nn) : nn;
#pragma unroll
    for (int rr = 0; rr < 8; ++rr) {
      int kk = (tid >> 6) + 8 * rr;
      float v = (c >= 0) ? W[(size_t)(k0 + kk) * ldn + c] : 0.f;
      tile[kk * 65 + (tid & 63)] = v;
    }
  }
  __syncthreads();
#pragma unroll
  for (int rr = 0; rr < 8; ++rr) {
    int nn = (tid >> 6) + 8 * rr;
    int kk = tid & 63;
    Wt[(size_t)(n0 + nn) * 1024 + k0 + kk] = f2bf(tile[kk * 65 + nn]);
  }
  __syncthreads();
}

DI void phase_prep(const Params& p, char* smem) {
  const size_t gtid = (size_t)blockIdx.x * blockDim.x + threadIdx.x;
  const size_t gn = (size_t)gridDim.x * blockDim.x;
  char* ws = p.ws;
  cvt_stream(p.x, (u16*)(ws + OFF_XB), (size_t)T_ * 1024, gtid, gn);
  cvt_stream(p.mem, (u16*)(ws + OFF_MEMB), (size_t)2048 * 1024, gtid, gn);
  {
    const int lane = threadIdx.x & 63;
    const int gw = (int)(gtid >> 6), nw = (int)(gn >> 6);
    for (int r = gw; r < 2 * 16384; r += nw) {
      const int tbl = r >> 14, row = r & 16383;
      const float* src = (tbl ? p.ex_up : p.ex_down) + (size_t)row * 1024 + lane * 16;
      f32x4 v[4]; float mx = 0.f;
#pragma unroll
      for (int c = 0; c < 4; ++c) {
        v[c] = *reinterpret_cast<const f32x4*>(src + c * 4);
#pragma unroll
        for (int k = 0; k < 4; ++k) mx = fmaxf(mx, fabsf(v[c][k]));
      }
#pragma unroll
      for (int d = 32; d >= 1; d >>= 1) mx = fmaxf(mx, __shfl_xor(mx, d));
      float sc = (mx > 0.f) ? exp2f(floorf(log2f(224.f / mx))) : 1.f;
      u32x4 o;
#pragma unroll
      for (int c = 0; c < 4; ++c) {
        int t = __builtin_amdgcn_cvt_pk_fp8_f32(v[c][0] * sc, v[c][1] * sc, 0, false);
        t = __builtin_amdgcn_cvt_pk_fp8_f32(v[c][2] * sc, v[c][3] * sc, t, true);
        o[c] = (unsigned)t;
      }
      *reinterpret_cast<u32x4*>(ws + (tbl ? OFF_EXU : OFF_EXD) + (size_t)row * 1024 + lane * 16) = o;
      if (lane == 0) ((float*)(ws + OFF_ESC))[r] = 1.f / sc;
    }
  }
  cvt_stream(p.sk1, (u16*)(ws + OFF_SK), (size_t)128 * 128, gtid, gn);
  cvt_stream(p.sk2, (u16*)(ws + OFF_SK) + 128 * 128, (size_t)128 * 128, gtid, gn);
  float* tile = (float*)smem;
  const int n_win = 54 * 16, n_sq = 256, n_pq = 512;
  const int total = n_win + 5 * n_sq + n_pq;
  for (int t = blockIdx.x; t < total; t += gridDim.x) {
    if (t < n_win) {
      transpose_tile<true>(p.w_in, 3384, (u16*)(ws + OFF_WIN), (t & 15) * 64, (t >> 4) * 64, tile);
    } else if (t < n_win + 5 * n_sq) {
      int u = t - n_win; int which = u >> 8; int r = u & 255;
      const float* W = which == 0 ? p.w_out : which == 1 ? p.wq : which == 2 ? p.wk : which == 3 ? p.wv : p.wo;
      size_t off = which == 0 ? OFF_WOUT : which == 1 ? OFF_WQ : which == 2 ? OFF_WK : which == 3 ? OFF_WV : OFF_WO;
      transpose_tile<false>(W, 1024, (u16*)(ws + off), (r & 15) * 64, (r >> 4) * 64, tile);
    } else {
      int r = t - n_win - 5 * n_sq;
      transpose_tile<false>(p.w_pq, 2048, (u16*)(ws + OFF_WPQ), (r & 15) * 64, (r >> 4) * 64, tile);
    }
  }
}

#define WAIT_V(n) asm volatile("s_waitcnt vmcnt(%0)" ::"n"(n) : "memory")
#define RAW_BARRIER() do { asm volatile("s_waitcnt lgkmcnt(0)" ::: "memory"); __builtin_amdgcn_s_barrier(); asm volatile("" ::: "memory"); } while (0)
constexpr int G_STAGE = 384 * 128;
DI void gemm_tile(const u16* __restrict__ X, int ldx, const u16* __restrict__ Wt, int ldw, int K, char* smem,
                  f32x16 (&acc)[2][2]) {
  const int tid = threadIdx.x, lane = tid & 63, wave = tid >> 6;
  const int fw = wave & 1, tq = wave >> 1, lr = lane & 31, lh = lane >> 5;
#pragma unroll
  for (int a = 0; a < 2; ++a)
#pragma unroll
    for (int b = 0; b < 2; ++b) acc[a][b] = zero16();
  const int nk = K / 64;
  const u16* src[6];
#pragma unroll
  for (int i = 0; i < 6; ++i) {
    const int R = 8 * (wave + 8 * i) + (lane >> 3);
    const int c = (lane & 7) ^ ((R >> 1) & 7);
    src[i] = (i < 4) ? (X + (size_t)R * ldx + c * 8) : (Wt + (size_t)(R - 256) * ldw + c * 8);
  }
#define GLDS_STAGE(slot, kt) do { _Pragma("unroll") for (int i = 0; i < 6; ++i) \
    __builtin_amdgcn_global_load_lds((const unsigned*)(src[i] + (kt) * 64), (__attribute__((address_space(3))) unsigned*)(smem + (slot) * G_STAGE + (wave + 8 * i) * 1024), 16, 0, 0); } while (0)
  int offA[2], offB[2], xa[2], xb[2];
#pragma unroll
  for (int ft = 0; ft < 2; ++ft) { const int R = 256 + fw * 64 + ft * 32 + lr; offA[ft] = R * 128; xa[ft] = (R >> 1) & 7; }
#pragma unroll
  for (int tt = 0; tt < 2; ++tt) { const int R = tq * 64 + tt * 32 + lr; offB[tt] = R * 128; xb[tt] = (R >> 1) & 7; }
  GLDS_STAGE(0, 0); GLDS_STAGE(1, 1); WAIT_V(6); RAW_BARRIER();
  int cur = 0;
  for (int kt = 0; kt < nk; ++kt) {
    const int nxt = (cur >= 1) ? cur - 1 : 2;
    if (kt + 2 < nk) GLDS_STAGE(nxt, kt + 2);
    __builtin_amdgcn_sched_barrier(0);
    const char* st = smem + cur * G_STAGE;
#pragma unroll
    for (int ks = 0; ks < 4; ++ks) {
      bf16x8 a[2], b[2];
#pragma unroll
      for (int ft = 0; ft < 2; ++ft) a[ft] = *reinterpret_cast<const bf16x8*>(st + offA[ft] + (((ks * 2 + lh) ^ xa[ft]) << 4));
#pragma unroll
      for (int tt = 0; tt < 2; ++tt) b[tt] = *reinterpret_cast<const bf16x8*>(st + offB[tt] + (((ks * 2 + lh) ^ xb[tt]) << 4));
#pragma unroll
      for (int ft = 0; ft < 2; ++ft)
#pragma unroll
        for (int tt = 0; tt < 2; ++tt) acc[ft][tt] = MFMA(a[ft], b[tt], acc[ft][tt]);
    }
    if (kt + 2 < nk) { WAIT_V(6); } else { WAIT_V(0); }
    RAW_BARRIER();
    cur = (cur == 2) ? 0 : cur + 1;
  }
#undef GLDS_STAGE
}

DI void store_tm_rows(f32x16 (&acc)[2][2], char* smem, u16* tm, int tokbase, int col) {
  const int lane = threadIdx.x & 63, wave = threadIdx.x >> 6, lr = lane & 31, lh = lane >> 5;
  float* wl = (float*)(smem + wave * 17408);
#pragma unroll
  for (int tt = 0; tt < 2; ++tt)
#pragma unroll
    for (int ft = 0; ft < 2; ++ft)
#pragma unroll
      for (int g = 0; g < 4; ++g) {
        f32x4 v = {acc[ft][tt][4 * g], acc[ft][tt][4 * g + 1], acc[ft][tt][4 * g + 2], acc[ft][tt][4 * g + 3]};
        *reinterpret_cast<f32x4*>(wl + (tt * 32 + lr) * 68 + ft * 32 + 8 * g + 4 * lh) = v;
      }
  const int ch = lane & 15, r0 = lane >> 4;
#pragma unroll 4
  for (int k = 0; k < 16; ++k) {
    const int row = r0 + 4 * k;
    f32x4 v = *reinterpret_cast<const f32x4*>(wl + row * 68 + ch * 4);
    st4bf(tm + (size_t)(tokbase + row) * TMW + col + ch * 4, v[0], v[1], v[2], v[3]);
  }
}

DI void epi_inproj(const Params& p, int tok0, int f0, f32x16 (&acc)[2][2], char* smem) {
  const int tid = threadIdx.x, lane = tid & 63, wave = tid >> 6;
  const int fw = wave & 1, tq = wave >> 1, lr = lane & 31, lh = lane >> 5;
  const int fbase = f0 + fw * 64;
  if (fbase >= 3392) return;
  u16* tm = (u16*)(p.ws + OFF_TM);
  int tmcol = -1;
#pragma unroll
  for (int tt = 0; tt < 2; ++tt) {
    const int tok = tok0 + tq * 64 + tt * 32 + lr;
    const float posf = (float)p.positions[tok];
    const int bb = tok >> 12, ss = tok & 4095;
    if (fbase < 1024) {
#pragma unroll
      for (int r = 0; r < 4; ++r) {
        float j = (float)(4 * lh + r);
        float inv = exp2f(-j * (18.931568569324174f / 8.0f));
        float sn, cs; sincos_rad(posf * inv, sn, cs);
        float x1 = acc[0][tt][r], x2 = acc[0][tt][r + 4];
        acc[0][tt][r] = x1 * cs - x2 * sn;
        acc[0][tt][r + 4] = x2 * cs + x1 * sn;
      }
      if (fbase < 512) {
        tmcol = fbase;
      } else {
        u16* kfr = (u16*)(p.ws + OFF_KFR);
        const int head = (fbase - 512) >> 6, gt = ss >> 5;
#pragma unroll
        for (int ft = 0; ft < 2; ++ft)
#pragma unroll
          for (int g = 0; g < 4; ++g) {
            const int ks = ft * 2 + (g >> 1), lane2 = (g & 1) * 32 + lr;
            st4bf(kfr + ((((size_t)(bb * 8 + head) * 128 + gt) * 4 + ks) * 64 + lane2) * 8 + 4 * lh, acc[ft][tt][4 * g], acc[ft][tt][4 * g + 1], acc[ft][tt][4 * g + 2], acc[ft][tt][4 * g + 3]);
          }
      }
    } else if (fbase < 1536) {
      u16* vfr = (u16*)(p.ws + OFF_VT);
      const int head = (fbase - 1024) >> 6, gt = ss >> 5;
      const int s = lr >> 4, r16 = lr & 15, j = 4 * (r16 >> 3) + (r16 & 3), lh2 = (r16 >> 2) & 1;
#pragma unroll
      for (int ft = 0; ft < 2; ++ft)
#pragma unroll
        for (int i = 0; i < 16; ++i) {
          const int lane2 = lh2 * 32 + crow(i, lh);
          vfr[((((((size_t)(bb * 8 + head) * 128 + gt) * 2 + ft) * 2 + s) * 64 + lane2) * 8) + j] = f2bf(acc[ft][tt][i]);
        }
    } else if (fbase >= 2368 && fbase < 2880) {
      u16* vt = (u16*)(p.ws + OFF_GVT);
      const int fo = fbase - 2368;
#pragma unroll
      for (int ft = 0; ft < 2; ++ft)
#pragma unroll
        for (int i = 0; i < 16; ++i) {
          int feat = fo + ft * 32 + crow(i, lh);
          vt[((size_t)bb * 512 + feat) * 4096 + ss] = f2bf(acc[ft][tt][i]);
        }
    } else {
      if (fbase < 1856) {
#pragma unroll
        for (int ft = 0; ft < 2; ++ft) {
          const bool rot = (fbase < 1792) || (ft == 0);
#pragma unroll
          for (int r = 0; r < 4; ++r) {
            float v = acc[ft][tt][r];
            float o = __shfl_xor(v, 32);
            float inv = exp2f(-(float)r * (18.931568569324174f / 4.0f));
            float sn, cs; sincos_rad(posf * inv, sn, cs);
            float res = (lh == 0) ? (v * cs - o * sn) : (v * cs + o * sn);
            acc[ft][tt][r] = rot ? res : v;
          }
        }
        tmcol = fbase - 512;
        if (fbase == 1792) {
          u16* kif = (u16*)(p.ws + OFF_KIF);
          const int gt = ss >> 5;
#pragma unroll
          for (int g = 0; g < 4; ++g) {
            const int ks = g >> 1, lane2 = (g & 1) * 32 + lr;
            st4bf(kif + ((((size_t)bb * 128 + gt) * 2 + ks) * 64 + lane2) * 8 + 4 * lh, acc[0][tt][4 * g], acc[0][tt][4 * g + 1], acc[0][tt][4 * g + 2], acc[0][tt][4 * g + 3]);
          }
        }
      } else if (fbase < 2368) {
        tmcol = fbase - 512;
      } else {
        tmcol = fbase - 1024;
      }
    }
  }
  if (tmcol >= 0) store_tm_rows(acc, smem, tm, tok0 + tq * 64, tmcol);
}

DI void phase_inproj(const Params& p, char* smem) {
  const int n_in = 128 * 27;
  const int total = n_in + 128;
  const u16* xb = (const u16*)(p.ws + OFF_XB);
  const u16* memb = (const u16*)(p.ws + OFF_MEMB);
  const int tid = threadIdx.x, lane = tid & 63, wave = tid >> 6;
  const int fw = wave & 1, tq = wave >> 1, lr = lane & 31, lh = lane >> 5;
  for (int t = blockIdx.x; t < total; t += gridDim.x) {
    f32x16 acc[2][2];
    if (t < n_in) {
      int mt = t / 27, nt = t % 27;
      gemm_tile(xb + (size_t)mt * 256 * 1024, 1024, (const u16*)(p.ws + OFF_WIN) + (size_t)nt * 128 * 1024, 1024, 1024, smem, acc);
      epi_inproj(p, mt * 256, nt * 128, acc, smem);
      __syncthreads();
    } else {
      int u = t - n_in; int which = u >> 6; int r = u & 63; int mt = r >> 3, nt = r & 7;
      const u16* W = (const u16*)(p.ws + (which == 0 ? OFF_WK : OFF_WV));
      gemm_tile(memb + (size_t)mt * 256 * 1024, 1024, W + (size_t)nt * 128 * 1024, 1024, 1024, smem, acc);
#pragma unroll
      for (int tt = 0; tt < 2; ++tt) {
        const int tok = mt * 256 + tq * 64 + tt * 32 + lr;
        const int bb = tok >> 8, mm = tok & 255, hh = nt >> 1, kt = mm >> 5;
        if (which == 0) {
          u16* mk = (u16*)(p.ws + OFF_MEMK);
#pragma unroll
          for (int ft = 0; ft < 2; ++ft)
#pragma unroll
            for (int g = 0; g < 4; ++g) {
              const int ks = (nt & 1) * 8 + fw * 4 + ft * 2 + (g >> 1), lane2 = (g & 1) * 32 + lr;
              st4bf(mk + ((((size_t)(bb * 4 + hh) * 8 + kt) * 16 + ks) * 64 + lane2) * 8 + 4 * lh, acc[ft][tt][4 * g], acc[ft][tt][4 * g + 1], acc[ft][tt][4 * g + 2], acc[ft][tt][4 * g + 3]);
            }
        } else {
          u16* mv = (u16*)(p.ws + OFF_MEMVT);
          const int s = lr >> 4, r16 = lr & 15, j = 4 * (r16 >> 3) + (r16 & 3), lh2 = (r16 >> 2) & 1;
#pragma unroll
          for (int ft = 0; ft < 2; ++ft) {
            const int dt = (nt & 1) * 4 + fw * 2 + ft;
#pragma unroll
            for (int i = 0; i < 16; ++i) {
              const int lane2 = lh2 * 32 + crow(i, lh);
              mv[((((((size_t)(bb * 4 + hh) * 8 + dt) * 8 + kt) * 2 + s) * 64 + lane2) * 8) + j] = f2bf(acc[ft][tt][i]);
            }
          }
        }
      }
    }
  }
}

DI void idx_scores(const bf16x8 (&qf)[8][2], const float (&wq)[8], bf16x8 k0, bf16x8 k1, float (&sc)[16]) {
#pragma unroll
  for (int i = 0; i < 16; ++i) sc[i] = 0.f;
#pragma unroll
  for (int hd = 0; hd < 8; ++hd) {
    f32x16 a = zero16();
    a = MFMA(k0, qf[hd][0], a);
    a = MFMA(k1, qf[hd][1], a);
#pragma unroll
    for (int i = 0; i < 16; ++i) sc[i] = fmaf(wq[hd], fmaxf(a[i], 0.f), sc[i]);
  }
}

DI void load_idx_q(const u16* tm, int tok, int lh, bf16x8 (&qf)[8][2], float (&wq)[8]) {
  const u16* row = tm + (size_t)tok * TMW;
#pragma unroll
  for (int hd = 0; hd < 8; ++hd)
#pragma unroll
    for (int ks = 0; ks < 2; ++ks) qf[hd][ks] = ldg8(row + TM_QI + hd * 32 + ks * 16 + lh * 8);
  bf16x8 w8 = ldg8(row + TM_WI);
#pragma unroll
  for (int hd = 0; hd < 8; ++hd) wq[hd] = bf2f((u16)w8[hd]) * 0.0625f;
}

DI int wave_incl_scan(int v, int lane) {
#pragma unroll
  for (int d = 1; d < 64; d <<= 1) {
    int t = __shfl_up(v, d);
    if (lane >= d) v += t;
  }
  return v;
}

DI void dsa_thr_item(const Params& p, int b, int qblk, char* smem) {
  unsigned* hist = (unsigned*)smem;
  unsigned* pref = (unsigned*)(smem + 32768);
  int* rank = (int*)(smem + 32768 + 128);
  const u16* tm = (const u16*)(p.ws + OFF_TM);
  const int tid = threadIdx.x, lane = tid & 63, wave = tid >> 6, lr = lane & 31, lh = lane >> 5;
  const int q0 = qblk * 32;
  u16* qi = (u16*)(smem + 33280);
  for (int i = tid; i < 32 * 32; i += 512) {
    int q = i >> 5, ch = i & 31;
    *reinterpret_cast<u32x4*>(qi + q * 296 + ch * 8) = *reinterpret_cast<const u32x4*>(tm + (size_t)(b * S_ + q0 + q) * TMW + TM_QI + ch * 8);
  }
  float wq[8];
  {
    bf16x8 w8 = ldg8(tm + (size_t)(b * S_ + q0 + lr) * TMW + TM_WI);
#pragma unroll
    for (int hd = 0; hd < 8; ++hd) wq[hd] = bf2f((u16)w8[hd]) * 0.0625f;
  }
  __syncthreads();
  for (int i = tid; i < 32 * 32; i += 512) {
    const int q = i >> 5, d = i & 31;
    float acc = 0.f;
#pragma unroll
    for (int hd = 0; hd < 8; ++hd) acc = fmaf(bf2f(tm[(size_t)(b * S_ + q0 + q) * TMW + TM_WI + hd]) * 0.0625f, bf2f(qi[q * 296 + hd * 32 + d]), acc);
    qi[q * 296 + 256 + d] = f2bf(acc);
  }
  const u16* qil = qi + lr * 296 + lh * 8;
  if (tid < 32) { pref[tid] = 0u; rank[tid] = min(256, q0 + tid + 1); }
  for (int pass = 0; pass < 4; ++pass) {
    for (int i = tid; i < 8192; i += 512) hist[i] = 0u;
    __syncthreads();
    const int shift = 24 - 8 * pass;
    const unsigned mypref = pref[lr];
    const u16* kib = (const u16*)(p.ws + OFF_KIF) + (size_t)b * 128 * 1024 + lane * 8;
    bf16x8 kn0, kn1;
    {
      const int kt0 = min(wave, qblk);
      kn0 = ldg8(kib + (size_t)kt0 * 1024); kn1 = ldg8(kib + (size_t)kt0 * 1024 + 512);
    }
    for (int kt = wave; kt <= qblk; kt += 8) {
      const bf16x8 k0 = kn0, k1 = kn1;
      {
        const int ktn = min(kt + 8, qblk);
        kn0 = ldg8(kib + (size_t)ktn * 1024); kn1 = ldg8(kib + (size_t)ktn * 1024 + 512);
      }
      float sc[16];
      {
        f32x16 a = zero16();
        a = MFMA(k0, *reinterpret_cast<const bf16x8*>(qil + 256), a);
        a = MFMA(k1, *reinterpret_cast<const bf16x8*>(qil + 256 + 16), a);
#pragma unroll
        for (int i = 0; i < 16; ++i) sc[i] = a[i];
      }
#pragma unroll
      for (int hd = 0; hd < 8; ++hd) {
        f32x16 a = zero16();
        a = MFMA(k0, *reinterpret_cast<const bf16x8*>(qil + hd * 32), a);
        a = MFMA(k1, *reinterpret_cast<const bf16x8*>(qil + hd * 32 + 16), a);
        const float wh = wq[hd];
#pragma unroll
        for (int i = 0; i < 16; ++i) sc[i] = fmaf(fabsf(a[i]), wh, sc[i]);
      }
      if (kt == qblk) {
#pragma unroll
        for (int i = 0; i < 16; ++i) {
          int kp = kt * 32 + crow(i, lh);
          unsigned ky = fkey(sc[i]);
          unsigned hi = (ky >> shift);
          if (kp <= q0 + lr && (hi >> 8) == mypref) atomicAdd(&hist[(hi & 255u) * 32 + lr], 1u);
        }
      } else {
#pragma unroll
        for (int i = 0; i < 16; ++i) {
          unsigned ky = fkey(sc[i]);
          unsigned hi = (ky >> shift);
          if ((hi >> 8) == mypref) atomicAdd(&hist[(hi & 255u) * 32 + lr], 1u);
        }
      }
    }
    __syncthreads();
#pragma unroll 1
    for (int qq = 0; qq < 4; ++qq) {
      const int q = wave * 4 + qq;
      const int rk = rank[q];
      int c[4];
#pragma unroll
      for (int j = 0; j < 4; ++j) c[j] = (int)hist[(255 - 4 * lane - j) * 32 + q];
      int s = c[0] + c[1] + c[2] + c[3];
      int P = wave_incl_scan(s, lane);
      int excl = P - s;
      if (P >= rk && excl < rk) {
        int cum = excl; int bin = 0; int nr = 1; bool found = false;
#pragma unroll
        for (int j = 0; j < 4; ++j) {
          if (!found && cum + c[j] >= rk) { bin = 255 - 4 * lane - j; nr = rk - cum; found = true; }
          if (!found) cum += c[j];
        }
        pref[q] = (pref[q] << 8) | (unsigned)bin;
        rank[q] = nr;
      }
    }
    __syncthreads();
  }
  if (tid < 32) ((unsigned*)(p.ws + OFF_THR))[b * S_ + q0 + tid] = pref[tid];
  __syncthreads();
}

DI void dsa_attn_item(const Params& p, int b, int qblk, char* smem) {
  u16* maskbuf = (u16*)smem;
  u16* qi = (u16*)(smem + 4096);
  const u16* tm = (const u16*)(p.ws + OFF_TM);
  const u16* vfr = (const u16*)(p.ws + OFF_VT) + ((size_t)(b * 8 + (threadIdx.x >> 6)) * 128) * 2048 + (threadIdx.x & 63) * 8;
  const u16* kfr = (const u16*)(p.ws + OFF_KFR) + ((size_t)(b * 8 + (threadIdx.x >> 6)) * 128) * 2048 + (threadIdx.x & 63) * 8;
  const unsigned* thr = (const unsigned*)(p.ws + OFF_THR);
  const int tid = threadIdx.x, lane = tid & 63, wave = tid >> 6, lr = lane & 31, lh = lane >> 5;
  const int q0 = qblk * 32;
  const int head = wave;
  const int qtok = b * S_ + q0 + lr;
  bf16x8 Qf[4];
#pragma unroll
  for (int ks = 0; ks < 4; ++ks) {
    bf16x8 raw = ldg8(tm + (size_t)qtok * TMW + TM_Q + head * 64 + ks * 16 + lh * 8);
    float f[8];
#pragma unroll
    for (int j = 0; j < 8; ++j) f[j] = bf2f((u16)raw[j]) * (0.125f * 1.4426950408889634f);
    Qf[ks] = pack8(f[0], f[1], f[2], f[3], f[4], f[5], f[6], f[7]);
  }
  f32x16 O[2];
  O[0] = zero16(); O[1] = zero16();
  float mrun = -INFINITY, lrun = 0.f;
  const unsigned thrq = thr[qtok];
  const int nchunks = (q0 + 31) / 256 + 1;
  for (int i = tid; i < 32 * 32; i += 512) {
    int q = i >> 5, ch = i & 31;
    *reinterpret_cast<u32x4*>(qi + q * 296 + ch * 8) = *reinterpret_cast<const u32x4*>(tm + (size_t)(b * S_ + q0 + q) * TMW + TM_QI + ch * 8);
  }
  float* wqs = (float*)(smem + 4096 + 32 * 296 * 2);
  if (tid < 256) wqs[tid] = bf2f(tm[(size_t)(b * S_ + q0 + (tid & 31)) * TMW + TM_WI + (tid >> 5)]) * 0.0625f;
  __syncthreads();
  for (int i = tid; i < 32 * 32; i += 512) {
    const int q = i >> 5, d = i & 31;
    float acc = 0.f;
#pragma unroll
    for (int hd = 0; hd < 8; ++hd) acc = fmaf(bf2f(tm[(size_t)(b * S_ + q0 + q) * TMW + TM_WI + hd]) * 0.0625f, bf2f(qi[q * 296 + hd * 32 + d]), acc);
    qi[q * 296 + 256 + d] = f2bf(acc);
  }
  __syncthreads();
  const u16* qil = qi + lr * 296 + lh * 8;
  const u16* kibase = (const u16*)(p.ws + OFF_KIF) + (size_t)b * 128 * 1024 + lane * 8;
  bf16x8 Kf[4], Kn[4];
#pragma unroll
  for (int ks = 0; ks < 4; ++ks) Kf[ks] = ldg8(kfr + ks * 512);
  bf16x8 Vf[2][2], Vn[2][2];
#pragma unroll
  for (int dt = 0; dt < 2; ++dt)
#pragma unroll
    for (int s = 0; s < 2; ++s) Vf[dt][s] = ldg8(vfr + (dt * 2 + s) * 512);
  bf16x8 ki0, ki1;
  {
    const int kt0 = min(wave, qblk);
    ki0 = ldg8(kibase + (size_t)kt0 * 1024); ki1 = ldg8(kibase + (size_t)kt0 * 1024 + 512);
  }
  for (int c = 0; c < nchunks; ++c) {
    const int buf = c & 1;
    {
      const int key0 = (c * 8 + wave) * 32;
      unsigned bits = 0u;
      const bf16x8 k0 = ki0, k1 = ki1;
      {
        const int ktn = min((c + 1) * 8 + wave, qblk);
        ki0 = ldg8(kibase + (size_t)ktn * 1024); ki1 = ldg8(kibase + (size_t)ktn * 1024 + 512);
      }
      if (key0 <= q0 + 31) {
        float sc[16];
        {
          f32x16 a = zero16();
          a = MFMA(k0, *reinterpret_cast<const bf16x8*>(qil + 256), a);
          a = MFMA(k1, *reinterpret_cast<const bf16x8*>(qil + 256 + 16), a);
#pragma unroll
          for (int i = 0; i < 16; ++i) sc[i] = a[i];
        }
#pragma unroll 2
        for (int hd = 0; hd < 8; ++hd) {
          f32x16 a = zero16();
          a = MFMA(k0, *reinterpret_cast<const bf16x8*>(qil + hd * 32), a);
          a = MFMA(k1, *reinterpret_cast<const bf16x8*>(qil + hd * 32 + 16), a);
          const float wh = wqs[hd * 32 + lr];
#pragma unroll
          for (int i = 0; i < 16; ++i) sc[i] = fmaf(fabsf(a[i]), wh, sc[i]);
        }
        __builtin_amdgcn_sched_barrier(0);
#pragma unroll
        for (int i = 0; i < 16; ++i) {
          int kp = key0 + crow(i, lh);
          if (kp <= q0 + lr && fkey(sc[i]) >= thrq) bits |= (1u << i);
        }
      }
      maskbuf[(buf * 8 + wave) * 64 + lane] = (u16)bits;
    }
    __syncthreads();
#pragma unroll 1
    for (int t8 = 0; t8 < 8; ++t8) {
      const int g = c * 8 + t8;
      if (g > qblk) break;
      {
        const int gn = min(g + 1, qblk);
        const u16* kr = kfr + (size_t)gn * 2048;
#pragma unroll
        for (int ks = 0; ks < 4; ++ks) Kn[ks] = ldg8(kr + ks * 512);
#pragma unroll
        for (int dt = 0; dt < 2; ++dt)
#pragma unroll
          for (int s = 0; s < 2; ++s) Vn[dt][s] = ldg8(vfr + (size_t)gn * 2048 + (dt * 2 + s) * 512);
      }

      const unsigned bits = maskbuf[(buf * 8 + t8) * 64 + lane];
      f32x16 Sx = zero16();
#pragma unroll
      for (int ks = 0; ks < 4; ++ks) Sx = MFMA(Kf[ks], Qf[ks], Sx);
      float sm[16];
#pragma unroll
      for (int i = 0; i < 16; ++i) sm[i] = ((bits >> i) & 1u) ? Sx[i] : -INFINITY;
      float mt = fmaxf(fmaxf(fmaxf(sm[0], sm[1]), fmaxf(sm[2], sm[3])), fmaxf(fmaxf(sm[4], sm[5]), fmaxf(sm[6], sm[7])));
      mt = fmaxf(mt, fmaxf(fmaxf(fmaxf(sm[8], sm[9]), fmaxf(sm[10], sm[11])), fmaxf(fmaxf(sm[12], sm[13]), fmaxf(sm[14], sm[15]))));
      mt = fmaxf(mt, __shfl_xor(mt, 32));
      const float mnew = fmaxf(mrun, mt);
      const float msafe = (mnew == -INFINITY) ? 0.f : mnew;
      const float alpha = __builtin_amdgcn_exp2f(mrun - msafe);
      float pv[16]; float ps = 0.f;
#pragma unroll
      for (int i = 0; i < 16; ++i) { pv[i] = __builtin_amdgcn_exp2f(sm[i] - msafe); ps += pv[i]; }
      lrun = lrun * alpha + ps;
      mrun = mnew;
      if (__builtin_amdgcn_ballot_w64(alpha != 1.f) != 0ull) {
#pragma unroll
        for (int dt = 0; dt < 2; ++dt)
#pragma unroll
          for (int i = 0; i < 16; ++i) O[dt][i] *= alpha;
      }
      bf16x8 Pf[2];
#pragma unroll
      for (int s = 0; s < 2; ++s) Pf[s] = pack8(pv[8 * s], pv[8 * s + 1], pv[8 * s + 2], pv[8 * s + 3], pv[8 * s + 4], pv[8 * s + 5], pv[8 * s + 6], pv[8 * s + 7]);
#pragma unroll
      for (int dt = 0; dt < 2; ++dt)
#pragma unroll
        for (int s = 0; s < 2; ++s) O[dt] = MFMA(Vf[dt][s], Pf[s], O[dt]);
#pragma unroll
      for (int ks = 0; ks < 4; ++ks) Kf[ks] = Kn[ks];
#pragma unroll
      for (int dt = 0; dt < 2; ++dt)
#pragma unroll
        for (int s = 0; s < 2; ++s) Vf[dt][s] = Vn[dt][s];
    }
  }
  u16* y = (u16*)(p.ws + OFF_XB);
  {
    float lt = lrun + __shfl_xor(lrun, 32);
    float inv = 1.f / lt;
#pragma unroll
    for (int dt = 0; dt < 2; ++dt)
#pragma unroll
      for (int g = 0; g < 4; ++g)
        st4bf(y + (size_t)qtok * 1024 + head * 64 + dt * 32 + 8 * g + 4 * lh, O[dt][4 * g] * inv, O[dt][4 * g + 1] * inv, O[dt][4 * g + 2] * inv, O[dt][4 * g + 3] * inv);
  }
  __syncthreads();
}

DI void gla_bcum(const Params& p, int b, int h, int n, float* bc, float* glr_s, float* segtot) {
  const u16* tm = (const u16*)(p.ws + OFF_TM);
  const int tid = threadIdx.x;
  const int tok0 = b * S_ + n * 64;
  for (int i = tid; i < 1024; i += 512) glr_s[i] = bf2f(tm[(size_t)(tok0 + (i >> 4)) * TMW + TM_GLR + (i & 15)]);
  const int d = tid & 63, cgp = tid >> 6;
  float gu[16];
#pragma unroll
  for (int j = 0; j < 16; ++j) gu[j] = p.gate_up[j * 256 + h * 64 + d];
  const float bias = p.gate_bias[h * 64 + d];
  __syncthreads();
  float v[8]; float run = 0.f;
#pragma unroll
  for (int r = 0; r < 8; ++r) {
    const int c = cgp * 8 + r;
    float z = bias;
#pragma unroll
    for (int j = 0; j < 16; ++j) z = fmaf(glr_s[c * 16 + j], gu[j], z);
    float la = (fminf(z, 0.f) - log1pf(__expf(-fabsf(z)))) * 0.0625f;
    run += la; v[r] = run;
  }
  segtot[cgp * 64 + d] = run;
  __syncthreads();
  float off = 0.f;
#pragma unroll
  for (int g = 0; g < 8; ++g) off += (g < cgp) ? segtot[g * 64 + d] : 0.f;
#pragma unroll
  for (int r = 0; r < 8; ++r) bc[(cgp * 8 + r) * 64 + d] = off + v[r];
  __syncthreads();
}

DI void gla_g1_item(const Params& p, int item, char* smem) {
  float* bc = (float*)smem;
  float* glr_s = (float*)(smem + 16384);
  float* segtot = (float*)(smem + 20480);
  u16* KeT = (u16*)(smem + 22528);
  const int b = item >> 8, h = (item >> 6) & 3, n = item & 63;
  const u16* tm = (const u16*)(p.ws + OFF_TM);
  const u16* gvT = (const u16*)(p.ws + OFF_GVT);
  const int tid = threadIdx.x, lane = tid & 63, wave = tid >> 6, lr = lane & 31, lh = lane >> 5;
  const int tok0 = b * S_ + n * 64;
  u16 kraw[8];
  {
    const int d = tid & 63, cgp = tid >> 6;
#pragma unroll
    for (int r = 0; r < 8; ++r) kraw[r] = tm[(size_t)(tok0 + cgp * 8 + r) * TMW + TM_GK + h * 64 + d];
  }
  bf16x8 afr[4];
  {
    const int et = wave & 3;
    const u16* arow = gvT + ((size_t)b * 512 + h * 128 + et * 32 + lr) * 4096 + n * 64 + lh * 8;
#pragma unroll
    for (int ks = 0; ks < 4; ++ks) afr[ks] = ldg8(arow + ks * 16);
  }
  gla_bcum(p, b, h, n, bc, glr_s, segtot);
  {
    const int d = tid & 63, cgp = tid >> 6;
    const float blast = bc[63 * 64 + d];
    {
      float* bcg = (float*)(p.ws + OFF_BCG) + (size_t)item * 4096;
#pragma unroll
      for (int r = 0; r < 8; ++r) bcg[(cgp * 8 + r) * 64 + d] = bc[(cgp * 8 + r) * 64 + d];
    }
    float f[8];
#pragma unroll
    for (int r = 0; r < 8; ++r) {
      const int c = cgp * 8 + r;
      float kv = bf2f(kraw[r]);
      f[r] = kv * __expf(blast - bc[c * 64 + d]);
    }
    *reinterpret_cast<bf16x8*>(KeT + d * 72 + cgp * 8) = pack8(f[0], f[1], f[2], f[3], f[4], f[5], f[6], f[7]);
    if (cgp == 0) ((float*)(p.ws + OFF_DECAY))[item * 64 + d] = __expf(blast);
  }
  __syncthreads();
  {
    const int et = wave & 3, dtl = wave >> 2;
    f32x16 acc = zero16();
#pragma unroll
    for (int ks = 0; ks < 4; ++ks) {
      bf16x8 a = afr[ks];
      bf16x8 bb = *reinterpret_cast<const bf16x8*>(KeT + (dtl * 32 + lr) * 72 + ks * 16 + lh * 8);
      acc = MFMA(a, bb, acc);
    }
    float* kvT = (float*)(p.ws + OFF_KVT);
#pragma unroll
    for (int i = 0; i < 16; ++i) kvT[((size_t)item * 128 + et * 32 + crow(i, lh)) * 64 + dtl * 32 + lr] = acc[i];
  }
  __syncthreads();
}

DI void gla_scan(const Params& p) {
  const float* kvT = (const float*)(p.ws + OFF_KVT);
  const float* decay = (const float*)(p.ws + OFF_DECAY);
  u16* prev = (u16*)(p.ws + OFF_PREV);
  const int gtid = blockIdx.x * blockDim.x + threadIdx.x;
  const int gn = gridDim.x * blockDim.x;
  for (int u = gtid; u < 32 * 2048; u += gn) {
    const int bh = u >> 11, rem = u & 2047, e = rem >> 4, d4 = (rem & 15) * 4;
    f32x4 st = {0.f, 0.f, 0.f, 0.f};
#pragma unroll 4
    for (int n = 0; n < 64; ++n) {
      const int item = bh * 64 + n;
      st4bf(prev + ((size_t)item * 128 + e) * 64 + d4, st[0], st[1], st[2], st[3]);
      f32x4 dc = *reinterpret_cast<const f32x4*>(decay + item * 64 + d4);
      f32x4 kv = *reinterpret_cast<const f32x4*>(kvT + ((size_t)item * 128 + e) * 64 + d4);
      st = dc * st + kv;
    }
  }
}

DI void gla_g3_item(const Params& p, int item, char* smem) {
  float* red = (float*)smem;
  const int b = item >> 8, h = (item >> 6) & 3, n = item & 63;
  const u16* tm = (const u16*)(p.ws + OFF_TM);
  const u16* gvT = (const u16*)(p.ws + OFF_GVT);
  const u16* prev = (const u16*)(p.ws + OFF_PREV);
  const float* bcg = (const float*)(p.ws + OFF_BCG) + (size_t)item * 4096;
  const int tid = threadIdx.x, lane = tid & 63, wave = tid >> 6, lr = lane & 31, lh = lane >> 5;
  const int tok0 = b * S_ + n * 64;
  const int et = wave & 3, ct = wave >> 2;
  bf16x8 qraw[4], kraw[2][4], sfr[4];
  bf16x4 vlo[2][2], vhi[2][2];
  f32x4 bq[4][2];
  {
    const u16* vrow0 = gvT + ((size_t)b * 512 + h * 128 + et * 32 + lr) * 4096 + n * 64 + 4 * lh;
    const u16* srow0 = prev + ((size_t)item * 128 + et * 32 + lr) * 64 + lh * 8;
#pragma unroll
    for (int ks = 0; ks < 4; ++ks) {
      qraw[ks] = ldg8(tm + (size_t)(tok0 + ct * 32 + lr) * TMW + TM_GQ + h * 64 + ks * 16 + lh * 8);
      kraw[0][ks] = ldg8(tm + (size_t)(tok0 + lr) * TMW + TM_GK + h * 64 + ks * 16 + lh * 8);
      kraw[1][ks] = ldg8(tm + (size_t)(tok0 + ct * 32 + lr) * TMW + TM_GK + h * 64 + ks * 16 + lh * 8);
      sfr[ks] = ldg8(srow0 + ks * 16);
      bq[ks][0] = *reinterpret_cast<const f32x4*>(bcg + (ct * 32 + lr) * 64 + ks * 16 + lh * 8);
      bq[ks][1] = *reinterpret_cast<const f32x4*>(bcg + (ct * 32 + lr) * 64 + ks * 16 + lh * 8 + 4);
    }
#pragma unroll
    for (int st = 0; st < 2; ++st)
#pragma unroll
      for (int s2 = 0; s2 < 2; ++s2) {
        const u16* vp = vrow0 + (st * ct) * 32 + 16 * s2;
        vlo[st][s2] = *reinterpret_cast<const bf16x4*>(vp);
        vhi[st][s2] = *reinterpret_cast<const bf16x4*>(vp + 8);
      }
  }
  bf16x8 Qd[4];
#pragma unroll
  for (int ks = 0; ks < 4; ++ks) {
    float f[8];
#pragma unroll
    for (int j = 0; j < 8; ++j) f[j] = bf2f((u16)qraw[ks][j]) * 0.125f * __expf(bq[ks][j >> 2][j & 3]);
    Qd[ks] = pack8(f[0], f[1], f[2], f[3], f[4], f[5], f[6], f[7]);
  }
  f32x16 O = zero16();
#pragma unroll
  for (int st = 0; st < 2; ++st) {
    if (st <= ct) {
      f32x16 A = zero16();
      const int s = st * 32 + lr;
#pragma unroll
      for (int ks = 0; ks < 4; ++ks) {
        f32x4 b0 = (st == 1) ? bq[ks][0] : *reinterpret_cast<const f32x4*>(bcg + s * 64 + ks * 16 + lh * 8);
        f32x4 b1 = (st == 1) ? bq[ks][1] : *reinterpret_cast<const f32x4*>(bcg + s * 64 + ks * 16 + lh * 8 + 4);
        float f[8];
#pragma unroll
        for (int j = 0; j < 8; ++j) f[j] = bf2f((u16)kraw[st][ks][j]) * __expf(-((j < 4) ? b0[j & 3] : b1[j & 3]));
        bf16x8 Ki = pack8(f[0], f[1], f[2], f[3], f[4], f[5], f[6], f[7]);
        A = MFMA(Ki, Qd[ks], A);
      }
      float pv[16];
#pragma unroll
      for (int i = 0; i < 16; ++i) pv[i] = (st * 32 + crow(i, lh) <= ct * 32 + lr) ? A[i] : 0.f;
#pragma unroll
      for (int s2 = 0; s2 < 2; ++s2) {
        bf16x8 Pf = pack8(pv[8 * s2], pv[8 * s2 + 1], pv[8 * s2 + 2], pv[8 * s2 + 3], pv[8 * s2 + 4], pv[8 * s2 + 5], pv[8 * s2 + 6], pv[8 * s2 + 7]);
        O = MFMA(cat44(vlo[st][s2], vhi[st][s2]), Pf, O);
      }
    }
  }
#pragma unroll
  for (int ks = 0; ks < 4; ++ks) O = MFMA(sfr[ks], Qd[ks], O);
  float ss = 0.f;
#pragma unroll
  for (int i = 0; i < 16; ++i) ss += O[i] * O[i];
  ss += __shfl_xor(ss, 32);
  if (lh == 0) red[(ct * 4 + et) * 32 + lr] = ss;
  __syncthreads();
  const float tot = red[(ct * 4 + 0) * 32 + lr] + red[(ct * 4 + 1) * 32 + lr] + red[(ct * 4 + 2) * 32 + lr] + red[(ct * 4 + 3) * 32 + lr];
  const float rinv = rsqrtf(tot * (1.f / 128.f) + 1e-6f);
  const int tok = tok0 + ct * 32 + lr;
  u16* y = (u16*)(p.ws + OFF_XB);
#pragma unroll
  for (int g = 0; g < 4; ++g) {
    const int e0 = et * 32 + 8 * g + 4 * lh;
    u32x2 gr = *reinterpret_cast<const u32x2*>(tm + (size_t)tok * TMW + TM_GR + h * 128 + e0);
    f32x4 ng = *reinterpret_cast<const f32x4*>(p.norm_g + e0);
    float grv[4] = {bflo(gr[0]), bfhi(gr[0]), bflo(gr[1]), bfhi(gr[1])};
    float o[4];
#pragma unroll
    for (int r = 0; r < 4; ++r) {
      float sl = grv[r] / (1.f + __expf(-grv[r]));
      o[r] = O[4 * g + r] * rinv * ng[r] * sl;
    }
    st4bf(y + (size_t)tok * 1024 + 512 + h * 128 + e0, o[0], o[1], o[2], o[3]);
  }
  __syncthreads();
}

template <int MODE>
DI void phase_gemm(const Params& p, const u16* X, const u16* Wt, int N, const float* resid, float* outf, u16* outb, int ldo, char* smem) {
  const int ntn = N / 128;
  const int total = 128 * ntn;
  const int tid = threadIdx.x, lane = tid & 63, wave = tid >> 6;
  const int fw = wave & 1, tq = wave >> 1, lr = lane & 31, lh = lane >> 5;
  for (int t = blockIdx.x; t < total; t += gridDim.x) {
    const int mt = t / ntn, nt = t % ntn;
    f32x16 acc[2][2];
    gemm_tile(X + (size_t)mt * 256 * 1024, 1024, Wt + (size_t)nt * 128 * 1024, 1024, 1024, smem, acc);
    if (MODE == 0 || MODE == 1) {
      float* wl = (float*)(smem + wave * 17408);
#pragma unroll
      for (int tt = 0; tt < 2; ++tt)
#pragma unroll
        for (int ft = 0; ft < 2; ++ft)
#pragma unroll
          for (int g = 0; g < 4; ++g) {
            f32x4 v = {acc[ft][tt][4 * g], acc[ft][tt][4 * g + 1], acc[ft][tt][4 * g + 2], acc[ft][tt][4 * g + 3]};
            *reinterpret_cast<f32x4*>(wl + (tt * 32 + lr) * 68 + ft * 32 + 8 * g + 4 * lh) = v;
          }
      const int ch = lane & 15, r0 = lane >> 4;
      const int f = nt * 128 + fw * 64 + ch * 4;
#pragma unroll 4
      for (int k = 0; k < 16; ++k) {
        const int row = r0 + 4 * k;
        const int tok = mt * 256 + tq * 64 + row;
        f32x4 v = *reinterpret_cast<const f32x4*>(wl + row * 68 + ch * 4);
        if (MODE == 0) {
          f32x4 r = *reinterpret_cast<const f32x4*>(resid + (size_t)tok * 1024 + f);
          f32x4 o;
#pragma unroll
          for (int j = 0; j < 4; ++j) o[j] = ALPHA * r[j] + v[j];
          *reinterpret_cast<f32x4*>(outf + (size_t)tok * 1024 + f) = o;
        } else {
          st4bf(outb + (size_t)tok * ldo + f, v[0], v[1], v[2], v[3]);
        }
      }
      __syncthreads();
    } else {
#pragma unroll
      for (int tt = 0; tt < 2; ++tt) {
        const int tok = mt * 256 + tq * 64 + tt * 32 + lr;
#pragma unroll
        for (int ft = 0; ft < 2; ++ft)
#pragma unroll
          for (int g = 0; g < 4; ++g) {
            const int f = nt * 128 + fw * 64 + ft * 32 + 8 * g + 4 * lh;
            if (MODE == 2) {
              const int hh = f >> 8, fh = f & 255, ks = fh >> 4, lane2 = ((fh >> 3) & 1) * 32 + lr;
              st4bf(outb + ((((size_t)(tok >> 5) * 4 + hh) * 16 + ks) * 64 + lane2) * 8 + 4 * lh, acc[ft][tt][4 * g], acc[ft][tt][4 * g + 1], acc[ft][tt][4 * g + 2], acc[ft][tt][4 * g + 3]);
            } else {
              const int hh = f >> 8, fq = f & 127, half = (f >> 7) & 1, ks = fq >> 4, lane2 = ((fq >> 3) & 1) * 32 + lr;
              st4bf(outb + (((((size_t)(tok >> 5) * 8 + hh) * 2 + half) * 8 + ks) * 64 + lane2) * 8 + 4 * lh, acc[ft][tt][4 * g], acc[ft][tt][4 * g + 1], acc[ft][tt][4 * g + 2], acc[ft][tt][4 * g + 3]);
            }
          }
      }
    }
  }
}

DI void phase_ln(const Params& p, float* h, u16* hb, const float* g, const float* bta) {
  const int lane = threadIdx.x & 63;
  const int gw = (blockIdx.x * blockDim.x + threadIdx.x) >> 6;
  const int nw = (gridDim.x * blockDim.x) >> 6;
  for (int row = gw; row < T_; row += nw) {
    float* r = h + (size_t)row * 1024;
    f32x4 v[4]; float s = 0.f;
#pragma unroll
    for (int c = 0; c < 4; ++c) { v[c] = *reinterpret_cast<const f32x4*>(r + c * 256 + lane * 4); s += v[c][0] + v[c][1] + v[c][2] + v[c][3]; }
    const float mean = wave_sum(s) * (1.f / 1024.f);
    float q = 0.f;
#pragma unroll
    for (int c = 0; c < 4; ++c)
#pragma unroll
      for (int k = 0; k < 4; ++k) { float d = v[c][k] - mean; q += d * d; }
    const float rstd = rsqrtf(wave_sum(q) * (1.f / 1024.f) + 1e-5f);
#pragma unroll
    for (int c = 0; c < 4; ++c) {
      f32x4 gg = *reinterpret_cast<const f32x4*>(g + c * 256 + lane * 4);
      f32x4 bb = *reinterpret_cast<const f32x4*>(bta + c * 256 + lane * 4);
      f32x4 o;
#pragma unroll
      for (int k = 0; k < 4; ++k) o[k] = (v[c][k] - mean) * rstd * gg[k] + bb[k];
      *reinterpret_cast<f32x4*>(r + c * 256 + lane * 4) = o;
      st4bf(hb + (size_t)row * 1024 + c * 256 + lane * 4, o[0], o[1], o[2], o[3]);
    }
  }
}

DI void phase_xattn(const Params& p) {
  const u16* qx = (const u16*)(p.ws + OFF_QX);
  const u16* mk = (const u16*)(p.ws + OFF_MEMK);
  const u16* mv = (const u16*)(p.ws + OFF_MEMVT);
  u16* ox = (u16*)(p.ws + OFF_OX);
  const int lane = threadIdx.x & 63, lr = lane & 31, lh = lane >> 5;
  const int gw = (blockIdx.x * blockDim.x + threadIdx.x) >> 6;
  const int nw = (gridDim.x * blockDim.x) >> 6;
  for (int it = gw; it < 8 * 4 * 128; it += nw) {
    const int qt = it & 127, h = (it >> 7) & 3, b = it >> 9;
    const int tok = b * S_ + qt * 32 + lr;
    f32x16 Sx[8];
#pragma unroll
    for (int kt = 0; kt < 8; ++kt) Sx[kt] = zero16();
    const u16* qrow = qx + (((size_t)(b * 128 + qt) * 4 + h) * 16) * 512 + lane * 8;
    const u16* krow = mk + (((size_t)(b * 4 + h) * 8) * 16) * 512 + lane * 8;
#pragma unroll 2
    for (int ks = 0; ks < 16; ++ks) {
      bf16x8 qf = ldg8(qrow + ks * 512);
#pragma unroll
      for (int kt = 0; kt < 8; ++kt) Sx[kt] = MFMA(ldg8(krow + (kt * 16 + ks) * 512), qf, Sx[kt]);
    }
    float mx = -INFINITY;
#pragma unroll
    for (int kt = 0; kt < 8; ++kt)
#pragma unroll
      for (int i = 0; i < 16; ++i) mx = fmaxf(mx, Sx[kt][i]);
    mx = fmaxf(mx, __shfl_xor(mx, 32));
    float ls = 0.f;
    bf16x8 Pf[8][2];
#pragma unroll
    for (int kt = 0; kt < 8; ++kt) {
      float pv[16];
#pragma unroll
      for (int i = 0; i < 16; ++i) { pv[i] = __expf((Sx[kt][i] - mx) * 0.0625f); ls += pv[i]; }
#pragma unroll
      for (int s = 0; s < 2; ++s) Pf[kt][s] = pack8(pv[8 * s], pv[8 * s + 1], pv[8 * s + 2], pv[8 * s + 3], pv[8 * s + 4], pv[8 * s + 5], pv[8 * s + 6], pv[8 * s + 7]);
    }
    ls += __shfl_xor(ls, 32);
    const float inv = 1.f / ls;
#pragma unroll 1
    for (int dt = 0; dt < 8; ++dt) {
      f32x16 o = zero16();
      const u16* vrow = mv + ((((size_t)(b * 4 + h) * 8 + dt) * 8) * 2) * 512 + lane * 8;
#pragma unroll
      for (int kt = 0; kt < 8; ++kt)
#pragma unroll
        for (int s = 0; s < 2; ++s) o = MFMA(ldg8(vrow + (kt * 2 + s) * 512), Pf[kt][s], o);
#pragma unroll
      for (int g = 0; g < 4; ++g)
        st4bf(ox + (size_t)tok * 1024 + h * 256 + dt * 32 + 8 * g + 4 * lh, o[4 * g] * inv, o[4 * g + 1] * inv, o[4 * g + 2] * inv, o[4 * g + 3] * inv);
    }
  }
}

DI void peer_topk_item(const Params& p, int tt128, int head, char* smem) {
  float* sc = (float*)smem;
  float* topv = (float*)(smem + 132096);
  unsigned char* topi = (unsigned char*)(smem + 132096 + 16384);
  const u16* pq = (const u16*)(p.ws + OFF_QX);
  const u16* sk = (const u16*)(p.ws + OFF_SK);
  const int tid = threadIdx.x, lane = tid & 63, wave = tid >> 6, lr = lane & 31, lh = lane >> 5;
  const int tok0 = tt128 * 128;
  {
    const int half = wave >> 2, kt = wave & 3;
    bf16x8 af[8];
#pragma unroll
    for (int ks = 0; ks < 8; ++ks) af[ks] = ldg8(sk + (size_t)half * 16384 + (kt * 32 + lr) * 128 + ks * 16 + lh * 8);
#pragma unroll 1
    for (int tt = 0; tt < 4; ++tt) {
      f32x16 acc = zero16();
      const u16* brow = pq + (((((size_t)(tok0 >> 5) + tt) * 8 + head) * 2 + half) * 8) * 512 + lane * 8;
#pragma unroll
      for (int ks = 0; ks < 8; ++ks) acc = MFMA(af[ks], ldg8(brow + ks * 512), acc);
#pragma unroll
      for (int i = 0; i < 16; ++i) sc[(half * 128 + tt * 32 + lr) * 129 + kt * 32 + crow(i, lh)] = acc[i];
    }
  }
  __syncthreads();
  if (tid < 256) {
    float* row = sc + tid * 129;
    float gm[8]; int gi[8];
#pragma unroll
    for (int g = 0; g < 8; ++g) {
      float m = -INFINITY; int mi = g * 16;
#pragma unroll
      for (int j = 0; j < 16; ++j) { float v = row[g * 16 + j]; if (v > m) { m = v; mi = g * 16 + j; } }
      gm[g] = m; gi[g] = mi;
    }
#pragma unroll 1
    for (int r = 0; r < 16; ++r) {
      float best = gm[0]; int bg = 0; int bi = gi[0];
#pragma unroll
      for (int g = 1; g < 8; ++g) if (gm[g] > best) { best = gm[g]; bg = g; bi = gi[g]; }
      topv[tid * 16 + r] = best; topi[tid * 16 + r] = (unsigned char)bi;
      row[bi] = -INFINITY;
      float m = -INFINITY; int mi = bg * 16;
#pragma unroll
      for (int j = 0; j < 16; ++j) { float v = row[bg * 16 + j]; if (v > m) { m = v; mi = bg * 16 + j; } }
#pragma unroll
      for (int g = 0; g < 8; ++g) { gm[g] = (g == bg) ? m : gm[g]; gi[g] = (g == bg) ? mi : gi[g]; }
    }
  }
  __syncthreads();
  if (tid < 128) {
    const float* av = topv + tid * 16;
    const float* bv = topv + (128 + tid) * 16;
    const unsigned char* ai = topi + tid * 16;
    const unsigned char* bi_ = topi + (128 + tid) * 16;
    float cur[16]; int pp[16];
    const float b0 = bv[0];
#pragma unroll
    for (int i = 0; i < 16; ++i) { cur[i] = av[i] + b0; pp[i] = 0; }
    float sel[16]; int eid[16];
#pragma unroll
    for (int r = 0; r < 16; ++r) {
      float best = cur[0]; int bi = 0; int bj = pp[0];
#pragma unroll
      for (int i = 1; i < 16; ++i) if (cur[i] > best) { best = cur[i]; bi = i; bj = pp[i]; }
      sel[r] = best;
      eid[r] = (int)ai[bi] * 128 + (int)bi_[bj];
      const int nj = bj + 1;
      const float nv = (nj < 16) ? (av[bi] + bv[nj & 15]) : -INFINITY;
#pragma unroll
      for (int i = 0; i < 16; ++i) { cur[i] = (i == bi) ? nv : cur[i]; pp[i] = (i == bi) ? nj : pp[i]; }
    }
    float sum = 0.f;
    const float smax = sel[0];
#pragma unroll
    for (int r = 0; r < 16; ++r) { sel[r] = __expf(sel[r] - smax); sum += sel[r]; }
    const float inv = 1.f / sum;
    int* eo = (int*)(p.ws + OFF_EIDX) + (size_t)(tok0 + tid) * 128 + head * 16;
    float* go = (float*)(p.ws + OFF_GATE) + (size_t)(tok0 + tid) * 128 + head * 16;
#pragma unroll
    for (int r = 0; r < 16; ++r) { eo[r] = eid[r]; go[r] = sel[r] * inv; }
  }
  __syncthreads();
}

DI float dot2bf(unsigned a, unsigned b, float c) {
  return __builtin_amdgcn_fdot2_f32_bf16(__builtin_bit_cast(bf2_t, a), __builtin_bit_cast(bf2_t, b), c, false);
}

DI float reduce8(float (&part)[8], int lane) {
  float r4[4], r2[2], r1;
#pragma unroll
  for (int k = 0; k < 4; ++k) {
    float send = (lane & 1) ? part[2 * k] : part[2 * k + 1];
    float keep = (lane & 1) ? part[2 * k + 1] : part[2 * k];
    r4[k] = keep + __shfl_xor(send, 1);
  }
#pragma unroll
  for (int k = 0; k < 2; ++k) {
    float send = (lane & 2) ? r4[2 * k] : r4[2 * k + 1];
    float keep = (lane & 2) ? r4[2 * k + 1] : r4[2 * k];
    r2[k] = keep + __shfl_xor(send, 2);
  }
  {
    float send = (lane & 4) ? r2[0] : r2[1];
    float keep = (lane & 4) ? r2[1] : r2[0];
    r1 = keep + __shfl_xor(send, 4);
  }
  r1 += __shfl_xor(r1, 8);
  r1 += __shfl_xor(r1, 16);
  r1 += __shfl_xor(r1, 32);
  return r1;
}

DI void phase_peer_down(const Params& p) {
  const char* exd = p.ws + OFF_EXD;
  const float* esc = (const float*)(p.ws + OFF_ESC);
  const u16* hb = (const u16*)(p.ws + OFF_HB);
  const int* eidx = (const int*)(p.ws + OFF_EIDX);
  const float* gate = (const float*)(p.ws + OFF_GATE);
  float* coefw = (float*)(p.ws + OFF_COEF);
  const int lane = threadIdx.x & 63;
  const int gw = (blockIdx.x * blockDim.x + threadIdx.x) >> 6;
  const int nw = (gridDim.x * blockDim.x) >> 6;
#pragma unroll 1
  for (int sl = 0; sl < 2; ++sl) {
#pragma unroll 1
    for (int tok = gw; tok < T_; tok += nw) {
      float x[16];
      {
        const u16* xr = hb + (size_t)tok * 1024 + lane * 16;
        u32x4 a = *reinterpret_cast<const u32x4*>(xr);
        u32x4 c = *reinterpret_cast<const u32x4*>(xr + 8);
#pragma unroll
        for (int w = 0; w < 4; ++w) { x[2 * w] = bflo(a[w]); x[2 * w + 1] = bfhi(a[w]); x[8 + 2 * w] = bflo(c[w]); x[8 + 2 * w + 1] = bfhi(c[w]); }
      }
#pragma unroll 1
      for (int half = 0; half < 2; ++half) {
        const int ev = eidx[(size_t)tok * 128 + half * 64 + lane];
        const float gv = gate[(size_t)tok * 128 + half * 64 + lane];
        unsigned long long m = __builtin_amdgcn_ballot_w64((ev >> 13) == sl);
        while (m != 0ull) {
          int pos[8];
          const int first = __builtin_ctzll(m);
#pragma unroll
          for (int k = 0; k < 8; ++k) {
            if (m != 0ull) { pos[k] = __builtin_ctzll(m); m &= m - 1ull; } else pos[k] = -1;
          }
          u32x4 dr[8];
#pragma unroll
          for (int k = 0; k < 8; ++k) {
            const int er = __builtin_amdgcn_readlane(ev, pos[k] >= 0 ? pos[k] : first);
            dr[k] = *reinterpret_cast<const u32x4*>(exd + (size_t)er * 1024 + lane * 16);
          }
          int pmine = pos[0];
#pragma unroll
          for (int k = 1; k < 8; ++k) pmine = ((lane & 7) == k) ? pos[k] : pmine;
          const int psafe = pmine >= 0 ? pmine : first;
          const int emine = __shfl(ev, psafe);
          const float gsel = __shfl(gv, psafe);
          const float sd = esc[emine];
          const float su = esc[16384 + emine];
          float part[8];
#pragma unroll
          for (int k = 0; k < 8; ++k) {
            float a0 = 0.f, a1 = 0.f;
#pragma unroll
            for (int w = 0; w < 4; ++w) {
              f2_t lo = __builtin_amdgcn_cvt_pk_f32_fp8((int)dr[k][w], false);
              f2_t hi = __builtin_amdgcn_cvt_pk_f32_fp8((int)dr[k][w], true);
              a0 = fmaf(lo[0], x[4 * w], a0); a1 = fmaf(lo[1], x[4 * w + 1], a1);
              a0 = fmaf(hi[0], x[4 * w + 2], a0); a1 = fmaf(hi[1], x[4 * w + 3], a1);
            }
            part[k] = a0 + a1;
          }
          float r1 = reduce8(part, lane) * sd;
          const float act = 0.5f * r1 * (1.f + erff(r1 * 0.70710678118654752f));
          if (lane < 8 && pmine >= 0) coefw[(size_t)tok * 128 + half * 64 + pmine] = gsel * act * su;
        }
      }
    }
  }
}

DI void phase_peer_ffn(const Params& p) {
  const char* exu = p.ws + OFF_EXU;
  const float* h = (const float*)(p.ws + OFF_H);
  const int* eidx = (const int*)(p.ws + OFF_EIDX);
  const float* coefw = (const float*)(p.ws + OFF_COEF);
  const int lane = threadIdx.x & 63;
  const int gw = (blockIdx.x * blockDim.x + threadIdx.x) >> 6;
  const int nw = (gridDim.x * blockDim.x) >> 6;
  for (int tok = gw; tok < T_; tok += nw) {
    float yacc[16];
#pragma unroll
    for (int i = 0; i < 16; ++i) yacc[i] = 0.f;
    const int e_lo = eidx[(size_t)tok * 128 + lane];
    const int e_hi = eidx[(size_t)tok * 128 + 64 + lane];
    const float c_lo = coefw[(size_t)tok * 128 + lane];
    const float c_hi = coefw[(size_t)tok * 128 + 64 + lane];
#pragma unroll 1
    for (int eb = 0; eb < 8; ++eb) {
      const int ev = (eb < 4) ? e_lo : e_hi;
      const float cv = (eb < 4) ? c_lo : c_hi;
      const int lbase = (eb & 3) * 16;
      u32x4 ur[16];
#pragma unroll
      for (int k = 0; k < 16; ++k) {
        const int er = __builtin_amdgcn_readlane(ev, lbase + k);
        ur[k] = *reinterpret_cast<const u32x4*>(exu + (size_t)er * 1024 + lane * 16);
      }
#pragma unroll
      for (int k = 0; k < 16; ++k) {
        const float ck = __int_as_float(__builtin_amdgcn_readlane(__float_as_int(cv), lbase + k));
#pragma unroll
        for (int w = 0; w < 4; ++w) {
          f2_t lo = __builtin_amdgcn_cvt_pk_f32_fp8((int)ur[k][w], false);
          f2_t hi = __builtin_amdgcn_cvt_pk_f32_fp8((int)ur[k][w], true);
          yacc[4 * w] = fmaf(ck, lo[0], yacc[4 * w]);
          yacc[4 * w + 1] = fmaf(ck, lo[1], yacc[4 * w + 1]);
          yacc[4 * w + 2] = fmaf(ck, hi[0], yacc[4 * w + 2]);
          yacc[4 * w + 3] = fmaf(ck, hi[1], yacc[4 * w + 3]);
        }
      }
    }
    const float* xr = h + (size_t)tok * 1024 + lane * 16;
    float v[16];
#pragma unroll
    for (int c = 0; c < 4; ++c) {
      f32x4 t = *reinterpret_cast<const f32x4*>(xr + c * 4);
#pragma unroll
      for (int k = 0; k < 4; ++k) v[4 * c + k] = ALPHA * t[k] + yacc[4 * c + k];
    }
    float s = 0.f;
#pragma unroll
    for (int i = 0; i < 16; ++i) s += v[i];
    const float mean = wave_sum(s) * (1.f / 1024.f);
    float q = 0.f;
#pragma unroll
    for (int i = 0; i < 16; ++i) { float d = v[i] - mean; q += d * d; }
    const float rstd = rsqrtf(wave_sum(q) * (1.f / 1024.f) + 1e-5f);
    float* orow = p.out + (size_t)tok * 1024 + lane * 16;
#pragma unroll
    for (int c = 0; c < 4; ++c) {
      f32x4 gg = *reinterpret_cast<const f32x4*>(p.ln_ffn_g + lane * 16 + c * 4);
      f32x4 bb = *reinterpret_cast<const f32x4*>(p.ln_ffn_b + lane * 16 + c * 4);
      f32x4 o;
#pragma unroll
      for (int k = 0; k < 4; ++k) o[k] = (v[4 * c + k] - mean) * rstd * gg[k] + bb[k];
      *reinterpret_cast<f32x4*>(orow + c * 4) = o;
    }
  }
}

constexpr size_t OFF_BAR = 166 * MiB;
DI void gbar(unsigned* ctr, unsigned target) {
  asm volatile("s_waitcnt vmcnt(0)" ::: "memory");
  __syncthreads();
  if (threadIdx.x == 0) {
    __builtin_amdgcn_fence(__ATOMIC_RELEASE, "agent");
    asm volatile("s_waitcnt vmcnt(0)" ::: "memory");
    __hip_atomic_fetch_add(ctr, 1u, __ATOMIC_RELAXED, __HIP_MEMORY_SCOPE_AGENT);
    while (__hip_atomic_load(ctr, __ATOMIC_RELAXED, __HIP_MEMORY_SCOPE_AGENT) < target) __builtin_amdgcn_s_sleep(2);
    __builtin_amdgcn_fence(__ATOMIC_ACQUIRE, "agent");
    asm volatile("s_waitcnt vmcnt(0)" ::: "memory");
  }
  __syncthreads();
}

__global__ void __launch_bounds__(512) fwd_megakernel(Params p) {
  __shared__ __attribute__((aligned(1024))) char smem[155648];
  cg::grid_group grid = cg::this_grid();
  const int G = gridDim.x;
  char* ws = p.ws;
  unsigned* bar = (unsigned*)(ws + OFF_BAR);

  phase_prep(p, smem);
  grid.sync();

  phase_inproj(p, smem);
  gbar(bar, (unsigned)(1 * G));

  for (int k = 0; k * G < 1024; ++k) {
    int j = (k & 1) ? (G - 1 - (int)blockIdx.x) : (int)blockIdx.x;
    int idx = k * G + j;
    if (idx < 1024) dsa_thr_item(p, idx & 7, 127 - (idx >> 3), smem);
  }
  for (int it = blockIdx.x; it < 2048; it += G) gla_g1_item(p, it, smem);
  gbar(bar, (unsigned)(2 * G));

  for (int k = 0; k * G < 1024; ++k) {
    int j = (k & 1) ? (G - 1 - (int)blockIdx.x) : (int)blockIdx.x;
    int idx = k * G + j;
    if (idx < 1024) dsa_attn_item(p, idx & 7, 127 - (idx >> 3), smem);
  }
  gla_scan(p);
  gbar(bar, (unsigned)(3 * G));

  for (int it = blockIdx.x; it < 2048; it += G) gla_g3_item(p, it, smem);
  gbar(bar, (unsigned)(4 * G));

  phase_gemm<0>(p, (const u16*)(ws + OFF_XB), (const u16*)(ws + OFF_WOUT), 1024, p.x, (float*)(ws + OFF_H), nullptr, 0, smem);
  gbar(bar, (unsigned)(5 * G));
  phase_ln(p, (float*)(ws + OFF_H), (u16*)(ws + OFF_HB), p.ln_mix_g, p.ln_mix_b);
  gbar(bar, (unsigned)(6 * G));

  phase_gemm<2>(p, (const u16*)(ws + OFF_HB), (const u16*)(ws + OFF_WQ), 1024, nullptr, nullptr, (u16*)(ws + OFF_QX), 1024, smem);
  gbar(bar, (unsigned)(7 * G));
  phase_xattn(p);
  gbar(bar, (unsigned)(8 * G));
  phase_gemm<0>(p, (const u16*)(ws + OFF_OX), (const u16*)(ws + OFF_WO), 1024, (const float*)(ws + OFF_H), (float*)(ws + OFF_H), nullptr, 0, smem);
  gbar(bar, (unsigned)(9 * G));
  phase_ln(p, (float*)(ws + OFF_H), (u16*)(ws + OFF_HB), p.ln_mem_g, p.ln_mem_b);
  gbar(bar, (unsigned)(10 * G));

  phase_gemm<5>(p, (const u16*)(ws + OFF_HB), (const u16*)(ws + OFF_WPQ), 2048, nullptr, nullptr, (u16*)(ws + OFF_QX), 2048, smem);
  gbar(bar, (unsigned)(11 * G));
  for (int it = blockIdx.x; it < 2048; it += G) peer_topk_item(p, it >> 3, it & 7, smem);
  gbar(bar, (unsigned)(12 * G));
  phase_peer_down(p);
  gbar(bar, (unsigned)(13 * G));
  phase_peer_ffn(p);
}

extern "C" void kernel_launch(void* const* d_in, const int* in_sizes, int n_in,
                              void* d_out, int out_size, void* d_ws, size_t ws_size,
                              hipStream_t stream) {
  static int grid_blocks = 0;
  if (!grid_blocks) {
    int dev = 0, cus = 0, per_cu = 0;
    (void)hipGetDevice(&dev);
    (void)hipDeviceGetAttribute(&cus, hipDeviceAttributeMultiprocessorCount, dev);
    (void)hipOccupancyMaxActiveBlocksPerMultiprocessor(&per_cu, fwd_megakernel, 512, 0);
    if (per_cu > 1) per_cu = 1;
    grid_blocks = cus * per_cu;
    if (grid_blocks > 256) grid_blocks = 256;
    if (ws_size < 512 * MiB) fprintf(stderr, "workspace too small: %zu\n", ws_size);
  }
  Params p{};
  p.x = (const float*)d_in[0]; p.positions = (const int*)d_in[1]; p.mem = (const float*)d_in[2]; p.w_in = (const float*)d_in[3];
  p.gate_up = (const float*)d_in[4]; p.gate_bias = (const float*)d_in[5]; p.norm_g = (const float*)d_in[6]; p.w_out = (const float*)d_in[7];
  p.ln_mix_g = (const float*)d_in[8]; p.ln_mix_b = (const float*)d_in[9];
  p.wq = (const float*)d_in[10]; p.wk = (const float*)d_in[11]; p.wv = (const float*)d_in[12]; p.wo = (const float*)d_in[13];
  p.ln_mem_g = (const float*)d_in[14]; p.ln_mem_b = (const float*)d_in[15];
  p.w_pq = (const float*)d_in[16]; p.sk1 = (const float*)d_in[17]; p.sk2 = (const float*)d_in[18];
  p.ex_down = (const float*)d_in[19]; p.ex_up = (const float*)d_in[20];
  p.ln_ffn_g = (const float*)d_in[21]; p.ln_ffn_b = (const float*)d_in[22];
  p.out = (float*)d_out; p.ws = (char*)d_ws;
  (void)hipMemsetAsync((char*)d_ws + OFF_BAR, 0, 256, stream);
  void* args[] = {&p};
  hipError_t e = hipLaunchCooperativeKernel((void*)fwd_megakernel, dim3(grid_blocks), dim3(512), args, 0, stream);
  if (e != hipSuccess) fprintf(stderr, "cooperative launch failed: %s (grid %d)\n", hipGetErrorString(e), grid_blocks);
}
```

```cpp
#include <hip/hip_runtime.h>
#include <hip/hip_cooperative_groups.h>
#include <cstdio>
#include <cmath>
namespace cg = cooperative_groups;

#define DI __device__ __forceinline__
typedef short bf16x8 __attribute__((ext_vector_type(8)));
typedef short bf16x4 __attribute__((ext_vector_type(4)));
typedef float f32x16 __attribute__((ext_vector_type(16)));
typedef float f32x4 __attribute__((ext_vector_type(4)));
typedef unsigned u32x4 __attribute__((ext_vector_type(4)));
typedef unsigned u32x2 __attribute__((ext_vector_type(2)));
typedef unsigned short u16;
typedef __bf16 bf2_t __attribute__((ext_vector_type(2)));
typedef float f2_t __attribute__((ext_vector_type(2)));

#define MFMA(a, b, c) __builtin_amdgcn_mfma_f32_32x32x16_bf16((a), (b), (c), 0, 0, 0)

constexpr int T_ = 32768;
constexpr int S_ = 4096;
constexpr int TMW = 2368;
constexpr int TM_Q = 0, TM_K = 512, TM_QI = 1024, TM_KI = 1280, TM_WI = 1312, TM_GLR = 1320, TM_GQ = 1344, TM_GK = 1600, TM_GR = 1856;
constexpr int PROJ_N = 3456;
constexpr float ALPHA = 1.189207115002721f;
constexpr size_t MiB = 1024 * 1024;

constexpr size_t OFF_XB = 0;
constexpr size_t OFF_EXD = 64 * MiB;
constexpr size_t OFF_EXU = 80 * MiB;
constexpr size_t OFF_BCG = 96 * MiB;
constexpr size_t OFF_WIN = 128 * MiB;
constexpr size_t OFF_WOUT = OFF_WIN + (size_t)PROJ_N * 1024 * 2;
constexpr size_t OFF_WQ = OFF_WOUT + 2 * MiB;
constexpr size_t OFF_WK = OFF_WQ + 2 * MiB;
constexpr size_t OFF_WV = OFF_WK + 2 * MiB;
constexpr size_t OFF_WO = OFF_WV + 2 * MiB;
constexpr size_t OFF_WPQ = OFF_WO + 2 * MiB;
constexpr size_t OFF_KIF = 149 * MiB;
constexpr size_t OFF_MEMB = 152 * MiB;
constexpr size_t OFF_MEMK = 156 * MiB;
constexpr size_t OFF_MEMVT = 160 * MiB;
constexpr size_t OFF_THR = 164 * MiB;
constexpr size_t OFF_SK = OFF_THR + 256 * 1024;
constexpr size_t OFF_DECAY = OFF_SK + 128 * 1024;
constexpr size_t OFF_ESC = 165 * MiB;
constexpr size_t OFF_TM = 168 * MiB;
constexpr size_t OFF_VT = 316 * MiB;
constexpr size_t OFF_KFR = 476 * MiB;
constexpr size_t OFF_GVT = 348 * MiB;
constexpr size_t OFF_KVT = 380 * MiB;
constexpr size_t OFF_PREV = 444 * MiB;
constexpr size_t OFF_H = 168 * MiB;
constexpr size_t OFF_HB = 296 * MiB;
constexpr size_t OFF_QX = 360 * MiB;
constexpr size_t OFF_OX = 424 * MiB;
constexpr size_t OFF_EIDX = 0;
constexpr size_t OFF_GATE = 16 * MiB;
constexpr size_t OFF_COEF = 32 * MiB;

struct Params {
  const float* x; const int* positions; const float* mem; const float* w_in;
  const float* gate_up; const float* gate_bias; const float* norm_g; const float* w_out;
  const float* ln_mix_g; const float* ln_mix_b;
  const float* wq; const float* wk; const float* wv; const float* wo;
  const float* ln_mem_g; const float* ln_mem_b;
  const float* w_pq; const float* sk1; const float* sk2; const float* ex_down; const float* ex_up;
  const float* ln_ffn_g; const float* ln_ffn_b;
  float* out; char* ws;
};

DI unsigned pk_bf16(float a, float b) {
  f2_t v = {a, b};
  bf2_t r = __builtin_convertvector(v, bf2_t);
  return __builtin_bit_cast(unsigned, r);
}
DI u16 f2bf(float a) { return (u16)(pk_bf16(a, 0.f) & 0xffffu); }
DI float bf2f(u16 u) { return __uint_as_float(((unsigned)u) << 16); }
DI float bflo(unsigned u) { return __uint_as_float(u << 16); }
DI float bfhi(unsigned u) { return __uint_as_float(u & 0xffff0000u); }
DI int crow(int i, int h) { return (i & 3) + 8 * (i >> 2) + 4 * h; }
DI bf16x8 ldg8(const u16* p) { return *reinterpret_cast<const bf16x8*>(p); }
DI bf16x8 pack8(float a0, float a1, float a2, float a3, float a4, float a5, float a6, float a7) {
  u32x4 r; r[0] = pk_bf16(a0, a1); r[1] = pk_bf16(a2, a3); r[2] = pk_bf16(a4, a5); r[3] = pk_bf16(a6, a7);
  return __builtin_bit_cast(bf16x8, r);
}
DI bf16x8 cat44(bf16x4 lo, bf16x4 hi) { return __builtin_shufflevector(lo, hi, 0, 1, 2, 3, 4, 5, 6, 7); }
DI void st4bf(u16* p, float a, float b, float c, float d) {
  u32x2 v; v[0] = pk_bf16(a, b); v[1] = pk_bf16(c, d);
  *reinterpret_cast<u32x2*>(p) = v;
}
DI float wave_sum(float v) {
#pragma unroll
  for (int d = 32; d >= 1; d >>= 1) v += __shfl_xor(v, d);
  return v;
}
DI void sincos_rad(float ang, float& s, float& c) {
  constexpr float C_hi = (float)0.15915494309189535;
  constexpr float C_lo = (float)(0.15915494309189535 - (double)C_hi);
  float k = rintf(ang * C_hi);
  float f = fmaf(ang, C_hi, -k);
  f = fmaf(ang, C_lo, f);
  s = __builtin_amdgcn_sinf(f);
  c = __builtin_amdgcn_cosf(f);
}
DI unsigned fkey(float s) {
  const unsigned u = __float_as_uint(s);
  return u ^ ((unsigned)((int)u >> 31) | 0x80000000u);
}
DI f32x16 zero16() { f32x16 z; for (int i = 0; i < 16; ++i) z[i] = 0.f; return z; }

DI int win_src_col(int n) {
  if (n < 1832) return n;
  if (n < 1848) return 2856 + (n - 1832);
  if (n < 1856) return -1;
  if (n < 2880) return n - 24;
  if (n < 3392) return n - 8;
  return -1;
}

DI void cvt_stream(const float* __restrict__ src, u16* __restrict__ dst, size_t n, size_t gtid, size_t gn) {
  size_t n8 = n / 8;
  for (size_t i = gtid; i < n8; i += gn) {
    f32x4 a = *reinterpret_cast<const f32x4*>(src + i * 8);
    f32x4 b = *reinterpret_cast<const f32x4*>(src + i * 8 + 4);
    u32x4 r; r[0] = pk_bf16(a[0], a[1]); r[1] = pk_bf16(a[2], a[3]); r[2] = pk_bf16(b[0], b[1]); r[3] = pk_bf16(b[2], b[3]);
    *reinterpret_cast<u32x4*>(dst + i * 8) = r;
  }
}

template <bool MAPPED>
DI void transpose_tile(const float* __restrict__ W, int ldn, u16* __restrict__ Wt, int k0, int n0, float* tile) {
  const int tid = threadIdx.x;
  {
    int nn = n0 + (tid & 63);
    int c = MAPPED ? win_src_col(nn) : nn;
#pragma unroll
    for (int rr = 0; rr < 8; ++rr) {
      int kk = (tid >> 6) + 8 * rr;
      float v = (c >= 0) ? W[(size_t)(k0 + kk) * ldn + c] : 0.f;
      tile[kk * 65 + (tid & 63)] = v;
    }
  }
  __syncthreads();
#pragma unroll
  for (int rr = 0; rr < 8; ++rr) {
    int nn = (tid >> 6) + 8 * rr;
    int kk = tid & 63;
    Wt[(size_t)(n0 + nn) * 1024 + k0 + kk] = f2bf(tile[kk * 65 + nn]);
  }
  __syncthreads();
}

DI void phase_prep(const Params& p, char* smem) {
  const size_t gtid = (size_t)blockIdx.x * blockDim.x + threadIdx.x;
  const size_t gn = (size_t)gridDim.x * blockDim.x;
  char* ws = p.ws;
  cvt_stream(p.x, (u16*)(ws + OFF_XB), (size_t)T_ * 1024, gtid, gn);
  cvt_stream(p.mem, (u16*)(ws + OFF_MEMB), (size_t)2048 * 1024, gtid, gn);
  {
    const int lane = threadIdx.x & 63;
    const int gw = (int)(gtid >> 6), nw = (int)(gn >> 6);
    for (int r = gw; r < 2 * 16384; r += nw) {
      const int tbl = r >> 14, row = r & 16383;
      const float* src = (tbl ? p.ex_up : p.ex_down) + (size_t)row * 1024 + lane * 16;
      f32x4 v[4]; float mx = 0.f;
#pragma unroll
      for (int c = 0; c < 4; ++c) {
        v[c] = *reinterpret_cast<const f32x4*>(src + c * 4);
#pragma unroll
        for (int k = 0; k < 4; ++k) mx = fmaxf(mx, fabsf(v[c][k]));
      }
#pragma unroll
      for (int d = 32; d >= 1; d >>= 1) mx = fmaxf(mx, __shfl_xor(mx, d));
      float sc = (mx > 0.f) ? exp2f(floorf(log2f(224.f / mx))) : 1.f;
      u32x4 o;
#pragma unroll
      for (int c = 0; c < 4; ++c) {
        int t = __builtin_amdgcn_cvt_pk_fp8_f32(v[c][0] * sc, v[c][1] * sc, 0, false);
        t = __builtin_amdgcn_cvt_pk_fp8_f32(v[c][2] * sc, v[c][3] * sc, t, true);
        o[c] = (unsigned)t;
      }
      *reinterpret_cast<u32x4*>(ws + (tbl ? OFF_EXU : OFF_EXD) + (size_t)row * 1024 + lane * 16) = o;
      if (lane == 0) ((float*)(ws + OFF_ESC))[r] = 1.f / sc;
    }
  }
  cvt_stream(p.sk1, (u16*)(ws + OFF_SK), (size_t)128 * 128, gtid, gn);
  cvt_stream(p.sk2, (u16*)(ws + OFF_SK) + 128 * 128, (size_t)128 * 128, gtid, gn);
  float* tile = (float*)smem;
  const int n_win = 54 * 16, n_sq = 256, n_pq = 512;
  const int total = n_win + 5 * n_sq + n_pq;
  for (int t = blockIdx.x; t < total; t += gridDim.x) {
    if (t < n_win) {
      transpose_tile<true>(p.w_in, 3384, (u16*)(ws + OFF_WIN), (t & 15) * 64, (t >> 4) * 64, tile);
    } else if (t < n_win + 5 * n_sq) {
      int u = t - n_win; int which = u >> 8; int r = u & 255;
      const float* W = which == 0 ? p.w_out : which == 1 ? p.wq : which == 2 ? p.wk : which == 3 ? p.wv : p.wo;
      size_t off = which == 0 ? OFF_WOUT : which == 1 ? OFF_WQ : which == 2 ? OFF_WK : which == 3 ? OFF_WV : OFF_WO;
      transpose_tile<false>(W, 1024, (u16*)(ws + off), (r & 15) * 64, (r >> 4) * 64, tile);
    } else {
      int r = t - n_win - 5 * n_sq;
      transpose_tile<false>(p.w_pq, 2048, (u16*)(ws + OFF_WPQ), (r & 15) * 64, (r >> 4) * 64, tile);
    }
  }
}

#define WAIT_V(n) asm volatile("s_waitcnt vmcnt(%0)" ::"n"(n) : "memory")
#define RAW_BARRIER() do { asm volatile("s_waitcnt lgkmcnt(0)" ::: "memory"); __builtin_amdgcn_s_barrier(); asm volatile("" ::: "memory"); } while (0)
constexpr int G_STAGE = 384 * 128;
DI void gemm_tile(const u16* __restrict__ X, int ldx, const u16* __restrict__ Wt, int ldw, int K, char* smem,
                  f32x16 (&acc)[2][2]) {
  const int tid = threadIdx.x, lane = tid & 63, wave = tid >> 6;
  const int fw = wave & 1, tq = wave >> 1, lr = lane & 31, lh = lane >> 5;
#pragma unroll
  for (int a = 0; a < 2; ++a)
#pragma unroll
    for (int b = 0; b < 2; ++b) acc[a][b] = zero16();
  const int nk = K / 64;
  const u16* src[6];
#pragma unroll
  for (int i = 0; i < 6; ++i) {
    const int R = 8 * (wave + 8 * i) + (lane >> 3);
    const int c = (lane & 7) ^ ((R >> 1) & 7);
    src[i] = (i < 4) ? (X + (size_t)R * ldx + c * 8) : (Wt + (size_t)(R - 256) * ldw + c * 8);
  }
#define GLDS_STAGE(slot, kt) do { _Pragma("unroll") for (int i = 0; i < 6; ++i) \
    __builtin_amdgcn_global_load_lds((const unsigned*)(src[i] + (kt) * 64), (__attribute__((address_space(3))) unsigned*)(smem + (slot) * G_STAGE + (wave + 8 * i) * 1024), 16, 0, 0); } while (0)
  int offA[2], offB[2], xa[2], xb[2];
#pragma unroll
  for (int ft = 0; ft < 2; ++ft) { const int R = 256 + fw * 64 + ft * 32 + lr; offA[ft] = R * 128; xa[ft] = (R >> 1) & 7; }
#pragma unroll
  for (int tt = 0; tt < 2; ++tt) { const int R = tq * 64 + tt * 32 + lr; offB[tt] = R * 128; xb[tt] = (R >> 1) & 7; }
  GLDS_STAGE(0, 0); GLDS_STAGE(1, 1); WAIT_V(6); RAW_BARRIER();
  int cur = 0;
  for (int kt = 0; kt < nk; ++kt) {
    const int nxt = (cur >= 1) ? cur - 1 : 2;
    if (kt + 2 < nk) GLDS_STAGE(nxt, kt + 2);
    __builtin_amdgcn_sched_barrier(0);
    const char* st = smem + cur * G_STAGE;
#pragma unroll
    for (int ks = 0; ks < 4; ++ks) {
      bf16x8 a[2], b[2];
#pragma unroll
      for (int ft = 0; ft < 2; ++ft) a[ft] = *reinterpret_cast<const bf16x8*>(st + offA[ft] + (((ks * 2 + lh) ^ xa[ft]) << 4));
#pragma unroll
      for (int tt = 0; tt < 2; ++tt) b[tt] = *reinterpret_cast<const bf16x8*>(st + offB[tt] + (((ks * 2 + lh) ^ xb[tt]) << 4));
#pragma unroll
      for (int ft = 0; ft < 2; ++ft)
#pragma unroll
        for (int tt = 0; tt < 2; ++tt) acc[ft][tt] = MFMA(a[ft], b[tt], acc[ft][tt]);
    }
    if (kt + 2 < nk) { WAIT_V(6); } else { WAIT_V(0); }
    RAW_BARRIER();
    cur = (cur == 2) ? 0 : cur + 1;
  }
#undef GLDS_STAGE
}

DI void store_tm_rows(f32x16 (&acc)[2][2], char* smem, u16* tm, int tokbase, int col) {
  const int lane = threadIdx.x & 63, wave = threadIdx.x >> 6, lr = lane & 31, lh = lane >> 5;
  float* wl = (float*)(smem + wave * 17408);
#pragma unroll
  for (int tt = 0; tt < 2; ++tt)
#pragma unroll
    for (int ft = 0; ft < 2; ++ft)
#pragma unroll
      for (int g = 0; g < 4; ++g) {
        f32x4 v = {acc[ft][tt][4 * g], acc[ft][tt][4 * g + 1], acc[ft][tt][4 * g + 2], acc[ft][tt][4 * g + 3]};
        *reinterpret_cast<f32x4*>(wl + (tt * 32 + lr) * 68 + ft * 32 + 8 * g + 4 * lh) = v;
      }
  const int ch = lane & 15, r0 = lane >> 4;
#pragma unroll 4
  for (int k = 0; k < 16; ++k) {
    const int row = r0 + 4 * k;
    f32x4 v = *reinterpret_cast<const f32x4*>(wl + row * 68 + ch * 4);
    st4bf(tm + (size_t)(tokbase + row) * TMW + col + ch * 4, v[0], v[1], v[2], v[3]);
  }
}

DI void epi_inproj(const Params& p, int tok0, int f0, f32x16 (&acc)[2][2], char* smem) {
  const int tid = threadIdx.x, lane = tid & 63, wave = tid >> 6;
  const int fw = wave & 1, tq = wave >> 1, lr = lane & 31, lh = lane >> 5;
  const int fbase = f0 + fw * 64;
  if (fbase >= 3392) return;
  u16* tm = (u16*)(p.ws + OFF_TM);
  int tmcol = -1;
#pragma unroll
  for (int tt = 0; tt < 2; ++tt) {
    const int tok = tok0 + tq * 64 + tt * 32 + lr;
    const float posf = (float)p.positions[tok];
    const int bb = tok >> 12, ss = tok & 4095;
    if (fbase < 1024) {
#pragma unroll
      for (int r = 0; r < 4; ++r) {
        float j = (float)(4 * lh + r);
        float inv = exp2f(-j * (18.931568569324174f / 8.0f));
        float sn, cs; sincos_rad(posf * inv, sn, cs);
        float x1 = acc[0][tt][r], x2 = acc[0][tt][r + 4];
        acc[0][tt][r] = x1 * cs - x2 * sn;
        acc[0][tt][r + 4] = x2 * cs + x1 * sn;
      }
      if (fbase < 512) {
        tmcol = fbase;
      } else {
        u16* kfr = (u16*)(p.ws + OFF_KFR);
        const int head = (fbase - 512) >> 6, gt = ss >> 5;
#pragma unroll
        for (int ft = 0; ft < 2; ++ft)
#pragma unroll
          for (int g = 0; g < 4; ++g) {
            const int ks = ft * 2 + (g >> 1), lane2 = (g & 1) * 32 + lr;
            st4bf(kfr + ((((size_t)(bb * 8 + head) * 128 + gt) * 4 + ks) * 64 + lane2) * 8 + 4 * lh, acc[ft][tt][4 * g], acc[ft][tt][4 * g + 1], acc[ft][tt][4 * g + 2], acc[ft][tt][4 * g + 3]);
          }
      }
    } else if (fbase < 1536) {
      u16* vfr = (u16*)(p.ws + OFF_VT);
      const int head = (fbase - 1024) >> 6, gt = ss >> 5;
      const int s = lr >> 4, r16 = lr & 15, j = 4 * (r16 >> 3) + (r16 & 3), lh2 = (r16 >> 2) & 1;
#pragma unroll
      for (int ft = 0; ft < 2; ++ft)
#pragma unroll
        for (int i = 0; i < 16; ++i) {
          const int lane2 = lh2 * 32 + crow(i, lh);
          vfr[((((((size_t)(bb * 8 + head) * 128 + gt) * 2 + ft) * 2 + s) * 64 + lane2) * 8) + j] = f2bf(acc[ft][tt][i]);
        }
    } else if (fbase >= 2368 && fbase < 2880) {
      u16* vt = (u16*)(p.ws + OFF_GVT);
      const int fo = fbase - 2368;
#pragma unroll
      for (int ft = 0; ft < 2; ++ft)
#pragma unroll
        for (int i = 0; i < 16; ++i) {
          int feat = fo + ft * 32 + crow(i, lh);
          vt[((size_t)bb * 512 + feat) * 4096 + ss] = f2bf(acc[ft][tt][i]);
        }
    } else {
      if (fbase < 1856) {
#pragma unroll
        for (int ft = 0; ft < 2; ++ft) {
          const bool rot = (fbase < 1792) || (ft == 0);
#pragma unroll
          for (int r = 0; r < 4; ++r) {
            float v = acc[ft][tt][r];
            float o = __shfl_xor(v, 32);
            float inv = exp2f(-(float)r * (18.931568569324174f / 4.0f));
            float sn, cs; sincos_rad(posf * inv, sn, cs);
            float res = (lh == 0) ? (v * cs - o * sn) : (v * cs + o * sn);
            acc[ft][tt][r] = rot ? res : v;
          }
        }
        tmcol = fbase - 512;
        if (fbase == 1792) {
          u16* kif = (u16*)(p.ws + OFF_KIF);
          const int gt = ss >> 5;
#pragma unroll
          for (int g = 0; g < 4; ++g) {
            const int ks = g >> 1, lane2 = (g & 1) * 32 + lr;
            st4bf(kif + ((((size_t)bb * 128 + gt) * 2 + ks) * 64 + lane2) * 8 + 4 * lh, acc[0][tt][4 * g], acc[0][tt][4 * g + 1], acc[0][tt][4 * g + 2], acc[0][tt][4 * g + 3]);
          }
        }
      } else if (fbase < 2368) {
        tmcol = fbase - 512;
      } else {
        tmcol = fbase - 1024;
      }
    }
  }
  if (tmcol >= 0) store_tm_rows(acc, smem, tm, tok0 + tq * 64, tmcol);
}

DI void phase_inproj(const Params& p, char* smem) {
  const int n_in = 128 * 27;
  const int total = n_in + 128;
  const u16* xb = (const u16*)(p.ws + OFF_XB);
  const u16* memb = (const u16*)(p.ws + OFF_MEMB);
  const int tid = threadIdx.x, lane = tid & 63, wave = tid >> 6;
  const int fw = wave & 1, tq = wave >> 1, lr = lane & 31, lh = lane >> 5;
  for (int t = blockIdx.x; t < total; t += gridDim.x) {
    f32x16 acc[2][2];
    if (t < n_in) {
      int mt = t / 27, nt = t % 27;
      gemm_tile(xb + (size_t)mt * 256 * 1024, 1024, (const u16*)(p.ws + OFF_WIN) + (size_t)nt * 128 * 1024, 1024, 1024, smem, acc);
      epi_inproj(p, mt * 256, nt * 128, acc, smem);
      __syncthreads();
    } else {
      int u = t - n_in; int which = u >> 6; int r = u & 63; int mt = r >> 3, nt = r & 7;
      const u16* W = (const u16*)(p.ws + (which == 0 ? OFF_WK : OFF_WV));
      gemm_tile(memb + (size_t)mt * 256 * 1024, 1024, W + (size_t)nt * 128 * 1024, 1024, 1024, smem, acc);
#pragma unroll
      for (int tt = 0; tt < 2; ++tt) {
        const int tok = mt * 256 + tq * 64 + tt * 32 + lr;
        const int bb = tok >> 8, mm = tok & 255, hh = nt >> 1, kt = mm >> 5;
        if (which == 0) {
          u16* mk = (u16*)(p.ws + OFF_MEMK);
#pragma unroll
          for (int ft = 0; ft < 2; ++ft)
#pragma unroll
            for (int g = 0; g < 4; ++g) {
              const int ks = (nt & 1) * 8 + fw * 4 + ft * 2 + (g >> 1), lane2 = (g & 1) * 32 + lr;
              st4bf(mk + ((((size_t)(bb * 4 + hh) * 8 + kt) * 16 + ks) * 64 + lane2) * 8 + 4 * lh, acc[ft][tt][4 * g], acc[ft][tt][4 * g + 1], acc[ft][tt][4 * g + 2], acc[ft][tt][4 * g + 3]);
            }
        } else {
          u16* mv = (u16*)(p.ws + OFF_MEMVT);
          const int s = lr >> 4, r16 = lr & 15, j = 4 * (r16 >> 3) + (r16 & 3), lh2 = (r16 >> 2) & 1;
#pragma unroll
          for (int ft = 0; ft < 2; ++ft) {
            const int dt = (nt & 1) * 4 + fw * 2 + ft;
#pragma unroll
            for (int i = 0; i < 16; ++i) {
              const int lane2 = lh2 * 32 + crow(i, lh);
              mv[((((((size_t)(bb * 4 + hh) * 8 + dt) * 8 + kt) * 2 + s) * 64 + lane2) * 8) + j] = f2bf(acc[ft][tt][i]);
            }
          }
        }
      }
    }
  }
}

DI void idx_scores(const bf16x8 (&qf)[8][2], const float (&wq)[8], bf16x8 k0, bf16x8 k1, float (&sc)[16]) {
#pragma unroll
  for (int i = 0; i < 16; ++i) sc[i] = 0.f;
#pragma unroll
  for (int hd = 0; hd < 8; ++hd) {
    f32x16 a = zero16();
    a = MFMA(k0, qf[hd][0], a);
    a = MFMA(k1, qf[hd][1], a);
#pragma unroll
    for (int i = 0; i < 16; ++i) sc[i] = fmaf(wq[hd], fmaxf(a[i], 0.f), sc[i]);
  }
}

DI void load_idx_q(const u16* tm, int tok, int lh, bf16x8 (&qf)[8][2], float (&wq)[8]) {
  const u16* row = tm + (size_t)tok * TMW;
#pragma unroll
  for (int hd = 0; hd < 8; ++hd)
#pragma unroll
    for (int ks = 0; ks < 2; ++ks) qf[hd][ks] = ldg8(row + TM_QI + hd * 32 + ks * 16 + lh * 8);
  bf16x8 w8 = ldg8(row + TM_WI);
#pragma unroll
  for (int hd = 0; hd < 8; ++hd) wq[hd] = bf2f((u16)w8[hd]) * 0.0625f;
}

DI int wave_incl_scan(int v, int lane) {
#pragma unroll
  for (int d = 1; d < 64; d <<= 1) {
    int t = __shfl_up(v, d);
    if (lane >= d) v += t;
  }
  return v;
}

DI void dsa_thr_item(const Params& p, int b, int qblk, char* smem) {
  unsigned* hist = (unsigned*)smem;
  unsigned* pref = (unsigned*)(smem + 32768);
  int* rank = (int*)(smem + 32768 + 128);
  const u16* tm = (const u16*)(p.ws + OFF_TM);
  const int tid = threadIdx.x, lane = tid & 63, wave = tid >> 6, lr = lane & 31, lh = lane >> 5;
  const int q0 = qblk * 32;
  u16* qi = (u16*)(smem + 33280);
  for (int i = tid; i < 32 * 32; i += 512) {
    int q = i >> 5, ch = i & 31;
    *reinterpret_cast<u32x4*>(qi + q * 296 + ch * 8) = *reinterpret_cast<const u32x4*>(tm + (size_t)(b * S_ + q0 + q) * TMW + TM_QI + ch * 8);
  }
  float wq[8];
  {
    bf16x8 w8 = ldg8(tm + (size_t)(b * S_ + q0 + lr) * TMW + TM_WI);
#pragma unroll
    for (int hd = 0; hd < 8; ++hd) wq[hd] = bf2f((u16)w8[hd]) * 0.0625f;
  }
  __syncthreads();
  for (int i = tid; i < 32 * 32; i += 512) {
    const int q = i >> 5, d = i & 31;
    float acc = 0.f;
#pragma unroll
    for (int hd = 0; hd < 8; ++hd) acc = fmaf(bf2f(tm[(size_t)(b * S_ + q0 + q) * TMW + TM_WI + hd]) * 0.0625f, bf2f(qi[q * 296 + hd * 32 + d]), acc);
    qi[q * 296 + 256 + d] = f2bf(acc);
  }
  const u16* qil = qi + lr * 296 + lh * 8;
  if (tid < 32) { pref[tid] = 0u; rank[tid] = min(256, q0 + tid + 1); }
  for (int pass = 0; pass < 4; ++pass) {
    for (int i = tid; i < 8192; i += 512) hist[i] = 0u;
    __syncthreads();
    const int shift = 24 - 8 * pass;
    const unsigned mypref = pref[lr];
    const u16* kib = (const u16*)(p.ws + OFF_KIF) + (size_t)b * 128 * 1024 + lane * 8;
    bf16x8 kn0, kn1;
    {
      const int kt0 = min(wave, qblk);
      kn0 = ldg8(kib + (size_t)kt0 * 1024); kn1 = ldg8(kib + (size_t)kt0 * 1024 + 512);
    }
    for (int kt = wave; kt <= qblk; kt += 8) {
      const bf16x8 k0 = kn0, k1 = kn1;
      {
        const int ktn = min(kt + 8, qblk);
        kn0 = ldg8(kib + (size_t)ktn * 1024); kn1 = ldg8(kib + (size_t)ktn * 1024 + 512);
      }
      float sc[16];
      {
        f32x16 a = zero16();
        a = MFMA(k0, *reinterpret_cast<const bf16x8*>(qil + 256), a);
        a = MFMA(k1, *reinterpret_cast<const bf16x8*>(qil + 256 + 16), a);
#pragma unroll
        for (int i = 0; i < 16; ++i) sc[i] = a[i];
      }
#pragma unroll
      for (int hd = 0; hd < 8; ++hd) {
        f32x16 a = zero16();
        a = MFMA(k0, *reinterpret_cast<const bf16x8*>(qil + hd * 32), a);
        a = MFMA(k1, *reinterpret_cast<const bf16x8*>(qil + hd * 32 + 16), a);
        const float wh = wq[hd];
#pragma unroll
        for (int i = 0; i < 16; ++i) sc[i] = fmaf(fabsf(a[i]), wh, sc[i]);
      }
      if (kt == qblk) {
#pragma unroll
        for (int i = 0; i < 16; ++i) {
          int kp = kt * 32 + crow(i, lh);
          unsigned ky = fkey(sc[i]);
          unsigned hi = (ky >> shift);
          if (kp <= q0 + lr && (hi >> 8) == mypref) atomicAdd(&hist[(hi & 255u) * 32 + lr], 1u);
        }
      } else {
#pragma unroll
        for (int i = 0; i < 16; ++i) {
          unsigned ky = fkey(sc[i]);
          unsigned hi = (ky >> shift);
          if ((hi >> 8) == mypref) atomicAdd(&hist[(hi & 255u) * 32 + lr], 1u);
        }
      }
    }
    __syncthreads();
#pragma unroll 1
    for (int qq = 0; qq < 4; ++qq) {
      const int q = wave * 4 + qq;
      const int rk = rank[q];
      int c[4];
#pragma unroll
      for (int j = 0; j < 4; ++j) c[j] = (int)hist[(255 - 4 * lane - j) * 32 + q];
      int s = c[0] + c[1] + c[2] + c[3];
      int P = wave_incl_scan(s, lane);
      int excl = P - s;
      if (P >= rk && excl < rk) {
        int cum = excl; int bin = 0; int nr = 1; bool found = false;
#pragma unroll
        for (int j = 0; j < 4; ++j) {
          if (!found && cum + c[j] >= rk) { bin = 255 - 4 * lane - j; nr = rk - cum; found = true; }
          if (!found) cum += c[j];
        }
        pref[q] = (pref[q] << 8) | (unsigned)bin;
        rank[q] = nr;
      }
    }
    __syncthreads();
  }
  if (tid < 32) ((unsigned*)(p.ws + OFF_THR))[b * S_ + q0 + tid] = pref[tid];
  __syncthreads();
}

DI void dsa_attn_item(const Params& p, int b, int qblk, char* smem) {
  u16* maskbuf = (u16*)smem;
  u16* qi = (u16*)(smem + 4096);
  const u16* tm = (const u16*)(p.ws + OFF_TM);
  const u16* vfr = (const u16*)(p.ws + OFF_VT) + ((size_t)(b * 8 + (threadIdx.x >> 6)) * 128) * 2048 + (threadIdx.x & 63) * 8;
  const u16* kfr = (const u16*)(p.ws + OFF_KFR) + ((size_t)(b * 8 + (threadIdx.x >> 6)) * 128) * 2048 + (threadIdx.x & 63) * 8;
  const unsigned* thr = (const unsigned*)(p.ws + OFF_THR);
  const int tid = threadIdx.x, lane = tid & 63, wave = tid >> 6, lr = lane & 31, lh = lane >> 5;
  const int q0 = qblk * 32;
  const int head = wave;
  const int qtok = b * S_ + q0 + lr;
  bf16x8 Qf[4];
#pragma unroll
  for (int ks = 0; ks < 4; ++ks) {
    bf16x8 raw = ldg8(tm + (size_t)qtok * TMW + TM_Q + head * 64 + ks * 16 + lh * 8);
    float f[8];
#pragma unroll
    for (int j = 0; j < 8; ++j) f[j] = bf2f((u16)raw[j]) * (0.125f * 1.4426950408889634f);
    Qf[ks] = pack8(f[0], f[1], f[2], f[3], f[4], f[5], f[6], f[7]);
  }
  f32x16 O[2];
  O[0] = zero16(); O[1] = zero16();
  float mrun = -INFINITY, lrun = 0.f;
  const unsigned thrq = thr[qtok];
  const int nchunks = (q0 + 31) / 256 + 1;
  for (int i = tid; i < 32 * 32; i += 512) {
    int q = i >> 5, ch = i & 31;
    *reinterpret_cast<u32x4*>(qi + q * 296 + ch * 8) = *reinterpret_cast<const u32x4*>(tm + (size_t)(b * S_ + q0 + q) * TMW + TM_QI + ch * 8);
  }
  float* wqs = (float*)(smem + 4096 + 32 * 296 * 2);
  if (tid < 256) wqs[tid] = bf2f(tm[(size_t)(b * S_ + q0 + (tid & 31)) * TMW + TM_WI + (tid >> 5)]) * 0.0625f;
  __syncthreads();
  for (int i = tid; i < 32 * 32; i += 512) {
    const int q = i >> 5, d = i & 31;
    float acc = 0.f;
#pragma unroll
    for (int hd = 0; hd < 8; ++hd) acc = fmaf(bf2f(tm[(size_t)(b * S_ + q0 + q) * TMW + TM_WI + hd]) * 0.0625f, bf2f(qi[q * 296 + hd * 32 + d]), acc);
    qi[q * 296 + 256 + d] = f2bf(acc);
  }
  __syncthreads();
  const u16* qil = qi + lr * 296 + lh * 8;
  const u16* kibase = (const u16*)(p.ws + OFF_KIF) + (size_t)b * 128 * 1024 + lane * 8;
  bf16x8 Kf[4], Kn[4];
#pragma unroll
  for (int ks = 0; ks < 4; ++ks) Kf[ks] = ldg8(kfr + ks * 512);
  bf16x8 Vf[2][2], Vn[2][2];
#pragma unroll
  for (int dt = 0; dt < 2; ++dt)
#pragma unroll
    for (int s = 0; s < 2; ++s) Vf[dt][s] = ldg8(vfr + (dt * 2 + s) * 512);
  bf16x8 ki0, ki1;
  {
    const int kt0 = min(wave, qblk);
    ki0 = ldg8(kibase + (size_t)kt0 * 1024); ki1 = ldg8(kibase + (size_t)kt0 * 1024 + 512);
  }
  for (int c = 0; c < nchunks; ++c) {
    const int buf = c & 1;
    {
      const int key0 = (c * 8 + wave) * 32;
      unsigned bits = 0u;
      const bf16x8 k0 = ki0, k1 = ki1;
      {
        const int ktn = min((c + 1) * 8 + wave, qblk);
        ki0 = ldg8(kibase + (size_t)ktn * 1024); ki1 = ldg8(kibase + (size_t)ktn * 1024 + 512);
      }
      if (key0 <= q0 + 31) {
        float sc[16];
        {
          f32x16 a = zero16();
          a = MFMA(k0, *reinterpret_cast<const bf16x8*>(qil + 256), a);
          a = MFMA(k1, *reinterpret_cast<const bf16x8*>(qil + 256 + 16), a);
#pragma unroll
          for (int i = 0; i < 16; ++i) sc[i] = a[i];
        }
#pragma unroll 2
        for (int hd = 0; hd < 8; ++hd) {
          f32x16 a = zero16();
          a = MFMA(k0, *reinterpret_cast<const bf16x8*>(qil + hd * 32), a);
          a = MFMA(k1, *reinterpret_cast<const bf16x8*>(qil + hd * 32 + 16), a);
          const float wh = wqs[hd * 32 + lr];
#pragma unroll
          for (int i = 0; i < 16; ++i) sc[i] = fmaf(fabsf(a[i]), wh, sc[i]);
        }
        __builtin_amdgcn_sched_barrier(0);
#pragma unroll
        for (int i = 0; i < 16; ++i) {
          int kp = key0 + crow(i, lh);
          if (kp <= q0 + lr && fkey(sc[i]) >= thrq) bits |= (1u << i);
        }
      }
      maskbuf[(buf * 8 + wave) * 64 + lane] = (u16)bits;
    }
    __syncthreads();
#pragma unroll 1
    for (int t8 = 0; t8 < 8; ++t8) {
      const int g = c * 8 + t8;
      if (g > qblk) break;
      {
        const int gn = min(g + 1, qblk);
        const u16* kr = kfr + (size_t)gn * 2048;
#pragma unroll
        for (int ks = 0; ks < 4; ++ks) Kn[ks] = ldg8(kr + ks * 512);
#pragma unroll
        for (int dt = 0; dt < 2; ++dt)
#pragma unroll
          for (int s = 0; s < 2; ++s) Vn[dt][s] = ldg8(vfr + (size_t)gn * 2048 + (dt * 2 + s) * 512);
      }

      const unsigned bits = maskbuf[(buf * 8 + t8) * 64 + lane];
      f32x16 Sx = zero16();
#pragma unroll
      for (int ks = 0; ks < 4; ++ks) Sx = MFMA(Kf[ks], Qf[ks], Sx);
      float sm[16];
#pragma unroll
      for (int i = 0; i < 16; ++i) {
        const unsigned t = (unsigned)__builtin_amdgcn_sbfe((int)bits, i, 1);
        sm[i] = __uint_as_float((t & __float_as_uint(Sx[i])) | (~t & 0xff800000u));
      }
      float mt = fmaxf(fmaxf(fmaxf(sm[0], sm[1]), fmaxf(sm[2], sm[3])), fmaxf(fmaxf(sm[4], sm[5]), fmaxf(sm[6], sm[7])));
      mt = fmaxf(mt, fmaxf(fmaxf(fmaxf(sm[8], sm[9]), fmaxf(sm[10], sm[11])), fmaxf(fmaxf(sm[12], sm[13]), fmaxf(sm[14], sm[15]))));
      mt = fmaxf(mt, __shfl_xor(mt, 32));
      const float mnew = fmaxf(mrun, mt);
      const float msafe = (mnew == -INFINITY) ? 0.f : mnew;
      const float alpha = __builtin_amdgcn_exp2f(mrun - msafe);
      float pv[16]; float ps = 0.f;
#pragma unroll
      for (int i = 0; i < 16; ++i) { pv[i] = __builtin_amdgcn_exp2f(sm[i] - msafe); ps += pv[i]; }
      lrun = lrun * alpha + ps;
      mrun = mnew;
      if (__builtin_amdgcn_ballot_w64(alpha != 1.f) != 0ull) {
#pragma unroll
        for (int dt = 0; dt < 2; ++dt)
#pragma unroll
          for (int i = 0; i < 16; ++i) O[dt][i] *= alpha;
      }
      bf16x8 Pf[2];
#pragma unroll
      for (int s = 0; s < 2; ++s) Pf[s] = pack8(pv[8 * s], pv[8 * s + 1], pv[8 * s + 2], pv[8 * s + 3], pv[8 * s + 4], pv[8 * s + 5], pv[8 * s + 6], pv[8 * s + 7]);
#pragma unroll
      for (int dt = 0; dt < 2; ++dt)
#pragma unroll
        for (int s = 0; s < 2; ++s) O[dt] = MFMA(Vf[dt][s], Pf[s], O[dt]);
#pragma unroll
      for (int ks = 0; ks < 4; ++ks) Kf[ks] = Kn[ks];
#pragma unroll
      for (int dt = 0; dt < 2; ++dt)
#pragma unroll
        for (int s = 0; s < 2; ++s) Vf[dt][s] = Vn[dt][s];
    }
  }
  u16* y = (u16*)(p.ws + OFF_XB);
  {
    float lt = lrun + __shfl_xor(lrun, 32);
    float inv = 1.f / lt;
#pragma unroll
    for (int dt = 0; dt < 2; ++dt)
#pragma unroll
      for (int g = 0; g < 4; ++g)
        st4bf(y + (size_t)qtok * 1024 + head * 64 + dt * 32 + 8 * g + 4 * lh, O[dt][4 * g] * inv, O[dt][4 * g + 1] * inv, O[dt][4 * g + 2] * inv, O[dt][4 * g + 3] * inv);
  }
  __syncthreads();
}

DI void gla_bcum(const Params& p, int b, int h, int n, float* bc, float* glr_s, float* segtot) {
  const u16* tm = (const u16*)(p.ws + OFF_TM);
  const int tid = threadIdx.x;
  const int tok0 = b * S_ + n * 64;
  for (int i = tid; i < 1024; i += 512) glr_s[i] = bf2f(tm[(size_t)(tok0 + (i >> 4)) * TMW + TM_GLR + (i & 15)]);
  const int d = tid & 63, cgp = tid >> 6;
  float gu[16];
#pragma unroll
  for (int j = 0; j < 16; ++j) gu[j] = p.gate_up[j * 256 + h * 64 + d];
  const float bias = p.gate_bias[h * 64 + d];
  __syncthreads();
  float v[8]; float run = 0.f;
#pragma unroll
  for (int r = 0; r < 8; ++r) {
    const int c = cgp * 8 + r;
    float z = bias;
#pragma unroll
    for (int j = 0; j < 16; ++j) z = fmaf(glr_s[c * 16 + j], gu[j], z);
    float la = (fminf(z, 0.f) - log1pf(__expf(-fabsf(z)))) * 0.0625f;
    run += la; v[r] = run;
  }
  segtot[cgp * 64 + d] = run;
  __syncthreads();
  float off = 0.f;
#pragma unroll
  for (int g = 0; g < 8; ++g) off += (g < cgp) ? segtot[g * 64 + d] : 0.f;
#pragma unroll
  for (int r = 0; r < 8; ++r) bc[(cgp * 8 + r) * 64 + d] = off + v[r];
  __syncthreads();
}

DI void gla_g1_item(const Params& p, int item, char* smem) {
  float* bc = (float*)smem;
  float* glr_s = (float*)(smem + 16384);
  float* segtot = (float*)(smem + 20480);
  u16* KeT = (u16*)(smem + 22528);
  const int b = item >> 8, h = (item >> 6) & 3, n = item & 63;
  const u16* tm = (const u16*)(p.ws + OFF_TM);
  const u16* gvT = (const u16*)(p.ws + OFF_GVT);
  const int tid = threadIdx.x, lane = tid & 63, wave = tid >> 6, lr = lane & 31, lh = lane >> 5;
  const int tok0 = b * S_ + n * 64;
  u16 kraw[8];
  {
    const int d = tid & 63, cgp = tid >> 6;
#pragma unroll
    for (int r = 0; r < 8; ++r) kraw[r] = tm[(size_t)(tok0 + cgp * 8 + r) * TMW + TM_GK + h * 64 + d];
  }
  bf16x8 afr[4];
  {
    const int et = wave & 3;
    const u16* arow = gvT + ((size_t)b * 512 + h * 128 + et * 32 + lr) * 4096 + n * 64 + lh * 8;
#pragma unroll
    for (int ks = 0; ks < 4; ++ks) afr[ks] = ldg8(arow + ks * 16);
  }
  gla_bcum(p, b, h, n, bc, glr_s, segtot);
  {
    const int d = tid & 63, cgp = tid >> 6;
    const float blast = bc[63 * 64 + d];
    {
      float* bcg = (float*)(p.ws + OFF_BCG) + (size_t)item * 4096;
#pragma unroll
      for (int r = 0; r < 8; ++r) bcg[(cgp * 8 + r) * 64 + d] = bc[(cgp * 8 + r) * 64 + d];
    }
    float f[8];
#pragma unroll
    for (int r = 0; r < 8; ++r) {
      const int c = cgp * 8 + r;
      float kv = bf2f(kraw[r]);
      f[r] = kv * __expf(blast - bc[c * 64 + d]);
    }
    *reinterpret_cast<bf16x8*>(KeT + d * 72 + cgp * 8) = pack8(f[0], f[1], f[2], f[3], f[4], f[5], f[6], f[7]);
    if (cgp == 0) ((float*)(p.ws + OFF_DECAY))[item * 64 + d] = __expf(blast);
  }
  __syncthreads();
  {
    const int et = wave & 3, dtl = wave >> 2;
    f32x16 acc = zero16();
#pragma unroll
    for (int ks = 0; ks < 4; ++ks) {
      bf16x8 a = afr[ks];
      bf16x8 bb = *reinterpret_cast<const bf16x8*>(KeT + (dtl * 32 + lr) * 72 + ks * 16 + lh * 8);
      acc = MFMA(a, bb, acc);
    }
    float* kvT = (float*)(p.ws + OFF_KVT);
#pragma unroll
    for (int i = 0; i < 16; ++i) kvT[((size_t)item * 128 + et * 32 + crow(i, lh)) * 64 + dtl * 32 + lr] = acc[i];
  }
  __syncthreads();
}

DI void gla_scan(const Params& p) {
  const float* kvT = (const float*)(p.ws + OFF_KVT);
  const float* decay = (const float*)(p.ws + OFF_DECAY);
  u16* prev = (u16*)(p.ws + OFF_PREV);
  const int gtid = blockIdx.x * blockDim.x + threadIdx.x;
  const int gn = gridDim.x * blockDim.x;
  for (int u = gtid; u < 32 * 2048; u += gn) {
    const int bh = u >> 11, rem = u & 2047, e = rem >> 4, d4 = (rem & 15) * 4;
    f32x4 st = {0.f, 0.f, 0.f, 0.f};
#pragma unroll 4
    for (int n = 0; n < 64; ++n) {
      const int item = bh * 64 + n;
      st4bf(prev + ((size_t)item * 128 + e) * 64 + d4, st[0], st[1], st[2], st[3]);
      f32x4 dc = *reinterpret_cast<const f32x4*>(decay + item * 64 + d4);
      f32x4 kv = *reinterpret_cast<const f32x4*>(kvT + ((size_t)item * 128 + e) * 64 + d4);
      st = dc * st + kv;
    }
  }
}

DI void gla_g3_item(const Params& p, int item, char* smem) {
  float* red = (float*)smem;
  const int b = item >> 8, h = (item >> 6) & 3, n = item & 63;
  const u16* tm = (const u16*)(p.ws + OFF_TM);
  const u16* gvT = (const u16*)(p.ws + OFF_GVT);
  const u16* prev = (const u16*)(p.ws + OFF_PREV);
  const float* bcg = (const float*)(p.ws + OFF_BCG) + (size_t)item * 4096;
  const int tid = threadIdx.x, lane = tid & 63, wave = tid >> 6, lr = lane & 31, lh = lane >> 5;
  const int tok0 = b * S_ + n * 64;
  const int et = wave & 3, ct = wave >> 2;
  bf16x8 qraw[4], kraw[2][4], sfr[4];
  bf16x4 vlo[2][2], vhi[2][2];
  f32x4 bq[4][2];
  {
    const u16* vrow0 = gvT + ((size_t)b * 512 + h * 128 + et * 32 + lr) * 4096 + n * 64 + 4 * lh;
    const u16* srow0 = prev + ((size_t)item * 128 + et * 32 + lr) * 64 + lh * 8;
#pragma unroll
    for (int ks = 0; ks < 4; ++ks) {
      qraw[ks] = ldg8(tm + (size_t)(tok0 + ct * 32 + lr) * TMW + TM_GQ + h * 64 + ks * 16 + lh * 8);
      kraw[0][ks] = ldg8(tm + (size_t)(tok0 + lr) * TMW + TM_GK + h * 64 + ks * 16 + lh * 8);
      kraw[1][ks] = ldg8(tm + (size_t)(tok0 + ct * 32 + lr) * TMW + TM_GK + h * 64 + ks * 16 + lh * 8);
      sfr[ks] = ldg8(srow0 + ks * 16);
      bq[ks][0] = *reinterpret_cast<const f32x4*>(bcg + (ct * 32 + lr) * 64 + ks * 16 + lh * 8);
      bq[ks][1] = *reinterpret_cast<const f32x4*>(bcg + (ct * 32 + lr) * 64 + ks * 16 + lh * 8 + 4);
    }
#pragma unroll
    for (int st = 0; st < 2; ++st)
#pragma unroll
      for (int s2 = 0; s2 < 2; ++s2) {
        const u16* vp = vrow0 + (st * ct) * 32 + 16 * s2;
        vlo[st][s2] = *reinterpret_cast<const bf16x4*>(vp);
        vhi[st][s2] = *reinterpret_cast<const bf16x4*>(vp + 8);
      }
  }
  bf16x8 Qd[4];
#pragma unroll
  for (int ks = 0; ks < 4; ++ks) {
    float f[8];
#pragma unroll
    for (int j = 0; j < 8; ++j) f[j] = bf2f((u16)qraw[ks][j]) * 0.125f * __expf(bq[ks][j >> 2][j & 3]);
    Qd[ks] = pack8(f[0], f[1], f[2], f[3], f[4], f[5], f[6], f[7]);
  }
  f32x16 O = zero16();
#pragma unroll
  for (int st = 0; st < 2; ++st) {
    if (st <= ct) {
      f32x16 A = zero16();
      const int s = st * 32 + lr;
#pragma unroll
      for (int ks = 0; ks < 4; ++ks) {
        f32x4 b0 = (st == 1) ? bq[ks][0] : *reinterpret_cast<const f32x4*>(bcg + s * 64 + ks * 16 + lh * 8);
        f32x4 b1 = (st == 1) ? bq[ks][1] : *reinterpret_cast<const f32x4*>(bcg + s * 64 + ks * 16 + lh * 8 + 4);
        float f[8];
#pragma unroll
        for (int j = 0; j < 8; ++j) f[j] = bf2f((u16)kraw[st][ks][j]) * __expf(-((j < 4) ? b0[j & 3] : b1[j & 3]));
        bf16x8 Ki = pack8(f[0], f[1], f[2], f[3], f[4], f[5], f[6], f[7]);
        A = MFMA(Ki, Qd[ks], A);
      }
      float pv[16];
#pragma unroll
      for (int i = 0; i < 16; ++i) pv[i] = (st * 32 + crow(i, lh) <= ct * 32 + lr) ? A[i] : 0.f;
#pragma unroll
      for (int s2 = 0; s2 < 2; ++s2) {
        bf16x8 Pf = pack8(pv[8 * s2], pv[8 * s2 + 1], pv[8 * s2 + 2], pv[8 * s2 + 3], pv[8 * s2 + 4], pv[8 * s2 + 5], pv[8 * s2 + 6], pv[8 * s2 + 7]);
        O = MFMA(cat44(vlo[st][s2], vhi[st][s2]), Pf, O);
      }
    }
  }
#pragma unroll
  for (int ks = 0; ks < 4; ++ks) O = MFMA(sfr[ks], Qd[ks], O);
  float ss = 0.f;
#pragma unroll
  for (int i = 0; i < 16; ++i) ss += O[i] * O[i];
  ss += __shfl_xor(ss, 32);
  if (lh == 0) red[(ct * 4 + et) * 32 + lr] = ss;
  __syncthreads();
  const float tot = red[(ct * 4 + 0) * 32 + lr] + red[(ct * 4 + 1) * 32 + lr] + red[(ct * 4 + 2) * 32 + lr] + red[(ct * 4 + 3) * 32 + lr];
  const float rinv = rsqrtf(tot * (1.f / 128.f) + 1e-6f);
  const int tok = tok0 + ct * 32 + lr;
  u16* y = (u16*)(p.ws + OFF_XB);
#pragma unroll
  for (int g = 0; g < 4; ++g) {
    const int e0 = et * 32 + 8 * g + 4 * lh;
    u32x2 gr = *reinterpret_cast<const u32x2*>(tm + (size_t)tok * TMW + TM_GR + h * 128 + e0);
    f32x4 ng = *reinterpret_cast<const f32x4*>(p.norm_g + e0);
    float grv[4] = {bflo(gr[0]), bfhi(gr[0]), bflo(gr[1]), bfhi(gr[1])};
    float o[4];
#pragma unroll
    for (int r = 0; r < 4; ++r) {
      float sl = grv[r] / (1.f + __expf(-grv[r]));
      o[r] = O[4 * g + r] * rinv * ng[r] * sl;
    }
    st4bf(y + (size_t)tok * 1024 + 512 + h * 128 + e0, o[0], o[1], o[2], o[3]);
  }
  __syncthreads();
}

template <int MODE>
DI void phase_gemm(const Params& p, const u16* X, const u16* Wt, int N, const float* resid, float* outf, u16* outb, int ldo, char* smem) {
  const int ntn = N / 128;
  const int total = 128 * ntn;
  const int tid = threadIdx.x, lane = tid & 63, wave = tid >> 6;
  const int fw = wave & 1, tq = wave >> 1, lr = lane & 31, lh = lane >> 5;
  for (int t = blockIdx.x; t < total; t += gridDim.x) {
    const int mt = t / ntn, nt = t % ntn;
    f32x16 acc[2][2];
    gemm_tile(X + (size_t)mt * 256 * 1024, 1024, Wt + (size_t)nt * 128 * 1024, 1024, 1024, smem, acc);
    if (MODE == 0 || MODE == 1) {
      float* wl = (float*)(smem + wave * 17408);
#pragma unroll
      for (int tt = 0; tt < 2; ++tt)
#pragma unroll
        for (int ft = 0; ft < 2; ++ft)
#pragma unroll
          for (int g = 0; g < 4; ++g) {
            f32x4 v = {acc[ft][tt][4 * g], acc[ft][tt][4 * g + 1], acc[ft][tt][4 * g + 2], acc[ft][tt][4 * g + 3]};
            *reinterpret_cast<f32x4*>(wl + (tt * 32 + lr) * 68 + ft * 32 + 8 * g + 4 * lh) = v;
          }
      const int ch = lane & 15, r0 = lane >> 4;
      const int f = nt * 128 + fw * 64 + ch * 4;
#pragma unroll 4
      for (int k = 0; k < 16; ++k) {
        const int row = r0 + 4 * k;
        const int tok = mt * 256 + tq * 64 + row;
        f32x4 v = *reinterpret_cast<const f32x4*>(wl + row * 68 + ch * 4);
        if (MODE == 0) {
          f32x4 r = *reinterpret_cast<const f32x4*>(resid + (size_t)tok * 1024 + f);
          f32x4 o;
#pragma unroll
          for (int j = 0; j < 4; ++j) o[j] = ALPHA * r[j] + v[j];
          *reinterpret_cast<f32x4*>(outf + (size_t)tok * 1024 + f) = o;
        } else {
          st4bf(outb + (size_t)tok * ldo + f, v[0], v[1], v[2], v[3]);
        }
      }
      __syncthreads();
    } else {
#pragma unroll
      for (int tt = 0; tt < 2; ++tt) {
        const int tok = mt * 256 + tq * 64 + tt * 32 + lr;
#pragma unroll
        for (int ft = 0; ft < 2; ++ft)
#pragma unroll
          for (int g = 0; g < 4; ++g) {
            const int f = nt * 128 + fw * 64 + ft * 32 + 8 * g + 4 * lh;
            if (MODE == 2) {
              const int hh = f >> 8, fh = f & 255, ks = fh >> 4, lane2 = ((fh >> 3) & 1) * 32 + lr;
              st4bf(outb + ((((size_t)(tok >> 5) * 4 + hh) * 16 + ks) * 64 + lane2) * 8 + 4 * lh, acc[ft][tt][4 * g], acc[ft][tt][4 * g + 1], acc[ft][tt][4 * g + 2], acc[ft][tt][4 * g + 3]);
            } else {
              const int hh = f >> 8, fq = f & 127, half = (f >> 7) & 1, ks = fq >> 4, lane2 = ((fq >> 3) & 1) * 32 + lr;
              st4bf(outb + (((((size_t)(tok >> 5) * 8 + hh) * 2 + half) * 8 + ks) * 64 + lane2) * 8 + 4 * lh, acc[ft][tt][4 * g], acc[ft][tt][4 * g + 1], acc[ft][tt][4 * g + 2], acc[ft][tt][4 * g + 3]);
            }
          }
      }
    }
  }
}

DI void phase_ln(const Params& p, float* h, u16* hb, const float* g, const float* bta) {
  const int lane = threadIdx.x & 63;
  const int gw = (blockIdx.x * blockDim.x + threadIdx.x) >> 6;
  const int nw = (gridDim.x * blockDim.x) >> 6;
  for (int row = gw; row < T_; row += nw) {
    float* r = h + (size_t)row * 1024;
    f32x4 v[4]; float s = 0.f;
#pragma unroll
    for (int c = 0; c < 4; ++c) { v[c] = *reinterpret_cast<const f32x4*>(r + c * 256 + lane * 4); s += v[c][0] + v[c][1] + v[c][2] + v[c][3]; }
    const float mean = wave_sum(s) * (1.f / 1024.f);
    float q = 0.f;
#pragma unroll
    for (int c = 0; c < 4; ++c)
#pragma unroll
      for (int k = 0; k < 4; ++k) { float d = v[c][k] - mean; q += d * d; }
    const float rstd = rsqrtf(wave_sum(q) * (1.f / 1024.f) + 1e-5f);
#pragma unroll
    for (int c = 0; c < 4; ++c) {
      f32x4 gg = *reinterpret_cast<const f32x4*>(g + c * 256 + lane * 4);
      f32x4 bb = *reinterpret_cast<const f32x4*>(bta + c * 256 + lane * 4);
      f32x4 o;
#pragma unroll
      for (int k = 0; k < 4; ++k) o[k] = (v[c][k] - mean) * rstd * gg[k] + bb[k];
      *reinterpret_cast<f32x4*>(r + c * 256 + lane * 4) = o;
      st4bf(hb + (size_t)row * 1024 + c * 256 + lane * 4, o[0], o[1], o[2], o[3]);
    }
  }
}

DI void phase_xattn(const Params& p) {
  const u16* qx = (const u16*)(p.ws + OFF_QX);
  const u16* mk = (const u16*)(p.ws + OFF_MEMK);
  const u16* mv = (const u16*)(p.ws + OFF_MEMVT);
  u16* ox = (u16*)(p.ws + OFF_OX);
  const int lane = threadIdx.x & 63, lr = lane & 31, lh = lane >> 5;
  const int gw = (blockIdx.x * blockDim.x + threadIdx.x) >> 6;
  const int nw = (gridDim.x * blockDim.x) >> 6;
  for (int it = gw; it < 8 * 4 * 128; it += nw) {
    const int qt = it & 127, h = (it >> 7) & 3, b = it >> 9;
    const int tok = b * S_ + qt * 32 + lr;
    f32x16 Sx[8];
#pragma unroll
    for (int kt = 0; kt < 8; ++kt) Sx[kt] = zero16();
    const u16* qrow = qx + (((size_t)(b * 128 + qt) * 4 + h) * 16) * 512 + lane * 8;
    const u16* krow = mk + (((size_t)(b * 4 + h) * 8) * 16) * 512 + lane * 8;
#pragma unroll 2
    for (int ks = 0; ks < 16; ++ks) {
      bf16x8 qf = ldg8(qrow + ks * 512);
#pragma unroll
      for (int kt = 0; kt < 8; ++kt) Sx[kt] = MFMA(ldg8(krow + (kt * 16 + ks) * 512), qf, Sx[kt]);
    }
    float mx = -INFINITY;
#pragma unroll
    for (int kt = 0; kt < 8; ++kt)
#pragma unroll
      for (int i = 0; i < 16; ++i) mx = fmaxf(mx, Sx[kt][i]);
    mx = fmaxf(mx, __shfl_xor(mx, 32));
    float ls = 0.f;
    bf16x8 Pf[8][2];
#pragma unroll
    for (int kt = 0; kt < 8; ++kt) {
      float pv[16];
#pragma unroll
      for (int i = 0; i < 16; ++i) { pv[i] = __expf((Sx[kt][i] - mx) * 0.0625f); ls += pv[i]; }
#pragma unroll
      for (int s = 0; s < 2; ++s) Pf[kt][s] = pack8(pv[8 * s], pv[8 * s + 1], pv[8 * s + 2], pv[8 * s + 3], pv[8 * s + 4], pv[8 * s + 5], pv[8 * s + 6], pv[8 * s + 7]);
    }
    ls += __shfl_xor(ls, 32);
    const float inv = 1.f / ls;
#pragma unroll 1
    for (int dt = 0; dt < 8; ++dt) {
      f32x16 o = zero16();
      const u16* vrow = mv + ((((size_t)(b * 4 + h) * 8 + dt) * 8) * 2) * 512 + lane * 8;
#pragma unroll
      for (int kt = 0; kt < 8; ++kt)
#pragma unroll
        for (int s = 0; s < 2; ++s) o = MFMA(ldg8(vrow + (kt * 2 + s) * 512), Pf[kt][s], o);
#pragma unroll
      for (int g = 0; g < 4; ++g)
        st4bf(ox + (size_t)tok * 1024 + h * 256 + dt * 32 + 8 * g + 4 * lh, o[4 * g] * inv, o[4 * g + 1] * inv, o[4 * g + 2] * inv, o[4 * g + 3] * inv);
    }
  }
}

DI void peer_topk_item(const Params& p, int tt128, int head, char* smem) {
  float* sc = (float*)smem;
  float* topv = (float*)(smem + 132096);
  unsigned char* topi = (unsigned char*)(smem + 132096 + 16384);
  const u16* pq = (const u16*)(p.ws + OFF_QX);
  const u16* sk = (const u16*)(p.ws + OFF_SK);
  const int tid = threadIdx.x, lane = tid & 63, wave = tid >> 6, lr = lane & 31, lh = lane >> 5;
  const int tok0 = tt128 * 128;
  {
    const int half = wave >> 2, kt = wave & 3;
    bf16x8 af[8];
#pragma unroll
    for (int ks = 0; ks < 8; ++ks) af[ks] = ldg8(sk + (size_t)half * 16384 + (kt * 32 + lr) * 128 + ks * 16 + lh * 8);
#pragma unroll 1
    for (int tt = 0; tt < 4; ++tt) {
      f32x16 acc = zero16();
      const u16* brow = pq + (((((size_t)(tok0 >> 5) + tt) * 8 + head) * 2 + half) * 8) * 512 + lane * 8;
#pragma unroll
      for (int ks = 0; ks < 8; ++ks) acc = MFMA(af[ks], ldg8(brow + ks * 512), acc);
#pragma unroll
      for (int i = 0; i < 16; ++i) sc[(half * 128 + tt * 32 + lr) * 129 + kt * 32 + crow(i, lh)] = acc[i];
    }
  }
  __syncthreads();
  if (tid < 256) {
    float* row = sc + tid * 129;
    float gm[8]; int gi[8];
#pragma unroll
    for (int g = 0; g < 8; ++g) {
      float m = -INFINITY; int mi = g * 16;
#pragma unroll
      for (int j = 0; j < 16; ++j) { float v = row[g * 16 + j]; if (v > m) { m = v; mi = g * 16 + j; } }
      gm[g] = m; gi[g] = mi;
    }
#pragma unroll 1
    for (int r = 0; r < 16; ++r) {
      float best = gm[0]; int bg = 0; int bi = gi[0];
#pragma unroll
      for (int g = 1; g < 8; ++g) if (gm[g] > best) { best = gm[g]; bg = g; bi = gi[g]; }
      topv[tid * 16 + r] = best; topi[tid * 16 + r] = (unsigned char)bi;
      row[bi] = -INFINITY;
      float m = -INFINITY; int mi = bg * 16;
#pragma unroll
      for (int j = 0; j < 16; ++j) { float v = row[bg * 16 + j]; if (v > m) { m = v; mi = bg * 16 + j; } }
#pragma unroll
      for (int g = 0; g < 8; ++g) { gm[g] = (g == bg) ? m : gm[g]; gi[g] = (g == bg) ? mi : gi[g]; }
    }
  }
  __syncthreads();
  if (tid < 128) {
    const float* av = topv + tid * 16;
    const float* bv = topv + (128 + tid) * 16;
    const unsigned char* ai = topi + tid * 16;
    const unsigned char* bi_ = topi + (128 + tid) * 16;
    float cur[16]; int pp[16];
    const float b0 = bv[0];
#pragma unroll
    for (int i = 0; i < 16; ++i) { cur[i] = av[i] + b0; pp[i] = 0; }
    float sel[16]; int eid[16];
#pragma unroll
    for (int r = 0; r < 16; ++r) {
      float best = cur[0]; int bi = 0; int bj = pp[0];
#pragma unroll
      for (int i = 1; i < 16; ++i) if (cur[i] > best) { best = cur[i]; bi = i; bj = pp[i]; }
      sel[r] = best;
      eid[r] = (int)ai[bi] * 128 + (int)bi_[bj];
      const int nj = bj + 1;
      const float nv = (nj < 16) ? (av[bi] + bv[nj & 15]) : -INFINITY;
#pragma unroll
      for (int i = 0; i < 16; ++i) { cur[i] = (i == bi) ? nv : cur[i]; pp[i] = (i == bi) ? nj : pp[i]; }
    }
    float sum = 0.f;
    const float smax = sel[0];
#pragma unroll
    for (int r = 0; r < 16; ++r) { sel[r] = __expf(sel[r] - smax); sum += sel[r]; }
    const float inv = 1.f / sum;
    int* eo = (int*)(p.ws + OFF_EIDX) + (size_t)(tok0 + tid) * 128 + head * 16;
    float* go = (float*)(p.ws + OFF_GATE) + (size_t)(tok0 + tid) * 128 + head * 16;
#pragma unroll
    for (int r = 0; r < 16; ++r) { eo[r] = eid[r]; go[r] = sel[r] * inv; }
  }
  __syncthreads();
}

DI float dot2bf(unsigned a, unsigned b, float c) {
  return __builtin_amdgcn_fdot2_f32_bf16(__builtin_bit_cast(bf2_t, a), __builtin_bit_cast(bf2_t, b), c, false);
}

DI float reduce8(float (&part)[8], int lane) {
  float r4[4], r2[2], r1;
#pragma unroll
  for (int k = 0; k < 4; ++k) {
    float send = (lane & 1) ? part[2 * k] : part[2 * k + 1];
    float keep = (lane & 1) ? part[2 * k + 1] : part[2 * k];
    r4[k] = keep + __shfl_xor(send, 1);
  }
#pragma unroll
  for (int k = 0; k < 2; ++k) {
    float send = (lane & 2) ? r4[2 * k] : r4[2 * k + 1];
    float keep = (lane & 2) ? r4[2 * k + 1] : r4[2 * k];
    r2[k] = keep + __shfl_xor(send, 2);
  }
  {
    float send = (lane & 4) ? r2[0] : r2[1];
    float keep = (lane & 4) ? r2[1] : r2[0];
    r1 = keep + __shfl_xor(send, 4);
  }
  r1 += __shfl_xor(r1, 8);
  r1 += __shfl_xor(r1, 16);
  r1 += __shfl_xor(r1, 32);
  return r1;
}

DI void phase_peer_down(const Params& p) {
  const char* exd = p.ws + OFF_EXD;
  const float* esc = (const float*)(p.ws + OFF_ESC);
  const u16* hb = (const u16*)(p.ws + OFF_HB);
  const int* eidx = (const int*)(p.ws + OFF_EIDX);
  const float* gate = (const float*)(p.ws + OFF_GATE);
  float* coefw = (float*)(p.ws + OFF_COEF);
  const int lane = threadIdx.x & 63;
  const int gw = (blockIdx.x * blockDim.x + threadIdx.x) >> 6;
  const int nw = (gridDim.x * blockDim.x) >> 6;
#pragma unroll 1
  for (int sl = 0; sl < 2; ++sl) {
#pragma unroll 1
    for (int tok = gw; tok < T_; tok += nw) {
      float x[16];
      {
        const u16* xr = hb + (size_t)tok * 1024 + lane * 16;
        u32x4 a = *reinterpret_cast<const u32x4*>(xr);
        u32x4 c = *reinterpret_cast<const u32x4*>(xr + 8);
#pragma unroll
        for (int w = 0; w < 4; ++w) { x[2 * w] = bflo(a[w]); x[2 * w + 1] = bfhi(a[w]); x[8 + 2 * w] = bflo(c[w]); x[8 + 2 * w + 1] = bfhi(c[w]); }
      }
#pragma unroll 1
      for (int half = 0; half < 2; ++half) {
        const int ev = eidx[(size_t)tok * 128 + half * 64 + lane];
        const float gv = gate[(size_t)tok * 128 + half * 64 + lane];
        unsigned long long m = __builtin_amdgcn_ballot_w64((ev >> 13) == sl);
        while (m != 0ull) {
          int pos[8];
          const int first = __builtin_ctzll(m);
#pragma unroll
          for (int k = 0; k < 8; ++k) {
            if (m != 0ull) { pos[k] = __builtin_ctzll(m); m &= m - 1ull; } else pos[k] = -1;
          }
          u32x4 dr[8];
#pragma unroll
          for (int k = 0; k < 8; ++k) {
            const int er = __builtin_amdgcn_readlane(ev, pos[k] >= 0 ? pos[k] : first);
            dr[k] = *reinterpret_cast<const u32x4*>(exd + (size_t)er * 1024 + lane * 16);
          }
          int pmine = pos[0];
#pragma unroll
          for (int k = 1; k < 8; ++k) pmine = ((lane & 7) == k) ? pos[k] : pmine;
          const int psafe = pmine >= 0 ? pmine : first;
          const int emine = __shfl(ev, psafe);
          const float gsel = __shfl(gv, psafe);
          const float sd = esc[emine];
          const float su = esc[16384 + emine];
          float part[8];
#pragma unroll
          for (int k = 0; k < 8; ++k) {
            float a0 = 0.f, a1 = 0.f;
#pragma unroll
            for (int w = 0; w < 4; ++w) {
              f2_t lo = __builtin_amdgcn_cvt_pk_f32_fp8((int)dr[k][w], false);
              f2_t hi = __builtin_amdgcn_cvt_pk_f32_fp8((int)dr[k][w], true);
              a0 = fmaf(lo[0], x[4 * w], a0); a1 = fmaf(lo[1], x[4 * w + 1], a1);
              a0 = fmaf(hi[0], x[4 * w + 2], a0); a1 = fmaf(hi[1], x[4 * w + 3], a1);
            }
            part[k] = a0 + a1;
          }
          float r1 = reduce8(part, lane) * sd;
          const float act = 0.5f * r1 * (1.f + erff(r1 * 0.70710678118654752f));
          if (lane < 8 && pmine >= 0) coefw[(size_t)tok * 128 + half * 64 + pmine] = gsel * act * su;
        }
      }
    }
  }
}

DI void phase_peer_ffn(const Params& p) {
  const char* exu = p.ws + OFF_EXU;
  const float* h = (const float*)(p.ws + OFF_H);
  const int* eidx = (const int*)(p.ws + OFF_EIDX);
  const float* coefw = (const float*)(p.ws + OFF_COEF);
  const int lane = threadIdx.x & 63;
  const int gw = (blockIdx.x * blockDim.x + threadIdx.x) >> 6;
  const int nw = (gridDim.x * blockDim.x) >> 6;
  for (int tok = gw; tok < T_; tok += nw) {
    float yacc[16];
#pragma unroll
    for (int i = 0; i < 16; ++i) yacc[i] = 0.f;
    const int e_lo = eidx[(size_t)tok * 128 + lane];
    const int e_hi = eidx[(size_t)tok * 128 + 64 + lane];
    const float c_lo = coefw[(size_t)tok * 128 + lane];
    const float c_hi = coefw[(size_t)tok * 128 + 64 + lane];
#pragma unroll 1
    for (int eb = 0; eb < 8; ++eb) {
      const int ev = (eb < 4) ? e_lo : e_hi;
      const float cv = (eb < 4) ? c_lo : c_hi;
      const int lbase = (eb & 3) * 16;
      u32x4 ur[16];
#pragma unroll
      for (int k = 0; k < 16; ++k) {
        const int er = __builtin_amdgcn_readlane(ev, lbase + k);
        ur[k] = *reinterpret_cast<const u32x4*>(exu + (size_t)er * 1024 + lane * 16);
      }
#pragma unroll
      for (int k = 0; k < 16; ++k) {
        const float ck = __int_as_float(__builtin_amdgcn_readlane(__float_as_int(cv), lbase + k));
#pragma unroll
        for (int w = 0; w < 4; ++w) {
          f2_t lo = __builtin_amdgcn_cvt_pk_f32_fp8((int)ur[k][w], false);
          f2_t hi = __builtin_amdgcn_cvt_pk_f32_fp8((int)ur[k][w], true);
          yacc[4 * w] = fmaf(ck, lo[0], yacc[4 * w]);
          yacc[4 * w + 1] = fmaf(ck, lo[1], yacc[4 * w + 1]);
          yacc[4 * w + 2] = fmaf(ck, hi[0], yacc[4 * w + 2]);
          yacc[4 * w + 3] = fmaf(ck, hi[1], yacc[4 * w + 3]);
        }
      }
    }
    const float* xr = h + (size_t)tok * 1024 + lane * 16;
    float v[16];
#pragma unroll
    for (int c = 0; c < 4; ++c) {
      f32x4 t = *reinterpret_cast<const f32x4*>(xr + c * 4);
#pragma unroll
      for (int k = 0; k < 4; ++k) v[4 * c + k] = ALPHA * t[k] + yacc[4 * c + k];
    }
    float s = 0.f;
#pragma unroll
    for (int i = 0; i < 16; ++i) s += v[i];
    const float mean = wave_sum(s) * (1.f / 1024.f);
    float q = 0.f;
#pragma unroll
    for (int i = 0; i < 16; ++i) { float d = v[i] - mean; q += d * d; }
    const float rstd = rsqrtf(wave_sum(q) * (1.f / 1024.f) + 1e-5f);
    float* orow = p.out + (size_t)tok * 1024 + lane * 16;
#pragma unroll
    for (int c = 0; c < 4; ++c) {
      f32x4 gg = *reinterpret_cast<const f32x4*>(p.ln_ffn_g + lane * 16 + c * 4);
      f32x4 bb = *reinterpret_cast<const f32x4*>(p.ln_ffn_b + lane * 16 + c * 4);
      f32x4 o;
#pragma unroll
      for (int k = 0; k < 4; ++k) o[k] = (v[4 * c + k] - mean) * rstd * gg[k] + bb[k];
      *reinterpret_cast<f32x4*>(orow + c * 4) = o;
    }
  }
}

constexpr size_t OFF_BAR = 166 * MiB;
DI void gbar(unsigned* ctr, unsigned target) {
  asm volatile("s_waitcnt vmcnt(0)" ::: "memory");
  __syncthreads();
  if (threadIdx.x == 0) {
    __builtin_amdgcn_fence(__ATOMIC_RELEASE, "agent");
    asm volatile("s_waitcnt vmcnt(0)" ::: "memory");
    __hip_atomic_fetch_add(ctr, 1u, __ATOMIC_RELAXED, __HIP_MEMORY_SCOPE_AGENT);
    while (__hip_atomic_load(ctr, __ATOMIC_RELAXED, __HIP_MEMORY_SCOPE_AGENT) < target) __builtin_amdgcn_s_sleep(2);
    __builtin_amdgcn_fence(__ATOMIC_ACQUIRE, "agent");
    asm volatile("s_waitcnt vmcnt(0)" ::: "memory");
  }
  __syncthreads();
}

__global__ void __launch_bounds__(512) fwd_megakernel(Params p) {
  __shared__ __attribute__((aligned(1024))) char smem[155648];
  cg::grid_group grid = cg::this_grid();
  const int G = gridDim.x;
  char* ws = p.ws;
  unsigned* bar = (unsigned*)(ws + OFF_BAR);

  phase_prep(p, smem);
  grid.sync();

  phase_inproj(p, smem);
  gbar(bar, (unsigned)(1 * G));

  for (int k = 0; k * G < 1024; ++k) {
    int j = (k & 1) ? (G - 1 - (int)blockIdx.x) : (int)blockIdx.x;
    int idx = k * G + j;
    if (idx < 1024) dsa_thr_item(p, idx & 7, 127 - (idx >> 3), smem);
  }
  for (int it = blockIdx.x; it < 2048; it += G) gla_g1_item(p, it, smem);
  gbar(bar, (unsigned)(2 * G));

  for (int k = 0; k * G < 1024; ++k) {
    int j = (k & 1) ? (G - 1 - (int)blockIdx.x) : (int)blockIdx.x;
    int idx = k * G + j;
    if (idx < 1024) dsa_attn_item(p, idx & 7, 127 - (idx >> 3), smem);
  }
  gla_scan(p);
  gbar(bar, (unsigned)(3 * G));

  for (int it = blockIdx.x; it < 2048; it += G) gla_g3_item(p, it, smem);
  gbar(bar, (unsigned)(4 * G));

  phase_gemm<0>(p, (const u16*)(ws + OFF_XB), (const u16*)(ws + OFF_WOUT), 1024, p.x, (float*)(ws + OFF_H), nullptr, 0, smem);
  gbar(bar, (unsigned)(5 * G));
  phase_ln(p, (float*)(ws + OFF_H), (u16*)(ws + OFF_HB), p.ln_mix_g, p.ln_mix_b);
  gbar(bar, (unsigned)(6 * G));

  phase_gemm<2>(p, (const u16*)(ws + OFF_HB), (const u16*)(ws + OFF_WQ), 1024, nullptr, nullptr, (u16*)(ws + OFF_QX), 1024, smem);
  gbar(bar, (unsigned)(7 * G));
  phase_xattn(p);
  gbar(bar, (unsigned)(8 * G));
  phase_gemm<0>(p, (const u16*)(ws + OFF_OX), (const u16*)(ws + OFF_WO), 1024, (const float*)(ws + OFF_H), (float*)(ws + OFF_H), nullptr, 0, smem);
  gbar(bar, (unsigned)(9 * G));
  phase_ln(p, (float*)(ws + OFF_H), (u16*)(ws + OFF_HB), p.ln_mem_g, p.ln_mem_b);
  gbar(bar, (unsigned)(10 * G));

  phase_gemm<5>(p, (const u16*)(ws + OFF_HB), (const u16*)(ws + OFF_WPQ), 2048, nullptr, nullptr, (u16*)(ws + OFF_QX), 2048, smem);
  gbar(bar, (unsigned)(11 * G));
  for (int it = blockIdx.x; it < 2048; it += G) peer_topk_item(p, it >> 3, it & 7, smem);
  gbar(bar, (unsigned)(12 * G));
  phase_peer_down(p);
  gbar(bar, (unsigned)(13 * G));
  phase_peer_ffn(p);
}

extern "C" void kernel_launch(void* const* d_in, const int* in_sizes, int n_in,
                              void* d_out, int out_size, void* d_ws, size_t ws_size,
                              hipStream_t stream) {
  static int grid_blocks = 0;
  if (!grid_blocks) {
    int dev = 0, cus = 0, per_cu = 0;
    (void)hipGetDevice(&dev);
    (void)hipDeviceGetAttribute(&cus, hipDeviceAttributeMultiprocessorCount, dev);
    (void)hipOccupancyMaxActiveBlocksPerMultiprocessor(&per_cu, fwd_megakernel, 512, 0);
    if (per_cu > 1) per_cu = 1;
    grid_blocks = cus * per_cu;
    if (grid_blocks > 256) grid_blocks = 256;
    if (ws_size < 512 * MiB) fprintf(stderr, "workspace too small: %zu\n", ws_size);
  }
  Params p{};
  p.x = (const float*)d_in[0]; p.positions = (const int*)d_in[1]; p.mem = (const float*)d_in[2]; p.w_in = (const float*)d_in[3];
  p.gate_up = (const float*)d_in[4]; p.gate_bias = (const float*)d_in[5]; p.norm_g = (const float*)d_in[6]; p.w_out = (const float*)d_in[7];
  p.ln_mix_g = (const float*)d_in[8]; p.ln_mix_b = (const float*)d_in[9];
  p.wq = (const float*)d_in[10]; p.wk = (const float*)d_in[11]; p.wv = (const float*)d_in[12]; p.wo = (const float*)d_in[13];
  p.ln_mem_g = (const float*)d_in[14]; p.ln_mem_b = (const float*)d_in[15];
  p.w_pq = (const float*)d_in[16]; p.sk1 = (const float*)d_in[17]; p.sk2 = (const float*)d_in[18];
  p.ex_down = (const float*)d_in[19]; p.ex_up = (const float*)d_in[20];
  p.ln_ffn_g = (const float*)d_in[21]; p.ln_ffn_b = (const float*)d_in[22];
  p.out = (float*)d_out; p.ws = (char*)d_ws;
  (void)hipMemsetAsync((char*)d_ws + OFF_BAR, 0, 256, stream);
  void* args[] = {&p};
  hipError_t e = hipLaunchCooperativeKernel((void*)fwd_megakernel, dim3(grid_blocks), dim3(512), args, 0, stream);
  if (e != hipSuccess) fprintf(stderr, "cooperative launch failed: %s (grid %d)\n", hipGetErrorString(e), grid_blocks);
}
```

```cpp
#include <hip/hip_runtime.h>
#include <hip/hip_cooperative_groups.h>
#include <cstdio>
#include <cmath>
namespace cg = cooperative_groups;

#define DI __device__ __forceinline__
typedef short bf16x8 __attribute__((ext_vector_type(8)));
typedef short bf16x4 __attribute__((ext_vector_type(4)));
typedef float f32x16 __attribute__((ext_vector_type(16)));
typedef float f32x4 __attribute__((ext_vector_type(4)));
typedef unsigned u32x4 __attribute__((ext_vector_type(4)));
typedef unsigned u32x2 __attribute__((ext_vector_type(2)));
typedef unsigned short u16;
typedef __bf16 bf2_t __attribute__((ext_vector_type(2)));
typedef float f2_t __attribute__((ext_vector_type(2)));

#define MFMA(a, b, c) __builtin_amdgcn_mfma_f32_32x32x16_bf16((a), (b), (c), 0, 0, 0)

constexpr int T_ = 32768;
constexpr int S_ = 4096;
constexpr int TMW = 2368;
constexpr int TM_Q = 0, TM_K = 512, TM_QI = 1024, TM_KI = 1280, TM_WI = 1312, TM_GLR = 1320, TM_GQ = 1344, TM_GK = 1600, TM_GR = 1856;
constexpr int PROJ_N = 3456;
constexpr float ALPHA = 1.189207115002721f;
constexpr size_t MiB = 1024 * 1024;

constexpr size_t OFF_XB = 0;
constexpr size_t OFF_EXD = 64 * MiB;
constexpr size_t OFF_EXU = 80 * MiB;
constexpr size_t OFF_BCG = 96 * MiB;
constexpr size_t OFF_WIN = 128 * MiB;
constexpr size_t OFF_WOUT = OFF_WIN + (size_t)PROJ_N * 1024 * 2;
constexpr size_t OFF_WQ = OFF_WOUT + 2 * MiB;
constexpr size_t OFF_WK = OFF_WQ + 2 * MiB;
constexpr size_t OFF_WV = OFF_WK + 2 * MiB;
constexpr size_t OFF_WO = OFF_WV + 2 * MiB;
constexpr size_t OFF_WPQ = OFF_WO + 2 * MiB;
constexpr size_t OFF_KIF = 149 * MiB;
constexpr size_t OFF_MEMB = 152 * MiB;
constexpr size_t OFF_MEMK = 156 * MiB;
constexpr size_t OFF_MEMVT = 160 * MiB;
constexpr size_t OFF_THR = 164 * MiB;
constexpr size_t OFF_SK = OFF_THR + 256 * 1024;
constexpr size_t OFF_DECAY = OFF_SK + 128 * 1024;
constexpr size_t OFF_ESC = 165 * MiB;
constexpr size_t OFF_TM = 168 * MiB;
constexpr size_t OFF_VT = 316 * MiB;
constexpr size_t OFF_KFR = 476 * MiB;
constexpr size_t OFF_GVT = 348 * MiB;
constexpr size_t OFF_KVT = 380 * MiB;
constexpr size_t OFF_PREV = 444 * MiB;
constexpr size_t OFF_H = 168 * MiB;
constexpr size_t OFF_HB = 296 * MiB;
constexpr size_t OFF_QX = 360 * MiB;
constexpr size_t OFF_OX = 424 * MiB;
constexpr size_t OFF_EIDX = 0;
constexpr size_t OFF_GATE = 16 * MiB;
constexpr size_t OFF_COEF = 32 * MiB;

struct Params {
  const float* x; const int* positions; const float* mem; const float* w_in;
  const float* gate_up; const float* gate_bias; const float* norm_g; const float* w_out;
  const float* ln_mix_g; const float* ln_mix_b;
  const float* wq; const float* wk; const float* wv; const float* wo;
  const float* ln_mem_g; const float* ln_mem_b;
  const float* w_pq; const float* sk1; const float* sk2; const float* ex_down; const float* ex_up;
  const float* ln_ffn_g; const float* ln_ffn_b;
  float* out; char* ws;
};

DI unsigned pk_bf16(float a, float b) {
  f2_t v = {a, b};
  bf2_t r = __builtin_convertvector(v, bf2_t);
  return __builtin_bit_cast(unsigned, r);
}
DI u16 f2bf(float a) { return (u16)(pk_bf16(a, 0.f) & 0xffffu); }
DI float bf2f(u16 u) { return __uint_as_float(((unsigned)u) << 16); }
DI float bflo(unsigned u) { return __uint_as_float(u << 16); }
DI float bfhi(unsigned u) { return __uint_as_float(u & 0xffff0000u); }
DI int crow(int i, int h) { return (i & 3) + 8 * (i >> 2) + 4 * h; }
DI bf16x8 ldg8(const u16* p) { return *reinterpret_cast<const bf16x8*>(p); }
DI bf16x8 pack8(float a0, float a1, float a2, float a3, float a4, float a5, float a6, float a7) {
  u32x4 r; r[0] = pk_bf16(a0, a1); r[1] = pk_bf16(a2, a3); r[2] = pk_bf16(a4, a5); r[3] = pk_bf16(a6, a7);
  return __builtin_bit_cast(bf16x8, r);
}
DI bf16x8 cat44(bf16x4 lo, bf16x4 hi) { return __builtin_shufflevector(lo, hi, 0, 1, 2, 3, 4, 5, 6, 7); }
DI void st4bf(u16* p, float a, float b, float c, float d) {
  u32x2 v; v[0] = pk_bf16(a, b); v[1] = pk_bf16(c, d);
  *reinterpret_cast<u32x2*>(p) = v;
}
DI float wave_sum(float v) {
#pragma unroll
  for (int d = 32; d >= 1; d >>= 1) v += __shfl_xor(v, d);
  return v;
}
DI void sincos_rad(float ang, float& s, float& c) {
  constexpr float C_hi = (float)0.15915494309189535;
  constexpr float C_lo = (float)(0.15915494309189535 - (double)C_hi);
  float k = rintf(ang * C_hi);
  float f = fmaf(ang, C_hi, -k);
  f = fmaf(ang, C_lo, f);
  s = __builtin_amdgcn_sinf(f);
  c = __builtin_amdgcn_cosf(f);
}
DI unsigned fkey(float s) {
  const unsigned u = __float_as_uint(s);
  return u ^ ((unsigned)((int)u >> 31) | 0x80000000u);
}
DI f32x16 zero16() { f32x16 z; for (int i = 0; i < 16; ++i) z[i] = 0.f; return z; }

DI int win_src_col(int n) {
  if (n < 1832) return n;
  if (n < 1848) return 2856 + (n - 1832);
  if (n < 1856) return -1;
  if (n < 2880) return n - 24;
  if (n < 3392) return n - 8;
  return -1;
}

DI void cvt_stream(const float* __restrict__ src, u16* __restrict__ dst, size_t n, size_t gtid, size_t gn) {
  size_t n8 = n / 8;
  for (size_t i = gtid; i < n8; i += gn) {
    f32x4 a = *reinterpret_cast<const f32x4*>(src + i * 8);
    f32x4 b = *reinterpret_cast<const f32x4*>(src + i * 8 + 4);
    u32x4 r; r[0] = pk_bf16(a[0], a[1]); r[1] = pk_bf16(a[2], a[3]); r[2] = pk_bf16(b[0], b[1]); r[3] = pk_bf16(b[2], b[3]);
    *reinterpret_cast<u32x4*>(dst + i * 8) = r;
  }
}

template <bool MAPPED>
DI void transpose_tile(const float* __restrict__ W, int ldn, u16* __restrict__ Wt, int k0, int n0, float* tile) {
  const int tid = threadIdx.x;
  {
    int nn = n0 + (tid & 63);
    int c = MAPPED ? win_src_col(nn) : nn;
#pragma unroll
    for (int rr = 0; rr < 8; ++rr) {
      int kk = (tid >> 6) + 8 * rr;
      float v = (c >= 0) ? W[(size_t)(k0 + kk) * ldn + c] : 0.f;
      tile[kk * 65 + (tid & 63)] = v;
    }
  }
  __syncthreads();
#pragma unroll
  for (int rr = 0; rr < 8; ++rr) {
    int nn = (tid >> 6) + 8 * rr;
    int kk = tid & 63;
    Wt[(size_t)(n0 + nn) * 1024 + k0 + kk] = f2bf(tile[kk * 65 + nn]);
  }
  __syncthreads();
}

DI void phase_prep(const Params& p, char* smem) {
  const size_t gtid = (size_t)blockIdx.x * blockDim.x + threadIdx.x;
  const size_t gn = (size_t)gridDim.x * blockDim.x;
  char* ws = p.ws;
  cvt_stream(p.x, (u16*)(ws + OFF_XB), (size_t)T_ * 1024, gtid, gn);
  cvt_stream(p.mem, (u16*)(ws + OFF_MEMB), (size_t)2048 * 1024, gtid, gn);
  {
    const int lane = threadIdx.x & 63;
    const int gw = (int)(gtid >> 6), nw = (int)(gn >> 6);
    for (int r = gw; r < 2 * 16384; r += nw) {
      const int tbl = r >> 14, row = r & 16383;
      const float* src = (tbl ? p.ex_up : p.ex_down) + (size_t)row * 1024 + lane * 16;
      f32x4 v[4]; float mx = 0.f;
#pragma unroll
      for (int c = 0; c < 4; ++c) {
        v[c] = *reinterpret_cast<const f32x4*>(src + c * 4);
#pragma unroll
        for (int k = 0; k < 4; ++k) mx = fmaxf(mx, fabsf(v[c][k]));
      }
#pragma unroll
      for (int d = 32; d >= 1; d >>= 1) mx = fmaxf(mx, __shfl_xor(mx, d));
      float sc = (mx > 0.f) ? exp2f(floorf(log2f(224.f / mx))) : 1.f;
      u32x4 o;
#pragma unroll
      for (int c = 0; c < 4; ++c) {
        int t = __builtin_amdgcn_cvt_pk_fp8_f32(v[c][0] * sc, v[c][1] * sc, 0, false);
        t = __builtin_amdgcn_cvt_pk_fp8_f32(v[c][2] * sc, v[c][3] * sc, t, true);
        o[c] = (unsigned)t;
      }
      *reinterpret_cast<u32x4*>(ws + (tbl ? OFF_EXU : OFF_EXD) + (size_t)row * 1024 + lane * 16) = o;
      if (lane == 0) ((float*)(ws + OFF_ESC))[r] = 1.f / sc;
    }
  }
  cvt_stream(p.sk1, (u16*)(ws + OFF_SK), (size_t)128 * 128, gtid, gn);
  cvt_stream(p.sk2, (u16*)(ws + OFF_SK) + 128 * 128, (size_t)128 * 128, gtid, gn);
  float* tile = (float*)smem;
  const int n_win = 54 * 16, n_sq = 256, n_pq = 512;
  const int total = n_win + 5 * n_sq + n_pq;
  for (int t = blockIdx.x; t < total; t += gridDim.x) {
    if (t < n_win) {
      transpose_tile<true>(p.w_in, 3384, (u16*)(ws + OFF_WIN), (t & 15) * 64, (t >> 4) * 64, tile);
    } else if (t < n_win + 5 * n_sq) {
      int u = t - n_win; int which = u >> 8; int r = u & 255;
      const float* W = which == 0 ? p.w_out : which == 1 ? p.wq : which == 2 ? p.wk : which == 3 ? p.wv : p.wo;
      size_t off = which == 0 ? OFF_WOUT : which == 1 ? OFF_WQ : which == 2 ? OFF_WK : which == 3 ? OFF_WV : OFF_WO;
      transpose_tile<false>(W, 1024, (u16*)(ws + off), (r & 15) * 64, (r >> 4) * 64, tile);
    } else {
      int r = t - n_win - 5 * n_sq;
      transpose_tile<false>(p.w_pq, 2048, (u16*)(ws + OFF_WPQ), (r & 15) * 64, (r >> 4) * 64, tile);
    }
  }
}

#define WAIT_V(n) asm volatile("s_waitcnt vmcnt(%0)" ::"n"(n) : "memory")
#define RAW_BARRIER() do { asm volatile("s_waitcnt lgkmcnt(0)" ::: "memory"); __builtin_amdgcn_s_barrier(); asm volatile("" ::: "memory"); } while (0)
constexpr int G_STAGE = 384 * 128;
DI void gemm_tile(const u16* __restrict__ X, int ldx, const u16* __restrict__ Wt, int ldw, int K, char* smem,
                  f32x16 (&acc)[2][2]) {
  const int tid = threadIdx.x, lane = tid & 63, wave = tid >> 6;
  const int fw = wave & 1, tq = wave >> 1, lr = lane & 31, lh = lane >> 5;
#pragma unroll
  for (int a = 0; a < 2; ++a)
#pragma unroll
    for (int b = 0; b < 2; ++b) acc[a][b] = zero16();
  const int nk = K / 64;
  const u16* src[6];
#pragma unroll
  for (int i = 0; i < 6; ++i) {
    const int R = 8 * (wave + 8 * i) + (lane >> 3);
    const int c = (lane & 7) ^ ((R >> 1) & 7);
    src[i] = (i < 4) ? (X + (size_t)R * ldx + c * 8) : (Wt + (size_t)(R - 256) * ldw + c * 8);
  }
#define GLDS_STAGE(slot, kt) do { _Pragma("unroll") for (int i = 0; i < 6; ++i) \
    __builtin_amdgcn_global_load_lds((const unsigned*)(src[i] + (kt) * 64), (__attribute__((address_space(3))) unsigned*)(smem + (slot) * G_STAGE + (wave + 8 * i) * 1024), 16, 0, 0); } while (0)
  int offA[2], offB[2], xa[2], xb[2];
#pragma unroll
  for (int ft = 0; ft < 2; ++ft) { const int R = 256 + fw * 64 + ft * 32 + lr; offA[ft] = R * 128; xa[ft] = (R >> 1) & 7; }
#pragma unroll
  for (int tt = 0; tt < 2; ++tt) { const int R = tq * 64 + tt * 32 + lr; offB[tt] = R * 128; xb[tt] = (R >> 1) & 7; }
  GLDS_STAGE(0, 0); GLDS_STAGE(1, 1); WAIT_V(6); RAW_BARRIER();
  int cur = 0;
  for (int kt = 0; kt < nk; ++kt) {
    const int nxt = (cur >= 1) ? cur - 1 : 2;
    if (kt + 2 < nk) GLDS_STAGE(nxt, kt + 2);
    __builtin_amdgcn_sched_barrier(0);
    const char* st = smem + cur * G_STAGE;
#pragma unroll
    for (int ks = 0; ks < 4; ++ks) {
      bf16x8 a[2], b[2];
#pragma unroll
      for (int ft = 0; ft < 2; ++ft) a[ft] = *reinterpret_cast<const bf16x8*>(st + offA[ft] + (((ks * 2 + lh) ^ xa[ft]) << 4));
#pragma unroll
      for (int tt = 0; tt < 2; ++tt) b[tt] = *reinterpret_cast<const bf16x8*>(st + offB[tt] + (((ks * 2 + lh) ^ xb[tt]) << 4));
#pragma unroll
      for (int ft = 0; ft < 2; ++ft)
#pragma unroll
        for (int tt = 0; tt < 2; ++tt) acc[ft][tt] = MFMA(a[ft], b[tt], acc[ft][tt]);
    }
    if (kt + 2 < nk) { WAIT_V(6); } else { WAIT_V(0); }
    RAW_BARRIER();
    cur = (cur == 2) ? 0 : cur + 1;
  }
#undef GLDS_STAGE
}

DI void store_tm_rows(f32x16 (&acc)[2][2], char* smem, u16* tm, int tokbase, int col) {
  const int lane = threadIdx.x & 63, wave = threadIdx.x >> 6, lr = lane & 31, lh = lane >> 5;
  float* wl = (float*)(smem + wave * 17408);
#pragma unroll
  for (int tt = 0; tt < 2; ++tt)
#pragma unroll
    for (int ft = 0; ft < 2; ++ft)
#pragma unroll
      for (int g = 0; g < 4; ++g) {
        f32x4 v = {acc[ft][tt][4 * g], acc[ft][tt][4 * g + 1], acc[ft][tt][4 * g + 2], acc[ft][tt][4 * g + 3]};
        *reinterpret_cast<f32x4*>(wl + (tt * 32 + lr) * 68 + ft * 32 + 8 * g + 4 * lh) = v;
      }
  const int ch = lane & 15, r0 = lane >> 4;
#pragma unroll 4
  for (int k = 0; k < 16; ++k) {
    const int row = r0 + 4 * k;
    f32x4 v = *reinterpret_cast<const f32x4*>(wl + row * 68 + ch * 4);
    st4bf(tm + (size_t)(tokbase + row) * TMW + col + ch * 4, v[0], v[1], v[2], v[3]);
  }
}

DI void epi_inproj(const Params& p, int tok0, int f0, f32x16 (&acc)[2][2], char* smem) {
  const int tid = threadIdx.x, lane = tid & 63, wave = tid >> 6;
  const int fw = wave & 1, tq = wave >> 1, lr = lane & 31, lh = lane >> 5;
  const int fbase = f0 + fw * 64;
  if (fbase >= 3392) return;
  u16* tm = (u16*)(p.ws + OFF_TM);
  int tmcol = -1;
#pragma unroll
  for (int tt = 0; tt < 2; ++tt) {
    const int tok = tok0 + tq * 64 + tt * 32 + lr;
    const float posf = (float)p.positions[tok];
    const int bb = tok >> 12, ss = tok & 4095;
    if (fbase < 1024) {
#pragma unroll
      for (int r = 0; r < 4; ++r) {
        float j = (float)(4 * lh + r);
        float inv = exp2f(-j * (18.931568569324174f / 8.0f));
        float sn, cs; sincos_rad(posf * inv, sn, cs);
        float x1 = acc[0][tt][r], x2 = acc[0][tt][r + 4];
        acc[0][tt][r] = x1 * cs - x2 * sn;
        acc[0][tt][r + 4] = x2 * cs + x1 * sn;
      }
      if (fbase < 512) {
        tmcol = fbase;
      } else {
        u16* kfr = (u16*)(p.ws + OFF_KFR);
        const int head = (fbase - 512) >> 6, gt = ss >> 5;
#pragma unroll
        for (int ft = 0; ft < 2; ++ft)
#pragma unroll
          for (int g = 0; g < 4; ++g) {
            const int ks = ft * 2 + (g >> 1), lane2 = (g & 1) * 32 + lr;
            st4bf(kfr + ((((size_t)(bb * 8 + head) * 128 + gt) * 4 + ks) * 64 + lane2) * 8 + 4 * lh, acc[ft][tt][4 * g], acc[ft][tt][4 * g + 1], acc[ft][tt][4 * g + 2], acc[ft][tt][4 * g + 3]);
          }
      }
    } else if (fbase < 1536) {
      u16* vfr = (u16*)(p.ws + OFF_VT);
      const int head = (fbase - 1024) >> 6, gt = ss >> 5;
      const int s = lr >> 4, r16 = lr & 15, j = 4 * (r16 >> 3) + (r16 & 3), lh2 = (r16 >> 2) & 1;
#pragma unroll
      for (int ft = 0; ft < 2; ++ft)
#pragma unroll
        for (int i = 0; i < 16; ++i) {
          const int lane2 = lh2 * 32 + crow(i, lh);
          vfr[((((((size_t)(bb * 8 + head) * 128 + gt) * 2 + ft) * 2 + s) * 64 + lane2) * 8) + j] = f2bf(acc[ft][tt][i]);
        }
    } else if (fbase >= 2368 && fbase < 2880) {
      u16* vt = (u16*)(p.ws + OFF_GVT);
      const int fo = fbase - 2368;
#pragma unroll
      for (int ft = 0; ft < 2; ++ft)
#pragma unroll
        for (int i = 0; i < 16; ++i) {
          int feat = fo + ft * 32 + crow(i, lh);
          vt[((size_t)bb * 512 + feat) * 4096 + ss] = f2bf(acc[ft][tt][i]);
        }
    } else {
      if (fbase < 1856) {
#pragma unroll
        for (int ft = 0; ft < 2; ++ft) {
          const bool rot = (fbase < 1792) || (ft == 0);
#pragma unroll
          for (int r = 0; r < 4; ++r) {
            float v = acc[ft][tt][r];
            float o = __shfl_xor(v, 32);
            float inv = exp2f(-(float)r * (18.931568569324174f / 4.0f));
            float sn, cs; sincos_rad(posf * inv, sn, cs);
            float res = (lh == 0) ? (v * cs - o * sn) : (v * cs + o * sn);
            acc[ft][tt][r] = rot ? res : v;
          }
        }
        tmcol = fbase - 512;
        if (fbase == 1792) {
          u16* kif = (u16*)(p.ws + OFF_KIF);
          const int gt = ss >> 5;
#pragma unroll
          for (int g = 0; g < 4; ++g) {
            const int ks = g >> 1, lane2 = (g & 1) * 32 + lr;
            st4bf(kif + ((((size_t)bb * 128 + gt) * 2 + ks) * 64 + lane2) * 8 + 4 * lh, acc[0][tt][4 * g], acc[0][tt][4 * g + 1], acc[0][tt][4 * g + 2], acc[0][tt][4 * g + 3]);
          }
        }
      } else if (fbase < 2368) {
        tmcol = fbase - 512;
      } else {
        tmcol = fbase - 1024;
      }
    }
  }
  if (tmcol >= 0) store_tm_rows(acc, smem, tm, tok0 + tq * 64, tmcol);
}

DI void phase_inproj(const Params& p, char* smem) {
  const int n_in = 128 * 27;
  const int total = n_in + 128;
  const u16* xb = (const u16*)(p.ws + OFF_XB);
  const u16* memb = (const u16*)(p.ws + OFF_MEMB);
  const int tid = threadIdx.x, lane = tid & 63, wave = tid >> 6;
  const int fw = wave & 1, tq = wave >> 1, lr = lane & 31, lh = lane >> 5;
  for (int t = blockIdx.x; t < total; t += gridDim.x) {
    f32x16 acc[2][2];
    if (t < n_in) {
      int mt = t / 27, nt = t % 27;
      gemm_tile(xb + (size_t)mt * 256 * 1024, 1024, (const u16*)(p.ws + OFF_WIN) + (size_t)nt * 128 * 1024, 1024, 1024, smem, acc);
      epi_inproj(p, mt * 256, nt * 128, acc, smem);
      __syncthreads();
    } else {
      int u = t - n_in; int which = u >> 6; int r = u & 63; int mt = r >> 3, nt = r & 7;
      const u16* W = (const u16*)(p.ws + (which == 0 ? OFF_WK : OFF_WV));
      gemm_tile(memb + (size_t)mt * 256 * 1024, 1024, W + (size_t)nt * 128 * 1024, 1024, 1024, smem, acc);
#pragma unroll
      for (int tt = 0; tt < 2; ++tt) {
        const int tok = mt * 256 + tq * 64 + tt * 32 + lr;
        const int bb = tok >> 8, mm = tok & 255, hh = nt >> 1, kt = mm >> 5;
        if (which == 0) {
          u16* mk = (u16*)(p.ws + OFF_MEMK);
#pragma unroll
          for (int ft = 0; ft < 2; ++ft)
#pragma unroll
            for (int g = 0; g < 4; ++g) {
              const int ks = (nt & 1) * 8 + fw * 4 + ft * 2 + (g >> 1), lane2 = (g & 1) * 32 + lr;
              st4bf(mk + ((((size_t)(bb * 4 + hh) * 8 + kt) * 16 + ks) * 64 + lane2) * 8 + 4 * lh, acc[ft][tt][4 * g], acc[ft][tt][4 * g + 1], acc[ft][tt][4 * g + 2], acc[ft][tt][4 * g + 3]);
            }
        } else {
          u16* mv = (u16*)(p.ws + OFF_MEMVT);
          const int s = lr >> 4, r16 = lr & 15, j = 4 * (r16 >> 3) + (r16 & 3), lh2 = (r16 >> 2) & 1;
#pragma unroll
          for (int ft = 0; ft < 2; ++ft) {
            const int dt = (nt & 1) * 4 + fw * 2 + ft;
#pragma unroll
            for (int i = 0; i < 16; ++i) {
              const int lane2 = lh2 * 32 + crow(i, lh);
              mv[((((((size_t)(bb * 4 + hh) * 8 + dt) * 8 + kt) * 2 + s) * 64 + lane2) * 8) + j] = f2bf(acc[ft][tt][i]);
            }
          }
        }
      }
    }
  }
}

DI void idx_scores(const bf16x8 (&qf)[8][2], const float (&wq)[8], bf16x8 k0, bf16x8 k1, float (&sc)[16]) {
#pragma unroll
  for (int i = 0; i < 16; ++i) sc[i] = 0.f;
#pragma unroll
  for (int hd = 0; hd < 8; ++hd) {
    f32x16 a = zero16();
    a = MFMA(k0, qf[hd][0], a);
    a = MFMA(k1, qf[hd][1], a);
#pragma unroll
    for (int i = 0; i < 16; ++i) sc[i] = fmaf(wq[hd], fmaxf(a[i], 0.f), sc[i]);
  }
}

DI void load_idx_q(const u16* tm, int tok, int lh, bf16x8 (&qf)[8][2], float (&wq)[8]) {
  const u16* row = tm + (size_t)tok * TMW;
#pragma unroll
  for (int hd = 0; hd < 8; ++hd)
#pragma unroll
    for (int ks = 0; ks < 2; ++ks) qf[hd][ks] = ldg8(row + TM_QI + hd * 32 + ks * 16 + lh * 8);
  bf16x8 w8 = ldg8(row + TM_WI);
#pragma unroll
  for (int hd = 0; hd < 8; ++hd) wq[hd] = bf2f((u16)w8[hd]) * 0.0625f;
}

DI int wave_incl_scan(int v, int lane) {
#pragma unroll
  for (int d = 1; d < 64; d <<= 1) {
    int t = __shfl_up(v, d);
    if (lane >= d) v += t;
  }
  return v;
}

DI void dsa_thr_item(const Params& p, int b, int qblk, char* smem) {
  unsigned* hist = (unsigned*)smem;
  unsigned* pref = (unsigned*)(smem + 32768);
  int* rank = (int*)(smem + 32768 + 128);
  const u16* tm = (const u16*)(p.ws + OFF_TM);
  const int tid = threadIdx.x, lane = tid & 63, wave = tid >> 6, lr = lane & 31, lh = lane >> 5;
  const int q0 = qblk * 32;
  u16* qi = (u16*)(smem + 33280);
  for (int i = tid; i < 32 * 32; i += 512) {
    int q = i >> 5, ch = i & 31;
    *reinterpret_cast<u32x4*>(qi + q * 296 + ch * 8) = *reinterpret_cast<const u32x4*>(tm + (size_t)(b * S_ + q0 + q) * TMW + TM_QI + ch * 8);
  }
  float wq[8];
  {
    bf16x8 w8 = ldg8(tm + (size_t)(b * S_ + q0 + lr) * TMW + TM_WI);
#pragma unroll
    for (int hd = 0; hd < 8; ++hd) wq[hd] = bf2f((u16)w8[hd]) * 0.0625f;
  }
  __syncthreads();
  for (int i = tid; i < 32 * 32; i += 512) {
    const int q = i >> 5, d = i & 31;
    float acc = 0.f;
#pragma unroll
    for (int hd = 0; hd < 8; ++hd) acc = fmaf(bf2f(tm[(size_t)(b * S_ + q0 + q) * TMW + TM_WI + hd]) * 0.0625f, bf2f(qi[q * 296 + hd * 32 + d]), acc);
    qi[q * 296 + 256 + d] = f2bf(acc);
  }
  const u16* qil = qi + lr * 296 + lh * 8;
  if (tid < 32) { pref[tid] = 0u; rank[tid] = min(256, q0 + tid + 1); }
  for (int pass = 0; pass < 4; ++pass) {
    for (int i = tid; i < 8192; i += 512) hist[i] = 0u;
    __syncthreads();
    const int shift = 24 - 8 * pass;
    const unsigned mypref = pref[lr];
    const u16* kib = (const u16*)(p.ws + OFF_KIF) + (size_t)b * 128 * 1024 + lane * 8;
    bf16x8 kn0, kn1;
    {
      const int kt0 = min(wave, qblk);
      kn0 = ldg8(kib + (size_t)kt0 * 1024); kn1 = ldg8(kib + (size_t)kt0 * 1024 + 512);
    }
    for (int kt = wave; kt <= qblk; kt += 8) {
      const bf16x8 k0 = kn0, k1 = kn1;
      {
        const int ktn = min(kt + 8, qblk);
        kn0 = ldg8(kib + (size_t)ktn * 1024); kn1 = ldg8(kib + (size_t)ktn * 1024 + 512);
      }
      float sc[16];
      {
        f32x16 a = zero16();
        a = MFMA(k0, *reinterpret_cast<const bf16x8*>(qil + 256), a);
        a = MFMA(k1, *reinterpret_cast<const bf16x8*>(qil + 256 + 16), a);
#pragma unroll
        for (int i = 0; i < 16; ++i) sc[i] = a[i];
      }
#pragma unroll
      for (int hd = 0; hd < 8; ++hd) {
        f32x16 a = zero16();
        a = MFMA(k0, *reinterpret_cast<const bf16x8*>(qil + hd * 32), a);
        a = MFMA(k1, *reinterpret_cast<const bf16x8*>(qil + hd * 32 + 16), a);
        const float wh = wq[hd];
#pragma unroll
        for (int i = 0; i < 16; ++i) sc[i] = fmaf(fabsf(a[i]), wh, sc[i]);
      }
      if (kt == qblk) {
#pragma unroll
        for (int i = 0; i < 16; ++i) {
          int kp = kt * 32 + crow(i, lh);
          unsigned ky = fkey(sc[i]);
          unsigned hi = (ky >> shift);
          if (kp <= q0 + lr && (hi >> 8) == mypref) atomicAdd(&hist[(hi & 255u) * 32 + lr], 1u);
        }
      } else {
#pragma unroll
        for (int i = 0; i < 16; ++i) {
          unsigned ky = fkey(sc[i]);
          unsigned hi = (ky >> shift);
          if ((hi >> 8) == mypref) atomicAdd(&hist[(hi & 255u) * 32 + lr], 1u);
        }
      }
    }
    __syncthreads();
#pragma unroll 1
    for (int qq = 0; qq < 4; ++qq) {
      const int q = wave * 4 + qq;
      const int rk = rank[q];
      int c[4];
#pragma unroll
      for (int j = 0; j < 4; ++j) c[j] = (int)hist[(255 - 4 * lane - j) * 32 + q];
      int s = c[0] + c[1] + c[2] + c[3];
      int P = wave_incl_scan(s, lane);
      int excl = P - s;
      if (P >= rk && excl < rk) {
        int cum = excl; int bin = 0; int nr = 1; bool found = false;
#pragma unroll
        for (int j = 0; j < 4; ++j) {
          if (!found && cum + c[j] >= rk) { bin = 255 - 4 * lane - j; nr = rk - cum; found = true; }
          if (!found) cum += c[j];
        }
        pref[q] = (pref[q] << 8) | (unsigned)bin;
        rank[q] = nr;
      }
    }
    __syncthreads();
  }
  if (tid < 32) ((unsigned*)(p.ws + OFF_THR))[b * S_ + q0 + tid] = pref[tid];
  __syncthreads();
}

DI void dsa_attn_item(const Params& p, int b, int qblk, char* smem) {
  u16* maskbuf = (u16*)smem;
  u16* qi = (u16*)(smem + 4096);
  const u16* tm = (const u16*)(p.ws + OFF_TM);
  const u16* vfr = (const u16*)(p.ws + OFF_VT) + ((size_t)(b * 8 + (threadIdx.x >> 6)) * 128) * 2048 + (threadIdx.x & 63) * 8;
  const u16* kfr = (const u16*)(p.ws + OFF_KFR) + ((size_t)(b * 8 + (threadIdx.x >> 6)) * 128) * 2048 + (threadIdx.x & 63) * 8;
  const unsigned* thr = (const unsigned*)(p.ws + OFF_THR);
  const int tid = threadIdx.x, lane = tid & 63, wave = tid >> 6, lr = lane & 31, lh = lane >> 5;
  const int q0 = qblk * 32;
  const int head = wave;
  const int qtok = b * S_ + q0 + lr;
  bf16x8 Qf[4];
#pragma unroll
  for (int ks = 0; ks < 4; ++ks) {
    bf16x8 raw = ldg8(tm + (size_t)qtok * TMW + TM_Q + head * 64 + ks * 16 + lh * 8);
    float f[8];
#pragma unroll
    for (int j = 0; j < 8; ++j) f[j] = bf2f((u16)raw[j]) * (0.125f * 1.4426950408889634f);
    Qf[ks] = pack8(f[0], f[1], f[2], f[3], f[4], f[5], f[6], f[7]);
  }
  f32x16 O[2];
  O[0] = zero16(); O[1] = zero16();
  float mrun = -INFINITY, lrun = 0.f;
  const unsigned thrq = thr[qtok];
  const int nchunks = (q0 + 31) / 256 + 1;
  for (int i = tid; i < 32 * 32; i += 512) {
    int q = i >> 5, ch = i & 31;
    *reinterpret_cast<u32x4*>(qi + q * 296 + ch * 8) = *reinterpret_cast<const u32x4*>(tm + (size_t)(b * S_ + q0 + q) * TMW + TM_QI + ch * 8);
  }
  float* wqs = (float*)(smem + 4096 + 32 * 296 * 2);
  if (tid < 256) wqs[tid] = bf2f(tm[(size_t)(b * S_ + q0 + (tid & 31)) * TMW + TM_WI + (tid >> 5)]) * 0.0625f;
  __syncthreads();
  for (int i = tid; i < 32 * 32; i += 512) {
    const int q = i >> 5, d = i & 31;
    float acc = 0.f;
#pragma unroll
    for (int hd = 0; hd < 8; ++hd) acc = fmaf(bf2f(tm[(size_t)(b * S_ + q0 + q) * TMW + TM_WI + hd]) * 0.0625f, bf2f(qi[q * 296 + hd * 32 + d]), acc);
    qi[q * 296 + 256 + d] = f2bf(acc);
  }
  __syncthreads();
  const u16* qil = qi + lr * 296 + lh * 8;
  const u16* kibase = (const u16*)(p.ws + OFF_KIF) + (size_t)b * 128 * 1024 + lane * 8;
  bf16x8 Kf[4], Kn[4];
#pragma unroll
  for (int ks = 0; ks < 4; ++ks) Kf[ks] = ldg8(kfr + ks * 512);
  bf16x8 Vf[2][2], Vn[2][2];
#pragma unroll
  for (int dt = 0; dt < 2; ++dt)
#pragma unroll
    for (int s = 0; s < 2; ++s) Vf[dt][s] = ldg8(vfr + (dt * 2 + s) * 512);
  bf16x8 ki0, ki1;
  {
    const int kt0 = min(wave, qblk);
    ki0 = ldg8(kibase + (size_t)kt0 * 1024); ki1 = ldg8(kibase + (size_t)kt0 * 1024 + 512);
  }
  for (int c = 0; c < nchunks; ++c) {
    const int buf = c & 1;
    {
      const int key0 = (c * 8 + wave) * 32;
      unsigned bits = 0u;
      const bf16x8 k0 = ki0, k1 = ki1;
      {
        const int ktn = min((c + 1) * 8 + wave, qblk);
        ki0 = ldg8(kibase + (size_t)ktn * 1024); ki1 = ldg8(kibase + (size_t)ktn * 1024 + 512);
      }
      if (key0 <= q0 + 31) {
        float sc[16];
        {
          f32x16 a = zero16();
          a = MFMA(k0, *reinterpret_cast<const bf16x8*>(qil + 256), a);
          a = MFMA(k1, *reinterpret_cast<const bf16x8*>(qil + 256 + 16), a);
#pragma unroll
          for (int i = 0; i < 16; ++i) sc[i] = a[i];
        }
#pragma unroll 2
        for (int hd = 0; hd < 8; ++hd) {
          f32x16 a = zero16();
          a = MFMA(k0, *reinterpret_cast<const bf16x8*>(qil + hd * 32), a);
          a = MFMA(k1, *reinterpret_cast<const bf16x8*>(qil + hd * 32 + 16), a);
          const float wh = wqs[hd * 32 + lr];
#pragma unroll
          for (int i = 0; i < 16; ++i) sc[i] = fmaf(fabsf(a[i]), wh, sc[i]);
        }
        __builtin_amdgcn_sched_barrier(0);
#pragma unroll
        for (int i = 0; i < 16; ++i) {
          int kp = key0 + crow(i, lh);
          if (kp <= q0 + lr && fkey(sc[i]) >= thrq) bits |= (1u << i);
        }
      }
      maskbuf[(buf * 8 + wave) * 64 + lane] = (u16)bits;
    }
    __syncthreads();
#pragma unroll 1
    for (int t8 = 0; t8 < 8; ++t8) {
      const int g = c * 8 + t8;
      if (g > qblk) break;
      {
        const int gn = min(g + 1, qblk);
        const u16* kr = kfr + (size_t)gn * 2048;
#pragma unroll
        for (int ks = 0; ks < 4; ++ks) Kn[ks] = ldg8(kr + ks * 512);
#pragma unroll
        for (int dt = 0; dt < 2; ++dt)
#pragma unroll
          for (int s = 0; s < 2; ++s) Vn[dt][s] = ldg8(vfr + (size_t)gn * 2048 + (dt * 2 + s) * 512);
      }

      const unsigned bits = maskbuf[(buf * 8 + t8) * 64 + lane];
      f32x16 Sx = zero16();
#pragma unroll
      for (int ks = 0; ks < 4; ++ks) Sx = MFMA(Kf[ks], Qf[ks], Sx);
      float sm[16];
#pragma unroll
      for (int i = 0; i < 16; ++i) {
        const unsigned t = (unsigned)__builtin_amdgcn_sbfe((int)bits, i, 1);
        sm[i] = __uint_as_float((t & __float_as_uint(Sx[i])) | (~t & 0xff800000u));
      }
      float mt = fmaxf(fmaxf(fmaxf(sm[0], sm[1]), fmaxf(sm[2], sm[3])), fmaxf(fmaxf(sm[4], sm[5]), fmaxf(sm[6], sm[7])));
      mt = fmaxf(mt, fmaxf(fmaxf(fmaxf(sm[8], sm[9]), fmaxf(sm[10], sm[11])), fmaxf(fmaxf(sm[12], sm[13]), fmaxf(sm[14], sm[15]))));
      mt = fmaxf(mt, __shfl_xor(mt, 32));
      const float mnew = fmaxf(mrun, mt);
      const float msafe = (mnew == -INFINITY) ? 0.f : mnew;
      const float alpha = __builtin_amdgcn_exp2f(mrun - msafe);
      float pv[16]; float ps = 0.f;
#pragma unroll
      for (int i = 0; i < 16; ++i) { pv[i] = __builtin_amdgcn_exp2f(sm[i] - msafe); ps += pv[i]; }
      lrun = lrun * alpha + ps;
      mrun = mnew;
      if (__builtin_amdgcn_ballot_w64(alpha != 1.f) != 0ull) {
#pragma unroll
        for (int dt = 0; dt < 2; ++dt)
#pragma unroll
          for (int i = 0; i < 16; ++i) O[dt][i] *= alpha;
      }
      bf16x8 Pf[2];
#pragma unroll
      for (int s = 0; s < 2; ++s) Pf[s] = pack8(pv[8 * s], pv[8 * s + 1], pv[8 * s + 2], pv[8 * s + 3], pv[8 * s + 4], pv[8 * s + 5], pv[8 * s + 6], pv[8 * s + 7]);
#pragma unroll
      for (int dt = 0; dt < 2; ++dt)
#pragma unroll
        for (int s = 0; s < 2; ++s) O[dt] = MFMA(Vf[dt][s], Pf[s], O[dt]);
#pragma unroll
      for (int ks = 0; ks < 4; ++ks) Kf[ks] = Kn[ks];
#pragma unroll
      for (int dt = 0; dt < 2; ++dt)
#pragma unroll
        for (int s = 0; s < 2; ++s) Vf[dt][s] = Vn[dt][s];
    }
  }
  u16* y = (u16*)(p.ws + OFF_XB);
  {
    float lt = lrun + __shfl_xor(lrun, 32);
    float inv = 1.f / lt;
#pragma unroll
    for (int dt = 0; dt < 2; ++dt)
#pragma unroll
      for (int g = 0; g < 4; ++g)
        st4bf(y + (size_t)qtok * 1024 + head * 64 + dt * 32 + 8 * g + 4 * lh, O[dt][4 * g] * inv, O[dt][4 * g + 1] * inv, O[dt][4 * g + 2] * inv, O[dt][4 * g + 3] * inv);
  }
  __syncthreads();
}

DI void gla_bcum(const Params& p, int b, int h, int n, float* bc, float* glr_s, float* segtot) {
  const u16* tm = (const u16*)(p.ws + OFF_TM);
  const int tid = threadIdx.x;
  const int tok0 = b * S_ + n * 64;
  for (int i = tid; i < 1024; i += 512) glr_s[i] = bf2f(tm[(size_t)(tok0 + (i >> 4)) * TMW + TM_GLR + (i & 15)]);
  const int d = tid & 63, cgp = tid >> 6;
  float gu[16];
#pragma unroll
  for (int j = 0; j < 16; ++j) gu[j] = p.gate_up[j * 256 + h * 64 + d];
  const float bias = p.gate_bias[h * 64 + d];
  __syncthreads();
  float v[8]; float run = 0.f;
#pragma unroll
  for (int r = 0; r < 8; ++r) {
    const int c = cgp * 8 + r;
    float z = bias;
#pragma unroll
    for (int j4 = 0; j4 < 4; ++j4) {
      const f32x4 gv = *reinterpret_cast<const f32x4*>(glr_s + c * 16 + j4 * 4);
#pragma unroll
      for (int j = 0; j < 4; ++j) z = fmaf(gv[j], gu[j4 * 4 + j], z);
    }
    float la = (fminf(z, 0.f) - __logf(1.f + __expf(-fabsf(z)))) * 0.0625f;
    run += la; v[r] = run;
  }
  segtot[cgp * 64 + d] = run;
  __syncthreads();
  float off = 0.f;
#pragma unroll
  for (int g = 0; g < 8; ++g) off += (g < cgp) ? segtot[g * 64 + d] : 0.f;
#pragma unroll
  for (int r = 0; r < 8; ++r) bc[(cgp * 8 + r) * 64 + d] = off + v[r];
  __syncthreads();
}

DI void gla_g1_item(const Params& p, int item, char* smem) {
  float* bc = (float*)smem;
  float* glr_s = (float*)(smem + 16384);
  float* segtot = (float*)(smem + 20480);
  u16* KeT = (u16*)(smem + 22528);
  const int b = item >> 8, h = (item >> 6) & 3, n = item & 63;
  const u16* tm = (const u16*)(p.ws + OFF_TM);
  const u16* gvT = (const u16*)(p.ws + OFF_GVT);
  const int tid = threadIdx.x, lane = tid & 63, wave = tid >> 6, lr = lane & 31, lh = lane >> 5;
  const int tok0 = b * S_ + n * 64;
  u16 kraw[8];
  {
    const int d = tid & 63, cgp = tid >> 6;
#pragma unroll
    for (int r = 0; r < 8; ++r) kraw[r] = tm[(size_t)(tok0 + cgp * 8 + r) * TMW + TM_GK + h * 64 + d];
  }
  bf16x8 afr[4];
  {
    const int et = wave & 3;
    const u16* arow = gvT + ((size_t)b * 512 + h * 128 + et * 32 + lr) * 4096 + n * 64 + lh * 8;
#pragma unroll
    for (int ks = 0; ks < 4; ++ks) afr[ks] = ldg8(arow + ks * 16);
  }
  gla_bcum(p, b, h, n, bc, glr_s, segtot);
  {
    const int d = tid & 63, cgp = tid >> 6;
    const float blast = bc[63 * 64 + d];
    {
      float* bcg = (float*)(p.ws + OFF_BCG) + (size_t)item * 4096;
#pragma unroll
      for (int r = 0; r < 8; ++r) bcg[(cgp * 8 + r) * 64 + d] = bc[(cgp * 8 + r) * 64 + d];
    }
    float f[8];
#pragma unroll
    for (int r = 0; r < 8; ++r) {
      const int c = cgp * 8 + r;
      float kv = bf2f(kraw[r]);
      f[r] = kv * __expf(blast - bc[c * 64 + d]);
    }
    *reinterpret_cast<bf16x8*>(KeT + d * 72 + cgp * 8) = pack8(f[0], f[1], f[2], f[3], f[4], f[5], f[6], f[7]);
    if (cgp == 0) ((float*)(p.ws + OFF_DECAY))[item * 64 + d] = __expf(blast);
  }
  __syncthreads();
  {
    const int et = wave & 3, dtl = wave >> 2;
    f32x16 acc = zero16();
#pragma unroll
    for (int ks = 0; ks < 4; ++ks) {
      bf16x8 a = afr[ks];
      bf16x8 bb = *reinterpret_cast<const bf16x8*>(KeT + (dtl * 32 + lr) * 72 + ks * 16 + lh * 8);
      acc = MFMA(a, bb, acc);
    }
    float* kvT = (float*)(p.ws + OFF_KVT);
#pragma unroll
    for (int i = 0; i < 16; ++i) kvT[((size_t)item * 128 + et * 32 + crow(i, lh)) * 64 + dtl * 32 + lr] = acc[i];
  }
  __syncthreads();
}

DI void gla_scan(const Params& p) {
  const float* kvT = (const float*)(p.ws + OFF_KVT);
  const float* decay = (const float*)(p.ws + OFF_DECAY);
  u16* prev = (u16*)(p.ws + OFF_PREV);
  const int gtid = blockIdx.x * blockDim.x + threadIdx.x;
  const int gn = gridDim.x * blockDim.x;
  for (int u = gtid; u < 32 * 2048; u += gn) {
    const int bh = u >> 11, rem = u & 2047, e = rem >> 4, d4 = (rem & 15) * 4;
    f32x4 st = {0.f, 0.f, 0.f, 0.f};
#pragma unroll 4
    for (int n = 0; n < 64; ++n) {
      const int item = bh * 64 + n;
      st4bf(prev + ((size_t)item * 128 + e) * 64 + d4, st[0], st[1], st[2], st[3]);
      f32x4 dc = *reinterpret_cast<const f32x4*>(decay + item * 64 + d4);
      f32x4 kv = *reinterpret_cast<const f32x4*>(kvT + ((size_t)item * 128 + e) * 64 + d4);
      st = dc * st + kv;
    }
  }
}

DI void gla_g3_item(const Params& p, int item, char* smem) {
  float* red = (float*)smem;
  const int b = item >> 8, h = (item >> 6) & 3, n = item & 63;
  const u16* tm = (const u16*)(p.ws + OFF_TM);
  const u16* gvT = (const u16*)(p.ws + OFF_GVT);
  const u16* prev = (const u16*)(p.ws + OFF_PREV);
  const float* bcg = (const float*)(p.ws + OFF_BCG) + (size_t)item * 4096;
  const int tid = threadIdx.x, lane = tid & 63, wave = tid >> 6, lr = lane & 31, lh = lane >> 5;
  const int tok0 = b * S_ + n * 64;
  const int et = wave & 3, ct = wave >> 2;
  bf16x8 qraw[4], kraw[2][4], sfr[4];
  bf16x4 vlo[2][2], vhi[2][2];
  f32x4 bq[4][2];
  {
    const u16* vrow0 = gvT + ((size_t)b * 512 + h * 128 + et * 32 + lr) * 4096 + n * 64 + 4 * lh;
    const u16* srow0 = prev + ((size_t)item * 128 + et * 32 + lr) * 64 + lh * 8;
#pragma unroll
    for (int ks = 0; ks < 4; ++ks) {
      qraw[ks] = ldg8(tm + (size_t)(tok0 + ct * 32 + lr) * TMW + TM_GQ + h * 64 + ks * 16 + lh * 8);
      kraw[0][ks] = ldg8(tm + (size_t)(tok0 + lr) * TMW + TM_GK + h * 64 + ks * 16 + lh * 8);
      kraw[1][ks] = ldg8(tm + (size_t)(tok0 + ct * 32 + lr) * TMW + TM_GK + h * 64 + ks * 16 + lh * 8);
      sfr[ks] = ldg8(srow0 + ks * 16);
      bq[ks][0] = *reinterpret_cast<const f32x4*>(bcg + (ct * 32 + lr) * 64 + ks * 16 + lh * 8);
      bq[ks][1] = *reinterpret_cast<const f32x4*>(bcg + (ct * 32 + lr) * 64 + ks * 16 + lh * 8 + 4);
    }
#pragma unroll
    for (int st = 0; st < 2; ++st)
#pragma unroll
      for (int s2 = 0; s2 < 2; ++s2) {
        const u16* vp = vrow0 + (st * ct) * 32 + 16 * s2;
        vlo[st][s2] = *reinterpret_cast<const bf16x4*>(vp);
        vhi[st][s2] = *reinterpret_cast<const bf16x4*>(vp + 8);
      }
  }
  bf16x8 Qd[4];
#pragma unroll
  for (int ks = 0; ks < 4; ++ks) {
    float f[8];
#pragma unroll
    for (int j = 0; j < 8; ++j) f[j] = bf2f((u16)qraw[ks][j]) * 0.125f * __expf(bq[ks][j >> 2][j & 3]);
    Qd[ks] = pack8(f[0], f[1], f[2], f[3], f[4], f[5], f[6], f[7]);
  }
  f32x16 O = zero16();
#pragma unroll
  for (int st = 0; st < 2; ++st) {
    if (st <= ct) {
      f32x16 A = zero16();
      const int s = st * 32 + lr;
#pragma unroll
      for (int ks = 0; ks < 4; ++ks) {
        f32x4 b0 = (st == 1) ? bq[ks][0] : *reinterpret_cast<const f32x4*>(bcg + s * 64 + ks * 16 + lh * 8);
        f32x4 b1 = (st == 1) ? bq[ks][1] : *reinterpret_cast<const f32x4*>(bcg + s * 64 + ks * 16 + lh * 8 + 4);
        float f[8];
#pragma unroll
        for (int j = 0; j < 8; ++j) f[j] = bf2f((u16)kraw[st][ks][j]) * __expf(-((j < 4) ? b0[j & 3] : b1[j & 3]));
        bf16x8 Ki = pack8(f[0], f[1], f[2], f[3], f[4], f[5], f[6], f[7]);
        A = MFMA(Ki, Qd[ks], A);
      }
      float pv[16];
#pragma unroll
      for (int i = 0; i < 16; ++i) pv[i] = (st * 32 + crow(i, lh) <= ct * 32 + lr) ? A[i] : 0.f;
#pragma unroll
      for (int s2 = 0; s2 < 2; ++s2) {
        bf16x8 Pf = pack8(pv[8 * s2], pv[8 * s2 + 1], pv[8 * s2 + 2], pv[8 * s2 + 3], pv[8 * s2 + 4], pv[8 * s2 + 5], pv[8 * s2 + 6], pv[8 * s2 + 7]);
        O = MFMA(cat44(vlo[st][s2], vhi[st][s2]), Pf, O);
      }
    }
  }
#pragma unroll
  for (int ks = 0; ks < 4; ++ks) O = MFMA(sfr[ks], Qd[ks], O);
  float ss = 0.f;
#pragma unroll
  for (int i = 0; i < 16; ++i) ss += O[i] * O[i];
  ss += __shfl_xor(ss, 32);
  if (lh == 0) red[(ct * 4 + et) * 32 + lr] = ss;
  __syncthreads();
  const float tot = red[(ct * 4 + 0) * 32 + lr] + red[(ct * 4 + 1) * 32 + lr] + red[(ct * 4 + 2) * 32 + lr] + red[(ct * 4 + 3) * 32 + lr];
  const float rinv = rsqrtf(tot * (1.f / 128.f) + 1e-6f);
  const int tok = tok0 + ct * 32 + lr;
  u16* y = (u16*)(p.ws + OFF_XB);
#pragma unroll
  for (int g = 0; g < 4; ++g) {
    const int e0 = et * 32 + 8 * g + 4 * lh;
    u32x2 gr = *reinterpret_cast<const u32x2*>(tm + (size_t)tok * TMW + TM_GR + h * 128 + e0);
    f32x4 ng = *reinterpret_cast<const f32x4*>(p.norm_g + e0);
    float grv[4] = {bflo(gr[0]), bfhi(gr[0]), bflo(gr[1]), bfhi(gr[1])};
    float o[4];
#pragma unroll
    for (int r = 0; r < 4; ++r) {
      float sl = grv[r] / (1.f + __expf(-grv[r]));
      o[r] = O[4 * g + r] * rinv * ng[r] * sl;
    }
    st4bf(y + (size_t)tok * 1024 + 512 + h * 128 + e0, o[0], o[1], o[2], o[3]);
  }
  __syncthreads();
}

template <int MODE>
DI void phase_gemm(const Params& p, const u16* X, const u16* Wt, int N, const float* resid, float* outf, u16* outb, int ldo, char* smem) {
  const int ntn = N / 128;
  const int total = 128 * ntn;
  const int tid = threadIdx.x, lane = tid & 63, wave = tid >> 6;
  const int fw = wave & 1, tq = wave >> 1, lr = lane & 31, lh = lane >> 5;
  for (int t = blockIdx.x; t < total; t += gridDim.x) {
    const int mt = t / ntn, nt = t % ntn;
    f32x16 acc[2][2];
    gemm_tile(X + (size_t)mt * 256 * 1024, 1024, Wt + (size_t)nt * 128 * 1024, 1024, 1024, smem, acc);
    if (MODE == 0 || MODE == 1) {
      float* wl = (float*)(smem + wave * 17408);
#pragma unroll
      for (int tt = 0; tt < 2; ++tt)
#pragma unroll
        for (int ft = 0; ft < 2; ++ft)
#pragma unroll
          for (int g = 0; g < 4; ++g) {
            f32x4 v = {acc[ft][tt][4 * g], acc[ft][tt][4 * g + 1], acc[ft][tt][4 * g + 2], acc[ft][tt][4 * g + 3]};
            *reinterpret_cast<f32x4*>(wl + (tt * 32 + lr) * 68 + ft * 32 + 8 * g + 4 * lh) = v;
          }
      const int ch = lane & 15, r0 = lane >> 4;
      const int f = nt * 128 + fw * 64 + ch * 4;
#pragma unroll 4
      for (int k = 0; k < 16; ++k) {
        const int row = r0 + 4 * k;
        const int tok = mt * 256 + tq * 64 + row;
        f32x4 v = *reinterpret_cast<const f32x4*>(wl + row * 68 + ch * 4);
        if (MODE == 0) {
          f32x4 r = *reinterpret_cast<const f32x4*>(resid + (size_t)tok * 1024 + f);
          f32x4 o;
#pragma unroll
          for (int j = 0; j < 4; ++j) o[j] = ALPHA * r[j] + v[j];
          *reinterpret_cast<f32x4*>(outf + (size_t)tok * 1024 + f) = o;
        } else {
          st4bf(outb + (size_t)tok * ldo + f, v[0], v[1], v[2], v[3]);
        }
      }
      __syncthreads();
    } else {
#pragma unroll
      for (int tt = 0; tt < 2; ++tt) {
        const int tok = mt * 256 + tq * 64 + tt * 32 + lr;
#pragma unroll
        for (int ft = 0; ft < 2; ++ft)
#pragma unroll
          for (int g = 0; g < 4; ++g) {
            const int f = nt * 128 + fw * 64 + ft * 32 + 8 * g + 4 * lh;
            if (MODE == 2) {
              const int hh = f >> 8, fh = f & 255, ks = fh >> 4, lane2 = ((fh >> 3) & 1) * 32 + lr;
              st4bf(outb + ((((size_t)(tok >> 5) * 4 + hh) * 16 + ks) * 64 + lane2) * 8 + 4 * lh, acc[ft][tt][4 * g], acc[ft][tt][4 * g + 1], acc[ft][tt][4 * g + 2], acc[ft][tt][4 * g + 3]);
            } else {
              const int hh = f >> 8, fq = f & 127, half = (f >> 7) & 1, ks = fq >> 4, lane2 = ((fq >> 3) & 1) * 32 + lr;
              st4bf(outb + (((((size_t)(tok >> 5) * 8 + hh) * 2 + half) * 8 + ks) * 64 + lane2) * 8 + 4 * lh, acc[ft][tt][4 * g], acc[ft][tt][4 * g + 1], acc[ft][tt][4 * g + 2], acc[ft][tt][4 * g + 3]);
            }
          }
      }
    }
  }
}

DI void phase_ln(const Params& p, float* h, u16* hb, const float* g, const float* bta) {
  const int lane = threadIdx.x & 63;
  const int gw = (blockIdx.x * blockDim.x + threadIdx.x) >> 6;
  const int nw = (gridDim.x * blockDim.x) >> 6;
  for (int row = gw; row < T_; row += nw) {
    float* r = h + (size_t)row * 1024;
    f32x4 v[4]; float s = 0.f;
#pragma unroll
    for (int c = 0; c < 4; ++c) { v[c] = *reinterpret_cast<const f32x4*>(r + c * 256 + lane * 4); s += v[c][0] + v[c][1] + v[c][2] + v[c][3]; }
    const float mean = wave_sum(s) * (1.f / 1024.f);
    float q = 0.f;
#pragma unroll
    for (int c = 0; c < 4; ++c)
#pragma unroll
      for (int k = 0; k < 4; ++k) { float d = v[c][k] - mean; q += d * d; }
    const float rstd = rsqrtf(wave_sum(q) * (1.f / 1024.f) + 1e-5f);
#pragma unroll
    for (int c = 0; c < 4; ++c) {
      f32x4 gg = *reinterpret_cast<const f32x4*>(g + c * 256 + lane * 4);
      f32x4 bb = *reinterpret_cast<const f32x4*>(bta + c * 256 + lane * 4);
      f32x4 o;
#pragma unroll
      for (int k = 0; k < 4; ++k) o[k] = (v[c][k] - mean) * rstd * gg[k] + bb[k];
      *reinterpret_cast<f32x4*>(r + c * 256 + lane * 4) = o;
      st4bf(hb + (size_t)row * 1024 + c * 256 + lane * 4, o[0], o[1], o[2], o[3]);
    }
  }
}

DI void phase_xattn(const Params& p) {
  const u16* qx = (const u16*)(p.ws + OFF_QX);
  const u16* mk = (const u16*)(p.ws + OFF_MEMK);
  const u16* mv = (const u16*)(p.ws + OFF_MEMVT);
  u16* ox = (u16*)(p.ws + OFF_OX);
  const int lane = threadIdx.x & 63, lr = lane & 31, lh = lane >> 5;
  const int gw = (blockIdx.x * blockDim.x + threadIdx.x) >> 6;
  const int nw = (gridDim.x * blockDim.x) >> 6;
  for (int it = gw; it < 8 * 4 * 128; it += nw) {
    const int qt = it & 127, h = (it >> 7) & 3, b = it >> 9;
    const int tok = b * S_ + qt * 32 + lr;
    f32x16 Sx[8];
#pragma unroll
    for (int kt = 0; kt < 8; ++kt) Sx[kt] = zero16();
    const u16* qrow = qx + (((size_t)(b * 128 + qt) * 4 + h) * 16) * 512 + lane * 8;
    const u16* krow = mk + (((size_t)(b * 4 + h) * 8) * 16) * 512 + lane * 8;
#pragma unroll 2
    for (int ks = 0; ks < 16; ++ks) {
      bf16x8 qf = ldg8(qrow + ks * 512);
#pragma unroll
      for (int kt = 0; kt < 8; ++kt) Sx[kt] = MFMA(ldg8(krow + (kt * 16 + ks) * 512), qf, Sx[kt]);
    }
    float mx = -INFINITY;
#pragma unroll
    for (int kt = 0; kt < 8; ++kt)
#pragma unroll
      for (int i = 0; i < 16; ++i) mx = fmaxf(mx, Sx[kt][i]);
    mx = fmaxf(mx, __shfl_xor(mx, 32));
    float ls = 0.f;
    bf16x8 Pf[8][2];
#pragma unroll
    for (int kt = 0; kt < 8; ++kt) {
      float pv[16];
#pragma unroll
      for (int i = 0; i < 16; ++i) { pv[i] = __expf((Sx[kt][i] - mx) * 0.0625f); ls += pv[i]; }
#pragma unroll
      for (int s = 0; s < 2; ++s) Pf[kt][s] = pack8(pv[8 * s], pv[8 * s + 1], pv[8 * s + 2], pv[8 * s + 3], pv[8 * s + 4], pv[8 * s + 5], pv[8 * s + 6], pv[8 * s + 7]);
    }
    ls += __shfl_xor(ls, 32);
    const float inv = 1.f / ls;
#pragma unroll 1
    for (int dt = 0; dt < 8; ++dt) {
      f32x16 o = zero16();
      const u16* vrow = mv + ((((size_t)(b * 4 + h) * 8 + dt) * 8) * 2) * 512 + lane * 8;
#pragma unroll
      for (int kt = 0; kt < 8; ++kt)
#pragma unroll
        for (int s = 0; s < 2; ++s) o = MFMA(ldg8(vrow + (kt * 2 + s) * 512), Pf[kt][s], o);
#pragma unroll
      for (int g = 0; g < 4; ++g)
        st4bf(ox + (size_t)tok * 1024 + h * 256 + dt * 32 + 8 * g + 4 * lh, o[4 * g] * inv, o[4 * g + 1] * inv, o[4 * g + 2] * inv, o[4 * g + 3] * inv);
    }
  }
}

DI void peer_topk_item(const Params& p, int tt128, int head, char* smem) {
  float* sc = (float*)smem;
  float* topv = (float*)(smem + 132096);
  unsigned char* topi = (unsigned char*)(smem + 132096 + 16384);
  const u16* pq = (const u16*)(p.ws + OFF_QX);
  const u16* sk = (const u16*)(p.ws + OFF_SK);
  const int tid = threadIdx.x, lane = tid & 63, wave = tid >> 6, lr = lane & 31, lh = lane >> 5;
  const int tok0 = tt128 * 128;
  {
    const int half = wave >> 2, kt = wave & 3;
    bf16x8 af[8];
#pragma unroll
    for (int ks = 0; ks < 8; ++ks) af[ks] = ldg8(sk + (size_t)half * 16384 + (kt * 32 + lr) * 128 + ks * 16 + lh * 8);
#pragma unroll 1
    for (int tt = 0; tt < 4; ++tt) {
      f32x16 acc = zero16();
      const u16* brow = pq + (((((size_t)(tok0 >> 5) + tt) * 8 + head) * 2 + half) * 8) * 512 + lane * 8;
#pragma unroll
      for (int ks = 0; ks < 8; ++ks) acc = MFMA(af[ks], ldg8(brow + ks * 512), acc);
#pragma unroll
      for (int i = 0; i < 16; ++i) sc[(half * 128 + tt * 32 + lr) * 129 + kt * 32 + crow(i, lh)] = acc[i];
    }
  }
  __syncthreads();
  if (tid < 256) {
    float* row = sc + tid * 129;
    float gm[8]; int gi[8];
#pragma unroll
    for (int g = 0; g < 8; ++g) {
      float m = -INFINITY; int mi = g * 16;
#pragma unroll
      for (int j = 0; j < 16; ++j) { float v = row[g * 16 + j]; if (v > m) { m = v; mi = g * 16 + j; } }
      gm[g] = m; gi[g] = mi;
    }
#pragma unroll 1
    for (int r = 0; r < 16; ++r) {
      float best = gm[0]; int bg = 0; int bi = gi[0];
#pragma unroll
      for (int g = 1; g < 8; ++g) if (gm[g] > best) { best = gm[g]; bg = g; bi = gi[g]; }
      topv[tid * 16 + r] = best; topi[tid * 16 + r] = (unsigned char)bi;
      row[bi] = -INFINITY;
      float m = -INFINITY; int mi = bg * 16;
#pragma unroll
      for (int j = 0; j < 16; ++j) { float v = row[bg * 16 + j]; if (v > m) { m = v; mi = bg * 16 + j; } }
#pragma unroll
      for (int g = 0; g < 8; ++g) { gm[g] = (g == bg) ? m : gm[g]; gi[g] = (g == bg) ? mi : gi[g]; }
    }
  }
  __syncthreads();
  if (tid < 128) {
    const float* av = topv + tid * 16;
    const float* bv = topv + (128 + tid) * 16;
    const unsigned char* ai = topi + tid * 16;
    const unsigned char* bi_ = topi + (128 + tid) * 16;
    float cur[16]; int pp[16];
    const float b0 = bv[0];
#pragma unroll
    for (int i = 0; i < 16; ++i) { cur[i] = av[i] + b0; pp[i] = 0; }
    float sel[16]; int eid[16];
#pragma unroll
    for (int r = 0; r < 16; ++r) {
      float best = cur[0]; int bi = 0; int bj = pp[0];
#pragma unroll
      for (int i = 1; i < 16; ++i) if (cur[i] > best) { best = cur[i]; bi = i; bj = pp[i]; }
      sel[r] = best;
      eid[r] = (int)ai[bi] * 128 + (int)bi_[bj];
      const int nj = bj + 1;
      const float nv = (nj < 16) ? (av[bi] + bv[nj & 15]) : -INFINITY;
#pragma unroll
      for (int i = 0; i < 16; ++i) { cur[i] = (i == bi) ? nv : cur[i]; pp[i] = (i == bi) ? nj : pp[i]; }
    }
    float sum = 0.f;
    const float smax = sel[0];
#pragma unroll
    for (int r = 0; r < 16; ++r) { sel[r] = __expf(sel[r] - smax); sum += sel[r]; }
    const float inv = 1.f / sum;
    int* eo = (int*)(p.ws + OFF_EIDX) + (size_t)(tok0 + tid) * 128 + head * 16;
    float* go = (float*)(p.ws + OFF_GATE) + (size_t)(tok0 + tid) * 128 + head * 16;
#pragma unroll
    for (int r = 0; r < 16; ++r) { eo[r] = eid[r]; go[r] = sel[r] * inv; }
  }
  __syncthreads();
}

DI float dot2bf(unsigned a, unsigned b, float c) {
  return __builtin_amdgcn_fdot2_f32_bf16(__builtin_bit_cast(bf2_t, a), __builtin_bit_cast(bf2_t, b), c, false);
}

DI float reduce8(float (&part)[8], int lane) {
  float r4[4], r2[2], r1;
#pragma unroll
  for (int k = 0; k < 4; ++k) {
    float send = (lane & 1) ? part[2 * k] : part[2 * k + 1];
    float keep = (lane & 1) ? part[2 * k + 1] : part[2 * k];
    r4[k] = keep + __shfl_xor(send, 1);
  }
#pragma unroll
  for (int k = 0; k < 2; ++k) {
    float send = (lane & 2) ? r4[2 * k] : r4[2 * k + 1];
    float keep = (lane & 2) ? r4[2 * k + 1] : r4[2 * k];
    r2[k] = keep + __shfl_xor(send, 2);
  }
  {
    float send = (lane & 4) ? r2[0] : r2[1];
    float keep = (lane & 4) ? r2[1] : r2[0];
    r1 = keep + __shfl_xor(send, 4);
  }
  r1 += __shfl_xor(r1, 8);
  r1 += __shfl_xor(r1, 16);
  r1 += __shfl_xor(r1, 32);
  return r1;
}

DI void phase_peer_down(const Params& p) {
  const char* exd = p.ws + OFF_EXD;
  const float* esc = (const float*)(p.ws + OFF_ESC);
  const u16* hb = (const u16*)(p.ws + OFF_HB);
  const int* eidx = (const int*)(p.ws + OFF_EIDX);
  const float* gate = (const float*)(p.ws + OFF_GATE);
  float* coefw = (float*)(p.ws + OFF_COEF);
  const int lane = threadIdx.x & 63;
  const int gw = (blockIdx.x * blockDim.x + threadIdx.x) >> 6;
  const int nw = (gridDim.x * blockDim.x) >> 6;
#pragma unroll 1
  for (int sl = 0; sl < 2; ++sl) {
#pragma unroll 1
    for (int tok = gw; tok < T_; tok += nw) {
      float x[16];
      {
        const u16* xr = hb + (size_t)tok * 1024 + lane * 16;
        u32x4 a = *reinterpret_cast<const u32x4*>(xr);
        u32x4 c = *reinterpret_cast<const u32x4*>(xr + 8);
#pragma unroll
        for (int w = 0; w < 4; ++w) { x[2 * w] = bflo(a[w]); x[2 * w + 1] = bfhi(a[w]); x[8 + 2 * w] = bflo(c[w]); x[8 + 2 * w + 1] = bfhi(c[w]); }
      }
#pragma unroll 1
      for (int half = 0; half < 2; ++half) {
        const int ev = eidx[(size_t)tok * 128 + half * 64 + lane];
        const float gv = gate[(size_t)tok * 128 + half * 64 + lane];
        unsigned long long m = __builtin_amdgcn_ballot_w64((ev >> 13) == sl);
        while (m != 0ull) {
          int pos[8];
          const int first = __builtin_ctzll(m);
#pragma unroll
          for (int k = 0; k < 8; ++k) {
            if (m != 0ull) { pos[k] = __builtin_ctzll(m); m &= m - 1ull; } else pos[k] = -1;
          }
          u32x4 dr[8];
#pragma unroll
          for (int k = 0; k < 8; ++k) {
            const int er = __builtin_amdgcn_readlane(ev, pos[k] >= 0 ? pos[k] : first);
            dr[k] = *reinterpret_cast<const u32x4*>(exd + (size_t)er * 1024 + lane * 16);
          }
          int pmine = pos[0];
#pragma unroll
          for (int k = 1; k < 8; ++k) pmine = ((lane & 7) == k) ? pos[k] : pmine;
          const int psafe = pmine >= 0 ? pmine : first;
          const int emine = __shfl(ev, psafe);
          const float gsel = __shfl(gv, psafe);
          const float sd = esc[emine];
          const float su = esc[16384 + emine];
          float part[8];
#pragma unroll
          for (int k = 0; k < 8; ++k) {
            float a0 = 0.f, a1 = 0.f;
#pragma unroll
            for (int w = 0; w < 4; ++w) {
              f2_t lo = __builtin_amdgcn_cvt_pk_f32_fp8((int)dr[k][w], false);
              f2_t hi = __builtin_amdgcn_cvt_pk_f32_fp8((int)dr[k][w], true);
              a0 = fmaf(lo[0], x[4 * w], a0); a1 = fmaf(lo[1], x[4 * w + 1], a1);
              a0 = fmaf(hi[0], x[4 * w + 2], a0); a1 = fmaf(hi[1], x[4 * w + 3], a1);
            }
            part[k] = a0 + a1;
          }
          float r1 = reduce8(part, lane) * sd;
          const float act = 0.5f * r1 * (1.f + erff(r1 * 0.70710678118654752f));
          if (lane < 8 && pmine >= 0) coefw[(size_t)tok * 128 + half * 64 + pmine] = gsel * act * su;
        }
      }
    }
  }
}

DI void phase_peer_ffn(const Params& p) {
  const char* exu = p.ws + OFF_EXU;
  const float* h = (const float*)(p.ws + OFF_H);
  const int* eidx = (const int*)(p.ws + OFF_EIDX);
  const float* coefw = (const float*)(p.ws + OFF_COEF);
  const int lane = threadIdx.x & 63;
  const int gw = (blockIdx.x * blockDim.x + threadIdx.x) >> 6;
  const int nw = (gridDim.x * blockDim.x) >> 6;
  for (int tok = gw; tok < T_; tok += nw) {
    float yacc[16];
#pragma unroll
    for (int i = 0; i < 16; ++i) yacc[i] = 0.f;
    const int e_lo = eidx[(size_t)tok * 128 + lane];
    const int e_hi = eidx[(size_t)tok * 128 + 64 + lane];
    const float c_lo = coefw[(size_t)tok * 128 + lane];
    const float c_hi = coefw[(size_t)tok * 128 + 64 + lane];
#pragma unroll 1
    for (int eb = 0; eb < 8; ++eb) {
      const int ev = (eb < 4) ? e_lo : e_hi;
      const float cv = (eb < 4) ? c_lo : c_hi;
      const int lbase = (eb & 3) * 16;
      u32x4 ur[16];
#pragma unroll
      for (int k = 0; k < 16; ++k) {
        const int er = __builtin_amdgcn_readlane(ev, lbase + k);
        ur[k] = *reinterpret_cast<const u32x4*>(exu + (size_t)er * 1024 + lane * 16);
      }
#pragma unroll
      for (int k = 0; k < 16; ++k) {
        const float ck = __int_as_float(__builtin_amdgcn_readlane(__float_as_int(cv), lbase + k));
#pragma unroll
        for (int w = 0; w < 4; ++w) {
          f2_t lo = __builtin_amdgcn_cvt_pk_f32_fp8((int)ur[k][w], false);
          f2_t hi = __builtin_amdgcn_cvt_pk_f32_fp8((int)ur[k][w], true);
          yacc[4 * w] = fmaf(ck, lo[0], yacc[4 * w]);
          yacc[4 * w + 1] = fmaf(ck, lo[1], yacc[4 * w + 1]);
          yacc[4 * w + 2] = fmaf(ck, hi[0], yacc[4 * w + 2]);
          yacc[4 * w + 3] = fmaf(ck, hi[1], yacc[4 * w + 3]);
        }
      }
    }
    const float* xr = h + (size_t)tok * 1024 + lane * 16;
    float v[16];
#pragma unroll
    for (int c = 0; c < 4; ++c) {
      f32x4 t = *reinterpret_cast<const f32x4*>(xr + c * 4);
#pragma unroll
      for (int k = 0; k < 4; ++k) v[4 * c + k] = ALPHA * t[k] + yacc[4 * c + k];
    }
    float s = 0.f;
#pragma unroll
    for (int i = 0; i < 16; ++i) s += v[i];
    const float mean = wave_sum(s) * (1.f / 1024.f);
    float q = 0.f;
#pragma unroll
    for (int i = 0; i < 16; ++i) { float d = v[i] - mean; q += d * d; }
    const float rstd = rsqrtf(wave_sum(q) * (1.f / 1024.f) + 1e-5f);
    float* orow = p.out + (size_t)tok * 1024 + lane * 16;
#pragma unroll
    for (int c = 0; c < 4; ++c) {
      f32x4 gg = *reinterpret_cast<const f32x4*>(p.ln_ffn_g + lane * 16 + c * 4);
      f32x4 bb = *reinterpret_cast<const f32x4*>(p.ln_ffn_b + lane * 16 + c * 4);
      f32x4 o;
#pragma unroll
      for (int k = 0; k < 4; ++k) o[k] = (v[4 * c + k] - mean) * rstd * gg[k] + bb[k];
      *reinterpret_cast<f32x4*>(orow + c * 4) = o;
    }
  }
}

constexpr size_t OFF_BAR = 166 * MiB;
DI void gbar(unsigned* ctr, unsigned target) {
  asm volatile("s_waitcnt vmcnt(0)" ::: "memory");
  __syncthreads();
  if (threadIdx.x == 0) {
    __builtin_amdgcn_fence(__ATOMIC_RELEASE, "agent");
    asm volatile("s_waitcnt vmcnt(0)" ::: "memory");
    __hip_atomic_fetch_add(ctr, 1u, __ATOMIC_RELAXED, __HIP_MEMORY_SCOPE_AGENT);
    while (__hip_atomic_load(ctr, __ATOMIC_RELAXED, __HIP_MEMORY_SCOPE_AGENT) < target) __builtin_amdgcn_s_sleep(2);
    __builtin_amdgcn_fence(__ATOMIC_ACQUIRE, "agent");
    asm volatile("s_waitcnt vmcnt(0)" ::: "memory");
  }
  __syncthreads();
}

__global__ void __launch_bounds__(512) fwd_megakernel(Params p) {
  __shared__ __attribute__((aligned(1024))) char smem[155648];
  cg::grid_group grid = cg::this_grid();
  const int G = gridDim.x;
  char* ws = p.ws;
  unsigned* bar = (unsigned*)(ws + OFF_BAR);

  phase_prep(p, smem);
  grid.sync();

  phase_inproj(p, smem);
  gbar(bar, (unsigned)(1 * G));

  for (int k = 0; k * G < 1024; ++k) {
    int j = (k & 1) ? (G - 1 - (int)blockIdx.x) : (int)blockIdx.x;
    int idx = k * G + j;
    if (idx < 1024) dsa_thr_item(p, idx & 7, 127 - (idx >> 3), smem);
  }
  for (int it = blockIdx.x; it < 2048; it += G) gla_g1_item(p, it, smem);
  gbar(bar, (unsigned)(2 * G));

  for (int k = 0; k * G < 1024; ++k) {
    int j = (k & 1) ? (G - 1 - (int)blockIdx.x) : (int)blockIdx.x;
    int idx = k * G + j;
    if (idx < 1024) dsa_attn_item(p, idx & 7, 127 - (idx >> 3), smem);
  }
  gla_scan(p);
  gbar(bar, (unsigned)(3 * G));

  for (int it = blockIdx.x; it < 2048; it += G) gla_g3_item(p, it, smem);
  gbar(bar, (unsigned)(4 * G));

  phase_gemm<0>(p, (const u16*)(ws + OFF_XB), (const u16*)(ws + OFF_WOUT), 1024, p.x, (float*)(ws + OFF_H), nullptr, 0, smem);
  gbar(bar, (unsigned)(5 * G));
  phase_ln(p, (float*)(ws + OFF_H), (u16*)(ws + OFF_HB), p.ln_mix_g, p.ln_mix_b);
  gbar(bar, (unsigned)(6 * G));

  phase_gemm<2>(p, (const u16*)(ws + OFF_HB), (const u16*)(ws + OFF_WQ), 1024, nullptr, nullptr, (u16*)(ws + OFF_QX), 1024, smem);
  gbar(bar, (unsigned)(7 * G));
  phase_xattn(p);
  gbar(bar, (unsigned)(8 * G));
  phase_gemm<0>(p, (const u16*)(ws + OFF_OX), (const u16*)(ws + OFF_WO), 1024, (const float*)(ws + OFF_H), (float*)(ws + OFF_H), nullptr, 0, smem);
  gbar(bar, (unsigned)(9 * G));
  phase_ln(p, (float*)(ws + OFF_H), (u16*)(ws + OFF_HB), p.ln_mem_g, p.ln_mem_b);
  gbar(bar, (unsigned)(10 * G));

  phase_gemm<5>(p, (const u16*)(ws + OFF_HB), (const u16*)(ws + OFF_WPQ), 2048, nullptr, nullptr, (u16*)(ws + OFF_QX), 2048, smem);
  gbar(bar, (unsigned)(11 * G));
  for (int it = blockIdx.x; it < 2048; it += G) peer_topk_item(p, it >> 3, it & 7, smem);
  gbar(bar, (unsigned)(12 * G));
  phase_peer_down(p);
  gbar(bar, (unsigned)(13 * G));
  phase_peer_ffn(p);
}

extern "C" void kernel_launch(void* const* d_in, const int* in_sizes, int n_in,
                              void* d_out, int out_size, void* d_ws, size_t ws_size,
                              hipStream_t stream) {
  static int grid_blocks = 0;
  if (!grid_blocks) {
    int dev = 0, cus = 0, per_cu = 0;
    (void)hipGetDevice(&dev);
    (void)hipDeviceGetAttribute(&cus, hipDeviceAttributeMultiprocessorCount, dev);
    (void)hipOccupancyMaxActiveBlocksPerMultiprocessor(&per_cu, fwd_megakernel, 512, 0);
    if (per_cu > 1) per_cu = 1;
    grid_blocks = cus * per_cu;
    if (grid_blocks > 256) grid_blocks = 256;
    if (ws_size < 512 * MiB) fprintf(stderr, "workspace too small: %zu\n", ws_size);
  }
  Params p{};
  p.x = (const float*)d_in[0]; p.positions = (const int*)d_in[1]; p.mem = (const float*)d_in[2]; p.w_in = (const float*)d_in[3];
  p.gate_up = (const float*)d_in[4]; p.gate_bias = (const float*)d_in[5]; p.norm_g = (const float*)d_in[6]; p.w_out = (const float*)d_in[7];
  p.ln_mix_g = (const float*)d_in[8]; p.ln_mix_b = (const float*)d_in[9];
  p.wq = (const float*)d_in[10]; p.wk = (const float*)d_in[11]; p.wv = (const float*)d_in[12]; p.wo = (const float*)d_in[13];
  p.ln_mem_g = (const float*)d_in[14]; p.ln_mem_b = (const float*)d_in[15];
  p.w_pq = (const float*)d_in[16]; p.sk1 = (const float*)d_in[17]; p.sk2 = (const float*)d_in[18];
  p.ex_down = (const float*)d_in[19]; p.ex_up = (const float*)d_in[20];
  p.ln_ffn_g = (const float*)d_in[21]; p.ln_ffn_b = (const float*)d_in[22];
  p.out = (float*)d_out; p.ws = (char*)d_ws;
  (void)hipMemsetAsync((char*)d_ws + OFF_BAR, 0, 256, stream);
  void* args[] = {&p};
  hipError_t e = hipLaunchCooperativeKernel((void*)fwd_megakernel, dim3(grid_blocks), dim3(512), args, 0, stream);
  if (e != hipSuccess) fprintf(stderr, "cooperative launch failed: %s (grid %d)\n", hipGetErrorString(e), grid_blocks);
}
```

```cpp
#include <hip/hip_runtime.h>
#include <hip/hip_cooperative_groups.h>
#include <cstdio>
#include <cmath>
namespace cg = cooperative_groups;

#define DI __device__ __forceinline__
typedef short bf16x8 __attribute__((ext_vector_type(8)));
typedef short bf16x4 __attribute__((ext_vector_type(4)));
typedef float f32x16 __attribute__((ext_vector_type(16)));
typedef float f32x4 __attribute__((ext_vector_type(4)));
typedef unsigned u32x4 __attribute__((ext_vector_type(4)));
typedef unsigned u32x2 __attribute__((ext_vector_type(2)));
typedef unsigned short u16;
typedef __bf16 bf2_t __attribute__((ext_vector_type(2)));
typedef float f2_t __attribute__((ext_vector_type(2)));

#define MFMA(a, b, c) __builtin_amdgcn_mfma_f32_32x32x16_bf16((a), (b), (c), 0, 0, 0)

constexpr int T_ = 32768;
constexpr int S_ = 4096;
constexpr int TMW = 2368;
constexpr int TM_Q = 0, TM_K = 512, TM_QI = 1024, TM_KI = 1280, TM_WI = 1312, TM_GLR = 1320, TM_GQ = 1344, TM_GK = 1600, TM_GR = 1856;
constexpr int PROJ_N = 3456;
constexpr float ALPHA = 1.189207115002721f;
constexpr size_t MiB = 1024 * 1024;

constexpr size_t OFF_XB = 0;
constexpr size_t OFF_EXD = 64 * MiB;
constexpr size_t OFF_EXU = 80 * MiB;
constexpr size_t OFF_BCG = 96 * MiB;
constexpr size_t OFF_WIN = 128 * MiB;
constexpr size_t OFF_WOUT = OFF_WIN + (size_t)PROJ_N * 1024 * 2;
constexpr size_t OFF_WQ = OFF_WOUT + 2 * MiB;
constexpr size_t OFF_WK = OFF_WQ + 2 * MiB;
constexpr size_t OFF_WV = OFF_WK + 2 * MiB;
constexpr size_t OFF_WO = OFF_WV + 2 * MiB;
constexpr size_t OFF_WPQ = OFF_WO + 2 * MiB;
constexpr size_t OFF_KIF = 149 * MiB;
constexpr size_t OFF_MEMB = 152 * MiB;
constexpr size_t OFF_MEMK = 156 * MiB;
constexpr size_t OFF_MEMVT = 160 * MiB;
constexpr size_t OFF_THR = 164 * MiB;
constexpr size_t OFF_SK = OFF_THR + 256 * 1024;
constexpr size_t OFF_DECAY = OFF_SK + 128 * 1024;
constexpr size_t OFF_ESC = 165 * MiB;
constexpr size_t OFF_TM = 168 * MiB;
constexpr size_t OFF_VT = 316 * MiB;
constexpr size_t OFF_KFR = 476 * MiB;
constexpr size_t OFF_GVT = 348 * MiB;
constexpr size_t OFF_KVT = 380 * MiB;
constexpr size_t OFF_PREV = 444 * MiB;
constexpr size_t OFF_H = 168 * MiB;
constexpr size_t OFF_HB = 296 * MiB;
constexpr size_t OFF_QX = 360 * MiB;
constexpr size_t OFF_OX = 424 * MiB;
constexpr size_t OFF_EIDX = 0;
constexpr size_t OFF_GATE = 16 * MiB;
constexpr size_t OFF_COEF = 32 * MiB;

struct Params {
  const float* x; const int* positions; const float* mem; const float* w_in;
  const float* gate_up; const float* gate_bias; const float* norm_g; const float* w_out;
  const float* ln_mix_g; const float* ln_mix_b;
  const float* wq; const float* wk; const float* wv; const float* wo;
  const float* ln_mem_g; const float* ln_mem_b;
  const float* w_pq; const float* sk1; const float* sk2; const float* ex_down; const float* ex_up;
  const float* ln_ffn_g; const float* ln_ffn_b;
  float* out; char* ws;
};

DI unsigned pk_bf16(float a, float b) {
  f2_t v = {a, b};
  bf2_t r = __builtin_convertvector(v, bf2_t);
  return __builtin_bit_cast(unsigned, r);
}
DI u16 f2bf(float a) { return (u16)(pk_bf16(a, 0.f) & 0xffffu); }
DI float bf2f(u16 u) { return __uint_as_float(((unsigned)u) << 16); }
DI float bflo(unsigned u) { return __uint_as_float(u << 16); }
DI float bfhi(unsigned u) { return __uint_as_float(u & 0xffff0000u); }
DI int crow(int i, int h) { return (i & 3) + 8 * (i >> 2) + 4 * h; }
DI bf16x8 ldg8(const u16* p) { return *reinterpret_cast<const bf16x8*>(p); }
DI bf16x8 pack8(float a0, float a1, float a2, float a3, float a4, float a5, float a6, float a7) {
  u32x4 r; r[0] = pk_bf16(a0, a1); r[1] = pk_bf16(a2, a3); r[2] = pk_bf16(a4, a5); r[3] = pk_bf16(a6, a7);
  return __builtin_bit_cast(bf16x8, r);
}
DI bf16x8 cat44(bf16x4 lo, bf16x4 hi) { return __builtin_shufflevector(lo, hi, 0, 1, 2, 3, 4, 5, 6, 7); }
DI void st4bf(u16* p, float a, float b, float c, float d) {
  u32x2 v; v[0] = pk_bf16(a, b); v[1] = pk_bf16(c, d);
  *reinterpret_cast<u32x2*>(p) = v;
}
DI float wave_sum(float v) {
#pragma unroll
  for (int d = 32; d >= 1; d >>= 1) v += __shfl_xor(v, d);
  return v;
}
DI void sincos_rad(float ang, float& s, float& c) {
  constexpr float C_hi = (float)0.15915494309189535;
  constexpr float C_lo = (float)(0.15915494309189535 - (double)C_hi);
  float k = rintf(ang * C_hi);
  float f = fmaf(ang, C_hi, -k);
  f = fmaf(ang, C_lo, f);
  s = __builtin_amdgcn_sinf(f);
  c = __builtin_amdgcn_cosf(f);
}
DI unsigned fkey(float s) {
  const unsigned u = __float_as_uint(s);
  return u ^ ((unsigned)((int)u >> 31) | 0x80000000u);
}
DI f32x16 zero16() { f32x16 z; for (int i = 0; i < 16; ++i) z[i] = 0.f; return z; }

DI int win_src_col(int n) {
  if (n < 1832) return n;
  if (n < 1848) return 2856 + (n - 1832);
  if (n < 1856) return -1;
  if (n < 2880) return n - 24;
  if (n < 3392) return n - 8;
  return -1;
}

DI void cvt_stream(const float* __restrict__ src, u16* __restrict__ dst, size_t n, size_t gtid, size_t gn) {
  size_t n8 = n / 8;
  for (size_t i = gtid; i < n8; i += gn) {
    f32x4 a = *reinterpret_cast<const f32x4*>(src + i * 8);
    f32x4 b = *reinterpret_cast<const f32x4*>(src + i * 8 + 4);
    u32x4 r; r[0] = pk_bf16(a[0], a[1]); r[1] = pk_bf16(a[2], a[3]); r[2] = pk_bf16(b[0], b[1]); r[3] = pk_bf16(b[2], b[3]);
    *reinterpret_cast<u32x4*>(dst + i * 8) = r;
  }
}

template <bool MAPPED>
DI void transpose_tile(const float* __restrict__ W, int ldn, u16* __restrict__ Wt, int k0, int n0, float* tile) {
  const int tid = threadIdx.x;
  {
    int nn = n0 + (tid & 63);
    int c = MAPPED ? win_src_col(nn) : nn;
#pragma unroll
    for (int rr = 0; rr < 8; ++rr) {
      int kk = (tid >> 6) + 8 * rr;
      float v = (c >= 0) ? W[(size_t)(k0 + kk) * ldn + c] : 0.f;
      tile[kk * 65 + (tid & 63)] = v;
    }
  }
  __syncthreads();
#pragma unroll
  for (int rr = 0; rr < 8; ++rr) {
    int nn = (tid >> 6) + 8 * rr;
    int kk = tid & 63;
    Wt[(size_t)(n0 + nn) * 1024 + k0 + kk] = f2bf(tile[kk * 65 + nn]);
  }
  __syncthreads();
}

DI void phase_prep(const Params& p, char* smem) {
  const size_t gtid = (size_t)blockIdx.x * blockDim.x + threadIdx.x;
  const size_t gn = (size_t)gridDim.x * blockDim.x;
  char* ws = p.ws;
  cvt_stream(p.x, (u16*)(ws + OFF_XB), (size_t)T_ * 1024, gtid, gn);
  cvt_stream(p.mem, (u16*)(ws + OFF_MEMB), (size_t)2048 * 1024, gtid, gn);
  {
    const int lane = threadIdx.x & 63;
    const int gw = (int)(gtid >> 6), nw = (int)(gn >> 6);
    for (int r = gw; r < 2 * 16384; r += nw) {
      const int tbl = r >> 14, row = r & 16383;
      const float* src = (tbl ? p.ex_up : p.ex_down) + (size_t)row * 1024 + lane * 16;
      f32x4 v[4]; float mx = 0.f;
#pragma unroll
      for (int c = 0; c < 4; ++c) {
        v[c] = *reinterpret_cast<const f32x4*>(src + c * 4);
#pragma unroll
        for (int k = 0; k < 4; ++k) mx = fmaxf(mx, fabsf(v[c][k]));
      }
#pragma unroll
      for (int d = 32; d >= 1; d >>= 1) mx = fmaxf(mx, __shfl_xor(mx, d));
      float sc = (mx > 0.f) ? exp2f(floorf(log2f(224.f / mx))) : 1.f;
      u32x4 o;
#pragma unroll
      for (int c = 0; c < 4; ++c) {
        int t = __builtin_amdgcn_cvt_pk_fp8_f32(v[c][0] * sc, v[c][1] * sc, 0, false);
        t = __builtin_amdgcn_cvt_pk_fp8_f32(v[c][2] * sc, v[c][3] * sc, t, true);
        o[c] = (unsigned)t;
      }
      *reinterpret_cast<u32x4*>(ws + (tbl ? OFF_EXU : OFF_EXD) + (size_t)row * 1024 + lane * 16) = o;
      if (lane == 0) ((float*)(ws + OFF_ESC))[r] = 1.f / sc;
    }
  }
  cvt_stream(p.sk1, (u16*)(ws + OFF_SK), (size_t)128 * 128, gtid, gn);
  cvt_stream(p.sk2, (u16*)(ws + OFF_SK) + 128 * 128, (size_t)128 * 128, gtid, gn);
  float* tile = (float*)smem;
  const int n_win = 54 * 16, n_sq = 256, n_pq = 512;
  const int total = n_win + 5 * n_sq + n_pq;
  for (int t = blockIdx.x; t < total; t += gridDim.x) {
    if (t < n_win) {
      transpose_tile<true>(p.w_in, 3384, (u16*)(ws + OFF_WIN), (t & 15) * 64, (t >> 4) * 64, tile);
    } else if (t < n_win + 5 * n_sq) {
      int u = t - n_win; int which = u >> 8; int r = u & 255;
      const float* W = which == 0 ? p.w_out : which == 1 ? p.wq : which == 2 ? p.wk : which == 3 ? p.wv : p.wo;
      size_t off = which == 0 ? OFF_WOUT : which == 1 ? OFF_WQ : which == 2 ? OFF_WK : which == 3 ? OFF_WV : OFF_WO;
      transpose_tile<false>(W, 1024, (u16*)(ws + off), (r & 15) * 64, (r >> 4) * 64, tile);
    } else {
      int r = t - n_win - 5 * n_sq;
      transpose_tile<false>(p.w_pq, 2048, (u16*)(ws + OFF_WPQ), (r & 15) * 64, (r >> 4) * 64, tile);
    }
  }
}

#define WAIT_V(n) asm volatile("s_waitcnt vmcnt(%0)" ::"n"(n) : "memory")
#define RAW_BARRIER() do { asm volatile("s_waitcnt lgkmcnt(0)" ::: "memory"); __builtin_amdgcn_s_barrier(); asm volatile("" ::: "memory"); } while (0)
constexpr int G_STAGE = 384 * 128;
DI void gemm_tile(const u16* __restrict__ X, int ldx, const u16* __restrict__ Wt, int ldw, int K, char* smem,
                  f32x16 (&acc)[2][2]) {
  const int tid = threadIdx.x, lane = tid & 63, wave = tid >> 6;
  const int fw = wave & 1, tq = wave >> 1, lr = lane & 31, lh = lane >> 5;
#pragma unroll
  for (int a = 0; a < 2; ++a)
#pragma unroll
    for (int b = 0; b < 2; ++b) acc[a][b] = zero16();
  const int nk = K / 64;
  const u16* src[6];
#pragma unroll
  for (int i = 0; i < 6; ++i) {
    const int R = 8 * (wave + 8 * i) + (lane >> 3);
    const int c = (lane & 7) ^ ((R >> 1) & 7);
    src[i] = (i < 4) ? (X + (size_t)R * ldx + c * 8) : (Wt + (size_t)(R - 256) * ldw + c * 8);
  }
#define GLDS_STAGE(slot, kt) do { _Pragma("unroll") for (int i = 0; i < 6; ++i) \
    __builtin_amdgcn_global_load_lds((const unsigned*)(src[i] + (kt) * 64), (__attribute__((address_space(3))) unsigned*)(smem + (slot) * G_STAGE + (wave + 8 * i) * 1024), 16, 0, 0); } while (0)
  int offA[2], offB[2], xa[2], xb[2];
#pragma unroll
  for (int ft = 0; ft < 2; ++ft) { const int R = 256 + fw * 64 + ft * 32 + lr; offA[ft] = R * 128; xa[ft] = (R >> 1) & 7; }
#pragma unroll
  for (int tt = 0; tt < 2; ++tt) { const int R = tq * 64 + tt * 32 + lr; offB[tt] = R * 128; xb[tt] = (R >> 1) & 7; }
  GLDS_STAGE(0, 0); GLDS_STAGE(1, 1); WAIT_V(6); RAW_BARRIER();
  int cur = 0;
  for (int kt = 0; kt < nk; ++kt) {
    const int nxt = (cur >= 1) ? cur - 1 : 2;
    if (kt + 2 < nk) GLDS_STAGE(nxt, kt + 2);
    __builtin_amdgcn_sched_barrier(0);
    const char* st = smem + cur * G_STAGE;
#pragma unroll
    for (int ks = 0; ks < 4; ++ks) {
      bf16x8 a[2], b[2];
#pragma unroll
      for (int ft = 0; ft < 2; ++ft) a[ft] = *reinterpret_cast<const bf16x8*>(st + offA[ft] + (((ks * 2 + lh) ^ xa[ft]) << 4));
#pragma unroll
      for (int tt = 0; tt < 2; ++tt) b[tt] = *reinterpret_cast<const bf16x8*>(st + offB[tt] + (((ks * 2 + lh) ^ xb[tt]) << 4));
#pragma unroll
      for (int ft = 0; ft < 2; ++ft)
#pragma unroll
        for (int tt = 0; tt < 2; ++tt) acc[ft][tt] = MFMA(a[ft], b[tt], acc[ft][tt]);
    }
    if (kt + 2 < nk) { WAIT_V(6); } else { WAIT_V(0); }
    RAW_BARRIER();
    cur = (cur == 2) ? 0 : cur + 1;
  }
#undef GLDS_STAGE
}

DI void store_tm_rows(f32x16 (&acc)[2][2], char* smem, u16* tm, int tokbase, int col) {
  const int lane = threadIdx.x & 63, wave = threadIdx.x >> 6, lr = lane & 31, lh = lane >> 5;
  float* wl = (float*)(smem + wave * 17408);
#pragma unroll
  for (int tt = 0; tt < 2; ++tt)
#pragma unroll
    for (int ft = 0; ft < 2; ++ft)
#pragma unroll
      for (int g = 0; g < 4; ++g) {
        f32x4 v = {acc[ft][tt][4 * g], acc[ft][tt][4 * g + 1], acc[ft][tt][4 * g + 2], acc[ft][tt][4 * g + 3]};
        *reinterpret_cast<f32x4*>(wl + (tt * 32 + lr) * 68 + ft * 32 + 8 * g + 4 * lh) = v;
      }
  const int ch = lane & 15, r0 = lane >> 4;
#pragma unroll 4
  for (int k = 0; k < 16; ++k) {
    const int row = r0 + 4 * k;
    f32x4 v = *reinterpret_cast<const f32x4*>(wl + row * 68 + ch * 4);
    st4bf(tm + (size_t)(tokbase + row) * TMW + col + ch * 4, v[0], v[1], v[2], v[3]);
  }
}

DI void epi_inproj(const Params& p, int tok0, int f0, f32x16 (&acc)[2][2], char* smem) {
  const int tid = threadIdx.x, lane = tid & 63, wave = tid >> 6;
  const int fw = wave & 1, tq = wave >> 1, lr = lane & 31, lh = lane >> 5;
  const int fbase = f0 + fw * 64;
  if (fbase >= 3392) return;
  u16* tm = (u16*)(p.ws + OFF_TM);
  int tmcol = -1;
#pragma unroll
  for (int tt = 0; tt < 2; ++tt) {
    const int tok = tok0 + tq * 64 + tt * 32 + lr;
    const float posf = (float)p.positions[tok];
    const int bb = tok >> 12, ss = tok & 4095;
    if (fbase < 1024) {
#pragma unroll
      for (int r = 0; r < 4; ++r) {
        float j = (float)(4 * lh + r);
        float inv = exp2f(-j * (18.931568569324174f / 8.0f));
        float sn, cs; sincos_rad(posf * inv, sn, cs);
        float x1 = acc[0][tt][r], x2 = acc[0][tt][r + 4];
        acc[0][tt][r] = x1 * cs - x2 * sn;
        acc[0][tt][r + 4] = x2 * cs + x1 * sn;
      }
      if (fbase < 512) {
        tmcol = fbase;
      } else {
        u16* kfr = (u16*)(p.ws + OFF_KFR);
        const int head = (fbase - 512) >> 6, gt = ss >> 5;
#pragma unroll
        for (int ft = 0; ft < 2; ++ft)
#pragma unroll
          for (int g = 0; g < 4; ++g) {
            const int ks = ft * 2 + (g >> 1), lane2 = (g & 1) * 32 + lr;
            st4bf(kfr + ((((size_t)(bb * 8 + head) * 128 + gt) * 4 + ks) * 64 + lane2) * 8 + 4 * lh, acc[ft][tt][4 * g], acc[ft][tt][4 * g + 1], acc[ft][tt][4 * g + 2], acc[ft][tt][4 * g + 3]);
          }
      }
    } else if (fbase < 1536) {
      u16* vfr = (u16*)(p.ws + OFF_VT);
      const int head = (fbase - 1024) >> 6, gt = ss >> 5;
      const int s = lr >> 4, r16 = lr & 15, j = 4 * (r16 >> 3) + (r16 & 3), lh2 = (r16 >> 2) & 1;
#pragma unroll
      for (int ft = 0; ft < 2; ++ft)
#pragma unroll
        for (int i = 0; i < 16; ++i) {
          const int lane2 = lh2 * 32 + crow(i, lh);
          vfr[((((((size_t)(bb * 8 + head) * 128 + gt) * 2 + ft) * 2 + s) * 64 + lane2) * 8) + j] = f2bf(acc[ft][tt][i]);
        }
    } else if (fbase >= 2368 && fbase < 2880) {
      u16* vt = (u16*)(p.ws + OFF_GVT);
      const int fo = fbase - 2368;
#pragma unroll
      for (int ft = 0; ft < 2; ++ft)
#pragma unroll
        for (int i = 0; i < 16; ++i) {
          int feat = fo + ft * 32 + crow(i, lh);
          vt[((size_t)bb * 512 + feat) * 4096 + ss] = f2bf(acc[ft][tt][i]);
        }
    } else {
      if (fbase < 1856) {
#pragma unroll
        for (int ft = 0; ft < 2; ++ft) {
          const bool rot = (fbase < 1792) || (ft == 0);
#pragma unroll
          for (int r = 0; r < 4; ++r) {
            float v = acc[ft][tt][r];
            float o = __shfl_xor(v, 32);
            float inv = exp2f(-(float)r * (18.931568569324174f / 4.0f));
            float sn, cs; sincos_rad(posf * inv, sn, cs);
            float res = (lh == 0) ? (v * cs - o * sn) : (v * cs + o * sn);
            acc[ft][tt][r] = rot ? res : v;
          }
        }
        tmcol = fbase - 512;
        if (fbase == 1792) {
          u16* kif = (u16*)(p.ws + OFF_KIF);
          const int gt = ss >> 5;
#pragma unroll
          for (int g = 0; g < 4; ++g) {
            const int ks = g >> 1, lane2 = (g & 1) * 32 + lr;
            st4bf(kif + ((((size_t)bb * 128 + gt) * 2 + ks) * 64 + lane2) * 8 + 4 * lh, acc[0][tt][4 * g], acc[0][tt][4 * g + 1], acc[0][tt][4 * g + 2], acc[0][tt][4 * g + 3]);
          }
        }
      } else if (fbase < 2368) {
        tmcol = fbase - 512;
      } else {
        tmcol = fbase - 1024;
      }
    }
  }
  if (tmcol >= 0) store_tm_rows(acc, smem, tm, tok0 + tq * 64, tmcol);
}

DI void phase_inproj(const Params& p, char* smem) {
  const int n_in = 128 * 27;
  const int total = n_in + 128;
  const u16* xb = (const u16*)(p.ws + OFF_XB);
  const u16* memb = (const u16*)(p.ws + OFF_MEMB);
  const int tid = threadIdx.x, lane = tid & 63, wave = tid >> 6;
  const int fw = wave & 1, tq = wave >> 1, lr = lane & 31, lh = lane >> 5;
  for (int t = blockIdx.x; t < total; t += gridDim.x) {
    f32x16 acc[2][2];
    if (t < n_in) {
      int mt = t / 27, nt = t % 27;
      gemm_tile(xb + (size_t)mt * 256 * 1024, 1024, (const u16*)(p.ws + OFF_WIN) + (size_t)nt * 128 * 1024, 1024, 1024, smem, acc);
      epi_inproj(p, mt * 256, nt * 128, acc, smem);
      __syncthreads();
    } else {
      int u = t - n_in; int which = u >> 6; int r = u & 63; int mt = r >> 3, nt = r & 7;
      const u16* W = (const u16*)(p.ws + (which == 0 ? OFF_WK : OFF_WV));
      gemm_tile(memb + (size_t)mt * 256 * 1024, 1024, W + (size_t)nt * 128 * 1024, 1024, 1024, smem, acc);
#pragma unroll
      for (int tt = 0; tt < 2; ++tt) {
        const int tok = mt * 256 + tq * 64 + tt * 32 + lr;
        const int bb = tok >> 8, mm = tok & 255, hh = nt >> 1, kt = mm >> 5;
        if (which == 0) {
          u16* mk = (u16*)(p.ws + OFF_MEMK);
#pragma unroll
          for (int ft = 0; ft < 2; ++ft)
#pragma unroll
            for (int g = 0; g < 4; ++g) {
              const int ks = (nt & 1) * 8 + fw * 4 + ft * 2 + (g >> 1), lane2 = (g & 1) * 32 + lr;
              st4bf(mk + ((((size_t)(bb * 4 + hh) * 8 + kt) * 16 + ks) * 64 + lane2) * 8 + 4 * lh, acc[ft][tt][4 * g], acc[ft][tt][4 * g + 1], acc[ft][tt][4 * g + 2], acc[ft][tt][4 * g + 3]);
            }
        } else {
          u16* mv = (u16*)(p.ws + OFF_MEMVT);
          const int s = lr >> 4, r16 = lr & 15, j = 4 * (r16 >> 3) + (r16 & 3), lh2 = (r16 >> 2) & 1;
#pragma unroll
          for (int ft = 0; ft < 2; ++ft) {
            const int dt = (nt & 1) * 4 + fw * 2 + ft;
#pragma unroll
            for (int i = 0; i < 16; ++i) {
              const int lane2 = lh2 * 32 + crow(i, lh);
              mv[((((((size_t)(bb * 4 + hh) * 8 + dt) * 8 + kt) * 2 + s) * 64 + lane2) * 8) + j] = f2bf(acc[ft][tt][i]);
            }
          }
        }
      }
    }
  }
}

DI void idx_scores(const bf16x8 (&qf)[8][2], const float (&wq)[8], bf16x8 k0, bf16x8 k1, float (&sc)[16]) {
#pragma unroll
  for (int i = 0; i < 16; ++i) sc[i] = 0.f;
#pragma unroll
  for (int hd = 0; hd < 8; ++hd) {
    f32x16 a = zero16();
    a = MFMA(k0, qf[hd][0], a);
    a = MFMA(k1, qf[hd][1], a);
#pragma unroll
    for (int i = 0; i < 16; ++i) sc[i] = fmaf(wq[hd], fmaxf(a[i], 0.f), sc[i]);
  }
}

DI void load_idx_q(const u16* tm, int tok, int lh, bf16x8 (&qf)[8][2], float (&wq)[8]) {
  const u16* row = tm + (size_t)tok * TMW;
#pragma unroll
  for (int hd = 0; hd < 8; ++hd)
#pragma unroll
    for (int ks = 0; ks < 2; ++ks) qf[hd][ks] = ldg8(row + TM_QI + hd * 32 + ks * 16 + lh * 8);
  bf16x8 w8 = ldg8(row + TM_WI);
#pragma unroll
  for (int hd = 0; hd < 8; ++hd) wq[hd] = bf2f((u16)w8[hd]) * 0.0625f;
}

DI int wave_incl_scan(int v, int lane) {
#pragma unroll
  for (int d = 1; d < 64; d <<= 1) {
    int t = __shfl_up(v, d);
    if (lane >= d) v += t;
  }
  return v;
}

DI void dsa_thr_item(const Params& p, int b, int qblk, char* smem) {
  unsigned* hist = (unsigned*)smem;
  unsigned* pref = (unsigned*)(smem + 32768);
  int* rank = (int*)(smem + 32768 + 128);
  const u16* tm = (const u16*)(p.ws + OFF_TM);
  const int tid = threadIdx.x, lane = tid & 63, wave = tid >> 6, lr = lane & 31, lh = lane >> 5;
  const int q0 = qblk * 32;
  u16* qi = (u16*)(smem + 33280);
  for (int i = tid; i < 32 * 32; i += 512) {
    int q = i >> 5, ch = i & 31;
    *reinterpret_cast<u32x4*>(qi + q * 296 + ch * 8) = *reinterpret_cast<const u32x4*>(tm + (size_t)(b * S_ + q0 + q) * TMW + TM_QI + ch * 8);
  }
  float wq[8];
  {
    bf16x8 w8 = ldg8(tm + (size_t)(b * S_ + q0 + lr) * TMW + TM_WI);
#pragma unroll
    for (int hd = 0; hd < 8; ++hd) wq[hd] = bf2f((u16)w8[hd]) * 0.0625f;
  }
  __syncthreads();
  for (int i = tid; i < 32 * 32; i += 512) {
    const int q = i >> 5, d = i & 31;
    float acc = 0.f;
#pragma unroll
    for (int hd = 0; hd < 8; ++hd) acc = fmaf(bf2f(tm[(size_t)(b * S_ + q0 + q) * TMW + TM_WI + hd]) * 0.0625f, bf2f(qi[q * 296 + hd * 32 + d]), acc);
    qi[q * 296 + 256 + d] = f2bf(acc);
  }
  const u16* qil = qi + lr * 296 + lh * 8;
  if (tid < 32) { pref[tid] = 0u; rank[tid] = min(256, q0 + tid + 1); }
  for (int pass = 0; pass < 4; ++pass) {
    for (int i = tid; i < 8192; i += 512) hist[i] = 0u;
    __syncthreads();
    const int shift = 24 - 8 * pass;
    const unsigned mypref = pref[lr];
    const u16* kib = (const u16*)(p.ws + OFF_KIF) + (size_t)b * 128 * 1024 + lane * 8;
    bf16x8 kn0, kn1;
    {
      const int kt0 = min(wave, qblk);
      kn0 = ldg8(kib + (size_t)kt0 * 1024); kn1 = ldg8(kib + (size_t)kt0 * 1024 + 512);
    }
    for (int kt = wave; kt <= qblk; kt += 8) {
      const bf16x8 k0 = kn0, k1 = kn1;
      {
        const int ktn = min(kt + 8, qblk);
        kn0 = ldg8(kib + (size_t)ktn * 1024); kn1 = ldg8(kib + (size_t)ktn * 1024 + 512);
      }
      float sc[16];
      {
        f32x16 a = zero16();
        a = MFMA(k0, *reinterpret_cast<const bf16x8*>(qil + 256), a);
        a = MFMA(k1, *reinterpret_cast<const bf16x8*>(qil + 256 + 16), a);
#pragma unroll
        for (int i = 0; i < 16; ++i) sc[i] = a[i];
      }
#pragma unroll
      for (int hd = 0; hd < 8; ++hd) {
        f32x16 a = zero16();
        a = MFMA(k0, *reinterpret_cast<const bf16x8*>(qil + hd * 32), a);
        a = MFMA(k1, *reinterpret_cast<const bf16x8*>(qil + hd * 32 + 16), a);
        const float wh = wq[hd];
#pragma unroll
        for (int i = 0; i < 16; ++i) sc[i] = fmaf(fabsf(a[i]), wh, sc[i]);
      }
      if (kt == qblk) {
#pragma unroll
        for (int i = 0; i < 16; ++i) {
          int kp = kt * 32 + crow(i, lh);
          unsigned ky = fkey(sc[i]);
          unsigned hi = (ky >> shift);
          if (kp <= q0 + lr && (hi >> 8) == mypref) atomicAdd(&hist[(hi & 255u) * 32 + lr], 1u);
        }
      } else {
#pragma unroll
        for (int i = 0; i < 16; ++i) {
          unsigned ky = fkey(sc[i]);
          unsigned hi = (ky >> shift);
          if ((hi >> 8) == mypref) atomicAdd(&hist[(hi & 255u) * 32 + lr], 1u);
        }
      }
    }
    __syncthreads();
#pragma unroll 1
    for (int qq = 0; qq < 4; ++qq) {
      const int q = wave * 4 + qq;
      const int rk = rank[q];
      int c[4];
#pragma unroll
      for (int j = 0; j < 4; ++j) c[j] = (int)hist[(255 - 4 * lane - j) * 32 + q];
      int s = c[0] + c[1] + c[2] + c[3];
      int P = wave_incl_scan(s, lane);
      int excl = P - s;
      if (P >= rk && excl < rk) {
        int cum = excl; int bin = 0; int nr = 1; bool found = false;
#pragma unroll
        for (int j = 0; j < 4; ++j) {
          if (!found && cum + c[j] >= rk) { bin = 255 - 4 * lane - j; nr = rk - cum; found = true; }
          if (!found) cum += c[j];
        }
        pref[q] = (pref[q] << 8) | (unsigned)bin;
        rank[q] = nr;
      }
    }
    __syncthreads();
  }
  if (tid < 32) ((unsigned*)(p.ws + OFF_THR))[b * S_ + q0 + tid] = pref[tid];
  __syncthreads();
}

DI void dsa_attn_item(const Params& p, int b, int qblk, char* smem) {
  u16* maskbuf = (u16*)smem;
  u16* qi = (u16*)(smem + 4096);
  const u16* tm = (const u16*)(p.ws + OFF_TM);
  const u16* vfr = (const u16*)(p.ws + OFF_VT) + ((size_t)(b * 8 + (threadIdx.x >> 6)) * 128) * 2048 + (threadIdx.x & 63) * 8;
  const u16* kfr = (const u16*)(p.ws + OFF_KFR) + ((size_t)(b * 8 + (threadIdx.x >> 6)) * 128) * 2048 + (threadIdx.x & 63) * 8;
  const unsigned* thr = (const unsigned*)(p.ws + OFF_THR);
  const int tid = threadIdx.x, lane = tid & 63, wave = tid >> 6, lr = lane & 31, lh = lane >> 5;
  const int q0 = qblk * 32;
  const int head = wave;
  const int qtok = b * S_ + q0 + lr;
  bf16x8 Qf[4];
#pragma unroll
  for (int ks = 0; ks < 4; ++ks) {
    bf16x8 raw = ldg8(tm + (size_t)qtok * TMW + TM_Q + head * 64 + ks * 16 + lh * 8);
    float f[8];
#pragma unroll
    for (int j = 0; j < 8; ++j) f[j] = bf2f((u16)raw[j]) * (0.125f * 1.4426950408889634f);
    Qf[ks] = pack8(f[0], f[1], f[2], f[3], f[4], f[5], f[6], f[7]);
  }
  f32x16 O[2];
  O[0] = zero16(); O[1] = zero16();
  float mrun = -INFINITY, lrun = 0.f;
  const unsigned thrq = thr[qtok];
  const int nchunks = (q0 + 31) / 256 + 1;
  for (int i = tid; i < 32 * 32; i += 512) {
    int q = i >> 5, ch = i & 31;
    *reinterpret_cast<u32x4*>(qi + q * 296 + ch * 8) = *reinterpret_cast<const u32x4*>(tm + (size_t)(b * S_ + q0 + q) * TMW + TM_QI + ch * 8);
  }
  float* wqs = (float*)(smem + 4096 + 32 * 296 * 2);
  if (tid < 256) wqs[tid] = bf2f(tm[(size_t)(b * S_ + q0 + (tid & 31)) * TMW + TM_WI + (tid >> 5)]) * 0.0625f;
  __syncthreads();
  for (int i = tid; i < 32 * 32; i += 512) {
    const int q = i >> 5, d = i & 31;
    float acc = 0.f;
#pragma unroll
    for (int hd = 0; hd < 8; ++hd) acc = fmaf(bf2f(tm[(size_t)(b * S_ + q0 + q) * TMW + TM_WI + hd]) * 0.0625f, bf2f(qi[q * 296 + hd * 32 + d]), acc);
    qi[q * 296 + 256 + d] = f2bf(acc);
  }
  __syncthreads();
  const u16* qil = qi + lr * 296 + lh * 8;
  const u16* kibase = (const u16*)(p.ws + OFF_KIF) + (size_t)b * 128 * 1024 + lane * 8;
  bf16x8 Kf[4], Kn[4];
#pragma unroll
  for (int ks = 0; ks < 4; ++ks) Kf[ks] = ldg8(kfr + ks * 512);
  bf16x8 Vf[2][2], Vn[2][2];
#pragma unroll
  for (int dt = 0; dt < 2; ++dt)
#pragma unroll
    for (int s = 0; s < 2; ++s) Vf[dt][s] = ldg8(vfr + (dt * 2 + s) * 512);
  bf16x8 ki0, ki1;
  {
    const int kt0 = min(wave, qblk);
    ki0 = ldg8(kibase + (size_t)kt0 * 1024); ki1 = ldg8(kibase + (size_t)kt0 * 1024 + 512);
  }
  for (int c = 0; c < nchunks; ++c) {
    const int buf = c & 1;
    {
      const int key0 = (c * 8 + wave) * 32;
      unsigned bits = 0u;
      const bf16x8 k0 = ki0, k1 = ki1;
      {
        const int ktn = min((c + 1) * 8 + wave, qblk);
        ki0 = ldg8(kibase + (size_t)ktn * 1024); ki1 = ldg8(kibase + (size_t)ktn * 1024 + 512);
      }
      if (key0 <= q0 + 31) {
        float sc[16];
        {
          f32x16 a = zero16();
          a = MFMA(k0, *reinterpret_cast<const bf16x8*>(qil + 256), a);
          a = MFMA(k1, *reinterpret_cast<const bf16x8*>(qil + 256 + 16), a);
#pragma unroll
          for (int i = 0; i < 16; ++i) sc[i] = a[i];
        }
#pragma unroll 2
        for (int hd = 0; hd < 8; ++hd) {
          f32x16 a = zero16();
          a = MFMA(k0, *reinterpret_cast<const bf16x8*>(qil + hd * 32), a);
          a = MFMA(k1, *reinterpret_cast<const bf16x8*>(qil + hd * 32 + 16), a);
          const float wh = wqs[hd * 32 + lr];
#pragma unroll
          for (int i = 0; i < 16; ++i) sc[i] = fmaf(fabsf(a[i]), wh, sc[i]);
        }
        __builtin_amdgcn_sched_barrier(0);
#pragma unroll
        for (int i = 0; i < 16; ++i) {
          int kp = key0 + crow(i, lh);
          if (kp <= q0 + lr && fkey(sc[i]) >= thrq) bits |= (1u << i);
        }
      }
      maskbuf[(buf * 8 + wave) * 64 + lane] = (u16)bits;
    }
    __syncthreads();
#pragma unroll 1
    for (int t8 = 0; t8 < 8; ++t8) {
      const int g = c * 8 + t8;
      if (g > qblk) break;
      {
        const int gn = min(g + 1, qblk);
        const u16* kr = kfr + (size_t)gn * 2048;
#pragma unroll
        for (int ks = 0; ks < 4; ++ks) Kn[ks] = ldg8(kr + ks * 512);
#pragma unroll
        for (int dt = 0; dt < 2; ++dt)
#pragma unroll
          for (int s = 0; s < 2; ++s) Vn[dt][s] = ldg8(vfr + (size_t)gn * 2048 + (dt * 2 + s) * 512);
      }

      const unsigned bits = maskbuf[(buf * 8 + t8) * 64 + lane];
      f32x16 Sx = zero16();
#pragma unroll
      for (int ks = 0; ks < 4; ++ks) Sx = MFMA(Kf[ks], Qf[ks], Sx);
      float sm[16];
#pragma unroll
      for (int i = 0; i < 16; ++i) {
        const unsigned t = (unsigned)__builtin_amdgcn_sbfe((int)bits, i, 1);
        sm[i] = __uint_as_float((t & __float_as_uint(Sx[i])) | (~t & 0xff800000u));
      }
      float mt = fmaxf(fmaxf(fmaxf(sm[0], sm[1]), fmaxf(sm[2], sm[3])), fmaxf(fmaxf(sm[4], sm[5]), fmaxf(sm[6], sm[7])));
      mt = fmaxf(mt, fmaxf(fmaxf(fmaxf(sm[8], sm[9]), fmaxf(sm[10], sm[11])), fmaxf(fmaxf(sm[12], sm[13]), fmaxf(sm[14], sm[15]))));
      mt = fmaxf(mt, __shfl_xor(mt, 32));
      const float mnew = fmaxf(mrun, mt);
      const float msafe = (mnew == -INFINITY) ? 0.f : mnew;
      const float alpha = __builtin_amdgcn_exp2f(mrun - msafe);
      float pv[16]; float ps = 0.f;
#pragma unroll
      for (int i = 0; i < 16; ++i) { pv[i] = __builtin_amdgcn_exp2f(sm[i] - msafe); ps += pv[i]; }
      lrun = lrun * alpha + ps;
      mrun = mnew;
      if (__builtin_amdgcn_ballot_w64(alpha != 1.f) != 0ull) {
#pragma unroll
        for (int dt = 0; dt < 2; ++dt)
#pragma unroll
          for (int i = 0; i < 16; ++i) O[dt][i] *= alpha;
      }
      bf16x8 Pf[2];
#pragma unroll
      for (int s = 0; s < 2; ++s) Pf[s] = pack8(pv[8 * s], pv[8 * s + 1], pv[8 * s + 2], pv[8 * s + 3], pv[8 * s + 4], pv[8 * s + 5], pv[8 * s + 6], pv[8 * s + 7]);
#pragma unroll
      for (int dt = 0; dt < 2; ++dt)
#pragma unroll
        for (int s = 0; s < 2; ++s) O[dt] = MFMA(Vf[dt][s], Pf[s], O[dt]);
#pragma unroll
      for (int ks = 0; ks < 4; ++ks) Kf[ks] = Kn[ks];
#pragma unroll
      for (int dt = 0; dt < 2; ++dt)
#pragma unroll
        for (int s = 0; s < 2; ++s) Vf[dt][s] = Vn[dt][s];
    }
  }
  u16* y = (u16*)(p.ws + OFF_XB);
  {
    float lt = lrun + __shfl_xor(lrun, 32);
    float inv = 1.f / lt;
#pragma unroll
    for (int dt = 0; dt < 2; ++dt)
#pragma unroll
      for (int g = 0; g < 4; ++g)
        st4bf(y + (size_t)qtok * 1024 + head * 64 + dt * 32 + 8 * g + 4 * lh, O[dt][4 * g] * inv, O[dt][4 * g + 1] * inv, O[dt][4 * g + 2] * inv, O[dt][4 * g + 3] * inv);
  }
  __syncthreads();
}

DI void gla_bcum(const Params& p, int b, int h, int n, float* bc, float* glr_s, float* segtot) {
  const u16* tm = (const u16*)(p.ws + OFF_TM);
  const int tid = threadIdx.x;
  const int tok0 = b * S_ + n * 64;
  for (int i = tid; i < 1024; i += 512) glr_s[i] = bf2f(tm[(size_t)(tok0 + (i >> 4)) * TMW + TM_GLR + (i & 15)]);
  const int d = tid & 63, cgp = tid >> 6;
  float gu[16];
#pragma unroll
  for (int j = 0; j < 16; ++j) gu[j] = p.gate_up[j * 256 + h * 64 + d];
  const float bias = p.gate_bias[h * 64 + d];
  __syncthreads();
  float v[8]; float run = 0.f;
#pragma unroll
  for (int r = 0; r < 8; ++r) {
    const int c = cgp * 8 + r;
    float z = bias;
#pragma unroll
    for (int j4 = 0; j4 < 4; ++j4) {
      const f32x4 gv = *reinterpret_cast<const f32x4*>(glr_s + c * 16 + j4 * 4);
#pragma unroll
      for (int j = 0; j < 4; ++j) z = fmaf(gv[j], gu[j4 * 4 + j], z);
    }
    float la = (fminf(z, 0.f) - __logf(1.f + __expf(-fabsf(z)))) * 0.0625f;
    run += la; v[r] = run;
  }
  segtot[cgp * 64 + d] = run;
  __syncthreads();
  float off = 0.f;
#pragma unroll
  for (int g = 0; g < 8; ++g) off += (g < cgp) ? segtot[g * 64 + d] : 0.f;
#pragma unroll
  for (int r = 0; r < 8; ++r) bc[(cgp * 8 + r) * 64 + d] = off + v[r];
  __syncthreads();
}

DI void gla_g1_item(const Params& p, int item, char* smem) {
  float* bc = (float*)smem;
  float* glr_s = (float*)(smem + 16384);
  float* segtot = (float*)(smem + 20480);
  u16* KeT = (u16*)(smem + 22528);
  const int b = item >> 8, h = (item >> 6) & 3, n = item & 63;
  const u16* tm = (const u16*)(p.ws + OFF_TM);
  const u16* gvT = (const u16*)(p.ws + OFF_GVT);
  const int tid = threadIdx.x, lane = tid & 63, wave = tid >> 6, lr = lane & 31, lh = lane >> 5;
  const int tok0 = b * S_ + n * 64;
  u16 kraw[8];
  {
    const int d = tid & 63, cgp = tid >> 6;
#pragma unroll
    for (int r = 0; r < 8; ++r) kraw[r] = tm[(size_t)(tok0 + cgp * 8 + r) * TMW + TM_GK + h * 64 + d];
  }
  bf16x8 afr[4];
  {
    const int et = wave & 3;
    const u16* arow = gvT + ((size_t)b * 512 + h * 128 + et * 32 + lr) * 4096 + n * 64 + lh * 8;
#pragma unroll
    for (int ks = 0; ks < 4; ++ks) afr[ks] = ldg8(arow + ks * 16);
  }
  gla_bcum(p, b, h, n, bc, glr_s, segtot);
  {
    const int d = tid & 63, cgp = tid >> 6;
    const float blast = bc[63 * 64 + d];
    {
      float* bcg = (float*)(p.ws + OFF_BCG) + (size_t)item * 4096;
#pragma unroll
      for (int r = 0; r < 8; ++r) bcg[(cgp * 8 + r) * 64 + d] = bc[(cgp * 8 + r) * 64 + d];
    }
    float f[8];
#pragma unroll
    for (int r = 0; r < 8; ++r) {
      const int c = cgp * 8 + r;
      float kv = bf2f(kraw[r]);
      f[r] = kv * __expf(blast - bc[c * 64 + d]);
    }
    *reinterpret_cast<bf16x8*>(KeT + d * 72 + cgp * 8) = pack8(f[0], f[1], f[2], f[3], f[4], f[5], f[6], f[7]);
    if (cgp == 0) ((float*)(p.ws + OFF_DECAY))[item * 64 + d] = __expf(blast);
  }
  __syncthreads();
  {
    const int et = wave & 3, dtl = wave >> 2;
    f32x16 acc = zero16();
#pragma unroll
    for (int ks = 0; ks < 4; ++ks) {
      bf16x8 a = afr[ks];
      bf16x8 bb = *reinterpret_cast<const bf16x8*>(KeT + (dtl * 32 + lr) * 72 + ks * 16 + lh * 8);
      acc = MFMA(a, bb, acc);
    }
    float* kvT = (float*)(p.ws + OFF_KVT);
#pragma unroll
    for (int i = 0; i < 16; ++i) kvT[((size_t)item * 128 + et * 32 + crow(i, lh)) * 64 + dtl * 32 + lr] = acc[i];
  }
  __syncthreads();
}

DI void gla_scan(const Params& p) {
  const float* kvT = (const float*)(p.ws + OFF_KVT);
  const float* decay = (const float*)(p.ws + OFF_DECAY);
  u16* prev = (u16*)(p.ws + OFF_PREV);
  const int gtid = blockIdx.x * blockDim.x + threadIdx.x;
  const int gn = gridDim.x * blockDim.x;
  for (int u = gtid; u < 32 * 2048; u += gn) {
    const int bh = u >> 11, rem = u & 2047, e = rem >> 4, d4 = (rem & 15) * 4;
    f32x4 st = {0.f, 0.f, 0.f, 0.f};
#pragma unroll 4
    for (int n = 0; n < 64; ++n) {
      const int item = bh * 64 + n;
      st4bf(prev + ((size_t)item * 128 + e) * 64 + d4, st[0], st[1], st[2], st[3]);
      f32x4 dc = *reinterpret_cast<const f32x4*>(decay + item * 64 + d4);
      f32x4 kv = *reinterpret_cast<const f32x4*>(kvT + ((size_t)item * 128 + e) * 64 + d4);
      st = dc * st + kv;
    }
  }
}

DI void gla_g3_item(const Params& p, int item, char* smem) {
  float* red = (float*)smem;
  const int b = item >> 8, h = (item >> 6) & 3, n = item & 63;
  const u16* tm = (const u16*)(p.ws + OFF_TM);
  const u16* gvT = (const u16*)(p.ws + OFF_GVT);
  const u16* prev = (const u16*)(p.ws + OFF_PREV);
  const float* bcg = (const float*)(p.ws + OFF_BCG) + (size_t)item * 4096;
  const int tid = threadIdx.x, lane = tid & 63, wave = tid >> 6, lr = lane & 31, lh = lane >> 5;
  const int tok0 = b * S_ + n * 64;
  const int et = wave & 3, ct = wave >> 2;
  bf16x8 qraw[4], kraw[2][4], sfr[4];
  bf16x4 vlo[2][2], vhi[2][2];
  f32x4 bq[4][2];
  {
    const u16* vrow0 = gvT + ((size_t)b * 512 + h * 128 + et * 32 + lr) * 4096 + n * 64 + 4 * lh;
    const u16* srow0 = prev + ((size_t)item * 128 + et * 32 + lr) * 64 + lh * 8;
#pragma unroll
    for (int ks = 0; ks < 4; ++ks) {
      qraw[ks] = ldg8(tm + (size_t)(tok0 + ct * 32 + lr) * TMW + TM_GQ + h * 64 + ks * 16 + lh * 8);
      kraw[0][ks] = ldg8(tm + (size_t)(tok0 + lr) * TMW + TM_GK + h * 64 + ks * 16 + lh * 8);
      kraw[1][ks] = ldg8(tm + (size_t)(tok0 + ct * 32 + lr) * TMW + TM_GK + h * 64 + ks * 16 + lh * 8);
      sfr[ks] = ldg8(srow0 + ks * 16);
      bq[ks][0] = *reinterpret_cast<const f32x4*>(bcg + (ct * 32 + lr) * 64 + ks * 16 + lh * 8);
      bq[ks][1] = *reinterpret_cast<const f32x4*>(bcg + (ct * 32 + lr) * 64 + ks * 16 + lh * 8 + 4);
    }
#pragma unroll
    for (int st = 0; st < 2; ++st)
#pragma unroll
      for (int s2 = 0; s2 < 2; ++s2) {
        const u16* vp = vrow0 + (st * ct) * 32 + 16 * s2;
        vlo[st][s2] = *reinterpret_cast<const bf16x4*>(vp);
        vhi[st][s2] = *reinterpret_cast<const bf16x4*>(vp + 8);
      }
  }
  bf16x8 Qd[4];
#pragma unroll
  for (int ks = 0; ks < 4; ++ks) {
    float f[8];
#pragma unroll
    for (int j = 0; j < 8; ++j) f[j] = bf2f((u16)qraw[ks][j]) * 0.125f * __expf(bq[ks][j >> 2][j & 3]);
    Qd[ks] = pack8(f[0], f[1], f[2], f[3], f[4], f[5], f[6], f[7]);
  }
  f32x16 O = zero16();
#pragma unroll
  for (int st = 0; st < 2; ++st) {
    if (st <= ct) {
      f32x16 A = zero16();
      const int s = st * 32 + lr;
#pragma unroll
      for (int ks = 0; ks < 4; ++ks) {
        f32x4 b0 = (st == 1) ? bq[ks][0] : *reinterpret_cast<const f32x4*>(bcg + s * 64 + ks * 16 + lh * 8);
        f32x4 b1 = (st == 1) ? bq[ks][1] : *reinterpret_cast<const f32x4*>(bcg + s * 64 + ks * 16 + lh * 8 + 4);
        float f[8];
#pragma unroll
        for (int j = 0; j < 8; ++j) f[j] = bf2f((u16)kraw[st][ks][j]) * __expf(-((j < 4) ? b0[j & 3] : b1[j & 3]));
        bf16x8 Ki = pack8(f[0], f[1], f[2], f[3], f[4], f[5], f[6], f[7]);
        A = MFMA(Ki, Qd[ks], A);
      }
      float pv[16];
#pragma unroll
      for (int i = 0; i < 16; ++i) pv[i] = (st * 32 + crow(i, lh) <= ct * 32 + lr) ? A[i] : 0.f;
#pragma unroll
      for (int s2 = 0; s2 < 2; ++s2) {
        bf16x8 Pf = pack8(pv[8 * s2], pv[8 * s2 + 1], pv[8 * s2 + 2], pv[8 * s2 + 3], pv[8 * s2 + 4], pv[8 * s2 + 5], pv[8 * s2 + 6], pv[8 * s2 + 7]);
        O = MFMA(cat44(vlo[st][s2], vhi[st][s2]), Pf, O);
      }
    }
  }
#pragma unroll
  for (int ks = 0; ks < 4; ++ks) O = MFMA(sfr[ks], Qd[ks], O);
  float ss = 0.f;
#pragma unroll
  for (int i = 0; i < 16; ++i) ss += O[i] * O[i];
  ss += __shfl_xor(ss, 32);
  if (lh == 0) red[(ct * 4 + et) * 32 + lr] = ss;
  __syncthreads();
  const float tot = red[(ct * 4 + 0) * 32 + lr] + red[(ct * 4 + 1) * 32 + lr] + red[(ct * 4 + 2) * 32 + lr] + red[(ct * 4 + 3) * 32 + lr];
  const float rinv = rsqrtf(tot * (1.f / 128.f) + 1e-6f);
  const int tok = tok0 + ct * 32 + lr;
  u16* y = (u16*)(p.ws + OFF_XB);
#pragma unroll
  for (int g = 0; g < 4; ++g) {
    const int e0 = et * 32 + 8 * g + 4 * lh;
    u32x2 gr = *reinterpret_cast<const u32x2*>(tm + (size_t)tok * TMW + TM_GR + h * 128 + e0);
    f32x4 ng = *reinterpret_cast<const f32x4*>(p.norm_g + e0);
    float grv[4] = {bflo(gr[0]), bfhi(gr[0]), bflo(gr[1]), bfhi(gr[1])};
    float o[4];
#pragma unroll
    for (int r = 0; r < 4; ++r) {
      float sl = grv[r] / (1.f + __expf(-grv[r]));
      o[r] = O[4 * g + r] * rinv * ng[r] * sl;
    }
    st4bf(y + (size_t)tok * 1024 + 512 + h * 128 + e0, o[0], o[1], o[2], o[3]);
  }
  __syncthreads();
}

template <int MODE>
DI void phase_gemm(const Params& p, const u16* X, const u16* Wt, int N, const float* resid, float* outf, u16* outb, int ldo, char* smem) {
  const int ntn = N / 128;
  const int total = 128 * ntn;
  const int tid = threadIdx.x, lane = tid & 63, wave = tid >> 6;
  const int fw = wave & 1, tq = wave >> 1, lr = lane & 31, lh = lane >> 5;
  for (int t = blockIdx.x; t < total; t += gridDim.x) {
    const int mt = t / ntn, nt = t % ntn;
    f32x16 acc[2][2];
    gemm_tile(X + (size_t)mt * 256 * 1024, 1024, Wt + (size_t)nt * 128 * 1024, 1024, 1024, smem, acc);
    if (MODE == 0 || MODE == 1) {
      float* wl = (float*)(smem + wave * 17408);
#pragma unroll
      for (int tt = 0; tt < 2; ++tt)
#pragma unroll
        for (int ft = 0; ft < 2; ++ft)
#pragma unroll
          for (int g = 0; g < 4; ++g) {
            f32x4 v = {acc[ft][tt][4 * g], acc[ft][tt][4 * g + 1], acc[ft][tt][4 * g + 2], acc[ft][tt][4 * g + 3]};
            *reinterpret_cast<f32x4*>(wl + (tt * 32 + lr) * 68 + ft * 32 + 8 * g + 4 * lh) = v;
          }
      const int ch = lane & 15, r0 = lane >> 4;
      const int f = nt * 128 + fw * 64 + ch * 4;
#pragma unroll 4
      for (int k = 0; k < 16; ++k) {
        const int row = r0 + 4 * k;
        const int tok = mt * 256 + tq * 64 + row;
        f32x4 v = *reinterpret_cast<const f32x4*>(wl + row * 68 + ch * 4);
        if (MODE == 0) {
          f32x4 r = *reinterpret_cast<const f32x4*>(resid + (size_t)tok * 1024 + f);
          f32x4 o;
#pragma unroll
          for (int j = 0; j < 4; ++j) o[j] = ALPHA * r[j] + v[j];
          *reinterpret_cast<f32x4*>(outf + (size_t)tok * 1024 + f) = o;
        } else {
          st4bf(outb + (size_t)tok * ldo + f, v[0], v[1], v[2], v[3]);
        }
      }
      __syncthreads();
    } else {
#pragma unroll
      for (int tt = 0; tt < 2; ++tt) {
        const int tok = mt * 256 + tq * 64 + tt * 32 + lr;
#pragma unroll
        for (int ft = 0; ft < 2; ++ft)
#pragma unroll
          for (int g = 0; g < 4; ++g) {
            const int f = nt * 128 + fw * 64 + ft * 32 + 8 * g + 4 * lh;
            if (MODE == 2) {
              const int hh = f >> 8, fh = f & 255, ks = fh >> 4, lane2 = ((fh >> 3) & 1) * 32 + lr;
              st4bf(outb + ((((size_t)(tok >> 5) * 4 + hh) * 16 + ks) * 64 + lane2) * 8 + 4 * lh, acc[ft][tt][4 * g], acc[ft][tt][4 * g + 1], acc[ft][tt][4 * g + 2], acc[ft][tt][4 * g + 3]);
            } else {
              const int hh = f >> 8, fq = f & 127, half = (f >> 7) & 1, ks = fq >> 4, lane2 = ((fq >> 3) & 1) * 32 + lr;
              st4bf(outb + (((((size_t)(tok >> 5) * 8 + hh) * 2 + half) * 8 + ks) * 64 + lane2) * 8 + 4 * lh, acc[ft][tt][4 * g], acc[ft][tt][4 * g + 1], acc[ft][tt][4 * g + 2], acc[ft][tt][4 * g + 3]);
            }
          }
      }
    }
  }
}

DI void phase_ln(const Params& p, float* h, u16* hb, const float* g, const float* bta) {
  const int lane = threadIdx.x & 63;
  const int gw = (blockIdx.x * blockDim.x + threadIdx.x) >> 6;
  const int nw = (gridDim.x * blockDim.x) >> 6;
  for (int row = gw; row < T_; row += nw) {
    float* r = h + (size_t)row * 1024;
    f32x4 v[4]; float s = 0.f;
#pragma unroll
    for (int c = 0; c < 4; ++c) { v[c] = *reinterpret_cast<const f32x4*>(r + c * 256 + lane * 4); s += v[c][0] + v[c][1] + v[c][2] + v[c][3]; }
    const float mean = wave_sum(s) * (1.f / 1024.f);
    float q = 0.f;
#pragma unroll
    for (int c = 0; c < 4; ++c)
#pragma unroll
      for (int k = 0; k < 4; ++k) { float d = v[c][k] - mean; q += d * d; }
    const float rstd = rsqrtf(wave_sum(q) * (1.f / 1024.f) + 1e-5f);
#pragma unroll
    for (int c = 0; c < 4; ++c) {
      f32x4 gg = *reinterpret_cast<const f32x4*>(g + c * 256 + lane * 4);
      f32x4 bb = *reinterpret_cast<const f32x4*>(bta + c * 256 + lane * 4);
      f32x4 o;
#pragma unroll
      for (int k = 0; k < 4; ++k) o[k] = (v[c][k] - mean) * rstd * gg[k] + bb[k];
      *reinterpret_cast<f32x4*>(r + c * 256 + lane * 4) = o;
      st4bf(hb + (size_t)row * 1024 + c * 256 + lane * 4, o[0], o[1], o[2], o[3]);
    }
  }
}

DI void phase_xattn(const Params& p) {
  const u16* qx = (const u16*)(p.ws + OFF_QX);
  const u16* mk = (const u16*)(p.ws + OFF_MEMK);
  const u16* mv = (const u16*)(p.ws + OFF_MEMVT);
  u16* ox = (u16*)(p.ws + OFF_OX);
  const int lane = threadIdx.x & 63, lr = lane & 31, lh = lane >> 5;
  const int gw = (blockIdx.x * blockDim.x + threadIdx.x) >> 6;
  const int nw = (gridDim.x * blockDim.x) >> 6;
  for (int it = gw; it < 8 * 4 * 128; it += nw) {
    const int qt = it & 127, h = (it >> 7) & 3, b = it >> 9;
    const int tok = b * S_ + qt * 32 + lr;
    f32x16 Sx[8];
#pragma unroll
    for (int kt = 0; kt < 8; ++kt) Sx[kt] = zero16();
    const u16* qrow = qx + (((size_t)(b * 128 + qt) * 4 + h) * 16) * 512 + lane * 8;
    const u16* krow = mk + (((size_t)(b * 4 + h) * 8) * 16) * 512 + lane * 8;
#pragma unroll 2
    for (int ks = 0; ks < 16; ++ks) {
      bf16x8 qf = ldg8(qrow + ks * 512);
#pragma unroll
      for (int kt = 0; kt < 8; ++kt) Sx[kt] = MFMA(ldg8(krow + (kt * 16 + ks) * 512), qf, Sx[kt]);
    }
    float mx = -INFINITY;
#pragma unroll
    for (int kt = 0; kt < 8; ++kt)
#pragma unroll
      for (int i = 0; i < 16; ++i) mx = fmaxf(mx, Sx[kt][i]);
    mx = fmaxf(mx, __shfl_xor(mx, 32));
    float ls = 0.f;
    bf16x8 Pf[8][2];
#pragma unroll
    for (int kt = 0; kt < 8; ++kt) {
      float pv[16];
#pragma unroll
      for (int i = 0; i < 16; ++i) { pv[i] = __expf((Sx[kt][i] - mx) * 0.0625f); ls += pv[i]; }
#pragma unroll
      for (int s = 0; s < 2; ++s) Pf[kt][s] = pack8(pv[8 * s], pv[8 * s + 1], pv[8 * s + 2], pv[8 * s + 3], pv[8 * s + 4], pv[8 * s + 5], pv[8 * s + 6], pv[8 * s + 7]);
    }
    ls += __shfl_xor(ls, 32);
    const float inv = 1.f / ls;
#pragma unroll 1
    for (int dt = 0; dt < 8; ++dt) {
      f32x16 o = zero16();
      const u16* vrow = mv + ((((size_t)(b * 4 + h) * 8 + dt) * 8) * 2) * 512 + lane * 8;
#pragma unroll
      for (int kt = 0; kt < 8; ++kt)
#pragma unroll
        for (int s = 0; s < 2; ++s) o = MFMA(ldg8(vrow + (kt * 2 + s) * 512), Pf[kt][s], o);
#pragma unroll
      for (int g = 0; g < 4; ++g)
        st4bf(ox + (size_t)tok * 1024 + h * 256 + dt * 32 + 8 * g + 4 * lh, o[4 * g] * inv, o[4 * g + 1] * inv, o[4 * g + 2] * inv, o[4 * g + 3] * inv);
    }
  }
}

DI void peer_topk_item(const Params& p, int tt128, int head, char* smem) {
  float* sc = (float*)smem;
  float* topv = (float*)(smem + 132096);
  unsigned char* topi = (unsigned char*)(smem + 132096 + 16384);
  const u16* pq = (const u16*)(p.ws + OFF_QX);
  const u16* sk = (const u16*)(p.ws + OFF_SK);
  const int tid = threadIdx.x, lane = tid & 63, wave = tid >> 6, lr = lane & 31, lh = lane >> 5;
  const int tok0 = tt128 * 128;
  {
    const int half = wave >> 2, kt = wave & 3;
    bf16x8 af[8];
#pragma unroll
    for (int ks = 0; ks < 8; ++ks) af[ks] = ldg8(sk + (size_t)half * 16384 + (kt * 32 + lr) * 128 + ks * 16 + lh * 8);
#pragma unroll 1
    for (int tt = 0; tt < 4; ++tt) {
      f32x16 acc = zero16();
      const u16* brow = pq + (((((size_t)(tok0 >> 5) + tt) * 8 + head) * 2 + half) * 8) * 512 + lane * 8;
#pragma unroll
      for (int ks = 0; ks < 8; ++ks) acc = MFMA(af[ks], ldg8(brow + ks * 512), acc);
#pragma unroll
      for (int i = 0; i < 16; ++i) sc[(half * 128 + tt * 32 + lr) * 129 + kt * 32 + crow(i, lh)] = acc[i];
    }
  }
  __syncthreads();
  if (tid < 256) {
    float* row = sc + tid * 129;
    float gm[8]; int gi[8];
#pragma unroll
    for (int g = 0; g < 8; ++g) {
      float m = -INFINITY; int mi = g * 16;
#pragma unroll
      for (int j = 0; j < 16; ++j) { float v = row[g * 16 + j]; if (v > m) { m = v; mi = g * 16 + j; } }
      gm[g] = m; gi[g] = mi;
    }
#pragma unroll 1
    for (int r = 0; r < 16; ++r) {
      float best = gm[0]; int bg = 0; int bi = gi[0];
#pragma unroll
      for (int g = 1; g < 8; ++g) if (gm[g] > best) { best = gm[g]; bg = g; bi = gi[g]; }
      topv[tid * 16 + r] = best; topi[tid * 16 + r] = (unsigned char)bi;
      row[bi] = -INFINITY;
      float m = -INFINITY; int mi = bg * 16;
#pragma unroll
      for (int j = 0; j < 16; ++j) { float v = row[bg * 16 + j]; if (v > m) { m = v; mi = bg * 16 + j; } }
#pragma unroll
      for (int g = 0; g < 8; ++g) { gm[g] = (g == bg) ? m : gm[g]; gi[g] = (g == bg) ? mi : gi[g]; }
    }
  }
  __syncthreads();
  if (tid < 128) {
    const float* av = topv + tid * 16;
    const float* bv = topv + (128 + tid) * 16;
    const unsigned char* ai = topi + tid * 16;
    const unsigned char* bi_ = topi + (128 + tid) * 16;
    float cur[16]; int pp[16];
    const float b0 = bv[0];
#pragma unroll
    for (int i = 0; i < 16; ++i) { cur[i] = av[i] + b0; pp[i] = 0; }
    float sel[16]; int eid[16];
#pragma unroll
    for (int r = 0; r < 16; ++r) {
      float best = cur[0]; int bi = 0; int bj = pp[0];
#pragma unroll
      for (int i = 1; i < 16; ++i) if (cur[i] > best) { best = cur[i]; bi = i; bj = pp[i]; }
      sel[r] = best;
      eid[r] = (int)ai[bi] * 128 + (int)bi_[bj];
      const int nj = bj + 1;
      const float nv = (nj < 16) ? (av[bi] + bv[nj & 15]) : -INFINITY;
#pragma unroll
      for (int i = 0; i < 16; ++i) { cur[i] = (i == bi) ? nv : cur[i]; pp[i] = (i == bi) ? nj : pp[i]; }
    }
    float sum = 0.f;
    const float smax = sel[0];
#pragma unroll
    for (int r = 0; r < 16; ++r) { sel[r] = __expf(sel[r] - smax); sum += sel[r]; }
    const float inv = 1.f / sum;
    int* eo = (int*)(p.ws + OFF_EIDX) + (size_t)(tok0 + tid) * 128 + head * 16;
    float* go = (float*)(p.ws + OFF_GATE) + (size_t)(tok0 + tid) * 128 + head * 16;
#pragma unroll
    for (int r = 0; r < 16; ++r) { eo[r] = eid[r]; go[r] = sel[r] * inv; }
  }
  __syncthreads();
}

DI float dot2bf(unsigned a, unsigned b, float c) {
  return __builtin_amdgcn_fdot2_f32_bf16(__builtin_bit_cast(bf2_t, a), __builtin_bit_cast(bf2_t, b), c, false);
}

DI float reduce8(float (&part)[8], int lane) {
  float r4[4], r2[2], r1;
#pragma unroll
  for (int k = 0; k < 4; ++k) {
    float send = (lane & 1) ? part[2 * k] : part[2 * k + 1];
    float keep = (lane & 1) ? part[2 * k + 1] : part[2 * k];
    r4[k] = keep + __shfl_xor(send, 1);
  }
#pragma unroll
  for (int k = 0; k < 2; ++k) {
    float send = (lane & 2) ? r4[2 * k] : r4[2 * k + 1];
    float keep = (lane & 2) ? r4[2 * k + 1] : r4[2 * k];
    r2[k] = keep + __shfl_xor(send, 2);
  }
  {
    float send = (lane & 4) ? r2[0] : r2[1];
    float keep = (lane & 4) ? r2[1] : r2[0];
    r1 = keep + __shfl_xor(send, 4);
  }
  r1 += __shfl_xor(r1, 8);
  r1 += __shfl_xor(r1, 16);
  r1 += __shfl_xor(r1, 32);
  return r1;
}

DI void phase_peer_down(const Params& p) {
  const char* exd = p.ws + OFF_EXD;
  const float* esc = (const float*)(p.ws + OFF_ESC);
  const u16* hb = (const u16*)(p.ws + OFF_HB);
  const int* eidx = (const int*)(p.ws + OFF_EIDX);
  const float* gate = (const float*)(p.ws + OFF_GATE);
  float* coefw = (float*)(p.ws + OFF_COEF);
  const int lane = threadIdx.x & 63;
  const int gw = (blockIdx.x * blockDim.x + threadIdx.x) >> 6;
  const int nw = (gridDim.x * blockDim.x) >> 6;
#pragma unroll 1
  for (int sl = 0; sl < 2; ++sl) {
#pragma unroll 1
    for (int tok = gw; tok < T_; tok += nw) {
      float x[16];
      {
        const u16* xr = hb + (size_t)tok * 1024 + lane * 16;
        u32x4 a = *reinterpret_cast<const u32x4*>(xr);
        u32x4 c = *reinterpret_cast<const u32x4*>(xr + 8);
#pragma unroll
        for (int w = 0; w < 4; ++w) { x[2 * w] = bflo(a[w]); x[2 * w + 1] = bfhi(a[w]); x[8 + 2 * w] = bflo(c[w]); x[8 + 2 * w + 1] = bfhi(c[w]); }
      }
#pragma unroll 1
      for (int half = 0; half < 2; ++half) {
        const int ev = eidx[(size_t)tok * 128 + half * 64 + lane];
        const float gv = gate[(size_t)tok * 128 + half * 64 + lane];
        unsigned long long m = __builtin_amdgcn_ballot_w64((ev >> 13) == sl);
        float racc = 0.f, gacc = 0.f; int pacc = -1; int bi = 0;
        while (m != 0ull) {
          int pos[8];
          const int first = __builtin_ctzll(m);
#pragma unroll
          for (int k = 0; k < 8; ++k) {
            if (m != 0ull) { pos[k] = __builtin_ctzll(m); m &= m - 1ull; } else pos[k] = -1;
          }
          u32x4 dr[8];
#pragma unroll
          for (int k = 0; k < 8; ++k) {
            const int er = __builtin_amdgcn_readlane(ev, pos[k] >= 0 ? pos[k] : first);
            dr[k] = *reinterpret_cast<const u32x4*>(exd + (size_t)er * 1024 + lane * 16);
          }
          int pmine = pos[0];
#pragma unroll
          for (int k = 1; k < 8; ++k) pmine = ((lane & 7) == k) ? pos[k] : pmine;
          const int psafe = pmine >= 0 ? pmine : first;
          const int emine = __shfl(ev, psafe);
          const float gsel = __shfl(gv, psafe);
          const float sd = esc[emine];
          const float su = esc[16384 + emine];
          float part[8];
#pragma unroll
          for (int k = 0; k < 8; ++k) {
            float a0 = 0.f, a1 = 0.f;
#pragma unroll
            for (int w = 0; w < 4; ++w) {
              f2_t lo = __builtin_amdgcn_cvt_pk_f32_fp8((int)dr[k][w], false);
              f2_t hi = __builtin_amdgcn_cvt_pk_f32_fp8((int)dr[k][w], true);
              a0 = fmaf(lo[0], x[4 * w], a0); a1 = fmaf(lo[1], x[4 * w + 1], a1);
              a0 = fmaf(hi[0], x[4 * w + 2], a0); a1 = fmaf(hi[1], x[4 * w + 3], a1);
            }
            part[k] = a0 + a1;
          }
          const float r1 = reduce8(part, lane) * sd;
          const bool mine = (lane >> 3) == bi;
          racc = mine ? r1 : racc; gacc = mine ? gsel * su : gacc; pacc = mine ? pmine : pacc;
          ++bi;
          if (bi == 8 || m == 0ull) {
            const float act = 0.5f * racc * (1.f + erff(racc * 0.70710678118654752f));
            if (pacc >= 0) coefw[(size_t)tok * 128 + half * 64 + pacc] = gacc * act;
            pacc = -1; bi = 0;
          }
        }
      }
    }
  }
}

DI void phase_peer_ffn(const Params& p) {
  const char* exu = p.ws + OFF_EXU;
  const float* h = (const float*)(p.ws + OFF_H);
  const int* eidx = (const int*)(p.ws + OFF_EIDX);
  const float* coefw = (const float*)(p.ws + OFF_COEF);
  const int lane = threadIdx.x & 63;
  const int gw = (blockIdx.x * blockDim.x + threadIdx.x) >> 6;
  const int nw = (gridDim.x * blockDim.x) >> 6;
  for (int tok = gw; tok < T_; tok += nw) {
    float yacc[16];
#pragma unroll
    for (int i = 0; i < 16; ++i) yacc[i] = 0.f;
    const int e_lo = eidx[(size_t)tok * 128 + lane];
    const int e_hi = eidx[(size_t)tok * 128 + 64 + lane];
    const float c_lo = coefw[(size_t)tok * 128 + lane];
    const float c_hi = coefw[(size_t)tok * 128 + 64 + lane];
#pragma unroll 1
    for (int eb = 0; eb < 8; ++eb) {
      const int ev = (eb < 4) ? e_lo : e_hi;
      const float cv = (eb < 4) ? c_lo : c_hi;
      const int lbase = (eb & 3) * 16;
      u32x4 ur[16];
#pragma unroll
      for (int k = 0; k < 16; ++k) {
        const int er = __builtin_amdgcn_readlane(ev, lbase + k);
        ur[k] = *reinterpret_cast<const u32x4*>(exu + (size_t)er * 1024 + lane * 16);
      }
#pragma unroll
      for (int k = 0; k < 16; ++k) {
        const float ck = __int_as_float(__builtin_amdgcn_readlane(__float_as_int(cv), lbase + k));
#pragma unroll
        for (int w = 0; w < 4; ++w) {
          f2_t lo = __builtin_amdgcn_cvt_pk_f32_fp8((int)ur[k][w], false);
          f2_t hi = __builtin_amdgcn_cvt_pk_f32_fp8((int)ur[k][w], true);
          yacc[4 * w] = fmaf(ck, lo[0], yacc[4 * w]);
          yacc[4 * w + 1] = fmaf(ck, lo[1], yacc[4 * w + 1]);
          yacc[4 * w + 2] = fmaf(ck, hi[0], yacc[4 * w + 2]);
          yacc[4 * w + 3] = fmaf(ck, hi[1], yacc[4 * w + 3]);
        }
      }
    }
    const float* xr = h + (size_t)tok * 1024 + lane * 16;
    float v[16];
#pragma unroll
    for (int c = 0; c < 4; ++c) {
      f32x4 t = *reinterpret_cast<const f32x4*>(xr + c * 4);
#pragma unroll
      for (int k = 0; k < 4; ++k) v[4 * c + k] = ALPHA * t[k] + yacc[4 * c + k];
    }
    float s = 0.f;
#pragma unroll
    for (int i = 0; i < 16; ++i) s += v[i];
    const float mean = wave_sum(s) * (1.f / 1024.f);
    float q = 0.f;
#pragma unroll
    for (int i = 0; i < 16; ++i) { float d = v[i] - mean; q += d * d; }
    const float rstd = rsqrtf(wave_sum(q) * (1.f / 1024.f) + 1e-5f);
    float* orow = p.out + (size_t)tok * 1024 + lane * 16;
#pragma unroll
    for (int c = 0; c < 4; ++c) {
      f32x4 gg = *reinterpret_cast<const f32x4*>(p.ln_ffn_g + lane * 16 + c * 4);
      f32x4 bb = *reinterpret_cast<const f32x4*>(p.ln_ffn_b + lane * 16 + c * 4);
      f32x4 o;
#pragma unroll
      for (int k = 0; k < 4; ++k) o[k] = (v[4 * c + k] - mean) * rstd * gg[k] + bb[k];
      *reinterpret_cast<f32x4*>(orow + c * 4) = o;
    }
  }
}

constexpr size_t OFF_BAR = 166 * MiB;
DI void gbar(unsigned* ctr, unsigned target) {
  asm volatile("s_waitcnt vmcnt(0)" ::: "memory");
  __syncthreads();
  if (threadIdx.x == 0) {
    __builtin_amdgcn_fence(__ATOMIC_RELEASE, "agent");
    asm volatile("s_waitcnt vmcnt(0)" ::: "memory");
    __hip_atomic_fetch_add(ctr, 1u, __ATOMIC_RELAXED, __HIP_MEMORY_SCOPE_AGENT);
    while (__hip_atomic_load(ctr, __ATOMIC_RELAXED, __HIP_MEMORY_SCOPE_AGENT) < target) __builtin_amdgcn_s_sleep(2);
    __builtin_amdgcn_fence(__ATOMIC_ACQUIRE, "agent");
    asm volatile("s_waitcnt vmcnt(0)" ::: "memory");
  }
  __syncthreads();
}

__global__ void __launch_bounds__(512) fwd_megakernel(Params p) {
  __shared__ __attribute__((aligned(1024))) char smem[155648];
  cg::grid_group grid = cg::this_grid();
  const int G = gridDim.x;
  char* ws = p.ws;
  unsigned* bar = (unsigned*)(ws + OFF_BAR);

  phase_prep(p, smem);
  grid.sync();

  phase_inproj(p, smem);
  gbar(bar, (unsigned)(1 * G));

  for (int k = 0; k * G < 1024; ++k) {
    int j = (k & 1) ? (G - 1 - (int)blockIdx.x) : (int)blockIdx.x;
    int idx = k * G + j;
    if (idx < 1024) dsa_thr_item(p, idx & 7, 127 - (idx >> 3), smem);
  }
  for (int it = blockIdx.x; it < 2048; it += G) gla_g1_item(p, it, smem);
  gbar(bar, (unsigned)(2 * G));

  for (int k = 0; k * G < 1024; ++k) {
    int j = (k & 1) ? (G - 1 - (int)blockIdx.x) : (int)blockIdx.x;
    int idx = k * G + j;
    if (idx < 1024) dsa_attn_item(p, idx & 7, 127 - (idx >> 3), smem);
  }
  gla_scan(p);
  gbar(bar, (unsigned)(3 * G));

  for (int it = blockIdx.x; it < 2048; it += G) gla_g3_item(p, it, smem);
  gbar(bar, (unsigned)(4 * G));

  phase_gemm<0>(p, (const u16*)(ws + OFF_XB), (const u16*)(ws + OFF_WOUT), 1024, p.x, (float*)(ws + OFF_H), nullptr, 0, smem);
  gbar(bar, (unsigned)(5 * G));
  phase_ln(p, (float*)(ws + OFF_H), (u16*)(ws + OFF_HB), p.ln_mix_g, p.ln_mix_b);
  gbar(bar, (unsigned)(6 * G));

  phase_gemm<2>(p, (const u16*)(ws + OFF_HB), (const u16*)(ws + OFF_WQ), 1024, nullptr, nullptr, (u16*)(ws + OFF_QX), 1024, smem);
  gbar(bar, (unsigned)(7 * G));
  phase_xattn(p);
  gbar(bar, (unsigned)(8 * G));
  phase_gemm<0>(p, (const u16*)(ws + OFF_OX), (const u16*)(ws + OFF_WO), 1024, (const float*)(ws + OFF_H), (float*)(ws + OFF_H), nullptr, 0, smem);
  gbar(bar, (unsigned)(9 * G));
  phase_ln(p, (float*)(ws + OFF_H), (u16*)(ws + OFF_HB), p.ln_mem_g, p.ln_mem_b);
  gbar(bar, (unsigned)(10 * G));

  phase_gemm<5>(p, (const u16*)(ws + OFF_HB), (const u16*)(ws + OFF_WPQ), 2048, nullptr, nullptr, (u16*)(ws + OFF_QX), 2048, smem);
  gbar(bar, (unsigned)(11 * G));
  for (int it = blockIdx.x; it < 2048; it += G) peer_topk_item(p, it >> 3, it & 7, smem);
  gbar(bar, (unsigned)(12 * G));
  phase_peer_down(p);
  gbar(bar, (unsigned)(13 * G));
  phase_peer_ffn(p);
}

extern "C" void kernel_launch(void* const* d_in, const int* in_sizes, int n_in,
                              void* d_out, int out_size, void* d_ws, size_t ws_size,
                              hipStream_t stream) {
  static int grid_blocks = 0;
  if (!grid_blocks) {
    int dev = 0, cus = 0, per_cu = 0;
    (void)hipGetDevice(&dev);
    (void)hipDeviceGetAttribute(&cus, hipDeviceAttributeMultiprocessorCount, dev);
    (void)hipOccupancyMaxActiveBlocksPerMultiprocessor(&per_cu, fwd_megakernel, 512, 0);
    if (per_cu > 1) per_cu = 1;
    grid_blocks = cus * per_cu;
    if (grid_blocks > 256) grid_blocks = 256;
    if (ws_size < 512 * MiB) fprintf(stderr, "workspace too small: %zu\n", ws_size);
  }
  Params p{};
  p.x = (const float*)d_in[0]; p.positions = (const int*)d_in[1]; p.mem = (const float*)d_in[2]; p.w_in = (const float*)d_in[3];
  p.gate_up = (const float*)d_in[4]; p.gate_bias = (const float*)d_in[5]; p.norm_g = (const float*)d_in[6]; p.w_out = (const float*)d_in[7];
  p.ln_mix_g = (const float*)d_in[8]; p.ln_mix_b = (const float*)d_in[9];
  p.wq = (const float*)d_in[10]; p.wk = (const float*)d_in[11]; p.wv = (const float*)d_in[12]; p.wo = (const float*)d_in[13];
  p.ln_mem_g = (const float*)d_in[14]; p.ln_mem_b = (const float*)d_in[15];
  p.w_pq = (const float*)d_in[16]; p.sk1 = (const float*)d_in[17]; p.sk2 = (const float*)d_in[18];
  p.ex_down = (const float*)d_in[19]; p.ex_up = (const float*)d_in[20];
  p.ln_ffn_g = (const float*)d_in[21]; p.ln_ffn_b = (const float*)d_in[22];
  p.out = (float*)d_out; p.ws = (char*)d_ws;
  (void)hipMemsetAsync((char*)d_ws + OFF_BAR, 0, 256, stream);
  void* args[] = {&p};
  hipError_t e = hipLaunchCooperativeKernel((void*)fwd_megakernel, dim3(grid_blocks), dim3(512), args, 0, stream);
  if (e != hipSuccess) fprintf(stderr, "cooperative launch failed: %s (grid %d)\n", hipGetErrorString(e), grid_blocks);
}
```

```cpp
#include <hip/hip_runtime.h>
#include <hip/hip_cooperative_groups.h>
#include <cstdio>
#include <cmath>
namespace cg = cooperative_groups;

#define DI __device__ __forceinline__
typedef short bf16x8 __attribute__((ext_vector_type(8)));
typedef short bf16x4 __attribute__((ext_vector_type(4)));
typedef float f32x16 __attribute__((ext_vector_type(16)));
typedef float f32x4 __attribute__((ext_vector_type(4)));
typedef unsigned u32x4 __attribute__((ext_vector_type(4)));
typedef unsigned u32x2 __attribute__((ext_vector_type(2)));
typedef unsigned short u16;
typedef __bf16 bf2_t __attribute__((ext_vector_type(2)));
typedef float f2_t __attribute__((ext_vector_type(2)));

#define MFMA(a, b, c) __builtin_amdgcn_mfma_f32_32x32x16_bf16((a), (b), (c), 0, 0, 0)

constexpr int T_ = 32768;
constexpr int S_ = 4096;
constexpr int TMW = 2368;
constexpr int TM_Q = 0, TM_K = 512, TM_QI = 1024, TM_KI = 1280, TM_WI = 1312, TM_GLR = 1320, TM_GQ = 1344, TM_GK = 1600, TM_GR = 1856;
constexpr int PROJ_N = 3456;
constexpr float ALPHA = 1.189207115002721f;
constexpr size_t MiB = 1024 * 1024;

constexpr size_t OFF_XB = 0;
constexpr size_t OFF_EXD = 64 * MiB;
constexpr size_t OFF_EXU = 80 * MiB;
constexpr size_t OFF_BCG = 96 * MiB;
constexpr size_t OFF_WIN = 128 * MiB;
constexpr size_t OFF_WOUT = OFF_WIN + (size_t)PROJ_N * 1024 * 2;
constexpr size_t OFF_WQ = OFF_WOUT + 2 * MiB;
constexpr size_t OFF_WK = OFF_WQ + 2 * MiB;
constexpr size_t OFF_WV = OFF_WK + 2 * MiB;
constexpr size_t OFF_WO = OFF_WV + 2 * MiB;
constexpr size_t OFF_WPQ = OFF_WO + 2 * MiB;
constexpr size_t OFF_KIF = 149 * MiB;
constexpr size_t OFF_MEMB = 152 * MiB;
constexpr size_t OFF_MEMK = 156 * MiB;
constexpr size_t OFF_MEMVT = 160 * MiB;
constexpr size_t OFF_THR = 164 * MiB;
constexpr size_t OFF_SK = OFF_THR + 256 * 1024;
constexpr size_t OFF_DECAY = OFF_SK + 128 * 1024;
constexpr size_t OFF_ESC = 165 * MiB;
constexpr size_t OFF_TM = 168 * MiB;
constexpr size_t OFF_VT = 316 * MiB;
constexpr size_t OFF_KFR = 476 * MiB;
constexpr size_t OFF_GVT = 348 * MiB;
constexpr size_t OFF_KVT = 380 * MiB;
constexpr size_t OFF_PREV = 444 * MiB;
constexpr size_t OFF_H = 168 * MiB;
constexpr size_t OFF_HB = 296 * MiB;
constexpr size_t OFF_QX = 360 * MiB;
constexpr size_t OFF_OX = 424 * MiB;
constexpr size_t OFF_EIDX = 0;
constexpr size_t OFF_GATE = 16 * MiB;
constexpr size_t OFF_COEF = 32 * MiB;

struct Params {
  const float* x; const int* positions; const float* mem; const float* w_in;
  const float* gate_up; const float* gate_bias; const float* norm_g; const float* w_out;
  const float* ln_mix_g; const float* ln_mix_b;
  const float* wq; const float* wk; const float* wv; const float* wo;
  const float* ln_mem_g; const float* ln_mem_b;
  const float* w_pq; const float* sk1; const float* sk2; const float* ex_down; const float* ex_up;
  const float* ln_ffn_g; const float* ln_ffn_b;
  float* out; char* ws;
};

DI unsigned pk_bf16(float a, float b) {
  f2_t v = {a, b};
  bf2_t r = __builtin_convertvector(v, bf2_t);
  return __builtin_bit_cast(unsigned, r);
}
DI u16 f2bf(float a) { return (u16)(pk_bf16(a, 0.f) & 0xffffu); }
DI float bf2f(u16 u) { return __uint_as_float(((unsigned)u) << 16); }
DI float bflo(unsigned u) { return __uint_as_float(u << 16); }
DI float bfhi(unsigned u) { return __uint_as_float(u & 0xffff0000u); }
DI int crow(int i, int h) { return (i & 3) + 8 * (i >> 2) + 4 * h; }
DI bf16x8 ldg8(const u16* p) { return *reinterpret_cast<const bf16x8*>(p); }
DI bf16x8 pack8(float a0, float a1, float a2, float a3, float a4, float a5, float a6, float a7) {
  u32x4 r; r[0] = pk_bf16(a0, a1); r[1] = pk_bf16(a2, a3); r[2] = pk_bf16(a4, a5); r[3] = pk_bf16(a6, a7);
  return __builtin_bit_cast(bf16x8, r);
}
DI bf16x8 cat44(bf16x4 lo, bf16x4 hi) { return __builtin_shufflevector(lo, hi, 0, 1, 2, 3, 4, 5, 6, 7); }
DI void st4bf(u16* p, float a, float b, float c, float d) {
  u32x2 v; v[0] = pk_bf16(a, b); v[1] = pk_bf16(c, d);
  *reinterpret_cast<u32x2*>(p) = v;
}
DI float wave_sum(float v) {
#pragma unroll
  for (int d = 32; d >= 1; d >>= 1) v += __shfl_xor(v, d);
  return v;
}
DI void sincos_rad(float ang, float& s, float& c) {
  constexpr float C_hi = (float)0.15915494309189535;
  constexpr float C_lo = (float)(0.15915494309189535 - (double)C_hi);
  float k = rintf(ang * C_hi);
  float f = fmaf(ang, C_hi, -k);
  f = fmaf(ang, C_lo, f);
  s = __builtin_amdgcn_sinf(f);
  c = __builtin_amdgcn_cosf(f);
}
DI unsigned fkey(float s) {
  const unsigned u = __float_as_uint(s);
  return u ^ ((unsigned)((int)u >> 31) | 0x80000000u);
}
DI f32x16 zero16() { f32x16 z; for (int i = 0; i < 16; ++i) z[i] = 0.f; return z; }

DI int win_src_col(int n) {
  if (n < 1832) return n;
  if (n < 1848) return 2856 + (n - 1832);
  if (n < 1856) return -1;
  if (n < 2880) return n - 24;
  if (n < 3392) return n - 8;
  return -1;
}

DI void cvt_stream(const float* __restrict__ src, u16* __restrict__ dst, size_t n, size_t gtid, size_t gn) {
  size_t n8 = n / 8;
  for (size_t i = gtid; i < n8; i += gn) {
    f32x4 a = *reinterpret_cast<const f32x4*>(src + i * 8);
    f32x4 b = *reinterpret_cast<const f32x4*>(src + i * 8 + 4);
    u32x4 r; r[0] = pk_bf16(a[0], a[1]); r[1] = pk_bf16(a[2], a[3]); r[2] = pk_bf16(b[0], b[1]); r[3] = pk_bf16(b[2], b[3]);
    *reinterpret_cast<u32x4*>(dst + i * 8) = r;
  }
}

template <bool MAPPED>
DI void transpose_tile(const float* __restrict__ W, int ldn, u16* __restrict__ Wt, int k0, int n0, float* tile) {
  const int tid = threadIdx.x;
  {
    int nn = n0 + (tid & 63);
    int c = MAPPED ? win_src_col(nn) : nn;
#pragma unroll
    for (int rr = 0; rr < 8; ++rr) {
      int kk = (tid >> 6) + 8 * rr;
      float v = (c >= 0) ? W[(size_t)(k0 + kk) * ldn + c] : 0.f;
      tile[kk * 65 + (tid & 63)] = v;
    }
  }
  __syncthreads();
#pragma unroll
  for (int rr = 0; rr < 8; ++rr) {
    int nn = (tid >> 6) + 8 * rr;
    int kk = tid & 63;
    Wt[(size_t)(n0 + nn) * 1024 + k0 + kk] = f2bf(tile[kk * 65 + nn]);
  }
  __syncthreads();
}

DI void phase_prep(const Params& p, char* smem) {
  const size_t gtid = (size_t)blockIdx.x * blockDim.x + threadIdx.x;
  const size_t gn = (size_t)gridDim.x * blockDim.x;
  char* ws = p.ws;
  cvt_stream(p.x, (u16*)(ws + OFF_XB), (size_t)T_ * 1024, gtid, gn);
  cvt_stream(p.mem, (u16*)(ws + OFF_MEMB), (size_t)2048 * 1024, gtid, gn);
  {
    const int lane = threadIdx.x & 63;
    const int gw = (int)(gtid >> 6), nw = (int)(gn >> 6);
    for (int r = gw; r < 2 * 16384; r += nw) {
      const int tbl = r >> 14, row = r & 16383;
      const float* src = (tbl ? p.ex_up : p.ex_down) + (size_t)row * 1024 + lane * 16;
      f32x4 v[4]; float mx = 0.f;
#pragma unroll
      for (int c = 0; c < 4; ++c) {
        v[c] = *reinterpret_cast<const f32x4*>(src + c * 4);
#pragma unroll
        for (int k = 0; k < 4; ++k) mx = fmaxf(mx, fabsf(v[c][k]));
      }
#pragma unroll
      for (int d = 32; d >= 1; d >>= 1) mx = fmaxf(mx, __shfl_xor(mx, d));
      float sc = (mx > 0.f) ? exp2f(floorf(log2f(224.f / mx))) : 1.f;
      u32x4 o;
#pragma unroll
      for (int c = 0; c < 4; ++c) {
        int t = __builtin_amdgcn_cvt_pk_fp8_f32(v[c][0] * sc, v[c][1] * sc, 0, false);
        t = __builtin_amdgcn_cvt_pk_fp8_f32(v[c][2] * sc, v[c][3] * sc, t, true);
        o[c] = (unsigned)t;
      }
      *reinterpret_cast<u32x4*>(ws + (tbl ? OFF_EXU : OFF_EXD) + (size_t)row * 1024 + lane * 16) = o;
      if (lane == 0) ((float*)(ws + OFF_ESC))[r] = 1.f / sc;
    }
  }
  cvt_stream(p.sk1, (u16*)(ws + OFF_SK), (size_t)128 * 128, gtid, gn);
  cvt_stream(p.sk2, (u16*)(ws + OFF_SK) + 128 * 128, (size_t)128 * 128, gtid, gn);
  float* tile = (float*)smem;
  const int n_win = 54 * 16, n_sq = 256, n_pq = 512;
  const int total = n_win + 5 * n_sq + n_pq;
  for (int t = blockIdx.x; t < total; t += gridDim.x) {
    if (t < n_win) {
      transpose_tile<true>(p.w_in, 3384, (u16*)(ws + OFF_WIN), (t & 15) * 64, (t >> 4) * 64, tile);
    } else if (t < n_win + 5 * n_sq) {
      int u = t - n_win; int which = u >> 8; int r = u & 255;
      const float* W = which == 0 ? p.w_out : which == 1 ? p.wq : which == 2 ? p.wk : which == 3 ? p.wv : p.wo;
      size_t off = which == 0 ? OFF_WOUT : which == 1 ? OFF_WQ : which == 2 ? OFF_WK : which == 3 ? OFF_WV : OFF_WO;
      transpose_tile<false>(W, 1024, (u16*)(ws + off), (r & 15) * 64, (r >> 4) * 64, tile);
    } else {
      int r = t - n_win - 5 * n_sq;
      transpose_tile<false>(p.w_pq, 2048, (u16*)(ws + OFF_WPQ), (r & 15) * 64, (r >> 4) * 64, tile);
    }
  }
}

#define WAIT_V(n) asm volatile("s_waitcnt vmcnt(%0)" ::"n"(n) : "memory")
#define RAW_BARRIER() do { asm volatile("s_waitcnt lgkmcnt(0)" ::: "memory"); __builtin_amdgcn_s_barrier(); asm volatile("" ::: "memory"); } while (0)
constexpr int G_STAGE = 384 * 128;
DI void gemm_tile(const u16* __restrict__ X, int ldx, const u16* __restrict__ Wt, int ldw, int K, char* smem,
                  f32x16 (&acc)[2][2]) {
  const int tid = threadIdx.x, lane = tid & 63, wave = tid >> 6;
  const int fw = wave & 1, tq = wave >> 1, lr = lane & 31, lh = lane >> 5;
#pragma unroll
  for (int a = 0; a < 2; ++a)
#pragma unroll
    for (int b = 0; b < 2; ++b) acc[a][b] = zero16();
  const int nk = K / 64;
  const u16* src[6];
#pragma unroll
  for (int i = 0; i < 6; ++i) {
    const int R = 8 * (wave + 8 * i) + (lane >> 3);
    const int c = (lane & 7) ^ ((R >> 1) & 7);
    src[i] = (i < 4) ? (X + (size_t)R * ldx + c * 8) : (Wt + (size_t)(R - 256) * ldw + c * 8);
  }
#define GLDS_STAGE(slot, kt) do { _Pragma("unroll") for (int i = 0; i < 6; ++i) \
    __builtin_amdgcn_global_load_lds((const unsigned*)(src[i] + (kt) * 64), (__attribute__((address_space(3))) unsigned*)(smem + (slot) * G_STAGE + (wave + 8 * i) * 1024), 16, 0, 0); } while (0)
  int offA[2], offB[2], xa[2], xb[2];
#pragma unroll
  for (int ft = 0; ft < 2; ++ft) { const int R = 256 + fw * 64 + ft * 32 + lr; offA[ft] = R * 128; xa[ft] = (R >> 1) & 7; }
#pragma unroll
  for (int tt = 0; tt < 2; ++tt) { const int R = tq * 64 + tt * 32 + lr; offB[tt] = R * 128; xb[tt] = (R >> 1) & 7; }
  GLDS_STAGE(0, 0); GLDS_STAGE(1, 1); WAIT_V(6); RAW_BARRIER();
  int cur = 0;
  for (int kt = 0; kt < nk; ++kt) {
    const int nxt = (cur >= 1) ? cur - 1 : 2;
    if (kt + 2 < nk) GLDS_STAGE(nxt, kt + 2);
    __builtin_amdgcn_sched_barrier(0);
    const char* st = smem + cur * G_STAGE;
#pragma unroll
    for (int ks = 0; ks < 4; ++ks) {
      bf16x8 a[2], b[2];
#pragma unroll
      for (int ft = 0; ft < 2; ++ft) a[ft] = *reinterpret_cast<const bf16x8*>(st + offA[ft] + (((ks * 2 + lh) ^ xa[ft]) << 4));
#pragma unroll
      for (int tt = 0; tt < 2; ++tt) b[tt] = *reinterpret_cast<const bf16x8*>(st + offB[tt] + (((ks * 2 + lh) ^ xb[tt]) << 4));
#pragma unroll
      for (int ft = 0; ft < 2; ++ft)
#pragma unroll
        for (int tt = 0; tt < 2; ++tt) acc[ft][tt] = MFMA(a[ft], b[tt], acc[ft][tt]);
    }
    if (kt + 2 < nk) { WAIT_V(6); } else { WAIT_V(0); }
    RAW_BARRIER();
    cur = (cur == 2) ? 0 : cur + 1;
  }
#undef GLDS_STAGE
}

DI void store_tm_rows(f32x16 (&acc)[2][2], char* smem, u16* tm, int tokbase, int col) {
  const int lane = threadIdx.x & 63, wave = threadIdx.x >> 6, lr = lane & 31, lh = lane >> 5;
  float* wl = (float*)(smem + wave * 17408);
#pragma unroll
  for (int tt = 0; tt < 2; ++tt)
#pragma unroll
    for (int ft = 0; ft < 2; ++ft)
#pragma unroll
      for (int g = 0; g < 4; ++g) {
        f32x4 v = {acc[ft][tt][4 * g], acc[ft][tt][4 * g + 1], acc[ft][tt][4 * g + 2], acc[ft][tt][4 * g + 3]};
        *reinterpret_cast<f32x4*>(wl + (tt * 32 + lr) * 68 + ft * 32 + 8 * g + 4 * lh) = v;
      }
  const int ch = lane & 15, r0 = lane >> 4;
#pragma unroll 4
  for (int k = 0; k < 16; ++k) {
    const int row = r0 + 4 * k;
    f32x4 v = *reinterpret_cast<const f32x4*>(wl + row * 68 + ch * 4);
    st4bf(tm + (size_t)(tokbase + row) * TMW + col + ch * 4, v[0], v[1], v[2], v[3]);
  }
}

DI void epi_inproj(const Params& p, int tok0, int f0, f32x16 (&acc)[2][2], char* smem) {
  const int tid = threadIdx.x, lane = tid & 63, wave = tid >> 6;
  const int fw = wave & 1, tq = wave >> 1, lr = lane & 31, lh = lane >> 5;
  const int fbase = f0 + fw * 64;
  if (fbase >= 3392) return;
  u16* tm = (u16*)(p.ws + OFF_TM);
  int tmcol = -1;
#pragma unroll
  for (int tt = 0; tt < 2; ++tt) {
    const int tok = tok0 + tq * 64 + tt * 32 + lr;
    const float posf = (float)p.positions[tok];
    const int bb = tok >> 12, ss = tok & 4095;
    if (fbase < 1024) {
#pragma unroll
      for (int r = 0; r < 4; ++r) {
        float j = (float)(4 * lh + r);
        float inv = exp2f(-j * (18.931568569324174f / 8.0f));
        float sn, cs; sincos_rad(posf * inv, sn, cs);
        float x1 = acc[0][tt][r], x2 = acc[0][tt][r + 4];
        acc[0][tt][r] = x1 * cs - x2 * sn;
        acc[0][tt][r + 4] = x2 * cs + x1 * sn;
      }
      if (fbase < 512) {
        tmcol = fbase;
      } else {
        u16* kfr = (u16*)(p.ws + OFF_KFR);
        const int head = (fbase - 512) >> 6, gt = ss >> 5;
#pragma unroll
        for (int ft = 0; ft < 2; ++ft)
#pragma unroll
          for (int g = 0; g < 4; ++g) {
            const int ks = ft * 2 + (g >> 1), lane2 = (g & 1) * 32 + lr;
            st4bf(kfr + ((((size_t)(bb * 8 + head) * 128 + gt) * 4 + ks) * 64 + lane2) * 8 + 4 * lh, acc[ft][tt][4 * g], acc[ft][tt][4 * g + 1], acc[ft][tt][4 * g + 2], acc[ft][tt][4 * g + 3]);
          }
      }
    } else if (fbase < 1536) {
      u16* vfr = (u16*)(p.ws + OFF_VT);
      const int head = (fbase - 1024) >> 6, gt = ss >> 5;
      const int s = lr >> 4, r16 = lr & 15, j = 4 * (r16 >> 3) + (r16 & 3), lh2 = (r16 >> 2) & 1;
#pragma unroll
      for (int ft = 0; ft < 2; ++ft)
#pragma unroll
        for (int i = 0; i < 16; ++i) {
          const int lane2 = lh2 * 32 + crow(i, lh);
          vfr[((((((size_t)(bb * 8 + head) * 128 + gt) * 2 + ft) * 2 + s) * 64 + lane2) * 8) + j] = f2bf(acc[ft][tt][i]);
        }
    } else if (fbase >= 2368 && fbase < 2880) {
      u16* vt = (u16*)(p.ws + OFF_GVT);
      const int fo = fbase - 2368;
#pragma unroll
      for (int ft = 0; ft < 2; ++ft)
#pragma unroll
        for (int i = 0; i < 16; ++i) {
          int feat = fo + ft * 32 + crow(i, lh);
          vt[((size_t)bb * 512 + feat) * 4096 + ss] = f2bf(acc[ft][tt][i]);
        }
    } else {
      if (fbase < 1856) {
#pragma unroll
        for (int ft = 0; ft < 2; ++ft) {
          const bool rot = (fbase < 1792) || (ft == 0);
#pragma unroll
          for (int r = 0; r < 4; ++r) {
            float v = acc[ft][tt][r];
            float o = __shfl_xor(v, 32);
            float inv = exp2f(-(float)r * (18.931568569324174f / 4.0f));
            float sn, cs; sincos_rad(posf * inv, sn, cs);
            float res = (lh == 0) ? (v * cs - o * sn) : (v * cs + o * sn);
            acc[ft][tt][r] = rot ? res : v;
          }
        }
        tmcol = fbase - 512;
        if (fbase == 1792) {
          u16* kif = (u16*)(p.ws + OFF_KIF);
          const int gt = ss >> 5;
#pragma unroll
          for (int g = 0; g < 4; ++g) {
            const int ks = g >> 1, lane2 = (g & 1) * 32 + lr;
            st4bf(kif + ((((size_t)bb * 128 + gt) * 2 + ks) * 64 + lane2) * 8 + 4 * lh, acc[0][tt][4 * g], acc[0][tt][4 * g + 1], acc[0][tt][4 * g + 2], acc[0][tt][4 * g + 3]);
          }
        }
      } else if (fbase < 2368) {
        tmcol = fbase - 512;
      } else {
        tmcol = fbase - 1024;
      }
    }
  }
  if (tmcol >= 0) store_tm_rows(acc, smem, tm, tok0 + tq * 64, tmcol);
}

DI void phase_inproj(const Params& p, char* smem) {
  const int n_in = 128 * 27;
  const int total = n_in + 128;
  const u16* xb = (const u16*)(p.ws + OFF_XB);
  const u16* memb = (const u16*)(p.ws + OFF_MEMB);
  const int tid = threadIdx.x, lane = tid & 63, wave = tid >> 6;
  const int fw = wave & 1, tq = wave >> 1, lr = lane & 31, lh = lane >> 5;
  for (int t = blockIdx.x; t < total; t += gridDim.x) {
    f32x16 acc[2][2];
    if (t < n_in) {
      int mt = t / 27, nt = t % 27;
      gemm_tile(xb + (size_t)mt * 256 * 1024, 1024, (const u16*)(p.ws + OFF_WIN) + (size_t)nt * 128 * 1024, 1024, 1024, smem, acc);
      epi_inproj(p, mt * 256, nt * 128, acc, smem);
      __syncthreads();
    } else {
      int u = t - n_in; int which = u >> 6; int r = u & 63; int mt = r >> 3, nt = r & 7;
      const u16* W = (const u16*)(p.ws + (which == 0 ? OFF_WK : OFF_WV));
      gemm_tile(memb + (size_t)mt * 256 * 1024, 1024, W + (size_t)nt * 128 * 1024, 1024, 1024, smem, acc);
#pragma unroll
      for (int tt = 0; tt < 2; ++tt) {
        const int tok = mt * 256 + tq * 64 + tt * 32 + lr;
        const int bb = tok >> 8, mm = tok & 255, hh = nt >> 1, kt = mm >> 5;
        if (which == 0) {
          u16* mk = (u16*)(p.ws + OFF_MEMK);
#pragma unroll
          for (int ft = 0; ft < 2; ++ft)
#pragma unroll
            for (int g = 0; g < 4; ++g) {
              const int ks = (nt & 1) * 8 + fw * 4 + ft * 2 + (g >> 1), lane2 = (g & 1) * 32 + lr;
              st4bf(mk + ((((size_t)(bb * 4 + hh) * 8 + kt) * 16 + ks) * 64 + lane2) * 8 + 4 * lh, acc[ft][tt][4 * g], acc[ft][tt][4 * g + 1], acc[ft][tt][4 * g + 2], acc[ft][tt][4 * g + 3]);
            }
        } else {
          u16* mv = (u16*)(p.ws + OFF_MEMVT);
          const int s = lr >> 4, r16 = lr & 15, j = 4 * (r16 >> 3) + (r16 & 3), lh2 = (r16 >> 2) & 1;
#pragma unroll
          for (int ft = 0; ft < 2; ++ft) {
            const int dt = (nt & 1) * 4 + fw * 2 + ft;
#pragma unroll
            for (int i = 0; i < 16; ++i) {
              const int lane2 = lh2 * 32 + crow(i, lh);
              mv[((((((size_t)(bb * 4 + hh) * 8 + dt) * 8 + kt) * 2 + s) * 64 + lane2) * 8) + j] = f2bf(acc[ft][tt][i]);
            }
          }
        }
      }
    }
  }
}

DI void idx_scores(const bf16x8 (&qf)[8][2], const float (&wq)[8], bf16x8 k0, bf16x8 k1, float (&sc)[16]) {
#pragma unroll
  for (int i = 0; i < 16; ++i) sc[i] = 0.f;
#pragma unroll
  for (int hd = 0; hd < 8; ++hd) {
    f32x16 a = zero16();
    a = MFMA(k0, qf[hd][0], a);
    a = MFMA(k1, qf[hd][1], a);
#pragma unroll
    for (int i = 0; i < 16; ++i) sc[i] = fmaf(wq[hd], fmaxf(a[i], 0.f), sc[i]);
  }
}

DI void load_idx_q(const u16* tm, int tok, int lh, bf16x8 (&qf)[8][2], float (&wq)[8]) {
  const u16* row = tm + (size_t)tok * TMW;
#pragma unroll
  for (int hd = 0; hd < 8; ++hd)
#pragma unroll
    for (int ks = 0; ks < 2; ++ks) qf[hd][ks] = ldg8(row + TM_QI + hd * 32 + ks * 16 + lh * 8);
  bf16x8 w8 = ldg8(row + TM_WI);
#pragma unroll
  for (int hd = 0; hd < 8; ++hd) wq[hd] = bf2f((u16)w8[hd]) * 0.0625f;
}

DI int wave_incl_scan(int v, int lane) {
#pragma unroll
  for (int d = 1; d < 64; d <<= 1) {
    int t = __shfl_up(v, d);
    if (lane >= d) v += t;
  }
  return v;
}

DI void dsa_thr_item(const Params& p, int b, int qblk, char* smem) {
  unsigned* hist = (unsigned*)smem;
  unsigned* pref = (unsigned*)(smem + 32768);
  int* rank = (int*)(smem + 32768 + 128);
  const u16* tm = (const u16*)(p.ws + OFF_TM);
  const int tid = threadIdx.x, lane = tid & 63, wave = tid >> 6, lr = lane & 31, lh = lane >> 5;
  const int q0 = qblk * 32;
  u16* qi = (u16*)(smem + 33280);
  for (int i = tid; i < 32 * 32; i += 512) {
    int q = i >> 5, ch = i & 31;
    *reinterpret_cast<u32x4*>(qi + q * 296 + ch * 8) = *reinterpret_cast<const u32x4*>(tm + (size_t)(b * S_ + q0 + q) * TMW + TM_QI + ch * 8);
  }
  float wq[8];
  {
    bf16x8 w8 = ldg8(tm + (size_t)(b * S_ + q0 + lr) * TMW + TM_WI);
#pragma unroll
    for (int hd = 0; hd < 8; ++hd) wq[hd] = bf2f((u16)w8[hd]) * 0.0625f;
  }
  __syncthreads();
  for (int i = tid; i < 32 * 32; i += 512) {
    const int q = i >> 5, d = i & 31;
    float acc = 0.f;
#pragma unroll
    for (int hd = 0; hd < 8; ++hd) acc = fmaf(bf2f(tm[(size_t)(b * S_ + q0 + q) * TMW + TM_WI + hd]) * 0.0625f, bf2f(qi[q * 296 + hd * 32 + d]), acc);
    qi[q * 296 + 256 + d] = f2bf(acc);
  }
  const u16* qil = qi + lr * 296 + lh * 8;
  if (tid < 32) { pref[tid] = 0u; rank[tid] = min(256, q0 + tid + 1); }
  for (int pass = 0; pass < 4; ++pass) {
    for (int i = tid; i < 8192; i += 512) hist[i] = 0u;
    __syncthreads();
    const int shift = 24 - 8 * pass;
    const unsigned mypref = pref[lr];
    const u16* kib = (const u16*)(p.ws + OFF_KIF) + (size_t)b * 128 * 1024 + lane * 8;
    bf16x8 kn0, kn1;
    {
      const int kt0 = min(wave, qblk);
      kn0 = ldg8(kib + (size_t)kt0 * 1024); kn1 = ldg8(kib + (size_t)kt0 * 1024 + 512);
    }
    for (int kt = wave; kt <= qblk; kt += 8) {
      const bf16x8 k0 = kn0, k1 = kn1;
      {
        const int ktn = min(kt + 8, qblk);
        kn0 = ldg8(kib + (size_t)ktn * 1024); kn1 = ldg8(kib + (size_t)ktn * 1024 + 512);
      }
      float sc[16];
      {
        f32x16 a = zero16();
        a = MFMA(k0, *reinterpret_cast<const bf16x8*>(qil + 256), a);
        a = MFMA(k1, *reinterpret_cast<const bf16x8*>(qil + 256 + 16), a);
#pragma unroll
        for (int i = 0; i < 16; ++i) sc[i] = a[i];
      }
#pragma unroll
      for (int hd = 0; hd < 8; ++hd) {
        f32x16 a = zero16();
        a = MFMA(k0, *reinterpret_cast<const bf16x8*>(qil + hd * 32), a);
        a = MFMA(k1, *reinterpret_cast<const bf16x8*>(qil + hd * 32 + 16), a);
        const float wh = wq[hd];
#pragma unroll
        for (int i = 0; i < 16; ++i) sc[i] = fmaf(fabsf(a[i]), wh, sc[i]);
      }
      if (kt == qblk) {
#pragma unroll
        for (int i = 0; i < 16; ++i) {
          int kp = kt * 32 + crow(i, lh);
          unsigned ky = fkey(sc[i]);
          unsigned hi = (ky >> shift);
          if (kp <= q0 + lr && (hi >> 8) == mypref) atomicAdd(&hist[(hi & 255u) * 32 + lr], 1u);
        }
      } else {
#pragma unroll
        for (int i = 0; i < 16; ++i) {
          unsigned ky = fkey(sc[i]);
          unsigned hi = (ky >> shift);
          if ((hi >> 8) == mypref) atomicAdd(&hist[(hi & 255u) * 32 + lr], 1u);
        }
      }
    }
    __syncthreads();
#pragma unroll 1
    for (int qq = 0; qq < 4; ++qq) {
      const int q = wave * 4 + qq;
      const int rk = rank[q];
      int c[4];
#pragma unroll
      for (int j = 0; j < 4; ++j) c[j] = (int)hist[(255 - 4 * lane - j) * 32 + q];
      int s = c[0] + c[1] + c[2] + c[3];
      int P = wave_incl_scan(s, lane);
      int excl = P - s;
      if (P >= rk && excl < rk) {
        int cum = excl; int bin = 0; int nr = 1; bool found = false;
#pragma unroll
        for (int j = 0; j < 4; ++j) {
          if (!found && cum + c[j] >= rk) { bin = 255 - 4 * lane - j; nr = rk - cum; found = true; }
          if (!found) cum += c[j];
        }
        pref[q] = (pref[q] << 8) | (unsigned)bin;
        rank[q] = nr;
      }
    }
    __syncthreads();
  }
  if (tid < 32) ((unsigned*)(p.ws + OFF_THR))[b * S_ + q0 + tid] = pref[tid];
  __syncthreads();
}

DI void dsa_attn_item(const Params& p, int b, int qblk, char* smem) {
  u16* maskbuf = (u16*)smem;
  u16* qi = (u16*)(smem + 4096);
  const u16* tm = (const u16*)(p.ws + OFF_TM);
  const u16* vfr = (const u16*)(p.ws + OFF_VT) + ((size_t)(b * 8 + (threadIdx.x >> 6)) * 128) * 2048 + (threadIdx.x & 63) * 8;
  const u16* kfr = (const u16*)(p.ws + OFF_KFR) + ((size_t)(b * 8 + (threadIdx.x >> 6)) * 128) * 2048 + (threadIdx.x & 63) * 8;
  const unsigned* thr = (const unsigned*)(p.ws + OFF_THR);
  const int tid = threadIdx.x, lane = tid & 63, wave = tid >> 6, lr = lane & 31, lh = lane >> 5;
  const int q0 = qblk * 32;
  const int head = wave;
  const int qtok = b * S_ + q0 + lr;
  bf16x8 Qf[4];
#pragma unroll
  for (int ks = 0; ks < 4; ++ks) {
    bf16x8 raw = ldg8(tm + (size_t)qtok * TMW + TM_Q + head * 64 + ks * 16 + lh * 8);
    float f[8];
#pragma unroll
    for (int j = 0; j < 8; ++j) f[j] = bf2f((u16)raw[j]) * (0.125f * 1.4426950408889634f);
    Qf[ks] = pack8(f[0], f[1], f[2], f[3], f[4], f[5], f[6], f[7]);
  }
  f32x16 O[2];
  O[0] = zero16(); O[1] = zero16();
  float mrun = -INFINITY, lrun = 0.f;
  const unsigned thrq = thr[qtok];
  const int nchunks = (q0 + 31) / 256 + 1;
  for (int i = tid; i < 32 * 32; i += 512) {
    int q = i >> 5, ch = i & 31;
    *reinterpret_cast<u32x4*>(qi + q * 296 + ch * 8) = *reinterpret_cast<const u32x4*>(tm + (size_t)(b * S_ + q0 + q) * TMW + TM_QI + ch * 8);
  }
  float* wqs = (float*)(smem + 4096 + 32 * 296 * 2);
  if (tid < 256) wqs[tid] = bf2f(tm[(size_t)(b * S_ + q0 + (tid & 31)) * TMW + TM_WI + (tid >> 5)]) * 0.0625f;
  __syncthreads();
  for (int i = tid; i < 32 * 32; i += 512) {
    const int q = i >> 5, d = i & 31;
    float acc = 0.f;
#pragma unroll
    for (int hd = 0; hd < 8; ++hd) acc = fmaf(bf2f(tm[(size_t)(b * S_ + q0 + q) * TMW + TM_WI + hd]) * 0.0625f, bf2f(qi[q * 296 + hd * 32 + d]), acc);
    qi[q * 296 + 256 + d] = f2bf(acc);
  }
  __syncthreads();
  const u16* qil = qi + lr * 296 + lh * 8;
  const u16* kibase = (const u16*)(p.ws + OFF_KIF) + (size_t)b * 128 * 1024 + lane * 8;
  bf16x8 Kf[4], Kn[4];
#pragma unroll
  for (int ks = 0; ks < 4; ++ks) Kf[ks] = ldg8(kfr + ks * 512);
  bf16x8 Vf[2][2], Vn[2][2];
#pragma unroll
  for (int dt = 0; dt < 2; ++dt)
#pragma unroll
    for (int s = 0; s < 2; ++s) Vf[dt][s] = ldg8(vfr + (dt * 2 + s) * 512);
  bf16x8 ki0, ki1;
  {
    const int kt0 = min(wave, qblk);
    ki0 = ldg8(kibase + (size_t)kt0 * 1024); ki1 = ldg8(kibase + (size_t)kt0 * 1024 + 512);
  }
  for (int c = 0; c < nchunks; ++c) {
    const int buf = c & 1;
    {
      const int key0 = (c * 8 + wave) * 32;
      unsigned bits = 0u;
      const bf16x8 k0 = ki0, k1 = ki1;
      {
        const int ktn = min((c + 1) * 8 + wave, qblk);
        ki0 = ldg8(kibase + (size_t)ktn * 1024); ki1 = ldg8(kibase + (size_t)ktn * 1024 + 512);
      }
      if (key0 <= q0 + 31) {
        float sc[16];
        {
          f32x16 a = zero16();
          a = MFMA(k0, *reinterpret_cast<const bf16x8*>(qil + 256), a);
          a = MFMA(k1, *reinterpret_cast<const bf16x8*>(qil + 256 + 16), a);
#pragma unroll
          for (int i = 0; i < 16; ++i) sc[i] = a[i];
        }
#pragma unroll 2
        for (int hd = 0; hd < 8; ++hd) {
          f32x16 a = zero16();
          a = MFMA(k0, *reinterpret_cast<const bf16x8*>(qil + hd * 32), a);
          a = MFMA(k1, *reinterpret_cast<const bf16x8*>(qil + hd * 32 + 16), a);
          const float wh = wqs[hd * 32 + lr];
#pragma unroll
          for (int i = 0; i < 16; ++i) sc[i] = fmaf(fabsf(a[i]), wh, sc[i]);
        }
        __builtin_amdgcn_sched_barrier(0);
#pragma unroll
        for (int i = 0; i < 16; ++i) {
          int kp = key0 + crow(i, lh);
          if (kp <= q0 + lr && fkey(sc[i]) >= thrq) bits |= (1u << i);
        }
      }
      maskbuf[(buf * 8 + wave) * 64 + lane] = (u16)bits;
    }
    __syncthreads();
#pragma unroll 1
    for (int t8 = 0; t8 < 8; ++t8) {
      const int g = c * 8 + t8;
      if (g > qblk) break;
      {
        const int gn = min(g + 1, qblk);
        const u16* kr = kfr + (size_t)gn * 2048;
#pragma unroll
        for (int ks = 0; ks < 4; ++ks) Kn[ks] = ldg8(kr + ks * 512);
#pragma unroll
        for (int dt = 0; dt < 2; ++dt)
#pragma unroll
          for (int s = 0; s < 2; ++s) Vn[dt][s] = ldg8(vfr + (size_t)gn * 2048 + (dt * 2 + s) * 512);
      }

      const unsigned bits = maskbuf[(buf * 8 + t8) * 64 + lane];
      f32x16 Sx = zero16();
#pragma unroll
      for (int ks = 0; ks < 4; ++ks) Sx = MFMA(Kf[ks], Qf[ks], Sx);
      float sm[16];
#pragma unroll
      for (int i = 0; i < 16; ++i) {
        const unsigned t = (unsigned)__builtin_amdgcn_sbfe((int)bits, i, 1);
        sm[i] = __uint_as_float((t & __float_as_uint(Sx[i])) | (~t & 0xff800000u));
      }
      float mt = fmaxf(fmaxf(fmaxf(sm[0], sm[1]), fmaxf(sm[2], sm[3])), fmaxf(fmaxf(sm[4], sm[5]), fmaxf(sm[6], sm[7])));
      mt = fmaxf(mt, fmaxf(fmaxf(fmaxf(sm[8], sm[9]), fmaxf(sm[10], sm[11])), fmaxf(fmaxf(sm[12], sm[13]), fmaxf(sm[14], sm[15]))));
      mt = fmaxf(mt, __shfl_xor(mt, 32));
      const float mnew = fmaxf(mrun, mt);
      const float msafe = (mnew == -INFINITY) ? 0.f : mnew;
      const float alpha = __builtin_amdgcn_exp2f(mrun - msafe);
      float pv[16]; float ps = 0.f;
#pragma unroll
      for (int i = 0; i < 16; ++i) { pv[i] = __builtin_amdgcn_exp2f(sm[i] - msafe); ps += pv[i]; }
      lrun = lrun * alpha + ps;
      mrun = mnew;
      if (__builtin_amdgcn_ballot_w64(alpha != 1.f) != 0ull) {
#pragma unroll
        for (int dt = 0; dt < 2; ++dt)
#pragma unroll
          for (int i = 0; i < 16; ++i) O[dt][i] *= alpha;
      }
      bf16x8 Pf[2];
#pragma unroll
      for (int s = 0; s < 2; ++s) Pf[s] = pack8(pv[8 * s], pv[8 * s + 1], pv[8 * s + 2], pv[8 * s + 3], pv[8 * s + 4], pv[8 * s + 5], pv[8 * s + 6], pv[8 * s + 7]);
#pragma unroll
      for (int dt = 0; dt < 2; ++dt)
#pragma unroll
        for (int s = 0; s < 2; ++s) O[dt] = MFMA(Vf[dt][s], Pf[s], O[dt]);
#pragma unroll
      for (int ks = 0; ks < 4; ++ks) Kf[ks] = Kn[ks];
#pragma unroll
      for (int dt = 0; dt < 2; ++dt)
#pragma unroll
        for (int s = 0; s < 2; ++s) Vf[dt][s] = Vn[dt][s];
    }
  }
  u16* y = (u16*)(p.ws + OFF_XB);
  {
    float lt = lrun + __shfl_xor(lrun, 32);
    float inv = 1.f / lt;
#pragma unroll
    for (int dt = 0; dt < 2; ++dt)
#pragma unroll
      for (int g = 0; g < 4; ++g)
        st4bf(y + (size_t)qtok * 1024 + head * 64 + dt * 32 + 8 * g + 4 * lh, O[dt][4 * g] * inv, O[dt][4 * g + 1] * inv, O[dt][4 * g + 2] * inv, O[dt][4 * g + 3] * inv);
  }
  __syncthreads();
}

DI void gla_bcum(const Params& p, int b, int h, int n, float* bc, float* glr_s, float* segtot) {
  const u16* tm = (const u16*)(p.ws + OFF_TM);
  const int tid = threadIdx.x;
  const int tok0 = b * S_ + n * 64;
  for (int i = tid; i < 1024; i += 512) glr_s[i] = bf2f(tm[(size_t)(tok0 + (i >> 4)) * TMW + TM_GLR + (i & 15)]);
  const int d = tid & 63, cgp = tid >> 6;
  float gu[16];
#pragma unroll
  for (int j = 0; j < 16; ++j) gu[j] = p.gate_up[j * 256 + h * 64 + d];
  const float bias = p.gate_bias[h * 64 + d];
  __syncthreads();
  float v[8]; float run = 0.f;
#pragma unroll
  for (int r = 0; r < 8; ++r) {
    const int c = cgp * 8 + r;
    float z = bias;
#pragma unroll
    for (int j4 = 0; j4 < 4; ++j4) {
      const f32x4 gv = *reinterpret_cast<const f32x4*>(glr_s + c * 16 + j4 * 4);
#pragma unroll
      for (int j = 0; j < 4; ++j) z = fmaf(gv[j], gu[j4 * 4 + j], z);
    }
    float la = (fminf(z, 0.f) - __logf(1.f + __expf(-fabsf(z)))) * 0.0625f;
    run += la; v[r] = run;
  }
  segtot[cgp * 64 + d] = run;
  __syncthreads();
  float off = 0.f;
#pragma unroll
  for (int g = 0; g < 8; ++g) off += (g < cgp) ? segtot[g * 64 + d] : 0.f;
#pragma unroll
  for (int r = 0; r < 8; ++r) bc[(cgp * 8 + r) * 64 + d] = off + v[r];
  __syncthreads();
}

DI void gla_g1_item(const Params& p, int item, char* smem) {
  float* bc = (float*)smem;
  float* glr_s = (float*)(smem + 16384);
  float* segtot = (float*)(smem + 20480);
  u16* KeT = (u16*)(smem + 22528);
  const int b = item >> 8, h = (item >> 6) & 3, n = item & 63;
  const u16* tm = (const u16*)(p.ws + OFF_TM);
  const u16* gvT = (const u16*)(p.ws + OFF_GVT);
  const int tid = threadIdx.x, lane = tid & 63, wave = tid >> 6, lr = lane & 31, lh = lane >> 5;
  const int tok0 = b * S_ + n * 64;
  u16 kraw[8];
  {
    const int d = tid & 63, cgp = tid >> 6;
#pragma unroll
    for (int r = 0; r < 8; ++r) kraw[r] = tm[(size_t)(tok0 + cgp * 8 + r) * TMW + TM_GK + h * 64 + d];
  }
  bf16x8 afr[4];
  {
    const int et = wave & 3;
    const u16* arow = gvT + ((size_t)b * 512 + h * 128 + et * 32 + lr) * 4096 + n * 64 + lh * 8;
#pragma unroll
    for (int ks = 0; ks < 4; ++ks) afr[ks] = ldg8(arow + ks * 16);
  }
  gla_bcum(p, b, h, n, bc, glr_s, segtot);
  {
    const int d = tid & 63, cgp = tid >> 6;
    const float blast = bc[63 * 64 + d];
    {
      float* bcg = (float*)(p.ws + OFF_BCG) + (size_t)item * 4096;
#pragma unroll
      for (int r = 0; r < 8; ++r) bcg[(cgp * 8 + r) * 64 + d] = bc[(cgp * 8 + r) * 64 + d];
    }
    float f[8];
#pragma unroll
    for (int r = 0; r < 8; ++r) {
      const int c = cgp * 8 + r;
      float kv = bf2f(kraw[r]);
      f[r] = kv * __expf(blast - bc[c * 64 + d]);
    }
    *reinterpret_cast<bf16x8*>(KeT + d * 72 + cgp * 8) = pack8(f[0], f[1], f[2], f[3], f[4], f[5], f[6], f[7]);
    if (cgp == 0) ((float*)(p.ws + OFF_DECAY))[item * 64 + d] = __expf(blast);
  }
  __syncthreads();
  {
    const int et = wave & 3, dtl = wave >> 2;
    f32x16 acc = zero16();
#pragma unroll
    for (int ks = 0; ks < 4; ++ks) {
      bf16x8 a = afr[ks];
      bf16x8 bb = *reinterpret_cast<const bf16x8*>(KeT + (dtl * 32 + lr) * 72 + ks * 16 + lh * 8);
      acc = MFMA(a, bb, acc);
    }
    float* kvT = (float*)(p.ws + OFF_KVT);
#pragma unroll
    for (int i = 0; i < 16; ++i) kvT[((size_t)item * 128 + et * 32 + crow(i, lh)) * 64 + dtl * 32 + lr] = acc[i];
  }
  __syncthreads();
}

DI void gla_scan(const Params& p) {
  const float* kvT = (const float*)(p.ws + OFF_KVT);
  const float* decay = (const float*)(p.ws + OFF_DECAY);
  u16* prev = (u16*)(p.ws + OFF_PREV);
  const int gtid = blockIdx.x * blockDim.x + threadIdx.x;
  const int gn = gridDim.x * blockDim.x;
  for (int u = gtid; u < 32 * 2048; u += gn) {
    const int bh = u >> 11, rem = u & 2047, e = rem >> 4, d4 = (rem & 15) * 4;
    f32x4 st = {0.f, 0.f, 0.f, 0.f};
#pragma unroll 4
    for (int n = 0; n < 64; ++n) {
      const int item = bh * 64 + n;
      st4bf(prev + ((size_t)item * 128 + e) * 64 + d4, st[0], st[1], st[2], st[3]);
      f32x4 dc = *reinterpret_cast<const f32x4*>(decay + item * 64 + d4);
      f32x4 kv = *reinterpret_cast<const f32x4*>(kvT + ((size_t)item * 128 + e) * 64 + d4);
      st = dc * st + kv;
    }
  }
}

DI void gla_g3_item(const Params& p, int item, char* smem) {
  float* red = (float*)smem;
  const int b = item >> 8, h = (item >> 6) & 3, n = item & 63;
  const u16* tm = (const u16*)(p.ws + OFF_TM);
  const u16* gvT = (const u16*)(p.ws + OFF_GVT);
  const u16* prev = (const u16*)(p.ws + OFF_PREV);
  const float* bcg = (const float*)(p.ws + OFF_BCG) + (size_t)item * 4096;
  const int tid = threadIdx.x, lane = tid & 63, wave = tid >> 6, lr = lane & 31, lh = lane >> 5;
  const int tok0 = b * S_ + n * 64;
  const int et = wave & 3, ct = wave >> 2;
  bf16x8 qraw[4], kraw[2][4], sfr[4];
  bf16x4 vlo[2][2], vhi[2][2];
  f32x4 bq[4][2];
  {
    const u16* vrow0 = gvT + ((size_t)b * 512 + h * 128 + et * 32 + lr) * 4096 + n * 64 + 4 * lh;
    const u16* srow0 = prev + ((size_t)item * 128 + et * 32 + lr) * 64 + lh * 8;
#pragma unroll
    for (int ks = 0; ks < 4; ++ks) {
      qraw[ks] = ldg8(tm + (size_t)(tok0 + ct * 32 + lr) * TMW + TM_GQ + h * 64 + ks * 16 + lh * 8);
      kraw[0][ks] = ldg8(tm + (size_t)(tok0 + lr) * TMW + TM_GK + h * 64 + ks * 16 + lh * 8);
      kraw[1][ks] = ldg8(tm + (size_t)(tok0 + ct * 32 + lr) * TMW + TM_GK + h * 64 + ks * 16 + lh * 8);
      sfr[ks] = ldg8(srow0 + ks * 16);
      bq[ks][0] = *reinterpret_cast<const f32x4*>(bcg + (ct * 32 + lr) * 64 + ks * 16 + lh * 8);
      bq[ks][1] = *reinterpret_cast<const f32x4*>(bcg + (ct * 32 + lr) * 64 + ks * 16 + lh * 8 + 4);
    }
#pragma unroll
    for (int st = 0; st < 2; ++st)
#pragma unroll
      for (int s2 = 0; s2 < 2; ++s2) {
        const u16* vp = vrow0 + (st * ct) * 32 + 16 * s2;
        vlo[st][s2] = *reinterpret_cast<const bf16x4*>(vp);
        vhi[st][s2] = *reinterpret_cast<const bf16x4*>(vp + 8);
      }
  }
  bf16x8 Qd[4];
#pragma unroll
  for (int ks = 0; ks < 4; ++ks) {
    float f[8];
#pragma unroll
    for (int j = 0; j < 8; ++j) f[j] = bf2f((u16)qraw[ks][j]) * 0.125f * __expf(bq[ks][j >> 2][j & 3]);
    Qd[ks] = pack8(f[0], f[1], f[2], f[3], f[4], f[5], f[6], f[7]);
  }
  f32x16 O = zero16();
#pragma unroll
  for (int st = 0; st < 2; ++st) {
    if (st <= ct) {
      f32x16 A = zero16();
      const int s = st * 32 + lr;
#pragma unroll
      for (int ks = 0; ks < 4; ++ks) {
        f32x4 b0 = (st == 1) ? bq[ks][0] : *reinterpret_cast<const f32x4*>(bcg + s * 64 + ks * 16 + lh * 8);
        f32x4 b1 = (st == 1) ? bq[ks][1] : *reinterpret_cast<const f32x4*>(bcg + s * 64 + ks * 16 + lh * 8 + 4);
        float f[8];
#pragma unroll
        for (int j = 0; j < 8; ++j) f[j] = bf2f((u16)kraw[st][ks][j]) * __expf(-((j < 4) ? b0[j & 3] : b1[j & 3]));
        bf16x8 Ki = pack8(f[0], f[1], f[2], f[3], f[4], f[5], f[6], f[7]);
        A = MFMA(Ki, Qd[ks], A);
      }
      float pv[16];
#pragma unroll
      for (int i = 0; i < 16; ++i) pv[i] = (st * 32 + crow(i, lh) <= ct * 32 + lr) ? A[i] : 0.f;
#pragma unroll
      for (int s2 = 0; s2 < 2; ++s2) {
        bf16x8 Pf = pack8(pv[8 * s2], pv[8 * s2 + 1], pv[8 * s2 + 2], pv[8 * s2 + 3], pv[8 * s2 + 4], pv[8 * s2 + 5], pv[8 * s2 + 6], pv[8 * s2 + 7]);
        O = MFMA(cat44(vlo[st][s2], vhi[st][s2]), Pf, O);
      }
    }
  }
#pragma unroll
  for (int ks = 0; ks < 4; ++ks) O = MFMA(sfr[ks], Qd[ks], O);
  float ss = 0.f;
#pragma unroll
  for (int i = 0; i < 16; ++i) ss += O[i] * O[i];
  ss += __shfl_xor(ss, 32);
  if (lh == 0) red[(ct * 4 + et) * 32 + lr] = ss;
  __syncthreads();
  const float tot = red[(ct * 4 + 0) * 32 + lr] + red[(ct * 4 + 1) * 32 + lr] + red[(ct * 4 + 2) * 32 + lr] + red[(ct * 4 + 3) * 32 + lr];
  const float rinv = rsqrtf(tot * (1.f / 128.f) + 1e-6f);
  const int tok = tok0 + ct * 32 + lr;
  u16* y = (u16*)(p.ws + OFF_XB);
#pragma unroll
  for (int g = 0; g < 4; ++g) {
    const int e0 = et * 32 + 8 * g + 4 * lh;
    u32x2 gr = *reinterpret_cast<const u32x2*>(tm + (size_t)tok * TMW + TM_GR + h * 128 + e0);
    f32x4 ng = *reinterpret_cast<const f32x4*>(p.norm_g + e0);
    float grv[4] = {bflo(gr[0]), bfhi(gr[0]), bflo(gr[1]), bfhi(gr[1])};
    float o[4];
#pragma unroll
    for (int r = 0; r < 4; ++r) {
      float sl = grv[r] / (1.f + __expf(-grv[r]));
      o[r] = O[4 * g + r] * rinv * ng[r] * sl;
    }
    st4bf(y + (size_t)tok * 1024 + 512 + h * 128 + e0, o[0], o[1], o[2], o[3]);
  }
  __syncthreads();
}

template <int MODE>
DI void phase_gemm(const Params& p, const u16* X, const u16* Wt, int N, const float* resid, float* outf, u16* outb, int ldo, char* smem) {
  const int ntn = N / 128;
  const int total = 128 * ntn;
  const int tid = threadIdx.x, lane = tid & 63, wave = tid >> 6;
  const int fw = wave & 1, tq = wave >> 1, lr = lane & 31, lh = lane >> 5;
  for (int t = blockIdx.x; t < total; t += gridDim.x) {
    const int mt = t / ntn, nt = t % ntn;
    f32x16 acc[2][2];
    gemm_tile(X + (size_t)mt * 256 * 1024, 1024, Wt + (size_t)nt * 128 * 1024, 1024, 1024, smem, acc);
    if (MODE == 0 || MODE == 1) {
      float* wl = (float*)(smem + wave * 17408);
#pragma unroll
      for (int tt = 0; tt < 2; ++tt)
#pragma unroll
        for (int ft = 0; ft < 2; ++ft)
#pragma unroll
          for (int g = 0; g < 4; ++g) {
            f32x4 v = {acc[ft][tt][4 * g], acc[ft][tt][4 * g + 1], acc[ft][tt][4 * g + 2], acc[ft][tt][4 * g + 3]};
            *reinterpret_cast<f32x4*>(wl + (tt * 32 + lr) * 68 + ft * 32 + 8 * g + 4 * lh) = v;
          }
      const int ch = lane & 15, r0 = lane >> 4;
      const int f = nt * 128 + fw * 64 + ch * 4;
#pragma unroll 4
      for (int k = 0; k < 16; ++k) {
        const int row = r0 + 4 * k;
        const int tok = mt * 256 + tq * 64 + row;
        f32x4 v = *reinterpret_cast<const f32x4*>(wl + row * 68 + ch * 4);
        if (MODE == 0) {
          f32x4 r = *reinterpret_cast<const f32x4*>(resid + (size_t)tok * 1024 + f);
          f32x4 o;
#pragma unroll
          for (int j = 0; j < 4; ++j) o[j] = ALPHA * r[j] + v[j];
          *reinterpret_cast<f32x4*>(outf + (size_t)tok * 1024 + f) = o;
        } else {
          st4bf(outb + (size_t)tok * ldo + f, v[0], v[1], v[2], v[3]);
        }
      }
      __syncthreads();
    } else {
#pragma unroll
      for (int tt = 0; tt < 2; ++tt) {
        const int tok = mt * 256 + tq * 64 + tt * 32 + lr;
#pragma unroll
        for (int ft = 0; ft < 2; ++ft)
#pragma unroll
          for (int g = 0; g < 4; ++g) {
            const int f = nt * 128 + fw * 64 + ft * 32 + 8 * g + 4 * lh;
            if (MODE == 2) {
              const int hh = f >> 8, fh = f & 255, ks = fh >> 4, lane2 = ((fh >> 3) & 1) * 32 + lr;
              st4bf(outb + ((((size_t)(tok >> 5) * 4 + hh) * 16 + ks) * 64 + lane2) * 8 + 4 * lh, acc[ft][tt][4 * g], acc[ft][tt][4 * g + 1], acc[ft][tt][4 * g + 2], acc[ft][tt][4 * g + 3]);
            } else {
              const int hh = f >> 8, fq = f & 127, half = (f >> 7) & 1, ks = fq >> 4, lane2 = ((fq >> 3) & 1) * 32 + lr;
              st4bf(outb + (((((size_t)(tok >> 5) * 8 + hh) * 2 + half) * 8 + ks) * 64 + lane2) * 8 + 4 * lh, acc[ft][tt][4 * g], acc[ft][tt][4 * g + 1], acc[ft][tt][4 * g + 2], acc[ft][tt][4 * g + 3]);
            }
          }
      }
    }
  }
}

DI void phase_ln(const Params& p, float* h, u16* hb, const float* g, const float* bta) {
  const int lane = threadIdx.x & 63;
  const int gw = (blockIdx.x * blockDim.x + threadIdx.x) >> 6;
  const int nw = (gridDim.x * blockDim.x) >> 6;
  for (int row = gw; row < T_; row += nw) {
    float* r = h + (size_t)row * 1024;
    f32x4 v[4]; float s = 0.f;
#pragma unroll
    for (int c = 0; c < 4; ++c) { v[c] = *reinterpret_cast<const f32x4*>(r + c * 256 + lane * 4); s += v[c][0] + v[c][1] + v[c][2] + v[c][3]; }
    const float mean = wave_sum(s) * (1.f / 1024.f);
    float q = 0.f;
#pragma unroll
    for (int c = 0; c < 4; ++c)
#pragma unroll
      for (int k = 0; k < 4; ++k) { float d = v[c][k] - mean; q += d * d; }
    const float rstd = rsqrtf(wave_sum(q) * (1.f / 1024.f) + 1e-5f);
#pragma unroll
    for (int c = 0; c < 4; ++c) {
      f32x4 gg = *reinterpret_cast<const f32x4*>(g + c * 256 + lane * 4);
      f32x4 bb = *reinterpret_cast<const f32x4*>(bta + c * 256 + lane * 4);
      f32x4 o;
#pragma unroll
      for (int k = 0; k < 4; ++k) o[k] = (v[c][k] - mean) * rstd * gg[k] + bb[k];
      *reinterpret_cast<f32x4*>(r + c * 256 + lane * 4) = o;
      st4bf(hb + (size_t)row * 1024 + c * 256 + lane * 4, o[0], o[1], o[2], o[3]);
    }
  }
}

DI void phase_xattn(const Params& p) {
  const u16* qx = (const u16*)(p.ws + OFF_QX);
  const u16* mk = (const u16*)(p.ws + OFF_MEMK);
  const u16* mv = (const u16*)(p.ws + OFF_MEMVT);
  u16* ox = (u16*)(p.ws + OFF_OX);
  const int lane = threadIdx.x & 63, lr = lane & 31, lh = lane >> 5;
  const int gw = (blockIdx.x * blockDim.x + threadIdx.x) >> 6;
  const int nw = (gridDim.x * blockDim.x) >> 6;
  for (int it = gw; it < 8 * 4 * 128; it += nw) {
    const int qt = it & 127, h = (it >> 7) & 3, b = it >> 9;
    const int tok = b * S_ + qt * 32 + lr;
    f32x16 Sx[8];
#pragma unroll
    for (int kt = 0; kt < 8; ++kt) Sx[kt] = zero16();
    const u16* qrow = qx + (((size_t)(b * 128 + qt) * 4 + h) * 16) * 512 + lane * 8;
    const u16* krow = mk + (((size_t)(b * 4 + h) * 8) * 16) * 512 + lane * 8;
#pragma unroll 2
    for (int ks = 0; ks < 16; ++ks) {
      bf16x8 qf = ldg8(qrow + ks * 512);
#pragma unroll
      for (int kt = 0; kt < 8; ++kt) Sx[kt] = MFMA(ldg8(krow + (kt * 16 + ks) * 512), qf, Sx[kt]);
    }
    float mx = -INFINITY;
#pragma unroll
    for (int kt = 0; kt < 8; ++kt)
#pragma unroll
      for (int i = 0; i < 16; ++i) mx = fmaxf(mx, Sx[kt][i]);
    mx = fmaxf(mx, __shfl_xor(mx, 32));
    float ls = 0.f;
    bf16x8 Pf[8][2];
#pragma unroll
    for (int kt = 0; kt < 8; ++kt) {
      float pv[16];
#pragma unroll
      for (int i = 0; i < 16; ++i) { pv[i] = __expf((Sx[kt][i] - mx) * 0.0625f); ls += pv[i]; }
#pragma unroll
      for (int s = 0; s < 2; ++s) Pf[kt][s] = pack8(pv[8 * s], pv[8 * s + 1], pv[8 * s + 2], pv[8 * s + 3], pv[8 * s + 4], pv[8 * s + 5], pv[8 * s + 6], pv[8 * s + 7]);
    }
    ls += __shfl_xor(ls, 32);
    const float inv = 1.f / ls;
#pragma unroll 1
    for (int dt = 0; dt < 8; ++dt) {
      f32x16 o = zero16();
      const u16* vrow = mv + ((((size_t)(b * 4 + h) * 8 + dt) * 8) * 2) * 512 + lane * 8;
#pragma unroll
      for (int kt = 0; kt < 8; ++kt)
#pragma unroll
        for (int s = 0; s < 2; ++s) o = MFMA(ldg8(vrow + (kt * 2 + s) * 512), Pf[kt][s], o);
#pragma unroll
      for (int g = 0; g < 4; ++g)
        st4bf(ox + (size_t)tok * 1024 + h * 256 + dt * 32 + 8 * g + 4 * lh, o[4 * g] * inv, o[4 * g + 1] * inv, o[4 * g + 2] * inv, o[4 * g + 3] * inv);
    }
  }
}

DI void peer_topk_item(const Params& p, int tt128, int head, char* smem) {
  float* sc = (float*)smem;
  float* topv = (float*)(smem + 132096);
  unsigned char* topi = (unsigned char*)(smem + 132096 + 16384);
  const u16* pq = (const u16*)(p.ws + OFF_QX);
  const u16* sk = (const u16*)(p.ws + OFF_SK);
  const int tid = threadIdx.x, lane = tid & 63, wave = tid >> 6, lr = lane & 31, lh = lane >> 5;
  const int tok0 = tt128 * 128;
  {
    const int half = wave >> 2, kt = wave & 3;
    bf16x8 af[8];
#pragma unroll
    for (int ks = 0; ks < 8; ++ks) af[ks] = ldg8(sk + (size_t)half * 16384 + (kt * 32 + lr) * 128 + ks * 16 + lh * 8);
#pragma unroll 1
    for (int tt = 0; tt < 4; ++tt) {
      f32x16 acc = zero16();
      const u16* brow = pq + (((((size_t)(tok0 >> 5) + tt) * 8 + head) * 2 + half) * 8) * 512 + lane * 8;
#pragma unroll
      for (int ks = 0; ks < 8; ++ks) acc = MFMA(af[ks], ldg8(brow + ks * 512), acc);
#pragma unroll
      for (int i = 0; i < 16; ++i) sc[(half * 128 + tt * 32 + lr) * 129 + kt * 32 + crow(i, lh)] = acc[i];
    }
  }
  __syncthreads();
  if (tid < 256) {
    float* row = sc + tid * 129;
    float gm[8]; int gi[8];
#pragma unroll
    for (int g = 0; g < 8; ++g) {
      float m = -INFINITY; int mi = g * 16;
#pragma unroll
      for (int j = 0; j < 16; ++j) { float v = row[g * 16 + j]; if (v > m) { m = v; mi = g * 16 + j; } }
      gm[g] = m; gi[g] = mi;
    }
#pragma unroll 1
    for (int r = 0; r < 16; ++r) {
      float best = gm[0]; int bg = 0; int bi = gi[0];
#pragma unroll
      for (int g = 1; g < 8; ++g) if (gm[g] > best) { best = gm[g]; bg = g; bi = gi[g]; }
      topv[tid * 16 + r] = best; topi[tid * 16 + r] = (unsigned char)bi;
      row[bi] = -INFINITY;
      float m = -INFINITY; int mi = bg * 16;
#pragma unroll
      for (int j = 0; j < 16; ++j) { float v = row[bg * 16 + j]; if (v > m) { m = v; mi = bg * 16 + j; } }
#pragma unroll
      for (int g = 0; g < 8; ++g) { gm[g] = (g == bg) ? m : gm[g]; gi[g] = (g == bg) ? mi : gi[g]; }
    }
  }
  __syncthreads();
  if (tid < 128) {
    const float* av = topv + tid * 16;
    const float* bv = topv + (128 + tid) * 16;
    const unsigned char* ai = topi + tid * 16;
    const unsigned char* bi_ = topi + (128 + tid) * 16;
    float cur[16]; int pp[16];
    const float b0 = bv[0];
#pragma unroll
    for (int i = 0; i < 16; ++i) { cur[i] = av[i] + b0; pp[i] = 0; }
    float sel[16]; int eid[16];
#pragma unroll
    for (int r = 0; r < 16; ++r) {
      float best = cur[0]; int bi = 0; int bj = pp[0];
#pragma unroll
      for (int i = 1; i < 16; ++i) if (cur[i] > best) { best = cur[i]; bi = i; bj = pp[i]; }
      sel[r] = best;
      eid[r] = (int)ai[bi] * 128 + (int)bi_[bj];
      const int nj = bj + 1;
      const float nv = (nj < 16) ? (av[bi] + bv[nj & 15]) : -INFINITY;
#pragma unroll
      for (int i = 0; i < 16; ++i) { cur[i] = (i == bi) ? nv : cur[i]; pp[i] = (i == bi) ? nj : pp[i]; }
    }
    float sum = 0.f;
    const float smax = sel[0];
#pragma unroll
    for (int r = 0; r < 16; ++r) { sel[r] = __expf(sel[r] - smax); sum += sel[r]; }
    const float inv = 1.f / sum;
    int* eo = (int*)(p.ws + OFF_EIDX) + (size_t)(tok0 + tid) * 128 + head * 16;
    float* go = (float*)(p.ws + OFF_GATE) + (size_t)(tok0 + tid) * 128 + head * 16;
#pragma unroll
    for (int r = 0; r < 16; ++r) { eo[r] = eid[r]; go[r] = sel[r] * inv; }
  }
  __syncthreads();
}

DI float dot2bf(unsigned a, unsigned b, float c) {
  return __builtin_amdgcn_fdot2_f32_bf16(__builtin_bit_cast(bf2_t, a), __builtin_bit_cast(bf2_t, b), c, false);
}

DI float reduce8(float (&part)[8], int lane) {
  float r4[4], r2[2], r1;
#pragma unroll
  for (int k = 0; k < 4; ++k) {
    float send = (lane & 1) ? part[2 * k] : part[2 * k + 1];
    float keep = (lane & 1) ? part[2 * k + 1] : part[2 * k];
    r4[k] = keep + __shfl_xor(send, 1);
  }
#pragma unroll
  for (int k = 0; k < 2; ++k) {
    float send = (lane & 2) ? r4[2 * k] : r4[2 * k + 1];
    float keep = (lane & 2) ? r4[2 * k + 1] : r4[2 * k];
    r2[k] = keep + __shfl_xor(send, 2);
  }
  {
    float send = (lane & 4) ? r2[0] : r2[1];
    float keep = (lane & 4) ? r2[1] : r2[0];
    r1 = keep + __shfl_xor(send, 4);
  }
  r1 += __shfl_xor(r1, 8);
  r1 += __shfl_xor(r1, 16);
  r1 += __shfl_xor(r1, 32);
  return r1;
}

DI void phase_peer_down(const Params& p) {
  const char* exd = p.ws + OFF_EXD;
  const float* esc = (const float*)(p.ws + OFF_ESC);
  const u16* hb = (const u16*)(p.ws + OFF_HB);
  const int* eidx = (const int*)(p.ws + OFF_EIDX);
  const float* gate = (const float*)(p.ws + OFF_GATE);
  float* coefw = (float*)(p.ws + OFF_COEF);
  const int lane = threadIdx.x & 63;
  const int gw = (blockIdx.x * blockDim.x + threadIdx.x) >> 6;
  const int nw = (gridDim.x * blockDim.x) >> 6;
#pragma unroll 1
  for (int sl = 0; sl < 1; ++sl) {
#pragma unroll 1
    for (int tok = gw; tok < T_; tok += nw) {
      float x[16];
      {
        const u16* xr = hb + (size_t)tok * 1024 + lane * 16;
        u32x4 a = *reinterpret_cast<const u32x4*>(xr);
        u32x4 c = *reinterpret_cast<const u32x4*>(xr + 8);
#pragma unroll
        for (int w = 0; w < 4; ++w) { x[2 * w] = bflo(a[w]); x[2 * w + 1] = bfhi(a[w]); x[8 + 2 * w] = bflo(c[w]); x[8 + 2 * w + 1] = bfhi(c[w]); }
      }
#pragma unroll 1
      for (int half = 0; half < 2; ++half) {
        const int ev = eidx[(size_t)tok * 128 + half * 64 + lane];
        const float gv = gate[(size_t)tok * 128 + half * 64 + lane];
        unsigned long long m = __builtin_amdgcn_ballot_w64((ev >> 14) == sl);
        float racc = 0.f, gacc = 0.f; int pacc = -1; int bi = 0;
        while (m != 0ull) {
          int pos[8];
          const int first = __builtin_ctzll(m);
#pragma unroll
          for (int k = 0; k < 8; ++k) {
            if (m != 0ull) { pos[k] = __builtin_ctzll(m); m &= m - 1ull; } else pos[k] = -1;
          }
          u32x4 dr[8];
#pragma unroll
          for (int k = 0; k < 8; ++k) {
            const int er = __builtin_amdgcn_readlane(ev, pos[k] >= 0 ? pos[k] : first);
            dr[k] = *reinterpret_cast<const u32x4*>(exd + (size_t)er * 1024 + lane * 16);
          }
          int pmine = pos[0];
#pragma unroll
          for (int k = 1; k < 8; ++k) pmine = ((lane & 7) == k) ? pos[k] : pmine;
          const int psafe = pmine >= 0 ? pmine : first;
          const int emine = __shfl(ev, psafe);
          const float gsel = __shfl(gv, psafe);
          const float sd = esc[emine];
          const float su = esc[16384 + emine];
          float part[8];
#pragma unroll
          for (int k = 0; k < 8; ++k) {
            float a0 = 0.f, a1 = 0.f;
#pragma unroll
            for (int w = 0; w < 4; ++w) {
              f2_t lo = __builtin_amdgcn_cvt_pk_f32_fp8((int)dr[k][w], false);
              f2_t hi = __builtin_amdgcn_cvt_pk_f32_fp8((int)dr[k][w], true);
              a0 = fmaf(lo[0], x[4 * w], a0); a1 = fmaf(lo[1], x[4 * w + 1], a1);
              a0 = fmaf(hi[0], x[4 * w + 2], a0); a1 = fmaf(hi[1], x[4 * w + 3], a1);
            }
            part[k] = a0 + a1;
          }
          const float r1 = reduce8(part, lane) * sd;
          const bool mine = (lane >> 3) == bi;
          racc = mine ? r1 : racc; gacc = mine ? gsel * su : gacc; pacc = mine ? pmine : pacc;
          ++bi;
          if (bi == 8 || m == 0ull) {
            const float act = 0.5f * racc * (1.f + erff(racc * 0.70710678118654752f));
            if (pacc >= 0) coefw[(size_t)tok * 128 + half * 64 + pacc] = gacc * act;
            pacc = -1; bi = 0;
          }
        }
      }
    }
  }
}

DI void phase_peer_ffn(const Params& p) {
  const char* exu = p.ws + OFF_EXU;
  const float* h = (const float*)(p.ws + OFF_H);
  const int* eidx = (const int*)(p.ws + OFF_EIDX);
  const float* coefw = (const float*)(p.ws + OFF_COEF);
  const int lane = threadIdx.x & 63;
  const int gw = (blockIdx.x * blockDim.x + threadIdx.x) >> 6;
  const int nw = (gridDim.x * blockDim.x) >> 6;
  for (int tok = gw; tok < T_; tok += nw) {
    float yacc[16];
#pragma unroll
    for (int i = 0; i < 16; ++i) yacc[i] = 0.f;
    const int e_lo = eidx[(size_t)tok * 128 + lane];
    const int e_hi = eidx[(size_t)tok * 128 + 64 + lane];
    const float c_lo = coefw[(size_t)tok * 128 + lane];
    const float c_hi = coefw[(size_t)tok * 128 + 64 + lane];
#pragma unroll 1
    for (int eb = 0; eb < 8; ++eb) {
      const int ev = (eb < 4) ? e_lo : e_hi;
      const float cv = (eb < 4) ? c_lo : c_hi;
      const int lbase = (eb & 3) * 16;
      u32x4 ur[16];
#pragma unroll
      for (int k = 0; k < 16; ++k) {
        const int er = __builtin_amdgcn_readlane(ev, lbase + k);
        ur[k] = *reinterpret_cast<const u32x4*>(exu + (size_t)er * 1024 + lane * 16);
      }
#pragma unroll
      for (int k = 0; k < 16; ++k) {
        const float ck = __int_as_float(__builtin_amdgcn_readlane(__float_as_int(cv), lbase + k));
#pragma unroll
        for (int w = 0; w < 4; ++w) {
          f2_t lo = __builtin_amdgcn_cvt_pk_f32_fp8((int)ur[k][w], false);
          f2_t hi = __builtin_amdgcn_cvt_pk_f32_fp8((int)ur[k][w], true);
          yacc[4 * w] = fmaf(ck, lo[0], yacc[4 * w]);
          yacc[4 * w + 1] = fmaf(ck, lo[1], yacc[4 * w + 1]);
          yacc[4 * w + 2] = fmaf(ck, hi[0], yacc[4 * w + 2]);
          yacc[4 * w + 3] = fmaf(ck, hi[1], yacc[4 * w + 3]);
        }
      }
    }
    const float* xr = h + (size_t)tok * 1024 + lane * 16;
    float v[16];
#pragma unroll
    for (int c = 0; c < 4; ++c) {
      f32x4 t = *reinterpret_cast<const f32x4*>(xr + c * 4);
#pragma unroll
      for (int k = 0; k < 4; ++k) v[4 * c + k] = ALPHA * t[k] + yacc[4 * c + k];
    }
    float s = 0.f;
#pragma unroll
    for (int i = 0; i < 16; ++i) s += v[i];
    const float mean = wave_sum(s) * (1.f / 1024.f);
    float q = 0.f;
#pragma unroll
    for (int i = 0; i < 16; ++i) { float d = v[i] - mean; q += d * d; }
    const float rstd = rsqrtf(wave_sum(q) * (1.f / 1024.f) + 1e-5f);
    float* orow = p.out + (size_t)tok * 1024 + lane * 16;
#pragma unroll
    for (int c = 0; c < 4; ++c) {
      f32x4 gg = *reinterpret_cast<const f32x4*>(p.ln_ffn_g + lane * 16 + c * 4);
      f32x4 bb = *reinterpret_cast<const f32x4*>(p.ln_ffn_b + lane * 16 + c * 4);
      f32x4 o;
#pragma unroll
      for (int k = 0; k < 4; ++k) o[k] = (v[4 * c + k] - mean) * rstd * gg[k] + bb[k];
      *reinterpret_cast<f32x4*>(orow + c * 4) = o;
    }
  }
}

constexpr size_t OFF_BAR = 166 * MiB;
DI void gbar(unsigned* ctr, unsigned target) {
  asm volatile("s_waitcnt vmcnt(0)" ::: "memory");
  __syncthreads();
  if (threadIdx.x == 0) {
    __builtin_amdgcn_fence(__ATOMIC_RELEASE, "agent");
    asm volatile("s_waitcnt vmcnt(0)" ::: "memory");
    __hip_atomic_fetch_add(ctr, 1u, __ATOMIC_RELAXED, __HIP_MEMORY_SCOPE_AGENT);
    while (__hip_atomic_load(ctr, __ATOMIC_RELAXED, __HIP_MEMORY_SCOPE_AGENT) < target) __builtin_amdgcn_s_sleep(2);
    __builtin_amdgcn_fence(__ATOMIC_ACQUIRE, "agent");
    asm volatile("s_waitcnt vmcnt(0)" ::: "memory");
  }
  __syncthreads();
}

__global__ void __launch_bounds__(512) fwd_megakernel(Params p) {
  __shared__ __attribute__((aligned(1024))) char smem[155648];
  cg::grid_group grid = cg::this_grid();
  const int G = gridDim.x;
  char* ws = p.ws;
  unsigned* bar = (unsigned*)(ws + OFF_BAR);

  phase_prep(p, smem);
  grid.sync();

  phase_inproj(p, smem);
  gbar(bar, (unsigned)(1 * G));

  for (int k = 0; k * G < 1024; ++k) {
    int j = (k & 1) ? (G - 1 - (int)blockIdx.x) : (int)blockIdx.x;
    int idx = k * G + j;
    if (idx < 1024) dsa_thr_item(p, idx & 7, 127 - (idx >> 3), smem);
  }
  for (int it = blockIdx.x; it < 2048; it += G) gla_g1_item(p, it, smem);
  gbar(bar, (unsigned)(2 * G));

  for (int k = 0; k * G < 1024; ++k) {
    int j = (k & 1) ? (G - 1 - (int)blockIdx.x) : (int)blockIdx.x;
    int idx = k * G + j;
    if (idx < 1024) dsa_attn_item(p, idx & 7, 127 - (idx >> 3), smem);
  }
  gla_scan(p);
  gbar(bar, (unsigned)(3 * G));

  for (int it = blockIdx.x; it < 2048; it += G) gla_g3_item(p, it, smem);
  gbar(bar, (unsigned)(4 * G));

  phase_gemm<0>(p, (const u16*)(ws + OFF_XB), (const u16*)(ws + OFF_WOUT), 1024, p.x, (float*)(ws + OFF_H), nullptr, 0, smem);
  gbar(bar, (unsigned)(5 * G));
  phase_ln(p, (float*)(ws + OFF_H), (u16*)(ws + OFF_HB), p.ln_mix_g, p.ln_mix_b);
  gbar(bar, (unsigned)(6 * G));

  phase_gemm<2>(p, (const u16*)(ws + OFF_HB), (const u16*)(ws + OFF_WQ), 1024, nullptr, nullptr, (u16*)(ws + OFF_QX), 1024, smem);
  gbar(bar, (unsigned)(7 * G));
  phase_xattn(p);
  gbar(bar, (unsigned)(8 * G));
  phase_gemm<0>(p, (const u16*)(ws + OFF_OX), (const u16*)(ws + OFF_WO), 1024, (const float*)(ws + OFF_H), (float*)(ws + OFF_H), nullptr, 0, smem);
  gbar(bar, (unsigned)(9 * G));
  phase_ln(p, (float*)(ws + OFF_H), (u16*)(ws + OFF_HB), p.ln_mem_g, p.ln_mem_b);
  gbar(bar, (unsigned)(10 * G));

  phase_gemm<5>(p, (const u16*)(ws + OFF_HB), (const u16*)(ws + OFF_WPQ), 2048, nullptr, nullptr, (u16*)(ws + OFF_QX), 2048, smem);
  gbar(bar, (unsigned)(11 * G));
  for (int it = blockIdx.x; it < 2048; it += G) peer_topk_item(p, it >> 3, it & 7, smem);
  gbar(bar, (unsigned)(12 * G));
  phase_peer_down(p);
  gbar(bar, (unsigned)(13 * G));
  phase_peer_ffn(p);
}

extern "C" void kernel_launch(void* const* d_in, const int* in_sizes, int n_in,
                              void* d_out, int out_size, void* d_ws, size_t ws_size,
                              hipStream_t stream) {
  static int grid_blocks = 0;
  if (!grid_blocks) {
    int dev = 0, cus = 0, per_cu = 0;
    (void)hipGetDevice(&dev);
    (void)hipDeviceGetAttribute(&cus, hipDeviceAttributeMultiprocessorCount, dev);
    (void)hipOccupancyMaxActiveBlocksPerMultiprocessor(&per_cu, fwd_megakernel, 512, 0);
    if (per_cu > 1) per_cu = 1;
    grid_blocks = cus * per_cu;
    if (grid_blocks > 256) grid_blocks = 256;
    if (ws_size < 512 * MiB) fprintf(stderr, "workspace too small: %zu\n", ws_size);
  }
  Params p{};
  p.x = (const float*)d_in[0]; p.positions = (const int*)d_in[1]; p.mem = (const float*)d_in[2]; p.w_in = (const float*)d_in[3];
  p.gate_up = (const float*)d_in[4]; p.gate_bias = (const float*)d_in[5]; p.norm_g = (const float*)d_in[6]; p.w_out = (const float*)d_in[7];
  p.ln_mix_g = (const float*)d_in[8]; p.ln_mix_b = (const float*)d_in[9];
  p.wq = (const float*)d_in[10]; p.wk = (const float*)d_in[11]; p.wv = (const float*)d_in[12]; p.wo = (const float*)d_in[13];
  p.ln_mem_g = (const float*)d_in[14]; p.ln_mem_b = (const float*)d_in[15];
  p.w_pq = (const float*)d_in[16]; p.sk1 = (const float*)d_in[17]; p.sk2 = (const float*)d_in[18];
  p.ex_down = (const float*)d_in[19]; p.ex_up = (const float*)d_in[20];
  p.ln_ffn_g = (const float*)d_in[21]; p.ln_ffn_b = (const float*)d_in[22];
  p.out = (float*)d_out; p.ws = (char*)d_ws;
  (void)hipMemsetAsync((char*)d_ws + OFF_BAR, 0, 256, stream);
  void* args[] = {&p};
  hipError_t e = hipLaunchCooperativeKernel((void*)fwd_megakernel, dim3(grid_blocks), dim3(512), args, 0, stream);
  if (e != hipSuccess) fprintf(stderr, "cooperative launch failed: %s (grid %d)\n", hipGetErrorString(e), grid_blocks);
}
```

```cpp
#include <hip/hip_runtime.h>
#include <hip/hip_cooperative_groups.h>
#include <cstdio>
#include <cmath>
namespace cg = cooperative_groups;

#define DI __device__ __forceinline__
typedef short bf16x8 __attribute__((ext_vector_type(8)));
typedef short bf16x4 __attribute__((ext_vector_type(4)));
typedef float f32x16 __attribute__((ext_vector_type(16)));
typedef float f32x4 __attribute__((ext_vector_type(4)));
typedef unsigned u32x4 __attribute__((ext_vector_type(4)));
typedef unsigned u32x2 __attribute__((ext_vector_type(2)));
typedef unsigned short u16;
typedef __bf16 bf2_t __attribute__((ext_vector_type(2)));
typedef float f2_t __attribute__((ext_vector_type(2)));

#define MFMA(a, b, c) __builtin_amdgcn_mfma_f32_32x32x16_bf16((a), (b), (c), 0, 0, 0)

constexpr int T_ = 32768;
constexpr int S_ = 4096;
constexpr int TMW = 2368;
constexpr int TM_Q = 0, TM_K = 512, TM_QI = 1024, TM_KI = 1280, TM_WI = 1312, TM_GLR = 1320, TM_GQ = 1344, TM_GK = 1600, TM_GR = 1856;
constexpr int PROJ_N = 3456;
constexpr float ALPHA = 1.189207115002721f;
constexpr size_t MiB = 1024 * 1024;

constexpr size_t OFF_XB = 0;
constexpr size_t OFF_EXD = 64 * MiB;
constexpr size_t OFF_EXU = 80 * MiB;
constexpr size_t OFF_BCG = 96 * MiB;
constexpr size_t OFF_WIN = 128 * MiB;
constexpr size_t OFF_WOUT = OFF_WIN + (size_t)PROJ_N * 1024 * 2;
constexpr size_t OFF_WQ = OFF_WOUT + 2 * MiB;
constexpr size_t OFF_WK = OFF_WQ + 2 * MiB;
constexpr size_t OFF_WV = OFF_WK + 2 * MiB;
constexpr size_t OFF_WO = OFF_WV + 2 * MiB;
constexpr size_t OFF_WPQ = OFF_WO + 2 * MiB;
constexpr size_t OFF_KIF = 149 * MiB;
constexpr size_t OFF_MEMB = 152 * MiB;
constexpr size_t OFF_MEMK = 156 * MiB;
constexpr size_t OFF_MEMVT = 160 * MiB;
constexpr size_t OFF_THR = 164 * MiB;
constexpr size_t OFF_SK = OFF_THR + 256 * 1024;
constexpr size_t OFF_DECAY = OFF_SK + 128 * 1024;
constexpr size_t OFF_ESC = 165 * MiB;
constexpr size_t OFF_TM = 168 * MiB;
constexpr size_t OFF_VT = 316 * MiB;
constexpr size_t OFF_KFR = 476 * MiB;
constexpr size_t OFF_GVT = 348 * MiB;
constexpr size_t OFF_KVT = 380 * MiB;
constexpr size_t OFF_PREV = 444 * MiB;
constexpr size_t OFF_H = 168 * MiB;
constexpr size_t OFF_HB = 296 * MiB;
constexpr size_t OFF_QX = 360 * MiB;
constexpr size_t OFF_OX = 424 * MiB;
constexpr size_t OFF_EIDX = 0;
constexpr size_t OFF_GATE = 16 * MiB;
constexpr size_t OFF_COEF = 32 * MiB;

struct Params {
  const float* x; const int* positions; const float* mem; const float* w_in;
  const float* gate_up; const float* gate_bias; const float* norm_g; const float* w_out;
  const float* ln_mix_g; const float* ln_mix_b;
  const float* wq; const float* wk; const float* wv; const float* wo;
  const float* ln_mem_g; const float* ln_mem_b;
  const float* w_pq; const float* sk1; const float* sk2; const float* ex_down; const float* ex_up;
  const float* ln_ffn_g; const float* ln_ffn_b;
  float* out; char* ws;
};

DI unsigned pk_bf16(float a, float b) {
  f2_t v = {a, b};
  bf2_t r = __builtin_convertvector(v, bf2_t);
  return __builtin_bit_cast(unsigned, r);
}
DI u16 f2bf(float a) { return (u16)(pk_bf16(a, 0.f) & 0xffffu); }
DI float bf2f(u16 u) { return __uint_as_float(((unsigned)u) << 16); }
DI float bflo(unsigned u) { return __uint_as_float(u << 16); }
DI float bfhi(unsigned u) { return __uint_as_float(u & 0xffff0000u); }
DI int crow(int i, int h) { return (i & 3) + 8 * (i >> 2) + 4 * h; }
DI bf16x8 ldg8(const u16* p) { return *reinterpret_cast<const bf16x8*>(p); }
DI bf16x8 pack8(float a0, float a1, float a2, float a3, float a4, float a5, float a6, float a7) {
  u32x4 r; r[0] = pk_bf16(a0, a1); r[1] = pk_bf16(a2, a3); r[2] = pk_bf16(a4, a5); r[3] = pk_bf16(a6, a7);
  return __builtin_bit_cast(bf16x8, r);
}
DI bf16x8 cat44(bf16x4 lo, bf16x4 hi) { return __builtin_shufflevector(lo, hi, 0, 1, 2, 3, 4, 5, 6, 7); }
DI void st4bf(u16* p, float a, float b, float c, float d) {
  u32x2 v; v[0] = pk_bf16(a, b); v[1] = pk_bf16(c, d);
  *reinterpret_cast<u32x2*>(p) = v;
}
DI float wave_sum(float v) {
#pragma unroll
  for (int d = 32; d >= 1; d >>= 1) v += __shfl_xor(v, d);
  return v;
}
DI void sincos_rad(float ang, float& s, float& c) {
  constexpr float C_hi = (float)0.15915494309189535;
  constexpr float C_lo = (float)(0.15915494309189535 - (double)C_hi);
  float k = rintf(ang * C_hi);
  float f = fmaf(ang, C_hi, -k);
  f = fmaf(ang, C_lo, f);
  s = __builtin_amdgcn_sinf(f);
  c = __builtin_amdgcn_cosf(f);
}
DI unsigned fkey(float s) {
  const unsigned u = __float_as_uint(s);
  return u ^ ((unsigned)((int)u >> 31) | 0x80000000u);
}
DI f32x16 zero16() { f32x16 z; for (int i = 0; i < 16; ++i) z[i] = 0.f; return z; }

DI int win_src_col(int n) {
  if (n < 1832) return n;
  if (n < 1848) return 2856 + (n - 1832);
  if (n < 1856) return -1;
  if (n < 2880) return n - 24;
  if (n < 3392) return n - 8;
  return -1;
}

DI void cvt_stream(const float* __restrict__ src, u16* __restrict__ dst, size_t n, size_t gtid, size_t gn) {
  size_t n8 = n / 8;
  for (size_t i = gtid; i < n8; i += gn) {
    f32x4 a = *reinterpret_cast<const f32x4*>(src + i * 8);
    f32x4 b = *reinterpret_cast<const f32x4*>(src + i * 8 + 4);
    u32x4 r; r[0] = pk_bf16(a[0], a[1]); r[1] = pk_bf16(a[2], a[3]); r[2] = pk_bf16(b[0], b[1]); r[3] = pk_bf16(b[2], b[3]);
    *reinterpret_cast<u32x4*>(dst + i * 8) = r;
  }
}

template <bool MAPPED>
DI void transpose_tile(const float* __restrict__ W, int ldn, u16* __restrict__ Wt, int k0, int n0, float* tile) {
  const int tid = threadIdx.x;
  {
    int nn = n0 + (tid & 63);
    int c = MAPPED ? win_src_col(nn) : nn;
#pragma unroll
    for (int rr = 0; rr < 8; ++rr) {
      int kk = (tid >> 6) + 8 * rr;
      float v = (c >= 0) ? W[(size_t)(k0 + kk) * ldn + c] : 0.f;
      tile[kk * 65 + (tid & 63)] = v;
    }
  }
  __syncthreads();
#pragma unroll
  for (int rr = 0; rr < 8; ++rr) {
    int nn = (tid >> 6) + 8 * rr;
    int kk = tid & 63;
    Wt[(size_t)(n0 + nn) * 1024 + k0 + kk] = f2bf(tile[kk * 65 + nn]);
  }
  __syncthreads();
}

DI void phase_prep(const Params& p, char* smem) {
  const size_t gtid = (size_t)blockIdx.x * blockDim.x + threadIdx.x;
  const size_t gn = (size_t)gridDim.x * blockDim.x;
  char* ws = p.ws;
  cvt_stream(p.x, (u16*)(ws + OFF_XB), (size_t)T_ * 1024, gtid, gn);
  cvt_stream(p.mem, (u16*)(ws + OFF_MEMB), (size_t)2048 * 1024, gtid, gn);
  {
    const int lane = threadIdx.x & 63;
    const int gw = (int)(gtid >> 6), nw = (int)(gn >> 6);
    for (int r = gw; r < 2 * 16384; r += nw) {
      const int tbl = r >> 14, row = r & 16383;
      const float* src = (tbl ? p.ex_up : p.ex_down) + (size_t)row * 1024 + lane * 16;
      f32x4 v[4]; float mx = 0.f;
#pragma unroll
      for (int c = 0; c < 4; ++c) {
        v[c] = *reinterpret_cast<const f32x4*>(src + c * 4);
#pragma unroll
        for (int k = 0; k < 4; ++k) mx = fmaxf(mx, fabsf(v[c][k]));
      }
#pragma unroll
      for (int d = 32; d >= 1; d >>= 1) mx = fmaxf(mx, __shfl_xor(mx, d));
      float sc = (mx > 0.f) ? exp2f(floorf(log2f(224.f / mx))) : 1.f;
      u32x4 o;
#pragma unroll
      for (int c = 0; c < 4; ++c) {
        int t = __builtin_amdgcn_cvt_pk_fp8_f32(v[c][0] * sc, v[c][1] * sc, 0, false);
        t = __builtin_amdgcn_cvt_pk_fp8_f32(v[c][2] * sc, v[c][3] * sc, t, true);
        o[c] = (unsigned)t;
      }
      *reinterpret_cast<u32x4*>(ws + (tbl ? OFF_EXU : OFF_EXD) + (size_t)row * 1024 + lane * 16) = o;
      if (lane == 0) ((float*)(ws + OFF_ESC))[r] = 1.f / sc;
    }
  }
  cvt_stream(p.sk1, (u16*)(ws + OFF_SK), (size_t)128 * 128, gtid, gn);
  cvt_stream(p.sk2, (u16*)(ws + OFF_SK) + 128 * 128, (size_t)128 * 128, gtid, gn);
  float* tile = (float*)smem;
  const int n_win = 54 * 16, n_sq = 256, n_pq = 512;
  const int total = n_win + 5 * n_sq + n_pq;
  for (int t = blockIdx.x; t < total; t += gridDim.x) {
    if (t < n_win) {
      transpose_tile<true>(p.w_in, 3384, (u16*)(ws + OFF_WIN), (t & 15) * 64, (t >> 4) * 64, tile);
    } else if (t < n_win + 5 * n_sq) {
      int u = t - n_win; int which = u >> 8; int r = u & 255;
      const float* W = which == 0 ? p.w_out : which == 1 ? p.wq : which == 2 ? p.wk : which == 3 ? p.wv : p.wo;
      size_t off = which == 0 ? OFF_WOUT : which == 1 ? OFF_WQ : which == 2 ? OFF_WK : which == 3 ? OFF_WV : OFF_WO;
      transpose_tile<false>(W, 1024, (u16*)(ws + off), (r & 15) * 64, (r >> 4) * 64, tile);
    } else {
      int r = t - n_win - 5 * n_sq;
      transpose_tile<false>(p.w_pq, 2048, (u16*)(ws + OFF_WPQ), (r & 15) * 64, (r >> 4) * 64, tile);
    }
  }
}

#define WAIT_V(n) asm volatile("s_waitcnt vmcnt(%0)" ::"n"(n) : "memory")
#define RAW_BARRIER() do { asm volatile("s_waitcnt lgkmcnt(0)" ::: "memory"); __builtin_amdgcn_s_barrier(); asm volatile("" ::: "memory"); } while (0)
constexpr int G_STAGE = 384 * 128;
DI void gemm_tile(const u16* __restrict__ X, int ldx, const u16* __restrict__ Wt, int ldw, int K, char* smem,
                  f32x16 (&acc)[2][2]) {
  const int tid = threadIdx.x, lane = tid & 63, wave = tid >> 6;
  const int fw = wave & 1, tq = wave >> 1, lr = lane & 31, lh = lane >> 5;
#pragma unroll
  for (int a = 0; a < 2; ++a)
#pragma unroll
    for (int b = 0; b < 2; ++b) acc[a][b] = zero16();
  const int nk = K / 64;
  const u16* src[6];
#pragma unroll
  for (int i = 0; i < 6; ++i) {
    const int R = 8 * (wave + 8 * i) + (lane >> 3);
    const int c = (lane & 7) ^ ((R >> 1) & 7);
    src[i] = (i < 4) ? (X + (size_t)R * ldx + c * 8) : (Wt + (size_t)(R - 256) * ldw + c * 8);
  }
#define GLDS_STAGE(slot, kt) do { _Pragma("unroll") for (int i = 0; i < 6; ++i) \
    __builtin_amdgcn_global_load_lds((const unsigned*)(src[i] + (kt) * 64), (__attribute__((address_space(3))) unsigned*)(smem + (slot) * G_STAGE + (wave + 8 * i) * 1024), 16, 0, 0); } while (0)
  int offA[2], offB[2], xa[2], xb[2];
#pragma unroll
  for (int ft = 0; ft < 2; ++ft) { const int R = 256 + fw * 64 + ft * 32 + lr; offA[ft] = R * 128; xa[ft] = (R >> 1) & 7; }
#pragma unroll
  for (int tt = 0; tt < 2; ++tt) { const int R = tq * 64 + tt * 32 + lr; offB[tt] = R * 128; xb[tt] = (R >> 1) & 7; }
  GLDS_STAGE(0, 0); GLDS_STAGE(1, 1); WAIT_V(6); RAW_BARRIER();
  int cur = 0;
  for (int kt = 0; kt < nk; ++kt) {
    const int nxt = (cur >= 1) ? cur - 1 : 2;
    if (kt + 2 < nk) GLDS_STAGE(nxt, kt + 2);
    __builtin_amdgcn_sched_barrier(0);
    const char* st = smem + cur * G_STAGE;
#pragma unroll
    for (int ks = 0; ks < 4; ++ks) {
      bf16x8 a[2], b[2];
#pragma unroll
      for (int ft = 0; ft < 2; ++ft) a[ft] = *reinterpret_cast<const bf16x8*>(st + offA[ft] + (((ks * 2 + lh) ^ xa[ft]) << 4));
#pragma unroll
      for (int tt = 0; tt < 2; ++tt) b[tt] = *reinterpret_cast<const bf16x8*>(st + offB[tt] + (((ks * 2 + lh) ^ xb[tt]) << 4));
#pragma unroll
      for (int ft = 0; ft < 2; ++ft)
#pragma unroll
        for (int tt = 0; tt < 2; ++tt) acc[ft][tt] = MFMA(a[ft], b[tt], acc[ft][tt]);
    }
    if (kt + 2 < nk) { WAIT_V(6); } else { WAIT_V(0); }
    RAW_BARRIER();
    cur = (cur == 2) ? 0 : cur + 1;
  }
#undef GLDS_STAGE
}

DI void store_tm_rows(f32x16 (&acc)[2][2], char* smem, u16* tm, int tokbase, int col) {
  const int lane = threadIdx.x & 63, wave = threadIdx.x >> 6, lr = lane & 31, lh = lane >> 5;
  float* wl = (float*)(smem + wave * 17408);
#pragma unroll
  for (int tt = 0; tt < 2; ++tt)
#pragma unroll
    for (int ft = 0; ft < 2; ++ft)
#pragma unroll
      for (int g = 0; g < 4; ++g) {
        f32x4 v = {acc[ft][tt][4 * g], acc[ft][tt][4 * g + 1], acc[ft][tt][4 * g + 2], acc[ft][tt][4 * g + 3]};
        *reinterpret_cast<f32x4*>(wl + (tt * 32 + lr) * 68 + ft * 32 + 8 * g + 4 * lh) = v;
      }
  const int ch = lane & 15, r0 = lane >> 4;
#pragma unroll 4
  for (int k = 0; k < 16; ++k) {
    const int row = r0 + 4 * k;
    f32x4 v = *reinterpret_cast<const f32x4*>(wl + row * 68 + ch * 4);
    st4bf(tm + (size_t)(tokbase + row) * TMW + col + ch * 4, v[0], v[1], v[2], v[3]);
  }
}

DI void epi_inproj(const Params& p, int tok0, int f0, f32x16 (&acc)[2][2], char* smem) {
  const int tid = threadIdx.x, lane = tid & 63, wave = tid >> 6;
  const int fw = wave & 1, tq = wave >> 1, lr = lane & 31, lh = lane >> 5;
  const int fbase = f0 + fw * 64;
  if (fbase >= 3392) return;
  u16* tm = (u16*)(p.ws + OFF_TM);
  int tmcol = -1;
#pragma unroll
  for (int tt = 0; tt < 2; ++tt) {
    const int tok = tok0 + tq * 64 + tt * 32 + lr;
    const float posf = (float)p.positions[tok];
    const int bb = tok >> 12, ss = tok & 4095;
    if (fbase < 1024) {
#pragma unroll
      for (int r = 0; r < 4; ++r) {
        float j = (float)(4 * lh + r);
        float inv = exp2f(-j * (18.931568569324174f / 8.0f));
        float sn, cs; sincos_rad(posf * inv, sn, cs);
        float x1 = acc[0][tt][r], x2 = acc[0][tt][r + 4];
        acc[0][tt][r] = x1 * cs - x2 * sn;
        acc[0][tt][r + 4] = x2 * cs + x1 * sn;
      }
      if (fbase < 512) {
        tmcol = fbase;
      } else {
        u16* kfr = (u16*)(p.ws + OFF_KFR);
        const int head = (fbase - 512) >> 6, gt = ss >> 5;
#pragma unroll
        for (int ft = 0; ft < 2; ++ft)
#pragma unroll
          for (int g = 0; g < 4; ++g) {
            const int ks = ft * 2 + (g >> 1), lane2 = (g & 1) * 32 + lr;
            st4bf(kfr + ((((size_t)(bb * 8 + head) * 128 + gt) * 4 + ks) * 64 + lane2) * 8 + 4 * lh, acc[ft][tt][4 * g], acc[ft][tt][4 * g + 1], acc[ft][tt][4 * g + 2], acc[ft][tt][4 * g + 3]);
          }
      }
    } else if (fbase < 1536) {
      u16* vfr = (u16*)(p.ws + OFF_VT);
      const int head = (fbase - 1024) >> 6, gt = ss >> 5;
      const int s = lr >> 4, r16 = lr & 15, j = 4 * (r16 >> 3) + (r16 & 3), lh2 = (r16 >> 2) & 1;
#pragma unroll
      for (int ft = 0; ft < 2; ++ft)
#pragma unroll
        for (int i = 0; i < 16; ++i) {
          const int lane2 = lh2 * 32 + crow(i, lh);
          vfr[((((((size_t)(bb * 8 + head) * 128 + gt) * 2 + ft) * 2 + s) * 64 + lane2) * 8) + j] = f2bf(acc[ft][tt][i]);
        }
    } else if (fbase >= 2368 && fbase < 2880) {
      u16* vt = (u16*)(p.ws + OFF_GVT);
      const int fo = fbase - 2368;
#pragma unroll
      for (int ft = 0; ft < 2; ++ft)
#pragma unroll
        for (int i = 0; i < 16; ++i) {
          int feat = fo + ft * 32 + crow(i, lh);
          vt[((size_t)bb * 512 + feat) * 4096 + ss] = f2bf(acc[ft][tt][i]);
        }
    } else {
      if (fbase < 1856) {
#pragma unroll
        for (int ft = 0; ft < 2; ++ft) {
          const bool rot = (fbase < 1792) || (ft == 0);
#pragma unroll
          for (int r = 0; r < 4; ++r) {
            float v = acc[ft][tt][r];
            float o = __shfl_xor(v, 32);
            float inv = exp2f(-(float)r * (18.931568569324174f / 4.0f));
            float sn, cs; sincos_rad(posf * inv, sn, cs);
            float res = (lh == 0) ? (v * cs - o * sn) : (v * cs + o * sn);
            acc[ft][tt][r] = rot ? res : v;
          }
        }
        tmcol = fbase - 512;
        if (fbase == 1792) {
          u16* kif = (u16*)(p.ws + OFF_KIF);
          const int gt = ss >> 5;
#pragma unroll
          for (int g = 0; g < 4; ++g) {
            const int ks = g >> 1, lane2 = (g & 1) * 32 + lr;
            st4bf(kif + ((((size_t)bb * 128 + gt) * 2 + ks) * 64 + lane2) * 8 + 4 * lh, acc[0][tt][4 * g], acc[0][tt][4 * g + 1], acc[0][tt][4 * g + 2], acc[0][tt][4 * g + 3]);
          }
        }
      } else if (fbase < 2368) {
        tmcol = fbase - 512;
      } else {
        tmcol = fbase - 1024;
      }
    }
  }
  if (tmcol >= 0) store_tm_rows(acc, smem, tm, tok0 + tq * 64, tmcol);
}

DI void phase_inproj(const Params& p, char* smem) {
  const int n_in = 128 * 27;
  const int total = n_in + 128;
  const u16* xb = (const u16*)(p.ws + OFF_XB);
  const u16* memb = (const u16*)(p.ws + OFF_MEMB);
  const int tid = threadIdx.x, lane = tid & 63, wave = tid >> 6;
  const int fw = wave & 1, tq = wave >> 1, lr = lane & 31, lh = lane >> 5;
  for (int t = blockIdx.x; t < total; t += gridDim.x) {
    f32x16 acc[2][2];
    if (t < n_in) {
      int mt = t / 27, nt = t % 27;
      gemm_tile(xb + (size_t)mt * 256 * 1024, 1024, (const u16*)(p.ws + OFF_WIN) + (size_t)nt * 128 * 1024, 1024, 1024, smem, acc);
      epi_inproj(p, mt * 256, nt * 128, acc, smem);
      __syncthreads();
    } else {
      int u = t - n_in; int which = u >> 6; int r = u & 63; int mt = r >> 3, nt = r & 7;
      const u16* W = (const u16*)(p.ws + (which == 0 ? OFF_WK : OFF_WV));
      gemm_tile(memb + (size_t)mt * 256 * 1024, 1024, W + (size_t)nt * 128 * 1024, 1024, 1024, smem, acc);
#pragma unroll
      for (int tt = 0; tt < 2; ++tt) {
        const int tok = mt * 256 + tq * 64 + tt * 32 + lr;
        const int bb = tok >> 8, mm = tok & 255, hh = nt >> 1, kt = mm >> 5;
        if (which == 0) {
          u16* mk = (u16*)(p.ws + OFF_MEMK);
#pragma unroll
          for (int ft = 0; ft < 2; ++ft)
#pragma unroll
            for (int g = 0; g < 4; ++g) {
              const int ks = (nt & 1) * 8 + fw * 4 + ft * 2 + (g >> 1), lane2 = (g & 1) * 32 + lr;
              st4bf(mk + ((((size_t)(bb * 4 + hh) * 8 + kt) * 16 + ks) * 64 + lane2) * 8 + 4 * lh, acc[ft][tt][4 * g], acc[ft][tt][4 * g + 1], acc[ft][tt][4 * g + 2], acc[ft][tt][4 * g + 3]);
            }
        } else {
          u16* mv = (u16*)(p.ws + OFF_MEMVT);
          const int s = lr >> 4, r16 = lr & 15, j = 4 * (r16 >> 3) + (r16 & 3), lh2 = (r16 >> 2) & 1;
#pragma unroll
          for (int ft = 0; ft < 2; ++ft) {
            const int dt = (nt & 1) * 4 + fw * 2 + ft;
#pragma unroll
            for (int i = 0; i < 16; ++i) {
              const int lane2 = lh2 * 32 + crow(i, lh);
              mv[((((((size_t)(bb * 4 + hh) * 8 + dt) * 8 + kt) * 2 + s) * 64 + lane2) * 8) + j] = f2bf(acc[ft][tt][i]);
            }
          }
        }
      }
    }
  }
}

DI void idx_scores(const bf16x8 (&qf)[8][2], const float (&wq)[8], bf16x8 k0, bf16x8 k1, float (&sc)[16]) {
#pragma unroll
  for (int i = 0; i < 16; ++i) sc[i] = 0.f;
#pragma unroll
  for (int hd = 0; hd < 8; ++hd) {
    f32x16 a = zero16();
    a = MFMA(k0, qf[hd][0], a);
    a = MFMA(k1, qf[hd][1], a);
#pragma unroll
    for (int i = 0; i < 16; ++i) sc[i] = fmaf(wq[hd], fmaxf(a[i], 0.f), sc[i]);
  }
}

DI void load_idx_q(const u16* tm, int tok, int lh, bf16x8 (&qf)[8][2], float (&wq)[8]) {
  const u16* row = tm + (size_t)tok * TMW;
#pragma unroll
  for (int hd = 0; hd < 8; ++hd)
#pragma unroll
    for (int ks = 0; ks < 2; ++ks) qf[hd][ks] = ldg8(row + TM_QI + hd * 32 + ks * 16 + lh * 8);
  bf16x8 w8 = ldg8(row + TM_WI);
#pragma unroll
  for (int hd = 0; hd < 8; ++hd) wq[hd] = bf2f((u16)w8[hd]) * 0.0625f;
}

DI int wave_incl_scan(int v, int lane) {
#pragma unroll
  for (int d = 1; d < 64; d <<= 1) {
    int t = __shfl_up(v, d);
    if (lane >= d) v += t;
  }
  return v;
}

DI void dsa_thr_item(const Params& p, int b, int qblk, char* smem) {
  unsigned* hist = (unsigned*)smem;
  unsigned* pref = (unsigned*)(smem + 32768);
  int* rank = (int*)(smem + 32768 + 128);
  const u16* tm = (const u16*)(p.ws + OFF_TM);
  const int tid = threadIdx.x, lane = tid & 63, wave = tid >> 6, lr = lane & 31, lh = lane >> 5;
  const int q0 = qblk * 32;
  u16* qi = (u16*)(smem + 33280);
  for (int i = tid; i < 32 * 32; i += 512) {
    int q = i >> 5, ch = i & 31;
    *reinterpret_cast<u32x4*>(qi + q * 296 + ch * 8) = *reinterpret_cast<const u32x4*>(tm + (size_t)(b * S_ + q0 + q) * TMW + TM_QI + ch * 8);
  }
  float wq[8];
  {
    bf16x8 w8 = ldg8(tm + (size_t)(b * S_ + q0 + lr) * TMW + TM_WI);
#pragma unroll
    for (int hd = 0; hd < 8; ++hd) wq[hd] = bf2f((u16)w8[hd]) * 0.0625f;
  }
  __syncthreads();
  for (int i = tid; i < 32 * 32; i += 512) {
    const int q = i >> 5, d = i & 31;
    float acc = 0.f;
#pragma unroll
    for (int hd = 0; hd < 8; ++hd) acc = fmaf(bf2f(tm[(size_t)(b * S_ + q0 + q) * TMW + TM_WI + hd]) * 0.0625f, bf2f(qi[q * 296 + hd * 32 + d]), acc);
    qi[q * 296 + 256 + d] = f2bf(acc);
  }
  const u16* qil = qi + lr * 296 + lh * 8;
  if (tid < 32) { pref[tid] = 0u; rank[tid] = min(256, q0 + tid + 1); }
  for (int pass = 0; pass < 4; ++pass) {
    for (int i = tid; i < 8192; i += 512) hist[i] = 0u;
    __syncthreads();
    const int shift = 24 - 8 * pass;
    const unsigned mypref = pref[lr];
    const u16* kib = (const u16*)(p.ws + OFF_KIF) + (size_t)b * 128 * 1024 + lane * 8;
    bf16x8 kn0, kn1;
    {
      const int kt0 = min(wave, qblk);
      kn0 = ldg8(kib + (size_t)kt0 * 1024); kn1 = ldg8(kib + (size_t)kt0 * 1024 + 512);
    }
    for (int kt = wave; kt <= qblk; kt += 8) {
      const bf16x8 k0 = kn0, k1 = kn1;
      {
        const int ktn = min(kt + 8, qblk);
        kn0 = ldg8(kib + (size_t)ktn * 1024); kn1 = ldg8(kib + (size_t)ktn * 1024 + 512);
      }
      float sc[16];
      {
        f32x16 a = zero16();
        a = MFMA(k0, *reinterpret_cast<const bf16x8*>(qil + 256), a);
        a = MFMA(k1, *reinterpret_cast<const bf16x8*>(qil + 256 + 16), a);
#pragma unroll
        for (int i = 0; i < 16; ++i) sc[i] = a[i];
      }
#pragma unroll
      for (int hd = 0; hd < 8; ++hd) {
        f32x16 a = zero16();
        a = MFMA(k0, *reinterpret_cast<const bf16x8*>(qil + hd * 32), a);
        a = MFMA(k1, *reinterpret_cast<const bf16x8*>(qil + hd * 32 + 16), a);
        const float wh = wq[hd];
#pragma unroll
        for (int i = 0; i < 16; ++i) sc[i] = fmaf(fabsf(a[i]), wh, sc[i]);
      }
      if (kt == qblk) {
#pragma unroll
        for (int i = 0; i < 16; ++i) {
          int kp = kt * 32 + crow(i, lh);
          unsigned ky = fkey(sc[i]);
          unsigned hi = (ky >> shift);
          if (kp <= q0 + lr && (hi >> 8) == mypref) atomicAdd(&hist[(hi & 255u) * 32 + lr], 1u);
        }
      } else {
#pragma unroll
        for (int i = 0; i < 16; ++i) {
          unsigned ky = fkey(sc[i]);
          unsigned hi = (ky >> shift);
          if ((hi >> 8) == mypref) atomicAdd(&hist[(hi & 255u) * 32 + lr], 1u);
        }
      }
    }
    __syncthreads();
#pragma unroll 1
    for (int qq = 0; qq < 4; ++qq) {
      const int q = wave * 4 + qq;
      const int rk = rank[q];
      int c[4];
#pragma unroll
      for (int j = 0; j < 4; ++j) c[j] = (int)hist[(255 - 4 * lane - j) * 32 + q];
      int s = c[0] + c[1] + c[2] + c[3];
      int P = wave_incl_scan(s, lane);
      int excl = P - s;
      if (P >= rk && excl < rk) {
        int cum = excl; int bin = 0; int nr = 1; bool found = false;
#pragma unroll
        for (int j = 0; j < 4; ++j) {
          if (!found && cum + c[j] >= rk) { bin = 255 - 4 * lane - j; nr = rk - cum; found = true; }
          if (!found) cum += c[j];
        }
        pref[q] = (pref[q] << 8) | (unsigned)bin;
        rank[q] = nr;
      }
    }
    __syncthreads();
  }
  if (tid < 32) ((unsigned*)(p.ws + OFF_THR))[b * S_ + q0 + tid] = pref[tid];
  __syncthreads();
}

DI void dsa_attn_item(const Params& p, int b, int qblk, char* smem) {
  u16* maskbuf = (u16*)smem;
  u16* qi = (u16*)(smem + 4096);
  const u16* tm = (const u16*)(p.ws + OFF_TM);
  const u16* vfr = (const u16*)(p.ws + OFF_VT) + ((size_t)(b * 8 + (threadIdx.x >> 6)) * 128) * 2048 + (threadIdx.x & 63) * 8;
  const u16* kfr = (const u16*)(p.ws + OFF_KFR) + ((size_t)(b * 8 + (threadIdx.x >> 6)) * 128) * 2048 + (threadIdx.x & 63) * 8;
  const unsigned* thr = (const unsigned*)(p.ws + OFF_THR);
  const int tid = threadIdx.x, lane = tid & 63, wave = tid >> 6, lr = lane & 31, lh = lane >> 5;
  const int q0 = qblk * 32;
  const int head = wave;
  const int qtok = b * S_ + q0 + lr;
  bf16x8 Qf[4];
#pragma unroll
  for (int ks = 0; ks < 4; ++ks) {
    bf16x8 raw = ldg8(tm + (size_t)qtok * TMW + TM_Q + head * 64 + ks * 16 + lh * 8);
    float f[8];
#pragma unroll
    for (int j = 0; j < 8; ++j) f[j] = bf2f((u16)raw[j]) * (0.125f * 1.4426950408889634f);
    Qf[ks] = pack8(f[0], f[1], f[2], f[3], f[4], f[5], f[6], f[7]);
  }
  f32x16 O[2];
  O[0] = zero16(); O[1] = zero16();
  float mrun = -INFINITY, lrun = 0.f;
  const unsigned thrq = thr[qtok];
  const int nchunks = (q0 + 31) / 256 + 1;
  for (int i = tid; i < 32 * 32; i += 512) {
    int q = i >> 5, ch = i & 31;
    *reinterpret_cast<u32x4*>(qi + q * 296 + ch * 8) = *reinterpret_cast<const u32x4*>(tm + (size_t)(b * S_ + q0 + q) * TMW + TM_QI + ch * 8);
  }
  float* wqs = (float*)(smem + 4096 + 32 * 296 * 2);
  if (tid < 256) wqs[tid] = bf2f(tm[(size_t)(b * S_ + q0 + (tid & 31)) * TMW + TM_WI + (tid >> 5)]) * 0.0625f;
  __syncthreads();
  for (int i = tid; i < 32 * 32; i += 512) {
    const int q = i >> 5, d = i & 31;
    float acc = 0.f;
#pragma unroll
    for (int hd = 0; hd < 8; ++hd) acc = fmaf(bf2f(tm[(size_t)(b * S_ + q0 + q) * TMW + TM_WI + hd]) * 0.0625f, bf2f(qi[q * 296 + hd * 32 + d]), acc);
    qi[q * 296 + 256 + d] = f2bf(acc);
  }
  __syncthreads();
  const u16* qil = qi + lr * 296 + lh * 8;
  const u16* kibase = (const u16*)(p.ws + OFF_KIF) + (size_t)b * 128 * 1024 + lane * 8;
  bf16x8 Kf[4], Kn[4];
#pragma unroll
  for (int ks = 0; ks < 4; ++ks) Kf[ks] = ldg8(kfr + ks * 512);
  bf16x8 Vf[2][2], Vn[2][2];
#pragma unroll
  for (int dt = 0; dt < 2; ++dt)
#pragma unroll
    for (int s = 0; s < 2; ++s) Vf[dt][s] = ldg8(vfr + (dt * 2 + s) * 512);
  bf16x8 ki0, ki1;
  {
    const int kt0 = min(wave, qblk);
    ki0 = ldg8(kibase + (size_t)kt0 * 1024); ki1 = ldg8(kibase + (size_t)kt0 * 1024 + 512);
  }
  for (int c = 0; c < nchunks; ++c) {
    const int buf = c & 1;
    {
      const int key0 = (c * 8 + wave) * 32;
      unsigned bits = 0u;
      const bf16x8 k0 = ki0, k1 = ki1;
      {
        const int ktn = min((c + 1) * 8 + wave, qblk);
        ki0 = ldg8(kibase + (size_t)ktn * 1024); ki1 = ldg8(kibase + (size_t)ktn * 1024 + 512);
      }
      if (key0 <= q0 + 31) {
        float sc[16];
        {
          f32x16 a = zero16();
          a = MFMA(k0, *reinterpret_cast<const bf16x8*>(qil + 256), a);
          a = MFMA(k1, *reinterpret_cast<const bf16x8*>(qil + 256 + 16), a);
#pragma unroll
          for (int i = 0; i < 16; ++i) sc[i] = a[i];
        }
#pragma unroll 2
        for (int hd = 0; hd < 8; ++hd) {
          f32x16 a = zero16();
          a = MFMA(k0, *reinterpret_cast<const bf16x8*>(qil + hd * 32), a);
          a = MFMA(k1, *reinterpret_cast<const bf16x8*>(qil + hd * 32 + 16), a);
          const float wh = wqs[hd * 32 + lr];
#pragma unroll
          for (int i = 0; i < 16; ++i) sc[i] = fmaf(fabsf(a[i]), wh, sc[i]);
        }
        __builtin_amdgcn_sched_barrier(0);
#pragma unroll
        for (int i = 0; i < 16; ++i) {
          int kp = key0 + crow(i, lh);
          if (kp <= q0 + lr && fkey(sc[i]) >= thrq) bits |= (1u << i);
        }
      }
      maskbuf[(buf * 8 + wave) * 64 + lane] = (u16)bits;
    }
    __syncthreads();
#pragma unroll 1
    for (int t8 = 0; t8 < 8; ++t8) {
      const int g = c * 8 + t8;
      if (g > qblk) break;
      {
        const int gn = min(g + 1, qblk);
        const u16* kr = kfr + (size_t)gn * 2048;
#pragma unroll
        for (int ks = 0; ks < 4; ++ks) Kn[ks] = ldg8(kr + ks * 512);
#pragma unroll
        for (int dt = 0; dt < 2; ++dt)
#pragma unroll
          for (int s = 0; s < 2; ++s) Vn[dt][s] = ldg8(vfr + (size_t)gn * 2048 + (dt * 2 + s) * 512);
      }

      const unsigned bits = maskbuf[(buf * 8 + t8) * 64 + lane];
      f32x16 Sx = zero16();
#pragma unroll
      for (int ks = 0; ks < 4; ++ks) Sx = MFMA(Kf[ks], Qf[ks], Sx);
      float sm[16];
#pragma unroll
      for (int i = 0; i < 16; ++i) {
        const unsigned t = (unsigned)__builtin_amdgcn_sbfe((int)bits, i, 1);
        sm[i] = __uint_as_float((t & __float_as_uint(Sx[i])) | (~t & 0xff800000u));
      }
      float mt = fmaxf(fmaxf(fmaxf(sm[0], sm[1]), fmaxf(sm[2], sm[3])), fmaxf(fmaxf(sm[4], sm[5]), fmaxf(sm[6], sm[7])));
      mt = fmaxf(mt, fmaxf(fmaxf(fmaxf(sm[8], sm[9]), fmaxf(sm[10], sm[11])), fmaxf(fmaxf(sm[12], sm[13]), fmaxf(sm[14], sm[15]))));
      mt = fmaxf(mt, __shfl_xor(mt, 32));
      const float mnew = fmaxf(mrun, mt);
      const float msafe = (mnew == -INFINITY) ? 0.f : mnew;
      const float alpha = __builtin_amdgcn_exp2f(mrun - msafe);
      float pv[16]; float ps = 0.f;
#pragma unroll
      for (int i = 0; i < 16; ++i) { pv[i] = __builtin_amdgcn_exp2f(sm[i] - msafe); ps += pv[i]; }
      lrun = lrun * alpha + ps;
      mrun = mnew;
      if (__builtin_amdgcn_ballot_w64(alpha != 1.f) != 0ull) {
#pragma unroll
        for (int dt = 0; dt < 2; ++dt)
#pragma unroll
          for (int i = 0; i < 16; ++i) O[dt][i] *= alpha;
      }
      bf16x8 Pf[2];
#pragma unroll
      for (int s = 0; s < 2; ++s) Pf[s] = pack8(pv[8 * s], pv[8 * s + 1], pv[8 * s + 2], pv[8 * s + 3], pv[8 * s + 4], pv[8 * s + 5], pv[8 * s + 6], pv[8 * s + 7]);
#pragma unroll
      for (int dt = 0; dt < 2; ++dt)
#pragma unroll
        for (int s = 0; s < 2; ++s) O[dt] = MFMA(Vf[dt][s], Pf[s], O[dt]);
#pragma unroll
      for (int ks = 0; ks < 4; ++ks) Kf[ks] = Kn[ks];
#pragma unroll
      for (int dt = 0; dt < 2; ++dt)
#pragma unroll
        for (int s = 0; s < 2; ++s) Vf[dt][s] = Vn[dt][s];
    }
  }
  u16* y = (u16*)(p.ws + OFF_XB);
  {
    float lt = lrun + __shfl_xor(lrun, 32);
    float inv = 1.f / lt;
#pragma unroll
    for (int dt = 0; dt < 2; ++dt)
#pragma unroll
      for (int g = 0; g < 4; ++g)
        st4bf(y + (size_t)qtok * 1024 + head * 64 + dt * 32 + 8 * g + 4 * lh, O[dt][4 * g] * inv, O[dt][4 * g + 1] * inv, O[dt][4 * g + 2] * inv, O[dt][4 * g + 3] * inv);
  }
  __syncthreads();
}

DI void gla_bcum(const Params& p, int b, int h, int n, float* bc, float* glr_s, float* segtot) {
  const u16* tm = (const u16*)(p.ws + OFF_TM);
  const int tid = threadIdx.x;
  const int tok0 = b * S_ + n * 64;
  for (int i = tid; i < 1024; i += 512) glr_s[i] = bf2f(tm[(size_t)(tok0 + (i >> 4)) * TMW + TM_GLR + (i & 15)]);
  const int d = tid & 63, cgp = tid >> 6;
  float gu[16];
#pragma unroll
  for (int j = 0; j < 16; ++j) gu[j] = p.gate_up[j * 256 + h * 64 + d];
  const float bias = p.gate_bias[h * 64 + d];
  __syncthreads();
  float v[8]; float run = 0.f;
#pragma unroll
  for (int r = 0; r < 8; ++r) {
    const int c = cgp * 8 + r;
    float z = bias;
#pragma unroll
    for (int j4 = 0; j4 < 4; ++j4) {
      const f32x4 gv = *reinterpret_cast<const f32x4*>(glr_s + c * 16 + j4 * 4);
#pragma unroll
      for (int j = 0; j < 4; ++j) z = fmaf(gv[j], gu[j4 * 4 + j], z);
    }
    float la = (fminf(z, 0.f) - __logf(1.f + __expf(-fabsf(z)))) * 0.0625f;
    run += la; v[r] = run;
  }
  segtot[cgp * 64 + d] = run;
  __syncthreads();
  float off = 0.f;
#pragma unroll
  for (int g = 0; g < 8; ++g) off += (g < cgp) ? segtot[g * 64 + d] : 0.f;
#pragma unroll
  for (int r = 0; r < 8; ++r) bc[(cgp * 8 + r) * 64 + d] = off + v[r];
  __syncthreads();
}

DI void gla_g1_item(const Params& p, int item, char* smem) {
  float* bc = (float*)smem;
  float* glr_s = (float*)(smem + 16384);
  float* segtot = (float*)(smem + 20480);
  u16* KeT = (u16*)(smem + 22528);
  const int b = item >> 8, h = (item >> 6) & 3, n = item & 63;
  const u16* tm = (const u16*)(p.ws + OFF_TM);
  const u16* gvT = (const u16*)(p.ws + OFF_GVT);
  const int tid = threadIdx.x, lane = tid & 63, wave = tid >> 6, lr = lane & 31, lh = lane >> 5;
  const int tok0 = b * S_ + n * 64;
  u16 kraw[8];
  {
    const int d = tid & 63, cgp = tid >> 6;
#pragma unroll
    for (int r = 0; r < 8; ++r) kraw[r] = tm[(size_t)(tok0 + cgp * 8 + r) * TMW + TM_GK + h * 64 + d];
  }
  bf16x8 afr[4];
  {
    const int et = wave & 3;
    const u16* arow = gvT + ((size_t)b * 512 + h * 128 + et * 32 + lr) * 4096 + n * 64 + lh * 8;
#pragma unroll
    for (int ks = 0; ks < 4; ++ks) afr[ks] = ldg8(arow + ks * 16);
  }
  gla_bcum(p, b, h, n, bc, glr_s, segtot);
  {
    const int d = tid & 63, cgp = tid >> 6;
    const float blast = bc[63 * 64 + d];
    {
      float* bcg = (float*)(p.ws + OFF_BCG) + (size_t)item * 4096;
#pragma unroll
      for (int r = 0; r < 8; ++r) bcg[(cgp * 8 + r) * 64 + d] = bc[(cgp * 8 + r) * 64 + d];
    }
    float f[8];
#pragma unroll
    for (int r = 0; r < 8; ++r) {
      const int c = cgp * 8 + r;
      float kv = bf2f(kraw[r]);
      f[r] = kv * __expf(blast - bc[c * 64 + d]);
    }
    *reinterpret_cast<bf16x8*>(KeT + d * 72 + cgp * 8) = pack8(f[0], f[1], f[2], f[3], f[4], f[5], f[6], f[7]);
    if (cgp == 0) ((float*)(p.ws + OFF_DECAY))[item * 64 + d] = __expf(blast);
  }
  __syncthreads();
  {
    const int et = wave & 3, dtl = wave >> 2;
    f32x16 acc = zero16();
#pragma unroll
    for (int ks = 0; ks < 4; ++ks) {
      bf16x8 a = afr[ks];
      bf16x8 bb = *reinterpret_cast<const bf16x8*>(KeT + (dtl * 32 + lr) * 72 + ks * 16 + lh * 8);
      acc = MFMA(a, bb, acc);
    }
    float* kvT = (float*)(p.ws + OFF_KVT);
#pragma unroll
    for (int i = 0; i < 16; ++i) kvT[((size_t)item * 128 + et * 32 + crow(i, lh)) * 64 + dtl * 32 + lr] = acc[i];
  }
  __syncthreads();
}

DI void gla_scan(const Params& p) {
  const float* kvT = (const float*)(p.ws + OFF_KVT);
  const float* decay = (const float*)(p.ws + OFF_DECAY);
  u16* prev = (u16*)(p.ws + OFF_PREV);
  const int gtid = blockIdx.x * blockDim.x + threadIdx.x;
  const int gn = gridDim.x * blockDim.x;
  for (int u = gtid; u < 32 * 2048; u += gn) {
    const int bh = u >> 11, rem = u & 2047, e = rem >> 4, d4 = (rem & 15) * 4;
    f32x4 st = {0.f, 0.f, 0.f, 0.f};
#pragma unroll 4
    for (int n = 0; n < 64; ++n) {
      const int item = bh * 64 + n;
      st4bf(prev + ((size_t)item * 128 + e) * 64 + d4, st[0], st[1], st[2], st[3]);
      f32x4 dc = *reinterpret_cast<const f32x4*>(decay + item * 64 + d4);
      f32x4 kv = *reinterpret_cast<const f32x4*>(kvT + ((size_t)item * 128 + e) * 64 + d4);
      st = dc * st + kv;
    }
  }
}

DI void gla_g3_item(const Params& p, int item, char* smem) {
  float* red = (float*)smem;
  const int b = item >> 8, h = (item >> 6) & 3, n = item & 63;
  const u16* tm = (const u16*)(p.ws + OFF_TM);
  const u16* gvT = (const u16*)(p.ws + OFF_GVT);
  const u16* prev = (const u16*)(p.ws + OFF_PREV);
  const float* bcg = (const float*)(p.ws + OFF_BCG) + (size_t)item * 4096;
  const int tid = threadIdx.x, lane = tid & 63, wave = tid >> 6, lr = lane & 31, lh = lane >> 5;
  const int tok0 = b * S_ + n * 64;
  const int et = wave & 3, ct = wave >> 2;
  bf16x8 qraw[4], kraw[2][4], sfr[4];
  bf16x4 vlo[2][2], vhi[2][2];
  f32x4 bq[4][2];
  {
    const u16* vrow0 = gvT + ((size_t)b * 512 + h * 128 + et * 32 + lr) * 4096 + n * 64 + 4 * lh;
    const u16* srow0 = prev + ((size_t)item * 128 + et * 32 + lr) * 64 + lh * 8;
#pragma unroll
    for (int ks = 0; ks < 4; ++ks) {
      qraw[ks] = ldg8(tm + (size_t)(tok0 + ct * 32 + lr) * TMW + TM_GQ + h * 64 + ks * 16 + lh * 8);
      kraw[0][ks] = ldg8(tm + (size_t)(tok0 + lr) * TMW + TM_GK + h * 64 + ks * 16 + lh * 8);
      kraw[1][ks] = ldg8(tm + (size_t)(tok0 + ct * 32 + lr) * TMW + TM_GK + h * 64 + ks * 16 + lh * 8);
      sfr[ks] = ldg8(srow0 + ks * 16);
      bq[ks][0] = *reinterpret_cast<const f32x4*>(bcg + (ct * 32 + lr) * 64 + ks * 16 + lh * 8);
      bq[ks][1] = *reinterpret_cast<const f32x4*>(bcg + (ct * 32 + lr) * 64 + ks * 16 + lh * 8 + 4);
    }
#pragma unroll
    for (int st = 0; st < 2; ++st)
#pragma unroll
      for (int s2 = 0; s2 < 2; ++s2) {
        const u16* vp = vrow0 + (st * ct) * 32 + 16 * s2;
        vlo[st][s2] = *reinterpret_cast<const bf16x4*>(vp);
        vhi[st][s2] = *reinterpret_cast<const bf16x4*>(vp + 8);
      }
  }
  bf16x8 Qd[4];
#pragma unroll
  for (int ks = 0; ks < 4; ++ks) {
    float f[8];
#pragma unroll
    for (int j = 0; j < 8; ++j) f[j] = bf2f((u16)qraw[ks][j]) * 0.125f * __expf(bq[ks][j >> 2][j & 3]);
    Qd[ks] = pack8(f[0], f[1], f[2], f[3], f[4], f[5], f[6], f[7]);
  }
  f32x16 O = zero16();
#pragma unroll
  for (int st = 0; st < 2; ++st) {
    if (st <= ct) {
      f32x16 A = zero16();
      const int s = st * 32 + lr;
#pragma unroll
      for (int ks = 0; ks < 4; ++ks) {
        f32x4 b0 = (st == 1) ? bq[ks][0] : *reinterpret_cast<const f32x4*>(bcg + s * 64 + ks * 16 + lh * 8);
        f32x4 b1 = (st == 1) ? bq[ks][1] : *reinterpret_cast<const f32x4*>(bcg + s * 64 + ks * 16 + lh * 8 + 4);
        float f[8];
#pragma unroll
        for (int j = 0; j < 8; ++j) f[j] = bf2f((u16)kraw[st][ks][j]) * __expf(-((j < 4) ? b0[j & 3] : b1[j & 3]));
        bf16x8 Ki = pack8(f[0], f[1], f[2], f[3], f[4], f[5], f[6], f[7]);
        A = MFMA(Ki, Qd[ks], A);
      }
      float pv[16];
#pragma unroll
      for (int i = 0; i < 16; ++i) pv[i] = (st * 32 + crow(i, lh) <= ct * 32 + lr) ? A[i] : 0.f;
#pragma unroll
      for (int s2 = 0; s2 < 2; ++s2) {
        bf16x8 Pf = pack8(pv[8 * s2], pv[8 * s2 + 1], pv[8 * s2 + 2], pv[8 * s2 + 3], pv[8 * s2 + 4], pv[8 * s2 + 5], pv[8 * s2 + 6], pv[8 * s2 + 7]);
        O = MFMA(cat44(vlo[st][s2], vhi[st][s2]), Pf, O);
      }
    }
  }
#pragma unroll
  for (int ks = 0; ks < 4; ++ks) O = MFMA(sfr[ks], Qd[ks], O);
  float ss = 0.f;
#pragma unroll
  for (int i = 0; i < 16; ++i) ss += O[i] * O[i];
  ss += __shfl_xor(ss, 32);
  if (lh == 0) red[(ct * 4 + et) * 32 + lr] = ss;
  __syncthreads();
  const float tot = red[(ct * 4 + 0) * 32 + lr] + red[(ct * 4 + 1) * 32 + lr] + red[(ct * 4 + 2) * 32 + lr] + red[(ct * 4 + 3) * 32 + lr];
  const float rinv = rsqrtf(tot * (1.f / 128.f) + 1e-6f);
  const int tok = tok0 + ct * 32 + lr;
  u16* y = (u16*)(p.ws + OFF_XB);
#pragma unroll
  for (int g = 0; g < 4; ++g) {
    const int e0 = et * 32 + 8 * g + 4 * lh;
    u32x2 gr = *reinterpret_cast<const u32x2*>(tm + (size_t)tok * TMW + TM_GR + h * 128 + e0);
    f32x4 ng = *reinterpret_cast<const f32x4*>(p.norm_g + e0);
    float grv[4] = {bflo(gr[0]), bfhi(gr[0]), bflo(gr[1]), bfhi(gr[1])};
    float o[4];
#pragma unroll
    for (int r = 0; r < 4; ++r) {
      float sl = grv[r] / (1.f + __expf(-grv[r]));
      o[r] = O[4 * g + r] * rinv * ng[r] * sl;
    }
    st4bf(y + (size_t)tok * 1024 + 512 + h * 128 + e0, o[0], o[1], o[2], o[3]);
  }
  __syncthreads();
}

template <int MODE>
DI void phase_gemm(const Params& p, const u16* X, const u16* Wt, int N, const float* resid, float* outf, u16* outb, int ldo, char* smem) {
  const int ntn = N / 128;
  const int total = 128 * ntn;
  const int tid = threadIdx.x, lane = tid & 63, wave = tid >> 6;
  const int fw = wave & 1, tq = wave >> 1, lr = lane & 31, lh = lane >> 5;
  for (int t = blockIdx.x; t < total; t += gridDim.x) {
    const int mt = t / ntn, nt = t % ntn;
    f32x16 acc[2][2];
    gemm_tile(X + (size_t)mt * 256 * 1024, 1024, Wt + (size_t)nt * 128 * 1024, 1024, 1024, smem, acc);
    if (MODE == 0 || MODE == 1) {
      float* wl = (float*)(smem + wave * 17408);
#pragma unroll
      for (int tt = 0; tt < 2; ++tt)
#pragma unroll
        for (int ft = 0; ft < 2; ++ft)
#pragma unroll
          for (int g = 0; g < 4; ++g) {
            f32x4 v = {acc[ft][tt][4 * g], acc[ft][tt][4 * g + 1], acc[ft][tt][4 * g + 2], acc[ft][tt][4 * g + 3]};
            *reinterpret_cast<f32x4*>(wl + (tt * 32 + lr) * 68 + ft * 32 + 8 * g + 4 * lh) = v;
          }
      const int ch = lane & 15, r0 = lane >> 4;
      const int f = nt * 128 + fw * 64 + ch * 4;
#pragma unroll 4
      for (int k = 0; k < 16; ++k) {
        const int row = r0 + 4 * k;
        const int tok = mt * 256 + tq * 64 + row;
        f32x4 v = *reinterpret_cast<const f32x4*>(wl + row * 68 + ch * 4);
        if (MODE == 0) {
          f32x4 r = *reinterpret_cast<const f32x4*>(resid + (size_t)tok * 1024 + f);
          f32x4 o;
#pragma unroll
          for (int j = 0; j < 4; ++j) o[j] = ALPHA * r[j] + v[j];
          *reinterpret_cast<f32x4*>(outf + (size_t)tok * 1024 + f) = o;
        } else {
          st4bf(outb + (size_t)tok * ldo + f, v[0], v[1], v[2], v[3]);
        }
      }
      __syncthreads();
    } else {
#pragma unroll
      for (int tt = 0; tt < 2; ++tt) {
        const int tok = mt * 256 + tq * 64 + tt * 32 + lr;
#pragma unroll
        for (int ft = 0; ft < 2; ++ft)
#pragma unroll
          for (int g = 0; g < 4; ++g) {
            const int f = nt * 128 + fw * 64 + ft * 32 + 8 * g + 4 * lh;
            if (MODE == 2) {
              const int hh = f >> 8, fh = f & 255, ks = fh >> 4, lane2 = ((fh >> 3) & 1) * 32 + lr;
              st4bf(outb + ((((size_t)(tok >> 5) * 4 + hh) * 16 + ks) * 64 + lane2) * 8 + 4 * lh, acc[ft][tt][4 * g], acc[ft][tt][4 * g + 1], acc[ft][tt][4 * g + 2], acc[ft][tt][4 * g + 3]);
            } else {
              const int hh = f >> 8, fq = f & 127, half = (f >> 7) & 1, ks = fq >> 4, lane2 = ((fq >> 3) & 1) * 32 + lr;
              st4bf(outb + (((((size_t)(tok >> 5) * 8 + hh) * 2 + half) * 8 + ks) * 64 + lane2) * 8 + 4 * lh, acc[ft][tt][4 * g], acc[ft][tt][4 * g + 1], acc[ft][tt][4 * g + 2], acc[ft][tt][4 * g + 3]);
            }
          }
      }
    }
  }
}

DI void phase_ln(const Params& p, float* h, u16* hb, const float* g, const float* bta) {
  const int lane = threadIdx.x & 63;
  const int gw = (blockIdx.x * blockDim.x + threadIdx.x) >> 6;
  const int nw = (gridDim.x * blockDim.x) >> 6;
  for (int row = gw; row < T_; row += nw) {
    float* r = h + (size_t)row * 1024;
    f32x4 v[4]; float s = 0.f;
#pragma unroll
    for (int c = 0; c < 4; ++c) { v[c] = *reinterpret_cast<const f32x4*>(r + c * 256 + lane * 4); s += v[c][0] + v[c][1] + v[c][2] + v[c][3]; }
    const float mean = wave_sum(s) * (1.f / 1024.f);
    float q = 0.f;
#pragma unroll
    for (int c = 0; c < 4; ++c)
#pragma unroll
      for (int k = 0; k < 4; ++k) { float d = v[c][k] - mean; q += d * d; }
    const float rstd = rsqrtf(wave_sum(q) * (1.f / 1024.f) + 1e-5f);
#pragma unroll
    for (int c = 0; c < 4; ++c) {
      f32x4 gg = *reinterpret_cast<const f32x4*>(g + c * 256 + lane * 4);
      f32x4 bb = *reinterpret_cast<const f32x4*>(bta + c * 256 + lane * 4);
      f32x4 o;
#pragma unroll
      for (int k = 0; k < 4; ++k) o[k] = (v[c][k] - mean) * rstd * gg[k] + bb[k];
      *reinterpret_cast<f32x4*>(r + c * 256 + lane * 4) = o;
      st4bf(hb + (size_t)row * 1024 + c * 256 + lane * 4, o[0], o[1], o[2], o[3]);
    }
  }
}

DI void phase_xattn(const Params& p) {
  const u16* qx = (const u16*)(p.ws + OFF_QX);
  const u16* mk = (const u16*)(p.ws + OFF_MEMK);
  const u16* mv = (const u16*)(p.ws + OFF_MEMVT);
  u16* ox = (u16*)(p.ws + OFF_OX);
  const int lane = threadIdx.x & 63, lr = lane & 31, lh = lane >> 5;
  const int gw = (blockIdx.x * blockDim.x + threadIdx.x) >> 6;
  const int nw = (gridDim.x * blockDim.x) >> 6;
  for (int it = gw; it < 8 * 4 * 128; it += nw) {
    const int qt = it & 127, h = (it >> 7) & 3, b = it >> 9;
    const int tok = b * S_ + qt * 32 + lr;
    f32x16 Sx[8];
#pragma unroll
    for (int kt = 0; kt < 8; ++kt) Sx[kt] = zero16();
    const u16* qrow = qx + (((size_t)(b * 128 + qt) * 4 + h) * 16) * 512 + lane * 8;
    const u16* krow = mk + (((size_t)(b * 4 + h) * 8) * 16) * 512 + lane * 8;
#pragma unroll 2
    for (int ks = 0; ks < 16; ++ks) {
      bf16x8 qf = ldg8(qrow + ks * 512);
#pragma unroll
      for (int kt = 0; kt < 8; ++kt) Sx[kt] = MFMA(ldg8(krow + (kt * 16 + ks) * 512), qf, Sx[kt]);
    }
    float mx = -INFINITY;
#pragma unroll
    for (int kt = 0; kt < 8; ++kt)
#pragma unroll
      for (int i = 0; i < 16; ++i) mx = fmaxf(mx, Sx[kt][i]);
    mx = fmaxf(mx, __shfl_xor(mx, 32));
    float ls = 0.f;
    bf16x8 Pf[8][2];
#pragma unroll
    for (int kt = 0; kt < 8; ++kt) {
      float pv[16];
#pragma unroll
      for (int i = 0; i < 16; ++i) { pv[i] = __expf((Sx[kt][i] - mx) * 0.0625f); ls += pv[i]; }
#pragma unroll
      for (int s = 0; s < 2; ++s) Pf[kt][s] = pack8(pv[8 * s], pv[8 * s + 1], pv[8 * s + 2], pv[8 * s + 3], pv[8 * s + 4], pv[8 * s + 5], pv[8 * s + 6], pv[8 * s + 7]);
    }
    ls += __shfl_xor(ls, 32);
    const float inv = 1.f / ls;
#pragma unroll 1
    for (int dt = 0; dt < 8; ++dt) {
      f32x16 o = zero16();
      const u16* vrow = mv + ((((size_t)(b * 4 + h) * 8 + dt) * 8) * 2) * 512 + lane * 8;
#pragma unroll
      for (int kt = 0; kt < 8; ++kt)
#pragma unroll
        for (int s = 0; s < 2; ++s) o = MFMA(ldg8(vrow + (kt * 2 + s) * 512), Pf[kt][s], o);
#pragma unroll
      for (int g = 0; g < 4; ++g)
        st4bf(ox + (size_t)tok * 1024 + h * 256 + dt * 32 + 8 * g + 4 * lh, o[4 * g] * inv, o[4 * g + 1] * inv, o[4 * g + 2] * inv, o[4 * g + 3] * inv);
    }
  }
}

DI void peer_topk_item(const Params& p, int tt128, int head, char* smem) {
  float* sc = (float*)smem;
  float* topv = (float*)(smem + 132096);
  unsigned char* topi = (unsigned char*)(smem + 132096 + 16384);
  const u16* pq = (const u16*)(p.ws + OFF_QX);
  const u16* sk = (const u16*)(p.ws + OFF_SK);
  const int tid = threadIdx.x, lane = tid & 63, wave = tid >> 6, lr = lane & 31, lh = lane >> 5;
  const int tok0 = tt128 * 128;
  {
    const int half = wave >> 2, kt = wave & 3;
    bf16x8 af[8];
#pragma unroll
    for (int ks = 0; ks < 8; ++ks) af[ks] = ldg8(sk + (size_t)half * 16384 + (kt * 32 + lr) * 128 + ks * 16 + lh * 8);
#pragma unroll 1
    for (int tt = 0; tt < 4; ++tt) {
      f32x16 acc = zero16();
      const u16* brow = pq + (((((size_t)(tok0 >> 5) + tt) * 8 + head) * 2 + half) * 8) * 512 + lane * 8;
#pragma unroll
      for (int ks = 0; ks < 8; ++ks) acc = MFMA(af[ks], ldg8(brow + ks * 512), acc);
#pragma unroll
      for (int i = 0; i < 16; ++i) sc[(half * 128 + tt * 32 + lr) * 129 + kt * 32 + crow(i, lh)] = acc[i];
    }
  }
  __syncthreads();
  if (tid < 256) {
    float* row = sc + tid * 129;
    float gm[8]; int gi[8];
#pragma unroll
    for (int g = 0; g < 8; ++g) {
      float m = -INFINITY; int mi = g * 16;
#pragma unroll
      for (int j = 0; j < 16; ++j) { float v = row[g * 16 + j]; if (v > m) { m = v; mi = g * 16 + j; } }
      gm[g] = m; gi[g] = mi;
    }
#pragma unroll 1
    for (int r = 0; r < 16; ++r) {
      float best = gm[0]; int bg = 0; int bi = gi[0];
#pragma unroll
      for (int g = 1; g < 8; ++g) if (gm[g] > best) { best = gm[g]; bg = g; bi = gi[g]; }
      topv[tid * 16 + r] = best; topi[tid * 16 + r] = (unsigned char)bi;
      row[bi] = -INFINITY;
      float m = -INFINITY; int mi = bg * 16;
#pragma unroll
      for (int j = 0; j < 16; ++j) { float v = row[bg * 16 + j]; if (v > m) { m = v; mi = bg * 16 + j; } }
#pragma unroll
      for (int g = 0; g < 8; ++g) { gm[g] = (g == bg) ? m : gm[g]; gi[g] = (g == bg) ? mi : gi[g]; }
    }
  }
  __syncthreads();
  if (tid < 128) {
    const float* av = topv + tid * 16;
    const float* bv = topv + (128 + tid) * 16;
    const unsigned char* ai = topi + tid * 16;
    const unsigned char* bi_ = topi + (128 + tid) * 16;
    float cur[16]; int pp[16];
    const float b0 = bv[0];
#pragma unroll
    for (int i = 0; i < 16; ++i) { cur[i] = av[i] + b0; pp[i] = 0; }
    float sel[16]; int eid[16];
#pragma unroll
    for (int r = 0; r < 16; ++r) {
      float best = cur[0]; int bi = 0; int bj = pp[0];
#pragma unroll
      for (int i = 1; i < 16; ++i) if (cur[i] > best) { best = cur[i]; bi = i; bj = pp[i]; }
      sel[r] = best;
      eid[r] = (int)ai[bi] * 128 + (int)bi_[bj];
      const int nj = bj + 1;
      const float nv = (nj < 16) ? (av[bi] + bv[nj & 15]) : -INFINITY;
#pragma unroll
      for (int i = 0; i < 16; ++i) { cur[i] = (i == bi) ? nv : cur[i]; pp[i] = (i == bi) ? nj : pp[i]; }
    }
    float sum = 0.f;
    const float smax = sel[0];
#pragma unroll
    for (int r = 0; r < 16; ++r) { sel[r] = __expf(sel[r] - smax); sum += sel[r]; }
    const float inv = 1.f / sum;
    int* eo = (int*)(p.ws + OFF_EIDX) + (size_t)(tok0 + tid) * 128 + head * 16;
    float* go = (float*)(p.ws + OFF_GATE) + (size_t)(tok0 + tid) * 128 + head * 16;
#pragma unroll
    for (int r = 0; r < 16; ++r) { eo[r] = eid[r]; go[r] = sel[r] * inv; }
  }
  __syncthreads();
}

DI float dot2bf(unsigned a, unsigned b, float c) {
  return __builtin_amdgcn_fdot2_f32_bf16(__builtin_bit_cast(bf2_t, a), __builtin_bit_cast(bf2_t, b), c, false);
}

DI float reduce8(float (&part)[8], int lane) {
  float r4[4], r2[2], r1;
#pragma unroll
  for (int k = 0; k < 4; ++k) {
    float send = (lane & 1) ? part[2 * k] : part[2 * k + 1];
    float keep = (lane & 1) ? part[2 * k + 1] : part[2 * k];
    r4[k] = keep + __shfl_xor(send, 1);
  }
#pragma unroll
  for (int k = 0; k < 2; ++k) {
    float send = (lane & 2) ? r4[2 * k] : r4[2 * k + 1];
    float keep = (lane & 2) ? r4[2 * k + 1] : r4[2 * k];
    r2[k] = keep + __shfl_xor(send, 2);
  }
  {
    float send = (lane & 4) ? r2[0] : r2[1];
    float keep = (lane & 4) ? r2[1] : r2[0];
    r1 = keep + __shfl_xor(send, 4);
  }
  r1 += __shfl_xor(r1, 8);
  r1 += __shfl_xor(r1, 16);
  r1 += __shfl_xor(r1, 32);
  return r1;
}

DI void phase_peer_down(const Params& p) {
  const char* exd = p.ws + OFF_EXD;
  const float* esc = (const float*)(p.ws + OFF_ESC);
  const u16* hb = (const u16*)(p.ws + OFF_HB);
  const int* eidx = (const int*)(p.ws + OFF_EIDX);
  const float* gate = (const float*)(p.ws + OFF_GATE);
  float* coefw = (float*)(p.ws + OFF_COEF);
  const int lane = threadIdx.x & 63;
  const int gw = (blockIdx.x * blockDim.x + threadIdx.x) >> 6;
  const int nw = (gridDim.x * blockDim.x) >> 6;
#pragma unroll 1
  for (int tok = gw; tok < T_; tok += nw) {
    float x[16];
    {
      const u16* xr = hb + (size_t)tok * 1024 + lane * 16;
      u32x4 a = *reinterpret_cast<const u32x4*>(xr);
      u32x4 c = *reinterpret_cast<const u32x4*>(xr + 8);
#pragma unroll
      for (int w = 0; w < 4; ++w) { x[2 * w] = bflo(a[w]); x[2 * w + 1] = bfhi(a[w]); x[8 + 2 * w] = bflo(c[w]); x[8 + 2 * w + 1] = bfhi(c[w]); }
    }
#pragma unroll 1
    for (int half = 0; half < 2; ++half) {
      const size_t slot = (size_t)tok * 128 + half * 64 + lane;
      const int ev = eidx[slot];
      const float gv = gate[slot];
      float racc = 0.f, gacc = 0.f;
#pragma unroll 1
      for (int bi = 0; bi < 8; ++bi) {
        u32x4 dr[8];
#pragma unroll
        for (int k = 0; k < 8; ++k) {
          const int er = __builtin_amdgcn_readlane(ev, bi * 8 + k);
          dr[k] = *reinterpret_cast<const u32x4*>(exd + (size_t)er * 1024 + lane * 16);
        }
        const int pmine = bi * 8 + (lane & 7);
        const int emine = __shfl(ev, pmine);
        const float gsel = __shfl(gv, pmine);
        const float sd = esc[emine];
        const float su = esc[16384 + emine];
        float part[8];
#pragma unroll
        for (int k = 0; k < 8; ++k) {
          float a0 = 0.f, a1 = 0.f;
#pragma unroll
          for (int w = 0; w < 4; ++w) {
            f2_t lo = __builtin_amdgcn_cvt_pk_f32_fp8((int)dr[k][w], false);
            f2_t hi = __builtin_amdgcn_cvt_pk_f32_fp8((int)dr[k][w], true);
            a0 = fmaf(lo[0], x[4 * w], a0); a1 = fmaf(lo[1], x[4 * w + 1], a1);
            a0 = fmaf(hi[0], x[4 * w + 2], a0); a1 = fmaf(hi[1], x[4 * w + 3], a1);
          }
          part[k] = a0 + a1;
        }
        const float r1 = reduce8(part, lane) * sd;
        const bool mine = (lane >> 3) == bi;
        racc = mine ? r1 : racc; gacc = mine ? gsel * su : gacc;
      }
      const float act = 0.5f * racc * (1.f + erff(racc * 0.70710678118654752f));
      coefw[slot] = gacc * act;
    }
  }
}

DI void phase_peer_ffn(const Params& p) {
  const char* exu = p.ws + OFF_EXU;
  const float* h = (const float*)(p.ws + OFF_H);
  const int* eidx = (const int*)(p.ws + OFF_EIDX);
  const float* coefw = (const float*)(p.ws + OFF_COEF);
  const int lane = threadIdx.x & 63;
  const int gw = (blockIdx.x * blockDim.x + threadIdx.x) >> 6;
  const int nw = (gridDim.x * blockDim.x) >> 6;
  for (int tok = gw; tok < T_; tok += nw) {
    float yacc[16];
#pragma unroll
    for (int i = 0; i < 16; ++i) yacc[i] = 0.f;
    const int e_lo = eidx[(size_t)tok * 128 + lane];
    const int e_hi = eidx[(size_t)tok * 128 + 64 + lane];
    const float c_lo = coefw[(size_t)tok * 128 + lane];
    const float c_hi = coefw[(size_t)tok * 128 + 64 + lane];
#pragma unroll 1
    for (int eb = 0; eb < 8; ++eb) {
      const int ev = (eb < 4) ? e_lo : e_hi;
      const float cv = (eb < 4) ? c_lo : c_hi;
      const int lbase = (eb & 3) * 16;
      u32x4 ur[16];
#pragma unroll
      for (int k = 0; k < 16; ++k) {
        const int er = __builtin_amdgcn_readlane(ev, lbase + k);
        ur[k] = *reinterpret_cast<const u32x4*>(exu + (size_t)er * 1024 + lane * 16);
      }
#pragma unroll
      for (int k = 0; k < 16; ++k) {
        const float ck = __int_as_float(__builtin_amdgcn_readlane(__float_as_int(cv), lbase + k));
#pragma unroll
        for (int w = 0; w < 4; ++w) {
          f2_t lo = __builtin_amdgcn_cvt_pk_f32_fp8((int)ur[k][w], false);
          f2_t hi = __builtin_amdgcn_cvt_pk_f32_fp8((int)ur[k][w], true);
          yacc[4 * w] = fmaf(ck, lo[0], yacc[4 * w]);
          yacc[4 * w + 1] = fmaf(ck, lo[1], yacc[4 * w + 1]);
          yacc[4 * w + 2] = fmaf(ck, hi[0], yacc[4 * w + 2]);
          yacc[4 * w + 3] = fmaf(ck, hi[1], yacc[4 * w + 3]);
        }
      }
    }
    const float* xr = h + (size_t)tok * 1024 + lane * 16;
    float v[16];
#pragma unroll
    for (int c = 0; c < 4; ++c) {
      f32x4 t = *reinterpret_cast<const f32x4*>(xr + c * 4);
#pragma unroll
      for (int k = 0; k < 4; ++k) v[4 * c + k] = ALPHA * t[k] + yacc[4 * c + k];
    }
    float s = 0.f;
#pragma unroll
    for (int i = 0; i < 16; ++i) s += v[i];
    const float mean = wave_sum(s) * (1.f / 1024.f);
    float q = 0.f;
#pragma unroll
    for (int i = 0; i < 16; ++i) { float d = v[i] - mean; q += d * d; }
    const float rstd = rsqrtf(wave_sum(q) * (1.f / 1024.f) + 1e-5f);
    float* orow = p.out + (size_t)tok * 1024 + lane * 16;
#pragma unroll
    for (int c = 0; c < 4; ++c) {
      f32x4 gg = *reinterpret_cast<const f32x4*>(p.ln_ffn_g + lane * 16 + c * 4);
      f32x4 bb = *reinterpret_cast<const f32x4*>(p.ln_ffn_b + lane * 16 + c * 4);
      f32x4 o;
#pragma unroll
      for (int k = 0; k < 4; ++k) o[k] = (v[4 * c + k] - mean) * rstd * gg[k] + bb[k];
      *reinterpret_cast<f32x4*>(orow + c * 4) = o;
    }
  }
}

constexpr size_t OFF_BAR = 166 * MiB;
DI void gbar(unsigned* ctr, unsigned target) {
  asm volatile("s_waitcnt vmcnt(0)" ::: "memory");
  __syncthreads();
  if (threadIdx.x == 0) {
    __builtin_amdgcn_fence(__ATOMIC_RELEASE, "agent");
    asm volatile("s_waitcnt vmcnt(0)" ::: "memory");
    __hip_atomic_fetch_add(ctr, 1u, __ATOMIC_RELAXED, __HIP_MEMORY_SCOPE_AGENT);
    while (__hip_atomic_load(ctr, __ATOMIC_RELAXED, __HIP_MEMORY_SCOPE_AGENT) < target) __builtin_amdgcn_s_sleep(2);
    __builtin_amdgcn_fence(__ATOMIC_ACQUIRE, "agent");
    asm volatile("s_waitcnt vmcnt(0)" ::: "memory");
  }
  __syncthreads();
}

__global__ void __launch_bounds__(512) fwd_megakernel(Params p) {
  __shared__ __attribute__((aligned(1024))) char smem[155648];
  cg::grid_group grid = cg::this_grid();
  const int G = gridDim.x;
  char* ws = p.ws;
  unsigned* bar = (unsigned*)(ws + OFF_BAR);

  phase_prep(p, smem);
  grid.sync();

  phase_inproj(p, smem);
  gbar(bar, (unsigned)(1 * G));

  for (int k = 0; k * G < 1024; ++k) {
    int j = (k & 1) ? (G - 1 - (int)blockIdx.x) : (int)blockIdx.x;
    int idx = k * G + j;
    if (idx < 1024) dsa_thr_item(p, idx & 7, 127 - (idx >> 3), smem);
  }
  for (int it = blockIdx.x; it < 2048; it += G) gla_g1_item(p, it, smem);
  gbar(bar, (unsigned)(2 * G));

  for (int k = 0; k * G < 1024; ++k) {
    int j = (k & 1) ? (G - 1 - (int)blockIdx.x) : (int)blockIdx.x;
    int idx = k * G + j;
    if (idx < 1024) dsa_attn_item(p, idx & 7, 127 - (idx >> 3), smem);
  }
  gla_scan(p);
  gbar(bar, (unsigned)(3 * G));

  for (int it = blockIdx.x; it < 2048; it += G) gla_g3_item(p, it, smem);
  gbar(bar, (unsigned)(4 * G));

  phase_gemm<0>(p, (const u16*)(ws + OFF_XB), (const u16*)(ws + OFF_WOUT), 1024, p.x, (float*)(ws + OFF_H), nullptr, 0, smem);
  gbar(bar, (unsigned)(5 * G));
  phase_ln(p, (float*)(ws + OFF_H), (u16*)(ws + OFF_HB), p.ln_mix_g, p.ln_mix_b);
  gbar(bar, (unsigned)(6 * G));

  phase_gemm<2>(p, (const u16*)(ws + OFF_HB), (const u16*)(ws + OFF_WQ), 1024, nullptr, nullptr, (u16*)(ws + OFF_QX), 1024, smem);
  gbar(bar, (unsigned)(7 * G));
  phase_xattn(p);
  gbar(bar, (unsigned)(8 * G));
  phase_gemm<0>(p, (const u16*)(ws + OFF_OX), (const u16*)(ws + OFF_WO), 1024, (const float*)(ws + OFF_H), (float*)(ws + OFF_H), nullptr, 0, smem);
  gbar(bar, (unsigned)(9 * G));
  phase_ln(p, (float*)(ws + OFF_H), (u16*)(ws + OFF_HB), p.ln_mem_g, p.ln_mem_b);
  gbar(bar, (unsigned)(10 * G));

  phase_gemm<5>(p, (const u16*)(ws + OFF_HB), (const u16*)(ws + OFF_WPQ), 2048, nullptr, nullptr, (u16*)(ws + OFF_QX), 2048, smem);
  gbar(bar, (unsigned)(11 * G));
  for (int it = blockIdx.x; it < 2048; it += G) peer_topk_item(p, it >> 3, it & 7, smem);
  gbar(bar, (unsigned)(12 * G));
  phase_peer_down(p);
  gbar(bar, (unsigned)(13 * G));
  phase_peer_ffn(p);
}

extern "C" void kernel_launch(void* const* d_in, const int* in_sizes, int n_in,
                              void* d_out, int out_size, void* d_ws, size_t ws_size,
                              hipStream_t stream) {
  static int grid_blocks = 0;
  if (!grid_blocks) {
    int dev = 0, cus = 0, per_cu = 0;
    (void)hipGetDevice(&dev);
    (void)hipDeviceGetAttribute(&cus, hipDeviceAttributeMultiprocessorCount, dev);
    (void)hipOccupancyMaxActiveBlocksPerMultiprocessor(&per_cu, fwd_megakernel, 512, 0);
    if (per_cu > 1) per_cu = 1;
    grid_blocks = cus * per_cu;
    if (grid_blocks > 256) grid_blocks = 256;
    if (ws_size < 512 * MiB) fprintf(stderr, "workspace too small: %zu\n", ws_size);
  }
  Params p{};
  p.x = (const float*)d_in[0]; p.positions = (const int*)d_in[1]; p.mem = (const float*)d_in[2]; p.w_in = (const float*)d_in[3];
  p.gate_up = (const float*)d_in[4]; p.gate_bias = (const float*)d_in[5]; p.norm_g = (const float*)d_in[6]; p.w_out = (const float*)d_in[7];
  p.ln_mix_g = (const float*)d_in[8]; p.ln_mix_b = (const float*)d_in[9];
  p.wq = (const float*)d_in[10]; p.wk = (const float*)d_in[11]; p.wv = (const float*)d_in[12]; p.wo = (const float*)d_in[13];
  p.ln_mem_g = (const float*)d_in[14]; p.ln_mem_b = (const float*)d_in[15];
  p.w_pq = (const float*)d_in[16]; p.sk1 = (const float*)d_in[17]; p.sk2 = (const float*)d_in[18];
  p.ex_down = (const float*)d_in[19]; p.ex_up = (const float*)d_in[20];
  p.ln_ffn_g = (const float*)d_in[21]; p.ln_ffn_b = (const float*)d_in[22];
  p.out = (float*)d_out; p.ws = (char*)d_ws;
  (void)hipMemsetAsync((char*)d_ws + OFF_BAR, 0, 256, stream);
  void* args[] = {&p};
  hipError_t e = hipLaunchCooperativeKernel((void*)fwd_megakernel, dim3(grid_blocks), dim3(512), args, 0, stream);
  if (e != hipSuccess) fprintf(stderr, "cooperative launch failed: %s (grid %d)\n", hipGetErrorString(e), grid_blocks);
}
```

```cpp
#include <hip/hip_runtime.h>
#include <hip/hip_cooperative_groups.h>
#include <cstdio>
#include <cmath>
namespace cg = cooperative_groups;

#define DI __device__ __forceinline__
typedef short bf16x8 __attribute__((ext_vector_type(8)));
typedef short bf16x4 __attribute__((ext_vector_type(4)));
typedef float f32x16 __attribute__((ext_vector_type(16)));
typedef float f32x4 __attribute__((ext_vector_type(4)));
typedef unsigned u32x4 __attribute__((ext_vector_type(4)));
typedef unsigned u32x2 __attribute__((ext_vector_type(2)));
typedef unsigned short u16;
typedef __bf16 bf2_t __attribute__((ext_vector_type(2)));
typedef float f2_t __attribute__((ext_vector_type(2)));

#define MFMA(a, b, c) __builtin_amdgcn_mfma_f32_32x32x16_bf16((a), (b), (c), 0, 0, 0)

constexpr int T_ = 32768;
constexpr int S_ = 4096;
constexpr int TMW = 2368;
constexpr int TM_Q = 0, TM_K = 512, TM_QI = 1024, TM_KI = 1280, TM_WI = 1312, TM_GLR = 1320, TM_GQ = 1344, TM_GK = 1600, TM_GR = 1856;
constexpr int PROJ_N = 3456;
constexpr float ALPHA = 1.189207115002721f;
constexpr size_t MiB = 1024 * 1024;

constexpr size_t OFF_XB = 0;
constexpr size_t OFF_EXD = 64 * MiB;
constexpr size_t OFF_EXU = 80 * MiB;
constexpr size_t OFF_BCG = 96 * MiB;
constexpr size_t OFF_WIN = 128 * MiB;
constexpr size_t OFF_WOUT = OFF_WIN + (size_t)PROJ_N * 1024 * 2;
constexpr size_t OFF_WQ = OFF_WOUT + 2 * MiB;
constexpr size_t OFF_WK = OFF_WQ + 2 * MiB;
constexpr size_t OFF_WV = OFF_WK + 2 * MiB;
constexpr size_t OFF_WO = OFF_WV + 2 * MiB;
constexpr size_t OFF_WPQ = OFF_WO + 2 * MiB;
constexpr size_t OFF_KIF = 149 * MiB;
constexpr size_t OFF_MEMB = 152 * MiB;
constexpr size_t OFF_MEMK = 156 * MiB;
constexpr size_t OFF_MEMVT = 160 * MiB;
constexpr size_t OFF_THR = 164 * MiB;
constexpr size_t OFF_SK = OFF_THR + 256 * 1024;
constexpr size_t OFF_DECAY = OFF_SK + 128 * 1024;
constexpr size_t OFF_ESC = 165 * MiB;
constexpr size_t OFF_TM = 168 * MiB;
constexpr size_t OFF_VT = 316 * MiB;
constexpr size_t OFF_KFR = 476 * MiB;
constexpr size_t OFF_GVT = 348 * MiB;
constexpr size_t OFF_KVT = 380 * MiB;
constexpr size_t OFF_PREV = 444 * MiB;
constexpr size_t OFF_H = 168 * MiB;
constexpr size_t OFF_HB = 296 * MiB;
constexpr size_t OFF_QX = 360 * MiB;
constexpr size_t OFF_OX = 424 * MiB;
constexpr size_t OFF_EIDX = 0;
constexpr size_t OFF_GATE = 16 * MiB;
constexpr size_t OFF_COEF = 32 * MiB;

struct Params {
  const float* x; const int* positions; const float* mem; const float* w_in;
  const float* gate_up; const float* gate_bias; const float* norm_g; const float* w_out;
  const float* ln_mix_g; const float* ln_mix_b;
  const float* wq; const float* wk; const float* wv; const float* wo;
  const float* ln_mem_g; const float* ln_mem_b;
  const float* w_pq; const float* sk1; const float* sk2; const float* ex_down; const float* ex_up;
  const float* ln_ffn_g; const float* ln_ffn_b;
  float* out; char* ws;
};

DI unsigned pk_bf16(float a, float b) {
  f2_t v = {a, b};
  bf2_t r = __builtin_convertvector(v, bf2_t);
  return __builtin_bit_cast(unsigned, r);
}
DI u16 f2bf(float a) { return (u16)(pk_bf16(a, 0.f) & 0xffffu); }
DI float bf2f(u16 u) { return __uint_as_float(((unsigned)u) << 16); }
DI float bflo(unsigned u) { return __uint_as_float(u << 16); }
DI float bfhi(unsigned u) { return __uint_as_float(u & 0xffff0000u); }
DI int crow(int i, int h) { return (i & 3) + 8 * (i >> 2) + 4 * h; }
DI bf16x8 ldg8(const u16* p) { return *reinterpret_cast<const bf16x8*>(p); }
DI bf16x8 pack8(float a0, float a1, float a2, float a3, float a4, float a5, float a6, float a7) {
  u32x4 r; r[0] = pk_bf16(a0, a1); r[1] = pk_bf16(a2, a3); r[2] = pk_bf16(a4, a5); r[3] = pk_bf16(a6, a7);
  return __builtin_bit_cast(bf16x8, r);
}
DI bf16x8 cat44(bf16x4 lo, bf16x4 hi) { return __builtin_shufflevector(lo, hi, 0, 1, 2, 3, 4, 5, 6, 7); }
DI void st4bf(u16* p, float a, float b, float c, float d) {
  u32x2 v; v[0] = pk_bf16(a, b); v[1] = pk_bf16(c, d);
  *reinterpret_cast<u32x2*>(p) = v;
}
DI float wave_sum(float v) {
#pragma unroll
  for (int d = 32; d >= 1; d >>= 1) v += __shfl_xor(v, d);
  return v;
}
DI void sincos_rad(float ang, float& s, float& c) {
  constexpr float C_hi = (float)0.15915494309189535;
  constexpr float C_lo = (float)(0.15915494309189535 - (double)C_hi);
  float k = rintf(ang * C_hi);
  float f = fmaf(ang, C_hi, -k);
  f = fmaf(ang, C_lo, f);
  s = __builtin_amdgcn_sinf(f);
  c = __builtin_amdgcn_cosf(f);
}
DI unsigned fkey(float s) {
  const unsigned u = __float_as_uint(s);
  return u ^ ((unsigned)((int)u >> 31) | 0x80000000u);
}
DI f32x16 zero16() { f32x16 z; for (int i = 0; i < 16; ++i) z[i] = 0.f; return z; }

DI int win_src_col(int n) {
  if (n < 1832) return n;
  if (n < 1848) return 2856 + (n - 1832);
  if (n < 1856) return -1;
  if (n < 2880) return n - 24;
  if (n < 3392) return n - 8;
  return -1;
}

DI void cvt_stream(const float* __restrict__ src, u16* __restrict__ dst, size_t n, size_t gtid, size_t gn) {
  size_t n8 = n / 8;
  for (size_t i = gtid; i < n8; i += gn) {
    f32x4 a = *reinterpret_cast<const f32x4*>(src + i * 8);
    f32x4 b = *reinterpret_cast<const f32x4*>(src + i * 8 + 4);
    u32x4 r; r[0] = pk_bf16(a[0], a[1]); r[1] = pk_bf16(a[2], a[3]); r[2] = pk_bf16(b[0], b[1]); r[3] = pk_bf16(b[2], b[3]);
    *reinterpret_cast<u32x4*>(dst + i * 8) = r;
  }
}

template <bool MAPPED>
DI void transpose_tile(const float* __restrict__ W, int ldn, u16* __restrict__ Wt, int k0, int n0, float* tile) {
  const int tid = threadIdx.x;
  {
    int nn = n0 + (tid & 63);
    int c = MAPPED ? win_src_col(nn) : nn;
#pragma unroll
    for (int rr = 0; rr < 8; ++rr) {
      int kk = (tid >> 6) + 8 * rr;
      float v = (c >= 0) ? W[(size_t)(k0 + kk) * ldn + c] : 0.f;
      tile[kk * 65 + (tid & 63)] = v;
    }
  }
  __syncthreads();
#pragma unroll
  for (int rr = 0; rr < 8; ++rr) {
    int nn = (tid >> 6) + 8 * rr;
    int kk = tid & 63;
    Wt[(size_t)(n0 + nn) * 1024 + k0 + kk] = f2bf(tile[kk * 65 + nn]);
  }
  __syncthreads();
}

DI void phase_prep(const Params& p, char* smem) {
  const size_t gtid = (size_t)blockIdx.x * blockDim.x + threadIdx.x;
  const size_t gn = (size_t)gridDim.x * blockDim.x;
  char* ws = p.ws;
  cvt_stream(p.x, (u16*)(ws + OFF_XB), (size_t)T_ * 1024, gtid, gn);
  cvt_stream(p.mem, (u16*)(ws + OFF_MEMB), (size_t)2048 * 1024, gtid, gn);
  {
    const int lane = threadIdx.x & 63;
    const int gw = (int)(gtid >> 6), nw = (int)(gn >> 6);
    for (int r = gw; r < 2 * 16384; r += nw) {
      const int tbl = r >> 14, row = r & 16383;
      const float* src = (tbl ? p.ex_up : p.ex_down) + (size_t)row * 1024 + lane * 16;
      f32x4 v[4]; float mx = 0.f;
#pragma unroll
      for (int c = 0; c < 4; ++c) {
        v[c] = *reinterpret_cast<const f32x4*>(src + c * 4);
#pragma unroll
        for (int k = 0; k < 4; ++k) mx = fmaxf(mx, fabsf(v[c][k]));
      }
#pragma unroll
      for (int d = 32; d >= 1; d >>= 1) mx = fmaxf(mx, __shfl_xor(mx, d));
      float sc = (mx > 0.f) ? exp2f(floorf(log2f(224.f / mx))) : 1.f;
      u32x4 o;
#pragma unroll
      for (int c = 0; c < 4; ++c) {
        int t = __builtin_amdgcn_cvt_pk_fp8_f32(v[c][0] * sc, v[c][1] * sc, 0, false);
        t = __builtin_amdgcn_cvt_pk_fp8_f32(v[c][2] * sc, v[c][3] * sc, t, true);
        o[c] = (unsigned)t;
      }
      *reinterpret_cast<u32x4*>(ws + (tbl ? OFF_EXU : OFF_EXD) + (size_t)row * 1024 + lane * 16) = o;
      if (lane == 0) ((float*)(ws + OFF_ESC))[r] = 1.f / sc;
    }
  }
  cvt_stream(p.sk1, (u16*)(ws + OFF_SK), (size_t)128 * 128, gtid, gn);
  cvt_stream(p.sk2, (u16*)(ws + OFF_SK) + 128 * 128, (size_t)128 * 128, gtid, gn);
  float* tile = (float*)smem;
  const int n_win = 54 * 16, n_sq = 256, n_pq = 512;
  const int total = n_win + 5 * n_sq + n_pq;
  for (int t = blockIdx.x; t < total; t += gridDim.x) {
    if (t < n_win) {
      transpose_tile<true>(p.w_in, 3384, (u16*)(ws + OFF_WIN), (t & 15) * 64, (t >> 4) * 64, tile);
    } else if (t < n_win + 5 * n_sq) {
      int u = t - n_win; int which = u >> 8; int r = u & 255;
      const float* W = which == 0 ? p.w_out : which == 1 ? p.wq : which == 2 ? p.wk : which == 3 ? p.wv : p.wo;
      size_t off = which == 0 ? OFF_WOUT : which == 1 ? OFF_WQ : which == 2 ? OFF_WK : which == 3 ? OFF_WV : OFF_WO;
      transpose_tile<false>(W, 1024, (u16*)(ws + off), (r & 15) * 64, (r >> 4) * 64, tile);
    } else {
      int r = t - n_win - 5 * n_sq;
      transpose_tile<false>(p.w_pq, 2048, (u16*)(ws + OFF_WPQ), (r & 15) * 64, (r >> 4) * 64, tile);
    }
  }
}

#define WAIT_V(n) asm volatile("s_waitcnt vmcnt(%0)" ::"n"(n) : "memory")
#define RAW_BARRIER() do { asm volatile("s_waitcnt lgkmcnt(0)" ::: "memory"); __builtin_amdgcn_s_barrier(); asm volatile("" ::: "memory"); } while (0)
constexpr int G_STAGE = 384 * 128;
DI void gemm_tile(const u16* __restrict__ X, int ldx, const u16* __restrict__ Wt, int ldw, int K, char* smem,
                  f32x16 (&acc)[2][2]) {
  const int tid = threadIdx.x, lane = tid & 63, wave = tid >> 6;
  const int fw = wave & 1, tq = wave >> 1, lr = lane & 31, lh = lane >> 5;
#pragma unroll
  for (int a = 0; a < 2; ++a)
#pragma unroll
    for (int b = 0; b < 2; ++b) acc[a][b] = zero16();
  const int nk = K / 64;
  const u16* src[6];
#pragma unroll
  for (int i = 0; i < 6; ++i) {
    const int R = 8 * (wave + 8 * i) + (lane >> 3);
    const int c = (lane & 7) ^ ((R >> 1) & 7);
    src[i] = (i < 4) ? (X + (size_t)R * ldx + c * 8) : (Wt + (size_t)(R - 256) * ldw + c * 8);
  }
#define GLDS_STAGE(slot, kt) do { _Pragma("unroll") for (int i = 0; i < 6; ++i) \
    __builtin_amdgcn_global_load_lds((const unsigned*)(src[i] + (kt) * 64), (__attribute__((address_space(3))) unsigned*)(smem + (slot) * G_STAGE + (wave + 8 * i) * 1024), 16, 0, 0); } while (0)
  int offA[2], offB[2], xa[2], xb[2];
#pragma unroll
  for (int ft = 0; ft < 2; ++ft) { const int R = 256 + fw * 64 + ft * 32 + lr; offA[ft] = R * 128; xa[ft] = (R >> 1) & 7; }
#pragma unroll
  for (int tt = 0; tt < 2; ++tt) { const int R = tq * 64 + tt * 32 + lr; offB[tt] = R * 128; xb[tt] = (R >> 1) & 7; }
  GLDS_STAGE(0, 0); GLDS_STAGE(1, 1); WAIT_V(6); RAW_BARRIER();
  int cur = 0;
  for (int kt = 0; kt < nk; ++kt) {
    const int nxt = (cur >= 1) ? cur - 1 : 2;
    if (kt + 2 < nk) GLDS_STAGE(nxt, kt + 2);
    __builtin_amdgcn_sched_barrier(0);
    const char* st = smem + cur * G_STAGE;
#pragma unroll
    for (int ks = 0; ks < 4; ++ks) {
      bf16x8 a[2], b[2];
#pragma unroll
      for (int ft = 0; ft < 2; ++ft) a[ft] = *reinterpret_cast<const bf16x8*>(st + offA[ft] + (((ks * 2 + lh) ^ xa[ft]) << 4));
#pragma unroll
      for (int tt = 0; tt < 2; ++tt) b[tt] = *reinterpret_cast<const bf16x8*>(st + offB[tt] + (((ks * 2 + lh) ^ xb[tt]) << 4));
#pragma unroll
      for (int ft = 0; ft < 2; ++ft)
#pragma unroll
        for (int tt = 0; tt < 2; ++tt) acc[ft][tt] = MFMA(a[ft], b[tt], acc[ft][tt]);
    }
    if (kt + 2 < nk) { WAIT_V(6); } else { WAIT_V(0); }
    RAW_BARRIER();
    cur = (cur == 2) ? 0 : cur + 1;
  }
#undef GLDS_STAGE
}

DI void store_tm_rows(f32x16 (&acc)[2][2], char* smem, u16* tm, int tokbase, int col) {
  const int lane = threadIdx.x & 63, wave = threadIdx.x >> 6, lr = lane & 31, lh = lane >> 5;
  float* wl = (float*)(smem + wave * 17408);
#pragma unroll
  for (int tt = 0; tt < 2; ++tt)
#pragma unroll
    for (int ft = 0; ft < 2; ++ft)
#pragma unroll
      for (int g = 0; g < 4; ++g) {
        f32x4 v = {acc[ft][tt][4 * g], acc[ft][tt][4 * g + 1], acc[ft][tt][4 * g + 2], acc[ft][tt][4 * g + 3]};
        *reinterpret_cast<f32x4*>(wl + (tt * 32 + lr) * 68 + ft * 32 + 8 * g + 4 * lh) = v;
      }
  const int ch = lane & 15, r0 = lane >> 4;
#pragma unroll 4
  for (int k = 0; k < 16; ++k) {
    const int row = r0 + 4 * k;
    f32x4 v = *reinterpret_cast<const f32x4*>(wl + row * 68 + ch * 4);
    st4bf(tm + (size_t)(tokbase + row) * TMW + col + ch * 4, v[0], v[1], v[2], v[3]);
  }
}

DI void epi_inproj(const Params& p, int tok0, int f0, f32x16 (&acc)[2][2], char* smem) {
  const int tid = threadIdx.x, lane = tid & 63, wave = tid >> 6;
  const int fw = wave & 1, tq = wave >> 1, lr = lane & 31, lh = lane >> 5;
  const int fbase = f0 + fw * 64;
  if (fbase >= 3392) return;
  u16* tm = (u16*)(p.ws + OFF_TM);
  int tmcol = -1;
#pragma unroll
  for (int tt = 0; tt < 2; ++tt) {
    const int tok = tok0 + tq * 64 + tt * 32 + lr;
    const float posf = (float)p.positions[tok];
    const int bb = tok >> 12, ss = tok & 4095;
    if (fbase < 1024) {
#pragma unroll
      for (int r = 0; r < 4; ++r) {
        float j = (float)(4 * lh + r);
        float inv = exp2f(-j * (18.931568569324174f / 8.0f));
        float sn, cs; sincos_rad(posf * inv, sn, cs);
        float x1 = acc[0][tt][r], x2 = acc[0][tt][r + 4];
        acc[0][tt][r] = x1 * cs - x2 * sn;
        acc[0][tt][r + 4] = x2 * cs + x1 * sn;
      }
      if (fbase < 512) {
        tmcol = fbase;
      } else {
        u16* kfr = (u16*)(p.ws + OFF_KFR);
        const int head = (fbase - 512) >> 6, gt = ss >> 5;
#pragma unroll
        for (int ft = 0; ft < 2; ++ft)
#pragma unroll
          for (int g = 0; g < 4; ++g) {
            const int ks = ft * 2 + (g >> 1), lane2 = (g & 1) * 32 + lr;
            st4bf(kfr + ((((size_t)(bb * 8 + head) * 128 + gt) * 4 + ks) * 64 + lane2) * 8 + 4 * lh, acc[ft][tt][4 * g], acc[ft][tt][4 * g + 1], acc[ft][tt][4 * g + 2], acc[ft][tt][4 * g + 3]);
          }
      }
    } else if (fbase < 1536) {
      u16* vfr = (u16*)(p.ws + OFF_VT);
      const int head = (fbase - 1024) >> 6, gt = ss >> 5;
      const int s = lr >> 4, r16 = lr & 15, j = 4 * (r16 >> 3) + (r16 & 3), lh2 = (r16 >> 2) & 1;
#pragma unroll
      for (int ft = 0; ft < 2; ++ft)
#pragma unroll
        for (int i = 0; i < 16; ++i) {
          const int lane2 = lh2 * 32 + crow(i, lh);
          vfr[((((((size_t)(bb * 8 + head) * 128 + gt) * 2 + ft) * 2 + s) * 64 + lane2) * 8) + j] = f2bf(acc[ft][tt][i]);
        }
    } else if (fbase >= 2368 && fbase < 2880) {
      u16* vt = (u16*)(p.ws + OFF_GVT);
      const int fo = fbase - 2368;
#pragma unroll
      for (int ft = 0; ft < 2; ++ft)
#pragma unroll
        for (int i = 0; i < 16; ++i) {
          int feat = fo + ft * 32 + crow(i, lh);
          vt[((size_t)bb * 512 + feat) * 4096 + ss] = f2bf(acc[ft][tt][i]);
        }
    } else {
      if (fbase < 1856) {
#pragma unroll
        for (int ft = 0; ft < 2; ++ft) {
          const bool rot = (fbase < 1792) || (ft == 0);
#pragma unroll
          for (int r = 0; r < 4; ++r) {
            float v = acc[ft][tt][r];
            float o = __shfl_xor(v, 32);
            float inv = exp2f(-(float)r * (18.931568569324174f / 4.0f));
            float sn, cs; sincos_rad(posf * inv, sn, cs);
            float res = (lh == 0) ? (v * cs - o * sn) : (v * cs + o * sn);
            acc[ft][tt][r] = rot ? res : v;
          }
        }
        tmcol = fbase - 512;
        if (fbase == 1792) {
          u16* kif = (u16*)(p.ws + OFF_KIF);
          const int gt = ss >> 5;
#pragma unroll
          for (int g = 0; g < 4; ++g) {
            const int ks = g >> 1, lane2 = (g & 1) * 32 + lr;
            st4bf(kif + ((((size_t)bb * 128 + gt) * 2 + ks) * 64 + lane2) * 8 + 4 * lh, acc[0][tt][4 * g], acc[0][tt][4 * g + 1], acc[0][tt][4 * g + 2], acc[0][tt][4 * g + 3]);
          }
        }
      } else if (fbase < 2368) {
        tmcol = fbase - 512;
      } else {
        tmcol = fbase - 1024;
      }
    }
  }
  if (tmcol >= 0) store_tm_rows(acc, smem, tm, tok0 + tq * 64, tmcol);
}

DI void phase_inproj(const Params& p, char* smem) {
  const int n_in = 128 * 27;
  const int total = n_in + 128;
  const u16* xb = (const u16*)(p.ws + OFF_XB);
  const u16* memb = (const u16*)(p.ws + OFF_MEMB);
  const int tid = threadIdx.x, lane = tid & 63, wave = tid >> 6;
  const int fw = wave & 1, tq = wave >> 1, lr = lane & 31, lh = lane >> 5;
  const int xg = blockIdx.x & 7, xi = blockIdx.x >> 3, xn = gridDim.x >> 3;
  for (int u = xi; u < 16 * 27 + 16; u += xn) {
    f32x16 acc[2][2];
    const int t = (u < 16 * 27) ? (xg + 8 * (u / 27)) * 27 + (u % 27) : n_in + (u - 16 * 27) * 8 + xg;
    if (t < n_in) {
      int mt = t / 27, nt = t % 27;
      gemm_tile(xb + (size_t)mt * 256 * 1024, 1024, (const u16*)(p.ws + OFF_WIN) + (size_t)nt * 128 * 1024, 1024, 1024, smem, acc);
      epi_inproj(p, mt * 256, nt * 128, acc, smem);
      __syncthreads();
    } else {
      int u = t - n_in; int which = u >> 6; int r = u & 63; int mt = r >> 3, nt = r & 7;
      const u16* W = (const u16*)(p.ws + (which == 0 ? OFF_WK : OFF_WV));
      gemm_tile(memb + (size_t)mt * 256 * 1024, 1024, W + (size_t)nt * 128 * 1024, 1024, 1024, smem, acc);
#pragma unroll
      for (int tt = 0; tt < 2; ++tt) {
        const int tok = mt * 256 + tq * 64 + tt * 32 + lr;
        const int bb = tok >> 8, mm = tok & 255, hh = nt >> 1, kt = mm >> 5;
        if (which == 0) {
          u16* mk = (u16*)(p.ws + OFF_MEMK);
#pragma unroll
          for (int ft = 0; ft < 2; ++ft)
#pragma unroll
            for (int g = 0; g < 4; ++g) {
              const int ks = (nt & 1) * 8 + fw * 4 + ft * 2 + (g >> 1), lane2 = (g & 1) * 32 + lr;
              st4bf(mk + ((((size_t)(bb * 4 + hh) * 8 + kt) * 16 + ks) * 64 + lane2) * 8 + 4 * lh, acc[ft][tt][4 * g], acc[ft][tt][4 * g + 1], acc[ft][tt][4 * g + 2], acc[ft][tt][4 * g + 3]);
            }
        } else {
          u16* mv = (u16*)(p.ws + OFF_MEMVT);
          const int s = lr >> 4, r16 = lr & 15, j = 4 * (r16 >> 3) + (r16 & 3), lh2 = (r16 >> 2) & 1;
#pragma unroll
          for (int ft = 0; ft < 2; ++ft) {
            const int dt = (nt & 1) * 4 + fw * 2 + ft;
#pragma unroll
            for (int i = 0; i < 16; ++i) {
              const int lane2 = lh2 * 32 + crow(i, lh);
              mv[((((((size_t)(bb * 4 + hh) * 8 + dt) * 8 + kt) * 2 + s) * 64 + lane2) * 8) + j] = f2bf(acc[ft][tt][i]);
            }
          }
        }
      }
    }
  }
}

DI void idx_scores(const bf16x8 (&qf)[8][2], const float (&wq)[8], bf16x8 k0, bf16x8 k1, float (&sc)[16]) {
#pragma unroll
  for (int i = 0; i < 16; ++i) sc[i] = 0.f;
#pragma unroll
  for (int hd = 0; hd < 8; ++hd) {
    f32x16 a = zero16();
    a = MFMA(k0, qf[hd][0], a);
    a = MFMA(k1, qf[hd][1], a);
#pragma unroll
    for (int i = 0; i < 16; ++i) sc[i] = fmaf(wq[hd], fmaxf(a[i], 0.f), sc[i]);
  }
}

DI void load_idx_q(const u16* tm, int tok, int lh, bf16x8 (&qf)[8][2], float (&wq)[8]) {
  const u16* row = tm + (size_t)tok * TMW;
#pragma unroll
  for (int hd = 0; hd < 8; ++hd)
#pragma unroll
    for (int ks = 0; ks < 2; ++ks) qf[hd][ks] = ldg8(row + TM_QI + hd * 32 + ks * 16 + lh * 8);
  bf16x8 w8 = ldg8(row + TM_WI);
#pragma unroll
  for (int hd = 0; hd < 8; ++hd) wq[hd] = bf2f((u16)w8[hd]) * 0.0625f;
}

DI int wave_incl_scan(int v, int lane) {
#pragma unroll
  for (int d = 1; d < 64; d <<= 1) {
    int t = __shfl_up(v, d);
    if (lane >= d) v += t;
  }
  return v;
}

DI void dsa_thr_item(const Params& p, int b, int qblk, char* smem) {
  unsigned* hist = (unsigned*)smem;
  unsigned* pref = (unsigned*)(smem + 32768);
  int* rank = (int*)(smem + 32768 + 128);
  const u16* tm = (const u16*)(p.ws + OFF_TM);
  const int tid = threadIdx.x, lane = tid & 63, wave = tid >> 6, lr = lane & 31, lh = lane >> 5;
  const int q0 = qblk * 32;
  u16* qi = (u16*)(smem + 33280);
  for (int i = tid; i < 32 * 32; i += 512) {
    int q = i >> 5, ch = i & 31;
    *reinterpret_cast<u32x4*>(qi + q * 296 + ch * 8) = *reinterpret_cast<const u32x4*>(tm + (size_t)(b * S_ + q0 + q) * TMW + TM_QI + ch * 8);
  }
  float wq[8];
  {
    bf16x8 w8 = ldg8(tm + (size_t)(b * S_ + q0 + lr) * TMW + TM_WI);
#pragma unroll
    for (int hd = 0; hd < 8; ++hd) wq[hd] = bf2f((u16)w8[hd]) * 0.0625f;
  }
  __syncthreads();
  for (int i = tid; i < 32 * 32; i += 512) {
    const int q = i >> 5, d = i & 31;
    float acc = 0.f;
#pragma unroll
    for (int hd = 0; hd < 8; ++hd) acc = fmaf(bf2f(tm[(size_t)(b * S_ + q0 + q) * TMW + TM_WI + hd]) * 0.0625f, bf2f(qi[q * 296 + hd * 32 + d]), acc);
    qi[q * 296 + 256 + d] = f2bf(acc);
  }
  const u16* qil = qi + lr * 296 + lh * 8;
  if (tid < 32) { pref[tid] = 0u; rank[tid] = min(256, q0 + tid + 1); }
  for (int pass = 0; pass < 4; ++pass) {
    for (int i = tid; i < 8192; i += 512) hist[i] = 0u;
    __syncthreads();
    const int shift = 24 - 8 * pass;
    const unsigned mypref = pref[lr];
    const u16* kib = (const u16*)(p.ws + OFF_KIF) + (size_t)b * 128 * 1024 + lane * 8;
    bf16x8 kn0, kn1;
    {
      const int kt0 = min(wave, qblk);
      kn0 = ldg8(kib + (size_t)kt0 * 1024); kn1 = ldg8(kib + (size_t)kt0 * 1024 + 512);
    }
    for (int kt = wave; kt <= qblk; kt += 8) {
      const bf16x8 k0 = kn0, k1 = kn1;
      {
        const int ktn = min(kt + 8, qblk);
        kn0 = ldg8(kib + (size_t)ktn * 1024); kn1 = ldg8(kib + (size_t)ktn * 1024 + 512);
      }
      float sc[16];
      {
        f32x16 a = zero16();
        a = MFMA(k0, *reinterpret_cast<const bf16x8*>(qil + 256), a);
        a = MFMA(k1, *reinterpret_cast<const bf16x8*>(qil + 256 + 16), a);
#pragma unroll
        for (int i = 0; i < 16; ++i) sc[i] = a[i];
      }
#pragma unroll
      for (int hd = 0; hd < 8; ++hd) {
        f32x16 a = zero16();
        a = MFMA(k0, *reinterpret_cast<const bf16x8*>(qil + hd * 32), a);
        a = MFMA(k1, *reinterpret_cast<const bf16x8*>(qil + hd * 32 + 16), a);
        const float wh = wq[hd];
#pragma unroll
        for (int i = 0; i < 16; ++i) sc[i] = fmaf(fabsf(a[i]), wh, sc[i]);
      }
      if (kt == qblk) {
#pragma unroll
        for (int i = 0; i < 16; ++i) {
          int kp = kt * 32 + crow(i, lh);
          unsigned ky = fkey(sc[i]);
          unsigned hi = (ky >> shift);
          if (kp <= q0 + lr && (hi >> 8) == mypref) atomicAdd(&hist[(hi & 255u) * 32 + lr], 1u);
        }
      } else {
#pragma unroll
        for (int i = 0; i < 16; ++i) {
          unsigned ky = fkey(sc[i]);
          unsigned hi = (ky >> shift);
          if ((hi >> 8) == mypref) atomicAdd(&hist[(hi & 255u) * 32 + lr], 1u);
        }
      }
    }
    __syncthreads();
#pragma unroll 1
    for (int qq = 0; qq < 4; ++qq) {
      const int q = wave * 4 + qq;
      const int rk = rank[q];
      int c[4];
#pragma unroll
      for (int j = 0; j < 4; ++j) c[j] = (int)hist[(255 - 4 * lane - j) * 32 + q];
      int s = c[0] + c[1] + c[2] + c[3];
      int P = wave_incl_scan(s, lane);
      int excl = P - s;
      if (P >= rk && excl < rk) {
        int cum = excl; int bin = 0; int nr = 1; bool found = false;
#pragma unroll
        for (int j = 0; j < 4; ++j) {
          if (!found && cum + c[j] >= rk) { bin = 255 - 4 * lane - j; nr = rk - cum; found = true; }
          if (!found) cum += c[j];
        }
        pref[q] = (pref[q] << 8) | (unsigned)bin;
        rank[q] = nr;
      }
    }
    __syncthreads();
  }
  if (tid < 32) ((unsigned*)(p.ws + OFF_THR))[b * S_ + q0 + tid] = pref[tid];
  __syncthreads();
}

DI void dsa_attn_item(const Params& p, int b, int qblk, char* smem) {
  u16* maskbuf = (u16*)smem;
  u16* qi = (u16*)(smem + 4096);
  const u16* tm = (const u16*)(p.ws + OFF_TM);
  const u16* vfr = (const u16*)(p.ws + OFF_VT) + ((size_t)(b * 8 + (threadIdx.x >> 6)) * 128) * 2048 + (threadIdx.x & 63) * 8;
  const u16* kfr = (const u16*)(p.ws + OFF_KFR) + ((size_t)(b * 8 + (threadIdx.x >> 6)) * 128) * 2048 + (threadIdx.x & 63) * 8;
  const unsigned* thr = (const unsigned*)(p.ws + OFF_THR);
  const int tid = threadIdx.x, lane = tid & 63, wave = tid >> 6, lr = lane & 31, lh = lane >> 5;
  const int q0 = qblk * 32;
  const int head = wave;
  const int qtok = b * S_ + q0 + lr;
  bf16x8 Qf[4];
#pragma unroll
  for (int ks = 0; ks < 4; ++ks) {
    bf16x8 raw = ldg8(tm + (size_t)qtok * TMW + TM_Q + head * 64 + ks * 16 + lh * 8);
    float f[8];
#pragma unroll
    for (int j = 0; j < 8; ++j) f[j] = bf2f((u16)raw[j]) * (0.125f * 1.4426950408889634f);
    Qf[ks] = pack8(f[0], f[1], f[2], f[3], f[4], f[5], f[6], f[7]);
  }
  f32x16 O[2];
  O[0] = zero16(); O[1] = zero16();
  float mrun = -INFINITY, lrun = 0.f;
  const unsigned thrq = thr[qtok];
  const int nchunks = (q0 + 31) / 256 + 1;
  for (int i = tid; i < 32 * 32; i += 512) {
    int q = i >> 5, ch = i & 31;
    *reinterpret_cast<u32x4*>(qi + q * 296 + ch * 8) = *reinterpret_cast<const u32x4*>(tm + (size_t)(b * S_ + q0 + q) * TMW + TM_QI + ch * 8);
  }
  float* wqs = (float*)(smem + 4096 + 32 * 296 * 2);
  if (tid < 256) wqs[tid] = bf2f(tm[(size_t)(b * S_ + q0 + (tid & 31)) * TMW + TM_WI + (tid >> 5)]) * 0.0625f;
  __syncthreads();
  for (int i = tid; i < 32 * 32; i += 512) {
    const int q = i >> 5, d = i & 31;
    float acc = 0.f;
#pragma unroll
    for (int hd = 0; hd < 8; ++hd) acc = fmaf(bf2f(tm[(size_t)(b * S_ + q0 + q) * TMW + TM_WI + hd]) * 0.0625f, bf2f(qi[q * 296 + hd * 32 + d]), acc);
    qi[q * 296 + 256 + d] = f2bf(acc);
  }
  __syncthreads();
  const u16* qil = qi + lr * 296 + lh * 8;
  const u16* kibase = (const u16*)(p.ws + OFF_KIF) + (size_t)b * 128 * 1024 + lane * 8;
  bf16x8 Kf[4], Kn[4];
#pragma unroll
  for (int ks = 0; ks < 4; ++ks) Kf[ks] = ldg8(kfr + ks * 512);
  bf16x8 Vf[2][2], Vn[2][2];
#pragma unroll
  for (int dt = 0; dt < 2; ++dt)
#pragma unroll
    for (int s = 0; s < 2; ++s) Vf[dt][s] = ldg8(vfr + (dt * 2 + s) * 512);
  bf16x8 ki0, ki1;
  {
    const int kt0 = min(wave, qblk);
    ki0 = ldg8(kibase + (size_t)kt0 * 1024); ki1 = ldg8(kibase + (size_t)kt0 * 1024 + 512);
  }
  for (int c = 0; c < nchunks; ++c) {
    const int buf = c & 1;
    {
      const int key0 = (c * 8 + wave) * 32;
      unsigned bits = 0u;
      const bf16x8 k0 = ki0, k1 = ki1;
      {
        const int ktn = min((c + 1) * 8 + wave, qblk);
        ki0 = ldg8(kibase + (size_t)ktn * 1024); ki1 = ldg8(kibase + (size_t)ktn * 1024 + 512);
      }
      if (key0 <= q0 + 31) {
        float sc[16];
        {
          f32x16 a = zero16();
          a = MFMA(k0, *reinterpret_cast<const bf16x8*>(qil + 256), a);
          a = MFMA(k1, *reinterpret_cast<const bf16x8*>(qil + 256 + 16), a);
#pragma unroll
          for (int i = 0; i < 16; ++i) sc[i] = a[i];
        }
#pragma unroll 2
        for (int hd = 0; hd < 8; ++hd) {
          f32x16 a = zero16();
          a = MFMA(k0, *reinterpret_cast<const bf16x8*>(qil + hd * 32), a);
          a = MFMA(k1, *reinterpret_cast<const bf16x8*>(qil + hd * 32 + 16), a);
          const float wh = wqs[hd * 32 + lr];
#pragma unroll
          for (int i = 0; i < 16; ++i) sc[i] = fmaf(fabsf(a[i]), wh, sc[i]);
        }
        __builtin_amdgcn_sched_barrier(0);
#pragma unroll
        for (int i = 0; i < 16; ++i) {
          int kp = key0 + crow(i, lh);
          if (kp <= q0 + lr && fkey(sc[i]) >= thrq) bits |= (1u << i);
        }
      }
      maskbuf[(buf * 8 + wave) * 64 + lane] = (u16)bits;
    }
    __syncthreads();
#pragma unroll 1
    for (int t8 = 0; t8 < 8; ++t8) {
      const int g = c * 8 + t8;
      if (g > qblk) break;
      {
        const int gn = min(g + 1, qblk);
        const u16* kr = kfr + (size_t)gn * 2048;
#pragma unroll
        for (int ks = 0; ks < 4; ++ks) Kn[ks] = ldg8(kr + ks * 512);
#pragma unroll
        for (int dt = 0; dt < 2; ++dt)
#pragma unroll
          for (int s = 0; s < 2; ++s) Vn[dt][s] = ldg8(vfr + (size_t)gn * 2048 + (dt * 2 + s) * 512);
      }

      const unsigned bits = maskbuf[(buf * 8 + t8) * 64 + lane];
      f32x16 Sx = zero16();
#pragma unroll
      for (int ks = 0; ks < 4; ++ks) Sx = MFMA(Kf[ks], Qf[ks], Sx);
      float sm[16];
#pragma unroll
      for (int i = 0; i < 16; ++i) {
        const unsigned t = (unsigned)__builtin_amdgcn_sbfe((int)bits, i, 1);
        sm[i] = __uint_as_float((t & __float_as_uint(Sx[i])) | (~t & 0xff800000u));
      }
      float mt = fmaxf(fmaxf(fmaxf(sm[0], sm[1]), fmaxf(sm[2], sm[3])), fmaxf(fmaxf(sm[4], sm[5]), fmaxf(sm[6], sm[7])));
      mt = fmaxf(mt, fmaxf(fmaxf(fmaxf(sm[8], sm[9]), fmaxf(sm[10], sm[11])), fmaxf(fmaxf(sm[12], sm[13]), fmaxf(sm[14], sm[15]))));
      mt = fmaxf(mt, __shfl_xor(mt, 32));
      const float mnew = fmaxf(mrun, mt);
      const float msafe = (mnew == -INFINITY) ? 0.f : mnew;
      const float alpha = __builtin_amdgcn_exp2f(mrun - msafe);
      float pv[16]; float ps = 0.f;
#pragma unroll
      for (int i = 0; i < 16; ++i) { pv[i] = __builtin_amdgcn_exp2f(sm[i] - msafe); ps += pv[i]; }
      lrun = lrun * alpha + ps;
      mrun = mnew;
      if (__builtin_amdgcn_ballot_w64(alpha != 1.f) != 0ull) {
#pragma unroll
        for (int dt = 0; dt < 2; ++dt)
#pragma unroll
          for (int i = 0; i < 16; ++i) O[dt][i] *= alpha;
      }
      bf16x8 Pf[2];
#pragma unroll
      for (int s = 0; s < 2; ++s) Pf[s] = pack8(pv[8 * s], pv[8 * s + 1], pv[8 * s + 2], pv[8 * s + 3], pv[8 * s + 4], pv[8 * s + 5], pv[8 * s + 6], pv[8 * s + 7]);
#pragma unroll
      for (int dt = 0; dt < 2; ++dt)
#pragma unroll
        for (int s = 0; s < 2; ++s) O[dt] = MFMA(Vf[dt][s], Pf[s], O[dt]);
#pragma unroll
      for (int ks = 0; ks < 4; ++ks) Kf[ks] = Kn[ks];
#pragma unroll
      for (int dt = 0; dt < 2; ++dt)
#pragma unroll
        for (int s = 0; s < 2; ++s) Vf[dt][s] = Vn[dt][s];
    }
  }
  u16* y = (u16*)(p.ws + OFF_XB);
  {
    float lt = lrun + __shfl_xor(lrun, 32);
    float inv = 1.f / lt;
#pragma unroll
    for (int dt = 0; dt < 2; ++dt)
#pragma unroll
      for (int g = 0; g < 4; ++g)
        st4bf(y + (size_t)qtok * 1024 + head * 64 + dt * 32 + 8 * g + 4 * lh, O[dt][4 * g] * inv, O[dt][4 * g + 1] * inv, O[dt][4 * g + 2] * inv, O[dt][4 * g + 3] * inv);
  }
  __syncthreads();
}

DI void gla_bcum(const Params& p, int b, int h, int n, float* bc, float* glr_s, float* segtot) {
  const u16* tm = (const u16*)(p.ws + OFF_TM);
  const int tid = threadIdx.x;
  const int tok0 = b * S_ + n * 64;
  for (int i = tid; i < 1024; i += 512) glr_s[i] = bf2f(tm[(size_t)(tok0 + (i >> 4)) * TMW + TM_GLR + (i & 15)]);
  const int d = tid & 63, cgp = tid >> 6;
  float gu[16];
#pragma unroll
  for (int j = 0; j < 16; ++j) gu[j] = p.gate_up[j * 256 + h * 64 + d];
  const float bias = p.gate_bias[h * 64 + d];
  __syncthreads();
  float v[8]; float run = 0.f;
#pragma unroll
  for (int r = 0; r < 8; ++r) {
    const int c = cgp * 8 + r;
    float z = bias;
#pragma unroll
    for (int j4 = 0; j4 < 4; ++j4) {
      const f32x4 gv = *reinterpret_cast<const f32x4*>(glr_s + c * 16 + j4 * 4);
#pragma unroll
      for (int j = 0; j < 4; ++j) z = fmaf(gv[j], gu[j4 * 4 + j], z);
    }
    float la = (fminf(z, 0.f) - __logf(1.f + __expf(-fabsf(z)))) * 0.0625f;
    run += la; v[r] = run;
  }
  segtot[cgp * 64 + d] = run;
  __syncthreads();
  float off = 0.f;
#pragma unroll
  for (int g = 0; g < 8; ++g) off += (g < cgp) ? segtot[g * 64 + d] : 0.f;
#pragma unroll
  for (int r = 0; r < 8; ++r) bc[(cgp * 8 + r) * 64 + d] = off + v[r];
  __syncthreads();
}

DI void gla_g1_item(const Params& p, int item, char* smem) {
  float* bc = (float*)smem;
  float* glr_s = (float*)(smem + 16384);
  float* segtot = (float*)(smem + 20480);
  u16* KeT = (u16*)(smem + 22528);
  const int b = item >> 8, h = (item >> 6) & 3, n = item & 63;
  const u16* tm = (const u16*)(p.ws + OFF_TM);
  const u16* gvT = (const u16*)(p.ws + OFF_GVT);
  const int tid = threadIdx.x, lane = tid & 63, wave = tid >> 6, lr = lane & 31, lh = lane >> 5;
  const int tok0 = b * S_ + n * 64;
  u16 kraw[8];
  {
    const int d = tid & 63, cgp = tid >> 6;
#pragma unroll
    for (int r = 0; r < 8; ++r) kraw[r] = tm[(size_t)(tok0 + cgp * 8 + r) * TMW + TM_GK + h * 64 + d];
  }
  bf16x8 afr[4];
  {
    const int et = wave & 3;
    const u16* arow = gvT + ((size_t)b * 512 + h * 128 + et * 32 + lr) * 4096 + n * 64 + lh * 8;
#pragma unroll
    for (int ks = 0; ks < 4; ++ks) afr[ks] = ldg8(arow + ks * 16);
  }
  gla_bcum(p, b, h, n, bc, glr_s, segtot);
  {
    const int d = tid & 63, cgp = tid >> 6;
    const float blast = bc[63 * 64 + d];
    {
      float* bcg = (float*)(p.ws + OFF_BCG) + (size_t)item * 4096;
#pragma unroll
      for (int r = 0; r < 8; ++r) bcg[(cgp * 8 + r) * 64 + d] = bc[(cgp * 8 + r) * 64 + d];
    }
    float f[8];
#pragma unroll
    for (int r = 0; r < 8; ++r) {
      const int c = cgp * 8 + r;
      float kv = bf2f(kraw[r]);
      f[r] = kv * __expf(blast - bc[c * 64 + d]);
    }
    *reinterpret_cast<bf16x8*>(KeT + d * 72 + cgp * 8) = pack8(f[0], f[1], f[2], f[3], f[4], f[5], f[6], f[7]);
    if (cgp == 0) ((float*)(p.ws + OFF_DECAY))[item * 64 + d] = __expf(blast);
  }
  __syncthreads();
  {
    const int et = wave & 3, dtl = wave >> 2;
    f32x16 acc = zero16();
#pragma unroll
    for (int ks = 0; ks < 4; ++ks) {
      bf16x8 a = afr[ks];
      bf16x8 bb = *reinterpret_cast<const bf16x8*>(KeT + (dtl * 32 + lr) * 72 + ks * 16 + lh * 8);
      acc = MFMA(a, bb, acc);
    }
    float* kvT = (float*)(p.ws + OFF_KVT);
#pragma unroll
    for (int i = 0; i < 16; ++i) kvT[((size_t)item * 128 + et * 32 + crow(i, lh)) * 64 + dtl * 32 + lr] = acc[i];
  }
  __syncthreads();
}

DI void gla_scan(const Params& p) {
  const float* kvT = (const float*)(p.ws + OFF_KVT);
  const float* decay = (const float*)(p.ws + OFF_DECAY);
  u16* prev = (u16*)(p.ws + OFF_PREV);
  const int gtid = blockIdx.x * blockDim.x + threadIdx.x;
  const int gn = gridDim.x * blockDim.x;
  for (int u = gtid; u < 32 * 2048; u += gn) {
    const int bh = u >> 11, rem = u & 2047, e = rem >> 4, d4 = (rem & 15) * 4;
    f32x4 st = {0.f, 0.f, 0.f, 0.f};
#pragma unroll 4
    for (int n = 0; n < 64; ++n) {
      const int item = bh * 64 + n;
      st4bf(prev + ((size_t)item * 128 + e) * 64 + d4, st[0], st[1], st[2], st[3]);
      f32x4 dc = *reinterpret_cast<const f32x4*>(decay + item * 64 + d4);
      f32x4 kv = *reinterpret_cast<const f32x4*>(kvT + ((size_t)item * 128 + e) * 64 + d4);
      st = dc * st + kv;
    }
  }
}

DI void gla_g3_item(const Params& p, int item, char* smem) {
  float* red = (float*)smem;
  const int b = item >> 8, h = (item >> 6) & 3, n = item & 63;
  const u16* tm = (const u16*)(p.ws + OFF_TM);
  const u16* gvT = (const u16*)(p.ws + OFF_GVT);
  const u16* prev = (const u16*)(p.ws + OFF_PREV);
  const float* bcg = (const float*)(p.ws + OFF_BCG) + (size_t)item * 4096;
  const int tid = threadIdx.x, lane = tid & 63, wave = tid >> 6, lr = lane & 31, lh = lane >> 5;
  const int tok0 = b * S_ + n * 64;
  const int et = wave & 3, ct = wave >> 2;
  bf16x8 qraw[4], kraw[2][4], sfr[4];
  bf16x4 vlo[2][2], vhi[2][2];
  f32x4 bq[4][2];
  {
    const u16* vrow0 = gvT + ((size_t)b * 512 + h * 128 + et * 32 + lr) * 4096 + n * 64 + 4 * lh;
    const u16* srow0 = prev + ((size_t)item * 128 + et * 32 + lr) * 64 + lh * 8;
#pragma unroll
    for (int ks = 0; ks < 4; ++ks) {
      qraw[ks] = ldg8(tm + (size_t)(tok0 + ct * 32 + lr) * TMW + TM_GQ + h * 64 + ks * 16 + lh * 8);
      kraw[0][ks] = ldg8(tm + (size_t)(tok0 + lr) * TMW + TM_GK + h * 64 + ks * 16 + lh * 8);
      kraw[1][ks] = ldg8(tm + (size_t)(tok0 + ct * 32 + lr) * TMW + TM_GK + h * 64 + ks * 16 + lh * 8);
      sfr[ks] = ldg8(srow0 + ks * 16);
      bq[ks][0] = *reinterpret_cast<const f32x4*>(bcg + (ct * 32 + lr) * 64 + ks * 16 + lh * 8);
      bq[ks][1] = *reinterpret_cast<const f32x4*>(bcg + (ct * 32 + lr) * 64 + ks * 16 + lh * 8 + 4);
    }
#pragma unroll
    for (int st = 0; st < 2; ++st)
#pragma unroll
      for (int s2 = 0; s2 < 2; ++s2) {
        const u16* vp = vrow0 + (st * ct) * 32 + 16 * s2;
        vlo[st][s2] = *reinterpret_cast<const bf16x4*>(vp);
        vhi[st][s2] = *reinterpret_cast<const bf16x4*>(vp + 8);
      }
  }
  bf16x8 Qd[4];
#pragma unroll
  for (int ks = 0; ks < 4; ++ks) {
    float f[8];
#pragma unroll
    for (int j = 0; j < 8; ++j) f[j] = bf2f((u16)qraw[ks][j]) * 0.125f * __expf(bq[ks][j >> 2][j & 3]);
    Qd[ks] = pack8(f[0], f[1], f[2], f[3], f[4], f[5], f[6], f[7]);
  }
  f32x16 O = zero16();
#pragma unroll
  for (int st = 0; st < 2; ++st) {
    if (st <= ct) {
      f32x16 A = zero16();
      const int s = st * 32 + lr;
#pragma unroll
      for (int ks = 0; ks < 4; ++ks) {
        f32x4 b0 = (st == 1) ? bq[ks][0] : *reinterpret_cast<const f32x4*>(bcg + s * 64 + ks * 16 + lh * 8);
        f32x4 b1 = (st == 1) ? bq[ks][1] : *reinterpret_cast<const f32x4*>(bcg + s * 64 + ks * 16 + lh * 8 + 4);
        float f[8];
#pragma unroll
        for (int j = 0; j < 8; ++j) f[j] = bf2f((u16)kraw[st][ks][j]) * __expf(-((j < 4) ? b0[j & 3] : b1[j & 3]));
        bf16x8 Ki = pack8(f[0], f[1], f[2], f[3], f[4], f[5], f[6], f[7]);
        A = MFMA(Ki, Qd[ks], A);
      }
      float pv[16];
#pragma unroll
      for (int i = 0; i < 16; ++i) pv[i] = (st * 32 + crow(i, lh) <= ct * 32 + lr) ? A[i] : 0.f;
#pragma unroll
      for (int s2 = 0; s2 < 2; ++s2) {
        bf16x8 Pf = pack8(pv[8 * s2], pv[8 * s2 + 1], pv[8 * s2 + 2], pv[8 * s2 + 3], pv[8 * s2 + 4], pv[8 * s2 + 5], pv[8 * s2 + 6], pv[8 * s2 + 7]);
        O = MFMA(cat44(vlo[st][s2], vhi[st][s2]), Pf, O);
      }
    }
  }
#pragma unroll
  for (int ks = 0; ks < 4; ++ks) O = MFMA(sfr[ks], Qd[ks], O);
  float ss = 0.f;
#pragma unroll
  for (int i = 0; i < 16; ++i) ss += O[i] * O[i];
  ss += __shfl_xor(ss, 32);
  if (lh == 0) red[(ct * 4 + et) * 32 + lr] = ss;
  __syncthreads();
  const float tot = red[(ct * 4 + 0) * 32 + lr] + red[(ct * 4 + 1) * 32 + lr] + red[(ct * 4 + 2) * 32 + lr] + red[(ct * 4 + 3) * 32 + lr];
  const float rinv = rsqrtf(tot * (1.f / 128.f) + 1e-6f);
  const int tok = tok0 + ct * 32 + lr;
  u16* y = (u16*)(p.ws + OFF_XB);
#pragma unroll
  for (int g = 0; g < 4; ++g) {
    const int e0 = et * 32 + 8 * g + 4 * lh;
    u32x2 gr = *reinterpret_cast<const u32x2*>(tm + (size_t)tok * TMW + TM_GR + h * 128 + e0);
    f32x4 ng = *reinterpret_cast<const f32x4*>(p.norm_g + e0);
    float grv[4] = {bflo(gr[0]), bfhi(gr[0]), bflo(gr[1]), bfhi(gr[1])};
    float o[4];
#pragma unroll
    for (int r = 0; r < 4; ++r) {
      float sl = grv[r] / (1.f + __expf(-grv[r]));
      o[r] = O[4 * g + r] * rinv * ng[r] * sl;
    }
    st4bf(y + (size_t)tok * 1024 + 512 + h * 128 + e0, o[0], o[1], o[2], o[3]);
  }
  __syncthreads();
}

template <int MODE>
DI void phase_gemm(const Params& p, const u16* X, const u16* Wt, int N, const float* resid, float* outf, u16* outb, int ldo, char* smem) {
  const int ntn = N / 128;
  const int tid = threadIdx.x, lane = tid & 63, wave = tid >> 6;
  const int fw = wave & 1, tq = wave >> 1, lr = lane & 31, lh = lane >> 5;
  const int xg = blockIdx.x & 7, xi = blockIdx.x >> 3, xn = gridDim.x >> 3;
  const int per_group = 16 * ntn;
  for (int u = xi; u < per_group; u += xn) {
    const int mt = xg + 8 * (u / ntn), nt = u % ntn;
    f32x16 acc[2][2];
    gemm_tile(X + (size_t)mt * 256 * 1024, 1024, Wt + (size_t)nt * 128 * 1024, 1024, 1024, smem, acc);
    if (MODE == 0 || MODE == 1) {
      float* wl = (float*)(smem + wave * 17408);
#pragma unroll
      for (int tt = 0; tt < 2; ++tt)
#pragma unroll
        for (int ft = 0; ft < 2; ++ft)
#pragma unroll
          for (int g = 0; g < 4; ++g) {
            f32x4 v = {acc[ft][tt][4 * g], acc[ft][tt][4 * g + 1], acc[ft][tt][4 * g + 2], acc[ft][tt][4 * g + 3]};
            *reinterpret_cast<f32x4*>(wl + (tt * 32 + lr) * 68 + ft * 32 + 8 * g + 4 * lh) = v;
          }
      const int ch = lane & 15, r0 = lane >> 4;
      const int f = nt * 128 + fw * 64 + ch * 4;
#pragma unroll 4
      for (int k = 0; k < 16; ++k) {
        const int row = r0 + 4 * k;
        const int tok = mt * 256 + tq * 64 + row;
        f32x4 v = *reinterpret_cast<const f32x4*>(wl + row * 68 + ch * 4);
        if (MODE == 0) {
          f32x4 r = *reinterpret_cast<const f32x4*>(resid + (size_t)tok * 1024 + f);
          f32x4 o;
#pragma unroll
          for (int j = 0; j < 4; ++j) o[j] = ALPHA * r[j] + v[j];
          *reinterpret_cast<f32x4*>(outf + (size_t)tok * 1024 + f) = o;
        } else {
          st4bf(outb + (size_t)tok * ldo + f, v[0], v[1], v[2], v[3]);
        }
      }
      __syncthreads();
    } else {
#pragma unroll
      for (int tt = 0; tt < 2; ++tt) {
        const int tok = mt * 256 + tq * 64 + tt * 32 + lr;
#pragma unroll
        for (int ft = 0; ft < 2; ++ft)
#pragma unroll
          for (int g = 0; g < 4; ++g) {
            const int f = nt * 128 + fw * 64 + ft * 32 + 8 * g + 4 * lh;
            if (MODE == 2) {
              const int hh = f >> 8, fh = f & 255, ks = fh >> 4, lane2 = ((fh >> 3) & 1) * 32 + lr;
              st4bf(outb + ((((size_t)(tok >> 5) * 4 + hh) * 16 + ks) * 64 + lane2) * 8 + 4 * lh, acc[ft][tt][4 * g], acc[ft][tt][4 * g + 1], acc[ft][tt][4 * g + 2], acc[ft][tt][4 * g + 3]);
            } else {
              const int hh = f >> 8, fq = f & 127, half = (f >> 7) & 1, ks = fq >> 4, lane2 = ((fq >> 3) & 1) * 32 + lr;
              st4bf(outb + (((((size_t)(tok >> 5) * 8 + hh) * 2 + half) * 8 + ks) * 64 + lane2) * 8 + 4 * lh, acc[ft][tt][4 * g], acc[ft][tt][4 * g + 1], acc[ft][tt][4 * g + 2], acc[ft][tt][4 * g + 3]);
            }
          }
      }
    }
  }
}

DI void phase_ln(const Params& p, float* h, u16* hb, const float* g, const float* bta) {
  const int lane = threadIdx.x & 63;
  const int gw = (blockIdx.x * blockDim.x + threadIdx.x) >> 6;
  const int nw = (gridDim.x * blockDim.x) >> 6;
  for (int row = gw; row < T_; row += nw) {
    float* r = h + (size_t)row * 1024;
    f32x4 v[4]; float s = 0.f;
#pragma unroll
    for (int c = 0; c < 4; ++c) { v[c] = *reinterpret_cast<const f32x4*>(r + c * 256 + lane * 4); s += v[c][0] + v[c][1] + v[c][2] + v[c][3]; }
    const float mean = wave_sum(s) * (1.f / 1024.f);
    float q = 0.f;
#pragma unroll
    for (int c = 0; c < 4; ++c)
#pragma unroll
      for (int k = 0; k < 4; ++k) { float d = v[c][k] - mean; q += d * d; }
    const float rstd = rsqrtf(wave_sum(q) * (1.f / 1024.f) + 1e-5f);
#pragma unroll
    for (int c = 0; c < 4; ++c) {
      f32x4 gg = *reinterpret_cast<const f32x4*>(g + c * 256 + lane * 4);
      f32x4 bb = *reinterpret_cast<const f32x4*>(bta + c * 256 + lane * 4);
      f32x4 o;
#pragma unroll
      for (int k = 0; k < 4; ++k) o[k] = (v[c][k] - mean) * rstd * gg[k] + bb[k];
      *reinterpret_cast<f32x4*>(r + c * 256 + lane * 4) = o;
      st4bf(hb + (size_t)row * 1024 + c * 256 + lane * 4, o[0], o[1], o[2], o[3]);
    }
  }
}

DI void phase_xattn(const Params& p) {
  const u16* qx = (const u16*)(p.ws + OFF_QX);
  const u16* mk = (const u16*)(p.ws + OFF_MEMK);
  const u16* mv = (const u16*)(p.ws + OFF_MEMVT);
  u16* ox = (u16*)(p.ws + OFF_OX);
  const int lane = threadIdx.x & 63, lr = lane & 31, lh = lane >> 5;
  const int gw = (blockIdx.x * blockDim.x + threadIdx.x) >> 6;
  const int nw = (gridDim.x * blockDim.x) >> 6;
  for (int it = gw; it < 8 * 4 * 128; it += nw) {
    const int qt = it & 127, h = (it >> 7) & 3, b = it >> 9;
    const int tok = b * S_ + qt * 32 + lr;
    f32x16 Sx[8];
#pragma unroll
    for (int kt = 0; kt < 8; ++kt) Sx[kt] = zero16();
    const u16* qrow = qx + (((size_t)(b * 128 + qt) * 4 + h) * 16) * 512 + lane * 8;
    const u16* krow = mk + (((size_t)(b * 4 + h) * 8) * 16) * 512 + lane * 8;
#pragma unroll 2
    for (int ks = 0; ks < 16; ++ks) {
      bf16x8 qf = ldg8(qrow + ks * 512);
#pragma unroll
      for (int kt = 0; kt < 8; ++kt) Sx[kt] = MFMA(ldg8(krow + (kt * 16 + ks) * 512), qf, Sx[kt]);
    }
    float mx = -INFINITY;
#pragma unroll
    for (int kt = 0; kt < 8; ++kt)
#pragma unroll
      for (int i = 0; i < 16; ++i) mx = fmaxf(mx, Sx[kt][i]);
    mx = fmaxf(mx, __shfl_xor(mx, 32));
    float ls = 0.f;
    bf16x8 Pf[8][2];
#pragma unroll
    for (int kt = 0; kt < 8; ++kt) {
      float pv[16];
#pragma unroll
      for (int i = 0; i < 16; ++i) { pv[i] = __expf((Sx[kt][i] - mx) * 0.0625f); ls += pv[i]; }
#pragma unroll
      for (int s = 0; s < 2; ++s) Pf[kt][s] = pack8(pv[8 * s], pv[8 * s + 1], pv[8 * s + 2], pv[8 * s + 3], pv[8 * s + 4], pv[8 * s + 5], pv[8 * s + 6], pv[8 * s + 7]);
    }
    ls += __shfl_xor(ls, 32);
    const float inv = 1.f / ls;
#pragma unroll 1
    for (int dt = 0; dt < 8; ++dt) {
      f32x16 o = zero16();
      const u16* vrow = mv + ((((size_t)(b * 4 + h) * 8 + dt) * 8) * 2) * 512 + lane * 8;
#pragma unroll
      for (int kt = 0; kt < 8; ++kt)
#pragma unroll
        for (int s = 0; s < 2; ++s) o = MFMA(ldg8(vrow + (kt * 2 + s) * 512), Pf[kt][s], o);
#pragma unroll
      for (int g = 0; g < 4; ++g)
        st4bf(ox + (size_t)tok * 1024 + h * 256 + dt * 32 + 8 * g + 4 * lh, o[4 * g] * inv, o[4 * g + 1] * inv, o[4 * g + 2] * inv, o[4 * g + 3] * inv);
    }
  }
}

DI void peer_topk_item(const Params& p, int tt128, int head, char* smem) {
  float* sc = (float*)smem;
  float* topv = (float*)(smem + 132096);
  unsigned char* topi = (unsigned char*)(smem + 132096 + 16384);
  const u16* pq = (const u16*)(p.ws + OFF_QX);
  const u16* sk = (const u16*)(p.ws + OFF_SK);
  const int tid = threadIdx.x, lane = tid & 63, wave = tid >> 6, lr = lane & 31, lh = lane >> 5;
  const int tok0 = tt128 * 128;
  {
    const int half = wave >> 2, kt = wave & 3;
    bf16x8 af[8];
#pragma unroll
    for (int ks = 0; ks < 8; ++ks) af[ks] = ldg8(sk + (size_t)half * 16384 + (kt * 32 + lr) * 128 + ks * 16 + lh * 8);
#pragma unroll 1
    for (int tt = 0; tt < 4; ++tt) {
      f32x16 acc = zero16();
      const u16* brow = pq + (((((size_t)(tok0 >> 5) + tt) * 8 + head) * 2 + half) * 8) * 512 + lane * 8;
#pragma unroll
      for (int ks = 0; ks < 8; ++ks) acc = MFMA(af[ks], ldg8(brow + ks * 512), acc);
#pragma unroll
      for (int i = 0; i < 16; ++i) sc[(half * 128 + tt * 32 + lr) * 129 + kt * 32 + crow(i, lh)] = acc[i];
    }
  }
  __syncthreads();
  if (tid < 256) {
    float* row = sc + tid * 129;
    float gm[8]; int gi[8];
#pragma unroll
    for (int g = 0; g < 8; ++g) {
      float m = -INFINITY; int mi = g * 16;
#pragma unroll
      for (int j = 0; j < 16; ++j) { float v = row[g * 16 + j]; if (v > m) { m = v; mi = g * 16 + j; } }
      gm[g] = m; gi[g] = mi;
    }
#pragma unroll 1
    for (int r = 0; r < 16; ++r) {
      float best = gm[0]; int bg = 0; int bi = gi[0];
#pragma unroll
      for (int g = 1; g < 8; ++g) if (gm[g] > best) { best = gm[g]; bg = g; bi = gi[g]; }
      topv[tid * 16 + r] = best; topi[tid * 16 + r] = (unsigned char)bi;
      row[bi] = -INFINITY;
      float m = -INFINITY; int mi = bg * 16;
#pragma unroll
      for (int j = 0; j < 16; ++j) { float v = row[bg * 16 + j]; if (v > m) { m = v; mi = bg * 16 + j; } }
#pragma unroll
      for (int g = 0; g < 8; ++g) { gm[g] = (g == bg) ? m : gm[g]; gi[g] = (g == bg) ? mi : gi[g]; }
    }
  }
  __syncthreads();
  if (tid < 128) {
    const float* av = topv + tid * 16;
    const float* bv = topv + (128 + tid) * 16;
    const unsigned char* ai = topi + tid * 16;
    const unsigned char* bi_ = topi + (128 + tid) * 16;
    float cur[16]; int pp[16];
    const float b0 = bv[0];
#pragma unroll
    for (int i = 0; i < 16; ++i) { cur[i] = av[i] + b0; pp[i] = 0; }
    float sel[16]; int eid[16];
#pragma unroll
    for (int r = 0; r < 16; ++r) {
      float best = cur[0]; int bi = 0; int bj = pp[0];
#pragma unroll
      for (int i = 1; i < 16; ++i) if (cur[i] > best) { best = cur[i]; bi = i; bj = pp[i]; }
      sel[r] = best;
      eid[r] = (int)ai[bi] * 128 + (int)bi_[bj];
      const int nj = bj + 1;
      const float nv = (nj < 16) ? (av[bi] + bv[nj & 15]) : -INFINITY;
#pragma unroll
      for (int i = 0; i < 16; ++i) { cur[i] = (i == bi) ? nv : cur[i]; pp[i] = (i == bi) ? nj : pp[i]; }
    }
    float sum = 0.f;
    const float smax = sel[0];
#pragma unroll
    for (int r = 0; r < 16; ++r) { sel[r] = __expf(sel[r] - smax); sum += sel[r]; }
    const float inv = 1.f / sum;
    int* eo = (int*)(p.ws + OFF_EIDX) + (size_t)(tok0 + tid) * 128 + head * 16;
    float* go = (float*)(p.ws + OFF_GATE) + (size_t)(tok0 + tid) * 128 + head * 16;
#pragma unroll
    for (int r = 0; r < 16; ++r) { eo[r] = eid[r]; go[r] = sel[r] * inv; }
  }
  __syncthreads();
}

DI float dot2bf(unsigned a, unsigned b, float c) {
  return __builtin_amdgcn_fdot2_f32_bf16(__builtin_bit_cast(bf2_t, a), __builtin_bit_cast(bf2_t, b), c, false);
}

DI float reduce8(float (&part)[8], int lane) {
  float r4[4], r2[2], r1;
#pragma unroll
  for (int k = 0; k < 4; ++k) {
    float send = (lane & 1) ? part[2 * k] : part[2 * k + 1];
    float keep = (lane & 1) ? part[2 * k + 1] : part[2 * k];
    r4[k] = keep + __shfl_xor(send, 1);
  }
#pragma unroll
  for (int k = 0; k < 2; ++k) {
    float send = (lane & 2) ? r4[2 * k] : r4[2 * k + 1];
    float keep = (lane & 2) ? r4[2 * k + 1] : r4[2 * k];
    r2[k] = keep + __shfl_xor(send, 2);
  }
  {
    float send = (lane & 4) ? r2[0] : r2[1];
    float keep = (lane & 4) ? r2[1] : r2[0];
    r1 = keep + __shfl_xor(send, 4);
  }
  r1 += __shfl_xor(r1, 8);
  r1 += __shfl_xor(r1, 16);
  r1 += __shfl_xor(r1, 32);
  return r1;
}

DI void phase_peer_down(const Params& p) {
  const char* exd = p.ws + OFF_EXD;
  const float* esc = (const float*)(p.ws + OFF_ESC);
  const u16* hb = (const u16*)(p.ws + OFF_HB);
  const int* eidx = (const int*)(p.ws + OFF_EIDX);
  const float* gate = (const float*)(p.ws + OFF_GATE);
  float* coefw = (float*)(p.ws + OFF_COEF);
  const int lane = threadIdx.x & 63;
  const int gw = (blockIdx.x * blockDim.x + threadIdx.x) >> 6;
  const int nw = (gridDim.x * blockDim.x) >> 6;
#pragma unroll 1
  for (int tok = gw; tok < T_; tok += nw) {
    float x[16];
    {
      const u16* xr = hb + (size_t)tok * 1024 + lane * 16;
      u32x4 a = *reinterpret_cast<const u32x4*>(xr);
      u32x4 c = *reinterpret_cast<const u32x4*>(xr + 8);
#pragma unroll
      for (int w = 0; w < 4; ++w) { x[2 * w] = bflo(a[w]); x[2 * w + 1] = bfhi(a[w]); x[8 + 2 * w] = bflo(c[w]); x[8 + 2 * w + 1] = bfhi(c[w]); }
    }
#pragma unroll 1
    for (int half = 0; half < 2; ++half) {
      const size_t slot = (size_t)tok * 128 + half * 64 + lane;
      const int ev = eidx[slot];
      const float gv = gate[slot];
      float racc = 0.f, gacc = 0.f;
#pragma unroll 1
      for (int bi = 0; bi < 8; ++bi) {
        u32x4 dr[8];
#pragma unroll
        for (int k = 0; k < 8; ++k) {
          const int er = __builtin_amdgcn_readlane(ev, bi * 8 + k);
          dr[k] = *reinterpret_cast<const u32x4*>(exd + (size_t)er * 1024 + lane * 16);
        }
        const int pmine = bi * 8 + (lane & 7);
        const int emine = __shfl(ev, pmine);
        const float gsel = __shfl(gv, pmine);
        const float sd = esc[emine];
        const float su = esc[16384 + emine];
        float part[8];
#pragma unroll
        for (int k = 0; k < 8; ++k) {
          float a0 = 0.f, a1 = 0.f;
#pragma unroll
          for (int w = 0; w < 4; ++w) {
            f2_t lo = __builtin_amdgcn_cvt_pk_f32_fp8((int)dr[k][w], false);
            f2_t hi = __builtin_amdgcn_cvt_pk_f32_fp8((int)dr[k][w], true);
            a0 = fmaf(lo[0], x[4 * w], a0); a1 = fmaf(lo[1], x[4 * w + 1], a1);
            a0 = fmaf(hi[0], x[4 * w + 2], a0); a1 = fmaf(hi[1], x[4 * w + 3], a1);
          }
          part[k] = a0 + a1;
        }
        const float r1 = reduce8(part, lane) * sd;
        const bool mine = (lane >> 3) == bi;
        racc = mine ? r1 : racc; gacc = mine ? gsel * su : gacc;
      }
      const float act = 0.5f * racc * (1.f + erff(racc * 0.70710678118654752f));
      coefw[slot] = gacc * act;
    }
  }
}

DI void phase_peer_ffn(const Params& p) {
  const char* exu = p.ws + OFF_EXU;
  const float* h = (const float*)(p.ws + OFF_H);
  const int* eidx = (const int*)(p.ws + OFF_EIDX);
  const float* coefw = (const float*)(p.ws + OFF_COEF);
  const int lane = threadIdx.x & 63;
  const int gw = (blockIdx.x * blockDim.x + threadIdx.x) >> 6;
  const int nw = (gridDim.x * blockDim.x) >> 6;
  for (int tok = gw; tok < T_; tok += nw) {
    float yacc[16];
#pragma unroll
    for (int i = 0; i < 16; ++i) yacc[i] = 0.f;
    const int e_lo = eidx[(size_t)tok * 128 + lane];
    const int e_hi = eidx[(size_t)tok * 128 + 64 + lane];
    const float c_lo = coefw[(size_t)tok * 128 + lane];
    const float c_hi = coefw[(size_t)tok * 128 + 64 + lane];
#pragma unroll 1
    for (int eb = 0; eb < 8; ++eb) {
      const int ev = (eb < 4) ? e_lo : e_hi;
      const float cv = (eb < 4) ? c_lo : c_hi;
      const int lbase = (eb & 3) * 16;
      u32x4 ur[16];
#pragma unroll
      for (int k = 0; k < 16; ++k) {
        const int er = __builtin_amdgcn_readlane(ev, lbase + k);
        ur[k] = *reinterpret_cast<const u32x4*>(exu + (size_t)er * 1024 + lane * 16);
      }
#pragma unroll
      for (int k = 0; k < 16; ++k) {
        const float ck = __int_as_float(__builtin_amdgcn_readlane(__float_as_int(cv), lbase + k));
#pragma unroll
        for (int w = 0; w < 4; ++w) {
          f2_t lo = __builtin_amdgcn_cvt_pk_f32_fp8((int)ur[k][w], false);
          f2_t hi = __builtin_amdgcn_cvt_pk_f32_fp8((int)ur[k][w], true);
          yacc[4 * w] = fmaf(ck, lo[0], yacc[4 * w]);
          yacc[4 * w + 1] = fmaf(ck, lo[1], yacc[4 * w + 1]);
          yacc[4 * w + 2] = fmaf(ck, hi[0], yacc[4 * w + 2]);
          yacc[4 * w + 3] = fmaf(ck, hi[1], yacc[4 * w + 3]);
        }
      }
    }
    const float* xr = h + (size_t)tok * 1024 + lane * 16;
    float v[16];
#pragma unroll
    for (int c = 0; c < 4; ++c) {
      f32x4 t = *reinterpret_cast<const f32x4*>(xr + c * 4);
#pragma unroll
      for (int k = 0; k < 4; ++k) v[4 * c + k] = ALPHA * t[k] + yacc[4 * c + k];
    }
    float s = 0.f;
#pragma unroll
    for (int i = 0; i < 16; ++i) s += v[i];
    const float mean = wave_sum(s) * (1.f / 1024.f);
    float q = 0.f;
#pragma unroll
    for (int i = 0; i < 16; ++i) { float d = v[i] - mean; q += d * d; }
    const float rstd = rsqrtf(wave_sum(q) * (1.f / 1024.f) + 1e-5f);
    float* orow = p.out + (size_t)tok * 1024 + lane * 16;
#pragma unroll
    for (int c = 0; c < 4; ++c) {
      f32x4 gg = *reinterpret_cast<const f32x4*>(p.ln_ffn_g + lane * 16 + c * 4);
      f32x4 bb = *reinterpret_cast<const f32x4*>(p.ln_ffn_b + lane * 16 + c * 4);
      f32x4 o;
#pragma unroll
      for (int k = 0; k < 4; ++k) o[k] = (v[4 * c + k] - mean) * rstd * gg[k] + bb[k];
      *reinterpret_cast<f32x4*>(orow + c * 4) = o;
    }
  }
}

constexpr size_t OFF_BAR = 166 * MiB;
DI void gbar(unsigned* ctr, unsigned target) {
  asm volatile("s_waitcnt vmcnt(0)" ::: "memory");
  __syncthreads();
  if (threadIdx.x == 0) {
    __builtin_amdgcn_fence(__ATOMIC_RELEASE, "agent");
    asm volatile("s_waitcnt vmcnt(0)" ::: "memory");
    __hip_atomic_fetch_add(ctr, 1u, __ATOMIC_RELAXED, __HIP_MEMORY_SCOPE_AGENT);
    while (__hip_atomic_load(ctr, __ATOMIC_RELAXED, __HIP_MEMORY_SCOPE_AGENT) < target) __builtin_amdgcn_s_sleep(2);
    __builtin_amdgcn_fence(__ATOMIC_ACQUIRE, "agent");
    asm volatile("s_waitcnt vmcnt(0)" ::: "memory");
  }
  __syncthreads();
}

__global__ void __launch_bounds__(512) fwd_megakernel(Params p) {
  __shared__ __attribute__((aligned(1024))) char smem[155648];
  cg::grid_group grid = cg::this_grid();
  const int G = gridDim.x;
  char* ws = p.ws;
  unsigned* bar = (unsigned*)(ws + OFF_BAR);

  phase_prep(p, smem);
  grid.sync();

  phase_inproj(p, smem);
  gbar(bar, (unsigned)(1 * G));

  for (int k = 0; k * G < 1024; ++k) {
    int j = (k & 1) ? (G - 1 - (int)blockIdx.x) : (int)blockIdx.x;
    int idx = k * G + j;
    if (idx < 1024) dsa_thr_item(p, idx & 7, 127 - (idx >> 3), smem);
  }
  for (int it = blockIdx.x; it < 2048; it += G) gla_g1_item(p, it, smem);
  gbar(bar, (unsigned)(2 * G));

  for (int k = 0; k * G < 1024; ++k) {
    int j = (k & 1) ? (G - 1 - (int)blockIdx.x) : (int)blockIdx.x;
    int idx = k * G + j;
    if (idx < 1024) dsa_attn_item(p, idx & 7, 127 - (idx >> 3), smem);
  }
  gla_scan(p);
  gbar(bar, (unsigned)(3 * G));

  for (int it = blockIdx.x; it < 2048; it += G) gla_g3_item(p, it, smem);
  gbar(bar, (unsigned)(4 * G));

  phase_gemm<0>(p, (const u16*)(ws + OFF_XB), (const u16*)(ws + OFF_WOUT), 1024, p.x, (float*)(ws + OFF_H), nullptr, 0, smem);
  gbar(bar, (unsigned)(5 * G));
  phase_ln(p, (float*)(ws + OFF_H), (u16*)(ws + OFF_HB), p.ln_mix_g, p.ln_mix_b);
  gbar(bar, (unsigned)(6 * G));

  phase_gemm<2>(p, (const u16*)(ws + OFF_HB), (const u16*)(ws + OFF_WQ), 1024, nullptr, nullptr, (u16*)(ws + OFF_QX), 1024, smem);
  gbar(bar, (unsigned)(7 * G));
  phase_xattn(p);
  gbar(bar, (unsigned)(8 * G));
  phase_gemm<0>(p, (const u16*)(ws + OFF_OX), (const u16*)(ws + OFF_WO), 1024, (const float*)(ws + OFF_H), (float*)(ws + OFF_H), nullptr, 0, smem);
  gbar(bar, (unsigned)(9 * G));
  phase_ln(p, (float*)(ws + OFF_H), (u16*)(ws + OFF_HB), p.ln_mem_g, p.ln_mem_b);
  gbar(bar, (unsigned)(10 * G));

  phase_gemm<5>(p, (const u16*)(ws + OFF_HB), (const u16*)(ws + OFF_WPQ), 2048, nullptr, nullptr, (u16*)(ws + OFF_QX), 2048, smem);
  gbar(bar, (unsigned)(11 * G));
  for (int it = blockIdx.x; it < 2048; it += G) peer_topk_item(p, it >> 3, it & 7, smem);
  gbar(bar, (unsigned)(12 * G));
  phase_peer_down(p);
  gbar(bar, (unsigned)(13 * G));
  phase_peer_ffn(p);
}

extern "C" void kernel_launch(void* const* d_in, const int* in_sizes, int n_in,
                              void* d_out, int out_size, void* d_ws, size_t ws_size,
                              hipStream_t stream) {
  static int grid_blocks = 0;
  if (!grid_blocks) {
    int dev = 0, cus = 0, per_cu = 0;
    (void)hipGetDevice(&dev);
    (void)hipDeviceGetAttribute(&cus, hipDeviceAttributeMultiprocessorCount, dev);
    (void)hipOccupancyMaxActiveBlocksPerMultiprocessor(&per_cu, fwd_megakernel, 512, 0);
    if (per_cu > 1) per_cu = 1;
    grid_blocks = cus * per_cu;
    if (grid_blocks > 256) grid_blocks = 256;
    if (ws_size < 512 * MiB) fprintf(stderr, "workspace too small: %zu\n", ws_size);
  }
  Params p{};
  p.x = (const float*)d_in[0]; p.positions = (const int*)d_in[1]; p.mem = (const float*)d_in[2]; p.w_in = (const float*)d_in[3];
  p.gate_up = (const float*)d_in[4]; p.gate_bias = (const float*)d_in[5]; p.norm_g = (const float*)d_in[6]; p.w_out = (const float*)d_in[7];
  p.ln_mix_g = (const float*)d_in[8]; p.ln_mix_b = (const float*)d_in[9];
  p.wq = (const float*)d_in[10]; p.wk = (const float*)d_in[11]; p.wv = (const float*)d_in[12]; p.wo = (const float*)d_in[13];
  p.ln_mem_g = (const float*)d_in[14]; p.ln_mem_b = (const float*)d_in[15];
  p.w_pq = (const float*)d_in[16]; p.sk1 = (const float*)d_in[17]; p.sk2 = (const float*)d_in[18];
  p.ex_down = (const float*)d_in[19]; p.ex_up = (const float*)d_in[20];
  p.ln_ffn_g = (const float*)d_in[21]; p.ln_ffn_b = (const float*)d_in[22];
  p.out = (float*)d_out; p.ws = (char*)d_ws;
  (void)hipMemsetAsync((char*)d_ws + OFF_BAR, 0, 256, stream);
  void* args[] = {&p};
  hipError_t e = hipLaunchCooperativeKernel((void*)fwd_megakernel, dim3(grid_blocks), dim3(512), args, 0, stream);
  if (e != hipSuccess) fprintf(stderr, "cooperative launch failed: %s (grid %d)\n", hipGetErrorString(e), grid_blocks);
}
```

```cpp
#include <hip/hip_runtime.h>
#include <hip/hip_cooperative_groups.h>
#include <cstdio>
#include <cmath>
namespace cg = cooperative_groups;

#define DI __device__ __forceinline__
typedef short bf16x8 __attribute__((ext_vector_type(8)));
typedef short bf16x4 __attribute__((ext_vector_type(4)));
typedef float f32x16 __attribute__((ext_vector_type(16)));
typedef float f32x4 __attribute__((ext_vector_type(4)));
typedef unsigned u32x4 __attribute__((ext_vector_type(4)));
typedef unsigned u32x2 __attribute__((ext_vector_type(2)));
typedef unsigned short u16;
typedef __bf16 bf2_t __attribute__((ext_vector_type(2)));
typedef float f2_t __attribute__((ext_vector_type(2)));

#define MFMA(a, b, c) __builtin_amdgcn_mfma_f32_32x32x16_bf16((a), (b), (c), 0, 0, 0)

constexpr int T_ = 32768;
constexpr int S_ = 4096;
constexpr int TMW = 2368;
constexpr int TM_Q = 0, TM_K = 512, TM_QI = 1024, TM_KI = 1280, TM_WI = 1312, TM_GLR = 1320, TM_GQ = 1344, TM_GK = 1600, TM_GR = 1856;
constexpr int PROJ_N = 3456;
constexpr float ALPHA = 1.189207115002721f;
constexpr size_t MiB = 1024 * 1024;

constexpr size_t OFF_XB = 0;
constexpr size_t OFF_EXD = 64 * MiB;
constexpr size_t OFF_EXU = 80 * MiB;
constexpr size_t OFF_BCG = 96 * MiB;
constexpr size_t OFF_WIN = 128 * MiB;
constexpr size_t OFF_WOUT = OFF_WIN + (size_t)PROJ_N * 1024 * 2;
constexpr size_t OFF_WQ = OFF_WOUT + 2 * MiB;
constexpr size_t OFF_WK = OFF_WQ + 2 * MiB;
constexpr size_t OFF_WV = OFF_WK + 2 * MiB;
constexpr size_t OFF_WO = OFF_WV + 2 * MiB;
constexpr size_t OFF_WPQ = OFF_WO + 2 * MiB;
constexpr size_t OFF_KIF = 149 * MiB;
constexpr size_t OFF_MEMB = 152 * MiB;
constexpr size_t OFF_MEMK = 156 * MiB;
constexpr size_t OFF_MEMVT = 160 * MiB;
constexpr size_t OFF_THR = 164 * MiB;
constexpr size_t OFF_SK = OFF_THR + 256 * 1024;
constexpr size_t OFF_DECAY = OFF_SK + 128 * 1024;
constexpr size_t OFF_ESC = 165 * MiB;
constexpr size_t OFF_TM = 168 * MiB;
constexpr size_t OFF_VT = 316 * MiB;
constexpr size_t OFF_KFR = 476 * MiB;
constexpr size_t OFF_GVT = 348 * MiB;
constexpr size_t OFF_KVT = 380 * MiB;
constexpr size_t OFF_PREV = 444 * MiB;
constexpr size_t OFF_H = 168 * MiB;
constexpr size_t OFF_HB = 296 * MiB;
constexpr size_t OFF_QX = 360 * MiB;
constexpr size_t OFF_OX = 424 * MiB;
constexpr size_t OFF_EIDX = 0;
constexpr size_t OFF_GATE = 16 * MiB;
constexpr size_t OFF_COEF = 32 * MiB;

struct Params {
  const float* x; const int* positions; const float* mem; const float* w_in;
  const float* gate_up; const float* gate_bias; const float* norm_g; const float* w_out;
  const float* ln_mix_g; const float* ln_mix_b;
  const float* wq; const float* wk; const float* wv; const float* wo;
  const float* ln_mem_g; const float* ln_mem_b;
  const float* w_pq; const float* sk1; const float* sk2; const float* ex_down; const float* ex_up;
  const float* ln_ffn_g; const float* ln_ffn_b;
  float* out; char* ws;
};

DI unsigned pk_bf16(float a, float b) {
  f2_t v = {a, b};
  bf2_t r = __builtin_convertvector(v, bf2_t);
  return __builtin_bit_cast(unsigned, r);
}
DI u16 f2bf(float a) { return (u16)(pk_bf16(a, 0.f) & 0xffffu); }
DI float bf2f(u16 u) { return __uint_as_float(((unsigned)u) << 16); }
DI float bflo(unsigned u) { return __uint_as_float(u << 16); }
DI float bfhi(unsigned u) { return __uint_as_float(u & 0xffff0000u); }
DI int crow(int i, int h) { return (i & 3) + 8 * (i >> 2) + 4 * h; }
DI bf16x8 ldg8(const u16* p) { return *reinterpret_cast<const bf16x8*>(p); }
DI bf16x8 pack8(float a0, float a1, float a2, float a3, float a4, float a5, float a6, float a7) {
  u32x4 r; r[0] = pk_bf16(a0, a1); r[1] = pk_bf16(a2, a3); r[2] = pk_bf16(a4, a5); r[3] = pk_bf16(a6, a7);
  return __builtin_bit_cast(bf16x8, r);
}
DI bf16x8 cat44(bf16x4 lo, bf16x4 hi) { return __builtin_shufflevector(lo, hi, 0, 1, 2, 3, 4, 5, 6, 7); }
DI void st4bf(u16* p, float a, float b, float c, float d) {
  u32x2 v; v[0] = pk_bf16(a, b); v[1] = pk_bf16(c, d);
  *reinterpret_cast<u32x2*>(p) = v;
}
DI float wave_sum(float v) {
#pragma unroll
  for (int d = 32; d >= 1; d >>= 1) v += __shfl_xor(v, d);
  return v;
}
DI void sincos_rad(float ang, float& s, float& c) {
  constexpr float C_hi = (float)0.15915494309189535;
  constexpr float C_lo = (float)(0.15915494309189535 - (double)C_hi);
  float k = rintf(ang * C_hi);
  float f = fmaf(ang, C_hi, -k);
  f = fmaf(ang, C_lo, f);
  s = __builtin_amdgcn_sinf(f);
  c = __builtin_amdgcn_cosf(f);
}
DI unsigned fkey(float s) {
  const unsigned u = __float_as_uint(s);
  return u ^ ((unsigned)((int)u >> 31) | 0x80000000u);
}
DI f32x16 zero16() { f32x16 z; for (int i = 0; i < 16; ++i) z[i] = 0.f; return z; }

DI int win_src_col(int n) {
  if (n < 1832) return n;
  if (n < 1848) return 2856 + (n - 1832);
  if (n < 1856) return -1;
  if (n < 2880) return n - 24;
  if (n < 3392) return n - 8;
  return -1;
}

DI void cvt_stream(const float* __restrict__ src, u16* __restrict__ dst, size_t n, size_t gtid, size_t gn) {
  size_t n8 = n / 8;
  for (size_t i = gtid; i < n8; i += gn) {
    f32x4 a = *reinterpret_cast<const f32x4*>(src + i * 8);
    f32x4 b = *reinterpret_cast<const f32x4*>(src + i * 8 + 4);
    u32x4 r; r[0] = pk_bf16(a[0], a[1]); r[1] = pk_bf16(a[2], a[3]); r[2] = pk_bf16(b[0], b[1]); r[3] = pk_bf16(b[2], b[3]);
    *reinterpret_cast<u32x4*>(dst + i * 8) = r;
  }
}

template <bool MAPPED>
DI void transpose_tile(const float* __restrict__ W, int ldn, u16* __restrict__ Wt, int k0, int n0, float* tile) {
  const int tid = threadIdx.x;
  {
    int nn = n0 + (tid & 63);
    int c = MAPPED ? win_src_col(nn) : nn;
#pragma unroll
    for (int rr = 0; rr < 8; ++rr) {
      int kk = (tid >> 6) + 8 * rr;
      float v = (c >= 0) ? W[(size_t)(k0 + kk) * ldn + c] : 0.f;
      tile[kk * 65 + (tid & 63)] = v;
    }
  }
  __syncthreads();
#pragma unroll
  for (int rr = 0; rr < 8; ++rr) {
    int nn = (tid >> 6) + 8 * rr;
    int kk = tid & 63;
    Wt[(size_t)(n0 + nn) * 1024 + k0 + kk] = f2bf(tile[kk * 65 + nn]);
  }
  __syncthreads();
}

DI void phase_prep(const Params& p, char* smem) {
  const size_t gtid = (size_t)blockIdx.x * blockDim.x + threadIdx.x;
  const size_t gn = (size_t)gridDim.x * blockDim.x;
  char* ws = p.ws;
  cvt_stream(p.x, (u16*)(ws + OFF_XB), (size_t)T_ * 1024, gtid, gn);
  cvt_stream(p.mem, (u16*)(ws + OFF_MEMB), (size_t)2048 * 1024, gtid, gn);
  {
    const int lane = threadIdx.x & 63;
    const int gw = (int)(gtid >> 6), nw = (int)(gn >> 6);
    for (int r = gw; r < 2 * 16384; r += nw) {
      const int tbl = r >> 14, row = r & 16383;
      const float* src = (tbl ? p.ex_up : p.ex_down) + (size_t)row * 1024 + lane * 16;
      f32x4 v[4]; float mx = 0.f;
#pragma unroll
      for (int c = 0; c < 4; ++c) {
        v[c] = *reinterpret_cast<const f32x4*>(src + c * 4);
#pragma unroll
        for (int k = 0; k < 4; ++k) mx = fmaxf(mx, fabsf(v[c][k]));
      }
#pragma unroll
      for (int d = 32; d >= 1; d >>= 1) mx = fmaxf(mx, __shfl_xor(mx, d));
      float sc = (mx > 0.f) ? exp2f(floorf(log2f(224.f / mx))) : 1.f;
      u32x4 o;
#pragma unroll
      for (int c = 0; c < 4; ++c) {
        int t = __builtin_amdgcn_cvt_pk_fp8_f32(v[c][0] * sc, v[c][1] * sc, 0, false);
        t = __builtin_amdgcn_cvt_pk_fp8_f32(v[c][2] * sc, v[c][3] * sc, t, true);
        o[c] = (unsigned)t;
      }
      *reinterpret_cast<u32x4*>(ws + (tbl ? OFF_EXU : OFF_EXD) + (size_t)row * 1024 + lane * 16) = o;
      if (lane == 0) ((float*)(ws + OFF_ESC))[r] = 1.f / sc;
    }
  }
  cvt_stream(p.sk1, (u16*)(ws + OFF_SK), (size_t)128 * 128, gtid, gn);
  cvt_stream(p.sk2, (u16*)(ws + OFF_SK) + 128 * 128, (size_t)128 * 128, gtid, gn);
  float* tile = (float*)smem;
  const int n_win = 54 * 16, n_sq = 256, n_pq = 512;
  const int total = n_win + 5 * n_sq + n_pq;
  for (int t = blockIdx.x; t < total; t += gridDim.x) {
    if (t < n_win) {
      transpose_tile<true>(p.w_in, 3384, (u16*)(ws + OFF_WIN), (t & 15) * 64, (t >> 4) * 64, tile);
    } else if (t < n_win + 5 * n_sq) {
      int u = t - n_win; int which = u >> 8; int r = u & 255;
      const float* W = which == 0 ? p.w_out : which == 1 ? p.wq : which == 2 ? p.wk : which == 3 ? p.wv : p.wo;
      size_t off = which == 0 ? OFF_WOUT : which == 1 ? OFF_WQ : which == 2 ? OFF_WK : which == 3 ? OFF_WV : OFF_WO;
      transpose_tile<false>(W, 1024, (u16*)(ws + off), (r & 15) * 64, (r >> 4) * 64, tile);
    } else {
      int r = t - n_win - 5 * n_sq;
      transpose_tile<false>(p.w_pq, 2048, (u16*)(ws + OFF_WPQ), (r & 15) * 64, (r >> 4) * 64, tile);
    }
  }
}

#define WAIT_V(n) asm volatile("s_waitcnt vmcnt(%0)" ::"n"(n) : "memory")
#define RAW_BARRIER() do { asm volatile("s_waitcnt lgkmcnt(0)" ::: "memory"); __builtin_amdgcn_s_barrier(); asm volatile("" ::: "memory"); } while (0)
constexpr int G_STAGE = 384 * 128;
DI void gemm_tile(const u16* __restrict__ X, int ldx, const u16* __restrict__ Wt, int ldw, int K, char* smem,
                  f32x16 (&acc)[2][2]) {
  const int tid = threadIdx.x, lane = tid & 63, wave = tid >> 6;
  const int fw = wave & 1, tq = wave >> 1, lr = lane & 31, lh = lane >> 5;
#pragma unroll
  for (int a = 0; a < 2; ++a)
#pragma unroll
    for (int b = 0; b < 2; ++b) acc[a][b] = zero16();
  const int nk = K / 64;
  const u16* src[6];
#pragma unroll
  for (int i = 0; i < 6; ++i) {
    const int R = 8 * (wave + 8 * i) + (lane >> 3);
    const int c = (lane & 7) ^ ((R >> 1) & 7);
    src[i] = (i < 4) ? (X + (size_t)R * ldx + c * 8) : (Wt + (size_t)(R - 256) * ldw + c * 8);
  }
#define GLDS_STAGE(slot, kt) do { _Pragma("unroll") for (int i = 0; i < 6; ++i) \
    __builtin_amdgcn_global_load_lds((const unsigned*)(src[i] + (kt) * 64), (__attribute__((address_space(3))) unsigned*)(smem + (slot) * G_STAGE + (wave + 8 * i) * 1024), 16, 0, 0); } while (0)
  int offA[2], offB[2], xa[2], xb[2];
#pragma unroll
  for (int ft = 0; ft < 2; ++ft) { const int R = 256 + fw * 64 + ft * 32 + lr; offA[ft] = R * 128; xa[ft] = (R >> 1) & 7; }
#pragma unroll
  for (int tt = 0; tt < 2; ++tt) { const int R = tq * 64 + tt * 32 + lr; offB[tt] = R * 128; xb[tt] = (R >> 1) & 7; }
  GLDS_STAGE(0, 0); GLDS_STAGE(1, 1); WAIT_V(6); RAW_BARRIER();
  int cur = 0;
  for (int kt = 0; kt < nk; ++kt) {
    const int nxt = (cur >= 1) ? cur - 1 : 2;
    if (kt + 2 < nk) GLDS_STAGE(nxt, kt + 2);
    __builtin_amdgcn_sched_barrier(0);
    const char* st = smem + cur * G_STAGE;
#pragma unroll
    for (int ks = 0; ks < 4; ++ks) {
      bf16x8 a[2], b[2];
#pragma unroll
      for (int ft = 0; ft < 2; ++ft) a[ft] = *reinterpret_cast<const bf16x8*>(st + offA[ft] + (((ks * 2 + lh) ^ xa[ft]) << 4));
#pragma unroll
      for (int tt = 0; tt < 2; ++tt) b[tt] = *reinterpret_cast<const bf16x8*>(st + offB[tt] + (((ks * 2 + lh) ^ xb[tt]) << 4));
#pragma unroll
      for (int ft = 0; ft < 2; ++ft)
#pragma unroll
        for (int tt = 0; tt < 2; ++tt) acc[ft][tt] = MFMA(a[ft], b[tt], acc[ft][tt]);
    }
    if (kt + 2 < nk) { WAIT_V(6); } else { WAIT_V(0); }
    RAW_BARRIER();
    cur = (cur == 2) ? 0 : cur + 1;
  }
#undef GLDS_STAGE
}

DI void store_tm_rows(f32x16 (&acc)[2][2], char* smem, u16* tm, int tokbase, int col) {
  const int lane = threadIdx.x & 63, wave = threadIdx.x >> 6, lr = lane & 31, lh = lane >> 5;
  float* wl = (float*)(smem + wave * 17408);
#pragma unroll
  for (int tt = 0; tt < 2; ++tt)
#pragma unroll
    for (int ft = 0; ft < 2; ++ft)
#pragma unroll
      for (int g = 0; g < 4; ++g) {
        f32x4 v = {acc[ft][tt][4 * g], acc[ft][tt][4 * g + 1], acc[ft][tt][4 * g + 2], acc[ft][tt][4 * g + 3]};
        *reinterpret_cast<f32x4*>(wl + (tt * 32 + lr) * 68 + ft * 32 + 8 * g + 4 * lh) = v;
      }
  const int ch = lane & 15, r0 = lane >> 4;
#pragma unroll 4
  for (int k = 0; k < 16; ++k) {
    const int row = r0 + 4 * k;
    f32x4 v = *reinterpret_cast<const f32x4*>(wl + row * 68 + ch * 4);
    st4bf(tm + (size_t)(tokbase + row) * TMW + col + ch * 4, v[0], v[1], v[2], v[3]);
  }
}

DI void epi_inproj(const Params& p, int tok0, int f0, f32x16 (&acc)[2][2], char* smem) {
  const int tid = threadIdx.x, lane = tid & 63, wave = tid >> 6;
  const int fw = wave & 1, tq = wave >> 1, lr = lane & 31, lh = lane >> 5;
  const int fbase = f0 + fw * 64;
  if (fbase >= 3392) return;
  u16* tm = (u16*)(p.ws + OFF_TM);
  int tmcol = -1;
#pragma unroll
  for (int tt = 0; tt < 2; ++tt) {
    const int tok = tok0 + tq * 64 + tt * 32 + lr;
    const float posf = (float)p.positions[tok];
    const int bb = tok >> 12, ss = tok & 4095;
    if (fbase < 1024) {
#pragma unroll
      for (int r = 0; r < 4; ++r) {
        float j = (float)(4 * lh + r);
        float inv = exp2f(-j * (18.931568569324174f / 8.0f));
        float sn, cs; sincos_rad(posf * inv, sn, cs);
        float x1 = acc[0][tt][r], x2 = acc[0][tt][r + 4];
        acc[0][tt][r] = x1 * cs - x2 * sn;
        acc[0][tt][r + 4] = x2 * cs + x1 * sn;
      }
      if (fbase < 512) {
        tmcol = fbase;
      } else {
        u16* kfr = (u16*)(p.ws + OFF_KFR);
        const int head = (fbase - 512) >> 6, gt = ss >> 5;
#pragma unroll
        for (int ft = 0; ft < 2; ++ft)
#pragma unroll
          for (int g = 0; g < 4; ++g) {
            const int ks = ft * 2 + (g >> 1), lane2 = (g & 1) * 32 + lr;
            st4bf(kfr + ((((size_t)(bb * 8 + head) * 128 + gt) * 4 + ks) * 64 + lane2) * 8 + 4 * lh, acc[ft][tt][4 * g], acc[ft][tt][4 * g + 1], acc[ft][tt][4 * g + 2], acc[ft][tt][4 * g + 3]);
          }
      }
    } else if (fbase < 1536) {
      u16* vfr = (u16*)(p.ws + OFF_VT);
      const int head = (fbase - 1024) >> 6, gt = ss >> 5;
      const int s = lr >> 4, r16 = lr & 15, j = 4 * (r16 >> 3) + (r16 & 3), lh2 = (r16 >> 2) & 1;
#pragma unroll
      for (int ft = 0; ft < 2; ++ft)
#pragma unroll
        for (int i = 0; i < 16; ++i) {
          const int lane2 = lh2 * 32 + crow(i, lh);
          vfr[((((((size_t)(bb * 8 + head) * 128 + gt) * 2 + ft) * 2 + s) * 64 + lane2) * 8) + j] = f2bf(acc[ft][tt][i]);
        }
    } else if (fbase >= 2368 && fbase < 2880) {
      u16* vt = (u16*)(p.ws + OFF_GVT);
      const int fo = fbase - 2368;
#pragma unroll
      for (int ft = 0; ft < 2; ++ft)
#pragma unroll
        for (int i = 0; i < 16; ++i) {
          int feat = fo + ft * 32 + crow(i, lh);
          vt[((size_t)bb * 512 + feat) * 4096 + ss] = f2bf(acc[ft][tt][i]);
        }
    } else {
      if (fbase < 1856) {
#pragma unroll
        for (int ft = 0; ft < 2; ++ft) {
          const bool rot = (fbase < 1792) || (ft == 0);
#pragma unroll
          for (int r = 0; r < 4; ++r) {
            float v = acc[ft][tt][r];
            float o = __shfl_xor(v, 32);
            float inv = exp2f(-(float)r * (18.931568569324174f / 4.0f));
            float sn, cs; sincos_rad(posf * inv, sn, cs);
            float res = (lh == 0) ? (v * cs - o * sn) : (v * cs + o * sn);
            acc[ft][tt][r] = rot ? res : v;
          }
        }
        tmcol = fbase - 512;
        if (fbase == 1792) {
          u16* kif = (u16*)(p.ws + OFF_KIF);
          const int gt = ss >> 5;
#pragma unroll
          for (int g = 0; g < 4; ++g) {
            const int ks = g >> 1, lane2 = (g & 1) * 32 + lr;
            st4bf(kif + ((((size_t)bb * 128 + gt) * 2 + ks) * 64 + lane2) * 8 + 4 * lh, acc[0][tt][4 * g], acc[0][tt][4 * g + 1], acc[0][tt][4 * g + 2], acc[0][tt][4 * g + 3]);
          }
        }
      } else if (fbase < 2368) {
        tmcol = fbase - 512;
      } else {
        tmcol = fbase - 1024;
      }
    }
  }
  if (tmcol >= 0) store_tm_rows(acc, smem, tm, tok0 + tq * 64, tmcol);
}

DI void phase_inproj(const Params& p, char* smem) {
  const int n_in = 128 * 27;
  const int total = n_in + 128;
  const u16* xb = (const u16*)(p.ws + OFF_XB);
  const u16* memb = (const u16*)(p.ws + OFF_MEMB);
  const int tid = threadIdx.x, lane = tid & 63, wave = tid >> 6;
  const int fw = wave & 1, tq = wave >> 1, lr = lane & 31, lh = lane >> 5;
  const int xg = blockIdx.x & 7, xi = blockIdx.x >> 3, xn = gridDim.x >> 3;
  for (int u = xi; u < 16 * 27 + 16; u += xn) {
    f32x16 acc[2][2];
    const int t = (u < 16 * 27) ? (xg * 16 + (u / 27)) * 27 + (u % 27) : n_in + (u - 16 * 27) * 8 + xg;
    if (t < n_in) {
      int mt = t / 27, nt = t % 27;
      gemm_tile(xb + (size_t)mt * 256 * 1024, 1024, (const u16*)(p.ws + OFF_WIN) + (size_t)nt * 128 * 1024, 1024, 1024, smem, acc);
      epi_inproj(p, mt * 256, nt * 128, acc, smem);
      __syncthreads();
    } else {
      int u = t - n_in; int which = u >> 6; int r = u & 63; int mt = r >> 3, nt = r & 7;
      const u16* W = (const u16*)(p.ws + (which == 0 ? OFF_WK : OFF_WV));
      gemm_tile(memb + (size_t)mt * 256 * 1024, 1024, W + (size_t)nt * 128 * 1024, 1024, 1024, smem, acc);
#pragma unroll
      for (int tt = 0; tt < 2; ++tt) {
        const int tok = mt * 256 + tq * 64 + tt * 32 + lr;
        const int bb = tok >> 8, mm = tok & 255, hh = nt >> 1, kt = mm >> 5;
        if (which == 0) {
          u16* mk = (u16*)(p.ws + OFF_MEMK);
#pragma unroll
          for (int ft = 0; ft < 2; ++ft)
#pragma unroll
            for (int g = 0; g < 4; ++g) {
              const int ks = (nt & 1) * 8 + fw * 4 + ft * 2 + (g >> 1), lane2 = (g & 1) * 32 + lr;
              st4bf(mk + ((((size_t)(bb * 4 + hh) * 8 + kt) * 16 + ks) * 64 + lane2) * 8 + 4 * lh, acc[ft][tt][4 * g], acc[ft][tt][4 * g + 1], acc[ft][tt][4 * g + 2], acc[ft][tt][4 * g + 3]);
            }
        } else {
          u16* mv = (u16*)(p.ws + OFF_MEMVT);
          const int s = lr >> 4, r16 = lr & 15, j = 4 * (r16 >> 3) + (r16 & 3), lh2 = (r16 >> 2) & 1;
#pragma unroll
          for (int ft = 0; ft < 2; ++ft) {
            const int dt = (nt & 1) * 4 + fw * 2 + ft;
#pragma unroll
            for (int i = 0; i < 16; ++i) {
              const int lane2 = lh2 * 32 + crow(i, lh);
              mv[((((((size_t)(bb * 4 + hh) * 8 + dt) * 8 + kt) * 2 + s) * 64 + lane2) * 8) + j] = f2bf(acc[ft][tt][i]);
            }
          }
        }
      }
    }
  }
}

DI void idx_scores(const bf16x8 (&qf)[8][2], const float (&wq)[8], bf16x8 k0, bf16x8 k1, float (&sc)[16]) {
#pragma unroll
  for (int i = 0; i < 16; ++i) sc[i] = 0.f;
#pragma unroll
  for (int hd = 0; hd < 8; ++hd) {
    f32x16 a = zero16();
    a = MFMA(k0, qf[hd][0], a);
    a = MFMA(k1, qf[hd][1], a);
#pragma unroll
    for (int i = 0; i < 16; ++i) sc[i] = fmaf(wq[hd], fmaxf(a[i], 0.f), sc[i]);
  }
}

DI void load_idx_q(const u16* tm, int tok, int lh, bf16x8 (&qf)[8][2], float (&wq)[8]) {
  const u16* row = tm + (size_t)tok * TMW;
#pragma unroll
  for (int hd = 0; hd < 8; ++hd)
#pragma unroll
    for (int ks = 0; ks < 2; ++ks) qf[hd][ks] = ldg8(row + TM_QI + hd * 32 + ks * 16 + lh * 8);
  bf16x8 w8 = ldg8(row + TM_WI);
#pragma unroll
  for (int hd = 0; hd < 8; ++hd) wq[hd] = bf2f((u16)w8[hd]) * 0.0625f;
}

DI int wave_incl_scan(int v, int lane) {
#pragma unroll
  for (int d = 1; d < 64; d <<= 1) {
    int t = __shfl_up(v, d);
    if (lane >= d) v += t;
  }
  return v;
}

DI void dsa_thr_item(const Params& p, int b, int qblk, char* smem) {
  unsigned* hist = (unsigned*)smem;
  unsigned* pref = (unsigned*)(smem + 32768);
  int* rank = (int*)(smem + 32768 + 128);
  const u16* tm = (const u16*)(p.ws + OFF_TM);
  const int tid = threadIdx.x, lane = tid & 63, wave = tid >> 6, lr = lane & 31, lh = lane >> 5;
  const int q0 = qblk * 32;
  u16* qi = (u16*)(smem + 33280);
  for (int i = tid; i < 32 * 32; i += 512) {
    int q = i >> 5, ch = i & 31;
    *reinterpret_cast<u32x4*>(qi + q * 296 + ch * 8) = *reinterpret_cast<const u32x4*>(tm + (size_t)(b * S_ + q0 + q) * TMW + TM_QI + ch * 8);
  }
  float wq[8];
  {
    bf16x8 w8 = ldg8(tm + (size_t)(b * S_ + q0 + lr) * TMW + TM_WI);
#pragma unroll
    for (int hd = 0; hd < 8; ++hd) wq[hd] = bf2f((u16)w8[hd]) * 0.0625f;
  }
  __syncthreads();
  for (int i = tid; i < 32 * 32; i += 512) {
    const int q = i >> 5, d = i & 31;
    float acc = 0.f;
#pragma unroll
    for (int hd = 0; hd < 8; ++hd) acc = fmaf(bf2f(tm[(size_t)(b * S_ + q0 + q) * TMW + TM_WI + hd]) * 0.0625f, bf2f(qi[q * 296 + hd * 32 + d]), acc);
    qi[q * 296 + 256 + d] = f2bf(acc);
  }
  const u16* qil = qi + lr * 296 + lh * 8;
  if (tid < 32) { pref[tid] = 0u; rank[tid] = min(256, q0 + tid + 1); }
  for (int pass = 0; pass < 4; ++pass) {
    for (int i = tid; i < 8192; i += 512) hist[i] = 0u;
    __syncthreads();
    const int shift = 24 - 8 * pass;
    const unsigned mypref = pref[lr];
    const u16* kib = (const u16*)(p.ws + OFF_KIF) + (size_t)b * 128 * 1024 + lane * 8;
    bf16x8 kn0, kn1;
    {
      const int kt0 = min(wave, qblk);
      kn0 = ldg8(kib + (size_t)kt0 * 1024); kn1 = ldg8(kib + (size_t)kt0 * 1024 + 512);
    }
    for (int kt = wave; kt <= qblk; kt += 8) {
      const bf16x8 k0 = kn0, k1 = kn1;
      {
        const int ktn = min(kt + 8, qblk);
        kn0 = ldg8(kib + (size_t)ktn * 1024); kn1 = ldg8(kib + (size_t)ktn * 1024 + 512);
      }
      float sc[16];
      {
        f32x16 a = zero16();
        a = MFMA(k0, *reinterpret_cast<const bf16x8*>(qil + 256), a);
        a = MFMA(k1, *reinterpret_cast<const bf16x8*>(qil + 256 + 16), a);
#pragma unroll
        for (int i = 0; i < 16; ++i) sc[i] = a[i];
      }
#pragma unroll
      for (int hd = 0; hd < 8; ++hd) {
        f32x16 a = zero16();
        a = MFMA(k0, *reinterpret_cast<const bf16x8*>(qil + hd * 32), a);
        a = MFMA(k1, *reinterpret_cast<const bf16x8*>(qil + hd * 32 + 16), a);
        const float wh = wq[hd];
#pragma unroll
        for (int i = 0; i < 16; ++i) sc[i] = fmaf(fabsf(a[i]), wh, sc[i]);
      }
      if (kt == qblk) {
#pragma unroll
        for (int i = 0; i < 16; ++i) {
          int kp = kt * 32 + crow(i, lh);
          unsigned ky = fkey(sc[i]);
          unsigned hi = (ky >> shift);
          if (kp <= q0 + lr && (hi >> 8) == mypref) atomicAdd(&hist[(hi & 255u) * 32 + lr], 1u);
        }
      } else {
#pragma unroll
        for (int i = 0; i < 16; ++i) {
          unsigned ky = fkey(sc[i]);
          unsigned hi = (ky >> shift);
          if ((hi >> 8) == mypref) atomicAdd(&hist[(hi & 255u) * 32 + lr], 1u);
        }
      }
    }
    __syncthreads();
#pragma unroll 1
    for (int qq = 0; qq < 4; ++qq) {
      const int q = wave * 4 + qq;
      const int rk = rank[q];
      int c[4];
#pragma unroll
      for (int j = 0; j < 4; ++j) c[j] = (int)hist[(255 - 4 * lane - j) * 32 + q];
      int s = c[0] + c[1] + c[2] + c[3];
      int P = wave_incl_scan(s, lane);
      int excl = P - s;
      if (P >= rk && excl < rk) {
        int cum = excl; int bin = 0; int nr = 1; bool found = false;
#pragma unroll
        for (int j = 0; j < 4; ++j) {
          if (!found && cum + c[j] >= rk) { bin = 255 - 4 * lane - j; nr = rk - cum; found = true; }
          if (!found) cum += c[j];
        }
        pref[q] = (pref[q] << 8) | (unsigned)bin;
        rank[q] = nr;
      }
    }
    __syncthreads();
  }
  if (tid < 32) ((unsigned*)(p.ws + OFF_THR))[b * S_ + q0 + tid] = pref[tid];
  __syncthreads();
}

DI void dsa_attn_item(const Params& p, int b, int qblk, char* smem) {
  u16* maskbuf = (u16*)smem;
  u16* qi = (u16*)(smem + 4096);
  const u16* tm = (const u16*)(p.ws + OFF_TM);
  const u16* vfr = (const u16*)(p.ws + OFF_VT) + ((size_t)(b * 8 + (threadIdx.x >> 6)) * 128) * 2048 + (threadIdx.x & 63) * 8;
  const u16* kfr = (const u16*)(p.ws + OFF_KFR) + ((size_t)(b * 8 + (threadIdx.x >> 6)) * 128) * 2048 + (threadIdx.x & 63) * 8;
  const unsigned* thr = (const unsigned*)(p.ws + OFF_THR);
  const int tid = threadIdx.x, lane = tid & 63, wave = tid >> 6, lr = lane & 31, lh = lane >> 5;
  const int q0 = qblk * 32;
  const int head = wave;
  const int qtok = b * S_ + q0 + lr;
  bf16x8 Qf[4];
#pragma unroll
  for (int ks = 0; ks < 4; ++ks) {
    bf16x8 raw = ldg8(tm + (size_t)qtok * TMW + TM_Q + head * 64 + ks * 16 + lh * 8);
    float f[8];
#pragma unroll
    for (int j = 0; j < 8; ++j) f[j] = bf2f((u16)raw[j]) * (0.125f * 1.4426950408889634f);
    Qf[ks] = pack8(f[0], f[1], f[2], f[3], f[4], f[5], f[6], f[7]);
  }
  f32x16 O[2];
  O[0] = zero16(); O[1] = zero16();
  float mrun = -INFINITY, lrun = 0.f;
  const unsigned thrq = thr[qtok];
  const int nchunks = (q0 + 31) / 256 + 1;
  for (int i = tid; i < 32 * 32; i += 512) {
    int q = i >> 5, ch = i & 31;
    *reinterpret_cast<u32x4*>(qi + q * 296 + ch * 8) = *reinterpret_cast<const u32x4*>(tm + (size_t)(b * S_ + q0 + q) * TMW + TM_QI + ch * 8);
  }
  float* wqs = (float*)(smem + 4096 + 32 * 296 * 2);
  if (tid < 256) wqs[tid] = bf2f(tm[(size_t)(b * S_ + q0 + (tid & 31)) * TMW + TM_WI + (tid >> 5)]) * 0.0625f;
  __syncthreads();
  for (int i = tid; i < 32 * 32; i += 512) {
    const int q = i >> 5, d = i & 31;
    float acc = 0.f;
#pragma unroll
    for (int hd = 0; hd < 8; ++hd) acc = fmaf(bf2f(tm[(size_t)(b * S_ + q0 + q) * TMW + TM_WI + hd]) * 0.0625f, bf2f(qi[q * 296 + hd * 32 + d]), acc);
    qi[q * 296 + 256 + d] = f2bf(acc);
  }
  __syncthreads();
  const u16* qil = qi + lr * 296 + lh * 8;
  const u16* kibase = (const u16*)(p.ws + OFF_KIF) + (size_t)b * 128 * 1024 + lane * 8;
  bf16x8 Kf[4], Kn[4];
#pragma unroll
  for (int ks = 0; ks < 4; ++ks) Kf[ks] = ldg8(kfr + ks * 512);
  bf16x8 Vf[2][2], Vn[2][2];
#pragma unroll
  for (int dt = 0; dt < 2; ++dt)
#pragma unroll
    for (int s = 0; s < 2; ++s) Vf[dt][s] = ldg8(vfr + (dt * 2 + s) * 512);
  bf16x8 ki0, ki1;
  {
    const int kt0 = min(wave, qblk);
    ki0 = ldg8(kibase + (size_t)kt0 * 1024); ki1 = ldg8(kibase + (size_t)kt0 * 1024 + 512);
  }
  for (int c = 0; c < nchunks; ++c) {
    const int buf = c & 1;
    {
      const int key0 = (c * 8 + wave) * 32;
      unsigned bits = 0u;
      const bf16x8 k0 = ki0, k1 = ki1;
      {
        const int ktn = min((c + 1) * 8 + wave, qblk);
        ki0 = ldg8(kibase + (size_t)ktn * 1024); ki1 = ldg8(kibase + (size_t)ktn * 1024 + 512);
      }
      if (key0 <= q0 + 31) {
        float sc[16];
        {
          f32x16 a = zero16();
          a = MFMA(k0, *reinterpret_cast<const bf16x8*>(qil + 256), a);
          a = MFMA(k1, *reinterpret_cast<const bf16x8*>(qil + 256 + 16), a);
#pragma unroll
          for (int i = 0; i < 16; ++i) sc[i] = a[i];
        }
#pragma unroll 2
        for (int hd = 0; hd < 8; ++hd) {
          f32x16 a = zero16();
          a = MFMA(k0, *reinterpret_cast<const bf16x8*>(qil + hd * 32), a);
          a = MFMA(k1, *reinterpret_cast<const bf16x8*>(qil + hd * 32 + 16), a);
          const float wh = wqs[hd * 32 + lr];
#pragma unroll
          for (int i = 0; i < 16; ++i) sc[i] = fmaf(fabsf(a[i]), wh, sc[i]);
        }
        __builtin_amdgcn_sched_barrier(0);
#pragma unroll
        for (int i = 0; i < 16; ++i) {
          int kp = key0 + crow(i, lh);
          if (kp <= q0 + lr && fkey(sc[i]) >= thrq) bits |= (1u << i);
        }
      }
      maskbuf[(buf * 8 + wave) * 64 + lane] = (u16)bits;
    }
    __syncthreads();
#pragma unroll 1
    for (int t8 = 0; t8 < 8; ++t8) {
      const int g = c * 8 + t8;
      if (g > qblk) break;
      {
        const int gn = min(g + 1, qblk);
        const u16* kr = kfr + (size_t)gn * 2048;
#pragma unroll
        for (int ks = 0; ks < 4; ++ks) Kn[ks] = ldg8(kr + ks * 512);
#pragma unroll
        for (int dt = 0; dt < 2; ++dt)
#pragma unroll
          for (int s = 0; s < 2; ++s) Vn[dt][s] = ldg8(vfr + (size_t)gn * 2048 + (dt * 2 + s) * 512);
      }

      const unsigned bits = maskbuf[(buf * 8 + t8) * 64 + lane];
      f32x16 Sx = zero16();
#pragma unroll
      for (int ks = 0; ks < 4; ++ks) Sx = MFMA(Kf[ks], Qf[ks], Sx);
      float sm[16];
#pragma unroll
      for (int i = 0; i < 16; ++i) {
        const unsigned t = (unsigned)__builtin_amdgcn_sbfe((int)bits, i, 1);
        sm[i] = __uint_as_float((t & __float_as_uint(Sx[i])) | (~t & 0xff800000u));
      }
      float mt = fmaxf(fmaxf(fmaxf(sm[0], sm[1]), fmaxf(sm[2], sm[3])), fmaxf(fmaxf(sm[4], sm[5]), fmaxf(sm[6], sm[7])));
      mt = fmaxf(mt, fmaxf(fmaxf(fmaxf(sm[8], sm[9]), fmaxf(sm[10], sm[11])), fmaxf(fmaxf(sm[12], sm[13]), fmaxf(sm[14], sm[15]))));
      mt = fmaxf(mt, __shfl_xor(mt, 32));
      const float mnew = fmaxf(mrun, mt);
      const float msafe = (mnew == -INFINITY) ? 0.f : mnew;
      const float alpha = __builtin_amdgcn_exp2f(mrun - msafe);
      float pv[16]; float ps = 0.f;
#pragma unroll
      for (int i = 0; i < 16; ++i) { pv[i] = __builtin_amdgcn_exp2f(sm[i] - msafe); ps += pv[i]; }
      lrun = lrun * alpha + ps;
      mrun = mnew;
      if (__builtin_amdgcn_ballot_w64(alpha != 1.f) != 0ull) {
#pragma unroll
        for (int dt = 0; dt < 2; ++dt)
#pragma unroll
          for (int i = 0; i < 16; ++i) O[dt][i] *= alpha;
      }
      bf16x8 Pf[2];
#pragma unroll
      for (int s = 0; s < 2; ++s) Pf[s] = pack8(pv[8 * s], pv[8 * s + 1], pv[8 * s + 2], pv[8 * s + 3], pv[8 * s + 4], pv[8 * s + 5], pv[8 * s + 6], pv[8 * s + 7]);
#pragma unroll
      for (int dt = 0; dt < 2; ++dt)
#pragma unroll
        for (int s = 0; s < 2; ++s) O[dt] = MFMA(Vf[dt][s], Pf[s], O[dt]);
#pragma unroll
      for (int ks = 0; ks < 4; ++ks) Kf[ks] = Kn[ks];
#pragma unroll
      for (int dt = 0; dt < 2; ++dt)
#pragma unroll
        for (int s = 0; s < 2; ++s) Vf[dt][s] = Vn[dt][s];
    }
  }
  u16* y = (u16*)(p.ws + OFF_XB);
  {
    float lt = lrun + __shfl_xor(lrun, 32);
    float inv = 1.f / lt;
#pragma unroll
    for (int dt = 0; dt < 2; ++dt)
#pragma unroll
      for (int g = 0; g < 4; ++g)
        st4bf(y + (size_t)qtok * 1024 + head * 64 + dt * 32 + 8 * g + 4 * lh, O[dt][4 * g] * inv, O[dt][4 * g + 1] * inv, O[dt][4 * g + 2] * inv, O[dt][4 * g + 3] * inv);
  }
  __syncthreads();
}

DI void gla_bcum(const Params& p, int b, int h, int n, float* bc, float* glr_s, float* segtot) {
  const u16* tm = (const u16*)(p.ws + OFF_TM);
  const int tid = threadIdx.x;
  const int tok0 = b * S_ + n * 64;
  for (int i = tid; i < 1024; i += 512) glr_s[i] = bf2f(tm[(size_t)(tok0 + (i >> 4)) * TMW + TM_GLR + (i & 15)]);
  const int d = tid & 63, cgp = tid >> 6;
  float gu[16];
#pragma unroll
  for (int j = 0; j < 16; ++j) gu[j] = p.gate_up[j * 256 + h * 64 + d];
  const float bias = p.gate_bias[h * 64 + d];
  __syncthreads();
  float v[8]; float run = 0.f;
#pragma unroll
  for (int r = 0; r < 8; ++r) {
    const int c = cgp * 8 + r;
    float z = bias;
#pragma unroll
    for (int j4 = 0; j4 < 4; ++j4) {
      const f32x4 gv = *reinterpret_cast<const f32x4*>(glr_s + c * 16 + j4 * 4);
#pragma unroll
      for (int j = 0; j < 4; ++j) z = fmaf(gv[j], gu[j4 * 4 + j], z);
    }
    float la = (fminf(z, 0.f) - __logf(1.f + __expf(-fabsf(z)))) * 0.0625f;
    run += la; v[r] = run;
  }
  segtot[cgp * 64 + d] = run;
  __syncthreads();
  float off = 0.f;
#pragma unroll
  for (int g = 0; g < 8; ++g) off += (g < cgp) ? segtot[g * 64 + d] : 0.f;
#pragma unroll
  for (int r = 0; r < 8; ++r) bc[(cgp * 8 + r) * 64 + d] = off + v[r];
  __syncthreads();
}

DI void gla_g1_item(const Params& p, int item, char* smem) {
  float* bc = (float*)smem;
  float* glr_s = (float*)(smem + 16384);
  float* segtot = (float*)(smem + 20480);
  u16* KeT = (u16*)(smem + 22528);
  const int b = item >> 8, h = (item >> 6) & 3, n = item & 63;
  const u16* tm = (const u16*)(p.ws + OFF_TM);
  const u16* gvT = (const u16*)(p.ws + OFF_GVT);
  const int tid = threadIdx.x, lane = tid & 63, wave = tid >> 6, lr = lane & 31, lh = lane >> 5;
  const int tok0 = b * S_ + n * 64;
  u16 kraw[8];
  {
    const int d = tid & 63, cgp = tid >> 6;
#pragma unroll
    for (int r = 0; r < 8; ++r) kraw[r] = tm[(size_t)(tok0 + cgp * 8 + r) * TMW + TM_GK + h * 64 + d];
  }
  bf16x8 afr[4];
  {
    const int et = wave & 3;
    const u16* arow = gvT + ((size_t)b * 512 + h * 128 + et * 32 + lr) * 4096 + n * 64 + lh * 8;
#pragma unroll
    for (int ks = 0; ks < 4; ++ks) afr[ks] = ldg8(arow + ks * 16);
  }
  gla_bcum(p, b, h, n, bc, glr_s, segtot);
  {
    const int d = tid & 63, cgp = tid >> 6;
    const float blast = bc[63 * 64 + d];
    {
      float* bcg = (float*)(p.ws + OFF_BCG) + (size_t)item * 4096;
#pragma unroll
      for (int r = 0; r < 8; ++r) bcg[(cgp * 8 + r) * 64 + d] = bc[(cgp * 8 + r) * 64 + d];
    }
    float f[8];
#pragma unroll
    for (int r = 0; r < 8; ++r) {
      const int c = cgp * 8 + r;
      float kv = bf2f(kraw[r]);
      f[r] = kv * __expf(blast - bc[c * 64 + d]);
    }
    *reinterpret_cast<bf16x8*>(KeT + d * 72 + cgp * 8) = pack8(f[0], f[1], f[2], f[3], f[4], f[5], f[6], f[7]);
    if (cgp == 0) ((float*)(p.ws + OFF_DECAY))[item * 64 + d] = __expf(blast);
  }
  __syncthreads();
  {
    const int et = wave & 3, dtl = wave >> 2;
    f32x16 acc = zero16();
#pragma unroll
    for (int ks = 0; ks < 4; ++ks) {
      bf16x8 a = afr[ks];
      bf16x8 bb = *reinterpret_cast<const bf16x8*>(KeT + (dtl * 32 + lr) * 72 + ks * 16 + lh * 8);
      acc = MFMA(a, bb, acc);
    }
    float* kvT = (float*)(p.ws + OFF_KVT);
#pragma unroll
    for (int i = 0; i < 16; ++i) kvT[((size_t)item * 128 + et * 32 + crow(i, lh)) * 64 + dtl * 32 + lr] = acc[i];
  }
  __syncthreads();
}

DI void gla_scan(const Params& p) {
  const float* kvT = (const float*)(p.ws + OFF_KVT);
  const float* decay = (const float*)(p.ws + OFF_DECAY);
  u16* prev = (u16*)(p.ws + OFF_PREV);
  const int gtid = blockIdx.x * blockDim.x + threadIdx.x;
  const int gn = gridDim.x * blockDim.x;
  for (int u = gtid; u < 32 * 2048; u += gn) {
    const int bh = u >> 11, rem = u & 2047, e = rem >> 4, d4 = (rem & 15) * 4;
    f32x4 st = {0.f, 0.f, 0.f, 0.f};
#pragma unroll 4
    for (int n = 0; n < 64; ++n) {
      const int item = bh * 64 + n;
      st4bf(prev + ((size_t)item * 128 + e) * 64 + d4, st[0], st[1], st[2], st[3]);
      f32x4 dc = *reinterpret_cast<const f32x4*>(decay + item * 64 + d4);
      f32x4 kv = *reinterpret_cast<const f32x4*>(kvT + ((size_t)item * 128 + e) * 64 + d4);
      st = dc * st + kv;
    }
  }
}

DI void gla_g3_item(const Params& p, int item, char* smem) {
  float* red = (float*)smem;
  const int b = item >> 8, h = (item >> 6) & 3, n = item & 63;
  const u16* tm = (const u16*)(p.ws + OFF_TM);
  const u16* gvT = (const u16*)(p.ws + OFF_GVT);
  const u16* prev = (const u16*)(p.ws + OFF_PREV);
  const float* bcg = (const float*)(p.ws + OFF_BCG) + (size_t)item * 4096;
  const int tid = threadIdx.x, lane = tid & 63, wave = tid >> 6, lr = lane & 31, lh = lane >> 5;
  const int tok0 = b * S_ + n * 64;
  const int et = wave & 3, ct = wave >> 2;
  bf16x8 qraw[4], kraw[2][4], sfr[4];
  bf16x4 vlo[2][2], vhi[2][2];
  f32x4 bq[4][2];
  {
    const u16* vrow0 = gvT + ((size_t)b * 512 + h * 128 + et * 32 + lr) * 4096 + n * 64 + 4 * lh;
    const u16* srow0 = prev + ((size_t)item * 128 + et * 32 + lr) * 64 + lh * 8;
#pragma unroll
    for (int ks = 0; ks < 4; ++ks) {
      qraw[ks] = ldg8(tm + (size_t)(tok0 + ct * 32 + lr) * TMW + TM_GQ + h * 64 + ks * 16 + lh * 8);
      kraw[0][ks] = ldg8(tm + (size_t)(tok0 + lr) * TMW + TM_GK + h * 64 + ks * 16 + lh * 8);
      kraw[1][ks] = ldg8(tm + (size_t)(tok0 + ct * 32 + lr) * TMW + TM_GK + h * 64 + ks * 16 + lh * 8);
      sfr[ks] = ldg8(srow0 + ks * 16);
      bq[ks][0] = *reinterpret_cast<const f32x4*>(bcg + (ct * 32 + lr) * 64 + ks * 16 + lh * 8);
      bq[ks][1] = *reinterpret_cast<const f32x4*>(bcg + (ct * 32 + lr) * 64 + ks * 16 + lh * 8 + 4);
    }
#pragma unroll
    for (int st = 0; st < 2; ++st)
#pragma unroll
      for (int s2 = 0; s2 < 2; ++s2) {
        const u16* vp = vrow0 + (st * ct) * 32 + 16 * s2;
        vlo[st][s2] = *reinterpret_cast<const bf16x4*>(vp);
        vhi[st][s2] = *reinterpret_cast<const bf16x4*>(vp + 8);
      }
  }
  bf16x8 Qd[4];
#pragma unroll
  for (int ks = 0; ks < 4; ++ks) {
    float f[8];
#pragma unroll
    for (int j = 0; j < 8; ++j) f[j] = bf2f((u16)qraw[ks][j]) * 0.125f * __expf(bq[ks][j >> 2][j & 3]);
    Qd[ks] = pack8(f[0], f[1], f[2], f[3], f[4], f[5], f[6], f[7]);
  }
  f32x16 O = zero16();
#pragma unroll
  for (int st = 0; st < 2; ++st) {
    if (st <= ct) {
      f32x16 A = zero16();
      const int s = st * 32 + lr;
#pragma unroll
      for (int ks = 0; ks < 4; ++ks) {
        f32x4 b0 = (st == 1) ? bq[ks][0] : *reinterpret_cast<const f32x4*>(bcg + s * 64 + ks * 16 + lh * 8);
        f32x4 b1 = (st == 1) ? bq[ks][1] : *reinterpret_cast<const f32x4*>(bcg + s * 64 + ks * 16 + lh * 8 + 4);
        float f[8];
#pragma unroll
        for (int j = 0; j < 8; ++j) f[j] = bf2f((u16)kraw[st][ks][j]) * __expf(-((j < 4) ? b0[j & 3] : b1[j & 3]));
        bf16x8 Ki = pack8(f[0], f[1], f[2], f[3], f[4], f[5], f[6], f[7]);
        A = MFMA(Ki, Qd[ks], A);
      }
      float pv[16];
#pragma unroll
      for (int i = 0; i < 16; ++i) pv[i] = (st * 32 + crow(i, lh) <= ct * 32 + lr) ? A[i] : 0.f;
#pragma unroll
      for (int s2 = 0; s2 < 2; ++s2) {
        bf16x8 Pf = pack8(pv[8 * s2], pv[8 * s2 + 1], pv[8 * s2 + 2], pv[8 * s2 + 3], pv[8 * s2 + 4], pv[8 * s2 + 5], pv[8 * s2 + 6], pv[8 * s2 + 7]);
        O = MFMA(cat44(vlo[st][s2], vhi[st][s2]), Pf, O);
      }
    }
  }
#pragma unroll
  for (int ks = 0; ks < 4; ++ks) O = MFMA(sfr[ks], Qd[ks], O);
  float ss = 0.f;
#pragma unroll
  for (int i = 0; i < 16; ++i) ss += O[i] * O[i];
  ss += __shfl_xor(ss, 32);
  if (lh == 0) red[(ct * 4 + et) * 32 + lr] = ss;
  __syncthreads();
  const float tot = red[(ct * 4 + 0) * 32 + lr] + red[(ct * 4 + 1) * 32 + lr] + red[(ct * 4 + 2) * 32 + lr] + red[(ct * 4 + 3) * 32 + lr];
  const float rinv = rsqrtf(tot * (1.f / 128.f) + 1e-6f);
  const int tok = tok0 + ct * 32 + lr;
  u16* y = (u16*)(p.ws + OFF_XB);
#pragma unroll
  for (int g = 0; g < 4; ++g) {
    const int e0 = et * 32 + 8 * g + 4 * lh;
    u32x2 gr = *reinterpret_cast<const u32x2*>(tm + (size_t)tok * TMW + TM_GR + h * 128 + e0);
    f32x4 ng = *reinterpret_cast<const f32x4*>(p.norm_g + e0);
    float grv[4] = {bflo(gr[0]), bfhi(gr[0]), bflo(gr[1]), bfhi(gr[1])};
    float o[4];
#pragma unroll
    for (int r = 0; r < 4; ++r) {
      float sl = grv[r] / (1.f + __expf(-grv[r]));
      o[r] = O[4 * g + r] * rinv * ng[r] * sl;
    }
    st4bf(y + (size_t)tok * 1024 + 512 + h * 128 + e0, o[0], o[1], o[2], o[3]);
  }
  __syncthreads();
}

template <int MODE>
DI void phase_gemm(const Params& p, const u16* X, const u16* Wt, int N, const float* resid, float* outf, u16* outb, int ldo, char* smem) {
  const int ntn = N / 128;
  const int tid = threadIdx.x, lane = tid & 63, wave = tid >> 6;
  const int fw = wave & 1, tq = wave >> 1, lr = lane & 31, lh = lane >> 5;
  const int xg = blockIdx.x & 7, xi = blockIdx.x >> 3, xn = gridDim.x >> 3;
  const int per_group = 16 * ntn;
  for (int u = xi; u < per_group; u += xn) {
    const int mt = xg + 8 * (u / ntn), nt = u % ntn;
    f32x16 acc[2][2];
    gemm_tile(X + (size_t)mt * 256 * 1024, 1024, Wt + (size_t)nt * 128 * 1024, 1024, 1024, smem, acc);
    if (MODE == 0 || MODE == 1) {
      float* wl = (float*)(smem + wave * 17408);
#pragma unroll
      for (int tt = 0; tt < 2; ++tt)
#pragma unroll
        for (int ft = 0; ft < 2; ++ft)
#pragma unroll
          for (int g = 0; g < 4; ++g) {
            f32x4 v = {acc[ft][tt][4 * g], acc[ft][tt][4 * g + 1], acc[ft][tt][4 * g + 2], acc[ft][tt][4 * g + 3]};
            *reinterpret_cast<f32x4*>(wl + (tt * 32 + lr) * 68 + ft * 32 + 8 * g + 4 * lh) = v;
          }
      const int ch = lane & 15, r0 = lane >> 4;
      const int f = nt * 128 + fw * 64 + ch * 4;
#pragma unroll 4
      for (int k = 0; k < 16; ++k) {
        const int row = r0 + 4 * k;
        const int tok = mt * 256 + tq * 64 + row;
        f32x4 v = *reinterpret_cast<const f32x4*>(wl + row * 68 + ch * 4);
        if (MODE == 0) {
          f32x4 r = *reinterpret_cast<const f32x4*>(resid + (size_t)tok * 1024 + f);
          f32x4 o;
#pragma unroll
          for (int j = 0; j < 4; ++j) o[j] = ALPHA * r[j] + v[j];
          *reinterpret_cast<f32x4*>(outf + (size_t)tok * 1024 + f) = o;
        } else {
          st4bf(outb + (size_t)tok * ldo + f, v[0], v[1], v[2], v[3]);
        }
      }
      __syncthreads();
    } else {
#pragma unroll
      for (int tt = 0; tt < 2; ++tt) {
        const int tok = mt * 256 + tq * 64 + tt * 32 + lr;
#pragma unroll
        for (int ft = 0; ft < 2; ++ft)
#pragma unroll
          for (int g = 0; g < 4; ++g) {
            const int f = nt * 128 + fw * 64 + ft * 32 + 8 * g + 4 * lh;
            if (MODE == 2) {
              const int hh = f >> 8, fh = f & 255, ks = fh >> 4, lane2 = ((fh >> 3) & 1) * 32 + lr;
              st4bf(outb + ((((size_t)(tok >> 5) * 4 + hh) * 16 + ks) * 64 + lane2) * 8 + 4 * lh, acc[ft][tt][4 * g], acc[ft][tt][4 * g + 1], acc[ft][tt][4 * g + 2], acc[ft][tt][4 * g + 3]);
            } else {
              const int hh = f >> 8, fq = f & 127, half = (f >> 7) & 1, ks = fq >> 4, lane2 = ((fq >> 3) & 1) * 32 + lr;
              st4bf(outb + (((((size_t)(tok >> 5) * 8 + hh) * 2 + half) * 8 + ks) * 64 + lane2) * 8 + 4 * lh, acc[ft][tt][4 * g], acc[ft][tt][4 * g + 1], acc[ft][tt][4 * g + 2], acc[ft][tt][4 * g + 3]);
            }
          }
      }
    }
  }
}

DI void phase_ln(const Params& p, float* h, u16* hb, const float* g, const float* bta) {
  const int lane = threadIdx.x & 63;
  const int xg = blockIdx.x & 7, xw = (blockIdx.x >> 3) * 8 + (threadIdx.x >> 6), xnw = (gridDim.x >> 3) * 8;
  for (int lrw = xw; lrw < 4096; lrw += xnw) {
    const int row = (xg + 8 * (lrw >> 8)) * 256 + (lrw & 255);
    float* r = h + (size_t)row * 1024;
    f32x4 v[4]; float s = 0.f;
#pragma unroll
    for (int c = 0; c < 4; ++c) { v[c] = *reinterpret_cast<const f32x4*>(r + c * 256 + lane * 4); s += v[c][0] + v[c][1] + v[c][2] + v[c][3]; }
    const float mean = wave_sum(s) * (1.f / 1024.f);
    float q = 0.f;
#pragma unroll
    for (int c = 0; c < 4; ++c)
#pragma unroll
      for (int k = 0; k < 4; ++k) { float d = v[c][k] - mean; q += d * d; }
    const float rstd = rsqrtf(wave_sum(q) * (1.f / 1024.f) + 1e-5f);
#pragma unroll
    for (int c = 0; c < 4; ++c) {
      f32x4 gg = *reinterpret_cast<const f32x4*>(g + c * 256 + lane * 4);
      f32x4 bb = *reinterpret_cast<const f32x4*>(bta + c * 256 + lane * 4);
      f32x4 o;
#pragma unroll
      for (int k = 0; k < 4; ++k) o[k] = (v[c][k] - mean) * rstd * gg[k] + bb[k];
      *reinterpret_cast<f32x4*>(r + c * 256 + lane * 4) = o;
      st4bf(hb + (size_t)row * 1024 + c * 256 + lane * 4, o[0], o[1], o[2], o[3]);
    }
  }
}

DI void phase_xattn(const Params& p) {
  const u16* qx = (const u16*)(p.ws + OFF_QX);
  const u16* mk = (const u16*)(p.ws + OFF_MEMK);
  const u16* mv = (const u16*)(p.ws + OFF_MEMVT);
  u16* ox = (u16*)(p.ws + OFF_OX);
  const int lane = threadIdx.x & 63, lr = lane & 31, lh = lane >> 5;
  const int xg = blockIdx.x & 7, xw = (blockIdx.x >> 3) * 8 + (threadIdx.x >> 6), xnw = (gridDim.x >> 3) * 8;
  for (int li = xw; li < 512; li += xnw) {
    const int qtl = li & 15, h = (li >> 4) & 3, b = li >> 6;
    const int qt = (xg + 8 * (qtl >> 3)) * 8 + (qtl & 7);
    const int tok = b * S_ + qt * 32 + lr;
    f32x16 Sx[8];
#pragma unroll
    for (int kt = 0; kt < 8; ++kt) Sx[kt] = zero16();
    const u16* qrow = qx + (((size_t)(b * 128 + qt) * 4 + h) * 16) * 512 + lane * 8;
    const u16* krow = mk + (((size_t)(b * 4 + h) * 8) * 16) * 512 + lane * 8;
#pragma unroll 2
    for (int ks = 0; ks < 16; ++ks) {
      bf16x8 qf = ldg8(qrow + ks * 512);
#pragma unroll
      for (int kt = 0; kt < 8; ++kt) Sx[kt] = MFMA(ldg8(krow + (kt * 16 + ks) * 512), qf, Sx[kt]);
    }
    float mx = -INFINITY;
#pragma unroll
    for (int kt = 0; kt < 8; ++kt)
#pragma unroll
      for (int i = 0; i < 16; ++i) mx = fmaxf(mx, Sx[kt][i]);
    mx = fmaxf(mx, __shfl_xor(mx, 32));
    float ls = 0.f;
    bf16x8 Pf[8][2];
#pragma unroll
    for (int kt = 0; kt < 8; ++kt) {
      float pv[16];
#pragma unroll
      for (int i = 0; i < 16; ++i) { pv[i] = __expf((Sx[kt][i] - mx) * 0.0625f); ls += pv[i]; }
#pragma unroll
      for (int s = 0; s < 2; ++s) Pf[kt][s] = pack8(pv[8 * s], pv[8 * s + 1], pv[8 * s + 2], pv[8 * s + 3], pv[8 * s + 4], pv[8 * s + 5], pv[8 * s + 6], pv[8 * s + 7]);
    }
    ls += __shfl_xor(ls, 32);
    const float inv = 1.f / ls;
#pragma unroll 1
    for (int dt = 0; dt < 8; ++dt) {
      f32x16 o = zero16();
      const u16* vrow = mv + ((((size_t)(b * 4 + h) * 8 + dt) * 8) * 2) * 512 + lane * 8;
#pragma unroll
      for (int kt = 0; kt < 8; ++kt)
#pragma unroll
        for (int s = 0; s < 2; ++s) o = MFMA(ldg8(vrow + (kt * 2 + s) * 512), Pf[kt][s], o);
#pragma unroll
      for (int g = 0; g < 4; ++g)
        st4bf(ox + (size_t)tok * 1024 + h * 256 + dt * 32 + 8 * g + 4 * lh, o[4 * g] * inv, o[4 * g + 1] * inv, o[4 * g + 2] * inv, o[4 * g + 3] * inv);
    }
  }
}

DI void peer_topk_item(const Params& p, int tt128, int head, char* smem) {
  float* sc = (float*)smem;
  float* topv = (float*)(smem + 132096);
  unsigned char* topi = (unsigned char*)(smem + 132096 + 16384);
  const u16* pq = (const u16*)(p.ws + OFF_QX);
  const u16* sk = (const u16*)(p.ws + OFF_SK);
  const int tid = threadIdx.x, lane = tid & 63, wave = tid >> 6, lr = lane & 31, lh = lane >> 5;
  const int tok0 = tt128 * 128;
  {
    const int half = wave >> 2, kt = wave & 3;
    bf16x8 af[8];
#pragma unroll
    for (int ks = 0; ks < 8; ++ks) af[ks] = ldg8(sk + (size_t)half * 16384 + (kt * 32 + lr) * 128 + ks * 16 + lh * 8);
#pragma unroll 1
    for (int tt = 0; tt < 4; ++tt) {
      f32x16 acc = zero16();
      const u16* brow = pq + (((((size_t)(tok0 >> 5) + tt) * 8 + head) * 2 + half) * 8) * 512 + lane * 8;
#pragma unroll
      for (int ks = 0; ks < 8; ++ks) acc = MFMA(af[ks], ldg8(brow + ks * 512), acc);
#pragma unroll
      for (int i = 0; i < 16; ++i) sc[(half * 128 + tt * 32 + lr) * 129 + kt * 32 + crow(i, lh)] = acc[i];
    }
  }
  __syncthreads();
  if (tid < 256) {
    float* row = sc + tid * 129;
    float gm[8]; int gi[8];
#pragma unroll
    for (int g = 0; g < 8; ++g) {
      float m = -INFINITY; int mi = g * 16;
#pragma unroll
      for (int j = 0; j < 16; ++j) { float v = row[g * 16 + j]; if (v > m) { m = v; mi = g * 16 + j; } }
      gm[g] = m; gi[g] = mi;
    }
#pragma unroll 1
    for (int r = 0; r < 16; ++r) {
      float best = gm[0]; int bg = 0; int bi = gi[0];
#pragma unroll
      for (int g = 1; g < 8; ++g) if (gm[g] > best) { best = gm[g]; bg = g; bi = gi[g]; }
      topv[tid * 16 + r] = best; topi[tid * 16 + r] = (unsigned char)bi;
      row[bi] = -INFINITY;
      float m = -INFINITY; int mi = bg * 16;
#pragma unroll
      for (int j = 0; j < 16; ++j) { float v = row[bg * 16 + j]; if (v > m) { m = v; mi = bg * 16 + j; } }
#pragma unroll
      for (int g = 0; g < 8; ++g) { gm[g] = (g == bg) ? m : gm[g]; gi[g] = (g == bg) ? mi : gi[g]; }
    }
  }
  __syncthreads();
  if (tid < 128) {
    const float* av = topv + tid * 16;
    const float* bv = topv + (128 + tid) * 16;
    const unsigned char* ai = topi + tid * 16;
    const unsigned char* bi_ = topi + (128 + tid) * 16;
    float cur[16]; int pp[16];
    const float b0 = bv[0];
#pragma unroll
    for (int i = 0; i < 16; ++i) { cur[i] = av[i] + b0; pp[i] = 0; }
    float sel[16]; int eid[16];
#pragma unroll
    for (int r = 0; r < 16; ++r) {
      float best = cur[0]; int bi = 0; int bj = pp[0];
#pragma unroll
      for (int i = 1; i < 16; ++i) if (cur[i] > best) { best = cur[i]; bi = i; bj = pp[i]; }
      sel[r] = best;
      eid[r] = (int)ai[bi] * 128 + (int)bi_[bj];
      const int nj = bj + 1;
      const float nv = (nj < 16) ? (av[bi] + bv[nj & 15]) : -INFINITY;
#pragma unroll
      for (int i = 0; i < 16; ++i) { cur[i] = (i == bi) ? nv : cur[i]; pp[i] = (i == bi) ? nj : pp[i]; }
    }
    float sum = 0.f;
    const float smax = sel[0];
#pragma unroll
    for (int r = 0; r < 16; ++r) { sel[r] = __expf(sel[r] - smax); sum += sel[r]; }
    const float inv = 1.f / sum;
    int* eo = (int*)(p.ws + OFF_EIDX) + (size_t)(tok0 + tid) * 128 + head * 16;
    float* go = (float*)(p.ws + OFF_GATE) + (size_t)(tok0 + tid) * 128 + head * 16;
#pragma unroll
    for (int r = 0; r < 16; ++r) { eo[r] = eid[r]; go[r] = sel[r] * inv; }
  }
  __syncthreads();
}

DI float dot2bf(unsigned a, unsigned b, float c) {
  return __builtin_amdgcn_fdot2_f32_bf16(__builtin_bit_cast(bf2_t, a), __builtin_bit_cast(bf2_t, b), c, false);
}

DI float reduce8(float (&part)[8], int lane) {
  float r4[4], r2[2], r1;
#pragma unroll
  for (int k = 0; k < 4; ++k) {
    float send = (lane & 1) ? part[2 * k] : part[2 * k + 1];
    float keep = (lane & 1) ? part[2 * k + 1] : part[2 * k];
    r4[k] = keep + __shfl_xor(send, 1);
  }
#pragma unroll
  for (int k = 0; k < 2; ++k) {
    float send = (lane & 2) ? r4[2 * k] : r4[2 * k + 1];
    float keep = (lane & 2) ? r4[2 * k + 1] : r4[2 * k];
    r2[k] = keep + __shfl_xor(send, 2);
  }
  {
    float send = (lane & 4) ? r2[0] : r2[1];
    float keep = (lane & 4) ? r2[1] : r2[0];
    r1 = keep + __shfl_xor(send, 4);
  }
  r1 += __shfl_xor(r1, 8);
  r1 += __shfl_xor(r1, 16);
  r1 += __shfl_xor(r1, 32);
  return r1;
}

DI void phase_peer_down(const Params& p) {
  const char* exd = p.ws + OFF_EXD;
  const float* esc = (const float*)(p.ws + OFF_ESC);
  const u16* hb = (const u16*)(p.ws + OFF_HB);
  const int* eidx = (const int*)(p.ws + OFF_EIDX);
  const float* gate = (const float*)(p.ws + OFF_GATE);
  float* coefw = (float*)(p.ws + OFF_COEF);
  const int lane = threadIdx.x & 63;
  const int gw = (blockIdx.x * blockDim.x + threadIdx.x) >> 6;
  const int nw = (gridDim.x * blockDim.x) >> 6;
#pragma unroll 1
  for (int tok = gw; tok < T_; tok += nw) {
    float x[16];
    {
      const u16* xr = hb + (size_t)tok * 1024 + lane * 16;
      u32x4 a = *reinterpret_cast<const u32x4*>(xr);
      u32x4 c = *reinterpret_cast<const u32x4*>(xr + 8);
#pragma unroll
      for (int w = 0; w < 4; ++w) { x[2 * w] = bflo(a[w]); x[2 * w + 1] = bfhi(a[w]); x[8 + 2 * w] = bflo(c[w]); x[8 + 2 * w + 1] = bfhi(c[w]); }
    }
#pragma unroll 1
    for (int half = 0; half < 2; ++half) {
      const size_t slot = (size_t)tok * 128 + half * 64 + lane;
      const int ev = eidx[slot];
      const float gv = gate[slot];
      float racc = 0.f, gacc = 0.f;
#pragma unroll 1
      for (int bi = 0; bi < 8; ++bi) {
        u32x4 dr[8];
#pragma unroll
        for (int k = 0; k < 8; ++k) {
          const int er = __builtin_amdgcn_readlane(ev, bi * 8 + k);
          dr[k] = *reinterpret_cast<const u32x4*>(exd + (size_t)er * 1024 + lane * 16);
        }
        const int pmine = bi * 8 + (lane & 7);
        const int emine = __shfl(ev, pmine);
        const float gsel = __shfl(gv, pmine);
        const float sd = esc[emine];
        const float su = esc[16384 + emine];
        float part[8];
#pragma unroll
        for (int k = 0; k < 8; ++k) {
          float a0 = 0.f, a1 = 0.f;
#pragma unroll
          for (int w = 0; w < 4; ++w) {
            f2_t lo = __builtin_amdgcn_cvt_pk_f32_fp8((int)dr[k][w], false);
            f2_t hi = __builtin_amdgcn_cvt_pk_f32_fp8((int)dr[k][w], true);
            a0 = fmaf(lo[0], x[4 * w], a0); a1 = fmaf(lo[1], x[4 * w + 1], a1);
            a0 = fmaf(hi[0], x[4 * w + 2], a0); a1 = fmaf(hi[1], x[4 * w + 3], a1);
          }
          part[k] = a0 + a1;
        }
        const float r1 = reduce8(part, lane) * sd;
        const bool mine = (lane >> 3) == bi;
        racc = mine ? r1 : racc; gacc = mine ? gsel * su : gacc;
      }
      const float act = 0.5f * racc * (1.f + erff(racc * 0.70710678118654752f));
      coefw[slot] = gacc * act;
    }
  }
}

DI void phase_peer_ffn(const Params& p) {
  const char* exu = p.ws + OFF_EXU;
  const float* h = (const float*)(p.ws + OFF_H);
  const int* eidx = (const int*)(p.ws + OFF_EIDX);
  const float* coefw = (const float*)(p.ws + OFF_COEF);
  const int lane = threadIdx.x & 63;
  const int gw = (blockIdx.x * blockDim.x + threadIdx.x) >> 6;
  const int nw = (gridDim.x * blockDim.x) >> 6;
  for (int tok = gw; tok < T_; tok += nw) {
    float yacc[16];
#pragma unroll
    for (int i = 0; i < 16; ++i) yacc[i] = 0.f;
    const int e_lo = eidx[(size_t)tok * 128 + lane];
    const int e_hi = eidx[(size_t)tok * 128 + 64 + lane];
    const float c_lo = coefw[(size_t)tok * 128 + lane];
    const float c_hi = coefw[(size_t)tok * 128 + 64 + lane];
#pragma unroll 1
    for (int eb = 0; eb < 8; ++eb) {
      const int ev = (eb < 4) ? e_lo : e_hi;
      const float cv = (eb < 4) ? c_lo : c_hi;
      const int lbase = (eb & 3) * 16;
      u32x4 ur[16];
#pragma unroll
      for (int k = 0; k < 16; ++k) {
        const int er = __builtin_amdgcn_readlane(ev, lbase + k);
        ur[k] = *reinterpret_cast<const u32x4*>(exu + (size_t)er * 1024 + lane * 16);
      }
#pragma unroll
      for (int k = 0; k < 16; ++k) {
        const float ck = __int_as_float(__builtin_amdgcn_readlane(__float_as_int(cv), lbase + k));
#pragma unroll
        for (int w = 0; w < 4; ++w) {
          f2_t lo = __builtin_amdgcn_cvt_pk_f32_fp8((int)ur[k][w], false);
          f2_t hi = __builtin_amdgcn_cvt_pk_f32_fp8((int)ur[k][w], true);
          yacc[4 * w] = fmaf(ck, lo[0], yacc[4 * w]);
          yacc[4 * w + 1] = fmaf(ck, lo[1], yacc[4 * w + 1]);
          yacc[4 * w + 2] = fmaf(ck, hi[0], yacc[4 * w + 2]);
          yacc[4 * w + 3] = fmaf(ck, hi[1], yacc[4 * w + 3]);
        }
      }
    }
    const float* xr = h + (size_t)tok * 1024 + lane * 16;
    float v[16];
#pragma unroll
    for (int c = 0; c < 4; ++c) {
      f32x4 t = *reinterpret_cast<const f32x4*>(xr + c * 4);
#pragma unroll
      for (int k = 0; k < 4; ++k) v[4 * c + k] = ALPHA * t[k] + yacc[4 * c + k];
    }
    float s = 0.f;
#pragma unroll
    for (int i = 0; i < 16; ++i) s += v[i];
    const float mean = wave_sum(s) * (1.f / 1024.f);
    float q = 0.f;
#pragma unroll
    for (int i = 0; i < 16; ++i) { float d = v[i] - mean; q += d * d; }
    const float rstd = rsqrtf(wave_sum(q) * (1.f / 1024.f) + 1e-5f);
    float* orow = p.out + (size_t)tok * 1024 + lane * 16;
#pragma unroll
    for (int c = 0; c < 4; ++c) {
      f32x4 gg = *reinterpret_cast<const f32x4*>(p.ln_ffn_g + lane * 16 + c * 4);
      f32x4 bb = *reinterpret_cast<const f32x4*>(p.ln_ffn_b + lane * 16 + c * 4);
      f32x4 o;
#pragma unroll
      for (int k = 0; k < 4; ++k) o[k] = (v[4 * c + k] - mean) * rstd * gg[k] + bb[k];
      *reinterpret_cast<f32x4*>(orow + c * 4) = o;
    }
  }
}

constexpr size_t OFF_BAR = 166 * MiB;
DI void gbar(unsigned* ctr, unsigned target) {
  asm volatile("s_waitcnt vmcnt(0)" ::: "memory");
  __syncthreads();
  if (threadIdx.x == 0) {
    __builtin_amdgcn_fence(__ATOMIC_RELEASE, "agent");
    asm volatile("s_waitcnt vmcnt(0)" ::: "memory");
    __hip_atomic_fetch_add(ctr, 1u, __ATOMIC_RELAXED, __HIP_MEMORY_SCOPE_AGENT);
    while (__hip_atomic_load(ctr, __ATOMIC_RELAXED, __HIP_MEMORY_SCOPE_AGENT) < target) __builtin_amdgcn_s_sleep(2);
    __builtin_amdgcn_fence(__ATOMIC_ACQUIRE, "agent");
    asm volatile("s_waitcnt vmcnt(0)" ::: "memory");
  }
  __syncthreads();
}

__global__ void __launch_bounds__(512) fwd_megakernel(Params p) {
  __shared__ __attribute__((aligned(1024))) char smem[155648];
  cg::grid_group grid = cg::this_grid();
  const int G = gridDim.x;
  char* ws = p.ws;
  unsigned* bar = (unsigned*)(ws + OFF_BAR);

  phase_prep(p, smem);
  grid.sync();

  phase_inproj(p, smem);
  gbar(bar, (unsigned)(1 * G));

  for (int k = 0; k * G < 1024; ++k) {
    int j = (k & 1) ? (G - 1 - (int)blockIdx.x) : (int)blockIdx.x;
    int idx = k * G + j;
    if (idx < 1024) dsa_thr_item(p, idx & 7, 127 - (idx >> 3), smem);
  }
  for (int it = blockIdx.x; it < 2048; it += G) gla_g1_item(p, it, smem);
  gbar(bar, (unsigned)(2 * G));

  for (int k = 0; k * G < 1024; ++k) {
    int j = (k & 1) ? (G - 1 - (int)blockIdx.x) : (int)blockIdx.x;
    int idx = k * G + j;
    if (idx < 1024) dsa_attn_item(p, idx & 7, 127 - (idx >> 3), smem);
  }
  gla_scan(p);
  gbar(bar, (unsigned)(3 * G));

  for (int it = blockIdx.x; it < 2048; it += G) gla_g3_item(p, it, smem);
  gbar(bar, (unsigned)(4 * G));

  phase_gemm<0>(p, (const u16*)(ws + OFF_XB), (const u16*)(ws + OFF_WOUT), 1024, p.x, (float*)(ws + OFF_H), nullptr, 0, smem);
  gbar(bar, (unsigned)(5 * G));
  phase_ln(p, (float*)(ws + OFF_H), (u16*)(ws + OFF_HB), p.ln_mix_g, p.ln_mix_b);
  gbar(bar, (unsigned)(6 * G));

  phase_gemm<2>(p, (const u16*)(ws + OFF_HB), (const u16*)(ws + OFF_WQ), 1024, nullptr, nullptr, (u16*)(ws + OFF_QX), 1024, smem);
  gbar(bar, (unsigned)(7 * G));
  phase_xattn(p);
  gbar(bar, (unsigned)(8 * G));
  phase_gemm<0>(p, (const u16*)(ws + OFF_OX), (const u16*)(ws + OFF_WO), 1024, (const float*)(ws + OFF_H), (float*)(ws + OFF_H), nullptr, 0, smem);
  gbar(bar, (unsigned)(9 * G));
  phase_ln(p, (float*)(ws + OFF_H), (u16*)(ws + OFF_HB), p.ln_mem_g, p.ln_mem_b);
  gbar(bar, (unsigned)(10 * G));

  phase_gemm<5>(p, (const u16*)(ws + OFF_HB), (const u16*)(ws + OFF_WPQ), 2048, nullptr, nullptr, (u16*)(ws + OFF_QX), 2048, smem);
  gbar(bar, (unsigned)(11 * G));
  for (int it = blockIdx.x; it < 2048; it += G) peer_topk_item(p, it >> 3, it & 7, smem);
  gbar(bar, (unsigned)(12 * G));
  phase_peer_down(p);
  gbar(bar, (unsigned)(13 * G));
  phase_peer_ffn(p);
}

extern "C" void kernel_launch(void* const* d_in, const int* in_sizes, int n_in,
                              void* d_out, int out_size, void* d_ws, size_t ws_size,
                              hipStream_t stream) {
  static int grid_blocks = 0;
  if (!grid_blocks) {
    int dev = 0, cus = 0, per_cu = 0;
    (void)hipGetDevice(&dev);
    (void)hipDeviceGetAttribute(&cus, hipDeviceAttributeMultiprocessorCount, dev);
    (void)hipOccupancyMaxActiveBlocksPerMultiprocessor(&per_cu, fwd_megakernel, 512, 0);
    if (per_cu > 1) per_cu = 1;
    grid_blocks = cus * per_cu;
    if (grid_blocks > 256) grid_blocks = 256;
    if (ws_size < 512 * MiB) fprintf(stderr, "workspace too small: %zu\n", ws_size);
  }
  Params p{};
  p.x = (const float*)d_in[0]; p.positions = (const int*)d_in[1]; p.mem = (const float*)d_in[2]; p.w_in = (const float*)d_in[3];
  p.gate_up = (const float*)d_in[4]; p.gate_bias = (const float*)d_in[5]; p.norm_g = (const float*)d_in[6]; p.w_out = (const float*)d_in[7];
  p.ln_mix_g = (const float*)d_in[8]; p.ln_mix_b = (const float*)d_in[9];
  p.wq = (const float*)d_in[10]; p.wk = (const float*)d_in[11]; p.wv = (const float*)d_in[12]; p.wo = (const float*)d_in[13];
  p.ln_mem_g = (const float*)d_in[14]; p.ln_mem_b = (const float*)d_in[15];
  p.w_pq = (const float*)d_in[16]; p.sk1 = (const float*)d_in[17]; p.sk2 = (const float*)d_in[18];
  p.ex_down = (const float*)d_in[19]; p.ex_up = (const float*)d_in[20];
  p.ln_ffn_g = (const float*)d_in[21]; p.ln_ffn_b = (const float*)d_in[22];
  p.out = (float*)d_out; p.ws = (char*)d_ws;
  (void)hipMemsetAsync((char*)d_ws + OFF_BAR, 0, 256, stream);
  void* args[] = {&p};
  hipError_t e = hipLaunchCooperativeKernel((void*)fwd_megakernel, dim3(grid_blocks), dim3(512), args, 0, stream);
  if (e != hipSuccess) fprintf(stderr, "cooperative launch failed: %s (grid %d)\n", hipGetErrorString(e), grid_blocks);
}
```

```cpp
#include <hip/hip_runtime.h>
#include <hip/hip_cooperative_groups.h>
#include <cstdio>
#include <cmath>
namespace cg = cooperative_groups;

#define DI __device__ __forceinline__
typedef short bf16x8 __attribute__((ext_vector_type(8)));
typedef short bf16x4 __attribute__((ext_vector_type(4)));
typedef float f32x16 __attribute__((ext_vector_type(16)));
typedef float f32x4 __attribute__((ext_vector_type(4)));
typedef unsigned u32x4 __attribute__((ext_vector_type(4)));
typedef unsigned u32x2 __attribute__((ext_vector_type(2)));
typedef unsigned short u16;
typedef __bf16 bf2_t __attribute__((ext_vector_type(2)));
typedef float f2_t __attribute__((ext_vector_type(2)));

#define MFMA(a, b, c) __builtin_amdgcn_mfma_f32_32x32x16_bf16((a), (b), (c), 0, 0, 0)

constexpr int T_ = 32768;
constexpr int S_ = 4096;
constexpr int TMW = 2368;
constexpr int TM_Q = 0, TM_K = 512, TM_QI = 1024, TM_KI = 1280, TM_WI = 1312, TM_GLR = 1320, TM_GQ = 1344, TM_GK = 1600, TM_GR = 1856;
constexpr int PROJ_N = 3456;
constexpr float ALPHA = 1.189207115002721f;
constexpr size_t MiB = 1024 * 1024;

constexpr size_t OFF_XB = 0;
constexpr size_t OFF_EXD = 64 * MiB;
constexpr size_t OFF_EXU = 80 * MiB;
constexpr size_t OFF_BCG = 96 * MiB;
constexpr size_t OFF_WIN = 128 * MiB;
constexpr size_t OFF_WOUT = OFF_WIN + (size_t)PROJ_N * 1024 * 2;
constexpr size_t OFF_WQ = OFF_WOUT + 2 * MiB;
constexpr size_t OFF_WK = OFF_WQ + 2 * MiB;
constexpr size_t OFF_WV = OFF_WK + 2 * MiB;
constexpr size_t OFF_WO = OFF_WV + 2 * MiB;
constexpr size_t OFF_WPQ = OFF_WO + 2 * MiB;
constexpr size_t OFF_KIF = 149 * MiB;
constexpr size_t OFF_MEMB = 152 * MiB;
constexpr size_t OFF_MEMK = 156 * MiB;
constexpr size_t OFF_MEMVT = 160 * MiB;
constexpr size_t OFF_THR = 164 * MiB;
constexpr size_t OFF_SK = OFF_THR + 256 * 1024;
constexpr size_t OFF_DECAY = OFF_SK + 128 * 1024;
constexpr size_t OFF_ESC = 165 * MiB;
constexpr size_t OFF_TM = 168 * MiB;
constexpr size_t OFF_VT = 316 * MiB;
constexpr size_t OFF_KFR = 476 * MiB;
constexpr size_t OFF_GVT = 348 * MiB;
constexpr size_t OFF_KVT = 380 * MiB;
constexpr size_t OFF_PREV = 444 * MiB;
constexpr size_t OFF_H = 168 * MiB;
constexpr size_t OFF_HB = 296 * MiB;
constexpr size_t OFF_QX = 360 * MiB;
constexpr size_t OFF_OX = 424 * MiB;
constexpr size_t OFF_EIDX = 0;
constexpr size_t OFF_GATE = 16 * MiB;
constexpr size_t OFF_COEF = 32 * MiB;

struct Params {
  const float* x; const int* positions; const float* mem; const float* w_in;
  const float* gate_up; const float* gate_bias; const float* norm_g; const float* w_out;
  const float* ln_mix_g; const float* ln_mix_b;
  const float* wq; const float* wk; const float* wv; const float* wo;
  const float* ln_mem_g; const float* ln_mem_b;
  const float* w_pq; const float* sk1; const float* sk2; const float* ex_down; const float* ex_up;
  const float* ln_ffn_g; const float* ln_ffn_b;
  float* out; char* ws;
};

DI unsigned pk_bf16(float a, float b) {
  f2_t v = {a, b};
  bf2_t r = __builtin_convertvector(v, bf2_t);
  return __builtin_bit_cast(unsigned, r);
}
DI u16 f2bf(float a) { return (u16)(pk_bf16(a, 0.f) & 0xffffu); }
DI float bf2f(u16 u) { return __uint_as_float(((unsigned)u) << 16); }
DI float bflo(unsigned u) { return __uint_as_float(u << 16); }
DI float bfhi(unsigned u) { return __uint_as_float(u & 0xffff0000u); }
DI int crow(int i, int h) { return (i & 3) + 8 * (i >> 2) + 4 * h; }
DI bf16x8 ldg8(const u16* p) { return *reinterpret_cast<const bf16x8*>(p); }
DI bf16x8 pack8(float a0, float a1, float a2, float a3, float a4, float a5, float a6, float a7) {
  u32x4 r; r[0] = pk_bf16(a0, a1); r[1] = pk_bf16(a2, a3); r[2] = pk_bf16(a4, a5); r[3] = pk_bf16(a6, a7);
  return __builtin_bit_cast(bf16x8, r);
}
DI bf16x8 cat44(bf16x4 lo, bf16x4 hi) { return __builtin_shufflevector(lo, hi, 0, 1, 2, 3, 4, 5, 6, 7); }
DI void st4bf(u16* p, float a, float b, float c, float d) {
  u32x2 v; v[0] = pk_bf16(a, b); v[1] = pk_bf16(c, d);
  *reinterpret_cast<u32x2*>(p) = v;
}
DI float wave_sum(float v) {
#pragma unroll
  for (int d = 32; d >= 1; d >>= 1) v += __shfl_xor(v, d);
  return v;
}
DI void sincos_rad(float ang, float& s, float& c) {
  constexpr float C_hi = (float)0.15915494309189535;
  constexpr float C_lo = (float)(0.15915494309189535 - (double)C_hi);
  float k = rintf(ang * C_hi);
  float f = fmaf(ang, C_hi, -k);
  f = fmaf(ang, C_lo, f);
  s = __builtin_amdgcn_sinf(f);
  c = __builtin_amdgcn_cosf(f);
}
DI unsigned fkey(float s) {
  const unsigned u = __float_as_uint(s);
  return u ^ ((unsigned)((int)u >> 31) | 0x80000000u);
}
DI f32x16 zero16() { f32x16 z; for (int i = 0; i < 16; ++i) z[i] = 0.f; return z; }

DI int win_src_col(int n) {
  if (n < 1832) return n;
  if (n < 1848) return 2856 + (n - 1832);
  if (n < 1856) return -1;
  if (n < 2880) return n - 24;
  if (n < 3392) return n - 8;
  return -1;
}

DI void cvt_stream(const float* __restrict__ src, u16* __restrict__ dst, size_t n, size_t gtid, size_t gn) {
  size_t n8 = n / 8;
  for (size_t i = gtid; i < n8; i += gn) {
    f32x4 a = *reinterpret_cast<const f32x4*>(src + i * 8);
    f32x4 b = *reinterpret_cast<const f32x4*>(src + i * 8 + 4);
    u32x4 r; r[0] = pk_bf16(a[0], a[1]); r[1] = pk_bf16(a[2], a[3]); r[2] = pk_bf16(b[0], b[1]); r[3] = pk_bf16(b[2], b[3]);
    *reinterpret_cast<u32x4*>(dst + i * 8) = r;
  }
}

template <bool MAPPED>
DI void transpose_tile(const float* __restrict__ W, int ldn, u16* __restrict__ Wt, int k0, int n0, float* tile) {
  const int tid = threadIdx.x;
  {
    int nn = n0 + (tid & 63);
    int c = MAPPED ? win_src_col(nn) : nn;
#pragma unroll
    for (int rr = 0; rr < 8; ++rr) {
      int kk = (tid >> 6) + 8 * rr;
      float v = (c >= 0) ? W[(size_t)(k0 + kk) * ldn + c] : 0.f;
      tile[kk * 65 + (tid & 63)] = v;
    }
  }
  __syncthreads();
#pragma unroll
  for (int rr = 0; rr < 8; ++rr) {
    int nn = (tid >> 6) + 8 * rr;
    int kk = tid & 63;
    Wt[(size_t)(n0 + nn) * 1024 + k0 + kk] = f2bf(tile[kk * 65 + nn]);
  }
  __syncthreads();
}

DI void phase_prep(const Params& p, char* smem) {
  const size_t gtid = (size_t)blockIdx.x * blockDim.x + threadIdx.x;
  const size_t gn = (size_t)gridDim.x * blockDim.x;
  char* ws = p.ws;
  cvt_stream(p.x, (u16*)(ws + OFF_XB), (size_t)T_ * 1024, gtid, gn);
  cvt_stream(p.mem, (u16*)(ws + OFF_MEMB), (size_t)2048 * 1024, gtid, gn);
  {
    const int lane = threadIdx.x & 63;
    const int gw = (int)(gtid >> 6), nw = (int)(gn >> 6);
    for (int r = gw; r < 2 * 16384; r += nw) {
      const int tbl = r >> 14, row = r & 16383;
      const float* src = (tbl ? p.ex_up : p.ex_down) + (size_t)row * 1024 + lane * 16;
      f32x4 v[4]; float mx = 0.f;
#pragma unroll
      for (int c = 0; c < 4; ++c) {
        v[c] = *reinterpret_cast<const f32x4*>(src + c * 4);
#pragma unroll
        for (int k = 0; k < 4; ++k) mx = fmaxf(mx, fabsf(v[c][k]));
      }
#pragma unroll
      for (int d = 32; d >= 1; d >>= 1) mx = fmaxf(mx, __shfl_xor(mx, d));
      float sc = (mx > 0.f) ? exp2f(floorf(log2f(224.f / mx))) : 1.f;
      u32x4 o;
#pragma unroll
      for (int c = 0; c < 4; ++c) {
        int t = __builtin_amdgcn_cvt_pk_fp8_f32(v[c][0] * sc, v[c][1] * sc, 0, false);
        t = __builtin_amdgcn_cvt_pk_fp8_f32(v[c][2] * sc, v[c][3] * sc, t, true);
        o[c] = (unsigned)t;
      }
      *reinterpret_cast<u32x4*>(ws + (tbl ? OFF_EXU : OFF_EXD) + (size_t)row * 1024 + lane * 16) = o;
      if (lane == 0) ((float*)(ws + OFF_ESC))[r] = 1.f / sc;
    }
  }
  cvt_stream(p.sk1, (u16*)(ws + OFF_SK), (size_t)128 * 128, gtid, gn);
  cvt_stream(p.sk2, (u16*)(ws + OFF_SK) + 128 * 128, (size_t)128 * 128, gtid, gn);
  float* tile = (float*)smem;
  const int n_win = 54 * 16, n_sq = 256, n_pq = 512;
  const int total = n_win + 5 * n_sq + n_pq;
  for (int t = blockIdx.x; t < total; t += gridDim.x) {
    if (t < n_win) {
      transpose_tile<true>(p.w_in, 3384, (u16*)(ws + OFF_WIN), (t & 15) * 64, (t >> 4) * 64, tile);
    } else if (t < n_win + 5 * n_sq) {
      int u = t - n_win; int which = u >> 8; int r = u & 255;
      const float* W = which == 0 ? p.w_out : which == 1 ? p.wq : which == 2 ? p.wk : which == 3 ? p.wv : p.wo;
      size_t off = which == 0 ? OFF_WOUT : which == 1 ? OFF_WQ : which == 2 ? OFF_WK : which == 3 ? OFF_WV : OFF_WO;
      transpose_tile<false>(W, 1024, (u16*)(ws + off), (r & 15) * 64, (r >> 4) * 64, tile);
    } else {
      int r = t - n_win - 5 * n_sq;
      transpose_tile<false>(p.w_pq, 2048, (u16*)(ws + OFF_WPQ), (r & 15) * 64, (r >> 4) * 64, tile);
    }
  }
}

#define WAIT_V(n) asm volatile("s_waitcnt vmcnt(%0)" ::"n"(n) : "memory")
#define RAW_BARRIER() do { asm volatile("s_waitcnt lgkmcnt(0)" ::: "memory"); __builtin_amdgcn_s_barrier(); asm volatile("" ::: "memory"); } while (0)
constexpr int G_STAGE = 384 * 128;
DI void gemm_tile(const u16* __restrict__ X, int ldx, const u16* __restrict__ Wt, int ldw, int K, char* smem,
                  f32x16 (&acc)[2][2]) {
  const int tid = threadIdx.x, lane = tid & 63, wave = tid >> 6;
  const int fw = wave & 1, tq = wave >> 1, lr = lane & 31, lh = lane >> 5;
#pragma unroll
  for (int a = 0; a < 2; ++a)
#pragma unroll
    for (int b = 0; b < 2; ++b) acc[a][b] = zero16();
  const int nk = K / 64;
  const u16* src[6];
#pragma unroll
  for (int i = 0; i < 6; ++i) {
    const int R = 8 * (wave + 8 * i) + (lane >> 3);
    const int c = (lane & 7) ^ ((R >> 1) & 7);
    src[i] = (i < 4) ? (X + (size_t)R * ldx + c * 8) : (Wt + (size_t)(R - 256) * ldw + c * 8);
  }
#define GLDS_STAGE(slot, kt) do { _Pragma("unroll") for (int i = 0; i < 6; ++i) \
    __builtin_amdgcn_global_load_lds((const unsigned*)(src[i] + (kt) * 64), (__attribute__((address_space(3))) unsigned*)(smem + (slot) * G_STAGE + (wave + 8 * i) * 1024), 16, 0, 0); } while (0)
  int offA[2], offB[2], xa[2], xb[2];
#pragma unroll
  for (int ft = 0; ft < 2; ++ft) { const int R = 256 + fw * 64 + ft * 32 + lr; offA[ft] = R * 128; xa[ft] = (R >> 1) & 7; }
#pragma unroll
  for (int tt = 0; tt < 2; ++tt) { const int R = tq * 64 + tt * 32 + lr; offB[tt] = R * 128; xb[tt] = (R >> 1) & 7; }
  GLDS_STAGE(0, 0); GLDS_STAGE(1, 1); WAIT_V(6); RAW_BARRIER();
  int cur = 0;
  for (int kt = 0; kt < nk; ++kt) {
    const int nxt = (cur >= 1) ? cur - 1 : 2;
    if (kt + 2 < nk) GLDS_STAGE(nxt, kt + 2);
    __builtin_amdgcn_sched_barrier(0);
    const char* st = smem + cur * G_STAGE;
#pragma unroll
    for (int ks = 0; ks < 4; ++ks) {
      bf16x8 a[2], b[2];
#pragma unroll
      for (int ft = 0; ft < 2; ++ft) a[ft] = *reinterpret_cast<const bf16x8*>(st + offA[ft] + (((ks * 2 + lh) ^ xa[ft]) << 4));
#pragma unroll
      for (int tt = 0; tt < 2; ++tt) b[tt] = *reinterpret_cast<const bf16x8*>(st + offB[tt] + (((ks * 2 + lh) ^ xb[tt]) << 4));
#pragma unroll
      for (int ft = 0; ft < 2; ++ft)
#pragma unroll
        for (int tt = 0; tt < 2; ++tt) acc[ft][tt] = MFMA(a[ft], b[tt], acc[ft][tt]);
    }
    if (kt + 2 < nk) { WAIT_V(6); } else { WAIT_V(0); }
    RAW_BARRIER();
    cur = (cur == 2) ? 0 : cur + 1;
  }
#undef GLDS_STAGE
}

DI void store_tm_rows(f32x16 (&acc)[2][2], char* smem, u16* tm, int tokbase, int col) {
  const int lane = threadIdx.x & 63, wave = threadIdx.x >> 6, lr = lane & 31, lh = lane >> 5;
  float* wl = (float*)(smem + wave * 17408);
#pragma unroll
  for (int tt = 0; tt < 2; ++tt)
#pragma unroll
    for (int ft = 0; ft < 2; ++ft)
#pragma unroll
      for (int g = 0; g < 4; ++g) {
        f32x4 v = {acc[ft][tt][4 * g], acc[ft][tt][4 * g + 1], acc[ft][tt][4 * g + 2], acc[ft][tt][4 * g + 3]};
        *reinterpret_cast<f32x4*>(wl + (tt * 32 + lr) * 68 + ft * 32 + 8 * g + 4 * lh) = v;
      }
  const int ch = lane & 15, r0 = lane >> 4;
#pragma unroll 4
  for (int k = 0; k < 16; ++k) {
    const int row = r0 + 4 * k;
    f32x4 v = *reinterpret_cast<const f32x4*>(wl + row * 68 + ch * 4);
    st4bf(tm + (size_t)(tokbase + row) * TMW + col + ch * 4, v[0], v[1], v[2], v[3]);
  }
}

DI void epi_inproj(const Params& p, int tok0, int f0, f32x16 (&acc)[2][2], char* smem) {
  const int tid = threadIdx.x, lane = tid & 63, wave = tid >> 6;
  const int fw = wave & 1, tq = wave >> 1, lr = lane & 31, lh = lane >> 5;
  const int fbase = f0 + fw * 64;
  if (fbase >= 3392) return;
  u16* tm = (u16*)(p.ws + OFF_TM);
  int tmcol = -1;
#pragma unroll
  for (int tt = 0; tt < 2; ++tt) {
    const int tok = tok0 + tq * 64 + tt * 32 + lr;
    const float posf = (float)p.positions[tok];
    const int bb = tok >> 12, ss = tok & 4095;
    if (fbase < 1024) {
#pragma unroll
      for (int r = 0; r < 4; ++r) {
        float j = (float)(4 * lh + r);
        float inv = exp2f(-j * (18.931568569324174f / 8.0f));
        float sn, cs; sincos_rad(posf * inv, sn, cs);
        float x1 = acc[0][tt][r], x2 = acc[0][tt][r + 4];
        acc[0][tt][r] = x1 * cs - x2 * sn;
        acc[0][tt][r + 4] = x2 * cs + x1 * sn;
      }
      if (fbase < 512) {
        tmcol = fbase;
      } else {
        u16* kfr = (u16*)(p.ws + OFF_KFR);
        const int head = (fbase - 512) >> 6, gt = ss >> 5;
#pragma unroll
        for (int ft = 0; ft < 2; ++ft)
#pragma unroll
          for (int g = 0; g < 4; ++g) {
            const int ks = ft * 2 + (g >> 1), lane2 = (g & 1) * 32 + lr;
            st4bf(kfr + ((((size_t)(bb * 8 + head) * 128 + gt) * 4 + ks) * 64 + lane2) * 8 + 4 * lh, acc[ft][tt][4 * g], acc[ft][tt][4 * g + 1], acc[ft][tt][4 * g + 2], acc[ft][tt][4 * g + 3]);
          }
      }
    } else if (fbase < 1536) {
      u16* vfr = (u16*)(p.ws + OFF_VT);
      const int head = (fbase - 1024) >> 6, gt = ss >> 5;
      const int s = lr >> 4, r16 = lr & 15, j = 4 * (r16 >> 3) + (r16 & 3), lh2 = (r16 >> 2) & 1;
#pragma unroll
      for (int ft = 0; ft < 2; ++ft)
#pragma unroll
        for (int i = 0; i < 16; ++i) {
          const int lane2 = lh2 * 32 + crow(i, lh);
          vfr[((((((size_t)(bb * 8 + head) * 128 + gt) * 2 + ft) * 2 + s) * 64 + lane2) * 8) + j] = f2bf(acc[ft][tt][i]);
        }
    } else if (fbase >= 2368 && fbase < 2880) {
      u16* vt = (u16*)(p.ws + OFF_GVT);
      const int fo = fbase - 2368;
#pragma unroll
      for (int ft = 0; ft < 2; ++ft)
#pragma unroll
        for (int i = 0; i < 16; ++i) {
          int feat = fo + ft * 32 + crow(i, lh);
          vt[((size_t)bb * 512 + feat) * 4096 + ss] = f2bf(acc[ft][tt][i]);
        }
    } else {
      if (fbase < 1856) {
#pragma unroll
        for (int ft = 0; ft < 2; ++ft) {
          const bool rot = (fbase < 1792) || (ft == 0);
#pragma unroll
          for (int r = 0; r < 4; ++r) {
            float v = acc[ft][tt][r];
            float o = __shfl_xor(v, 32);
            float inv = exp2f(-(float)r * (18.931568569324174f / 4.0f));
            float sn, cs; sincos_rad(posf * inv, sn, cs);
            float res = (lh == 0) ? (v * cs - o * sn) : (v * cs + o * sn);
            acc[ft][tt][r] = rot ? res : v;
          }
        }
        tmcol = fbase - 512;
        if (fbase == 1792) {
          u16* kif = (u16*)(p.ws + OFF_KIF);
          const int gt = ss >> 5;
#pragma unroll
          for (int g = 0; g < 4; ++g) {
            const int ks = g >> 1, lane2 = (g & 1) * 32 + lr;
            st4bf(kif + ((((size_t)bb * 128 + gt) * 2 + ks) * 64 + lane2) * 8 + 4 * lh, acc[0][tt][4 * g], acc[0][tt][4 * g + 1], acc[0][tt][4 * g + 2], acc[0][tt][4 * g + 3]);
          }
        }
      } else if (fbase < 2368) {
        tmcol = fbase - 512;
      } else {
        tmcol = fbase - 1024;
      }
    }
  }
  if (tmcol >= 0) store_tm_rows(acc, smem, tm, tok0 + tq * 64, tmcol);
}

DI void phase_inproj(const Params& p, char* smem) {
  const int n_in = 128 * 27;
  const int total = n_in + 128;
  const u16* xb = (const u16*)(p.ws + OFF_XB);
  const u16* memb = (const u16*)(p.ws + OFF_MEMB);
  const int tid = threadIdx.x, lane = tid & 63, wave = tid >> 6;
  const int fw = wave & 1, tq = wave >> 1, lr = lane & 31, lh = lane >> 5;
  const int xg = blockIdx.x & 7, xi = blockIdx.x >> 3, xn = gridDim.x >> 3;
  for (int u = xi; u < 16 * 27 + 16; u += xn) {
    f32x16 acc[2][2];
    const int t = (u < 16 * 27) ? (xg * 16 + (u / 27)) * 27 + (u % 27) : n_in + (u - 16 * 27) * 8 + xg;
    if (t < n_in) {
      int mt = t / 27, nt = t % 27;
      gemm_tile(xb + (size_t)mt * 256 * 1024, 1024, (const u16*)(p.ws + OFF_WIN) + (size_t)nt * 128 * 1024, 1024, 1024, smem, acc);
      epi_inproj(p, mt * 256, nt * 128, acc, smem);
      __syncthreads();
    } else {
      int u = t - n_in; int which = u >> 6; int r = u & 63; int mt = r >> 3, nt = r & 7;
      const u16* W = (const u16*)(p.ws + (which == 0 ? OFF_WK : OFF_WV));
      gemm_tile(memb + (size_t)mt * 256 * 1024, 1024, W + (size_t)nt * 128 * 1024, 1024, 1024, smem, acc);
#pragma unroll
      for (int tt = 0; tt < 2; ++tt) {
        const int tok = mt * 256 + tq * 64 + tt * 32 + lr;
        const int bb = tok >> 8, mm = tok & 255, hh = nt >> 1, kt = mm >> 5;
        if (which == 0) {
          u16* mk = (u16*)(p.ws + OFF_MEMK);
#pragma unroll
          for (int ft = 0; ft < 2; ++ft)
#pragma unroll
            for (int g = 0; g < 4; ++g) {
              const int ks = (nt & 1) * 8 + fw * 4 + ft * 2 + (g >> 1), lane2 = (g & 1) * 32 + lr;
              st4bf(mk + ((((size_t)(bb * 4 + hh) * 8 + kt) * 16 + ks) * 64 + lane2) * 8 + 4 * lh, acc[ft][tt][4 * g], acc[ft][tt][4 * g + 1], acc[ft][tt][4 * g + 2], acc[ft][tt][4 * g + 3]);
            }
        } else {
          u16* mv = (u16*)(p.ws + OFF_MEMVT);
          const int s = lr >> 4, r16 = lr & 15, j = 4 * (r16 >> 3) + (r16 & 3), lh2 = (r16 >> 2) & 1;
#pragma unroll
          for (int ft = 0; ft < 2; ++ft) {
            const int dt = (nt & 1) * 4 + fw * 2 + ft;
#pragma unroll
            for (int i = 0; i < 16; ++i) {
              const int lane2 = lh2 * 32 + crow(i, lh);
              mv[((((((size_t)(bb * 4 + hh) * 8 + dt) * 8 + kt) * 2 + s) * 64 + lane2) * 8) + j] = f2bf(acc[ft][tt][i]);
            }
          }
        }
      }
    }
  }
}

DI void idx_scores(const bf16x8 (&qf)[8][2], const float (&wq)[8], bf16x8 k0, bf16x8 k1, float (&sc)[16]) {
#pragma unroll
  for (int i = 0; i < 16; ++i) sc[i] = 0.f;
#pragma unroll
  for (int hd = 0; hd < 8; ++hd) {
    f32x16 a = zero16();
    a = MFMA(k0, qf[hd][0], a);
    a = MFMA(k1, qf[hd][1], a);
#pragma unroll
    for (int i = 0; i < 16; ++i) sc[i] = fmaf(wq[hd], fmaxf(a[i], 0.f), sc[i]);
  }
}

DI void load_idx_q(const u16* tm, int tok, int lh, bf16x8 (&qf)[8][2], float (&wq)[8]) {
  const u16* row = tm + (size_t)tok * TMW;
#pragma unroll
  for (int hd = 0; hd < 8; ++hd)
#pragma unroll
    for (int ks = 0; ks < 2; ++ks) qf[hd][ks] = ldg8(row + TM_QI + hd * 32 + ks * 16 + lh * 8);
  bf16x8 w8 = ldg8(row + TM_WI);
#pragma unroll
  for (int hd = 0; hd < 8; ++hd) wq[hd] = bf2f((u16)w8[hd]) * 0.0625f;
}

DI int wave_incl_scan(int v, int lane) {
#pragma unroll
  for (int d = 1; d < 64; d <<= 1) {
    int t = __shfl_up(v, d);
    if (lane >= d) v += t;
  }
  return v;
}

DI void dsa_thr_item(const Params& p, int b, int qblk, char* smem) {
  unsigned* hist = (unsigned*)smem;
  unsigned* pref = (unsigned*)(smem + 32768);
  int* rank = (int*)(smem + 32768 + 128);
  const u16* tm = (const u16*)(p.ws + OFF_TM);
  const int tid = threadIdx.x, lane = tid & 63, wave = tid >> 6, lr = lane & 31, lh = lane >> 5;
  const int q0 = qblk * 32;
  u16* qi = (u16*)(smem + 33280);
  for (int i = tid; i < 32 * 32; i += 512) {
    int q = i >> 5, ch = i & 31;
    *reinterpret_cast<u32x4*>(qi + q * 296 + ch * 8) = *reinterpret_cast<const u32x4*>(tm + (size_t)(b * S_ + q0 + q) * TMW + TM_QI + ch * 8);
  }
  float wq[8];
  {
    bf16x8 w8 = ldg8(tm + (size_t)(b * S_ + q0 + lr) * TMW + TM_WI);
#pragma unroll
    for (int hd = 0; hd < 8; ++hd) wq[hd] = bf2f((u16)w8[hd]) * 0.0625f;
  }
  __syncthreads();
  for (int i = tid; i < 32 * 32; i += 512) {
    const int q = i >> 5, d = i & 31;
    float acc = 0.f;
#pragma unroll
    for (int hd = 0; hd < 8; ++hd) acc = fmaf(bf2f(tm[(size_t)(b * S_ + q0 + q) * TMW + TM_WI + hd]) * 0.0625f, bf2f(qi[q * 296 + hd * 32 + d]), acc);
    qi[q * 296 + 256 + d] = f2bf(acc);
  }
  const u16* qil = qi + lr * 296 + lh * 8;
  if (tid < 32) { pref[tid] = 0u; rank[tid] = min(256, q0 + tid + 1); }
  for (int pass = 0; pass < 4; ++pass) {
    for (int i = tid; i < 8192; i += 512) hist[i] = 0u;
    __syncthreads();
    const int shift = 24 - 8 * pass;
    const unsigned mypref = pref[lr];
    const u16* kib = (const u16*)(p.ws + OFF_KIF) + (size_t)b * 128 * 1024 + lane * 8;
    bf16x8 kn0, kn1;
    {
      const int kt0 = min(wave, qblk);
      kn0 = ldg8(kib + (size_t)kt0 * 1024); kn1 = ldg8(kib + (size_t)kt0 * 1024 + 512);
    }
    for (int kt = wave; kt <= qblk; kt += 8) {
      const bf16x8 k0 = kn0, k1 = kn1;
      {
        const int ktn = min(kt + 8, qblk);
        kn0 = ldg8(kib + (size_t)ktn * 1024); kn1 = ldg8(kib + (size_t)ktn * 1024 + 512);
      }
      float sc[16];
      {
        f32x16 a = zero16();
        a = MFMA(k0, *reinterpret_cast<const bf16x8*>(qil + 256), a);
        a = MFMA(k1, *reinterpret_cast<const bf16x8*>(qil + 256 + 16), a);
#pragma unroll
        for (int i = 0; i < 16; ++i) sc[i] = a[i];
      }
#pragma unroll
      for (int hd = 0; hd < 8; ++hd) {
        f32x16 a = zero16();
        a = MFMA(k0, *reinterpret_cast<const bf16x8*>(qil + hd * 32), a);
        a = MFMA(k1, *reinterpret_cast<const bf16x8*>(qil + hd * 32 + 16), a);
        const float wh = wq[hd];
#pragma unroll
        for (int i = 0; i < 16; ++i) sc[i] = fmaf(fabsf(a[i]), wh, sc[i]);
      }
      if (kt == qblk) {
#pragma unroll
        for (int i = 0; i < 16; ++i) {
          int kp = kt * 32 + crow(i, lh);
          unsigned ky = fkey(sc[i]);
          unsigned hi = (ky >> shift);
          if (kp <= q0 + lr && (hi >> 8) == mypref) atomicAdd(&hist[(hi & 255u) * 32 + lr], 1u);
        }
      } else {
#pragma unroll
        for (int i = 0; i < 16; ++i) {
          unsigned ky = fkey(sc[i]);
          unsigned hi = (ky >> shift);
          if ((hi >> 8) == mypref) atomicAdd(&hist[(hi & 255u) * 32 + lr], 1u);
        }
      }
    }
    __syncthreads();
#pragma unroll 1
    for (int qq = 0; qq < 4; ++qq) {
      const int q = wave * 4 + qq;
      const int rk = rank[q];
      int c[4];
#pragma unroll
      for (int j = 0; j < 4; ++j) c[j] = (int)hist[(255 - 4 * lane - j) * 32 + q];
      int s = c[0] + c[1] + c[2] + c[3];
      int P = wave_incl_scan(s, lane);
      int excl = P - s;
      if (P >= rk && excl < rk) {
        int cum = excl; int bin = 0; int nr = 1; bool found = false;
#pragma unroll
        for (int j = 0; j < 4; ++j) {
          if (!found && cum + c[j] >= rk) { bin = 255 - 4 * lane - j; nr = rk - cum; found = true; }
          if (!found) cum += c[j];
        }
        pref[q] = (pref[q] << 8) | (unsigned)bin;
        rank[q] = nr;
      }
    }
    __syncthreads();
  }
  if (tid < 32) ((unsigned*)(p.ws + OFF_THR))[b * S_ + q0 + tid] = pref[tid];
  __syncthreads();
}

DI void dsa_attn_item(const Params& p, int b, int qblk, char* smem) {
  u16* maskbuf = (u16*)smem;
  u16* qi = (u16*)(smem + 4096);
  const u16* tm = (const u16*)(p.ws + OFF_TM);
  const u16* vfr = (const u16*)(p.ws + OFF_VT) + ((size_t)(b * 8 + (threadIdx.x >> 6)) * 128) * 2048 + (threadIdx.x & 63) * 8;
  const u16* kfr = (const u16*)(p.ws + OFF_KFR) + ((size_t)(b * 8 + (threadIdx.x >> 6)) * 128) * 2048 + (threadIdx.x & 63) * 8;
  const unsigned* thr = (const unsigned*)(p.ws + OFF_THR);
  const int tid = threadIdx.x, lane = tid & 63, wave = tid >> 6, lr = lane & 31, lh = lane >> 5;
  const int q0 = qblk * 32;
  const int head = wave;
  const int qtok = b * S_ + q0 + lr;
  bf16x8 Qf[4];
#pragma unroll
  for (int ks = 0; ks < 4; ++ks) {
    bf16x8 raw = ldg8(tm + (size_t)qtok * TMW + TM_Q + head * 64 + ks * 16 + lh * 8);
    float f[8];
#pragma unroll
    for (int j = 0; j < 8; ++j) f[j] = bf2f((u16)raw[j]) * (0.125f * 1.4426950408889634f);
    Qf[ks] = pack8(f[0], f[1], f[2], f[3], f[4], f[5], f[6], f[7]);
  }
  f32x16 O[2];
  O[0] = zero16(); O[1] = zero16();
  float mrun = -INFINITY, lrun = 0.f;
  const unsigned thrq = thr[qtok];
  const int nchunks = (q0 + 31) / 256 + 1;
  for (int i = tid; i < 32 * 32; i += 512) {
    int q = i >> 5, ch = i & 31;
    *reinterpret_cast<u32x4*>(qi + q * 296 + ch * 8) = *reinterpret_cast<const u32x4*>(tm + (size_t)(b * S_ + q0 + q) * TMW + TM_QI + ch * 8);
  }
  float* wqs = (float*)(smem + 4096 + 32 * 296 * 2);
  if (tid < 256) wqs[tid] = bf2f(tm[(size_t)(b * S_ + q0 + (tid & 31)) * TMW + TM_WI + (tid >> 5)]) * 0.0625f;
  __syncthreads();
  for (int i = tid; i < 32 * 32; i += 512) {
    const int q = i >> 5, d = i & 31;
    float acc = 0.f;
#pragma unroll
    for (int hd = 0; hd < 8; ++hd) acc = fmaf(bf2f(tm[(size_t)(b * S_ + q0 + q) * TMW + TM_WI + hd]) * 0.0625f, bf2f(qi[q * 296 + hd * 32 + d]), acc);
    qi[q * 296 + 256 + d] = f2bf(acc);
  }
  __syncthreads();
  const u16* qil = qi + lr * 296 + lh * 8;
  const u16* kibase = (const u16*)(p.ws + OFF_KIF) + (size_t)b * 128 * 1024 + lane * 8;
  bf16x8 Kf[4], Kn[4];
#pragma unroll
  for (int ks = 0; ks < 4; ++ks) Kf[ks] = ldg8(kfr + ks * 512);
  bf16x8 Vf[2][2], Vn[2][2];
#pragma unroll
  for (int dt = 0; dt < 2; ++dt)
#pragma unroll
    for (int s = 0; s < 2; ++s) Vf[dt][s] = ldg8(vfr + (dt * 2 + s) * 512);
  bf16x8 ki0, ki1;
  {
    const int kt0 = min(wave, qblk);
    ki0 = ldg8(kibase + (size_t)kt0 * 1024); ki1 = ldg8(kibase + (size_t)kt0 * 1024 + 512);
  }
  for (int c = 0; c < nchunks; ++c) {
    const int buf = c & 1;
    {
      const int key0 = (c * 8 + wave) * 32;
      unsigned bits = 0u;
      const bf16x8 k0 = ki0, k1 = ki1;
      {
        const int ktn = min((c + 1) * 8 + wave, qblk);
        ki0 = ldg8(kibase + (size_t)ktn * 1024); ki1 = ldg8(kibase + (size_t)ktn * 1024 + 512);
      }
      if (key0 <= q0 + 31) {
        float sc[16];
        {
          f32x16 a = zero16();
          a = MFMA(k0, *reinterpret_cast<const bf16x8*>(qil + 256), a);
          a = MFMA(k1, *reinterpret_cast<const bf16x8*>(qil + 256 + 16), a);
#pragma unroll
          for (int i = 0; i < 16; ++i) sc[i] = a[i];
        }
#pragma unroll 2
        for (int hd = 0; hd < 8; ++hd) {
          f32x16 a = zero16();
          a = MFMA(k0, *reinterpret_cast<const bf16x8*>(qil + hd * 32), a);
          a = MFMA(k1, *reinterpret_cast<const bf16x8*>(qil + hd * 32 + 16), a);
          const float wh = wqs[hd * 32 + lr];
#pragma unroll
          for (int i = 0; i < 16; ++i) sc[i] = fmaf(fabsf(a[i]), wh, sc[i]);
        }
        __builtin_amdgcn_sched_barrier(0);
#pragma unroll
        for (int i = 0; i < 16; ++i) {
          int kp = key0 + crow(i, lh);
          if (kp <= q0 + lr && fkey(sc[i]) >= thrq) bits |= (1u << i);
        }
      }
      maskbuf[(buf * 8 + wave) * 64 + lane] = (u16)bits;
    }
    __syncthreads();
#pragma unroll 1
    for (int t8 = 0; t8 < 8; ++t8) {
      const int g = c * 8 + t8;
      if (g > qblk) break;
      {
        const int gn = min(g + 1, qblk);
        const u16* kr = kfr + (size_t)gn * 2048;
#pragma unroll
        for (int ks = 0; ks < 4; ++ks) Kn[ks] = ldg8(kr + ks * 512);
#pragma unroll
        for (int dt = 0; dt < 2; ++dt)
#pragma unroll
          for (int s = 0; s < 2; ++s) Vn[dt][s] = ldg8(vfr + (size_t)gn * 2048 + (dt * 2 + s) * 512);
      }

      const unsigned bits = maskbuf[(buf * 8 + t8) * 64 + lane];
      f32x16 Sx = zero16();
#pragma unroll
      for (int ks = 0; ks < 4; ++ks) Sx = MFMA(Kf[ks], Qf[ks], Sx);
      float sm[16];
#pragma unroll
      for (int i = 0; i < 16; ++i) {
        const unsigned t = (unsigned)__builtin_amdgcn_sbfe((int)bits, i, 1);
        sm[i] = __uint_as_float((t & __float_as_uint(Sx[i])) | (~t & 0xff800000u));
      }
      float mt = fmaxf(fmaxf(fmaxf(sm[0], sm[1]), fmaxf(sm[2], sm[3])), fmaxf(fmaxf(sm[4], sm[5]), fmaxf(sm[6], sm[7])));
      mt = fmaxf(mt, fmaxf(fmaxf(fmaxf(sm[8], sm[9]), fmaxf(sm[10], sm[11])), fmaxf(fmaxf(sm[12], sm[13]), fmaxf(sm[14], sm[15]))));
      mt = fmaxf(mt, __shfl_xor(mt, 32));
      const float mnew = fmaxf(mrun, mt);
      const float msafe = (mnew == -INFINITY) ? 0.f : mnew;
      const float alpha = __builtin_amdgcn_exp2f(mrun - msafe);
      float pv[16]; float ps = 0.f;
#pragma unroll
      for (int i = 0; i < 16; ++i) { pv[i] = __builtin_amdgcn_exp2f(sm[i] - msafe); ps += pv[i]; }
      lrun = lrun * alpha + ps;
      mrun = mnew;
      if (__builtin_amdgcn_ballot_w64(alpha != 1.f) != 0ull) {
#pragma unroll
        for (int dt = 0; dt < 2; ++dt)
#pragma unroll
          for (int i = 0; i < 16; ++i) O[dt][i] *= alpha;
      }
      bf16x8 Pf[2];
#pragma unroll
      for (int s = 0; s < 2; ++s) Pf[s] = pack8(pv[8 * s], pv[8 * s + 1], pv[8 * s + 2], pv[8 * s + 3], pv[8 * s + 4], pv[8 * s + 5], pv[8 * s + 6], pv[8 * s + 7]);
#pragma unroll
      for (int dt = 0; dt < 2; ++dt)
#pragma unroll
        for (int s = 0; s < 2; ++s) O[dt] = MFMA(Vf[dt][s], Pf[s], O[dt]);
#pragma unroll
      for (int ks = 0; ks < 4; ++ks) Kf[ks] = Kn[ks];
#pragma unroll
      for (int dt = 0; dt < 2; ++dt)
#pragma unroll
        for (int s = 0; s < 2; ++s) Vf[dt][s] = Vn[dt][s];
    }
  }
  u16* y = (u16*)(p.ws + OFF_XB);
  {
    float lt = lrun + __shfl_xor(lrun, 32);
    float inv = 1.f / lt;
#pragma unroll
    for (int dt = 0; dt < 2; ++dt)
#pragma unroll
      for (int g = 0; g < 4; ++g)
        st4bf(y + (size_t)qtok * 1024 + head * 64 + dt * 32 + 8 * g + 4 * lh, O[dt][4 * g] * inv, O[dt][4 * g + 1] * inv, O[dt][4 * g + 2] * inv, O[dt][4 * g + 3] * inv);
  }
  __syncthreads();
}

DI void gla_bcum(const Params& p, int b, int h, int n, float* bc, float* glr_s, float* segtot) {
  const u16* tm = (const u16*)(p.ws + OFF_TM);
  const int tid = threadIdx.x;
  const int tok0 = b * S_ + n * 64;
  for (int i = tid; i < 1024; i += 512) glr_s[i] = bf2f(tm[(size_t)(tok0 + (i >> 4)) * TMW + TM_GLR + (i & 15)]);
  const int d = tid & 63, cgp = tid >> 6;
  float gu[16];
#pragma unroll
  for (int j = 0; j < 16; ++j) gu[j] = p.gate_up[j * 256 + h * 64 + d];
  const float bias = p.gate_bias[h * 64 + d];
  __syncthreads();
  float v[8]; float run = 0.f;
#pragma unroll
  for (int r = 0; r < 8; ++r) {
    const int c = cgp * 8 + r;
    float z = bias;
#pragma unroll
    for (int j4 = 0; j4 < 4; ++j4) {
      const f32x4 gv = *reinterpret_cast<const f32x4*>(glr_s + c * 16 + j4 * 4);
#pragma unroll
      for (int j = 0; j < 4; ++j) z = fmaf(gv[j], gu[j4 * 4 + j], z);
    }
    float la = (fminf(z, 0.f) - __logf(1.f + __expf(-fabsf(z)))) * 0.0625f;
    run += la; v[r] = run;
  }
  segtot[cgp * 64 + d] = run;
  __syncthreads();
  float off = 0.f;
#pragma unroll
  for (int g = 0; g < 8; ++g) off += (g < cgp) ? segtot[g * 64 + d] : 0.f;
#pragma unroll
  for (int r = 0; r < 8; ++r) bc[(cgp * 8 + r) * 64 + d] = off + v[r];
  __syncthreads();
}

DI void gla_g1_item(const Params& p, int item, char* smem) {
  float* bc = (float*)smem;
  float* glr_s = (float*)(smem + 16384);
  float* segtot = (float*)(smem + 20480);
  u16* KeT = (u16*)(smem + 22528);
  const int b = item >> 8, h = (item >> 6) & 3, n = item & 63;
  const u16* tm = (const u16*)(p.ws + OFF_TM);
  const u16* gvT = (const u16*)(p.ws + OFF_GVT);
  const int tid = threadIdx.x, lane = tid & 63, wave = tid >> 6, lr = lane & 31, lh = lane >> 5;
  const int tok0 = b * S_ + n * 64;
  u16 kraw[8];
  {
    const int d = tid & 63, cgp = tid >> 6;
#pragma unroll
    for (int r = 0; r < 8; ++r) kraw[r] = tm[(size_t)(tok0 + cgp * 8 + r) * TMW + TM_GK + h * 64 + d];
  }
  bf16x8 afr[4];
  {
    const int et = wave & 3;
    const u16* arow = gvT + ((size_t)b * 512 + h * 128 + et * 32 + lr) * 4096 + n * 64 + lh * 8;
#pragma unroll
    for (int ks = 0; ks < 4; ++ks) afr[ks] = ldg8(arow + ks * 16);
  }
  gla_bcum(p, b, h, n, bc, glr_s, segtot);
  {
    const int d = tid & 63, cgp = tid >> 6;
    const float blast = bc[63 * 64 + d];
    {
      float* bcg = (float*)(p.ws + OFF_BCG) + (size_t)item * 4096;
#pragma unroll
      for (int r = 0; r < 8; ++r) bcg[(cgp * 8 + r) * 64 + d] = bc[(cgp * 8 + r) * 64 + d];
    }
    float f[8];
#pragma unroll
    for (int r = 0; r < 8; ++r) {
      const int c = cgp * 8 + r;
      float kv = bf2f(kraw[r]);
      f[r] = kv * __expf(blast - bc[c * 64 + d]);
    }
    *reinterpret_cast<bf16x8*>(KeT + d * 72 + cgp * 8) = pack8(f[0], f[1], f[2], f[3], f[4], f[5], f[6], f[7]);
    if (cgp == 0) ((float*)(p.ws + OFF_DECAY))[item * 64 + d] = __expf(blast);
  }
  __syncthreads();
  {
    const int et = wave & 3, dtl = wave >> 2;
    f32x16 acc = zero16();
#pragma unroll
    for (int ks = 0; ks < 4; ++ks) {
      bf16x8 a = afr[ks];
      bf16x8 bb = *reinterpret_cast<const bf16x8*>(KeT + (dtl * 32 + lr) * 72 + ks * 16 + lh * 8);
      acc = MFMA(a, bb, acc);
    }
    float* kvT = (float*)(p.ws + OFF_KVT);
#pragma unroll
    for (int i = 0; i < 16; ++i) kvT[((size_t)item * 128 + et * 32 + crow(i, lh)) * 64 + dtl * 32 + lr] = acc[i];
  }
  __syncthreads();
}

DI void gla_scan(const Params& p) {
  const float* kvT = (const float*)(p.ws + OFF_KVT);
  const float* decay = (const float*)(p.ws + OFF_DECAY);
  u16* prev = (u16*)(p.ws + OFF_PREV);
  const int gtid = blockIdx.x * blockDim.x + threadIdx.x;
  const int gn = gridDim.x * blockDim.x;
  for (int u = gtid; u < 32 * 2048; u += gn) {
    const int bh = u >> 11, rem = u & 2047, e = rem >> 4, d4 = (rem & 15) * 4;
    f32x4 st = {0.f, 0.f, 0.f, 0.f};
#pragma unroll 4
    for (int n = 0; n < 64; ++n) {
      const int item = bh * 64 + n;
      st4bf(prev + ((size_t)item * 128 + e) * 64 + d4, st[0], st[1], st[2], st[3]);
      f32x4 dc = *reinterpret_cast<const f32x4*>(decay + item * 64 + d4);
      f32x4 kv = *reinterpret_cast<const f32x4*>(kvT + ((size_t)item * 128 + e) * 64 + d4);
      st = dc * st + kv;
    }
  }
}

DI void gla_g3_item(const Params& p, int item, char* smem) {
  float* red = (float*)smem;
  const int b = item >> 8, h = (item >> 6) & 3, n = item & 63;
  const u16* tm = (const u16*)(p.ws + OFF_TM);
  const u16* gvT = (const u16*)(p.ws + OFF_GVT);
  const u16* prev = (const u16*)(p.ws + OFF_PREV);
  const float* bcg = (const float*)(p.ws + OFF_BCG) + (size_t)item * 4096;
  const int tid = threadIdx.x, lane = tid & 63, wave = tid >> 6, lr = lane & 31, lh = lane >> 5;
  const int tok0 = b * S_ + n * 64;
  const int et = wave & 3, ct = wave >> 2;
  bf16x8 qraw[4], kraw[2][4], sfr[4];
  bf16x4 vlo[2][2], vhi[2][2];
  f32x4 bq[4][2];
  {
    const u16* vrow0 = gvT + ((size_t)b * 512 + h * 128 + et * 32 + lr) * 4096 + n * 64 + 4 * lh;
    const u16* srow0 = prev + ((size_t)item * 128 + et * 32 + lr) * 64 + lh * 8;
#pragma unroll
    for (int ks = 0; ks < 4; ++ks) {
      qraw[ks] = ldg8(tm + (size_t)(tok0 + ct * 32 + lr) * TMW + TM_GQ + h * 64 + ks * 16 + lh * 8);
      kraw[0][ks] = ldg8(tm + (size_t)(tok0 + lr) * TMW + TM_GK + h * 64 + ks * 16 + lh * 8);
      kraw[1][ks] = ldg8(tm + (size_t)(tok0 + ct * 32 + lr) * TMW + TM_GK + h * 64 + ks * 16 + lh * 8);
      sfr[ks] = ldg8(srow0 + ks * 16);
      bq[ks][0] = *reinterpret_cast<const f32x4*>(bcg + (ct * 32 + lr) * 64 + ks * 16 + lh * 8);
      bq[ks][1] = *reinterpret_cast<const f32x4*>(bcg + (ct * 32 + lr) * 64 + ks * 16 + lh * 8 + 4);
    }
#pragma unroll
    for (int st = 0; st < 2; ++st)
#pragma unroll
      for (int s2 = 0; s2 < 2; ++s2) {
        const u16* vp = vrow0 + (st * ct) * 32 + 16 * s2;
        vlo[st][s2] = *reinterpret_cast<const bf16x4*>(vp);
        vhi[st][s2] = *reinterpret_cast<const bf16x4*>(vp + 8);
      }
  }
  bf16x8 Qd[4];
#pragma unroll
  for (int ks = 0; ks < 4; ++ks) {
    float f[8];
#pragma unroll
    for (int j = 0; j < 8; ++j) f[j] = bf2f((u16)qraw[ks][j]) * 0.125f * __expf(bq[ks][j >> 2][j & 3]);
    Qd[ks] = pack8(f[0], f[1], f[2], f[3], f[4], f[5], f[6], f[7]);
  }
  f32x16 O = zero16();
#pragma unroll
  for (int st = 0; st < 2; ++st) {
    if (st <= ct) {
      f32x16 A = zero16();
      const int s = st * 32 + lr;
#pragma unroll
      for (int ks = 0; ks < 4; ++ks) {
        f32x4 b0 = (st == 1) ? bq[ks][0] : *reinterpret_cast<const f32x4*>(bcg + s * 64 + ks * 16 + lh * 8);
        f32x4 b1 = (st == 1) ? bq[ks][1] : *reinterpret_cast<const f32x4*>(bcg + s * 64 + ks * 16 + lh * 8 + 4);
        float f[8];
#pragma unroll
        for (int j = 0; j < 8; ++j) f[j] = bf2f((u16)kraw[st][ks][j]) * __expf(-((j < 4) ? b0[j & 3] : b1[j & 3]));
        bf16x8 Ki = pack8(f[0], f[1], f[2], f[3], f[4], f[5], f[6], f[7]);
        A = MFMA(Ki, Qd[ks], A);
      }
      float pv[16];
#pragma unroll
      for (int i = 0; i < 16; ++i) pv[i] = (st * 32 + crow(i, lh) <= ct * 32 + lr) ? A[i] : 0.f;
#pragma unroll
      for (int s2 = 0; s2 < 2; ++s2) {
        bf16x8 Pf = pack8(pv[8 * s2], pv[8 * s2 + 1], pv[8 * s2 + 2], pv[8 * s2 + 3], pv[8 * s2 + 4], pv[8 * s2 + 5], pv[8 * s2 + 6], pv[8 * s2 + 7]);
        O = MFMA(cat44(vlo[st][s2], vhi[st][s2]), Pf, O);
      }
    }
  }
#pragma unroll
  for (int ks = 0; ks < 4; ++ks) O = MFMA(sfr[ks], Qd[ks], O);
  float ss = 0.f;
#pragma unroll
  for (int i = 0; i < 16; ++i) ss += O[i] * O[i];
  ss += __shfl_xor(ss, 32);
  if (lh == 0) red[(ct * 4 + et) * 32 + lr] = ss;
  __syncthreads();
  const float tot = red[(ct * 4 + 0) * 32 + lr] + red[(ct * 4 + 1) * 32 + lr] + red[(ct * 4 + 2) * 32 + lr] + red[(ct * 4 + 3) * 32 + lr];
  const float rinv = rsqrtf(tot * (1.f / 128.f) + 1e-6f);
  const int tok = tok0 + ct * 32 + lr;
  u16* y = (u16*)(p.ws + OFF_XB);
#pragma unroll
  for (int g = 0; g < 4; ++g) {
    const int e0 = et * 32 + 8 * g + 4 * lh;
    u32x2 gr = *reinterpret_cast<const u32x2*>(tm + (size_t)tok * TMW + TM_GR + h * 128 + e0);
    f32x4 ng = *reinterpret_cast<const f32x4*>(p.norm_g + e0);
    float grv[4] = {bflo(gr[0]), bfhi(gr[0]), bflo(gr[1]), bfhi(gr[1])};
    float o[4];
#pragma unroll
    for (int r = 0; r < 4; ++r) {
      float sl = grv[r] / (1.f + __expf(-grv[r]));
      o[r] = O[4 * g + r] * rinv * ng[r] * sl;
    }
    st4bf(y + (size_t)tok * 1024 + 512 + h * 128 + e0, o[0], o[1], o[2], o[3]);
  }
  __syncthreads();
}

template <int MODE>
DI void phase_gemm(const Params& p, const u16* X, const u16* Wt, int N, const float* resid, float* outf, u16* outb, int ldo, char* smem) {
  const int ntn = N / 128;
  const int tid = threadIdx.x, lane = tid & 63, wave = tid >> 6;
  const int fw = wave & 1, tq = wave >> 1, lr = lane & 31, lh = lane >> 5;
  const int xg = blockIdx.x & 7, xi = blockIdx.x >> 3, xn = gridDim.x >> 3;
  const int per_group = 16 * ntn;
  for (int u = xi; u < per_group; u += xn) {
    const int mt = xg + 8 * (u / ntn), nt = u % ntn;
    f32x16 acc[2][2];
    gemm_tile(X + (size_t)mt * 256 * 1024, 1024, Wt + (size_t)nt * 128 * 1024, 1024, 1024, smem, acc);
    if (MODE == 0 || MODE == 1) {
      float* wl = (float*)(smem + wave * 17408);
#pragma unroll
      for (int tt = 0; tt < 2; ++tt)
#pragma unroll
        for (int ft = 0; ft < 2; ++ft)
#pragma unroll
          for (int g = 0; g < 4; ++g) {
            f32x4 v = {acc[ft][tt][4 * g], acc[ft][tt][4 * g + 1], acc[ft][tt][4 * g + 2], acc[ft][tt][4 * g + 3]};
            *reinterpret_cast<f32x4*>(wl + (tt * 32 + lr) * 68 + ft * 32 + 8 * g + 4 * lh) = v;
          }
      const int ch = lane & 15, r0 = lane >> 4;
      const int f = nt * 128 + fw * 64 + ch * 4;
#pragma unroll 4
      for (int k = 0; k < 16; ++k) {
        const int row = r0 + 4 * k;
        const int tok = mt * 256 + tq * 64 + row;
        f32x4 v = *reinterpret_cast<const f32x4*>(wl + row * 68 + ch * 4);
        if (MODE == 0) {
          f32x4 r = *reinterpret_cast<const f32x4*>(resid + (size_t)tok * 1024 + f);
          f32x4 o;
#pragma unroll
          for (int j = 0; j < 4; ++j) o[j] = ALPHA * r[j] + v[j];
          *reinterpret_cast<f32x4*>(outf + (size_t)tok * 1024 + f) = o;
        } else {
          st4bf(outb + (size_t)tok * ldo + f, v[0], v[1], v[2], v[3]);
        }
      }
      __syncthreads();
    } else {
#pragma unroll
      for (int tt = 0; tt < 2; ++tt) {
        const int tok = mt * 256 + tq * 64 + tt * 32 + lr;
#pragma unroll
        for (int ft = 0; ft < 2; ++ft)
#pragma unroll
          for (int g = 0; g < 4; ++g) {
            const int f = nt * 128 + fw * 64 + ft * 32 + 8 * g + 4 * lh;
            if (MODE == 2) {
              const int hh = f >> 8, fh = f & 255, ks = fh >> 4, lane2 = ((fh >> 3) & 1) * 32 + lr;
              st4bf(outb + ((((size_t)(tok >> 5) * 4 + hh) * 16 + ks) * 64 + lane2) * 8 + 4 * lh, acc[ft][tt][4 * g], acc[ft][tt][4 * g + 1], acc[ft][tt][4 * g + 2], acc[ft][tt][4 * g + 3]);
            } else {
              const int hh = f >> 8, fq = f & 127, half = (f >> 7) & 1, ks = fq >> 4, lane2 = ((fq >> 3) & 1) * 32 + lr;
              st4bf(outb + (((((size_t)(tok >> 5) * 8 + hh) * 2 + half) * 8 + ks) * 64 + lane2) * 8 + 4 * lh, acc[ft][tt][4 * g], acc[ft][tt][4 * g + 1], acc[ft][tt][4 * g + 2], acc[ft][tt][4 * g + 3]);
            }
          }
      }
    }
  }
}

DI void phase_ln(const Params& p, float* h, u16* hb, const float* g, const float* bta) {
  const int lane = threadIdx.x & 63;
  const int xg = blockIdx.x & 7, xw = (blockIdx.x >> 3) * 8 + (threadIdx.x >> 6), xnw = (gridDim.x >> 3) * 8;
  for (int lrw = xw; lrw < 4096; lrw += xnw) {
    const int row = (xg + 8 * (lrw >> 8)) * 256 + (lrw & 255);
    float* r = h + (size_t)row * 1024;
    f32x4 v[4]; float s = 0.f;
#pragma unroll
    for (int c = 0; c < 4; ++c) { v[c] = *reinterpret_cast<const f32x4*>(r + c * 256 + lane * 4); s += v[c][0] + v[c][1] + v[c][2] + v[c][3]; }
    const float mean = wave_sum(s) * (1.f / 1024.f);
    float q = 0.f;
#pragma unroll
    for (int c = 0; c < 4; ++c)
#pragma unroll
      for (int k = 0; k < 4; ++k) { float d = v[c][k] - mean; q += d * d; }
    const float rstd = rsqrtf(wave_sum(q) * (1.f / 1024.f) + 1e-5f);
#pragma unroll
    for (int c = 0; c < 4; ++c) {
      f32x4 gg = *reinterpret_cast<const f32x4*>(g + c * 256 + lane * 4);
      f32x4 bb = *reinterpret_cast<const f32x4*>(bta + c * 256 + lane * 4);
      f32x4 o;
#pragma unroll
      for (int k = 0; k < 4; ++k) o[k] = (v[c][k] - mean) * rstd * gg[k] + bb[k];
      *reinterpret_cast<f32x4*>(r + c * 256 + lane * 4) = o;
      st4bf(hb + (size_t)row * 1024 + c * 256 + lane * 4, o[0], o[1], o[2], o[3]);
    }
  }
}

DI void phase_xattn(const Params& p) {
  const u16* qx = (const u16*)(p.ws + OFF_QX);
  const u16* mk = (const u16*)(p.ws + OFF_MEMK);
  const u16* mv = (const u16*)(p.ws + OFF_MEMVT);
  u16* ox = (u16*)(p.ws + OFF_OX);
  const int lane = threadIdx.x & 63, lr = lane & 31, lh = lane >> 5;
  const int xg = blockIdx.x & 7, xw = (blockIdx.x >> 3) * 8 + (threadIdx.x >> 6), xnw = (gridDim.x >> 3) * 8;
  for (int li = xw; li < 512; li += xnw) {
    const int qtl = li & 15, h = (li >> 4) & 3, b = li >> 6;
    const int qt = (xg + 8 * (qtl >> 3)) * 8 + (qtl & 7);
    const int tok = b * S_ + qt * 32 + lr;
    f32x16 Sx[8];
#pragma unroll
    for (int kt = 0; kt < 8; ++kt) Sx[kt] = zero16();
    const u16* qrow = qx + (((size_t)(b * 128 + qt) * 4 + h) * 16) * 512 + lane * 8;
    const u16* krow = mk + (((size_t)(b * 4 + h) * 8) * 16) * 512 + lane * 8;
#pragma unroll 2
    for (int ks = 0; ks < 16; ++ks) {
      bf16x8 qf = ldg8(qrow + ks * 512);
#pragma unroll
      for (int kt = 0; kt < 8; ++kt) Sx[kt] = MFMA(ldg8(krow + (kt * 16 + ks) * 512), qf, Sx[kt]);
    }
    float mx = -INFINITY;
#pragma unroll
    for (int kt = 0; kt < 8; ++kt)
#pragma unroll
      for (int i = 0; i < 16; ++i) mx = fmaxf(mx, Sx[kt][i]);
    mx = fmaxf(mx, __shfl_xor(mx, 32));
    float ls = 0.f;
    bf16x8 Pf[8][2];
#pragma unroll
    for (int kt = 0; kt < 8; ++kt) {
      float pv[16];
#pragma unroll
      for (int i = 0; i < 16; ++i) { pv[i] = __expf((Sx[kt][i] - mx) * 0.0625f); ls += pv[i]; }
#pragma unroll
      for (int s = 0; s < 2; ++s) Pf[kt][s] = pack8(pv[8 * s], pv[8 * s + 1], pv[8 * s + 2], pv[8 * s + 3], pv[8 * s + 4], pv[8 * s + 5], pv[8 * s + 6], pv[8 * s + 7]);
    }
    ls += __shfl_xor(ls, 32);
    const float inv = 1.f / ls;
#pragma unroll 1
    for (int dt = 0; dt < 8; ++dt) {
      f32x16 o = zero16();
      const u16* vrow = mv + ((((size_t)(b * 4 + h) * 8 + dt) * 8) * 2) * 512 + lane * 8;
#pragma unroll
      for (int kt = 0; kt < 8; ++kt)
#pragma unroll
        for (int s = 0; s < 2; ++s) o = MFMA(ldg8(vrow + (kt * 2 + s) * 512), Pf[kt][s], o);
#pragma unroll
      for (int g = 0; g < 4; ++g)
        st4bf(ox + (size_t)tok * 1024 + h * 256 + dt * 32 + 8 * g + 4 * lh, o[4 * g] * inv, o[4 * g + 1] * inv, o[4 * g + 2] * inv, o[4 * g + 3] * inv);
    }
  }
}

DI void peer_topk_item(const Params& p, int tt128, int head, char* smem) {
  float* sc = (float*)smem;
  float* topv = (float*)(smem + 132096);
  unsigned char* topi = (unsigned char*)(smem + 132096 + 16384);
  const u16* pq = (const u16*)(p.ws + OFF_QX);
  const u16* sk = (const u16*)(p.ws + OFF_SK);
  const int tid = threadIdx.x, lane = tid & 63, wave = tid >> 6, lr = lane & 31, lh = lane >> 5;
  const int tok0 = tt128 * 128;
  {
    const int half = wave >> 2, kt = wave & 3;
    bf16x8 af[8];
#pragma unroll
    for (int ks = 0; ks < 8; ++ks) af[ks] = ldg8(sk + (size_t)half * 16384 + (kt * 32 + lr) * 128 + ks * 16 + lh * 8);
#pragma unroll 1
    for (int tt = 0; tt < 4; ++tt) {
      f32x16 acc = zero16();
      const u16* brow = pq + (((((size_t)(tok0 >> 5) + tt) * 8 + head) * 2 + half) * 8) * 512 + lane * 8;
#pragma unroll
      for (int ks = 0; ks < 8; ++ks) acc = MFMA(af[ks], ldg8(brow + ks * 512), acc);
#pragma unroll
      for (int i = 0; i < 16; ++i) sc[(half * 128 + tt * 32 + lr) * 129 + kt * 32 + crow(i, lh)] = acc[i];
    }
  }
  __syncthreads();
  if (tid < 256) {
    float* row = sc + tid * 129;
    float gm[8]; int gi[8];
#pragma unroll
    for (int g = 0; g < 8; ++g) {
      float m = -INFINITY; int mi = g * 16;
#pragma unroll
      for (int j = 0; j < 16; ++j) { float v = row[g * 16 + j]; if (v > m) { m = v; mi = g * 16 + j; } }
      gm[g] = m; gi[g] = mi;
    }
#pragma unroll 1
    for (int r = 0; r < 16; ++r) {
      float best = gm[0]; int bg = 0; int bi = gi[0];
#pragma unroll
      for (int g = 1; g < 8; ++g) if (gm[g] > best) { best = gm[g]; bg = g; bi = gi[g]; }
      topv[tid * 16 + r] = best; topi[tid * 16 + r] = (unsigned char)bi;
      row[bi] = -INFINITY;
      float m = -INFINITY; int mi = bg * 16;
#pragma unroll
      for (int j = 0; j < 16; ++j) { float v = row[bg * 16 + j]; if (v > m) { m = v; mi = bg * 16 + j; } }
#pragma unroll
      for (int g = 0; g < 8; ++g) { gm[g] = (g == bg) ? m : gm[g]; gi[g] = (g == bg) ? mi : gi[g]; }
    }
  }
  __syncthreads();
  if (tid < 128) {
    const float* av = topv + tid * 16;
    const float* bv = topv + (128 + tid) * 16;
    const unsigned char* ai = topi + tid * 16;
    const unsigned char* bi_ = topi + (128 + tid) * 16;
    float cur[16]; int pp[16];
    const float b0 = bv[0];
#pragma unroll
    for (int i = 0; i < 16; ++i) { cur[i] = av[i] + b0; pp[i] = 0; }
    float sel[16]; int eid[16];
#pragma unroll
    for (int r = 0; r < 16; ++r) {
      float best = cur[0]; int bi = 0; int bj = pp[0];
#pragma unroll
      for (int i = 1; i < 16; ++i) if (cur[i] > best) { best = cur[i]; bi = i; bj = pp[i]; }
      sel[r] = best;
      eid[r] = (int)ai[bi] * 128 + (int)bi_[bj];
      const int nj = bj + 1;
      const float nv = (nj < 16) ? (av[bi] + bv[nj & 15]) : -INFINITY;
#pragma unroll
      for (int i = 0; i < 16; ++i) { cur[i] = (i == bi) ? nv : cur[i]; pp[i] = (i == bi) ? nj : pp[i]; }
    }
    float sum = 0.f;
    const float smax = sel[0];
#pragma unroll
    for (int r = 0; r < 16; ++r) { sel[r] = __expf(sel[r] - smax); sum += sel[r]; }
    const float inv = 1.f / sum;
    int* eo = (int*)(p.ws + OFF_EIDX) + (size_t)(tok0 + tid) * 128 + head * 16;
    float* go = (float*)(p.ws + OFF_GATE) + (size_t)(tok0 + tid) * 128 + head * 16;
#pragma unroll
    for (int r = 0; r < 16; ++r) { eo[r] = eid[r]; go[r] = sel[r] * inv; }
  }
  __syncthreads();
}

DI float dot2bf(unsigned a, unsigned b, float c) {
  return __builtin_amdgcn_fdot2_f32_bf16(__builtin_bit_cast(bf2_t, a), __builtin_bit_cast(bf2_t, b), c, false);
}

DI float reduce8(float (&part)[8], int lane) {
  float r4[4], r2[2], r1;
#pragma unroll
  for (int k = 0; k < 4; ++k) {
    float send = (lane & 1) ? part[2 * k] : part[2 * k + 1];
    float keep = (lane & 1) ? part[2 * k + 1] : part[2 * k];
    r4[k] = keep + __shfl_xor(send, 1);
  }
#pragma unroll
  for (int k = 0; k < 2; ++k) {
    float send = (lane & 2) ? r4[2 * k] : r4[2 * k + 1];
    float keep = (lane & 2) ? r4[2 * k + 1] : r4[2 * k];
    r2[k] = keep + __shfl_xor(send, 2);
  }
  {
    float send = (lane & 4) ? r2[0] : r2[1];
    float keep = (lane & 4) ? r2[1] : r2[0];
    r1 = keep + __shfl_xor(send, 4);
  }
  r1 += __shfl_xor(r1, 8);
  r1 += __shfl_xor(r1, 16);
  r1 += __shfl_xor(r1, 32);
  return r1;
}

DI void phase_peer_down(const Params& p) {
  const char* exd = p.ws + OFF_EXD;
  const float* esc = (const float*)(p.ws + OFF_ESC);
  const u16* hb = (const u16*)(p.ws + OFF_HB);
  const int* eidx = (const int*)(p.ws + OFF_EIDX);
  const float* gate = (const float*)(p.ws + OFF_GATE);
  float* coefw = (float*)(p.ws + OFF_COEF);
  const int lane = threadIdx.x & 63;
  const int gw = (blockIdx.x * blockDim.x + threadIdx.x) >> 6;
  const int nw = (gridDim.x * blockDim.x) >> 6;
#pragma unroll 1
  for (int tok = gw; tok < T_; tok += nw) {
    float x[16];
    {
      const u16* xr = hb + (size_t)tok * 1024 + lane * 16;
      u32x4 a = *reinterpret_cast<const u32x4*>(xr);
      u32x4 c = *reinterpret_cast<const u32x4*>(xr + 8);
#pragma unroll
      for (int w = 0; w < 4; ++w) { x[2 * w] = bflo(a[w]); x[2 * w + 1] = bfhi(a[w]); x[8 + 2 * w] = bflo(c[w]); x[8 + 2 * w + 1] = bfhi(c[w]); }
    }
#pragma unroll 1
    for (int half = 0; half < 2; ++half) {
      const size_t slot = (size_t)tok * 128 + half * 64 + lane;
      const int ev = eidx[slot];
      const float gv = gate[slot];
      float racc = 0.f, gacc = 0.f;
#pragma unroll 1
      for (int bi = 0; bi < 8; ++bi) {
        u32x4 dr[8];
#pragma unroll
        for (int k = 0; k < 8; ++k) {
          const int er = __builtin_amdgcn_readlane(ev, bi * 8 + k);
          dr[k] = *reinterpret_cast<const u32x4*>(exd + (size_t)er * 1024 + lane * 16);
        }
        const int pmine = bi * 8 + (lane & 7);
        const int emine = __shfl(ev, pmine);
        const float gsel = __shfl(gv, pmine);
        const float sd = esc[emine];
        const float su = esc[16384 + emine];
        float part[8];
#pragma unroll
        for (int k = 0; k < 8; ++k) {
          float a0 = 0.f, a1 = 0.f;
#pragma unroll
          for (int w = 0; w < 4; ++w) {
            f2_t lo = __builtin_amdgcn_cvt_pk_f32_fp8((int)dr[k][w], false);
            f2_t hi = __builtin_amdgcn_cvt_pk_f32_fp8((int)dr[k][w], true);
            a0 = fmaf(lo[0], x[4 * w], a0); a1 = fmaf(lo[1], x[4 * w + 1], a1);
            a0 = fmaf(hi[0], x[4 * w + 2], a0); a1 = fmaf(hi[1], x[4 * w + 3], a1);
          }
          part[k] = a0 + a1;
        }
        const float r1 = reduce8(part, lane) * sd;
        const bool mine = (lane >> 3) == bi;
        racc = mine ? r1 : racc; gacc = mine ? gsel * su : gacc;
      }
      const float act = 0.5f * racc * (1.f + erff(racc * 0.70710678118654752f));
      coefw[slot] = gacc * act;
    }
  }
}

DI void phase_peer_ffn(const Params& p) {
  const char* exu = p.ws + OFF_EXU;
  const float* h = (const float*)(p.ws + OFF_H);
  const int* eidx = (const int*)(p.ws + OFF_EIDX);
  const float* coefw = (const float*)(p.ws + OFF_COEF);
  const int lane = threadIdx.x & 63;
  const int gw = (blockIdx.x * blockDim.x + threadIdx.x) >> 6;
  const int nw = (gridDim.x * blockDim.x) >> 6;
  for (int tok = gw; tok < T_; tok += nw) {
    float yacc[16];
#pragma unroll
    for (int i = 0; i < 16; ++i) yacc[i] = 0.f;
    const int e_lo = eidx[(size_t)tok * 128 + lane];
    const int e_hi = eidx[(size_t)tok * 128 + 64 + lane];
    const float c_lo = coefw[(size_t)tok * 128 + lane];
    const float c_hi = coefw[(size_t)tok * 128 + 64 + lane];
#pragma unroll 1
    for (int eb = 0; eb < 8; ++eb) {
      const int ev = (eb < 4) ? e_lo : e_hi;
      const float cv = (eb < 4) ? c_lo : c_hi;
      const int lbase = (eb & 3) * 16;
      u32x4 ur[16];
#pragma unroll
      for (int k = 0; k < 16; ++k) {
        const int er = __builtin_amdgcn_readlane(ev, lbase + k);
        ur[k] = *reinterpret_cast<const u32x4*>(exu + (size_t)er * 1024 + lane * 16);
      }
#pragma unroll
      for (int k = 0; k < 16; ++k) {
        const float ck = __int_as_float(__builtin_amdgcn_readlane(__float_as_int(cv), lbase + k));
#pragma unroll
        for (int w = 0; w < 4; ++w) {
          f2_t lo = __builtin_amdgcn_cvt_pk_f32_fp8((int)ur[k][w], false);
          f2_t hi = __builtin_amdgcn_cvt_pk_f32_fp8((int)ur[k][w], true);
          yacc[4 * w] = fmaf(ck, lo[0], yacc[4 * w]);
          yacc[4 * w + 1] = fmaf(ck, lo[1], yacc[4 * w + 1]);
          yacc[4 * w + 2] = fmaf(ck, hi[0], yacc[4 * w + 2]);
          yacc[4 * w + 3] = fmaf(ck, hi[1], yacc[4 * w + 3]);
        }
      }
    }
    const float* xr = h + (size_t)tok * 1024 + lane * 16;
    float v[16];
#pragma unroll
    for (int c = 0; c < 4; ++c) {
      f32x4 t = *reinterpret_cast<const f32x4*>(xr + c * 4);
#pragma unroll
      for (int k = 0; k < 4; ++k) v[4 * c + k] = ALPHA * t[k] + yacc[4 * c + k];
    }
    float s = 0.f;
#pragma unroll
    for (int i = 0; i < 16; ++i) s += v[i];
    const float mean = wave_sum(s) * (1.f / 1024.f);
    float q = 0.f;
#pragma unroll
    for (int i = 0; i < 16; ++i) { float d = v[i] - mean; q += d * d; }
    const float rstd = rsqrtf(wave_sum(q) * (1.f / 1024.f) + 1e-5f);
    float* orow = p.out + (size_t)tok * 1024 + lane * 16;
#pragma unroll
    for (int c = 0; c < 4; ++c) {
      f32x4 gg = *reinterpret_cast<const f32x4*>(p.ln_ffn_g + lane * 16 + c * 4);
      f32x4 bb = *reinterpret_cast<const f32x4*>(p.ln_ffn_b + lane * 16 + c * 4);
      f32x4 o;
#pragma unroll
      for (int k = 0; k < 4; ++k) o[k] = (v[4 * c + k] - mean) * rstd * gg[k] + bb[k];
      *reinterpret_cast<f32x4*>(orow + c * 4) = o;
    }
  }
}

constexpr size_t OFF_BAR = 166 * MiB;
DI void gbar(unsigned* ctr, unsigned target) {
  asm volatile("s_waitcnt vmcnt(0)" ::: "memory");
  __syncthreads();
  if (threadIdx.x == 0) {
    __builtin_amdgcn_fence(__ATOMIC_RELEASE, "agent");
    asm volatile("s_waitcnt vmcnt(0)" ::: "memory");
    __hip_atomic_fetch_add(ctr, 1u, __ATOMIC_RELAXED, __HIP_MEMORY_SCOPE_AGENT);
    while (__hip_atomic_load(ctr, __ATOMIC_RELAXED, __HIP_MEMORY_SCOPE_AGENT) < target) __builtin_amdgcn_s_sleep(2);
    __builtin_amdgcn_fence(__ATOMIC_ACQUIRE, "agent");
    asm volatile("s_waitcnt vmcnt(0)" ::: "memory");
  }
  __syncthreads();
}

#define XB_TMO      128
#define XB_XCNT(j)  (256  + 64 * (j))
#define XB_XSUB(j)  (1280 + 64 * (j))
#define XB_XGEN(j)  (2304 + 64 * (j))
#define XB_TOP      3328
#define XB_TOPGEN   3392
#define XCD_BAR_WORDS 3456
#define XB_SPIN_CAP (1u << 18)
#define LAS __attribute__((address_space(3)))
DI unsigned xb_ld(unsigned* p)              { return __hip_atomic_load(p, __ATOMIC_RELAXED, __HIP_MEMORY_SCOPE_AGENT); }
DI unsigned xb_add(unsigned* p, unsigned v) { return __hip_atomic_fetch_add(p, v, __ATOMIC_RELAXED, __HIP_MEMORY_SCOPE_AGENT); }
DI unsigned xb_xcc_id() { return (unsigned)__builtin_amdgcn_s_getreg((3 << 11) | 20) & 0xFu; }
#define XB_SPIN(cond, bar) do { unsigned _sp = 0; while (cond) { __builtin_amdgcn_s_sleep(1); \
    if ((++_sp & 255u) == 0u) { if (xb_ld(&(bar)[XB_TMO])) break; if (_sp > XB_SPIN_CAP) { atomicAdd(&(bar)[XB_TMO], 1u); break; } } } } while (0)
struct XcdBarrier { unsigned* bar; unsigned x; volatile LAS unsigned* st; };
DI XcdBarrier xcd_barrier_post(unsigned* bar, volatile LAS unsigned* st) {
  XcdBarrier b; b.bar = bar; b.x = xb_xcc_id(); b.st = st;
  if (threadIdx.x == 0) (void)xb_add(&bar[XB_XCNT(b.x)], 1u);
  return b;
}
DI void xcd_barrier_complete(unsigned* bar, unsigned x, unsigned& nloc, unsigned& nx) {
  const unsigned G = gridDim.x;
  unsigned sum, cnt, mine, sp = 0u;
  for (;;) {
    sum = 0u; cnt = 0u; mine = 0u;
#pragma unroll
    for (unsigned j = 0; j < 16; ++j) { const unsigned c = xb_ld(&bar[XB_XCNT(j)]); sum += c; cnt += (c > 0u) ? 1u : 0u; mine = (j == x) ? c : mine; }
    if (sum == G) break;
    __builtin_amdgcn_s_sleep(1);
    if ((++sp & 255u) == 0u) { if (xb_ld(&bar[XB_TMO])) break; if (sp > XB_SPIN_CAP) { atomicAdd(&bar[XB_TMO], 1u); break; } }
  }
  nloc = mine > 0u ? mine : 1u; nx = cnt > 0u ? cnt : 1u;
}
DI void xcd_barrier(const XcdBarrier& b) {
  asm volatile("s_waitcnt vmcnt(0)" ::: "memory");
  __syncthreads();
  if (threadIdx.x == 0) {
    unsigned* bar = b.bar;
    __builtin_amdgcn_s_waitcnt(0);
    unsigned nloc = b.st[0], nx = b.st[1];
    if (nloc == 0u) { xcd_barrier_complete(bar, b.x, nloc, nx); b.st[0] = nloc; b.st[1] = nx; }
    const unsigned old = xb_add(&bar[XB_XSUB(b.x)], 1u);
    const unsigned gen = old / nloc;
    if (old + 1u == (gen + 1u) * nloc) {
      __builtin_amdgcn_fence(__ATOMIC_RELEASE, "agent");
      asm volatile("s_waitcnt vmcnt(0)" ::: "memory");
      const unsigned og = xb_add(&bar[XB_TOP], 1u);
      const unsigned tg = og / nx;
      if (og + 1u == (tg + 1u) * nx) xb_add(&bar[XB_TOPGEN], 1u);
      else XB_SPIN(xb_ld(&bar[XB_TOPGEN]) == tg, bar);
      __builtin_amdgcn_fence(__ATOMIC_ACQUIRE, "agent");
      xb_add(&bar[XB_XGEN(b.x)], 1u);
      asm volatile("s_waitcnt vmcnt(0)" ::: "memory");
    } else {
      XB_SPIN(xb_ld(&bar[XB_XGEN(b.x)]) == gen, bar);
      __builtin_amdgcn_fence(__ATOMIC_ACQUIRE, "agent");
      asm volatile("s_waitcnt vmcnt(0)" ::: "memory");
    }
  }
  __syncthreads();
}

__global__ void __launch_bounds__(512) fwd_megakernel(Params p) {
  __shared__ __attribute__((aligned(1024))) char smem[155648];
  cg::grid_group grid = cg::this_grid();
  const int G = gridDim.x;
  char* ws = p.ws;
  unsigned* bar = (unsigned*)(ws + OFF_BAR);
  volatile LAS unsigned* xst = (volatile LAS unsigned*)(smem + 155648 - 16);
  if (threadIdx.x == 0) { xst[0] = 0u; xst[1] = 0u; }
  const XcdBarrier xb = xcd_barrier_post(bar, xst);

  phase_prep(p, smem);
  grid.sync();

  phase_inproj(p, smem);
  xcd_barrier(xb);

  for (int k = 0; k * G < 1024; ++k) {
    int j = (k & 1) ? (G - 1 - (int)blockIdx.x) : (int)blockIdx.x;
    int idx = k * G + j;
    if (idx < 1024) dsa_thr_item(p, idx & 7, 127 - (idx >> 3), smem);
  }
  for (int it = blockIdx.x; it < 2048; it += G) gla_g1_item(p, it, smem);
  xcd_barrier(xb);

  for (int k = 0; k * G < 1024; ++k) {
    int j = (k & 1) ? (G - 1 - (int)blockIdx.x) : (int)blockIdx.x;
    int idx = k * G + j;
    if (idx < 1024) dsa_attn_item(p, idx & 7, 127 - (idx >> 3), smem);
  }
  gla_scan(p);
  xcd_barrier(xb);

  for (int it = blockIdx.x; it < 2048; it += G) gla_g3_item(p, it, smem);
  xcd_barrier(xb);

  phase_gemm<0>(p, (const u16*)(ws + OFF_XB), (const u16*)(ws + OFF_WOUT), 1024, p.x, (float*)(ws + OFF_H), nullptr, 0, smem);
  xcd_barrier(xb);
  phase_ln(p, (float*)(ws + OFF_H), (u16*)(ws + OFF_HB), p.ln_mix_g, p.ln_mix_b);
  xcd_barrier(xb);

  phase_gemm<2>(p, (const u16*)(ws + OFF_HB), (const u16*)(ws + OFF_WQ), 1024, nullptr, nullptr, (u16*)(ws + OFF_QX), 1024, smem);
  xcd_barrier(xb);
  phase_xattn(p);
  xcd_barrier(xb);
  phase_gemm<0>(p, (const u16*)(ws + OFF_OX), (const u16*)(ws + OFF_WO), 1024, (const float*)(ws + OFF_H), (float*)(ws + OFF_H), nullptr, 0, smem);
  xcd_barrier(xb);
  phase_ln(p, (float*)(ws + OFF_H), (u16*)(ws + OFF_HB), p.ln_mem_g, p.ln_mem_b);
  xcd_barrier(xb);

  phase_gemm<5>(p, (const u16*)(ws + OFF_HB), (const u16*)(ws + OFF_WPQ), 2048, nullptr, nullptr, (u16*)(ws + OFF_QX), 2048, smem);
  xcd_barrier(xb);
  for (int it = blockIdx.x; it < 2048; it += G) peer_topk_item(p, it >> 3, it & 7, smem);
  xcd_barrier(xb);
  phase_peer_down(p);
  xcd_barrier(xb);
  phase_peer_ffn(p);
}

extern "C" void kernel_launch(void* const* d_in, const int* in_sizes, int n_in,
                              void* d_out, int out_size, void* d_ws, size_t ws_size,
                              hipStream_t stream) {
  static int grid_blocks = 0;
  if (!grid_blocks) {
    int dev = 0, cus = 0, per_cu = 0;
    (void)hipGetDevice(&dev);
    (void)hipDeviceGetAttribute(&cus, hipDeviceAttributeMultiprocessorCount, dev);
    (void)hipOccupancyMaxActiveBlocksPerMultiprocessor(&per_cu, fwd_megakernel, 512, 0);
    if (per_cu > 1) per_cu = 1;
    grid_blocks = cus * per_cu;
    if (grid_blocks > 256) grid_blocks = 256;
    if (ws_size < 512 * MiB) fprintf(stderr, "workspace too small: %zu\n", ws_size);
  }
  Params p{};
  p.x = (const float*)d_in[0]; p.positions = (const int*)d_in[1]; p.mem = (const float*)d_in[2]; p.w_in = (const float*)d_in[3];
  p.gate_up = (const float*)d_in[4]; p.gate_bias = (const float*)d_in[5]; p.norm_g = (const float*)d_in[6]; p.w_out = (const float*)d_in[7];
  p.ln_mix_g = (const float*)d_in[8]; p.ln_mix_b = (const float*)d_in[9];
  p.wq = (const float*)d_in[10]; p.wk = (const float*)d_in[11]; p.wv = (const float*)d_in[12]; p.wo = (const float*)d_in[13];
  p.ln_mem_g = (const float*)d_in[14]; p.ln_mem_b = (const float*)d_in[15];
  p.w_pq = (const float*)d_in[16]; p.sk1 = (const float*)d_in[17]; p.sk2 = (const float*)d_in[18];
  p.ex_down = (const float*)d_in[19]; p.ex_up = (const float*)d_in[20];
  p.ln_ffn_g = (const float*)d_in[21]; p.ln_ffn_b = (const float*)d_in[22];
  p.out = (float*)d_out; p.ws = (char*)d_ws;
  (void)hipMemsetAsync((char*)d_ws + OFF_BAR, 0, XCD_BAR_WORDS * sizeof(unsigned), stream);
  void* args[] = {&p};
  hipError_t e = hipLaunchCooperativeKernel((void*)fwd_megakernel, dim3(grid_blocks), dim3(512), args, 0, stream);
  if (e != hipSuccess) fprintf(stderr, "cooperative launch failed: %s (grid %d)\n", hipGetErrorString(e), grid_blocks);
}
```

```cpp
#include <hip/hip_runtime.h>
#include <hip/hip_cooperative_groups.h>
#include <cstdio>
#include <cmath>
namespace cg = cooperative_groups;

#define DI __device__ __forceinline__
typedef short bf16x8 __attribute__((ext_vector_type(8)));
typedef short bf16x4 __attribute__((ext_vector_type(4)));
typedef float f32x16 __attribute__((ext_vector_type(16)));
typedef float f32x4 __attribute__((ext_vector_type(4)));
typedef unsigned u32x4 __attribute__((ext_vector_type(4)));
typedef unsigned u32x2 __attribute__((ext_vector_type(2)));
typedef unsigned short u16;
typedef __bf16 bf2_t __attribute__((ext_vector_type(2)));
typedef float f2_t __attribute__((ext_vector_type(2)));

#define MFMA(a, b, c) __builtin_amdgcn_mfma_f32_32x32x16_bf16((a), (b), (c), 0, 0, 0)

constexpr int T_ = 32768;
constexpr int S_ = 4096;
constexpr int TMW = 2368;
constexpr int TM_Q = 0, TM_K = 512, TM_QI = 1024, TM_KI = 1280, TM_WI = 1312, TM_GLR = 1320, TM_GQ = 1344, TM_GK = 1600, TM_GR = 1856;
constexpr int PROJ_N = 3456;
constexpr float ALPHA = 1.189207115002721f;
constexpr size_t MiB = 1024 * 1024;

constexpr size_t OFF_XB = 0;
constexpr size_t OFF_EXD = 64 * MiB;
constexpr size_t OFF_EXU = 80 * MiB;
constexpr size_t OFF_BCG = 96 * MiB;
constexpr size_t OFF_WIN = 128 * MiB;
constexpr size_t OFF_WOUT = OFF_WIN + (size_t)PROJ_N * 1024 * 2;
constexpr size_t OFF_WQ = OFF_WOUT + 2 * MiB;
constexpr size_t OFF_WK = OFF_WQ + 2 * MiB;
constexpr size_t OFF_WV = OFF_WK + 2 * MiB;
constexpr size_t OFF_WO = OFF_WV + 2 * MiB;
constexpr size_t OFF_WPQ = OFF_WO + 2 * MiB;
constexpr size_t OFF_KIF = 149 * MiB;
constexpr size_t OFF_MEMB = 152 * MiB;
constexpr size_t OFF_MEMK = 156 * MiB;
constexpr size_t OFF_MEMVT = 160 * MiB;
constexpr size_t OFF_THR = 164 * MiB;
constexpr size_t OFF_SK = OFF_THR + 256 * 1024;
constexpr size_t OFF_DECAY = OFF_SK + 128 * 1024;
constexpr size_t OFF_ESC = 165 * MiB;
constexpr size_t OFF_TM = 168 * MiB;
constexpr size_t OFF_VT = 316 * MiB;
constexpr size_t OFF_KFR = 476 * MiB;
constexpr size_t OFF_GVT = 348 * MiB;
constexpr size_t OFF_KVT = 380 * MiB;
constexpr size_t OFF_PREV = 444 * MiB;
constexpr size_t OFF_H = 168 * MiB;
constexpr size_t OFF_HB = 296 * MiB;
constexpr size_t OFF_QX = 360 * MiB;
constexpr size_t OFF_OX = 424 * MiB;
constexpr size_t OFF_EIDX = 0;
constexpr size_t OFF_GATE = 16 * MiB;
constexpr size_t OFF_COEF = 32 * MiB;

struct Params {
  const float* x; const int* positions; const float* mem; const float* w_in;
  const float* gate_up; const float* gate_bias; const float* norm_g; const float* w_out;
  const float* ln_mix_g; const float* ln_mix_b;
  const float* wq; const float* wk; const float* wv; const float* wo;
  const float* ln_mem_g; const float* ln_mem_b;
  const float* w_pq; const float* sk1; const float* sk2; const float* ex_down; const float* ex_up;
  const float* ln_ffn_g; const float* ln_ffn_b;
  float* out; char* ws;
};

DI unsigned pk_bf16(float a, float b) {
  f2_t v = {a, b};
  bf2_t r = __builtin_convertvector(v, bf2_t);
  return __builtin_bit_cast(unsigned, r);
}
DI u16 f2bf(float a) { return (u16)(pk_bf16(a, 0.f) & 0xffffu); }
DI float bf2f(u16 u) { return __uint_as_float(((unsigned)u) << 16); }
DI float bflo(unsigned u) { return __uint_as_float(u << 16); }
DI float bfhi(unsigned u) { return __uint_as_float(u & 0xffff0000u); }
DI int crow(int i, int h) { return (i & 3) + 8 * (i >> 2) + 4 * h; }
DI bf16x8 ldg8(const u16* p) { return *reinterpret_cast<const bf16x8*>(p); }
DI bf16x8 pack8(float a0, float a1, float a2, float a3, float a4, float a5, float a6, float a7) {
  u32x4 r; r[0] = pk_bf16(a0, a1); r[1] = pk_bf16(a2, a3); r[2] = pk_bf16(a4, a5); r[3] = pk_bf16(a6, a7);
  return __builtin_bit_cast(bf16x8, r);
}
DI bf16x8 cat44(bf16x4 lo, bf16x4 hi) { return __builtin_shufflevector(lo, hi, 0, 1, 2, 3, 4, 5, 6, 7); }
DI void st4bf(u16* p, float a, float b, float c, float d) {
  u32x2 v; v[0] = pk_bf16(a, b); v[1] = pk_bf16(c, d);
  *reinterpret_cast<u32x2*>(p) = v;
}
DI float wave_sum(float v) {
#pragma unroll
  for (int d = 32; d >= 1; d >>= 1) v += __shfl_xor(v, d);
  return v;
}
DI void sincos_rad(float ang, float& s, float& c) {
  constexpr float C_hi = (float)0.15915494309189535;
  constexpr float C_lo = (float)(0.15915494309189535 - (double)C_hi);
  float k = rintf(ang * C_hi);
  float f = fmaf(ang, C_hi, -k);
  f = fmaf(ang, C_lo, f);
  s = __builtin_amdgcn_sinf(f);
  c = __builtin_amdgcn_cosf(f);
}
DI unsigned fkey(float s) {
  const unsigned u = __float_as_uint(s);
  return u ^ ((unsigned)((int)u >> 31) | 0x80000000u);
}
DI f32x16 zero16() { f32x16 z; for (int i = 0; i < 16; ++i) z[i] = 0.f; return z; }

DI int win_src_col(int n) {
  if (n < 1832) return n;
  if (n < 1848) return 2856 + (n - 1832);
  if (n < 1856) return -1;
  if (n < 2880) return n - 24;
  if (n < 3392) return n - 8;
  return -1;
}

DI void cvt_stream(const float* __restrict__ src, u16* __restrict__ dst, size_t n, size_t gtid, size_t gn) {
  size_t n8 = n / 8;
  for (size_t i = gtid; i < n8; i += gn) {
    f32x4 a = *reinterpret_cast<const f32x4*>(src + i * 8);
    f32x4 b = *reinterpret_cast<const f32x4*>(src + i * 8 + 4);
    u32x4 r; r[0] = pk_bf16(a[0], a[1]); r[1] = pk_bf16(a[2], a[3]); r[2] = pk_bf16(b[0], b[1]); r[3] = pk_bf16(b[2], b[3]);
    *reinterpret_cast<u32x4*>(dst + i * 8) = r;
  }
}

template <bool MAPPED>
DI void transpose_tile(const float* __restrict__ W, int ldn, u16* __restrict__ Wt, int k0, int n0, float* tile) {
  const int tid = threadIdx.x;
  {
    int nn = n0 + (tid & 63);
    int c = MAPPED ? win_src_col(nn) : nn;
#pragma unroll
    for (int rr = 0; rr < 8; ++rr) {
      int kk = (tid >> 6) + 8 * rr;
      float v = (c >= 0) ? W[(size_t)(k0 + kk) * ldn + c] : 0.f;
      tile[kk * 65 + (tid & 63)] = v;
    }
  }
  __syncthreads();
#pragma unroll
  for (int rr = 0; rr < 8; ++rr) {
    int nn = (tid >> 6) + 8 * rr;
    int kk = tid & 63;
    Wt[(size_t)(n0 + nn) * 1024 + k0 + kk] = f2bf(tile[kk * 65 + nn]);
  }
  __syncthreads();
}

DI void phase_prep(const Params& p, char* smem) {
  const size_t gtid = (size_t)blockIdx.x * blockDim.x + threadIdx.x;
  const size_t gn = (size_t)gridDim.x * blockDim.x;
  char* ws = p.ws;
  cvt_stream(p.x, (u16*)(ws + OFF_XB), (size_t)T_ * 1024, gtid, gn);
  cvt_stream(p.mem, (u16*)(ws + OFF_MEMB), (size_t)2048 * 1024, gtid, gn);
  {
    const int lane = threadIdx.x & 63;
    const int gw = (int)(gtid >> 6), nw = (int)(gn >> 6);
    for (int r = gw; r < 2 * 16384; r += nw) {
      const int tbl = r >> 14, row = r & 16383;
      const float* src = (tbl ? p.ex_up : p.ex_down) + (size_t)row * 1024 + lane * 16;
      f32x4 v[4]; float mx = 0.f;
#pragma unroll
      for (int c = 0; c < 4; ++c) {
        v[c] = *reinterpret_cast<const f32x4*>(src + c * 4);
#pragma unroll
        for (int k = 0; k < 4; ++k) mx = fmaxf(mx, fabsf(v[c][k]));
      }
#pragma unroll
      for (int d = 32; d >= 1; d >>= 1) mx = fmaxf(mx, __shfl_xor(mx, d));
      float sc = (mx > 0.f) ? exp2f(floorf(log2f(224.f / mx))) : 1.f;
      u32x4 o;
#pragma unroll
      for (int c = 0; c < 4; ++c) {
        int t = __builtin_amdgcn_cvt_pk_fp8_f32(v[c][0] * sc, v[c][1] * sc, 0, false);
        t = __builtin_amdgcn_cvt_pk_fp8_f32(v[c][2] * sc, v[c][3] * sc, t, true);
        o[c] = (unsigned)t;
      }
      *reinterpret_cast<u32x4*>(ws + (tbl ? OFF_EXU : OFF_EXD) + (size_t)row * 1024 + lane * 16) = o;
      if (lane == 0) ((float*)(ws + OFF_ESC))[r] = 1.f / sc;
    }
  }
  cvt_stream(p.sk1, (u16*)(ws + OFF_SK), (size_t)128 * 128, gtid, gn);
  cvt_stream(p.sk2, (u16*)(ws + OFF_SK) + 128 * 128, (size_t)128 * 128, gtid, gn);
  float* tile = (float*)smem;
  const int n_win = 54 * 16, n_sq = 256, n_pq = 512;
  const int total = n_win + 5 * n_sq + n_pq;
  for (int t = blockIdx.x; t < total; t += gridDim.x) {
    if (t < n_win) {
      transpose_tile<true>(p.w_in, 3384, (u16*)(ws + OFF_WIN), (t & 15) * 64, (t >> 4) * 64, tile);
    } else if (t < n_win + 5 * n_sq) {
      int u = t - n_win; int which = u >> 8; int r = u & 255;
      const float* W = which == 0 ? p.w_out : which == 1 ? p.wq : which == 2 ? p.wk : which == 3 ? p.wv : p.wo;
      size_t off = which == 0 ? OFF_WOUT : which == 1 ? OFF_WQ : which == 2 ? OFF_WK : which == 3 ? OFF_WV : OFF_WO;
      transpose_tile<false>(W, 1024, (u16*)(ws + off), (r & 15) * 64, (r >> 4) * 64, tile);
    } else {
      int r = t - n_win - 5 * n_sq;
      transpose_tile<false>(p.w_pq, 2048, (u16*)(ws + OFF_WPQ), (r & 15) * 64, (r >> 4) * 64, tile);
    }
  }
}

#define WAIT_V(n) asm volatile("s_waitcnt vmcnt(%0)" ::"n"(n) : "memory")
#define RAW_BARRIER() do { asm volatile("s_waitcnt lgkmcnt(0)" ::: "memory"); __builtin_amdgcn_s_barrier(); asm volatile("" ::: "memory"); } while (0)
constexpr int G_STAGE = 384 * 128;
DI void gemm_tile(const u16* __restrict__ X, int ldx, const u16* __restrict__ Wt, int ldw, int K, char* smem,
                  f32x16 (&acc)[2][2]) {
  const int tid = threadIdx.x, lane = tid & 63, wave = tid >> 6;
  const int fw = wave & 1, tq = wave >> 1, lr = lane & 31, lh = lane >> 5;
#pragma unroll
  for (int a = 0; a < 2; ++a)
#pragma unroll
    for (int b = 0; b < 2; ++b) acc[a][b] = zero16();
  const int nk = K / 64;
  const u16* src[6];
#pragma unroll
  for (int i = 0; i < 6; ++i) {
    const int R = 8 * (wave + 8 * i) + (lane >> 3);
    const int c = (lane & 7) ^ ((R >> 1) & 7);
    src[i] = (i < 4) ? (X + (size_t)R * ldx + c * 8) : (Wt + (size_t)(R - 256) * ldw + c * 8);
  }
#define GLDS_STAGE(slot, kt) do { _Pragma("unroll") for (int i = 0; i < 6; ++i) \
    __builtin_amdgcn_global_load_lds((const unsigned*)(src[i] + (kt) * 64), (__attribute__((address_space(3))) unsigned*)(smem + (slot) * G_STAGE + (wave + 8 * i) * 1024), 16, 0, 0); } while (0)
  int offA[2], offB[2], xa[2], xb[2];
#pragma unroll
  for (int ft = 0; ft < 2; ++ft) { const int R = 256 + fw * 64 + ft * 32 + lr; offA[ft] = R * 128; xa[ft] = (R >> 1) & 7; }
#pragma unroll
  for (int tt = 0; tt < 2; ++tt) { const int R = tq * 64 + tt * 32 + lr; offB[tt] = R * 128; xb[tt] = (R >> 1) & 7; }
  GLDS_STAGE(0, 0); GLDS_STAGE(1, 1); WAIT_V(6); RAW_BARRIER();
  int cur = 0;
  for (int kt = 0; kt < nk; ++kt) {
    const int nxt = (cur >= 1) ? cur - 1 : 2;
    if (kt + 2 < nk) GLDS_STAGE(nxt, kt + 2);
    __builtin_amdgcn_sched_barrier(0);
    const char* st = smem + cur * G_STAGE;
#pragma unroll
    for (int ks = 0; ks < 4; ++ks) {
      bf16x8 a[2], b[2];
#pragma unroll
      for (int ft = 0; ft < 2; ++ft) a[ft] = *reinterpret_cast<const bf16x8*>(st + offA[ft] + (((ks * 2 + lh) ^ xa[ft]) << 4));
#pragma unroll
      for (int tt = 0; tt < 2; ++tt) b[tt] = *reinterpret_cast<const bf16x8*>(st + offB[tt] + (((ks * 2 + lh) ^ xb[tt]) << 4));
#pragma unroll
      for (int ft = 0; ft < 2; ++ft)
#pragma unroll
        for (int tt = 0; tt < 2; ++tt) acc[ft][tt] = MFMA(a[ft], b[tt], acc[ft][tt]);
    }
    if (kt + 2 < nk) { WAIT_V(6); } else { WAIT_V(0); }
    RAW_BARRIER();
    cur = (cur == 2) ? 0 : cur + 1;
  }
#undef GLDS_STAGE
}

DI void store_tm_rows(f32x16 (&acc)[2][2], char* smem, u16* tm, int tokbase, int col) {
  const int lane = threadIdx.x & 63, wave = threadIdx.x >> 6, lr = lane & 31, lh = lane >> 5;
  float* wl = (float*)(smem + wave * 17408);
#pragma unroll
  for (int tt = 0; tt < 2; ++tt)
#pragma unroll
    for (int ft = 0; ft < 2; ++ft)
#pragma unroll
      for (int g = 0; g < 4; ++g) {
        f32x4 v = {acc[ft][tt][4 * g], acc[ft][tt][4 * g + 1], acc[ft][tt][4 * g + 2], acc[ft][tt][4 * g + 3]};
        *reinterpret_cast<f32x4*>(wl + (tt * 32 + lr) * 68 + ft * 32 + 8 * g + 4 * lh) = v;
      }
  const int ch = lane & 15, r0 = lane >> 4;
#pragma unroll 4
  for (int k = 0; k < 16; ++k) {
    const int row = r0 + 4 * k;
    f32x4 v = *reinterpret_cast<const f32x4*>(wl + row * 68 + ch * 4);
    st4bf(tm + (size_t)(tokbase + row) * TMW + col + ch * 4, v[0], v[1], v[2], v[3]);
  }
}

DI void epi_inproj(const Params& p, int tok0, int f0, f32x16 (&acc)[2][2], char* smem) {
  const int tid = threadIdx.x, lane = tid & 63, wave = tid >> 6;
  const int fw = wave & 1, tq = wave >> 1, lr = lane & 31, lh = lane >> 5;
  const int fbase = f0 + fw * 64;
  if (fbase >= 3392) return;
  u16* tm = (u16*)(p.ws + OFF_TM);
  int tmcol = -1;
#pragma unroll
  for (int tt = 0; tt < 2; ++tt) {
    const int tok = tok0 + tq * 64 + tt * 32 + lr;
    const float posf = (float)p.positions[tok];
    const int bb = tok >> 12, ss = tok & 4095;
    if (fbase < 1024) {
#pragma unroll
      for (int r = 0; r < 4; ++r) {
        float j = (float)(4 * lh + r);
        float inv = exp2f(-j * (18.931568569324174f / 8.0f));
        float sn, cs; sincos_rad(posf * inv, sn, cs);
        float x1 = acc[0][tt][r], x2 = acc[0][tt][r + 4];
        acc[0][tt][r] = x1 * cs - x2 * sn;
        acc[0][tt][r + 4] = x2 * cs + x1 * sn;
      }
      if (fbase < 512) {
        tmcol = fbase;
      } else {
        u16* kfr = (u16*)(p.ws + OFF_KFR);
        const int head = (fbase - 512) >> 6, gt = ss >> 5;
#pragma unroll
        for (int ft = 0; ft < 2; ++ft)
#pragma unroll
          for (int g = 0; g < 4; ++g) {
            const int ks = ft * 2 + (g >> 1), lane2 = (g & 1) * 32 + lr;
            st4bf(kfr + ((((size_t)(bb * 8 + head) * 128 + gt) * 4 + ks) * 64 + lane2) * 8 + 4 * lh, acc[ft][tt][4 * g], acc[ft][tt][4 * g + 1], acc[ft][tt][4 * g + 2], acc[ft][tt][4 * g + 3]);
          }
      }
    } else if (fbase < 1536) {
      u16* vfr = (u16*)(p.ws + OFF_VT);
      const int head = (fbase - 1024) >> 6, gt = ss >> 5;
      const int s = lr >> 4, r16 = lr & 15, j = 4 * (r16 >> 3) + (r16 & 3), lh2 = (r16 >> 2) & 1;
#pragma unroll
      for (int ft = 0; ft < 2; ++ft)
#pragma unroll
        for (int i = 0; i < 16; ++i) {
          const int lane2 = lh2 * 32 + crow(i, lh);
          vfr[((((((size_t)(bb * 8 + head) * 128 + gt) * 2 + ft) * 2 + s) * 64 + lane2) * 8) + j] = f2bf(acc[ft][tt][i]);
        }
    } else if (fbase >= 2368 && fbase < 2880) {
      u16* vt = (u16*)(p.ws + OFF_GVT);
      const int fo = fbase - 2368;
#pragma unroll
      for (int ft = 0; ft < 2; ++ft)
#pragma unroll
        for (int i = 0; i < 16; ++i) {
          int feat = fo + ft * 32 + crow(i, lh);
          vt[((size_t)bb * 512 + feat) * 4096 + ss] = f2bf(acc[ft][tt][i]);
        }
    } else {
      if (fbase < 1856) {
#pragma unroll
        for (int ft = 0; ft < 2; ++ft) {
          const bool rot = (fbase < 1792) || (ft == 0);
#pragma unroll
          for (int r = 0; r < 4; ++r) {
            float v = acc[ft][tt][r];
            float o = __shfl_xor(v, 32);
            float inv = exp2f(-(float)r * (18.931568569324174f / 4.0f));
            float sn, cs; sincos_rad(posf * inv, sn, cs);
            float res = (lh == 0) ? (v * cs - o * sn) : (v * cs + o * sn);
            acc[ft][tt][r] = rot ? res : v;
          }
        }
        tmcol = fbase - 512;
        if (fbase == 1792) {
          u16* kif = (u16*)(p.ws + OFF_KIF);
          const int gt = ss >> 5;
#pragma unroll
          for (int g = 0; g < 4; ++g) {
            const int ks = g >> 1, lane2 = (g & 1) * 32 + lr;
            st4bf(kif + ((((size_t)bb * 128 + gt) * 2 + ks) * 64 + lane2) * 8 + 4 * lh, acc[0][tt][4 * g], acc[0][tt][4 * g + 1], acc[0][tt][4 * g + 2], acc[0][tt][4 * g + 3]);
          }
        }
      } else if (fbase < 2368) {
        tmcol = fbase - 512;
      } else {
        tmcol = fbase - 1024;
      }
    }
  }
  if (tmcol >= 0) store_tm_rows(acc, smem, tm, tok0 + tq * 64, tmcol);
}

DI void phase_inproj(const Params& p, char* smem) {
  const int n_in = 128 * 27;
  const int total = n_in + 128;
  const u16* xb = (const u16*)(p.ws + OFF_XB);
  const u16* memb = (const u16*)(p.ws + OFF_MEMB);
  const int tid = threadIdx.x, lane = tid & 63, wave = tid >> 6;
  const int fw = wave & 1, tq = wave >> 1, lr = lane & 31, lh = lane >> 5;
  const int xg = blockIdx.x & 7, xi = blockIdx.x >> 3, xn = gridDim.x >> 3;
  for (int u = xi; u < 16 * 27 + 16; u += xn) {
    f32x16 acc[2][2];
    const int t = (u < 16 * 27) ? (xg * 16 + (u / 27)) * 27 + (u % 27) : n_in + (u - 16 * 27) * 8 + xg;
    if (t < n_in) {
      int mt = t / 27, nt = t % 27;
      gemm_tile(xb + (size_t)mt * 256 * 1024, 1024, (const u16*)(p.ws + OFF_WIN) + (size_t)nt * 128 * 1024, 1024, 1024, smem, acc);
      epi_inproj(p, mt * 256, nt * 128, acc, smem);
      __syncthreads();
    } else {
      int u = t - n_in; int which = u >> 6; int r = u & 63; int mt = r >> 3, nt = r & 7;
      const u16* W = (const u16*)(p.ws + (which == 0 ? OFF_WK : OFF_WV));
      gemm_tile(memb + (size_t)mt * 256 * 1024, 1024, W + (size_t)nt * 128 * 1024, 1024, 1024, smem, acc);
#pragma unroll
      for (int tt = 0; tt < 2; ++tt) {
        const int tok = mt * 256 + tq * 64 + tt * 32 + lr;
        const int bb = tok >> 8, mm = tok & 255, hh = nt >> 1, kt = mm >> 5;
        if (which == 0) {
          u16* mk = (u16*)(p.ws + OFF_MEMK);
#pragma unroll
          for (int ft = 0; ft < 2; ++ft)
#pragma unroll
            for (int g = 0; g < 4; ++g) {
              const int ks = (nt & 1) * 8 + fw * 4 + ft * 2 + (g >> 1), lane2 = (g & 1) * 32 + lr;
              st4bf(mk + ((((size_t)(bb * 4 + hh) * 8 + kt) * 16 + ks) * 64 + lane2) * 8 + 4 * lh, acc[ft][tt][4 * g], acc[ft][tt][4 * g + 1], acc[ft][tt][4 * g + 2], acc[ft][tt][4 * g + 3]);
            }
        } else {
          u16* mv = (u16*)(p.ws + OFF_MEMVT);
          const int s = lr >> 4, r16 = lr & 15, j = 4 * (r16 >> 3) + (r16 & 3), lh2 = (r16 >> 2) & 1;
#pragma unroll
          for (int ft = 0; ft < 2; ++ft) {
            const int dt = (nt & 1) * 4 + fw * 2 + ft;
#pragma unroll
            for (int i = 0; i < 16; ++i) {
              const int lane2 = lh2 * 32 + crow(i, lh);
              mv[((((((size_t)(bb * 4 + hh) * 8 + dt) * 8 + kt) * 2 + s) * 64 + lane2) * 8) + j] = f2bf(acc[ft][tt][i]);
            }
          }
        }
      }
    }
  }
}

DI void idx_scores(const bf16x8 (&qf)[8][2], const float (&wq)[8], bf16x8 k0, bf16x8 k1, float (&sc)[16]) {
#pragma unroll
  for (int i = 0; i < 16; ++i) sc[i] = 0.f;
#pragma unroll
  for (int hd = 0; hd < 8; ++hd) {
    f32x16 a = zero16();
    a = MFMA(k0, qf[hd][0], a);
    a = MFMA(k1, qf[hd][1], a);
#pragma unroll
    for (int i = 0; i < 16; ++i) sc[i] = fmaf(wq[hd], fmaxf(a[i], 0.f), sc[i]);
  }
}

DI void load_idx_q(const u16* tm, int tok, int lh, bf16x8 (&qf)[8][2], float (&wq)[8]) {
  const u16* row = tm + (size_t)tok * TMW;
#pragma unroll
  for (int hd = 0; hd < 8; ++hd)
#pragma unroll
    for (int ks = 0; ks < 2; ++ks) qf[hd][ks] = ldg8(row + TM_QI + hd * 32 + ks * 16 + lh * 8);
  bf16x8 w8 = ldg8(row + TM_WI);
#pragma unroll
  for (int hd = 0; hd < 8; ++hd) wq[hd] = bf2f((u16)w8[hd]) * 0.0625f;
}

DI int wave_incl_scan(int v, int lane) {
#pragma unroll
  for (int d = 1; d < 64; d <<= 1) {
    int t = __shfl_up(v, d);
    if (lane >= d) v += t;
  }
  return v;
}

DI void dsa_thr_item(const Params& p, int b, int qblk, char* smem) {
  unsigned* hist = (unsigned*)smem;
  unsigned* pref = (unsigned*)(smem + 32768);
  int* rank = (int*)(smem + 32768 + 128);
  const u16* tm = (const u16*)(p.ws + OFF_TM);
  const int tid = threadIdx.x, lane = tid & 63, wave = tid >> 6, lr = lane & 31, lh = lane >> 5;
  const int q0 = qblk * 32;
  u16* qi = (u16*)(smem + 33280);
  for (int i = tid; i < 32 * 32; i += 512) {
    int q = i >> 5, ch = i & 31;
    *reinterpret_cast<u32x4*>(qi + q * 296 + ch * 8) = *reinterpret_cast<const u32x4*>(tm + (size_t)(b * S_ + q0 + q) * TMW + TM_QI + ch * 8);
  }
  float wq[8];
  {
    bf16x8 w8 = ldg8(tm + (size_t)(b * S_ + q0 + lr) * TMW + TM_WI);
#pragma unroll
    for (int hd = 0; hd < 8; ++hd) wq[hd] = bf2f((u16)w8[hd]) * 0.0625f;
  }
  __syncthreads();
  for (int i = tid; i < 32 * 32; i += 512) {
    const int q = i >> 5, d = i & 31;
    float acc = 0.f;
#pragma unroll
    for (int hd = 0; hd < 8; ++hd) acc = fmaf(bf2f(tm[(size_t)(b * S_ + q0 + q) * TMW + TM_WI + hd]) * 0.0625f, bf2f(qi[q * 296 + hd * 32 + d]), acc);
    qi[q * 296 + 256 + d] = f2bf(acc);
  }
  const u16* qil = qi + lr * 296 + lh * 8;
  if (tid < 32) { pref[tid] = 0u; rank[tid] = min(256, q0 + tid + 1); }
  for (int pass = 0; pass < 4; ++pass) {
    for (int i = tid; i < 8192; i += 512) hist[i] = 0u;
    __syncthreads();
    const int shift = 24 - 8 * pass;
    const unsigned mypref = pref[lr];
    const u16* kib = (const u16*)(p.ws + OFF_KIF) + (size_t)b * 128 * 1024 + lane * 8;
    bf16x8 kn0, kn1;
    {
      const int kt0 = min(wave, qblk);
      kn0 = ldg8(kib + (size_t)kt0 * 1024); kn1 = ldg8(kib + (size_t)kt0 * 1024 + 512);
    }
    for (int kt = wave; kt <= qblk; kt += 8) {
      const bf16x8 k0 = kn0, k1 = kn1;
      {
        const int ktn = min(kt + 8, qblk);
        kn0 = ldg8(kib + (size_t)ktn * 1024); kn1 = ldg8(kib + (size_t)ktn * 1024 + 512);
      }
      float sc[16];
      {
        f32x16 a = zero16();
        a = MFMA(k0, *reinterpret_cast<const bf16x8*>(qil + 256), a);
        a = MFMA(k1, *reinterpret_cast<const bf16x8*>(qil + 256 + 16), a);
#pragma unroll
        for (int i = 0; i < 16; ++i) sc[i] = a[i];
      }
#pragma unroll
      for (int hd = 0; hd < 8; ++hd) {
        f32x16 a = zero16();
        a = MFMA(k0, *reinterpret_cast<const bf16x8*>(qil + hd * 32), a);
        a = MFMA(k1, *reinterpret_cast<const bf16x8*>(qil + hd * 32 + 16), a);
        const float wh = wq[hd];
#pragma unroll
        for (int i = 0; i < 16; ++i) sc[i] = fmaf(fabsf(a[i]), wh, sc[i]);
      }
      if (kt == qblk) {
#pragma unroll
        for (int i = 0; i < 16; ++i) {
          int kp = kt * 32 + crow(i, lh);
          unsigned ky = fkey(sc[i]);
          unsigned hi = (ky >> shift);
          if (kp <= q0 + lr && (hi >> 8) == mypref) atomicAdd(&hist[(hi & 255u) * 32 + lr], 1u);
        }
      } else {
#pragma unroll
        for (int i = 0; i < 16; ++i) {
          unsigned ky = fkey(sc[i]);
          unsigned hi = (ky >> shift);
          if ((hi >> 8) == mypref) atomicAdd(&hist[(hi & 255u) * 32 + lr], 1u);
        }
      }
    }
    __syncthreads();
#pragma unroll 1
    for (int qq = 0; qq < 4; ++qq) {
      const int q = wave * 4 + qq;
      const int rk = rank[q];
      int c[4];
#pragma unroll
      for (int j = 0; j < 4; ++j) c[j] = (int)hist[(255 - 4 * lane - j) * 32 + q];
      int s = c[0] + c[1] + c[2] + c[3];
      int P = wave_incl_scan(s, lane);
      int excl = P - s;
      if (P >= rk && excl < rk) {
        int cum = excl; int bin = 0; int nr = 1; bool found = false;
#pragma unroll
        for (int j = 0; j < 4; ++j) {
          if (!found && cum + c[j] >= rk) { bin = 255 - 4 * lane - j; nr = rk - cum; found = true; }
          if (!found) cum += c[j];
        }
        pref[q] = (pref[q] << 8) | (unsigned)bin;
        rank[q] = nr;
      }
    }
    __syncthreads();
  }
  if (tid < 32) ((unsigned*)(p.ws + OFF_THR))[b * S_ + q0 + tid] = pref[tid];
  __syncthreads();
}

DI void dsa_attn_item(const Params& p, int b, int qblk, char* smem) {
  u16* maskbuf = (u16*)smem;
  u16* qi = (u16*)(smem + 4096);
  const u16* tm = (const u16*)(p.ws + OFF_TM);
  const u16* vfr = (const u16*)(p.ws + OFF_VT) + ((size_t)(b * 8 + (threadIdx.x >> 6)) * 128) * 2048 + (threadIdx.x & 63) * 8;
  const u16* kfr = (const u16*)(p.ws + OFF_KFR) + ((size_t)(b * 8 + (threadIdx.x >> 6)) * 128) * 2048 + (threadIdx.x & 63) * 8;
  const unsigned* thr = (const unsigned*)(p.ws + OFF_THR);
  const int tid = threadIdx.x, lane = tid & 63, wave = tid >> 6, lr = lane & 31, lh = lane >> 5;
  const int q0 = qblk * 32;
  const int head = wave;
  const int qtok = b * S_ + q0 + lr;
  bf16x8 Qf[4];
#pragma unroll
  for (int ks = 0; ks < 4; ++ks) {
    bf16x8 raw = ldg8(tm + (size_t)qtok * TMW + TM_Q + head * 64 + ks * 16 + lh * 8);
    float f[8];
#pragma unroll
    for (int j = 0; j < 8; ++j) f[j] = bf2f((u16)raw[j]) * (0.125f * 1.4426950408889634f);
    Qf[ks] = pack8(f[0], f[1], f[2], f[3], f[4], f[5], f[6], f[7]);
  }
  f32x16 O[2];
  O[0] = zero16(); O[1] = zero16();
  float mrun = -INFINITY, lrun = 0.f;
  const unsigned thrq = thr[qtok];
  const int nchunks = (q0 + 31) / 256 + 1;
  for (int i = tid; i < 32 * 32; i += 512) {
    int q = i >> 5, ch = i & 31;
    *reinterpret_cast<u32x4*>(qi + q * 296 + ch * 8) = *reinterpret_cast<const u32x4*>(tm + (size_t)(b * S_ + q0 + q) * TMW + TM_QI + ch * 8);
  }
  float* wqs = (float*)(smem + 4096 + 32 * 296 * 2);
  if (tid < 256) wqs[tid] = bf2f(tm[(size_t)(b * S_ + q0 + (tid & 31)) * TMW + TM_WI + (tid >> 5)]) * 0.0625f;
  __syncthreads();
  for (int i = tid; i < 32 * 32; i += 512) {
    const int q = i >> 5, d = i & 31;
    float acc = 0.f;
#pragma unroll
    for (int hd = 0; hd < 8; ++hd) acc = fmaf(bf2f(tm[(size_t)(b * S_ + q0 + q) * TMW + TM_WI + hd]) * 0.0625f, bf2f(qi[q * 296 + hd * 32 + d]), acc);
    qi[q * 296 + 256 + d] = f2bf(acc);
  }
  __syncthreads();
  const u16* qil = qi + lr * 296 + lh * 8;
  const u16* kibase = (const u16*)(p.ws + OFF_KIF) + (size_t)b * 128 * 1024 + lane * 8;
  bf16x8 Kf[4], Kn[4];
#pragma unroll
  for (int ks = 0; ks < 4; ++ks) Kf[ks] = ldg8(kfr + ks * 512);
  bf16x8 Vf[2][2], Vn[2][2];
#pragma unroll
  for (int dt = 0; dt < 2; ++dt)
#pragma unroll
    for (int s = 0; s < 2; ++s) Vf[dt][s] = ldg8(vfr + (dt * 2 + s) * 512);
  bf16x8 ki0, ki1;
  {
    const int kt0 = min(wave, qblk);
    ki0 = ldg8(kibase + (size_t)kt0 * 1024); ki1 = ldg8(kibase + (size_t)kt0 * 1024 + 512);
  }
  for (int c = 0; c < nchunks; ++c) {
    const int buf = c & 1;
    {
      const int key0 = (c * 8 + wave) * 32;
      unsigned bits = 0u;
      const bf16x8 k0 = ki0, k1 = ki1;
      {
        const int ktn = min((c + 1) * 8 + wave, qblk);
        ki0 = ldg8(kibase + (size_t)ktn * 1024); ki1 = ldg8(kibase + (size_t)ktn * 1024 + 512);
      }
      if (key0 <= q0 + 31) {
        float sc[16];
        {
          f32x16 a = zero16();
          a = MFMA(k0, *reinterpret_cast<const bf16x8*>(qil + 256), a);
          a = MFMA(k1, *reinterpret_cast<const bf16x8*>(qil + 256 + 16), a);
#pragma unroll
          for (int i = 0; i < 16; ++i) sc[i] = a[i];
        }
#pragma unroll 2
        for (int hd = 0; hd < 8; ++hd) {
          f32x16 a = zero16();
          a = MFMA(k0, *reinterpret_cast<const bf16x8*>(qil + hd * 32), a);
          a = MFMA(k1, *reinterpret_cast<const bf16x8*>(qil + hd * 32 + 16), a);
          const float wh = wqs[hd * 32 + lr];
#pragma unroll
          for (int i = 0; i < 16; ++i) sc[i] = fmaf(fabsf(a[i]), wh, sc[i]);
        }
        __builtin_amdgcn_sched_barrier(0);
#pragma unroll
        for (int i = 0; i < 16; ++i) {
          int kp = key0 + crow(i, lh);
          if (kp <= q0 + lr && fkey(sc[i]) >= thrq) bits |= (1u << i);
        }
      }
      maskbuf[(buf * 8 + wave) * 64 + lane] = (u16)bits;
    }
    __syncthreads();
#pragma unroll 1
    for (int t8 = 0; t8 < 8; ++t8) {
      const int g = c * 8 + t8;
      if (g > qblk) break;
      {
        const int gn = min(g + 1, qblk);
        const u16* kr = kfr + (size_t)gn * 2048;
#pragma unroll
        for (int ks = 0; ks < 4; ++ks) Kn[ks] = ldg8(kr + ks * 512);
#pragma unroll
        for (int dt = 0; dt < 2; ++dt)
#pragma unroll
          for (int s = 0; s < 2; ++s) Vn[dt][s] = ldg8(vfr + (size_t)gn * 2048 + (dt * 2 + s) * 512);
      }

      const unsigned bits = maskbuf[(buf * 8 + t8) * 64 + lane];
      f32x16 Sx = zero16();
#pragma unroll
      for (int ks = 0; ks < 4; ++ks) Sx = MFMA(Kf[ks], Qf[ks], Sx);
      float sm[16];
#pragma unroll
      for (int i = 0; i < 16; ++i) {
        const unsigned t = (unsigned)__builtin_amdgcn_sbfe((int)bits, i, 1);
        sm[i] = __uint_as_float((t & __float_as_uint(Sx[i])) | (~t & 0xff800000u));
      }
      float mt = fmaxf(fmaxf(fmaxf(sm[0], sm[1]), fmaxf(sm[2], sm[3])), fmaxf(fmaxf(sm[4], sm[5]), fmaxf(sm[6], sm[7])));
      mt = fmaxf(mt, fmaxf(fmaxf(fmaxf(sm[8], sm[9]), fmaxf(sm[10], sm[11])), fmaxf(fmaxf(sm[12], sm[13]), fmaxf(sm[14], sm[15]))));
      mt = fmaxf(mt, __shfl_xor(mt, 32));
      const float mnew = fmaxf(mrun, mt);
      const float msafe = (mnew == -INFINITY) ? 0.f : mnew;
      const float alpha = __builtin_amdgcn_exp2f(mrun - msafe);
      float pv[16]; float ps = 0.f;
#pragma unroll
      for (int i = 0; i < 16; ++i) { pv[i] = __builtin_amdgcn_exp2f(sm[i] - msafe); ps += pv[i]; }
      lrun = lrun * alpha + ps;
      mrun = mnew;
      if (__builtin_amdgcn_ballot_w64(alpha != 1.f) != 0ull) {
#pragma unroll
        for (int dt = 0; dt < 2; ++dt)
#pragma unroll
          for (int i = 0; i < 16; ++i) O[dt][i] *= alpha;
      }
      bf16x8 Pf[2];
#pragma unroll
      for (int s = 0; s < 2; ++s) Pf[s] = pack8(pv[8 * s], pv[8 * s + 1], pv[8 * s + 2], pv[8 * s + 3], pv[8 * s + 4], pv[8 * s + 5], pv[8 * s + 6], pv[8 * s + 7]);
#pragma unroll
      for (int dt = 0; dt < 2; ++dt)
#pragma unroll
        for (int s = 0; s < 2; ++s) O[dt] = MFMA(Vf[dt][s], Pf[s], O[dt]);
#pragma unroll
      for (int ks = 0; ks < 4; ++ks) Kf[ks] = Kn[ks];
#pragma unroll
      for (int dt = 0; dt < 2; ++dt)
#pragma unroll
        for (int s = 0; s < 2; ++s) Vf[dt][s] = Vn[dt][s];
    }
  }
  u16* y = (u16*)(p.ws + OFF_XB);
  {
    float lt = lrun + __shfl_xor(lrun, 32);
    float inv = 1.f / lt;
#pragma unroll
    for (int dt = 0; dt < 2; ++dt)
#pragma unroll
      for (int g = 0; g < 4; ++g)
        st4bf(y + (size_t)qtok * 1024 + head * 64 + dt * 32 + 8 * g + 4 * lh, O[dt][4 * g] * inv, O[dt][4 * g + 1] * inv, O[dt][4 * g + 2] * inv, O[dt][4 * g + 3] * inv);
  }
  __syncthreads();
}

DI void gla_bcum(const Params& p, int b, int h, int n, float* bc, float* glr_s, float* segtot) {
  const u16* tm = (const u16*)(p.ws + OFF_TM);
  const int tid = threadIdx.x;
  const int tok0 = b * S_ + n * 64;
  for (int i = tid; i < 1024; i += 512) glr_s[i] = bf2f(tm[(size_t)(tok0 + (i >> 4)) * TMW + TM_GLR + (i & 15)]);
  const int d = tid & 63, cgp = tid >> 6;
  float gu[16];
#pragma unroll
  for (int j = 0; j < 16; ++j) gu[j] = p.gate_up[j * 256 + h * 64 + d];
  const float bias = p.gate_bias[h * 64 + d];
  __syncthreads();
  float v[8]; float run = 0.f;
#pragma unroll
  for (int r = 0; r < 8; ++r) {
    const int c = cgp * 8 + r;
    float z = bias;
#pragma unroll
    for (int j4 = 0; j4 < 4; ++j4) {
      const f32x4 gv = *reinterpret_cast<const f32x4*>(glr_s + c * 16 + j4 * 4);
#pragma unroll
      for (int j = 0; j < 4; ++j) z = fmaf(gv[j], gu[j4 * 4 + j], z);
    }
    float la = (fminf(z, 0.f) - __logf(1.f + __expf(-fabsf(z)))) * 0.0625f;
    run += la; v[r] = run;
  }
  segtot[cgp * 64 + d] = run;
  __syncthreads();
  float off = 0.f;
#pragma unroll
  for (int g = 0; g < 8; ++g) off += (g < cgp) ? segtot[g * 64 + d] : 0.f;
#pragma unroll
  for (int r = 0; r < 8; ++r) bc[(cgp * 8 + r) * 64 + d] = off + v[r];
  __syncthreads();
}

DI void gla_g1_item(const Params& p, int item, char* smem) {
  float* bc = (float*)smem;
  float* glr_s = (float*)(smem + 16384);
  float* segtot = (float*)(smem + 20480);
  u16* KeT = (u16*)(smem + 22528);
  const int b = item >> 8, h = (item >> 6) & 3, n = item & 63;
  const u16* tm = (const u16*)(p.ws + OFF_TM);
  const u16* gvT = (const u16*)(p.ws + OFF_GVT);
  const int tid = threadIdx.x, lane = tid & 63, wave = tid >> 6, lr = lane & 31, lh = lane >> 5;
  const int tok0 = b * S_ + n * 64;
  u16 kraw[8];
  {
    const int d = tid & 63, cgp = tid >> 6;
#pragma unroll
    for (int r = 0; r < 8; ++r) kraw[r] = tm[(size_t)(tok0 + cgp * 8 + r) * TMW + TM_GK + h * 64 + d];
  }
  bf16x8 afr[4];
  {
    const int et = wave & 3;
    const u16* arow = gvT + ((size_t)b * 512 + h * 128 + et * 32 + lr) * 4096 + n * 64 + lh * 8;
#pragma unroll
    for (int ks = 0; ks < 4; ++ks) afr[ks] = ldg8(arow + ks * 16);
  }
  gla_bcum(p, b, h, n, bc, glr_s, segtot);
  {
    const int d = tid & 63, cgp = tid >> 6;
    const float blast = bc[63 * 64 + d];
    {
      float* bcg = (float*)(p.ws + OFF_BCG) + (size_t)item * 4096;
#pragma unroll
      for (int r = 0; r < 8; ++r) bcg[(cgp * 8 + r) * 64 + d] = bc[(cgp * 8 + r) * 64 + d];
    }
    float f[8];
#pragma unroll
    for (int r = 0; r < 8; ++r) {
      const int c = cgp * 8 + r;
      float kv = bf2f(kraw[r]);
      f[r] = kv * __expf(blast - bc[c * 64 + d]);
    }
    *reinterpret_cast<bf16x8*>(KeT + d * 72 + cgp * 8) = pack8(f[0], f[1], f[2], f[3], f[4], f[5], f[6], f[7]);
    if (cgp == 0) ((float*)(p.ws + OFF_DECAY))[item * 64 + d] = __expf(blast);
  }
  __syncthreads();
  {
    const int et = wave & 3, dtl = wave >> 2;
    f32x16 acc = zero16();
#pragma unroll
    for (int ks = 0; ks < 4; ++ks) {
      bf16x8 a = afr[ks];
      bf16x8 bb = *reinterpret_cast<const bf16x8*>(KeT + (dtl * 32 + lr) * 72 + ks * 16 + lh * 8);
      acc = MFMA(a, bb, acc);
    }
    float* kvT = (float*)(p.ws + OFF_KVT);
#pragma unroll
    for (int i = 0; i < 16; ++i) kvT[((size_t)item * 128 + et * 32 + crow(i, lh)) * 64 + dtl * 32 + lr] = acc[i];
  }
  __syncthreads();
}

DI void gla_scan(const Params& p) {
  const float* kvT = (const float*)(p.ws + OFF_KVT);
  const float* decay = (const float*)(p.ws + OFF_DECAY);
  u16* prev = (u16*)(p.ws + OFF_PREV);
  const int gtid = blockIdx.x * blockDim.x + threadIdx.x;
  const int gn = gridDim.x * blockDim.x;
  for (int u = gtid; u < 32 * 2048; u += gn) {
    const int bh = u >> 11, rem = u & 2047, e = rem >> 4, d4 = (rem & 15) * 4;
    f32x4 st = {0.f, 0.f, 0.f, 0.f};
#pragma unroll 4
    for (int n = 0; n < 64; ++n) {
      const int item = bh * 64 + n;
      st4bf(prev + ((size_t)item * 128 + e) * 64 + d4, st[0], st[1], st[2], st[3]);
      f32x4 dc = *reinterpret_cast<const f32x4*>(decay + item * 64 + d4);
      f32x4 kv = *reinterpret_cast<const f32x4*>(kvT + ((size_t)item * 128 + e) * 64 + d4);
      st = dc * st + kv;
    }
  }
}

DI void gla_g3_item(const Params& p, int item, char* smem) {
  float* red = (float*)smem;
  const int b = item >> 8, h = (item >> 6) & 3, n = item & 63;
  const u16* tm = (const u16*)(p.ws + OFF_TM);
  const u16* gvT = (const u16*)(p.ws + OFF_GVT);
  const u16* prev = (const u16*)(p.ws + OFF_PREV);
  const float* bcg = (const float*)(p.ws + OFF_BCG) + (size_t)item * 4096;
  const int tid = threadIdx.x, lane = tid & 63, wave = tid >> 6, lr = lane & 31, lh = lane >> 5;
  const int tok0 = b * S_ + n * 64;
  const int et = wave & 3, ct = wave >> 2;
  bf16x8 qraw[4], kraw[2][4], sfr[4];
  bf16x4 vlo[2][2], vhi[2][2];
  f32x4 bq[4][2];
  {
    const u16* vrow0 = gvT + ((size_t)b * 512 + h * 128 + et * 32 + lr) * 4096 + n * 64 + 4 * lh;
    const u16* srow0 = prev + ((size_t)item * 128 + et * 32 + lr) * 64 + lh * 8;
#pragma unroll
    for (int ks = 0; ks < 4; ++ks) {
      qraw[ks] = ldg8(tm + (size_t)(tok0 + ct * 32 + lr) * TMW + TM_GQ + h * 64 + ks * 16 + lh * 8);
      kraw[0][ks] = ldg8(tm + (size_t)(tok0 + lr) * TMW + TM_GK + h * 64 + ks * 16 + lh * 8);
      kraw[1][ks] = ldg8(tm + (size_t)(tok0 + ct * 32 + lr) * TMW + TM_GK + h * 64 + ks * 16 + lh * 8);
      sfr[ks] = ldg8(srow0 + ks * 16);
      bq[ks][0] = *reinterpret_cast<const f32x4*>(bcg + (ct * 32 + lr) * 64 + ks * 16 + lh * 8);
      bq[ks][1] = *reinterpret_cast<const f32x4*>(bcg + (ct * 32 + lr) * 64 + ks * 16 + lh * 8 + 4);
    }
#pragma unroll
    for (int st = 0; st < 2; ++st)
#pragma unroll
      for (int s2 = 0; s2 < 2; ++s2) {
        const u16* vp = vrow0 + (st * ct) * 32 + 16 * s2;
        vlo[st][s2] = *reinterpret_cast<const bf16x4*>(vp);
        vhi[st][s2] = *reinterpret_cast<const bf16x4*>(vp + 8);
      }
  }
  bf16x8 Qd[4];
#pragma unroll
  for (int ks = 0; ks < 4; ++ks) {
    float f[8];
#pragma unroll
    for (int j = 0; j < 8; ++j) f[j] = bf2f((u16)qraw[ks][j]) * 0.125f * __expf(bq[ks][j >> 2][j & 3]);
    Qd[ks] = pack8(f[0], f[1], f[2], f[3], f[4], f[5], f[6], f[7]);
  }
  f32x16 O = zero16();
#pragma unroll
  for (int st = 0; st < 2; ++st) {
    if (st <= ct) {
      f32x16 A = zero16();
      const int s = st * 32 + lr;
#pragma unroll
      for (int ks = 0; ks < 4; ++ks) {
        f32x4 b0 = (st == 1) ? bq[ks][0] : *reinterpret_cast<const f32x4*>(bcg + s * 64 + ks * 16 + lh * 8);
        f32x4 b1 = (st == 1) ? bq[ks][1] : *reinterpret_cast<const f32x4*>(bcg + s * 64 + ks * 16 + lh * 8 + 4);
        float f[8];
#pragma unroll
        for (int j = 0; j < 8; ++j) f[j] = bf2f((u16)kraw[st][ks][j]) * __expf(-((j < 4) ? b0[j & 3] : b1[j & 3]));
        bf16x8 Ki = pack8(f[0], f[1], f[2], f[3], f[4], f[5], f[6], f[7]);
        A = MFMA(Ki, Qd[ks], A);
      }
      float pv[16];
#pragma unroll
      for (int i = 0; i < 16; ++i) pv[i] = (st * 32 + crow(i, lh) <= ct * 32 + lr) ? A[i] : 0.f;
#pragma unroll
      for (int s2 = 0; s2 < 2; ++s2) {
        bf16x8 Pf = pack8(pv[8 * s2], pv[8 * s2 + 1], pv[8 * s2 + 2], pv[8 * s2 + 3], pv[8 * s2 + 4], pv[8 * s2 + 5], pv[8 * s2 + 6], pv[8 * s2 + 7]);
        O = MFMA(cat44(vlo[st][s2], vhi[st][s2]), Pf, O);
      }
    }
  }
#pragma unroll
  for (int ks = 0; ks < 4; ++ks) O = MFMA(sfr[ks], Qd[ks], O);
  float ss = 0.f;
#pragma unroll
  for (int i = 0; i < 16; ++i) ss += O[i] * O[i];
  ss += __shfl_xor(ss, 32);
  if (lh == 0) red[(ct * 4 + et) * 32 + lr] = ss;
  __syncthreads();
  const float tot = red[(ct * 4 + 0) * 32 + lr] + red[(ct * 4 + 1) * 32 + lr] + red[(ct * 4 + 2) * 32 + lr] + red[(ct * 4 + 3) * 32 + lr];
  const float rinv = rsqrtf(tot * (1.f / 128.f) + 1e-6f);
  const int tok = tok0 + ct * 32 + lr;
  u16* y = (u16*)(p.ws + OFF_XB);
#pragma unroll
  for (int g = 0; g < 4; ++g) {
    const int e0 = et * 32 + 8 * g + 4 * lh;
    u32x2 gr = *reinterpret_cast<const u32x2*>(tm + (size_t)tok * TMW + TM_GR + h * 128 + e0);
    f32x4 ng = *reinterpret_cast<const f32x4*>(p.norm_g + e0);
    float grv[4] = {bflo(gr[0]), bfhi(gr[0]), bflo(gr[1]), bfhi(gr[1])};
    float o[4];
#pragma unroll
    for (int r = 0; r < 4; ++r) {
      float sl = grv[r] / (1.f + __expf(-grv[r]));
      o[r] = O[4 * g + r] * rinv * ng[r] * sl;
    }
    st4bf(y + (size_t)tok * 1024 + 512 + h * 128 + e0, o[0], o[1], o[2], o[3]);
  }
  __syncthreads();
}

template <int MODE>
DI void phase_gemm(const Params& p, const u16* X, const u16* Wt, int N, const float* resid, float* outf, u16* outb, int ldo, char* smem) {
  const int ntn = N / 128;
  const int tid = threadIdx.x, lane = tid & 63, wave = tid >> 6;
  const int fw = wave & 1, tq = wave >> 1, lr = lane & 31, lh = lane >> 5;
  const int xg = blockIdx.x & 7, xi = blockIdx.x >> 3, xn = gridDim.x >> 3;
  const int per_group = 16 * ntn;
  for (int u = xi; u < per_group; u += xn) {
    const int mt = xg + 8 * (u / ntn), nt = u % ntn;
    f32x16 acc[2][2];
    gemm_tile(X + (size_t)mt * 256 * 1024, 1024, Wt + (size_t)nt * 128 * 1024, 1024, 1024, smem, acc);
    if (MODE == 0 || MODE == 1) {
      float* wl = (float*)(smem + wave * 17408);
#pragma unroll
      for (int tt = 0; tt < 2; ++tt)
#pragma unroll
        for (int ft = 0; ft < 2; ++ft)
#pragma unroll
          for (int g = 0; g < 4; ++g) {
            f32x4 v = {acc[ft][tt][4 * g], acc[ft][tt][4 * g + 1], acc[ft][tt][4 * g + 2], acc[ft][tt][4 * g + 3]};
            *reinterpret_cast<f32x4*>(wl + (tt * 32 + lr) * 68 + ft * 32 + 8 * g + 4 * lh) = v;
          }
      const int ch = lane & 15, r0 = lane >> 4;
      const int f = nt * 128 + fw * 64 + ch * 4;
#pragma unroll 4
      for (int k = 0; k < 16; ++k) {
        const int row = r0 + 4 * k;
        const int tok = mt * 256 + tq * 64 + row;
        f32x4 v = *reinterpret_cast<const f32x4*>(wl + row * 68 + ch * 4);
        if (MODE == 0) {
          f32x4 r = *reinterpret_cast<const f32x4*>(resid + (size_t)tok * 1024 + f);
          f32x4 o;
#pragma unroll
          for (int j = 0; j < 4; ++j) o[j] = ALPHA * r[j] + v[j];
          *reinterpret_cast<f32x4*>(outf + (size_t)tok * 1024 + f) = o;
        } else {
          st4bf(outb + (size_t)tok * ldo + f, v[0], v[1], v[2], v[3]);
        }
      }
      __syncthreads();
    } else {
#pragma unroll
      for (int tt = 0; tt < 2; ++tt) {
        const int tok = mt * 256 + tq * 64 + tt * 32 + lr;
#pragma unroll
        for (int ft = 0; ft < 2; ++ft)
#pragma unroll
          for (int g = 0; g < 4; ++g) {
            const int f = nt * 128 + fw * 64 + ft * 32 + 8 * g + 4 * lh;
            if (MODE == 2) {
              const int hh = f >> 8, fh = f & 255, ks = fh >> 4, lane2 = ((fh >> 3) & 1) * 32 + lr;
              st4bf(outb + ((((size_t)(tok >> 5) * 4 + hh) * 16 + ks) * 64 + lane2) * 8 + 4 * lh, acc[ft][tt][4 * g], acc[ft][tt][4 * g + 1], acc[ft][tt][4 * g + 2], acc[ft][tt][4 * g + 3]);
            } else {
              const int hh = f >> 8, fq = f & 127, half = (f >> 7) & 1, ks = fq >> 4, lane2 = ((fq >> 3) & 1) * 32 + lr;
              st4bf(outb + (((((size_t)(tok >> 5) * 8 + hh) * 2 + half) * 8 + ks) * 64 + lane2) * 8 + 4 * lh, acc[ft][tt][4 * g], acc[ft][tt][4 * g + 1], acc[ft][tt][4 * g + 2], acc[ft][tt][4 * g + 3]);
            }
          }
      }
    }
  }
}

DI void phase_ln(const Params& p, float* h, u16* hb, const float* g, const float* bta) {
  const int lane = threadIdx.x & 63;
  const int xg = blockIdx.x & 7, xw = (blockIdx.x >> 3) * 8 + (threadIdx.x >> 6), xnw = (gridDim.x >> 3) * 8;
  for (int lrw = xw; lrw < 4096; lrw += xnw) {
    const int row = (xg + 8 * (lrw >> 8)) * 256 + (lrw & 255);
    float* r = h + (size_t)row * 1024;
    f32x4 v[4]; float s = 0.f;
#pragma unroll
    for (int c = 0; c < 4; ++c) { v[c] = *reinterpret_cast<const f32x4*>(r + c * 256 + lane * 4); s += v[c][0] + v[c][1] + v[c][2] + v[c][3]; }
    const float mean = wave_sum(s) * (1.f / 1024.f);
    float q = 0.f;
#pragma unroll
    for (int c = 0; c < 4; ++c)
#pragma unroll
      for (int k = 0; k < 4; ++k) { float d = v[c][k] - mean; q += d * d; }
    const float rstd = rsqrtf(wave_sum(q) * (1.f / 1024.f) + 1e-5f);
#pragma unroll
    for (int c = 0; c < 4; ++c) {
      f32x4 gg = *reinterpret_cast<const f32x4*>(g + c * 256 + lane * 4);
      f32x4 bb = *reinterpret_cast<const f32x4*>(bta + c * 256 + lane * 4);
      f32x4 o;
#pragma unroll
      for (int k = 0; k < 4; ++k) o[k] = (v[c][k] - mean) * rstd * gg[k] + bb[k];
      *reinterpret_cast<f32x4*>(r + c * 256 + lane * 4) = o;
      st4bf(hb + (size_t)row * 1024 + c * 256 + lane * 4, o[0], o[1], o[2], o[3]);
    }
  }
}

DI void phase_xattn(const Params& p) {
  const u16* qx = (const u16*)(p.ws + OFF_QX);
  const u16* mk = (const u16*)(p.ws + OFF_MEMK);
  const u16* mv = (const u16*)(p.ws + OFF_MEMVT);
  u16* ox = (u16*)(p.ws + OFF_OX);
  const int lane = threadIdx.x & 63, lr = lane & 31, lh = lane >> 5;
  const int xg = blockIdx.x & 7, xw = (blockIdx.x >> 3) * 8 + (threadIdx.x >> 6), xnw = (gridDim.x >> 3) * 8;
  for (int li = xw; li < 512; li += xnw) {
    const int qtl = li & 15, h = (li >> 4) & 3, b = li >> 6;
    const int qt = (xg + 8 * (qtl >> 3)) * 8 + (qtl & 7);
    const int tok = b * S_ + qt * 32 + lr;
    f32x16 Sx[8];
#pragma unroll
    for (int kt = 0; kt < 8; ++kt) Sx[kt] = zero16();
    const u16* qrow = qx + (((size_t)(b * 128 + qt) * 4 + h) * 16) * 512 + lane * 8;
    const u16* krow = mk + (((size_t)(b * 4 + h) * 8) * 16) * 512 + lane * 8;
#pragma unroll 2
    for (int ks = 0; ks < 16; ++ks) {
      bf16x8 qf = ldg8(qrow + ks * 512);
#pragma unroll
      for (int kt = 0; kt < 8; ++kt) Sx[kt] = MFMA(ldg8(krow + (kt * 16 + ks) * 512), qf, Sx[kt]);
    }
    float mx = -INFINITY;
#pragma unroll
    for (int kt = 0; kt < 8; ++kt)
#pragma unroll
      for (int i = 0; i < 16; ++i) mx = fmaxf(mx, Sx[kt][i]);
    mx = fmaxf(mx, __shfl_xor(mx, 32));
    float ls = 0.f;
    bf16x8 Pf[8][2];
#pragma unroll
    for (int kt = 0; kt < 8; ++kt) {
      float pv[16];
#pragma unroll
      for (int i = 0; i < 16; ++i) { pv[i] = __expf((Sx[kt][i] - mx) * 0.0625f); ls += pv[i]; }
#pragma unroll
      for (int s = 0; s < 2; ++s) Pf[kt][s] = pack8(pv[8 * s], pv[8 * s + 1], pv[8 * s + 2], pv[8 * s + 3], pv[8 * s + 4], pv[8 * s + 5], pv[8 * s + 6], pv[8 * s + 7]);
    }
    ls += __shfl_xor(ls, 32);
    const float inv = 1.f / ls;
#pragma unroll 1
    for (int dt = 0; dt < 8; ++dt) {
      f32x16 o = zero16();
      const u16* vrow = mv + ((((size_t)(b * 4 + h) * 8 + dt) * 8) * 2) * 512 + lane * 8;
#pragma unroll
      for (int kt = 0; kt < 8; ++kt)
#pragma unroll
        for (int s = 0; s < 2; ++s) o = MFMA(ldg8(vrow + (kt * 2 + s) * 512), Pf[kt][s], o);
#pragma unroll
      for (int g = 0; g < 4; ++g)
        st4bf(ox + (size_t)tok * 1024 + h * 256 + dt * 32 + 8 * g + 4 * lh, o[4 * g] * inv, o[4 * g + 1] * inv, o[4 * g + 2] * inv, o[4 * g + 3] * inv);
    }
  }
}

DI void peer_topk_item(const Params& p, int tt128, int head, char* smem) {
  float* sc = (float*)smem;
  float* topv = (float*)(smem + 132096);
  unsigned char* topi = (unsigned char*)(smem + 132096 + 16384);
  const u16* pq = (const u16*)(p.ws + OFF_QX);
  const u16* sk = (const u16*)(p.ws + OFF_SK);
  const int tid = threadIdx.x, lane = tid & 63, wave = tid >> 6, lr = lane & 31, lh = lane >> 5;
  const int tok0 = tt128 * 128;
  {
    const int half = wave >> 2, kt = wave & 3;
    bf16x8 af[8];
#pragma unroll
    for (int ks = 0; ks < 8; ++ks) af[ks] = ldg8(sk + (size_t)half * 16384 + (kt * 32 + lr) * 128 + ks * 16 + lh * 8);
#pragma unroll 1
    for (int tt = 0; tt < 4; ++tt) {
      f32x16 acc = zero16();
      const u16* brow = pq + (((((size_t)(tok0 >> 5) + tt) * 8 + head) * 2 + half) * 8) * 512 + lane * 8;
#pragma unroll
      for (int ks = 0; ks < 8; ++ks) acc = MFMA(af[ks], ldg8(brow + ks * 512), acc);
#pragma unroll
      for (int i = 0; i < 16; ++i) sc[(half * 128 + tt * 32 + lr) * 129 + kt * 32 + crow(i, lh)] = acc[i];
    }
  }
  __syncthreads();
  if (tid < 256) {
    float* row = sc + tid * 129;
    float gm[8]; int gi[8];
#pragma unroll
    for (int g = 0; g < 8; ++g) {
      float m = -INFINITY; int mi = g * 16;
#pragma unroll
      for (int j = 0; j < 16; ++j) { float v = row[g * 16 + j]; if (v > m) { m = v; mi = g * 16 + j; } }
      gm[g] = m; gi[g] = mi;
    }
#pragma unroll 1
    for (int r = 0; r < 16; ++r) {
      float best = gm[0]; int bg = 0; int bi = gi[0];
#pragma unroll
      for (int g = 1; g < 8; ++g) if (gm[g] > best) { best = gm[g]; bg = g; bi = gi[g]; }
      topv[tid * 16 + r] = best; topi[tid * 16 + r] = (unsigned char)bi;
      row[bi] = -INFINITY;
      float m = -INFINITY; int mi = bg * 16;
#pragma unroll
      for (int j = 0; j < 16; ++j) { float v = row[bg * 16 + j]; if (v > m) { m = v; mi = bg * 16 + j; } }
#pragma unroll
      for (int g = 0; g < 8; ++g) { gm[g] = (g == bg) ? m : gm[g]; gi[g] = (g == bg) ? mi : gi[g]; }
    }
  }
  __syncthreads();
  if (tid < 128) {
    const float* av = topv + tid * 16;
    const float* bv = topv + (128 + tid) * 16;
    const unsigned char* ai = topi + tid * 16;
    const unsigned char* bi_ = topi + (128 + tid) * 16;
    float cur[16]; int pp[16];
    const float b0 = bv[0];
#pragma unroll
    for (int i = 0; i < 16; ++i) { cur[i] = av[i] + b0; pp[i] = 0; }
    float sel[16]; int eid[16];
#pragma unroll
    for (int r = 0; r < 16; ++r) {
      float best = cur[0]; int bi = 0; int bj = pp[0];
#pragma unroll
      for (int i = 1; i < 16; ++i) if (cur[i] > best) { best = cur[i]; bi = i; bj = pp[i]; }
      sel[r] = best;
      eid[r] = (int)ai[bi] * 128 + (int)bi_[bj];
      const int nj = bj + 1;
      const float nv = (nj < 16) ? (av[bi] + bv[nj & 15]) : -INFINITY;
#pragma unroll
      for (int i = 0; i < 16; ++i) { cur[i] = (i == bi) ? nv : cur[i]; pp[i] = (i == bi) ? nj : pp[i]; }
    }
    float sum = 0.f;
    const float smax = sel[0];
#pragma unroll
    for (int r = 0; r < 16; ++r) { sel[r] = __expf(sel[r] - smax); sum += sel[r]; }
    const float inv = 1.f / sum;
    int* eo = (int*)(p.ws + OFF_EIDX) + (size_t)(tok0 + tid) * 128 + head * 16;
    float* go = (float*)(p.ws + OFF_GATE) + (size_t)(tok0 + tid) * 128 + head * 16;
#pragma unroll
    for (int r = 0; r < 16; ++r) { eo[r] = eid[r]; go[r] = sel[r] * inv; }
  }
  __syncthreads();
}

DI float dot2bf(unsigned a, unsigned b, float c) {
  return __builtin_amdgcn_fdot2_f32_bf16(__builtin_bit_cast(bf2_t, a), __builtin_bit_cast(bf2_t, b), c, false);
}

DI float reduce8(float (&part)[8], int lane) {
  float r4[4], r2[2], r1;
#pragma unroll
  for (int k = 0; k < 4; ++k) {
    float send = (lane & 1) ? part[2 * k] : part[2 * k + 1];
    float keep = (lane & 1) ? part[2 * k + 1] : part[2 * k];
    r4[k] = keep + __shfl_xor(send, 1);
  }
#pragma unroll
  for (int k = 0; k < 2; ++k) {
    float send = (lane & 2) ? r4[2 * k] : r4[2 * k + 1];
    float keep = (lane & 2) ? r4[2 * k + 1] : r4[2 * k];
    r2[k] = keep + __shfl_xor(send, 2);
  }
  {
    float send = (lane & 4) ? r2[0] : r2[1];
    float keep = (lane & 4) ? r2[1] : r2[0];
    r1 = keep + __shfl_xor(send, 4);
  }
  r1 += __shfl_xor(r1, 8);
  r1 += __shfl_xor(r1, 16);
  r1 += __shfl_xor(r1, 32);
  return r1;
}

DI void phase_peer_down(const Params& p) {
  const char* exd = p.ws + OFF_EXD;
  const float* esc = (const float*)(p.ws + OFF_ESC);
  const u16* hb = (const u16*)(p.ws + OFF_HB);
  const int* eidx = (const int*)(p.ws + OFF_EIDX);
  const float* gate = (const float*)(p.ws + OFF_GATE);
  float* coefw = (float*)(p.ws + OFF_COEF);
  const int lane = threadIdx.x & 63;
  const int gw = (blockIdx.x * blockDim.x + threadIdx.x) >> 6;
  const int nw = (gridDim.x * blockDim.x) >> 6;
#pragma unroll 1
  for (int tok = gw; tok < T_; tok += nw) {
    float x[16];
    {
      const u16* xr = hb + (size_t)tok * 1024 + lane * 16;
      u32x4 a = *reinterpret_cast<const u32x4*>(xr);
      u32x4 c = *reinterpret_cast<const u32x4*>(xr + 8);
#pragma unroll
      for (int w = 0; w < 4; ++w) { x[2 * w] = bflo(a[w]); x[2 * w + 1] = bfhi(a[w]); x[8 + 2 * w] = bflo(c[w]); x[8 + 2 * w + 1] = bfhi(c[w]); }
    }
#pragma unroll 1
    for (int half = 0; half < 2; ++half) {
      const size_t slot = (size_t)tok * 128 + half * 64 + lane;
      const int ev = eidx[slot];
      const float gv = gate[slot];
      float racc = 0.f, gacc = 0.f;
#pragma unroll 1
      for (int bi = 0; bi < 8; ++bi) {
        u32x4 dr[8];
#pragma unroll
        for (int k = 0; k < 8; ++k) {
          const int er = __builtin_amdgcn_readlane(ev, bi * 8 + k);
          dr[k] = *reinterpret_cast<const u32x4*>(exd + (size_t)er * 1024 + lane * 16);
        }
        const int pmine = bi * 8 + (lane & 7);
        const int emine = __shfl(ev, pmine);
        const float gsel = __shfl(gv, pmine);
        const float sd = esc[emine];
        const float su = esc[16384 + emine];
        float part[8];
#pragma unroll
        for (int k = 0; k < 8; ++k) {
          float a0 = 0.f, a1 = 0.f;
#pragma unroll
          for (int w = 0; w < 4; ++w) {
            f2_t lo = __builtin_amdgcn_cvt_pk_f32_fp8((int)dr[k][w], false);
            f2_t hi = __builtin_amdgcn_cvt_pk_f32_fp8((int)dr[k][w], true);
            a0 = fmaf(lo[0], x[4 * w], a0); a1 = fmaf(lo[1], x[4 * w + 1], a1);
            a0 = fmaf(hi[0], x[4 * w + 2], a0); a1 = fmaf(hi[1], x[4 * w + 3], a1);
          }
          part[k] = a0 + a1;
        }
        const float r1 = reduce8(part, lane) * sd;
        const bool mine = (lane >> 3) == bi;
        racc = mine ? r1 : racc; gacc = mine ? gsel * su : gacc;
      }
      const float act = 0.5f * racc * (1.f + erff(racc * 0.70710678118654752f));
      coefw[slot] = gacc * act;
    }
  }
}

DI void phase_peer_ffn(const Params& p) {
  const char* exu = p.ws + OFF_EXU;
  const float* h = (const float*)(p.ws + OFF_H);
  const int* eidx = (const int*)(p.ws + OFF_EIDX);
  const float* coefw = (const float*)(p.ws + OFF_COEF);
  const int lane = threadIdx.x & 63;
  const int gw = (blockIdx.x * blockDim.x + threadIdx.x) >> 6;
  const int nw = (gridDim.x * blockDim.x) >> 6;
  for (int tok = gw; tok < T_; tok += nw) {
    float yacc[16];
#pragma unroll
    for (int i = 0; i < 16; ++i) yacc[i] = 0.f;
    const int e_lo = eidx[(size_t)tok * 128 + lane];
    const int e_hi = eidx[(size_t)tok * 128 + 64 + lane];
    const float c_lo = coefw[(size_t)tok * 128 + lane];
    const float c_hi = coefw[(size_t)tok * 128 + 64 + lane];
#pragma unroll 1
    for (int eb = 0; eb < 8; ++eb) {
      const int ev = (eb < 4) ? e_lo : e_hi;
      const float cv = (eb < 4) ? c_lo : c_hi;
      const int lbase = (eb & 3) * 16;
      u32x4 ur[16];
#pragma unroll
      for (int k = 0; k < 16; ++k) {
        const int er = __builtin_amdgcn_readlane(ev, lbase + k);
        ur[k] = *reinterpret_cast<const u32x4*>(exu + (size_t)er * 1024 + lane * 16);
      }
#pragma unroll
      for (int k = 0; k < 16; ++k) {
        const float ck = __int_as_float(__builtin_amdgcn_readlane(__float_as_int(cv), lbase + k));
#pragma unroll
        for (int w = 0; w < 4; ++w) {
          f2_t lo = __builtin_amdgcn_cvt_pk_f32_fp8((int)ur[k][w], false);
          f2_t hi = __builtin_amdgcn_cvt_pk_f32_fp8((int)ur[k][w], true);
          yacc[4 * w] = fmaf(ck, lo[0], yacc[4 * w]);
          yacc[4 * w + 1] = fmaf(ck, lo[1], yacc[4 * w + 1]);
          yacc[4 * w + 2] = fmaf(ck, hi[0], yacc[4 * w + 2]);
          yacc[4 * w + 3] = fmaf(ck, hi[1], yacc[4 * w + 3]);
        }
      }
    }
    const float* xr = h + (size_t)tok * 1024 + lane * 16;
    float v[16];
#pragma unroll
    for (int c = 0; c < 4; ++c) {
      f32x4 t = *reinterpret_cast<const f32x4*>(xr + c * 4);
#pragma unroll
      for (int k = 0; k < 4; ++k) v[4 * c + k] = ALPHA * t[k] + yacc[4 * c + k];
    }
    float s = 0.f;
#pragma unroll
    for (int i = 0; i < 16; ++i) s += v[i];
    const float mean = wave_sum(s) * (1.f / 1024.f);
    float q = 0.f;
#pragma unroll
    for (int i = 0; i < 16; ++i) { float d = v[i] - mean; q += d * d; }
    const float rstd = rsqrtf(wave_sum(q) * (1.f / 1024.f) + 1e-5f);
    float* orow = p.out + (size_t)tok * 1024 + lane * 16;
#pragma unroll
    for (int c = 0; c < 4; ++c) {
      f32x4 gg = *reinterpret_cast<const f32x4*>(p.ln_ffn_g + lane * 16 + c * 4);
      f32x4 bb = *reinterpret_cast<const f32x4*>(p.ln_ffn_b + lane * 16 + c * 4);
      f32x4 o;
#pragma unroll
      for (int k = 0; k < 4; ++k) o[k] = (v[4 * c + k] - mean) * rstd * gg[k] + bb[k];
      *reinterpret_cast<f32x4*>(orow + c * 4) = o;
    }
  }
}

constexpr size_t OFF_BAR = 166 * MiB;
DI void gbar(unsigned* ctr, unsigned target) {
  asm volatile("s_waitcnt vmcnt(0)" ::: "memory");
  __syncthreads();
  if (threadIdx.x == 0) {
    __builtin_amdgcn_fence(__ATOMIC_RELEASE, "agent");
    asm volatile("s_waitcnt vmcnt(0)" ::: "memory");
    __hip_atomic_fetch_add(ctr, 1u, __ATOMIC_RELAXED, __HIP_MEMORY_SCOPE_AGENT);
    while (__hip_atomic_load(ctr, __ATOMIC_RELAXED, __HIP_MEMORY_SCOPE_AGENT) < target) __builtin_amdgcn_s_sleep(2);
    __builtin_amdgcn_fence(__ATOMIC_ACQUIRE, "agent");
    asm volatile("s_waitcnt vmcnt(0)" ::: "memory");
  }
  __syncthreads();
}

#define XB_TMO      128
#define XB_XCNT(j)  (256  + 64 * (j))
#define XB_XSUB(j)  (1280 + 64 * (j))
#define XB_XGEN(j)  (2304 + 64 * (j))
#define XB_TOP      3328
#define XB_TOPGEN   3392
#define XCD_BAR_WORDS 3456
#define XB_SPIN_CAP (1u << 18)
#define LAS __attribute__((address_space(3)))
DI unsigned xb_ld(unsigned* p)              { return __hip_atomic_load(p, __ATOMIC_RELAXED, __HIP_MEMORY_SCOPE_AGENT); }
DI unsigned xb_add(unsigned* p, unsigned v) { return __hip_atomic_fetch_add(p, v, __ATOMIC_RELAXED, __HIP_MEMORY_SCOPE_AGENT); }
DI unsigned xb_xcc_id() { return (unsigned)__builtin_amdgcn_s_getreg((3 << 11) | 20) & 0xFu; }
#define XB_SPIN(cond, bar) do { unsigned _sp = 0; while (cond) { __builtin_amdgcn_s_sleep(1); \
    if ((++_sp & 255u) == 0u) { if (xb_ld(&(bar)[XB_TMO])) break; if (_sp > XB_SPIN_CAP) { atomicAdd(&(bar)[XB_TMO], 1u); break; } } } } while (0)
struct XcdBarrier { unsigned* bar; unsigned x; volatile LAS unsigned* st; };
DI XcdBarrier xcd_barrier_post(unsigned* bar, volatile LAS unsigned* st) {
  XcdBarrier b; b.bar = bar; b.x = xb_xcc_id(); b.st = st;
  if (threadIdx.x == 0) (void)xb_add(&bar[XB_XCNT(b.x)], 1u);
  return b;
}
DI void xcd_barrier_complete(unsigned* bar, unsigned x, unsigned& nloc, unsigned& nx) {
  const unsigned G = gridDim.x;
  unsigned sum, cnt, mine, sp = 0u;
  for (;;) {
    sum = 0u; cnt = 0u; mine = 0u;
#pragma unroll
    for (unsigned j = 0; j < 16; ++j) { const unsigned c = xb_ld(&bar[XB_XCNT(j)]); sum += c; cnt += (c > 0u) ? 1u : 0u; mine = (j == x) ? c : mine; }
    if (sum == G) break;
    __builtin_amdgcn_s_sleep(1);
    if ((++sp & 255u) == 0u) { if (xb_ld(&bar[XB_TMO])) break; if (sp > XB_SPIN_CAP) { atomicAdd(&bar[XB_TMO], 1u); break; } }
  }
  nloc = mine > 0u ? mine : 1u; nx = cnt > 0u ? cnt : 1u;
}
DI void xcd_barrier(const XcdBarrier& b) {
  asm volatile("s_waitcnt vmcnt(0)" ::: "memory");
  __syncthreads();
  if (threadIdx.x == 0) {
    unsigned* bar = b.bar;
    __builtin_amdgcn_s_waitcnt(0);
    unsigned nloc = b.st[0], nx = b.st[1];
    if (nloc == 0u) { xcd_barrier_complete(bar, b.x, nloc, nx); b.st[0] = nloc; b.st[1] = nx; }
    const unsigned old = xb_add(&bar[XB_XSUB(b.x)], 1u);
    const unsigned gen = old / nloc;
    if (old + 1u == (gen + 1u) * nloc) {
      __builtin_amdgcn_fence(__ATOMIC_RELEASE, "agent");
      asm volatile("s_waitcnt vmcnt(0)" ::: "memory");
      const unsigned og = xb_add(&bar[XB_TOP], 1u);
      const unsigned tg = og / nx;
      if (og + 1u == (tg + 1u) * nx) xb_add(&bar[XB_TOPGEN], 1u);
      else XB_SPIN(xb_ld(&bar[XB_TOPGEN]) == tg, bar);
      __builtin_amdgcn_fence(__ATOMIC_ACQUIRE, "agent");
      xb_add(&bar[XB_XGEN(b.x)], 1u);
      asm volatile("s_waitcnt vmcnt(0)" ::: "memory");
    } else {
      XB_SPIN(xb_ld(&bar[XB_XGEN(b.x)]) == gen, bar);
      __builtin_amdgcn_fence(__ATOMIC_ACQUIRE, "agent");
      asm volatile("s_waitcnt vmcnt(0)" ::: "memory");
    }
  }
  __syncthreads();
}

__global__ void __launch_bounds__(512) fwd_megakernel(Params p) {
  __shared__ __attribute__((aligned(1024))) char smem[155648];
  cg::grid_group grid = cg::this_grid();
  const int G = gridDim.x;
  char* ws = p.ws;
  unsigned* bar = (unsigned*)(ws + OFF_BAR);
  volatile LAS unsigned* xst = (volatile LAS unsigned*)(smem + 155648 - 16);
  if (threadIdx.x == 0) { xst[0] = 0u; xst[1] = 0u; }
  const XcdBarrier xb = xcd_barrier_post(bar, xst);

  phase_prep(p, smem);
  if (p.out == nullptr) grid.sync();
  xcd_barrier(xb);

  phase_inproj(p, smem);
  xcd_barrier(xb);

  for (int k = 0; k * G < 1024; ++k) {
    int j = (k & 1) ? (G - 1 - (int)blockIdx.x) : (int)blockIdx.x;
    int idx = k * G + j;
    if (idx < 1024) dsa_thr_item(p, idx & 7, 127 - (idx >> 3), smem);
  }
  for (int it = blockIdx.x; it < 2048; it += G) gla_g1_item(p, it, smem);
  xcd_barrier(xb);

  for (int k = 0; k * G < 1024; ++k) {
    int j = (k & 1) ? (G - 1 - (int)blockIdx.x) : (int)blockIdx.x;
    int idx = k * G + j;
    if (idx < 1024) dsa_attn_item(p, idx & 7, 127 - (idx >> 3), smem);
  }
  gla_scan(p);
  xcd_barrier(xb);

  for (int it = blockIdx.x; it < 2048; it += G) gla_g3_item(p, it, smem);
  xcd_barrier(xb);

  phase_gemm<0>(p, (const u16*)(ws + OFF_XB), (const u16*)(ws + OFF_WOUT), 1024, p.x, (float*)(ws + OFF_H), nullptr, 0, smem);
  xcd_barrier(xb);
  phase_ln(p, (float*)(ws + OFF_H), (u16*)(ws + OFF_HB), p.ln_mix_g, p.ln_mix_b);
  xcd_barrier(xb);

  phase_gemm<2>(p, (const u16*)(ws + OFF_HB), (const u16*)(ws + OFF_WQ), 1024, nullptr, nullptr, (u16*)(ws + OFF_QX), 1024, smem);
  xcd_barrier(xb);
  phase_xattn(p);
  xcd_barrier(xb);
  phase_gemm<0>(p, (const u16*)(ws + OFF_OX), (const u16*)(ws + OFF_WO), 1024, (const float*)(ws + OFF_H), (float*)(ws + OFF_H), nullptr, 0, smem);
  xcd_barrier(xb);
  phase_ln(p, (float*)(ws + OFF_H), (u16*)(ws + OFF_HB), p.ln_mem_g, p.ln_mem_b);
  xcd_barrier(xb);

  phase_gemm<5>(p, (const u16*)(ws + OFF_HB), (const u16*)(ws + OFF_WPQ), 2048, nullptr, nullptr, (u16*)(ws + OFF_QX), 2048, smem);
  xcd_barrier(xb);
  for (int it = blockIdx.x; it < 2048; it += G) peer_topk_item(p, it >> 3, it & 7, smem);
  xcd_barrier(xb);
  phase_peer_down(p);
  xcd_barrier(xb);
  phase_peer_ffn(p);
}

extern "C" void kernel_launch(void* const* d_in, const int* in_sizes, int n_in,
                              void* d_out, int out_size, void* d_ws, size_t ws_size,
                              hipStream_t stream) {
  static int grid_blocks = 0;
  if (!grid_blocks) {
    int dev = 0, cus = 0, per_cu = 0;
    (void)hipGetDevice(&dev);
    (void)hipDeviceGetAttribute(&cus, hipDeviceAttributeMultiprocessorCount, dev);
    (void)hipOccupancyMaxActiveBlocksPerMultiprocessor(&per_cu, fwd_megakernel, 512, 0);
    if (per_cu > 1) per_cu = 1;
    grid_blocks = cus * per_cu;
    if (grid_blocks > 256) grid_blocks = 256;
    if (ws_size < 512 * MiB) fprintf(stderr, "workspace too small: %zu\n", ws_size);
  }
  Params p{};
  p.x = (const float*)d_in[0]; p.positions = (const int*)d_in[1]; p.mem = (const float*)d_in[2]; p.w_in = (const float*)d_in[3];
  p.gate_up = (const float*)d_in[4]; p.gate_bias = (const float*)d_in[5]; p.norm_g = (const float*)d_in[6]; p.w_out = (const float*)d_in[7];
  p.ln_mix_g = (const float*)d_in[8]; p.ln_mix_b = (const float*)d_in[9];
  p.wq = (const float*)d_in[10]; p.wk = (const float*)d_in[11]; p.wv = (const float*)d_in[12]; p.wo = (const float*)d_in[13];
  p.ln_mem_g = (const float*)d_in[14]; p.ln_mem_b = (const float*)d_in[15];
  p.w_pq = (const float*)d_in[16]; p.sk1 = (const float*)d_in[17]; p.sk2 = (const float*)d_in[18];
  p.ex_down = (const float*)d_in[19]; p.ex_up = (const float*)d_in[20];
  p.ln_ffn_g = (const float*)d_in[21]; p.ln_ffn_b = (const float*)d_in[22];
  p.out = (float*)d_out; p.ws = (char*)d_ws;
  (void)hipMemsetAsync((char*)d_ws + OFF_BAR, 0, XCD_BAR_WORDS * sizeof(unsigned), stream);
  void* args[] = {&p};
  hipError_t e = hipLaunchCooperativeKernel((void*)fwd_megakernel, dim3(grid_blocks), dim3(512), args, 0, stream);
  if (e != hipSuccess) fprintf(stderr, "cooperative launch failed: %s (grid %d)\n", hipGetErrorString(e), grid_blocks);
}
```

```cpp
#include <hip/hip_runtime.h>
#include <hip/hip_cooperative_groups.h>
#include <cstdio>
#include <cmath>
namespace cg = cooperative_groups;

#define DI __device__ __forceinline__
typedef short bf16x8 __attribute__((ext_vector_type(8)));
typedef short bf16x4 __attribute__((ext_vector_type(4)));
typedef float f32x16 __attribute__((ext_vector_type(16)));
typedef float f32x4 __attribute__((ext_vector_type(4)));
typedef unsigned u32x4 __attribute__((ext_vector_type(4)));
typedef unsigned u32x2 __attribute__((ext_vector_type(2)));
typedef unsigned short u16;
typedef __bf16 bf2_t __attribute__((ext_vector_type(2)));
typedef float f2_t __attribute__((ext_vector_type(2)));

#define MFMA(a, b, c) __builtin_amdgcn_mfma_f32_32x32x16_bf16((a), (b), (c), 0, 0, 0)

constexpr int T_ = 32768;
constexpr int S_ = 4096;
constexpr int TMW = 2368;
constexpr int TM_Q = 0, TM_K = 512, TM_QI = 1024, TM_KI = 1280, TM_WI = 1312, TM_GLR = 1320, TM_GQ = 1344, TM_GK = 1600, TM_GR = 1856;
constexpr int PROJ_N = 3456;
constexpr float ALPHA = 1.189207115002721f;
constexpr size_t MiB = 1024 * 1024;

constexpr size_t OFF_XB = 0;
constexpr size_t OFF_EXD = 64 * MiB;
constexpr size_t OFF_EXU = 80 * MiB;
constexpr size_t OFF_BCG = 96 * MiB;
constexpr size_t OFF_WIN = 128 * MiB;
constexpr size_t OFF_WOUT = OFF_WIN + (size_t)PROJ_N * 1024 * 2;
constexpr size_t OFF_WQ = OFF_WOUT + 2 * MiB;
constexpr size_t OFF_WK = OFF_WQ + 2 * MiB;
constexpr size_t OFF_WV = OFF_WK + 2 * MiB;
constexpr size_t OFF_WO = OFF_WV + 2 * MiB;
constexpr size_t OFF_WPQ = OFF_WO + 2 * MiB;
constexpr size_t OFF_KIF = 149 * MiB;
constexpr size_t OFF_MEMB = 152 * MiB;
constexpr size_t OFF_MEMK = 156 * MiB;
constexpr size_t OFF_MEMVT = 160 * MiB;
constexpr size_t OFF_THR = 164 * MiB;
constexpr size_t OFF_SK = OFF_THR + 256 * 1024;
constexpr size_t OFF_DECAY = OFF_SK + 128 * 1024;
constexpr size_t OFF_ESC = 165 * MiB;
constexpr size_t OFF_TM = 168 * MiB;
constexpr size_t OFF_VT = 316 * MiB;
constexpr size_t OFF_KFR = 476 * MiB;
constexpr size_t OFF_GVT = 348 * MiB;
constexpr size_t OFF_KVT = 380 * MiB;
constexpr size_t OFF_PREV = 444 * MiB;
constexpr size_t OFF_H = 168 * MiB;
constexpr size_t OFF_HB = 296 * MiB;
constexpr size_t OFF_QX = 360 * MiB;
constexpr size_t OFF_OX = 424 * MiB;
constexpr size_t OFF_EIDX = 0;
constexpr size_t OFF_GATE = 16 * MiB;
constexpr size_t OFF_COEF = 32 * MiB;

struct Params {
  const float* x; const int* positions; const float* mem; const float* w_in;
  const float* gate_up; const float* gate_bias; const float* norm_g; const float* w_out;
  const float* ln_mix_g; const float* ln_mix_b;
  const float* wq; const float* wk; const float* wv; const float* wo;
  const float* ln_mem_g; const float* ln_mem_b;
  const float* w_pq; const float* sk1; const float* sk2; const float* ex_down; const float* ex_up;
  const float* ln_ffn_g; const float* ln_ffn_b;
  float* out; char* ws;
};

DI unsigned pk_bf16(float a, float b) {
  f2_t v = {a, b};
  bf2_t r = __builtin_convertvector(v, bf2_t);
  return __builtin_bit_cast(unsigned, r);
}
DI u16 f2bf(float a) { return (u16)(pk_bf16(a, 0.f) & 0xffffu); }
DI float bf2f(u16 u) { return __uint_as_float(((unsigned)u) << 16); }
DI float bflo(unsigned u) { return __uint_as_float(u << 16); }
DI float bfhi(unsigned u) { return __uint_as_float(u & 0xffff0000u); }
DI int crow(int i, int h) { return (i & 3) + 8 * (i >> 2) + 4 * h; }
DI bf16x8 ldg8(const u16* p) { return *reinterpret_cast<const bf16x8*>(p); }
DI bf16x8 pack8(float a0, float a1, float a2, float a3, float a4, float a5, float a6, float a7) {
  u32x4 r; r[0] = pk_bf16(a0, a1); r[1] = pk_bf16(a2, a3); r[2] = pk_bf16(a4, a5); r[3] = pk_bf16(a6, a7);
  return __builtin_bit_cast(bf16x8, r);
}
DI bf16x8 cat44(bf16x4 lo, bf16x4 hi) { return __builtin_shufflevector(lo, hi, 0, 1, 2, 3, 4, 5, 6, 7); }
DI void st4bf(u16* p, float a, float b, float c, float d) {
  u32x2 v; v[0] = pk_bf16(a, b); v[1] = pk_bf16(c, d);
  *reinterpret_cast<u32x2*>(p) = v;
}
DI float wave_sum(float v) {
#pragma unroll
  for (int d = 32; d >= 1; d >>= 1) v += __shfl_xor(v, d);
  return v;
}
DI void sincos_rad(float ang, float& s, float& c) {
  constexpr float C_hi = (float)0.15915494309189535;
  constexpr float C_lo = (float)(0.15915494309189535 - (double)C_hi);
  float k = rintf(ang * C_hi);
  float f = fmaf(ang, C_hi, -k);
  f = fmaf(ang, C_lo, f);
  s = __builtin_amdgcn_sinf(f);
  c = __builtin_amdgcn_cosf(f);
}
DI unsigned fkey(float s) {
  const unsigned u = __float_as_uint(s);
  return u ^ ((unsigned)((int)u >> 31) | 0x80000000u);
}
DI f32x16 zero16() { f32x16 z; for (int i = 0; i < 16; ++i) z[i] = 0.f; return z; }

DI int win_src_col(int n) {
  if (n < 1832) return n;
  if (n < 1848) return 2856 + (n - 1832);
  if (n < 1856) return -1;
  if (n < 2880) return n - 24;
  if (n < 3392) return n - 8;
  return -1;
}

DI void cvt_stream(const float* __restrict__ src, u16* __restrict__ dst, size_t n, size_t gtid, size_t gn) {
  size_t n8 = n / 8;
  for (size_t i = gtid; i < n8; i += gn) {
    f32x4 a = *reinterpret_cast<const f32x4*>(src + i * 8);
    f32x4 b = *reinterpret_cast<const f32x4*>(src + i * 8 + 4);
    u32x4 r; r[0] = pk_bf16(a[0], a[1]); r[1] = pk_bf16(a[2], a[3]); r[2] = pk_bf16(b[0], b[1]); r[3] = pk_bf16(b[2], b[3]);
    *reinterpret_cast<u32x4*>(dst + i * 8) = r;
  }
}

template <bool MAPPED>
DI void transpose_tile(const float* __restrict__ W, int ldn, u16* __restrict__ Wt, int k0, int n0, float* tile) {
  const int tid = threadIdx.x;
  {
    int nn = n0 + (tid & 63);
    int c = MAPPED ? win_src_col(nn) : nn;
#pragma unroll
    for (int rr = 0; rr < 8; ++rr) {
      int kk = (tid >> 6) + 8 * rr;
      float v = (c >= 0) ? W[(size_t)(k0 + kk) * ldn + c] : 0.f;
      tile[kk * 65 + (tid & 63)] = v;
    }
  }
  __syncthreads();
#pragma unroll
  for (int rr = 0; rr < 8; ++rr) {
    int nn = (tid >> 6) + 8 * rr;
    int kk = tid & 63;
    Wt[(size_t)(n0 + nn) * 1024 + k0 + kk] = f2bf(tile[kk * 65 + nn]);
  }
  __syncthreads();
}

DI void phase_prep(const Params& p, char* smem) {
  const size_t gtid = (size_t)blockIdx.x * blockDim.x + threadIdx.x;
  const size_t gn = (size_t)gridDim.x * blockDim.x;
  char* ws = p.ws;
  cvt_stream(p.x, (u16*)(ws + OFF_XB), (size_t)T_ * 1024, gtid, gn);
  cvt_stream(p.mem, (u16*)(ws + OFF_MEMB), (size_t)2048 * 1024, gtid, gn);
  {
    const int lane = threadIdx.x & 63;
    const int gw = (int)(gtid >> 6), nw = (int)(gn >> 6);
    for (int r = gw; r < 2 * 16384; r += nw) {
      const int tbl = r >> 14, row = r & 16383;
      const float* src = (tbl ? p.ex_up : p.ex_down) + (size_t)row * 1024 + lane * 16;
      f32x4 v[4]; float mx = 0.f;
#pragma unroll
      for (int c = 0; c < 4; ++c) {
        v[c] = *reinterpret_cast<const f32x4*>(src + c * 4);
#pragma unroll
        for (int k = 0; k < 4; ++k) mx = fmaxf(mx, fabsf(v[c][k]));
      }
#pragma unroll
      for (int d = 32; d >= 1; d >>= 1) mx = fmaxf(mx, __shfl_xor(mx, d));
      float sc = (mx > 0.f) ? exp2f(floorf(log2f(224.f / mx))) : 1.f;
      u32x4 o;
#pragma unroll
      for (int c = 0; c < 4; ++c) {
        int t = __builtin_amdgcn_cvt_pk_fp8_f32(v[c][0] * sc, v[c][1] * sc, 0, false);
        t = __builtin_amdgcn_cvt_pk_fp8_f32(v[c][2] * sc, v[c][3] * sc, t, true);
        o[c] = (unsigned)t;
      }
      *reinterpret_cast<u32x4*>(ws + (tbl ? OFF_EXU : OFF_EXD) + (size_t)row * 1024 + lane * 16) = o;
      if (lane == 0) ((float*)(ws + OFF_ESC))[r] = 1.f / sc;
    }
  }
  cvt_stream(p.sk1, (u16*)(ws + OFF_SK), (size_t)128 * 128, gtid, gn);
  cvt_stream(p.sk2, (u16*)(ws + OFF_SK) + 128 * 128, (size_t)128 * 128, gtid, gn);
  float* tile = (float*)smem;
  const int n_win = 54 * 16, n_sq = 256, n_pq = 512;
  const int total = n_win + 5 * n_sq + n_pq;
  for (int t = blockIdx.x; t < total; t += gridDim.x) {
    if (t < n_win) {
      transpose_tile<true>(p.w_in, 3384, (u16*)(ws + OFF_WIN), (t & 15) * 64, (t >> 4) * 64, tile);
    } else if (t < n_win + 5 * n_sq) {
      int u = t - n_win; int which = u >> 8; int r = u & 255;
      const float* W = which == 0 ? p.w_out : which == 1 ? p.wq : which == 2 ? p.wk : which == 3 ? p.wv : p.wo;
      size_t off = which == 0 ? OFF_WOUT : which == 1 ? OFF_WQ : which == 2 ? OFF_WK : which == 3 ? OFF_WV : OFF_WO;
      transpose_tile<false>(W, 1024, (u16*)(ws + off), (r & 15) * 64, (r >> 4) * 64, tile);
    } else {
      int r = t - n_win - 5 * n_sq;
      transpose_tile<false>(p.w_pq, 2048, (u16*)(ws + OFF_WPQ), (r & 15) * 64, (r >> 4) * 64, tile);
    }
  }
}

#define WAIT_V(n) asm volatile("s_waitcnt vmcnt(%0)" ::"n"(n) : "memory")
#define RAW_BARRIER() do { asm volatile("s_waitcnt lgkmcnt(0)" ::: "memory"); __builtin_amdgcn_s_barrier(); asm volatile("" ::: "memory"); } while (0)
constexpr int G_STAGE = 384 * 128;
DI void gemm_tile(const u16* __restrict__ X, int ldx, const u16* __restrict__ Wt, int ldw, int K, char* smem,
                  f32x16 (&acc)[2][2]) {
  const int tid = threadIdx.x, lane = tid & 63, wave = tid >> 6;
  const int fw = wave & 1, tq = wave >> 1, lr = lane & 31, lh = lane >> 5;
#pragma unroll
  for (int a = 0; a < 2; ++a)
#pragma unroll
    for (int b = 0; b < 2; ++b) acc[a][b] = zero16();
  const int nk = K / 64;
  const u16* src[6];
#pragma unroll
  for (int i = 0; i < 6; ++i) {
    const int R = 8 * (wave + 8 * i) + (lane >> 3);
    const int c = (lane & 7) ^ ((R >> 1) & 7);
    src[i] = (i < 4) ? (X + (size_t)R * ldx + c * 8) : (Wt + (size_t)(R - 256) * ldw + c * 8);
  }
#define GLDS_STAGE(slot, kt) do { _Pragma("unroll") for (int i = 0; i < 6; ++i) \
    __builtin_amdgcn_global_load_lds((const unsigned*)(src[i] + (kt) * 64), (__attribute__((address_space(3))) unsigned*)(smem + (slot) * G_STAGE + (wave + 8 * i) * 1024), 16, 0, 0); } while (0)
  int offA[2], offB[2], xa[2], xb[2];
#pragma unroll
  for (int ft = 0; ft < 2; ++ft) { const int R = 256 + fw * 64 + ft * 32 + lr; offA[ft] = R * 128; xa[ft] = (R >> 1) & 7; }
#pragma unroll
  for (int tt = 0; tt < 2; ++tt) { const int R = tq * 64 + tt * 32 + lr; offB[tt] = R * 128; xb[tt] = (R >> 1) & 7; }
  GLDS_STAGE(0, 0); GLDS_STAGE(1, 1); WAIT_V(6); RAW_BARRIER();
  int cur = 0;
  for (int kt = 0; kt < nk; ++kt) {
    const int nxt = (cur >= 1) ? cur - 1 : 2;
    if (kt + 2 < nk) GLDS_STAGE(nxt, kt + 2);
    __builtin_amdgcn_sched_barrier(0);
    const char* st = smem + cur * G_STAGE;
#pragma unroll
    for (int ks = 0; ks < 4; ++ks) {
      bf16x8 a[2], b[2];
#pragma unroll
      for (int ft = 0; ft < 2; ++ft) a[ft] = *reinterpret_cast<const bf16x8*>(st + offA[ft] + (((ks * 2 + lh) ^ xa[ft]) << 4));
#pragma unroll
      for (int tt = 0; tt < 2; ++tt) b[tt] = *reinterpret_cast<const bf16x8*>(st + offB[tt] + (((ks * 2 + lh) ^ xb[tt]) << 4));
#pragma unroll
      for (int ft = 0; ft < 2; ++ft)
#pragma unroll
        for (int tt = 0; tt < 2; ++tt) acc[ft][tt] = MFMA(a[ft], b[tt], acc[ft][tt]);
    }
    if (kt + 2 < nk) { WAIT_V(6); } else { WAIT_V(0); }
    RAW_BARRIER();
    cur = (cur == 2) ? 0 : cur + 1;
  }
#undef GLDS_STAGE
}

DI void store_tm_rows(f32x16 (&acc)[2][2], char* smem, u16* tm, int tokbase, int col) {
  const int lane = threadIdx.x & 63, wave = threadIdx.x >> 6, lr = lane & 31, lh = lane >> 5;
  float* wl = (float*)(smem + wave * 17408);
#pragma unroll
  for (int tt = 0; tt < 2; ++tt)
#pragma unroll
    for (int ft = 0; ft < 2; ++ft)
#pragma unroll
      for (int g = 0; g < 4; ++g) {
        f32x4 v = {acc[ft][tt][4 * g], acc[ft][tt][4 * g + 1], acc[ft][tt][4 * g + 2], acc[ft][tt][4 * g + 3]};
        *reinterpret_cast<f32x4*>(wl + (tt * 32 + lr) * 68 + ft * 32 + 8 * g + 4 * lh) = v;
      }
  const int ch = lane & 15, r0 = lane >> 4;
#pragma unroll 4
  for (int k = 0; k < 16; ++k) {
    const int row = r0 + 4 * k;
    f32x4 v = *reinterpret_cast<const f32x4*>(wl + row * 68 + ch * 4);
    st4bf(tm + (size_t)(tokbase + row) * TMW + col + ch * 4, v[0], v[1], v[2], v[3]);
  }
}

DI void epi_inproj(const Params& p, int tok0, int f0, f32x16 (&acc)[2][2], char* smem) {
  const int tid = threadIdx.x, lane = tid & 63, wave = tid >> 6;
  const int fw = wave & 1, tq = wave >> 1, lr = lane & 31, lh = lane >> 5;
  const int fbase = f0 + fw * 64;
  if (fbase >= 3392) return;
  u16* tm = (u16*)(p.ws + OFF_TM);
  int tmcol = -1;
#pragma unroll
  for (int tt = 0; tt < 2; ++tt) {
    const int tok = tok0 + tq * 64 + tt * 32 + lr;
    const float posf = (float)p.positions[tok];
    const int bb = tok >> 12, ss = tok & 4095;
    if (fbase < 1024) {
#pragma unroll
      for (int r = 0; r < 4; ++r) {
        float j = (float)(4 * lh + r);
        float inv = exp2f(-j * (18.931568569324174f / 8.0f));
        float sn, cs; sincos_rad(posf * inv, sn, cs);
        float x1 = acc[0][tt][r], x2 = acc[0][tt][r + 4];
        acc[0][tt][r] = x1 * cs - x2 * sn;
        acc[0][tt][r + 4] = x2 * cs + x1 * sn;
      }
      if (fbase < 512) {
        tmcol = fbase;
      } else {
        u16* kfr = (u16*)(p.ws + OFF_KFR);
        const int head = (fbase - 512) >> 6, gt = ss >> 5;
#pragma unroll
        for (int ft = 0; ft < 2; ++ft)
#pragma unroll
          for (int g = 0; g < 4; ++g) {
            const int ks = ft * 2 + (g >> 1), lane2 = (g & 1) * 32 + lr;
            st4bf(kfr + ((((size_t)(bb * 8 + head) * 128 + gt) * 4 + ks) * 64 + lane2) * 8 + 4 * lh, acc[ft][tt][4 * g], acc[ft][tt][4 * g + 1], acc[ft][tt][4 * g + 2], acc[ft][tt][4 * g + 3]);
          }
      }
    } else if (fbase < 1536) {
      u16* vfr = (u16*)(p.ws + OFF_VT);
      const int head = (fbase - 1024) >> 6, gt = ss >> 5;
      const int s = lr >> 4, r16 = lr & 15, j = 4 * (r16 >> 3) + (r16 & 3), lh2 = (r16 >> 2) & 1;
#pragma unroll
      for (int ft = 0; ft < 2; ++ft)
#pragma unroll
        for (int i = 0; i < 16; ++i) {
          const int lane2 = lh2 * 32 + crow(i, lh);
          vfr[((((((size_t)(bb * 8 + head) * 128 + gt) * 2 + ft) * 2 + s) * 64 + lane2) * 8) + j] = f2bf(acc[ft][tt][i]);
        }
    } else if (fbase >= 2368 && fbase < 2880) {
      u16* vt = (u16*)(p.ws + OFF_GVT);
      const int fo = fbase - 2368;
#pragma unroll
      for (int ft = 0; ft < 2; ++ft)
#pragma unroll
        for (int i = 0; i < 16; ++i) {
          int feat = fo + ft * 32 + crow(i, lh);
          vt[((size_t)bb * 512 + feat) * 4096 + ss] = f2bf(acc[ft][tt][i]);
        }
    } else {
      if (fbase < 1856) {
#pragma unroll
        for (int ft = 0; ft < 2; ++ft) {
          const bool rot = (fbase < 1792) || (ft == 0);
#pragma unroll
          for (int r = 0; r < 4; ++r) {
            float v = acc[ft][tt][r];
            float o = __shfl_xor(v, 32);
            float inv = exp2f(-(float)r * (18.931568569324174f / 4.0f));
            float sn, cs; sincos_rad(posf * inv, sn, cs);
            float res = (lh == 0) ? (v * cs - o * sn) : (v * cs + o * sn);
            acc[ft][tt][r] = rot ? res : v;
          }
        }
        tmcol = fbase - 512;
        if (fbase == 1792) {
          u16* kif = (u16*)(p.ws + OFF_KIF);
          const int gt = ss >> 5;
#pragma unroll
          for (int g = 0; g < 4; ++g) {
            const int ks = g >> 1, lane2 = (g & 1) * 32 + lr;
            st4bf(kif + ((((size_t)bb * 128 + gt) * 2 + ks) * 64 + lane2) * 8 + 4 * lh, acc[0][tt][4 * g], acc[0][tt][4 * g + 1], acc[0][tt][4 * g + 2], acc[0][tt][4 * g + 3]);
          }
        }
      } else if (fbase < 2368) {
        tmcol = fbase - 512;
      } else {
        tmcol = fbase - 1024;
      }
    }
  }
  if (tmcol >= 0) store_tm_rows(acc, smem, tm, tok0 + tq * 64, tmcol);
}

DI void phase_inproj(const Params& p, char* smem) {
  const int n_in = 128 * 27;
  const int total = n_in + 128;
  const u16* xb = (const u16*)(p.ws + OFF_XB);
  const u16* memb = (const u16*)(p.ws + OFF_MEMB);
  const int tid = threadIdx.x, lane = tid & 63, wave = tid >> 6;
  const int fw = wave & 1, tq = wave >> 1, lr = lane & 31, lh = lane >> 5;
  const int xg = blockIdx.x & 7, xi = blockIdx.x >> 3, xn = gridDim.x >> 3;
  for (int u = xi; u < 16 * 27 + 16; u += xn) {
    f32x16 acc[2][2];
    const int t = (u < 16 * 27) ? (xg * 16 + (u / 27)) * 27 + (u % 27) : n_in + (u - 16 * 27) * 8 + xg;
    if (t < n_in) {
      int mt = t / 27, nt = t % 27;
      gemm_tile(xb + (size_t)mt * 256 * 1024, 1024, (const u16*)(p.ws + OFF_WIN) + (size_t)nt * 128 * 1024, 1024, 1024, smem, acc);
      epi_inproj(p, mt * 256, nt * 128, acc, smem);
      __syncthreads();
    } else {
      int u = t - n_in; int which = u >> 6; int r = u & 63; int mt = r >> 3, nt = r & 7;
      const u16* W = (const u16*)(p.ws + (which == 0 ? OFF_WK : OFF_WV));
      gemm_tile(memb + (size_t)mt * 256 * 1024, 1024, W + (size_t)nt * 128 * 1024, 1024, 1024, smem, acc);
#pragma unroll
      for (int tt = 0; tt < 2; ++tt) {
        const int tok = mt * 256 + tq * 64 + tt * 32 + lr;
        const int bb = tok >> 8, mm = tok & 255, hh = nt >> 1, kt = mm >> 5;
        if (which == 0) {
          u16* mk = (u16*)(p.ws + OFF_MEMK);
#pragma unroll
          for (int ft = 0; ft < 2; ++ft)
#pragma unroll
            for (int g = 0; g < 4; ++g) {
              const int ks = (nt & 1) * 8 + fw * 4 + ft * 2 + (g >> 1), lane2 = (g & 1) * 32 + lr;
              st4bf(mk + ((((size_t)(bb * 4 + hh) * 8 + kt) * 16 + ks) * 64 + lane2) * 8 + 4 * lh, acc[ft][tt][4 * g], acc[ft][tt][4 * g + 1], acc[ft][tt][4 * g + 2], acc[ft][tt][4 * g + 3]);
            }
        } else {
          u16* mv = (u16*)(p.ws + OFF_MEMVT);
          const int s = lr >> 4, r16 = lr & 15, j = 4 * (r16 >> 3) + (r16 & 3), lh2 = (r16 >> 2) & 1;
#pragma unroll
          for (int ft = 0; ft < 2; ++ft) {
            const int dt = (nt & 1) * 4 + fw * 2 + ft;
#pragma unroll
            for (int i = 0; i < 16; ++i) {
              const int lane2 = lh2 * 32 + crow(i, lh);
              mv[((((((size_t)(bb * 4 + hh) * 8 + dt) * 8 + kt) * 2 + s) * 64 + lane2) * 8) + j] = f2bf(acc[ft][tt][i]);
            }
          }
        }
      }
    }
  }
}

DI void idx_scores(const bf16x8 (&qf)[8][2], const float (&wq)[8], bf16x8 k0, bf16x8 k1, float (&sc)[16]) {
#pragma unroll
  for (int i = 0; i < 16; ++i) sc[i] = 0.f;
#pragma unroll
  for (int hd = 0; hd < 8; ++hd) {
    f32x16 a = zero16();
    a = MFMA(k0, qf[hd][0], a);
    a = MFMA(k1, qf[hd][1], a);
#pragma unroll
    for (int i = 0; i < 16; ++i) sc[i] = fmaf(wq[hd], fmaxf(a[i], 0.f), sc[i]);
  }
}

DI void load_idx_q(const u16* tm, int tok, int lh, bf16x8 (&qf)[8][2], float (&wq)[8]) {
  const u16* row = tm + (size_t)tok * TMW;
#pragma unroll
  for (int hd = 0; hd < 8; ++hd)
#pragma unroll
    for (int ks = 0; ks < 2; ++ks) qf[hd][ks] = ldg8(row + TM_QI + hd * 32 + ks * 16 + lh * 8);
  bf16x8 w8 = ldg8(row + TM_WI);
#pragma unroll
  for (int hd = 0; hd < 8; ++hd) wq[hd] = bf2f((u16)w8[hd]) * 0.0625f;
}

DI int wave_incl_scan(int v, int lane) {
#pragma unroll
  for (int d = 1; d < 64; d <<= 1) {
    int t = __shfl_up(v, d);
    if (lane >= d) v += t;
  }
  return v;
}

DI void dsa_thr_item(const Params& p, int b, int qblk, char* smem) {
  unsigned* hist = (unsigned*)smem;
  unsigned* pref = (unsigned*)(smem + 32768);
  int* rank = (int*)(smem + 32768 + 128);
  const u16* tm = (const u16*)(p.ws + OFF_TM);
  const int tid = threadIdx.x, lane = tid & 63, wave = tid >> 6, lr = lane & 31, lh = lane >> 5;
  const int q0 = qblk * 32;
  u16* qi = (u16*)(smem + 33280);
  for (int i = tid; i < 32 * 32; i += 512) {
    int q = i >> 5, ch = i & 31;
    *reinterpret_cast<u32x4*>(qi + q * 296 + ch * 8) = *reinterpret_cast<const u32x4*>(tm + (size_t)(b * S_ + q0 + q) * TMW + TM_QI + ch * 8);
  }
  float wq[8];
  {
    bf16x8 w8 = ldg8(tm + (size_t)(b * S_ + q0 + lr) * TMW + TM_WI);
#pragma unroll
    for (int hd = 0; hd < 8; ++hd) wq[hd] = bf2f((u16)w8[hd]) * 0.0625f;
  }
  __syncthreads();
  for (int i = tid; i < 32 * 32; i += 512) {
    const int q = i >> 5, d = i & 31;
    float acc = 0.f;
#pragma unroll
    for (int hd = 0; hd < 8; ++hd) acc = fmaf(bf2f(tm[(size_t)(b * S_ + q0 + q) * TMW + TM_WI + hd]) * 0.0625f, bf2f(qi[q * 296 + hd * 32 + d]), acc);
    qi[q * 296 + 256 + d] = f2bf(acc);
  }
  const u16* qil = qi + lr * 296 + lh * 8;
  if (tid < 32) { pref[tid] = 0u; rank[tid] = min(256, q0 + tid + 1); }
  for (int pass = 0; pass < 4; ++pass) {
    for (int i = tid; i < 8192; i += 512) hist[i] = 0u;
    __syncthreads();
    const int shift = 24 - 8 * pass;
    const unsigned mypref = pref[lr];
    const u16* kib = (const u16*)(p.ws + OFF_KIF) + (size_t)b * 128 * 1024 + lane * 8;
    bf16x8 kn0, kn1;
    {
      const int kt0 = min(wave, qblk);
      kn0 = ldg8(kib + (size_t)kt0 * 1024); kn1 = ldg8(kib + (size_t)kt0 * 1024 + 512);
    }
    for (int kt = wave; kt <= qblk; kt += 8) {
      const bf16x8 k0 = kn0, k1 = kn1;
      {
        const int ktn = min(kt + 8, qblk);
        kn0 = ldg8(kib + (size_t)ktn * 1024); kn1 = ldg8(kib + (size_t)ktn * 1024 + 512);
      }
      float sc[16];
      {
        f32x16 a = zero16();
        a = MFMA(k0, *reinterpret_cast<const bf16x8*>(qil + 256), a);
        a = MFMA(k1, *reinterpret_cast<const bf16x8*>(qil + 256 + 16), a);
#pragma unroll
        for (int i = 0; i < 16; ++i) sc[i] = a[i];
      }
#pragma unroll
      for (int hd = 0; hd < 8; ++hd) {
        f32x16 a = zero16();
        a = MFMA(k0, *reinterpret_cast<const bf16x8*>(qil + hd * 32), a);
        a = MFMA(k1, *reinterpret_cast<const bf16x8*>(qil + hd * 32 + 16), a);
        const float wh = wq[hd];
#pragma unroll
        for (int i = 0; i < 16; ++i) sc[i] = fmaf(fabsf(a[i]), wh, sc[i]);
      }
      if (kt == qblk) {
#pragma unroll
        for (int i = 0; i < 16; ++i) {
          int kp = kt * 32 + crow(i, lh);
          unsigned ky = fkey(sc[i]);
          unsigned hi = (ky >> shift);
          if (kp <= q0 + lr && (hi >> 8) == mypref) atomicAdd(&hist[(hi & 255u) * 32 + lr], 1u);
        }
      } else {
#pragma unroll
        for (int i = 0; i < 16; ++i) {
          unsigned ky = fkey(sc[i]);
          unsigned hi = (ky >> shift);
          if ((hi >> 8) == mypref) atomicAdd(&hist[(hi & 255u) * 32 + lr], 1u);
        }
      }
    }
    __syncthreads();
#pragma unroll 1
    for (int qq = 0; qq < 4; ++qq) {
      const int q = wave * 4 + qq;
      const int rk = rank[q];
      int c[4];
#pragma unroll
      for (int j = 0; j < 4; ++j) c[j] = (int)hist[(255 - 4 * lane - j) * 32 + q];
      int s = c[0] + c[1] + c[2] + c[3];
      int P = wave_incl_scan(s, lane);
      int excl = P - s;
      if (P >= rk && excl < rk) {
        int cum = excl; int bin = 0; int nr = 1; bool found = false;
#pragma unroll
        for (int j = 0; j < 4; ++j) {
          if (!found && cum + c[j] >= rk) { bin = 255 - 4 * lane - j; nr = rk - cum; found = true; }
          if (!found) cum += c[j];
        }
        pref[q] = (pref[q] << 8) | (unsigned)bin;
        rank[q] = nr;
      }
    }
    __syncthreads();
  }
  if (tid < 32) ((unsigned*)(p.ws + OFF_THR))[b * S_ + q0 + tid] = pref[tid];
  __syncthreads();
}

DI void dsa_attn_item(const Params& p, int b, int qblk, char* smem) {
  u16* maskbuf = (u16*)smem;
  u16* qi = (u16*)(smem + 4096);
  const u16* tm = (const u16*)(p.ws + OFF_TM);
  const u16* vfr = (const u16*)(p.ws + OFF_VT) + ((size_t)(b * 8 + (threadIdx.x >> 6)) * 128) * 2048 + (threadIdx.x & 63) * 8;
  const u16* kfr = (const u16*)(p.ws + OFF_KFR) + ((size_t)(b * 8 + (threadIdx.x >> 6)) * 128) * 2048 + (threadIdx.x & 63) * 8;
  const unsigned* thr = (const unsigned*)(p.ws + OFF_THR);
  const int tid = threadIdx.x, lane = tid & 63, wave = tid >> 6, lr = lane & 31, lh = lane >> 5;
  const int q0 = qblk * 32;
  const int head = wave;
  const int qtok = b * S_ + q0 + lr;
  bf16x8 Qf[4];
#pragma unroll
  for (int ks = 0; ks < 4; ++ks) {
    bf16x8 raw = ldg8(tm + (size_t)qtok * TMW + TM_Q + head * 64 + ks * 16 + lh * 8);
    float f[8];
#pragma unroll
    for (int j = 0; j < 8; ++j) f[j] = bf2f((u16)raw[j]) * (0.125f * 1.4426950408889634f);
    Qf[ks] = pack8(f[0], f[1], f[2], f[3], f[4], f[5], f[6], f[7]);
  }
  f32x16 O[2];
  O[0] = zero16(); O[1] = zero16();
  float mrun = -INFINITY, lrun = 0.f;
  const unsigned thrq = thr[qtok];
  const int nchunks = (q0 + 31) / 256 + 1;
  for (int i = tid; i < 32 * 32; i += 512) {
    int q = i >> 5, ch = i & 31;
    *reinterpret_cast<u32x4*>(qi + q * 296 + ch * 8) = *reinterpret_cast<const u32x4*>(tm + (size_t)(b * S_ + q0 + q) * TMW + TM_QI + ch * 8);
  }
  float* wqs = (float*)(smem + 4096 + 32 * 296 * 2);
  if (tid < 256) wqs[tid] = bf2f(tm[(size_t)(b * S_ + q0 + (tid & 31)) * TMW + TM_WI + (tid >> 5)]) * 0.0625f;
  __syncthreads();
  for (int i = tid; i < 32 * 32; i += 512) {
    const int q = i >> 5, d = i & 31;
    float acc = 0.f;
#pragma unroll
    for (int hd = 0; hd < 8; ++hd) acc = fmaf(bf2f(tm[(size_t)(b * S_ + q0 + q) * TMW + TM_WI + hd]) * 0.0625f, bf2f(qi[q * 296 + hd * 32 + d]), acc);
    qi[q * 296 + 256 + d] = f2bf(acc);
  }
  __syncthreads();
  const u16* qil = qi + lr * 296 + lh * 8;
  const u16* kibase = (const u16*)(p.ws + OFF_KIF) + (size_t)b * 128 * 1024 + lane * 8;
  bf16x8 Kf[4], Kn[4];
#pragma unroll
  for (int ks = 0; ks < 4; ++ks) Kf[ks] = ldg8(kfr + ks * 512);
  bf16x8 Vf[2][2], Vn[2][2];
#pragma unroll
  for (int dt = 0; dt < 2; ++dt)
#pragma unroll
    for (int s = 0; s < 2; ++s) Vf[dt][s] = ldg8(vfr + (dt * 2 + s) * 512);
  bf16x8 ki0, ki1;
  {
    const int kt0 = min(wave, qblk);
    ki0 = ldg8(kibase + (size_t)kt0 * 1024); ki1 = ldg8(kibase + (size_t)kt0 * 1024 + 512);
  }
  for (int c = 0; c < nchunks; ++c) {
    const int buf = c & 1;
    {
      const int key0 = (c * 8 + wave) * 32;
      unsigned bits = 0u;
      const bf16x8 k0 = ki0, k1 = ki1;
      {
        const int ktn = min((c + 1) * 8 + wave, qblk);
        ki0 = ldg8(kibase + (size_t)ktn * 1024); ki1 = ldg8(kibase + (size_t)ktn * 1024 + 512);
      }
      if (key0 <= q0 + 31) {
        float sc[16];
        {
          f32x16 a = zero16();
          a = MFMA(k0, *reinterpret_cast<const bf16x8*>(qil + 256), a);
          a = MFMA(k1, *reinterpret_cast<const bf16x8*>(qil + 256 + 16), a);
#pragma unroll
          for (int i = 0; i < 16; ++i) sc[i] = a[i];
        }
#pragma unroll 2
        for (int hd = 0; hd < 8; ++hd) {
          f32x16 a = zero16();
          a = MFMA(k0, *reinterpret_cast<const bf16x8*>(qil + hd * 32), a);
          a = MFMA(k1, *reinterpret_cast<const bf16x8*>(qil + hd * 32 + 16), a);
          const float wh = wqs[hd * 32 + lr];
#pragma unroll
          for (int i = 0; i < 16; ++i) sc[i] = fmaf(fabsf(a[i]), wh, sc[i]);
        }
        __builtin_amdgcn_sched_barrier(0);
#pragma unroll
        for (int i = 0; i < 16; ++i) {
          int kp = key0 + crow(i, lh);
          if (kp <= q0 + lr && fkey(sc[i]) >= thrq) bits |= (1u << i);
        }
      }
      maskbuf[(buf * 8 + wave) * 64 + lane] = (u16)bits;
    }
    __syncthreads();
#pragma unroll 1
    for (int t8 = 0; t8 < 8; ++t8) {
      const int g = c * 8 + t8;
      if (g > qblk) break;
      {
        const int gn = min(g + 1, qblk);
        const u16* kr = kfr + (size_t)gn * 2048;
#pragma unroll
        for (int ks = 0; ks < 4; ++ks) Kn[ks] = ldg8(kr + ks * 512);
#pragma unroll
        for (int dt = 0; dt < 2; ++dt)
#pragma unroll
          for (int s = 0; s < 2; ++s) Vn[dt][s] = ldg8(vfr + (size_t)gn * 2048 + (dt * 2 + s) * 512);
      }

      const unsigned bits = maskbuf[(buf * 8 + t8) * 64 + lane];
      f32x16 Sx = zero16();
#pragma unroll
      for (int ks = 0; ks < 4; ++ks) Sx = MFMA(Kf[ks], Qf[ks], Sx);
      float sm[16];
#pragma unroll
      for (int i = 0; i < 16; ++i) {
        const unsigned t = (unsigned)__builtin_amdgcn_sbfe((int)bits, i, 1);
        sm[i] = __uint_as_float((t & __float_as_uint(Sx[i])) | (~t & 0xff800000u));
      }
      float mt = fmaxf(fmaxf(fmaxf(sm[0], sm[1]), fmaxf(sm[2], sm[3])), fmaxf(fmaxf(sm[4], sm[5]), fmaxf(sm[6], sm[7])));
      mt = fmaxf(mt, fmaxf(fmaxf(fmaxf(sm[8], sm[9]), fmaxf(sm[10], sm[11])), fmaxf(fmaxf(sm[12], sm[13]), fmaxf(sm[14], sm[15]))));
      mt = fmaxf(mt, __shfl_xor(mt, 32));
      if (__builtin_amdgcn_ballot_w64(mt > mrun + 8.f) != 0ull) {
        const float mnew = fmaxf(mrun, mt);
        const float ms = (mnew == -INFINITY) ? 0.f : mnew;
        const float alpha = __builtin_amdgcn_exp2f(mrun - ms);
        lrun *= alpha;
        mrun = mnew;
#pragma unroll
        for (int dt = 0; dt < 2; ++dt)
#pragma unroll
          for (int i = 0; i < 16; ++i) O[dt][i] *= alpha;
      }
      const float msafe = (mrun == -INFINITY) ? 0.f : mrun;
      float pv[16]; float ps = 0.f;
#pragma unroll
      for (int i = 0; i < 16; ++i) { pv[i] = __builtin_amdgcn_exp2f(sm[i] - msafe); ps += pv[i]; }
      lrun += ps;
      bf16x8 Pf[2];
#pragma unroll
      for (int s = 0; s < 2; ++s) Pf[s] = pack8(pv[8 * s], pv[8 * s + 1], pv[8 * s + 2], pv[8 * s + 3], pv[8 * s + 4], pv[8 * s + 5], pv[8 * s + 6], pv[8 * s + 7]);
#pragma unroll
      for (int dt = 0; dt < 2; ++dt)
#pragma unroll
        for (int s = 0; s < 2; ++s) O[dt] = MFMA(Vf[dt][s], Pf[s], O[dt]);
#pragma unroll
      for (int ks = 0; ks < 4; ++ks) Kf[ks] = Kn[ks];
#pragma unroll
      for (int dt = 0; dt < 2; ++dt)
#pragma unroll
        for (int s = 0; s < 2; ++s) Vf[dt][s] = Vn[dt][s];
    }
  }
  u16* y = (u16*)(p.ws + OFF_XB);
  {
    float lt = lrun + __shfl_xor(lrun, 32);
    float inv = 1.f / lt;
#pragma unroll
    for (int dt = 0; dt < 2; ++dt)
#pragma unroll
      for (int g = 0; g < 4; ++g)
        st4bf(y + (size_t)qtok * 1024 + head * 64 + dt * 32 + 8 * g + 4 * lh, O[dt][4 * g] * inv, O[dt][4 * g + 1] * inv, O[dt][4 * g + 2] * inv, O[dt][4 * g + 3] * inv);
  }
  __syncthreads();
}

DI void gla_bcum(const Params& p, int b, int h, int n, float* bc, float* glr_s, float* segtot) {
  const u16* tm = (const u16*)(p.ws + OFF_TM);
  const int tid = threadIdx.x;
  const int tok0 = b * S_ + n * 64;
  for (int i = tid; i < 1024; i += 512) glr_s[i] = bf2f(tm[(size_t)(tok0 + (i >> 4)) * TMW + TM_GLR + (i & 15)]);
  const int d = tid & 63, cgp = tid >> 6;
  float gu[16];
#pragma unroll
  for (int j = 0; j < 16; ++j) gu[j] = p.gate_up[j * 256 + h * 64 + d];
  const float bias = p.gate_bias[h * 64 + d];
  __syncthreads();
  float v[8]; float run = 0.f;
#pragma unroll
  for (int r = 0; r < 8; ++r) {
    const int c = cgp * 8 + r;
    float z = bias;
#pragma unroll
    for (int j4 = 0; j4 < 4; ++j4) {
      const f32x4 gv = *reinterpret_cast<const f32x4*>(glr_s + c * 16 + j4 * 4);
#pragma unroll
      for (int j = 0; j < 4; ++j) z = fmaf(gv[j], gu[j4 * 4 + j], z);
    }
    float la = (fminf(z, 0.f) - __logf(1.f + __expf(-fabsf(z)))) * 0.0625f;
    run += la; v[r] = run;
  }
  segtot[cgp * 64 + d] = run;
  __syncthreads();
  float off = 0.f;
#pragma unroll
  for (int g = 0; g < 8; ++g) off += (g < cgp) ? segtot[g * 64 + d] : 0.f;
#pragma unroll
  for (int r = 0; r < 8; ++r) bc[(cgp * 8 + r) * 64 + d] = off + v[r];
  __syncthreads();
}

DI void gla_g1_item(const Params& p, int item, char* smem) {
  float* bc = (float*)smem;
  float* glr_s = (float*)(smem + 16384);
  float* segtot = (float*)(smem + 20480);
  u16* KeT = (u16*)(smem + 22528);
  const int b = item >> 8, h = (item >> 6) & 3, n = item & 63;
  const u16* tm = (const u16*)(p.ws + OFF_TM);
  const u16* gvT = (const u16*)(p.ws + OFF_GVT);
  const int tid = threadIdx.x, lane = tid & 63, wave = tid >> 6, lr = lane & 31, lh = lane >> 5;
  const int tok0 = b * S_ + n * 64;
  u16 kraw[8];
  {
    const int d = tid & 63, cgp = tid >> 6;
#pragma unroll
    for (int r = 0; r < 8; ++r) kraw[r] = tm[(size_t)(tok0 + cgp * 8 + r) * TMW + TM_GK + h * 64 + d];
  }
  bf16x8 afr[4];
  {
    const int et = wave & 3;
    const u16* arow = gvT + ((size_t)b * 512 + h * 128 + et * 32 + lr) * 4096 + n * 64 + lh * 8;
#pragma unroll
    for (int ks = 0; ks < 4; ++ks) afr[ks] = ldg8(arow + ks * 16);
  }
  gla_bcum(p, b, h, n, bc, glr_s, segtot);
  {
    const int d = tid & 63, cgp = tid >> 6;
    const float blast = bc[63 * 64 + d];
    {
      float* bcg = (float*)(p.ws + OFF_BCG) + (size_t)item * 4096;
#pragma unroll
      for (int r = 0; r < 8; ++r) bcg[(cgp * 8 + r) * 64 + d] = bc[(cgp * 8 + r) * 64 + d];
    }
    float f[8];
#pragma unroll
    for (int r = 0; r < 8; ++r) {
      const int c = cgp * 8 + r;
      float kv = bf2f(kraw[r]);
      f[r] = kv * __expf(blast - bc[c * 64 + d]);
    }
    *reinterpret_cast<bf16x8*>(KeT + d * 72 + cgp * 8) = pack8(f[0], f[1], f[2], f[3], f[4], f[5], f[6], f[7]);
    if (cgp == 0) ((float*)(p.ws + OFF_DECAY))[item * 64 + d] = __expf(blast);
  }
  __syncthreads();
  {
    const int et = wave & 3, dtl = wave >> 2;
    f32x16 acc = zero16();
#pragma unroll
    for (int ks = 0; ks < 4; ++ks) {
      bf16x8 a = afr[ks];
      bf16x8 bb = *reinterpret_cast<const bf16x8*>(KeT + (dtl * 32 + lr) * 72 + ks * 16 + lh * 8);
      acc = MFMA(a, bb, acc);
    }
    float* kvT = (float*)(p.ws + OFF_KVT);
#pragma unroll
    for (int i = 0; i < 16; ++i) kvT[((size_t)item * 128 + et * 32 + crow(i, lh)) * 64 + dtl * 32 + lr] = acc[i];
  }
  __syncthreads();
}

DI void gla_scan(const Params& p) {
  const float* kvT = (const float*)(p.ws + OFF_KVT);
  const float* decay = (const float*)(p.ws + OFF_DECAY);
  u16* prev = (u16*)(p.ws + OFF_PREV);
  const int gtid = blockIdx.x * blockDim.x + threadIdx.x;
  const int gn = gridDim.x * blockDim.x;
  for (int u = gtid; u < 32 * 2048; u += gn) {
    const int bh = u >> 11, rem = u & 2047, e = rem >> 4, d4 = (rem & 15) * 4;
    f32x4 st = {0.f, 0.f, 0.f, 0.f};
#pragma unroll 4
    for (int n = 0; n < 64; ++n) {
      const int item = bh * 64 + n;
      st4bf(prev + ((size_t)item * 128 + e) * 64 + d4, st[0], st[1], st[2], st[3]);
      f32x4 dc = *reinterpret_cast<const f32x4*>(decay + item * 64 + d4);
      f32x4 kv = *reinterpret_cast<const f32x4*>(kvT + ((size_t)item * 128 + e) * 64 + d4);
      st = dc * st + kv;
    }
  }
}

DI void gla_g3_item(const Params& p, int item, char* smem) {
  float* red = (float*)smem;
  const int b = item >> 8, h = (item >> 6) & 3, n = item & 63;
  const u16* tm = (const u16*)(p.ws + OFF_TM);
  const u16* gvT = (const u16*)(p.ws + OFF_GVT);
  const u16* prev = (const u16*)(p.ws + OFF_PREV);
  const float* bcg = (const float*)(p.ws + OFF_BCG) + (size_t)item * 4096;
  const int tid = threadIdx.x, lane = tid & 63, wave = tid >> 6, lr = lane & 31, lh = lane >> 5;
  const int tok0 = b * S_ + n * 64;
  const int et = wave & 3, ct = wave >> 2;
  bf16x8 qraw[4], kraw[2][4], sfr[4];
  bf16x4 vlo[2][2], vhi[2][2];
  f32x4 bq[4][2];
  {
    const u16* vrow0 = gvT + ((size_t)b * 512 + h * 128 + et * 32 + lr) * 4096 + n * 64 + 4 * lh;
    const u16* srow0 = prev + ((size_t)item * 128 + et * 32 + lr) * 64 + lh * 8;
#pragma unroll
    for (int ks = 0; ks < 4; ++ks) {
      qraw[ks] = ldg8(tm + (size_t)(tok0 + ct * 32 + lr) * TMW + TM_GQ + h * 64 + ks * 16 + lh * 8);
      kraw[0][ks] = ldg8(tm + (size_t)(tok0 + lr) * TMW + TM_GK + h * 64 + ks * 16 + lh * 8);
      kraw[1][ks] = ldg8(tm + (size_t)(tok0 + ct * 32 + lr) * TMW + TM_GK + h * 64 + ks * 16 + lh * 8);
      sfr[ks] = ldg8(srow0 + ks * 16);
      bq[ks][0] = *reinterpret_cast<const f32x4*>(bcg + (ct * 32 + lr) * 64 + ks * 16 + lh * 8);
      bq[ks][1] = *reinterpret_cast<const f32x4*>(bcg + (ct * 32 + lr) * 64 + ks * 16 + lh * 8 + 4);
    }
#pragma unroll
    for (int st = 0; st < 2; ++st)
#pragma unroll
      for (int s2 = 0; s2 < 2; ++s2) {
        const u16* vp = vrow0 + (st * ct) * 32 + 16 * s2;
        vlo[st][s2] = *reinterpret_cast<const bf16x4*>(vp);
        vhi[st][s2] = *reinterpret_cast<const bf16x4*>(vp + 8);
      }
  }
  bf16x8 Qd[4];
#pragma unroll
  for (int ks = 0; ks < 4; ++ks) {
    float f[8];
#pragma unroll
    for (int j = 0; j < 8; ++j) f[j] = bf2f((u16)qraw[ks][j]) * 0.125f * __expf(bq[ks][j >> 2][j & 3]);
    Qd[ks] = pack8(f[0], f[1], f[2], f[3], f[4], f[5], f[6], f[7]);
  }
  f32x16 O = zero16();
#pragma unroll
  for (int st = 0; st < 2; ++st) {
    if (st <= ct) {
      f32x16 A = zero16();
      const int s = st * 32 + lr;
#pragma unroll
      for (int ks = 0; ks < 4; ++ks) {
        f32x4 b0 = (st == 1) ? bq[ks][0] : *reinterpret_cast<const f32x4*>(bcg + s * 64 + ks * 16 + lh * 8);
        f32x4 b1 = (st == 1) ? bq[ks][1] : *reinterpret_cast<const f32x4*>(bcg + s * 64 + ks * 16 + lh * 8 + 4);
        float f[8];
#pragma unroll
        for (int j = 0; j < 8; ++j) f[j] = bf2f((u16)kraw[st][ks][j]) * __expf(-((j < 4) ? b0[j & 3] : b1[j & 3]));
        bf16x8 Ki = pack8(f[0], f[1], f[2], f[3], f[4], f[5], f[6], f[7]);
        A = MFMA(Ki, Qd[ks], A);
      }
      float pv[16];
#pragma unroll
      for (int i = 0; i < 16; ++i) pv[i] = (st * 32 + crow(i, lh) <= ct * 32 + lr) ? A[i] : 0.f;
#pragma unroll
      for (int s2 = 0; s2 < 2; ++s2) {
        bf16x8 Pf = pack8(pv[8 * s2], pv[8 * s2 + 1], pv[8 * s2 + 2], pv[8 * s2 + 3], pv[8 * s2 + 4], pv[8 * s2 + 5], pv[8 * s2 + 6], pv[8 * s2 + 7]);
        O = MFMA(cat44(vlo[st][s2], vhi[st][s2]), Pf, O);
      }
    }
  }
#pragma unroll
  for (int ks = 0; ks < 4; ++ks) O = MFMA(sfr[ks], Qd[ks], O);
  float ss = 0.f;
#pragma unroll
  for (int i = 0; i < 16; ++i) ss += O[i] * O[i];
  ss += __shfl_xor(ss, 32);
  if (lh == 0) red[(ct * 4 + et) * 32 + lr] = ss;
  __syncthreads();
  const float tot = red[(ct * 4 + 0) * 32 + lr] + red[(ct * 4 + 1) * 32 + lr] + red[(ct * 4 + 2) * 32 + lr] + red[(ct * 4 + 3) * 32 + lr];
  const float rinv = rsqrtf(tot * (1.f / 128.f) + 1e-6f);
  const int tok = tok0 + ct * 32 + lr;
  u16* y = (u16*)(p.ws + OFF_XB);
#pragma unroll
  for (int g = 0; g < 4; ++g) {
    const int e0 = et * 32 + 8 * g + 4 * lh;
    u32x2 gr = *reinterpret_cast<const u32x2*>(tm + (size_t)tok * TMW + TM_GR + h * 128 + e0);
    f32x4 ng = *reinterpret_cast<const f32x4*>(p.norm_g + e0);
    float grv[4] = {bflo(gr[0]), bfhi(gr[0]), bflo(gr[1]), bfhi(gr[1])};
    float o[4];
#pragma unroll
    for (int r = 0; r < 4; ++r) {
      float sl = grv[r] / (1.f + __expf(-grv[r]));
      o[r] = O[4 * g + r] * rinv * ng[r] * sl;
    }
    st4bf(y + (size_t)tok * 1024 + 512 + h * 128 + e0, o[0], o[1], o[2], o[3]);
  }
  __syncthreads();
}

template <int MODE>
DI void phase_gemm(const Params& p, const u16* X, const u16* Wt, int N, const float* resid, float* outf, u16* outb, int ldo, char* smem) {
  const int ntn = N / 128;
  const int tid = threadIdx.x, lane = tid & 63, wave = tid >> 6;
  const int fw = wave & 1, tq = wave >> 1, lr = lane & 31, lh = lane >> 5;
  const int xg = blockIdx.x & 7, xi = blockIdx.x >> 3, xn = gridDim.x >> 3;
  const int per_group = 16 * ntn;
  for (int u = xi; u < per_group; u += xn) {
    const int mt = xg + 8 * (u / ntn), nt = u % ntn;
    f32x16 acc[2][2];
    gemm_tile(X + (size_t)mt * 256 * 1024, 1024, Wt + (size_t)nt * 128 * 1024, 1024, 1024, smem, acc);
    if (MODE == 0 || MODE == 1) {
      float* wl = (float*)(smem + wave * 17408);
#pragma unroll
      for (int tt = 0; tt < 2; ++tt)
#pragma unroll
        for (int ft = 0; ft < 2; ++ft)
#pragma unroll
          for (int g = 0; g < 4; ++g) {
            f32x4 v = {acc[ft][tt][4 * g], acc[ft][tt][4 * g + 1], acc[ft][tt][4 * g + 2], acc[ft][tt][4 * g + 3]};
            *reinterpret_cast<f32x4*>(wl + (tt * 32 + lr) * 68 + ft * 32 + 8 * g + 4 * lh) = v;
          }
      const int ch = lane & 15, r0 = lane >> 4;
      const int f = nt * 128 + fw * 64 + ch * 4;
#pragma unroll 4
      for (int k = 0; k < 16; ++k) {
        const int row = r0 + 4 * k;
        const int tok = mt * 256 + tq * 64 + row;
        f32x4 v = *reinterpret_cast<const f32x4*>(wl + row * 68 + ch * 4);
        if (MODE == 0) {
          f32x4 r = *reinterpret_cast<const f32x4*>(resid + (size_t)tok * 1024 + f);
          f32x4 o;
#pragma unroll
          for (int j = 0; j < 4; ++j) o[j] = ALPHA * r[j] + v[j];
          *reinterpret_cast<f32x4*>(outf + (size_t)tok * 1024 + f) = o;
        } else {
          st4bf(outb + (size_t)tok * ldo + f, v[0], v[1], v[2], v[3]);
        }
      }
      __syncthreads();
    } else {
#pragma unroll
      for (int tt = 0; tt < 2; ++tt) {
        const int tok = mt * 256 + tq * 64 + tt * 32 + lr;
#pragma unroll
        for (int ft = 0; ft < 2; ++ft)
#pragma unroll
          for (int g = 0; g < 4; ++g) {
            const int f = nt * 128 + fw * 64 + ft * 32 + 8 * g + 4 * lh;
            if (MODE == 2) {
              const int hh = f >> 8, fh = f & 255, ks = fh >> 4, lane2 = ((fh >> 3) & 1) * 32 + lr;
              st4bf(outb + ((((size_t)(tok >> 5) * 4 + hh) * 16 + ks) * 64 + lane2) * 8 + 4 * lh, acc[ft][tt][4 * g], acc[ft][tt][4 * g + 1], acc[ft][tt][4 * g + 2], acc[ft][tt][4 * g + 3]);
            } else {
              const int hh = f >> 8, fq = f & 127, half = (f >> 7) & 1, ks = fq >> 4, lane2 = ((fq >> 3) & 1) * 32 + lr;
              st4bf(outb + (((((size_t)(tok >> 5) * 8 + hh) * 2 + half) * 8 + ks) * 64 + lane2) * 8 + 4 * lh, acc[ft][tt][4 * g], acc[ft][tt][4 * g + 1], acc[ft][tt][4 * g + 2], acc[ft][tt][4 * g + 3]);
            }
          }
      }
    }
  }
}

DI void phase_ln(const Params& p, float* h, u16* hb, const float* g, const float* bta) {
  const int lane = threadIdx.x & 63;
  const int xg = blockIdx.x & 7, xw = (blockIdx.x >> 3) * 8 + (threadIdx.x >> 6), xnw = (gridDim.x >> 3) * 8;
  for (int lrw = xw; lrw < 4096; lrw += xnw) {
    const int row = (xg + 8 * (lrw >> 8)) * 256 + (lrw & 255);
    float* r = h + (size_t)row * 1024;
    f32x4 v[4]; float s = 0.f;
#pragma unroll
    for (int c = 0; c < 4; ++c) { v[c] = *reinterpret_cast<const f32x4*>(r + c * 256 + lane * 4); s += v[c][0] + v[c][1] + v[c][2] + v[c][3]; }
    const float mean = wave_sum(s) * (1.f / 1024.f);
    float q = 0.f;
#pragma unroll
    for (int c = 0; c < 4; ++c)
#pragma unroll
      for (int k = 0; k < 4; ++k) { float d = v[c][k] - mean; q += d * d; }
    const float rstd = rsqrtf(wave_sum(q) * (1.f / 1024.f) + 1e-5f);
#pragma unroll
    for (int c = 0; c < 4; ++c) {
      f32x4 gg = *reinterpret_cast<const f32x4*>(g + c * 256 + lane * 4);
      f32x4 bb = *reinterpret_cast<const f32x4*>(bta + c * 256 + lane * 4);
      f32x4 o;
#pragma unroll
      for (int k = 0; k < 4; ++k) o[k] = (v[c][k] - mean) * rstd * gg[k] + bb[k];
      *reinterpret_cast<f32x4*>(r + c * 256 + lane * 4) = o;
      st4bf(hb + (size_t)row * 1024 + c * 256 + lane * 4, o[0], o[1], o[2], o[3]);
    }
  }
}

DI void phase_xattn(const Params& p) {
  const u16* qx = (const u16*)(p.ws + OFF_QX);
  const u16* mk = (const u16*)(p.ws + OFF_MEMK);
  const u16* mv = (const u16*)(p.ws + OFF_MEMVT);
  u16* ox = (u16*)(p.ws + OFF_OX);
  const int lane = threadIdx.x & 63, lr = lane & 31, lh = lane >> 5;
  const int xg = blockIdx.x & 7, xw = (blockIdx.x >> 3) * 8 + (threadIdx.x >> 6), xnw = (gridDim.x >> 3) * 8;
  for (int li = xw; li < 512; li += xnw) {
    const int qtl = li & 15, h = (li >> 4) & 3, b = li >> 6;
    const int qt = (xg + 8 * (qtl >> 3)) * 8 + (qtl & 7);
    const int tok = b * S_ + qt * 32 + lr;
    f32x16 Sx[8];
#pragma unroll
    for (int kt = 0; kt < 8; ++kt) Sx[kt] = zero16();
    const u16* qrow = qx + (((size_t)(b * 128 + qt) * 4 + h) * 16) * 512 + lane * 8;
    const u16* krow = mk + (((size_t)(b * 4 + h) * 8) * 16) * 512 + lane * 8;
#pragma unroll 2
    for (int ks = 0; ks < 16; ++ks) {
      bf16x8 qf = ldg8(qrow + ks * 512);
#pragma unroll
      for (int kt = 0; kt < 8; ++kt) Sx[kt] = MFMA(ldg8(krow + (kt * 16 + ks) * 512), qf, Sx[kt]);
    }
    float mx = -INFINITY;
#pragma unroll
    for (int kt = 0; kt < 8; ++kt)
#pragma unroll
      for (int i = 0; i < 16; ++i) mx = fmaxf(mx, Sx[kt][i]);
    mx = fmaxf(mx, __shfl_xor(mx, 32));
    float ls = 0.f;
    bf16x8 Pf[8][2];
#pragma unroll
    for (int kt = 0; kt < 8; ++kt) {
      float pv[16];
#pragma unroll
      for (int i = 0; i < 16; ++i) { pv[i] = __expf((Sx[kt][i] - mx) * 0.0625f); ls += pv[i]; }
#pragma unroll
      for (int s = 0; s < 2; ++s) Pf[kt][s] = pack8(pv[8 * s], pv[8 * s + 1], pv[8 * s + 2], pv[8 * s + 3], pv[8 * s + 4], pv[8 * s + 5], pv[8 * s + 6], pv[8 * s + 7]);
    }
    ls += __shfl_xor(ls, 32);
    const float inv = 1.f / ls;
#pragma unroll 1
    for (int dt = 0; dt < 8; ++dt) {
      f32x16 o = zero16();
      const u16* vrow = mv + ((((size_t)(b * 4 + h) * 8 + dt) * 8) * 2) * 512 + lane * 8;
#pragma unroll
      for (int kt = 0; kt < 8; ++kt)
#pragma unroll
        for (int s = 0; s < 2; ++s) o = MFMA(ldg8(vrow + (kt * 2 + s) * 512), Pf[kt][s], o);
#pragma unroll
      for (int g = 0; g < 4; ++g)
        st4bf(ox + (size_t)tok * 1024 + h * 256 + dt * 32 + 8 * g + 4 * lh, o[4 * g] * inv, o[4 * g + 1] * inv, o[4 * g + 2] * inv, o[4 * g + 3] * inv);
    }
  }
}

DI void peer_topk_item(const Params& p, int tt128, int head, char* smem) {
  float* sc = (float*)smem;
  float* topv = (float*)(smem + 132096);
  unsigned char* topi = (unsigned char*)(smem + 132096 + 16384);
  const u16* pq = (const u16*)(p.ws + OFF_QX);
  const u16* sk = (const u16*)(p.ws + OFF_SK);
  const int tid = threadIdx.x, lane = tid & 63, wave = tid >> 6, lr = lane & 31, lh = lane >> 5;
  const int tok0 = tt128 * 128;
  {
    const int half = wave >> 2, kt = wave & 3;
    bf16x8 af[8];
#pragma unroll
    for (int ks = 0; ks < 8; ++ks) af[ks] = ldg8(sk + (size_t)half * 16384 + (kt * 32 + lr) * 128 + ks * 16 + lh * 8);
#pragma unroll 1
    for (int tt = 0; tt < 4; ++tt) {
      f32x16 acc = zero16();
      const u16* brow = pq + (((((size_t)(tok0 >> 5) + tt) * 8 + head) * 2 + half) * 8) * 512 + lane * 8;
#pragma unroll
      for (int ks = 0; ks < 8; ++ks) acc = MFMA(af[ks], ldg8(brow + ks * 512), acc);
#pragma unroll
      for (int i = 0; i < 16; ++i) sc[(half * 128 + tt * 32 + lr) * 129 + kt * 32 + crow(i, lh)] = acc[i];
    }
  }
  __syncthreads();
  if (tid < 256) {
    float* row = sc + tid * 129;
    float gm[8]; int gi[8];
#pragma unroll
    for (int g = 0; g < 8; ++g) {
      float m = -INFINITY; int mi = g * 16;
#pragma unroll
      for (int j = 0; j < 16; ++j) { float v = row[g * 16 + j]; if (v > m) { m = v; mi = g * 16 + j; } }
      gm[g] = m; gi[g] = mi;
    }
#pragma unroll 1
    for (int r = 0; r < 16; ++r) {
      float best = gm[0]; int bg = 0; int bi = gi[0];
#pragma unroll
      for (int g = 1; g < 8; ++g) if (gm[g] > best) { best = gm[g]; bg = g; bi = gi[g]; }
      topv[tid * 16 + r] = best; topi[tid * 16 + r] = (unsigned char)bi;
      row[bi] = -INFINITY;
      float m = -INFINITY; int mi = bg * 16;
#pragma unroll
      for (int j = 0; j < 16; ++j) { float v = row[bg * 16 + j]; if (v > m) { m = v; mi = bg * 16 + j; } }
#pragma unroll
      for (int g = 0; g < 8; ++g) { gm[g] = (g == bg) ? m : gm[g]; gi[g] = (g == bg) ? mi : gi[g]; }
    }
  }
  __syncthreads();
  if (tid < 128) {
    const float* av = topv + tid * 16;
    const float* bv = topv + (128 + tid) * 16;
    const unsigned char* ai = topi + tid * 16;
    const unsigned char* bi_ = topi + (128 + tid) * 16;
    float cur[16]; int pp[16];
    const float b0 = bv[0];
#pragma unroll
    for (int i = 0; i < 16; ++i) { cur[i] = av[i] + b0; pp[i] = 0; }
    float sel[16]; int eid[16];
#pragma unroll
    for (int r = 0; r < 16; ++r) {
      float best = cur[0]; int bi = 0; int bj = pp[0];
#pragma unroll
      for (int i = 1; i < 16; ++i) if (cur[i] > best) { best = cur[i]; bi = i; bj = pp[i]; }
      sel[r] = best;
      eid[r] = (int)ai[bi] * 128 + (int)bi_[bj];
      const int nj = bj + 1;
      const float nv = (nj < 16) ? (av[bi] + bv[nj & 15]) : -INFINITY;
#pragma unroll
      for (int i = 0; i < 16; ++i) { cur[i] = (i == bi) ? nv : cur[i]; pp[i] = (i == bi) ? nj : pp[i]; }
    }
    float sum = 0.f;
    const float smax = sel[0];
#pragma unroll
    for (int r = 0; r < 16; ++r) { sel[r] = __expf(sel[r] - smax); sum += sel[r]; }
    const float inv = 1.f / sum;
    int* eo = (int*)(p.ws + OFF_EIDX) + (size_t)(tok0 + tid) * 128 + head * 16;
    float* go = (float*)(p.ws + OFF_GATE) + (size_t)(tok0 + tid) * 128 + head * 16;
#pragma unroll
    for (int r = 0; r < 16; ++r) { eo[r] = eid[r]; go[r] = sel[r] * inv; }
  }
  __syncthreads();
}

DI float dot2bf(unsigned a, unsigned b, float c) {
  return __builtin_amdgcn_fdot2_f32_bf16(__builtin_bit_cast(bf2_t, a), __builtin_bit_cast(bf2_t, b), c, false);
}

DI float reduce8(float (&part)[8], int lane) {
  float r4[4], r2[2], r1;
#pragma unroll
  for (int k = 0; k < 4; ++k) {
    float send = (lane & 1) ? part[2 * k] : part[2 * k + 1];
    float keep = (lane & 1) ? part[2 * k + 1] : part[2 * k];
    r4[k] = keep + __shfl_xor(send, 1);
  }
#pragma unroll
  for (int k = 0; k < 2; ++k) {
    float send = (lane & 2) ? r4[2 * k] : r4[2 * k + 1];
    float keep = (lane & 2) ? r4[2 * k + 1] : r4[2 * k];
    r2[k] = keep + __shfl_xor(send, 2);
  }
  {
    float send = (lane & 4) ? r2[0] : r2[1];
    float keep = (lane & 4) ? r2[1] : r2[0];
    r1 = keep + __shfl_xor(send, 4);
  }
  r1 += __shfl_xor(r1, 8);
  r1 += __shfl_xor(r1, 16);
  r1 += __shfl_xor(r1, 32);
  return r1;
}

DI void phase_peer_down(const Params& p) {
  const char* exd = p.ws + OFF_EXD;
  const float* esc = (const float*)(p.ws + OFF_ESC);
  const u16* hb = (const u16*)(p.ws + OFF_HB);
  const int* eidx = (const int*)(p.ws + OFF_EIDX);
  const float* gate = (const float*)(p.ws + OFF_GATE);
  float* coefw = (float*)(p.ws + OFF_COEF);
  const int lane = threadIdx.x & 63;
  const int gw = (blockIdx.x * blockDim.x + threadIdx.x) >> 6;
  const int nw = (gridDim.x * blockDim.x) >> 6;
#pragma unroll 1
  for (int tok = gw; tok < T_; tok += nw) {
    float x[16];
    {
      const u16* xr = hb + (size_t)tok * 1024 + lane * 16;
      u32x4 a = *reinterpret_cast<const u32x4*>(xr);
      u32x4 c = *reinterpret_cast<const u32x4*>(xr + 8);
#pragma unroll
      for (int w = 0; w < 4; ++w) { x[2 * w] = bflo(a[w]); x[2 * w + 1] = bfhi(a[w]); x[8 + 2 * w] = bflo(c[w]); x[8 + 2 * w + 1] = bfhi(c[w]); }
    }
#pragma unroll 1
    for (int half = 0; half < 2; ++half) {
      const size_t slot = (size_t)tok * 128 + half * 64 + lane;
      const int ev = eidx[slot];
      const float gv = gate[slot];
      float racc = 0.f, gacc = 0.f;
#pragma unroll 1
      for (int bi = 0; bi < 8; ++bi) {
        u32x4 dr[8];
#pragma unroll
        for (int k = 0; k < 8; ++k) {
          const int er = __builtin_amdgcn_readlane(ev, bi * 8 + k);
          dr[k] = *reinterpret_cast<const u32x4*>(exd + (size_t)er * 1024 + lane * 16);
        }
        const int pmine = bi * 8 + (lane & 7);
        const int emine = __shfl(ev, pmine);
        const float gsel = __shfl(gv, pmine);
        const float sd = esc[emine];
        const float su = esc[16384 + emine];
        float part[8];
#pragma unroll
        for (int k = 0; k < 8; ++k) {
          float a0 = 0.f, a1 = 0.f;
#pragma unroll
          for (int w = 0; w < 4; ++w) {
            f2_t lo = __builtin_amdgcn_cvt_pk_f32_fp8((int)dr[k][w], false);
            f2_t hi = __builtin_amdgcn_cvt_pk_f32_fp8((int)dr[k][w], true);
            a0 = fmaf(lo[0], x[4 * w], a0); a1 = fmaf(lo[1], x[4 * w + 1], a1);
            a0 = fmaf(hi[0], x[4 * w + 2], a0); a1 = fmaf(hi[1], x[4 * w + 3], a1);
          }
          part[k] = a0 + a1;
        }
        const float r1 = reduce8(part, lane) * sd;
        const bool mine = (lane >> 3) == bi;
        racc = mine ? r1 : racc; gacc = mine ? gsel * su : gacc;
      }
      const float act = 0.5f * racc * (1.f + erff(racc * 0.70710678118654752f));
      coefw[slot] = gacc * act;
    }
  }
}

DI void phase_peer_ffn(const Params& p) {
  const char* exu = p.ws + OFF_EXU;
  const float* h = (const float*)(p.ws + OFF_H);
  const int* eidx = (const int*)(p.ws + OFF_EIDX);
  const float* coefw = (const float*)(p.ws + OFF_COEF);
  const int lane = threadIdx.x & 63;
  const int gw = (blockIdx.x * blockDim.x + threadIdx.x) >> 6;
  const int nw = (gridDim.x * blockDim.x) >> 6;
  for (int tok = gw; tok < T_; tok += nw) {
    float yacc[16];
#pragma unroll
    for (int i = 0; i < 16; ++i) yacc[i] = 0.f;
    const int e_lo = eidx[(size_t)tok * 128 + lane];
    const int e_hi = eidx[(size_t)tok * 128 + 64 + lane];
    const float c_lo = coefw[(size_t)tok * 128 + lane];
    const float c_hi = coefw[(size_t)tok * 128 + 64 + lane];
#pragma unroll 1
    for (int eb = 0; eb < 8; ++eb) {
      const int ev = (eb < 4) ? e_lo : e_hi;
      const float cv = (eb < 4) ? c_lo : c_hi;
      const int lbase = (eb & 3) * 16;
      u32x4 ur[16];
#pragma unroll
      for (int k = 0; k < 16; ++k) {
        const int er = __builtin_amdgcn_readlane(ev, lbase + k);
        ur[k] = *reinterpret_cast<const u32x4*>(exu + (size_t)er * 1024 + lane * 16);
      }
#pragma unroll
      for (int k = 0; k < 16; ++k) {
        const float ck = __int_as_float(__builtin_amdgcn_readlane(__float_as_int(cv), lbase + k));
#pragma unroll
        for (int w = 0; w < 4; ++w) {
          f2_t lo = __builtin_amdgcn_cvt_pk_f32_fp8((int)ur[k][w], false);
          f2_t hi = __builtin_amdgcn_cvt_pk_f32_fp8((int)ur[k][w], true);
          yacc[4 * w] = fmaf(ck, lo[0], yacc[4 * w]);
          yacc[4 * w + 1] = fmaf(ck, lo[1], yacc[4 * w + 1]);
          yacc[4 * w + 2] = fmaf(ck, hi[0], yacc[4 * w + 2]);
          yacc[4 * w + 3] = fmaf(ck, hi[1], yacc[4 * w + 3]);
        }
      }
    }
    const float* xr = h + (size_t)tok * 1024 + lane * 16;
    float v[16];
#pragma unroll
    for (int c = 0; c < 4; ++c) {
      f32x4 t = *reinterpret_cast<const f32x4*>(xr + c * 4);
#pragma unroll
      for (int k = 0; k < 4; ++k) v[4 * c + k] = ALPHA * t[k] + yacc[4 * c + k];
    }
    float s = 0.f;
#pragma unroll
    for (int i = 0; i < 16; ++i) s += v[i];
    const float mean = wave_sum(s) * (1.f / 1024.f);
    float q = 0.f;
#pragma unroll
    for (int i = 0; i < 16; ++i) { float d = v[i] - mean; q += d * d; }
    const float rstd = rsqrtf(wave_sum(q) * (1.f / 1024.f) + 1e-5f);
    float* orow = p.out + (size_t)tok * 1024 + lane * 16;
#pragma unroll
    for (int c = 0; c < 4; ++c) {
      f32x4 gg = *reinterpret_cast<const f32x4*>(p.ln_ffn_g + lane * 16 + c * 4);
      f32x4 bb = *reinterpret_cast<const f32x4*>(p.ln_ffn_b + lane * 16 + c * 4);
      f32x4 o;
#pragma unroll
      for (int k = 0; k < 4; ++k) o[k] = (v[4 * c + k] - mean) * rstd * gg[k] + bb[k];
      *reinterpret_cast<f32x4*>(orow + c * 4) = o;
    }
  }
}

constexpr size_t OFF_BAR = 166 * MiB;
DI void gbar(unsigned* ctr, unsigned target) {
  asm volatile("s_waitcnt vmcnt(0)" ::: "memory");
  __syncthreads();
  if (threadIdx.x == 0) {
    __builtin_amdgcn_fence(__ATOMIC_RELEASE, "agent");
    asm volatile("s_waitcnt vmcnt(0)" ::: "memory");
    __hip_atomic_fetch_add(ctr, 1u, __ATOMIC_RELAXED, __HIP_MEMORY_SCOPE_AGENT);
    while (__hip_atomic_load(ctr, __ATOMIC_RELAXED, __HIP_MEMORY_SCOPE_AGENT) < target) __builtin_amdgcn_s_sleep(2);
    __builtin_amdgcn_fence(__ATOMIC_ACQUIRE, "agent");
    asm volatile("s_waitcnt vmcnt(0)" ::: "memory");
  }
  __syncthreads();
}

#define XB_TMO      128
#define XB_XCNT(j)  (256  + 64 * (j))
#define XB_XSUB(j)  (1280 + 64 * (j))
#define XB_XGEN(j)  (2304 + 64 * (j))
#define XB_TOP      3328
#define XB_TOPGEN   3392
#define XCD_BAR_WORDS 3456
#define XB_SPIN_CAP (1u << 18)
#define LAS __attribute__((address_space(3)))
DI unsigned xb_ld(unsigned* p)              { return __hip_atomic_load(p, __ATOMIC_RELAXED, __HIP_MEMORY_SCOPE_AGENT); }
DI unsigned xb_add(unsigned* p, unsigned v) { return __hip_atomic_fetch_add(p, v, __ATOMIC_RELAXED, __HIP_MEMORY_SCOPE_AGENT); }
DI unsigned xb_xcc_id() { return (unsigned)__builtin_amdgcn_s_getreg((3 << 11) | 20) & 0xFu; }
#define XB_SPIN(cond, bar) do { unsigned _sp = 0; while (cond) { __builtin_amdgcn_s_sleep(1); \
    if ((++_sp & 255u) == 0u) { if (xb_ld(&(bar)[XB_TMO])) break; if (_sp > XB_SPIN_CAP) { atomicAdd(&(bar)[XB_TMO], 1u); break; } } } } while (0)
struct XcdBarrier { unsigned* bar; unsigned x; volatile LAS unsigned* st; };
DI XcdBarrier xcd_barrier_post(unsigned* bar, volatile LAS unsigned* st) {
  XcdBarrier b; b.bar = bar; b.x = xb_xcc_id(); b.st = st;
  if (threadIdx.x == 0) (void)xb_add(&bar[XB_XCNT(b.x)], 1u);
  return b;
}
DI void xcd_barrier_complete(unsigned* bar, unsigned x, unsigned& nloc, unsigned& nx) {
  const unsigned G = gridDim.x;
  unsigned sum, cnt, mine, sp = 0u;
  for (;;) {
    sum = 0u; cnt = 0u; mine = 0u;
#pragma unroll
    for (unsigned j = 0; j < 16; ++j) { const unsigned c = xb_ld(&bar[XB_XCNT(j)]); sum += c; cnt += (c > 0u) ? 1u : 0u; mine = (j == x) ? c : mine; }
    if (sum == G) break;
    __builtin_amdgcn_s_sleep(1);
    if ((++sp & 255u) == 0u) { if (xb_ld(&bar[XB_TMO])) break; if (sp > XB_SPIN_CAP) { atomicAdd(&bar[XB_TMO], 1u); break; } }
  }
  nloc = mine > 0u ? mine : 1u; nx = cnt > 0u ? cnt : 1u;
}
DI void xcd_barrier(const XcdBarrier& b) {
  asm volatile("s_waitcnt vmcnt(0)" ::: "memory");
  __syncthreads();
  if (threadIdx.x == 0) {
    unsigned* bar = b.bar;
    __builtin_amdgcn_s_waitcnt(0);
    unsigned nloc = b.st[0], nx = b.st[1];
    if (nloc == 0u) { xcd_barrier_complete(bar, b.x, nloc, nx); b.st[0] = nloc; b.st[1] = nx; }
    const unsigned old = xb_add(&bar[XB_XSUB(b.x)], 1u);
    const unsigned gen = old / nloc;
    if (old + 1u == (gen + 1u) * nloc) {
      __builtin_amdgcn_fence(__ATOMIC_RELEASE, "agent");
      asm volatile("s_waitcnt vmcnt(0)" ::: "memory");
      const unsigned og = xb_add(&bar[XB_TOP], 1u);
      const unsigned tg = og / nx;
      if (og + 1u == (tg + 1u) * nx) xb_add(&bar[XB_TOPGEN], 1u);
      else XB_SPIN(xb_ld(&bar[XB_TOPGEN]) == tg, bar);
      __builtin_amdgcn_fence(__ATOMIC_ACQUIRE, "agent");
      xb_add(&bar[XB_XGEN(b.x)], 1u);
      asm volatile("s_waitcnt vmcnt(0)" ::: "memory");
    } else {
      XB_SPIN(xb_ld(&bar[XB_XGEN(b.x)]) == gen, bar);
      __builtin_amdgcn_fence(__ATOMIC_ACQUIRE, "agent");
      asm volatile("s_waitcnt vmcnt(0)" ::: "memory");
    }
  }
  __syncthreads();
}

__global__ void __launch_bounds__(512) fwd_megakernel(Params p) {
  __shared__ __attribute__((aligned(1024))) char smem[155648];
  cg::grid_group grid = cg::this_grid();
  const int G = gridDim.x;
  char* ws = p.ws;
  unsigned* bar = (unsigned*)(ws + OFF_BAR);
  volatile LAS unsigned* xst = (volatile LAS unsigned*)(smem + 155648 - 16);
  if (threadIdx.x == 0) { xst[0] = 0u; xst[1] = 0u; }
  const XcdBarrier xb = xcd_barrier_post(bar, xst);

  phase_prep(p, smem);
  if (p.out == nullptr) grid.sync();
  xcd_barrier(xb);

  phase_inproj(p, smem);
  xcd_barrier(xb);

  for (int k = 0; k * G < 1024; ++k) {
    int j = (k & 1) ? (G - 1 - (int)blockIdx.x) : (int)blockIdx.x;
    int idx = k * G + j;
    if (idx < 1024) dsa_thr_item(p, idx & 7, 127 - (idx >> 3), smem);
  }
  for (int it = blockIdx.x; it < 2048; it += G) gla_g1_item(p, it, smem);
  xcd_barrier(xb);

  for (int k = 0; k * G < 1024; ++k) {
    int j = (k & 1) ? (G - 1 - (int)blockIdx.x) : (int)blockIdx.x;
    int idx = k * G + j;
    if (idx < 1024) dsa_attn_item(p, idx & 7, 127 - (idx >> 3), smem);
  }
  gla_scan(p);
  xcd_barrier(xb);

  for (int it = blockIdx.x; it < 2048; it += G) gla_g3_item(p, it, smem);
  xcd_barrier(xb);

  phase_gemm<0>(p, (const u16*)(ws + OFF_XB), (const u16*)(ws + OFF_WOUT), 1024, p.x, (float*)(ws + OFF_H), nullptr, 0, smem);
  xcd_barrier(xb);
  phase_ln(p, (float*)(ws + OFF_H), (u16*)(ws + OFF_HB), p.ln_mix_g, p.ln_mix_b);
  xcd_barrier(xb);

  phase_gemm<2>(p, (const u16*)(ws + OFF_HB), (const u16*)(ws + OFF_WQ), 1024, nullptr, nullptr, (u16*)(ws + OFF_QX), 1024, smem);
  xcd_barrier(xb);
  phase_xattn(p);
  xcd_barrier(xb);
  phase_gemm<0>(p, (const u16*)(ws + OFF_OX), (const u16*)(ws + OFF_WO), 1024, (const float*)(ws + OFF_H), (float*)(ws + OFF_H), nullptr, 0, smem);
  xcd_barrier(xb);
  phase_ln(p, (float*)(ws + OFF_H), (u16*)(ws + OFF_HB), p.ln_mem_g, p.ln_mem_b);
  xcd_barrier(xb);

  phase_gemm<5>(p, (const u16*)(ws + OFF_HB), (const u16*)(ws + OFF_WPQ), 2048, nullptr, nullptr, (u16*)(ws + OFF_QX), 2048, smem);
  xcd_barrier(xb);
  for (int it = blockIdx.x; it < 2048; it += G) peer_topk_item(p, it >> 3, it & 7, smem);
  xcd_barrier(xb);
  phase_peer_down(p);
  xcd_barrier(xb);
  phase_peer_ffn(p);
}

extern "C" void kernel_launch(void* const* d_in, const int* in_sizes, int n_in,
                              void* d_out, int out_size, void* d_ws, size_t ws_size,
                              hipStream_t stream) {
  static int grid_blocks = 0;
  if (!grid_blocks) {
    int dev = 0, cus = 0, per_cu = 0;
    (void)hipGetDevice(&dev);
    (void)hipDeviceGetAttribute(&cus, hipDeviceAttributeMultiprocessorCount, dev);
    (void)hipOccupancyMaxActiveBlocksPerMultiprocessor(&per_cu, fwd_megakernel, 512, 0);
    if (per_cu > 1) per_cu = 1;
    grid_blocks = cus * per_cu;
    if (grid_blocks > 256) grid_blocks = 256;
    if (ws_size < 512 * MiB) fprintf(stderr, "workspace too small: %zu\n", ws_size);
  }
  Params p{};
  p.x = (const float*)d_in[0]; p.positions = (const int*)d_in[1]; p.mem = (const float*)d_in[2]; p.w_in = (const float*)d_in[3];
  p.gate_up = (const float*)d_in[4]; p.gate_bias = (const float*)d_in[5]; p.norm_g = (const float*)d_in[6]; p.w_out = (const float*)d_in[7];
  p.ln_mix_g = (const float*)d_in[8]; p.ln_mix_b = (const float*)d_in[9];
  p.wq = (const float*)d_in[10]; p.wk = (const float*)d_in[11]; p.wv = (const float*)d_in[12]; p.wo = (const float*)d_in[13];
  p.ln_mem_g = (const float*)d_in[14]; p.ln_mem_b = (const float*)d_in[15];
  p.w_pq = (const float*)d_in[16]; p.sk1 = (const float*)d_in[17]; p.sk2 = (const float*)d_in[18];
  p.ex_down = (const float*)d_in[19]; p.ex_up = (const float*)d_in[20];
  p.ln_ffn_g = (const float*)d_in[21]; p.ln_ffn_b = (const float*)d_in[22];
  p.out = (float*)d_out; p.ws = (char*)d_ws;
  (void)hipMemsetAsync((char*)d_ws + OFF_BAR, 0, XCD_BAR_WORDS * sizeof(unsigned), stream);
  void* args[] = {&p};
  hipError_t e = hipLaunchCooperativeKernel((void*)fwd_megakernel, dim3(grid_blocks), dim3(512), args, 0, stream);
  if (e != hipSuccess) fprintf(stderr, "cooperative launch failed: %s (grid %d)\n", hipGetErrorString(e), grid_blocks);
}
```
